# Optimizing an MI355X kernel written in HIP

```python
import jax, jax.numpy as jnp
from jax import lax
import numpy as np

D_MODEL = 1024
BATCH = 2
SEQ = 16384
DEPTH = 2

HEAD_DIM = 64
ATT_SLOTS = 8
DIL_PATTERNS = ((128, 1), (512, 4), (2048, 16))
N_DIL = 3
ATT_SUBHEADS = ATT_SLOTS * N_DIL
ATT_BLOCK = 128
ATT_Q = ATT_SUBHEADS * HEAD_DIM
ATT_KV = ATT_SLOTS * HEAD_DIM
ALIBI_MAX_EXP = 8.0
CONV_CH = 512
CONV_K = 31
MLSTM_HEADS = 4
MLSTM_DH = 128
MLSTM_W = MLSTM_HEADS * MLSTM_DH
MLSTM_CONV_K = 4
MLSTM_CHUNK = 128
N_BRANCH = 3
N_GROUPS_MOE = 4
EXPERTS_PER_GROUP = 8
N_EXPERTS = N_GROUPS_MOE * EXPERTS_PER_GROUP
TOP_K = 2
D_EXPERT = 256
MOE_BLOCK = 128
PLE_DIM = 256
EPS = 1e-6

SPLITS = (ATT_Q, ATT_KV, ATT_KV, 2 * CONV_CH, MLSTM_W, MLSTM_W, MLSTM_W, MLSTM_W,
          MLSTM_HEADS, MLSTM_HEADS, N_BRANCH * D_MODEL)
D_IN = sum(SPLITS)
SPLIT_IDX = tuple(int(c) for c in np.cumsum(SPLITS)[:-1])

kernel_name = "hybrid_dilated_conv_mlstm_hmoe"


def rmsnorm(x, g):
    xf = x.astype(jnp.float32)
    r = lax.rsqrt(jnp.mean(xf * xf, axis=-1, keepdims=True) + EPS)
    return (xf * r).astype(x.dtype) * g


def layernorm(x, g, b):
    xf = x.astype(jnp.float32)
    mu = jnp.mean(xf, axis=-1, keepdims=True)
    var = jnp.mean(jnp.square(xf - mu), axis=-1, keepdims=True)
    return ((xf - mu) * lax.rsqrt(var + EPS)).astype(x.dtype) * g + b


def causal_dwconv(x, w, b):
    k, c = w.shape
    y = lax.conv_general_dilated(x, w[:, None, :], window_strides=(1,), padding=((k - 1, 0),),
                                 dimension_numbers=("NWC", "WIO", "NWC"), feature_group_count=c)
    return y + b


def alibi_slopes():
    j = jnp.arange(1, ATT_SUBHEADS + 1, dtype=jnp.float32)
    return (2.0 ** (-ALIBI_MAX_EXP * j / ATT_SUBHEADS)).reshape(N_DIL, ATT_SLOTS)


def _window_attend(q, k, v, slopes, dilation, steps):
    n, l, h, hd = q.shape
    nb = l // ATT_BLOCK
    qb = q.reshape(n, nb, ATT_BLOCK, h, hd)
    kb = k.reshape(n, nb, ATT_BLOCK, h, hd)
    vb = v.reshape(n, nb, ATT_BLOCK, h, hd)
    prev = ((0, 0), (1, 0), (0, 0), (0, 0), (0, 0))
    k2 = jnp.concatenate([jnp.pad(kb[:, :-1], prev), kb], axis=2)
    v2 = jnp.concatenate([jnp.pad(vb[:, :-1], prev), vb], axis=2)
    qi = jnp.arange(ATT_BLOCK)[:, None] + ATT_BLOCK
    ki = jnp.arange(2 * ATT_BLOCK)[None, :]
    dist = qi - ki
    kabs = jnp.arange(nb)[:, None, None] * ATT_BLOCK + ki[None] - ATT_BLOCK
    valid = (dist >= 0) & (dist <= steps) & (kabs >= 0)
    bias = -(slopes[:, None, None] * (dilation * dist).astype(jnp.float32))
    s = jnp.einsum("nbqhd,nbkhd->nbhqk", qb, k2).astype(jnp.float32) + bias
    s = jnp.where(valid[None, :, None], s, -jnp.inf)
    m = jnp.max(s, axis=-1, keepdims=True)
    pr = jnp.exp(s - m)
    den = jnp.sum(pr, axis=-1, keepdims=True)
    o = jnp.einsum("nbhqk,nbkhd->nbqhd", pr / den, v2.astype(jnp.float32))
    lse = (m + jnp.log(den))[..., 0]
    return o.reshape(n, l, h, hd), lse.transpose(0, 1, 3, 2).reshape(n, l, h)


def dilated_attention(q, k, v):
    b, s = q.shape[0], q.shape[1]
    slopes = alibi_slopes()
    q = q * HEAD_DIM ** -0.5
    outs, lses = [], []
    for g, (window, dil) in enumerate(DIL_PATTERNS):
        l = s // dil
        lp = -(-l // ATT_BLOCK) * ATT_BLOCK

        def to_sub(t):
            t = t.reshape(b, l, dil, ATT_SLOTS, HEAD_DIM).transpose(0, 2, 1, 3, 4)
            t = t.reshape(b * dil, l, ATT_SLOTS, HEAD_DIM)
            return jnp.pad(t, ((0, 0), (0, lp - l), (0, 0), (0, 0)))

        o, lse = _window_attend(to_sub(q[:, :, g]), to_sub(k), to_sub(v), slopes[g], dil, window // dil)
        o = o[:, :l].reshape(b, dil, l, ATT_SLOTS, HEAD_DIM).transpose(0, 2, 1, 3, 4)
        lse = lse[:, :l].reshape(b, dil, l, ATT_SLOTS).transpose(0, 2, 1, 3)
        outs.append(o.reshape(b, s, ATT_SLOTS, HEAD_DIM))
        lses.append(lse.reshape(b, s, ATT_SLOTS))
    wts = jax.nn.softmax(jnp.stack(lses, axis=0), axis=0)
    o = jnp.einsum("gbsh,gbshd->bshd", wts, jnp.stack(outs, axis=0))
    return o.reshape(b, s, ATT_SLOTS * HEAD_DIM).astype(k.dtype)


def conformer_conv(u, dw_w, dw_b, ln_g, ln_b):
    a, gt = jnp.split(u, 2, axis=-1)
    y = a * jax.nn.sigmoid(gt)
    y = causal_dwconv(y, dw_w, dw_b)
    y = layernorm(y, ln_g, ln_b)
    return jax.nn.silu(y)


def mlstm(q, k, v, i_pre, f_pre):
    b, s, h, dh = q.shape
    lc = MLSTM_CHUNK
    nc = s // lc
    f32 = jnp.float32

    def chunks(t):
        return t.astype(f32).reshape(b, nc, lc, h, -1).transpose(0, 3, 1, 2, 4)

    def gchunks(t):
        return t.astype(f32).reshape(b, nc, lc, h).transpose(0, 3, 1, 2)

    qc, kc, vc = chunks(q), chunks(k) * dh ** -0.5, chunks(v)
    ig = gchunks(i_pre)
    lf = jax.nn.log_sigmoid(gchunks(f_pre))
    bcum = jnp.cumsum(lf, axis=-1)
    gtot = bcum[..., -1]
    causal = jnp.tril(jnp.ones((lc, lc), dtype=bool))
    dmat = bcum[..., :, None] - bcum[..., None, :] + ig[..., None, :]
    dmat = jnp.where(causal, dmat, -jnp.inf)
    wst = gtot[..., None] - bcum + ig
    m_loc = jnp.max(wst, axis=-1)
    e = jnp.exp(wst - m_loc[..., None])
    c_loc = jnp.einsum("bhcl,bhclv,bhclk->bhcvk", e, vc, kc)
    n_loc = jnp.einsum("bhcl,bhclk->bhck", e, kc)

    def step(carry, inp):
        c_prev, n_prev, m_prev = carry
        cl, nl, ml, gc = inp
        m_new = jnp.maximum(gc + m_prev, ml)
        a = jnp.exp(gc + m_prev - m_new)
        bb = jnp.exp(ml - m_new)
        c_new = a[..., None, None] * c_prev + bb[..., None, None] * cl
        n_new = a[..., None] * n_prev + bb[..., None] * nl
        return (c_new, n_new, m_new), (c_prev, n_prev, m_prev)

    init = (jnp.zeros((b, h, dh, dh), f32), jnp.zeros((b, h, dh), f32), jnp.zeros((b, h), f32))
    xs = (jnp.moveaxis(c_loc, 2, 0), jnp.moveaxis(n_loc, 2, 0), jnp.moveaxis(m_loc, 2, 0), jnp.moveaxis(gtot, 2, 0))
    _, (c_st, n_st, m_st) = lax.scan(step, init, xs)
    c_st = jnp.moveaxis(c_st, 0, 2)
    n_st = jnp.moveaxis(n_st, 0, 2)
    m_st = jnp.moveaxis(m_st, 0, 2)
    a_inter = bcum + m_st[..., None]
    m_t = jnp.maximum(a_inter, jnp.max(dmat, axis=-1))
    w_intra = jnp.exp(dmat - m_t[..., None])
    sc = jnp.einsum("bhcqd,bhckd->bhcqk", qc, kc) * w_intra
    s_inter = jnp.exp(a_inter - m_t)
    num = jnp.einsum("bhcqk,bhckv->bhcqv", sc, vc) + s_inter[..., None] * jnp.einsum("bhcvk,bhcqk->bhcqv", c_st, qc)
    den = jnp.sum(sc, axis=-1) + s_inter * jnp.einsum("bhck,bhcqk->bhcq", n_st, qc)
    hout = num / jnp.maximum(jnp.abs(den), jnp.exp(-m_t))[..., None]
    return hout.transpose(0, 2, 3, 1, 4).reshape(b, s, h * dh).astype(q.dtype)


def expert_dispatch(xf, eid, wts, w_gate, w_up, w_down):
    t, d = xf.shape
    a = t * TOP_K
    e_flat = eid.reshape(a)
    tok = jnp.arange(a, dtype=jnp.int32) // TOP_K
    order = jnp.argsort(e_flat)
    e_sorted = e_flat[order]
    counts = jnp.zeros((N_EXPERTS,), jnp.int32).at[e_flat].add(1)
    padded = (counts + MOE_BLOCK - 1) // MOE_BLOCK * MOE_BLOCK
    start = jnp.cumsum(counts) - counts
    ends_p = jnp.cumsum(padded)
    pstart = ends_p - padded
    dest = pstart[e_sorted] + (jnp.arange(a, dtype=jnp.int32) - start[e_sorted])
    p_len = a + N_EXPERTS * MOE_BLOCK
    nb = p_len // MOE_BLOCK
    buf_tok = jnp.full((p_len,), t, jnp.int32).at[dest].set(tok[order])
    buf_w = jnp.zeros((p_len,), xf.dtype).at[dest].set(wts.reshape(a)[order].astype(xf.dtype))
    blk_e = jnp.minimum(jnp.searchsorted(ends_p, jnp.arange(nb, dtype=jnp.int32) * MOE_BLOCK, side="right"), N_EXPERTS - 1)
    x_pad = jnp.concatenate([xf, jnp.zeros((1, d), xf.dtype)], axis=0)

    def run_block(args):
        idx, e, w = args
        xb = x_pad[idx]
        hb = jax.nn.silu(xb @ w_gate[e]) * (xb @ w_up[e])
        return (hb @ w_down[e]) * w[:, None]

    yb = lax.map(run_block, (buf_tok.reshape(nb, MOE_BLOCK), blk_e, buf_w.reshape(nb, MOE_BLOCK)))
    out = jnp.zeros((t + 1, d), yb.dtype).at[buf_tok].add(yb.reshape(p_len, d))
    return out[:t]


def hier_moe(h, w_rg, b_rg, w_re, b_re, w_gate, w_up, w_down):
    b, s, d = h.shape
    t = b * s
    hf = h.reshape(t, d)
    rows = jnp.arange(t)
    lg = (hf @ w_rg).astype(jnp.float32) + b_rg
    pg = jax.nn.softmax(lg, axis=-1)
    _, g_sel = lax.top_k(lg, 1)
    g_sel = g_sel[:, 0]
    p_g = pg[rows, g_sel]
    le = ((hf @ w_re).astype(jnp.float32) + b_re).reshape(t, N_GROUPS_MOE, EXPERTS_PER_GROUP)
    le_sel = le[rows, g_sel]
    top_v, top_i = lax.top_k(le_sel, TOP_K)
    wts = p_g[:, None] * jax.nn.softmax(top_v, axis=-1)
    eid = g_sel[:, None] * EXPERTS_PER_GROUP + top_i
    return expert_dispatch(hf, eid, wts, w_gate, w_up, w_down).reshape(b, s, d)


def setup_inputs(seed: int = 0) -> dict:
    key = jax.random.key(seed)
    ks = jax.random.split(key, 28)
    f32 = jnp.float32
    L, D = DEPTH, D_MODEL

    def nrm(k, shape, scale):
        return jax.random.normal(k, shape, f32) * scale

    def gain(k, shape):
        return 1.0 + 0.05 * jax.random.normal(k, shape, f32)

    return {
        "x": nrm(ks[0], (BATCH, SEQ, D), 1.0),
        "p": nrm(ks[1], (DEPTH, BATCH, SEQ, PLE_DIM), 1.0),
        "g_mix": gain(ks[2], (L, D)),
        "w_in": nrm(ks[3], (L, D, D_IN), D ** -0.5),
        "conv_w": nrm(ks[4], (L, CONV_K, CONV_CH), CONV_K ** -0.5),
        "conv_b": nrm(ks[5], (L, CONV_CH), 0.02),
        "conv_ln_g": gain(ks[6], (L, CONV_CH)),
        "conv_ln_b": nrm(ks[7], (L, CONV_CH), 0.02),
        "mlstm_conv_w": nrm(ks[8], (L, MLSTM_CONV_K, 2 * MLSTM_W), MLSTM_CONV_K ** -0.5),
        "mlstm_conv_b": nrm(ks[9], (L, 2 * MLSTM_W), 0.02),
        "mlstm_i_bias": nrm(ks[10], (L, MLSTM_HEADS), 0.1),
        "mlstm_f_bias": jnp.linspace(3.0, 6.0, MLSTM_HEADS, dtype=f32) + nrm(ks[11], (L, MLSTM_HEADS), 0.1),
        "w_br_att": nrm(ks[12], (L, ATT_KV, D), ATT_KV ** -0.5),
        "w_br_conv": nrm(ks[13], (L, CONV_CH, D), CONV_CH ** -0.5),
        "w_br_mlstm": nrm(ks[14], (L, MLSTM_W, D), MLSTM_W ** -0.5),
        "w_out": nrm(ks[15], (L, D, D), D ** -0.5),
        "g_ffn": gain(ks[16], (L, D)),
        "w_router_g": nrm(ks[17], (L, D, N_GROUPS_MOE), D ** -0.5),
        "b_router_g": nrm(ks[18], (L, N_GROUPS_MOE), 0.01),
        "w_router_e": nrm(ks[19], (L, D, N_EXPERTS), D ** -0.5),
        "b_router_e": nrm(ks[20], (L, N_EXPERTS), 0.01),
        "w_exp_gate": nrm(ks[21], (L, N_EXPERTS, D, D_EXPERT), D ** -0.5),
        "w_exp_up": nrm(ks[22], (L, N_EXPERTS, D, D_EXPERT), D ** -0.5),
        "w_exp_down": nrm(ks[23], (L, N_EXPERTS, D_EXPERT, D), D_EXPERT ** -0.5),
        "g_ple": gain(ks[24], (L, D)),
        "w_ple_gate": nrm(ks[25], (L, D, D), D ** -0.5),
        "w_ple_proj": nrm(ks[26], (L, PLE_DIM, D), PLE_DIM ** -0.5),
        "g_final": gain(ks[27], (D,)),
    }


def reference(x, p, g_mix, w_in, conv_w, conv_b, conv_ln_g, conv_ln_b, mlstm_conv_w, mlstm_conv_b,
              mlstm_i_bias, mlstm_f_bias, w_br_att, w_br_conv, w_br_mlstm, w_out, g_ffn,
              w_router_g, b_router_g, w_router_e, b_router_e, w_exp_gate, w_exp_up, w_exp_down,
              g_ple, w_ple_gate, w_ple_proj, g_final):
    b, s, d = x.shape
    for i in range(DEPTH):
        h = rmsnorm(x, g_mix[i])
        proj = h @ w_in[i]
        (q_a, k_a, v_a, u_conv, q_m, k_m, v_m, o_m, i_m, f_m, gate_pre) = jnp.split(proj, SPLIT_IDX, axis=-1)
        y_att = dilated_attention(q_a.reshape(b, s, N_DIL, ATT_SLOTS, HEAD_DIM),
                                  k_a.reshape(b, s, ATT_SLOTS, HEAD_DIM),
                                  v_a.reshape(b, s, ATT_SLOTS, HEAD_DIM))
        y_conv = conformer_conv(u_conv, conv_w[i], conv_b[i], conv_ln_g[i], conv_ln_b[i])
        qk = jax.nn.silu(causal_dwconv(jnp.concatenate([q_m, k_m], axis=-1), mlstm_conv_w[i], mlstm_conv_b[i]))
        q_c, k_c = jnp.split(qk, 2, axis=-1)
        h_m = mlstm(q_c.reshape(b, s, MLSTM_HEADS, MLSTM_DH), k_c.reshape(b, s, MLSTM_HEADS, MLSTM_DH),
                    v_m.reshape(b, s, MLSTM_HEADS, MLSTM_DH), i_m + mlstm_i_bias[i], f_m + mlstm_f_bias[i])
        y_m = jax.nn.sigmoid(o_m) * h_m
        gates = jax.nn.sigmoid(gate_pre).reshape(b, s, N_BRANCH, d)
        merged = (gates[..., 0, :] * (y_att @ w_br_att[i])
                  + gates[..., 1, :] * (y_conv @ w_br_conv[i])
                  + gates[..., 2, :] * (y_m @ w_br_mlstm[i]))
        x = x + merged @ w_out[i]
        h2 = rmsnorm(x, g_ffn[i])
        x = x + hier_moe(h2, w_router_g[i], b_router_g[i], w_router_e[i], b_router_e[i],
                         w_exp_gate[i], w_exp_up[i], w_exp_down[i])
        hp = rmsnorm(x, g_ple[i])
        x = x + jax.nn.sigmoid(hp @ w_ple_gate[i]) * (p[i] @ w_ple_proj[i])
    return rmsnorm(x, g_final)
```

```cpp
#include <hip/hip_runtime.h>
#include <cstdio>
#include <cstdint>

#ifndef MK_MEGA
#define MK_MEGA 1
#endif

#ifndef ABL
#define ABL 0
#endif
#define LAS __attribute__((address_space(3)))
#define GAS __attribute__((address_space(1)))
typedef unsigned short bf16_t;
typedef short bf16x8 __attribute__((ext_vector_type(8)));
typedef float f32x4 __attribute__((ext_vector_type(4)));
typedef float f32x2 __attribute__((ext_vector_type(2)));
typedef unsigned u32x4 __attribute__((ext_vector_type(4)));
typedef unsigned u32x2 __attribute__((ext_vector_type(2)));

constexpr int T = 32768, SEQ = 16384, D = 1024, DEPTH = 2;
constexpr int D_IN = 8712;
constexpr float EPS = 1e-6f;
constexpr int NTHREADS = 512, NWAVES = 8;
constexpr int LISTCAP = 40960;

constexpr size_t MiB = 1u << 20;
constexpr size_t WS_CTL = 0, CTL_ZERO_BYTES = 1 * MiB;
constexpr size_t WS_TAB = 1 * MiB;
constexpr size_t WS_ROUTE = 2 * MiB;
constexpr size_t WS_LISTS = 3 * MiB;
constexpr size_t WS_SS0 = 4 * MiB, WS_SS1 = 6 * MiB;
constexpr size_t WS_IF = 8 * MiB;
constexpr size_t WS_NST = 9 * MiB;
constexpr size_t WS_LOGITS = 10 * MiB;
constexpr size_t WS_WIN = 18 * MiB;
constexpr size_t WS_WBR = WS_WIN + 8960ull * 1024 * 2;
constexpr size_t WS_WOUT = WS_WBR + 3ull * 1024 * 512 * 2;
constexpr size_t WS_WPG = WS_WOUT + 1024ull * 1024 * 2;
constexpr size_t WS_WPP = WS_WPG + 1024ull * 1024 * 2;
constexpr size_t WS_WR = WS_WPP + 1024ull * 256 * 2;
static_assert(WS_WR + 256ull * 1024 * 2 <= 44 * MiB, "small weights");
constexpr size_t WS_XB = 44 * MiB;
constexpr size_t WS_QA0 = 108 * MiB;
constexpr size_t WS_YATT = WS_QA0;
constexpr size_t WS_OM = 140 * MiB;
constexpr size_t WS_YC = 172 * MiB;
constexpr size_t WS_CST = 204 * MiB;
constexpr size_t WS_B = 236 * MiB;
constexpr size_t WS_KA = WS_B, WS_QA1 = WS_B + 32 * MiB, WS_QA2 = WS_B + 64 * MiB, WS_VA = WS_B + 96 * MiB, WS_YG = WS_B + 128 * MiB, WS_QM = WS_B + 160 * MiB, WS_KM = WS_B + 192 * MiB, WS_VM = WS_B + 224 * MiB;
constexpr size_t WS_G0 = WS_B, WS_MERGED = WS_B + 192 * MiB;
constexpr size_t WS_WEXP = WS_B, WS_HB = WS_B + 48 * MiB, WS_PBF = WS_B + 88 * MiB, WS_PE = WS_B + 104 * MiB, WS_YB1 = WS_B + 168 * MiB, WS_XBT = WS_B;
constexpr size_t WS_END = 492 * MiB;
constexpr size_t TAB_CNT = 0;
constexpr size_t TAB_META = 65536;
constexpr size_t TAB_MLOC = 131072, TAB_GTOT = 131072 + 4096, TAB_MST = 131072 + 8192;

constexpr int RING_BYTES = 131072;
constexpr int MISC_OFF = 155648;
constexpr int LDS_BYTES = 156672;

__device__ __forceinline__ unsigned f2bf(float f) { unsigned u = __builtin_bit_cast(unsigned, f); return (u + 0x7fffu + ((u >> 16) & 1u)) >> 16; }
__device__ __forceinline__ unsigned pk2(float lo, float hi) { return f2bf(lo) | (f2bf(hi) << 16); }
__device__ __forceinline__ unsigned cvt_pk_bf16(float lo, float hi) { unsigned r; asm volatile("v_cvt_pk_bf16_f32 %0, %1, %2" : "=v"(r) : "v"(lo), "v"(hi)); return r; }
__device__ __forceinline__ float bf_lo(unsigned w) { return __builtin_bit_cast(float, w << 16); }
__device__ __forceinline__ float bf_hi(unsigned w) { return __builtin_bit_cast(float, w & 0xffff0000u); }
__device__ __forceinline__ float bf1(bf16_t h) { return __builtin_bit_cast(float, ((unsigned)h) << 16); }
__device__ __forceinline__ float sigmoidf_(float v) { return 1.0f / (1.0f + __expf(-v)); }
__device__ __forceinline__ float siluf_(float v) { return v / (1.0f + __expf(-v)); }
__device__ __forceinline__ float wave_sum(float v) {
#pragma unroll
    for (int o = 1; o < 64; o <<= 1) v += __shfl_xor(v, o);
    return v;
}
__device__ __forceinline__ float wave_max(float v) {
#pragma unroll
    for (int o = 1; o < 64; o <<= 1) v = fmaxf(v, __shfl_xor(v, o));
    return v;
}
__device__ __forceinline__ int lane_id_() { int l; asm volatile("v_mbcnt_lo_u32_b32 %0, -1, 0\n\tv_mbcnt_hi_u32_b32 %0, -1, %0" : "=&v"(l)); return l; }
#define LDS_WAIT() asm volatile("s_waitcnt lgkmcnt(0)" ::: "memory")
#define VM_WAIT() asm volatile("s_waitcnt vmcnt(0)" ::: "memory")

#define XB_TMO      128
#define XB_XCNT(j)  (256  + 64 * (j))
#define XB_XSUB(j)  (1280 + 64 * (j))
#define XB_XGEN(j)  (2304 + 64 * (j))
#define XB_TOP      3328
#define XB_TOPGEN   3392
#define XCD_BAR_WORDS 3456
#define XB_SPIN_CAP (1u << 22)
__device__ __forceinline__ unsigned xb_ld(unsigned* p)              { return __hip_atomic_load(p, __ATOMIC_RELAXED, __HIP_MEMORY_SCOPE_AGENT); }
__device__ __forceinline__ unsigned xb_add(unsigned* p, unsigned v) { return __hip_atomic_fetch_add(p, v, __ATOMIC_RELAXED, __HIP_MEMORY_SCOPE_AGENT); }
__device__ __forceinline__ unsigned xb_xcc_id() { return (unsigned)__builtin_amdgcn_s_getreg((3 << 11) | 20) & 0xFu; }
#define XB_SPIN(cond, bar) do { unsigned _sp = 0; while (cond) { __builtin_amdgcn_s_sleep(1); \
    if ((++_sp & 255u) == 0u) { if (xb_ld(&(bar)[XB_TMO])) break; if (_sp > XB_SPIN_CAP) { atomicAdd(&(bar)[XB_TMO], 1u); break; } } } } while (0)
struct XcdBarrier { unsigned* bar; unsigned x; volatile LAS unsigned* st; int wave; };
__device__ __forceinline__ XcdBarrier xcd_barrier_post(unsigned* bar, volatile LAS unsigned* st, int wave) {
    XcdBarrier b; b.bar = bar; b.x = xb_xcc_id(); b.st = st; b.wave = wave;
    if (wave == 0 && lane_id_() == 0) (void)xb_add(&bar[XB_XCNT(b.x)], 1u);
    return b;
}
__device__ __forceinline__ void xcd_barrier_complete(unsigned* bar, unsigned x, unsigned& nloc, unsigned& nx) {
    const unsigned G = gridDim.x * gridDim.y * gridDim.z;
    unsigned sum, cnt, mine, sp = 0u;
    for (;;) {
        sum = 0u; cnt = 0u; mine = 0u;
#pragma unroll
        for (unsigned j = 0; j < 16; ++j) { const unsigned c = xb_ld(&bar[XB_XCNT(j)]); sum += c; cnt += (c > 0u) ? 1u : 0u; mine = (j == x) ? c : mine; }
        if (sum == G) break;
        __builtin_amdgcn_s_sleep(1);
        if ((++sp & 255u) == 0u) { if (xb_ld(&bar[XB_TMO])) break; if (sp > XB_SPIN_CAP) { atomicAdd(&bar[XB_TMO], 1u); break; } }
    }
    nloc = mine > 0u ? mine : 1u; nx = cnt > 0u ? cnt : 1u;
}
__device__ __forceinline__ void xcd_barrier(const XcdBarrier& b) {
    asm volatile("s_waitcnt vmcnt(0)" ::: "memory");
    __syncthreads();
    if (b.wave == 0 && lane_id_() == 0) {
        unsigned* bar = b.bar;
        __builtin_amdgcn_s_waitcnt(0);
        unsigned nloc = b.st[0], nx = b.st[1];
        if (nloc == 0u) { xcd_barrier_complete(bar, b.x, nloc, nx); b.st[0] = nloc; b.st[1] = nx; }
        const unsigned old = xb_add(&bar[XB_XSUB(b.x)], 1u);
        const unsigned gen = old / nloc;
        if (old + 1u == (gen + 1u) * nloc) {
            __builtin_amdgcn_fence(__ATOMIC_RELEASE, "agent");
            asm volatile("s_waitcnt vmcnt(0)" ::: "memory");
            const unsigned og = xb_add(&bar[XB_TOP], 1u);
            const unsigned tg = og / nx;
            if (og + 1u == (tg + 1u) * nx) xb_add(&bar[XB_TOPGEN], 1u);
            else XB_SPIN(xb_ld(&bar[XB_TOPGEN]) == tg, bar);
            __builtin_amdgcn_fence(__ATOMIC_ACQUIRE, "agent");
            xb_add(&bar[XB_XGEN(b.x)], 1u);
            asm volatile("s_waitcnt vmcnt(0)" ::: "memory");
        } else {
            XB_SPIN(xb_ld(&bar[XB_XGEN(b.x)]) == gen, bar);
            __builtin_amdgcn_fence(__ATOMIC_ACQUIRE, "agent");
            asm volatile("s_waitcnt vmcnt(0)" ::: "memory");
        }
    }
    __syncthreads();
}

namespace pg8 {
constexpr int BM = 256, BK = 64, HALF = 128, HTB = HALF * BK * 2, NXCD = 8, WGM = 8;
__device__ __forceinline__ int lds_byte(int r, int c) { const int st = (r >> 4) * 2 + (c >> 5), rr = r & 15, cc = c & 31, ob = rr * 64 + cc * 2; return st * 1024 + (ob ^ (((ob >> 9) & 1) << 5)); }
__device__ __forceinline__ void stage_rc(int b, int& R, int& C) { const int st = b / 1024, sb = b % 1024, swz = sb ^ (((sb >> 9) & 1) << 5); R = (st >> 1) * 16 + swz / 64; C = (st & 1) * 32 + (swz % 64) / 2; }
__device__ __forceinline__ int perm32(int rho) { const int n = rho >> 4, i = rho & 15; return 8 * (i >> 2) + 4 * n + (i & 3); }

struct GUnit { const char* A; const char* B; int pm, pn, a0, a1; };

__device__ __forceinline__ void tile_order(int L, int nM, int nN, int& pm, int& pn) {
    const int nwg = nM * nN; int wgid = L;
    { const int q = nwg / NXCD, r = nwg % NXCD, xcd = wgid % NXCD, off = wgid / NXCD; wgid = (xcd < r ? xcd * (q + 1) : r * (q + 1) + (xcd - r) * q) + off; }
    const int nig = WGM * nN, gid = wgid / nig, fm = gid * WGM, gsz = (nM - fm) < WGM ? (nM - fm) : WGM;
    pm = fm + ((wgid % nig) % gsz); pn = (wgid % nig) / gsz;
}

typedef f32x4 Acc[2][2][4][2];

template <class P>
__device__ __forceinline__ void gemm_phase(LAS unsigned char* lds, const P& S, int tid) {
    asm volatile("" : "+v"(tid));
    const int wid = __builtin_amdgcn_readfirstlane(tid >> 6), lane = tid & 63, wr = wid >> 2, wc = wid & 3, fr = lane & 15, fq = lane >> 4;
    constexpr int K = P::K, nt = K / BK;
    static_assert(nt >= 4 && (nt % 2) == 0, "K multiple of 128, >= 256");
    unsigned voffB[2];
#pragma unroll
    for (int i = 0; i < 2; ++i) { int R, C; stage_rc(tid * 16 + i * 8192, R, C); const int Rb = (R & ~31) + perm32(R & 31); voffB[i] = (unsigned)(Rb * K + C) * 2u; }
    constexpr size_t kstep = (size_t)(BK * 2);
    constexpr size_t hstepB = (size_t)HALF * K * 2;
    const unsigned ldsw = (unsigned)wid * 1024u;
    const int aoff = lds_byte(wr * 64 + fr, fq * 8), boff = lds_byte(wc * 32 + fr, fq * 8);
#define PG8_SA(b, h) (((b) * 2 + (h)) * HTB)
#define PG8_SB(b, h) ((4 + (b) * 2 + (h)) * HTB)
#define PG8_STAGE(bufoff, gbase, voff) do { _Pragma("unroll") for (int _i = 0; _i < 2; ++_i) \
        __builtin_amdgcn_global_load_lds((const unsigned*)((const char*)(gbase) + (voff)[_i]), (LAS unsigned*)(lds + (bufoff) + ldsw + _i * 8192), 16, 0, 0); } while (0)
#define PG8_LDA(dst, b, h) do { _Pragma("unroll") for (int m = 0; m < 4; ++m) _Pragma("unroll") for (int k = 0; k < 2; ++k) dst[m][k] = *(const LAS bf16x8*)(lds + PG8_SA(b, h) + aoff + m * 2048 + k * 1024); } while (0)
#define PG8_LDB(dst, b, h) do { _Pragma("unroll") for (int n = 0; n < 2; ++n) _Pragma("unroll") for (int k = 0; k < 2; ++k) dst[n][k] = *(const LAS bf16x8*)(lds + PG8_SB(b, h) + boff + n * 2048 + k * 1024); } while (0)
#define PG8_MMA(ai, bj, At, Bt) do { __builtin_amdgcn_s_setprio(1); _Pragma("unroll") for (int m = 0; m < 4; ++m) _Pragma("unroll") for (int n = 0; n < 2; ++n) _Pragma("unroll") for (int k = 0; k < 2; ++k) \
        acc[ai][bj][m][n] = __builtin_amdgcn_mfma_f32_16x16x32_bf16(Bt[n][k], At[m][k], acc[ai][bj][m][n], 0, 0, 0); __builtin_amdgcn_s_setprio(0); } while (0)
#define PG8_WAIT_V(n) asm volatile("s_waitcnt vmcnt(" #n ")" ::: "memory")
#define PG8_WAIT_L(n) asm volatile("s_waitcnt lgkmcnt(" #n ")" ::: "memory")
#define PG8_BAR __builtin_amdgcn_s_barrier()
#define PG8_SCHED __builtin_amdgcn_sched_barrier(0)
#define PG8_VOA(dst, u) do { _Pragma("unroll") for (int _h = 0; _h < 2; ++_h) _Pragma("unroll") for (int _i = 0; _i < 2; ++_i) { int _R, _C; stage_rc(tid * 16 + _i * 8192, _R, _C); \
        if constexpr (P::GATHER) dst[_h][_i] = (S.arow(u, _h * HALF + _R) * (unsigned)K + (unsigned)_C) * 2u; \
        else dst[_h][_i] = (unsigned)((_h * HALF + _R) * K + _C) * 2u; } } while (0)
    GUnit cur, nxt; int ui = 0;
    if (!S.next(0, cur)) return;
    Acc acc;
#pragma unroll
    for (int a = 0; a < 2; ++a)
#pragma unroll
        for (int b = 0; b < 2; ++b)
#pragma unroll
            for (int m = 0; m < 4; ++m)
#pragma unroll
                for (int n = 0; n < 2; ++n) acc[a][b][m][n] = (f32x4){0.f, 0.f, 0.f, 0.f};
    bf16x8 At[4][2], B0[2][2], B1[2][2];
    unsigned voA[2][2], voAn[2][2];
    PG8_VOA(voA, cur);
    const char* cA = cur.A; const char* cB = cur.B;
    PG8_STAGE(PG8_SB(0, 0), cB, voffB); PG8_STAGE(PG8_SB(0, 1), cB + hstepB, voffB); PG8_STAGE(PG8_SA(0, 0), cA, voA[0]); PG8_STAGE(PG8_SA(0, 1), cA, voA[1]);
    if (wr == 1) PG8_BAR;
    PG8_WAIT_V(2); PG8_BAR;
    PG8_STAGE(PG8_SB(1, 0), cB + kstep, voffB); PG8_STAGE(PG8_SA(1, 0), cA + kstep, voA[0]); PG8_STAGE(PG8_SB(1, 1), cB + hstepB + kstep, voffB);
    PG8_WAIT_V(6); PG8_BAR;
    for (;;) {
        const bool has_next = S.next(ui + 1, nxt);
        const char* nA = has_next ? nxt.A : cA; const char* nB = has_next ? nxt.B : cB;
        if constexpr (P::GATHER) {
            if (has_next) { PG8_VOA(voAn, nxt); }
            else {
#pragma unroll
                for (int h = 0; h < 2; ++h)
#pragma unroll
                    for (int i = 0; i < 2; ++i) voAn[h][i] = voA[h][i];
            }
        }
#pragma unroll 1
        for (int t = 0; t < nt; t += 2) {
            const bool last = (t == nt - 2);
            const char* a1 = cA + (size_t)(t + 1) * kstep;
            const char* a2 = last ? nA : cA + (size_t)(t + 2) * kstep; const char* b2 = last ? nB : cB + (size_t)(t + 2) * kstep;
            const char* a3 = a2 + kstep; const char* b3 = b2 + kstep;
            unsigned s0[2], s1[2];
#pragma unroll
            for (int i = 0; i < 2; ++i) {
                if constexpr (P::GATHER) { s0[i] = last ? voAn[0][i] : voA[0][i]; s1[i] = last ? voAn[1][i] : voA[1][i]; }
                else { s0[i] = voA[0][i]; s1[i] = voA[1][i]; }
            }
            PG8_LDB(B0, 0, 0); PG8_LDB(B1, 0, 1); PG8_SCHED; PG8_LDA(At, 0, 0); PG8_STAGE(PG8_SA(1, 1), a1, voA[1]);
            PG8_WAIT_V(8); PG8_WAIT_L(0); PG8_BAR; PG8_MMA(0, 0, At, B0); PG8_MMA(0, 1, At, B1); PG8_BAR; PG8_SCHED;
            PG8_LDA(At, 0, 1); PG8_STAGE(PG8_SB(0, 0), b2, voffB); PG8_STAGE(PG8_SB(0, 1), b2 + hstepB, voffB); PG8_STAGE(PG8_SA(0, 0), a2, s0);
            PG8_WAIT_V(8); PG8_WAIT_L(0); PG8_BAR; PG8_MMA(1, 0, At, B0); PG8_MMA(1, 1, At, B1); PG8_BAR; PG8_SCHED;
            PG8_LDB(B0, 1, 0); PG8_LDB(B1, 1, 1); PG8_SCHED; PG8_LDA(At, 1, 0); PG8_STAGE(PG8_SA(0, 1), a2, s1);
            PG8_WAIT_V(8); PG8_WAIT_L(0); PG8_BAR; PG8_MMA(0, 0, At, B0); PG8_MMA(0, 1, At, B1); PG8_BAR; PG8_SCHED;
            PG8_LDA(At, 1, 1); PG8_STAGE(PG8_SB(1, 0), b3, voffB); PG8_STAGE(PG8_SB(1, 1), b3 + hstepB, voffB); PG8_STAGE(PG8_SA(1, 0), a3, s0);
            PG8_WAIT_V(8); PG8_WAIT_L(0); PG8_BAR; PG8_MMA(1, 0, At, B0); PG8_MMA(1, 1, At, B1); PG8_BAR; PG8_SCHED;
        }
        if (wr == 0) PG8_BAR;
        const bool zero = S.epi(acc, cur, wr, wc, fr, fq);
        if (!has_next) break;
        if (zero) {
#pragma unroll
            for (int a = 0; a < 2; ++a)
#pragma unroll
                for (int b = 0; b < 2; ++b)
#pragma unroll
                    for (int m = 0; m < 4; ++m)
#pragma unroll
                        for (int n = 0; n < 2; ++n) acc[a][b][m][n] = (f32x4){0.f, 0.f, 0.f, 0.f};
        }
        cur = nxt; cA = nA; cB = nB; ++ui;
        if constexpr (P::GATHER) {
#pragma unroll
            for (int h = 0; h < 2; ++h)
#pragma unroll
                for (int i = 0; i < 2; ++i) voA[h][i] = voAn[h][i];
        }
        if (wr == 1) PG8_BAR;
    }
    PG8_WAIT_V(0);
    PG8_BAR;
#undef PG8_SA
#undef PG8_SB
#undef PG8_STAGE
#undef PG8_LDA
#undef PG8_LDB
#undef PG8_MMA
#undef PG8_WAIT_V
#undef PG8_WAIT_L
#undef PG8_BAR
#undef PG8_SCHED
#undef PG8_VOA
}
}
using pg8::GUnit; using pg8::Acc;

__device__ __forceinline__ float row_rs(const float* SS, int row) {
    const f32x4* p = (const f32x4*)(SS + (size_t)row * 16);
    const f32x4 a = p[0], b = p[1], c = p[2], d = p[3];
    const float s = (((a.x + a.y) + (a.z + a.w)) + ((b.x + b.y) + (b.z + b.w))) + (((c.x + c.y) + (c.z + c.w)) + ((d.x + d.y) + (d.z + d.w)));
    return rsqrtf(s * (1.0f / 1024.0f) + EPS);
}
__device__ __forceinline__ u32x4 pack8(const f32x4 v0, const f32x4 v1) { u32x4 w; w.x = cvt_pk_bf16(v0[0], v0[1]); w.y = cvt_pk_bf16(v0[2], v0[3]); w.z = cvt_pk_bf16(v1[0], v1[1]); w.w = cvt_pk_bf16(v1[2], v1[3]); return w; }
__device__ __forceinline__ void unpack8(const u32x4 w, f32x4& v0, f32x4& v1) { v0 = (f32x4){bf_lo(w.x), bf_hi(w.x), bf_lo(w.y), bf_hi(w.y)}; v1 = (f32x4){bf_lo(w.z), bf_hi(w.z), bf_lo(w.w), bf_hi(w.w)}; }
__device__ __forceinline__ f32x4 sig4(const f32x4 v) { return (f32x4){sigmoidf_(v[0]), sigmoidf_(v[1]), sigmoidf_(v[2]), sigmoidf_(v[3])}; }
__device__ __forceinline__ f32x4 gate4(const f32x4 v) { f32x4 s = sig4(v); return (f32x4){fmaxf(s[0], 1e-6f), fmaxf(s[1], 1e-6f), fmaxf(s[2], 1e-6f), fmaxf(s[3], 1e-6f)}; }

struct PhProj {
    static constexpr int K = 1024; static constexpr bool GATHER = false;
    const char* xb; const char* W; const float* SS; unsigned char* ws; int G, c;
    __device__ __forceinline__ bool next(int i, GUnit& u) const {
        const long L = (long)i * G + c; if (L >= 128 * 23) return false;
        pg8::tile_order((int)L, 128, 23, u.pm, u.pn);
        u.A = xb + (size_t)u.pm * 256 * K * 2; u.B = W + (size_t)u.pn * 256 * K * 2; u.a0 = 0; u.a1 = 0; return true;
    }
    __device__ __forceinline__ unsigned arow(const GUnit&, int) const { return 0u; }
    __device__ __forceinline__ bool epi(Acc& acc, const GUnit& u, int wr, int wc, int fr, int fq) const {
        const int pn = u.pn; const int row0 = u.pm * 256 + wr * 64 + fr;
        if (pn == 22) {
            if (wc == 0 && fq == 0) {
                float* IFp = (float*)(ws + WS_IF);
#pragma unroll
                for (int ai = 0; ai < 2; ++ai)
#pragma unroll
                    for (int m = 0; m < 4; ++m) { const int row = row0 + ai * 128 + m * 16; const float rs = row_rs(SS, row);
                        *(f32x4*)(IFp + (size_t)row * 8) = acc[ai][0][m][0] * rs; *(f32x4*)(IFp + (size_t)row * 8 + 4) = acc[ai][0][m][1] * rs; }
            }
            return true;
        }
        if (pn >= 10 && pn < 14) {
            bf16_t* Y = (bf16_t*)(ws + WS_YG);
#pragma unroll
            for (int ai = 0; ai < 2; ++ai)
#pragma unroll
                for (int m = 0; m < 4; ++m) { const int row = row0 + ai * 128 + m * 16; const float rs = row_rs(SS, row);
#pragma unroll
                    for (int bj = 0; bj < 2; ++bj) { const f32x4 a = acc[ai][bj][m][0] * rs, g = sig4(acc[ai][bj][m][1] * rs), y = a * g;
                        u32x2 w; w.x = cvt_pk_bf16(y[0], y[1]); w.y = cvt_pk_bf16(y[2], y[3]);
                        *(u32x2*)(Y + (size_t)row * 512 + (pn - 10) * 128 + bj * 64 + wc * 16 + fq * 4) = w; } }
            return true;
        }
        bf16_t* dst; int col0; bool sg = false;
        if (pn < 6) { dst = (bf16_t*)(ws + (pn < 2 ? WS_QA0 : (pn < 4 ? WS_QA1 : WS_QA2))); col0 = (pn & 1) * 256; }
        else if (pn < 8) { dst = (bf16_t*)(ws + WS_KA); col0 = (pn - 6) * 256; }
        else if (pn < 10) { dst = (bf16_t*)(ws + WS_VA); col0 = (pn - 8) * 256; }
        else if (pn < 16) { dst = (bf16_t*)(ws + WS_QM); col0 = (pn - 14) * 256; }
        else if (pn < 18) { dst = (bf16_t*)(ws + WS_KM); col0 = (pn - 16) * 256; }
        else if (pn < 20) { dst = (bf16_t*)(ws + WS_VM); col0 = (pn - 18) * 256; }
        else { dst = (bf16_t*)(ws + WS_OM); col0 = (pn - 20) * 256; sg = true; }
        col0 += wc * 32 + fq * 8;
#pragma unroll
        for (int ai = 0; ai < 2; ++ai)
#pragma unroll
            for (int m = 0; m < 4; ++m) { const int row = row0 + ai * 128 + m * 16; const float rs = row_rs(SS, row);
#pragma unroll
                for (int bj = 0; bj < 2; ++bj) { f32x4 v0 = acc[ai][bj][m][0] * rs, v1 = acc[ai][bj][m][1] * rs;
                    if (sg) { v0 = sig4(v0); v1 = sig4(v1); }
                    *(u32x4*)(dst + (size_t)row * 512 + col0 + bj * 128) = pack8(v0, v1); } }
        return true;
    }
};
struct PhGates {
    static constexpr int K = 1024; static constexpr bool GATHER = false;
    const char* xb; const char* W; const float* SS; unsigned char* ws; int G, c;
    __device__ __forceinline__ bool next(int i, GUnit& u) const {
        const long L = (long)i * G + c; if (L >= 128 * 12) return false;
        pg8::tile_order((int)L, 128, 12, u.pm, u.pn);
        u.A = xb + (size_t)u.pm * 256 * K * 2; u.B = W + (size_t)(5888 + u.pn * 256) * K * 2; u.a0 = 0; u.a1 = 0; return true;
    }
    __device__ __forceinline__ unsigned arow(const GUnit&, int) const { return 0u; }
    __device__ __forceinline__ bool epi(Acc& acc, const GUnit& u, int wr, int wc, int fr, int fq) const {
        const int row0 = u.pm * 256 + wr * 64 + fr;
        bf16_t* dst = (bf16_t*)(ws + WS_G0 + (size_t)(u.pn >> 2) * 64 * MiB); const int col0 = (u.pn & 3) * 256 + wc * 32 + fq * 8;
#pragma unroll
        for (int ai = 0; ai < 2; ++ai)
#pragma unroll
            for (int m = 0; m < 4; ++m) { const int row = row0 + ai * 128 + m * 16; const float rs = row_rs(SS, row);
#pragma unroll
                for (int bj = 0; bj < 2; ++bj) *(u32x4*)(dst + (size_t)row * 1024 + col0 + bj * 128) = pack8(gate4(acc[ai][bj][m][0] * rs), gate4(acc[ai][bj][m][1] * rs)); }
        return true;
    }
};
struct PhMerge {
    static constexpr int K = 512; static constexpr bool GATHER = false;
    unsigned char* ws; int G, c;
    __device__ __forceinline__ bool next(int i, GUnit& u) const {
        const int ti = i / 3, seg = i - ti * 3; const long L = (long)ti * G + c; if (L >= 128 * 4) return false;
        pg8::tile_order((int)L, 128, 4, u.pm, u.pn);
        const size_t ya = seg == 0 ? WS_YATT : (seg == 1 ? WS_YC : WS_OM);
        u.A = (const char*)ws + ya + (size_t)u.pm * 256 * K * 2; u.B = (const char*)ws + WS_WBR + (size_t)seg * 1024 * 512 * 2 + (size_t)u.pn * 256 * K * 2; u.a0 = seg; u.a1 = 0; return true;
    }
    __device__ __forceinline__ unsigned arow(const GUnit&, int) const { return 0u; }
    __device__ __forceinline__ bool epi(Acc& acc, const GUnit& u, int wr, int wc, int fr, int fq) const {
        const int seg = u.a0; const int row0 = u.pm * 256 + wr * 64 + fr; const int col0 = u.pn * 256 + wc * 32 + fq * 8;
        const bf16_t* Gn = (const bf16_t*)(ws + WS_G0 + (size_t)seg * 64 * MiB);
        const bf16_t* Gd = (const bf16_t*)(ws + WS_G0 + (size_t)(seg + 1) * 64 * MiB);
        bf16_t* Mo = (bf16_t*)(ws + WS_MERGED);
#pragma unroll
        for (int ai = 0; ai < 2; ++ai)
#pragma unroll
            for (int m = 0; m < 4; ++m) { const size_t off = (size_t)(row0 + ai * 128 + m * 16) * 1024 + col0;
#pragma unroll
                for (int bj = 0; bj < 2; ++bj) {
                    f32x4 n0, n1; unpack8(*(const u32x4*)(Gn + off + bj * 128), n0, n1);
                    if (seg < 2) { f32x4 d0, d1; unpack8(*(const u32x4*)(Gd + off + bj * 128), d0, d1);
#pragma unroll
                        for (int j = 0; j < 4; ++j) { acc[ai][bj][m][0][j] *= n0[j] * __builtin_amdgcn_rcpf(d0[j]); acc[ai][bj][m][1][j] *= n1[j] * __builtin_amdgcn_rcpf(d1[j]); } }
                    else *(u32x4*)(Mo + off + bj * 128) = pack8(acc[ai][bj][m][0] * n0, acc[ai][bj][m][1] * n1);
                } }
        return seg == 2;
    }
};
__device__ __forceinline__ float store_x8(float* xp, bf16_t* xbp, const f32x4 v0, const f32x4 v1) {
    *(f32x4*)xp = v0; *(f32x4*)(xp + 4) = v1; *(u32x4*)xbp = pack8(v0, v1);
    return ((v0[0] * v0[0] + v0[1] * v0[1]) + (v0[2] * v0[2] + v0[3] * v0[3])) + ((v1[0] * v1[0] + v1[1] * v1[1]) + (v1[2] * v1[2] + v1[3] * v1[3]));
}
struct PhOut {
    static constexpr int K = 1024; static constexpr bool GATHER = false;
    unsigned char* ws; float* x; float* SSo; int G, c;
    __device__ __forceinline__ bool next(int i, GUnit& u) const {
        const long L = (long)i * G + c; if (L >= 128 * 4) return false;
        pg8::tile_order((int)L, 128, 4, u.pm, u.pn);
        u.A = (const char*)ws + WS_MERGED + (size_t)u.pm * 256 * K * 2; u.B = (const char*)ws + WS_WOUT + (size_t)u.pn * 256 * K * 2; u.a0 = 0; u.a1 = 0; return true;
    }
    __device__ __forceinline__ unsigned arow(const GUnit&, int) const { return 0u; }
    __device__ __forceinline__ bool epi(Acc& acc, const GUnit& u, int wr, int wc, int fr, int fq) const {
        const int row0 = u.pm * 256 + wr * 64 + fr; const int col0 = u.pn * 256 + wc * 32 + fq * 8; bf16_t* XB = (bf16_t*)(ws + WS_XB);
#pragma unroll
        for (int ai = 0; ai < 2; ++ai)
#pragma unroll
            for (int m = 0; m < 4; ++m) { const int row = row0 + ai * 128 + m * 16; const size_t off = (size_t)row * 1024 + col0; float ss = 0.f;
#pragma unroll
                for (int bj = 0; bj < 2; ++bj) { float* xp = x + off + bj * 128; const f32x4 v0 = *(const f32x4*)xp + acc[ai][bj][m][0], v1 = *(const f32x4*)(xp + 4) + acc[ai][bj][m][1];
                    ss += store_x8(xp, XB + off + bj * 128, v0, v1); }
                ss += __shfl_xor(ss, 16); ss += __shfl_xor(ss, 32);
                if (fq == 0) SSo[(size_t)row * 16 + u.pn * 4 + wc] = ss; }
        return true;
    }
};
struct PhRouter {
    static constexpr int K = 1024; static constexpr bool GATHER = false;
    unsigned char* ws; const float* SS; int G, c;
    __device__ __forceinline__ bool next(int i, GUnit& u) const {
        const long L = (long)i * G + c; if (L >= 128) return false;
        u.pm = (int)L; u.pn = 0; u.A = (const char*)ws + WS_XB + (size_t)u.pm * 256 * K * 2; u.B = (const char*)ws + WS_WR; u.a0 = 0; u.a1 = 0; return true;
    }
    __device__ __forceinline__ unsigned arow(const GUnit&, int) const { return 0u; }
    __device__ __forceinline__ bool epi(Acc& acc, const GUnit& u, int wr, int wc, int fr, int fq) const {
        if (wc < 2) { float* Lg = (float*)(ws + WS_LOGITS); const int row0 = u.pm * 256 + wr * 64 + fr;
#pragma unroll
            for (int ai = 0; ai < 2; ++ai)
#pragma unroll
                for (int m = 0; m < 4; ++m) { const int row = row0 + ai * 128 + m * 16; const float rs = row_rs(SS, row); float* p = Lg + (size_t)row * 64 + wc * 32 + fq * 8;
                    *(f32x4*)p = acc[ai][0][m][0] * rs; *(f32x4*)(p + 4) = acc[ai][0][m][1] * rs; } }
        return true;
    }
};
__device__ __forceinline__ int moe_expert_of(const int* META, int k, int rb) {
    const int r = rb * 256; int e = 0;
    for (int j = 1; j < 32; ++j) e += (META[16 + 64 * k + j] <= r) ? 1 : 0;
    return __builtin_amdgcn_readfirstlane(e);
}
struct PhUp {
    static constexpr int K = 1024; static constexpr bool GATHER = true;
    unsigned char* ws; const float* SS; const int* META; const int* tok; int G, c;
    __device__ __forceinline__ bool next(int i, GUnit& u) const {
        const int nb0 = __builtin_amdgcn_readfirstlane(META[0]), nb1 = __builtin_amdgcn_readfirstlane(META[1]); const long L = (long)i * G + c; if (L >= 2L * (nb0 + nb1)) return false;
        int blk = (int)(L >> 1); u.pn = (int)(L & 1); int k = 0; if (blk >= nb0) { k = 1; blk -= nb0; }
        const int e = moe_expert_of(META, k, blk);
        u.pm = blk; u.a0 = k; u.a1 = e; u.A = (const char*)ws + WS_XB; u.B = (const char*)ws + WS_WEXP + (size_t)e * 512 * 1024 * 2 + (size_t)u.pn * 256 * K * 2; return true;
    }
    __device__ __forceinline__ unsigned arow(const GUnit& u, int r) const { const int t = tok[u.a0 * LISTCAP + u.pm * 256 + r]; return t < 0 ? 0u : (unsigned)t; }
    __device__ __forceinline__ bool epi(Acc& acc, const GUnit& u, int wr, int wc, int fr, int fq) const {
        const int lr0 = u.a0 * LISTCAP + u.pm * 256 + wr * 64 + fr; bf16_t* HB = (bf16_t*)(ws + WS_HB);
#pragma unroll
        for (int ai = 0; ai < 2; ++ai)
#pragma unroll
            for (int m = 0; m < 4; ++m) { const int lr = lr0 + ai * 128 + m * 16; const int t = tok[lr]; const float rs = t < 0 ? 0.f : row_rs(SS, t < 0 ? 0 : t);
#pragma unroll
                for (int bj = 0; bj < 2; ++bj) { const f32x4 g = acc[ai][bj][m][0] * rs, uu = acc[ai][bj][m][1] * rs;
                    f32x4 h = (f32x4){siluf_(g[0]) * uu[0], siluf_(g[1]) * uu[1], siluf_(g[2]) * uu[2], siluf_(g[3]) * uu[3]}; if (ABL == 8) h = (f32x4){1.f, 1.f, 1.f, 1.f};
                    u32x2 w; w.x = cvt_pk_bf16(h[0], h[1]); w.y = cvt_pk_bf16(h[2], h[3]);
                    *(u32x2*)(HB + (size_t)lr * 256 + u.pn * 128 + bj * 64 + wc * 16 + fq * 4) = w; }
                asm volatile("" ::: "memory"); }
        return true;
    }
};
template <int KL> struct PhDown {
    static constexpr int K = 256; static constexpr bool GATHER = false;
    unsigned char* ws; float* x; float* SSo; const int* META; const int* tok; const float* wl; int G, c;
    __device__ __forceinline__ bool next(int i, GUnit& u) const {
        const int nb = __builtin_amdgcn_readfirstlane(META[KL]); const long L = (long)i * G + c;
        if (L < 4L * nb) { const int blk = (int)(L >> 2); u.pn = (int)(L & 3); const int e = moe_expert_of(META, KL, blk); u.pm = blk; u.a0 = 0; u.a1 = e;
            u.A = (const char*)ws + WS_HB + (size_t)(KL * LISTCAP + blk * 256) * 256 * 2; u.B = (const char*)ws + WS_WEXP + 32ull * 512 * 1024 * 2 + (size_t)e * 1024 * 256 * 2 + (size_t)u.pn * 256 * K * 2; return true; }
        if (KL == 1) { const long L2 = L - 4L * nb; if (L2 >= 128 * 4) return false;
            pg8::tile_order((int)L2, 128, 4, u.pm, u.pn); u.a0 = 1; u.a1 = 0;
            u.A = (const char*)ws + WS_PBF + (size_t)u.pm * 256 * K * 2; u.B = (const char*)ws + WS_WPP + (size_t)u.pn * 256 * K * 2; return true; }
        return false;
    }
    __device__ __forceinline__ unsigned arow(const GUnit&, int) const { return 0u; }
    __device__ __forceinline__ bool epi(Acc& acc, const GUnit& u, int wr, int wc, int fr, int fq) const {
        const int col0 = u.pn * 256 + wc * 32 + fq * 8;
        if (KL == 1 && u.a0 == 1) {
            bf16_t* PE = (bf16_t*)(ws + WS_PE); const int row0 = u.pm * 256 + wr * 64 + fr;
#pragma unroll
            for (int ai = 0; ai < 2; ++ai)
#pragma unroll
                for (int m = 0; m < 4; ++m)
#pragma unroll
                    for (int bj = 0; bj < 2; ++bj) *(u32x4*)(PE + (size_t)(row0 + ai * 128 + m * 16) * 1024 + col0 + bj * 128) = pack8(acc[ai][bj][m][0], acc[ai][bj][m][1]);
            return true;
        }
        const int lr0 = KL * LISTCAP + u.pm * 256 + wr * 64 + fr; bf16_t* YB = (bf16_t*)(ws + WS_YB1); bf16_t* XB = (bf16_t*)(ws + WS_XB);
#pragma unroll
        for (int ai = 0; ai < 2; ++ai)
#pragma unroll
            for (int m = 0; m < 4; ++m) { const int lr = lr0 + ai * 128 + m * 16; const int t = tok[lr]; const float w = (ABL == 9) ? 1.0f : wl[lr]; const size_t off = (size_t)(t < 0 ? 0 : t) * 1024 + col0;
                if (KL == 1) { if (t >= 0) {
#pragma unroll
                        for (int bj = 0; bj < 2; ++bj) *(u32x4*)(YB + off + bj * 128) = pack8(acc[ai][bj][m][0] * w, acc[ai][bj][m][1] * w); } }
                else { float ss = 0.f;
                    if (t >= 0) {
#pragma unroll
                        for (int bj = 0; bj < 2; ++bj) { float* xp = x + off + bj * 128; f32x4 y0, y1; unpack8(*(const u32x4*)(YB + off + bj * 128), y0, y1);
                            f32x4 v0 = (*(const f32x4*)xp + y0) + acc[ai][bj][m][0] * w, v1 = (*(const f32x4*)(xp + 4) + y1) + acc[ai][bj][m][1] * w; if (ABL == 7) { v0 = v0 + 1.0f; v1 = v1 + 1.0f; }
                            ss += store_x8(xp, XB + off + bj * 128, v0, v1); } }
                    ss += __shfl_xor(ss, 16); ss += __shfl_xor(ss, 32);
                    if (fq == 0 && t >= 0) SSo[(size_t)t * 16 + u.pn * 4 + wc] = ss; }
                asm volatile("" ::: "memory"); }
        return true;
    }
};
struct PhPle {
    static constexpr int K = 1024; static constexpr bool GATHER = false;
    unsigned char* ws; float* x; const float* SSi; float* SSo; int G, c;
    __device__ __forceinline__ bool next(int i, GUnit& u) const {
        const long L = (long)i * G + c; if (L >= 128 * 4) return false;
        pg8::tile_order((int)L, 128, 4, u.pm, u.pn);
        u.A = (const char*)ws + WS_XB + (size_t)u.pm * 256 * K * 2; u.B = (const char*)ws + WS_WPG + (size_t)u.pn * 256 * K * 2; u.a0 = 0; u.a1 = 0; return true;
    }
    __device__ __forceinline__ unsigned arow(const GUnit&, int) const { return 0u; }
    __device__ __forceinline__ bool epi(Acc& acc, const GUnit& u, int wr, int wc, int fr, int fq) const {
        const int row0 = u.pm * 256 + wr * 64 + fr; const int col0 = u.pn * 256 + wc * 32 + fq * 8; bf16_t* XT = (bf16_t*)(ws + WS_XBT); const bf16_t* PE = (const bf16_t*)(ws + WS_PE);
#pragma unroll
        for (int ai = 0; ai < 2; ++ai)
#pragma unroll
            for (int m = 0; m < 4; ++m) { const int row = row0 + ai * 128 + m * 16; const size_t off = (size_t)row * 1024 + col0; const float rs = row_rs(SSi, row); float ss = 0.f;
#pragma unroll
                for (int bj = 0; bj < 2; ++bj) { float* xp = x + off + bj * 128; f32x4 p0, p1; unpack8(*(const u32x4*)(PE + off + bj * 128), p0, p1); if (ABL == 5) { p0 = p0 * 0.f; p1 = p1 * 0.f; }
                    const f32x4 v0 = *(const f32x4*)xp + sig4(acc[ai][bj][m][0] * rs) * p0, v1 = *(const f32x4*)(xp + 4) + sig4(acc[ai][bj][m][1] * rs) * p1;
                    ss += store_x8(xp, XT + off + bj * 128, v0, v1); }
                ss += __shfl_xor(ss, 16); ss += __shfl_xor(ss, 32);
                if (fq == 0) SSo[(size_t)row * 16 + u.pn * 4 + wc] = ss; }
        return true;
    }
};

struct Ctx {
    const float* const* in; float* out; unsigned char* ws; LAS unsigned char* lds;
    int tid, lane, wave, G, bid;
};
enum { I_X = 0, I_P, I_GMIX, I_WIN, I_CONVW, I_CONVB, I_CLNG, I_CLNB, I_MCW, I_MCB, I_MIB, I_MFB, I_WBA, I_WBC, I_WBM, I_WOUT, I_GFFN, I_WRG, I_BRG, I_WRE, I_BRE,
       I_WEG, I_WEU, I_WED, I_GPLE, I_WPG, I_WPP, I_GFIN };

__device__ __forceinline__ void tr_item(const float* colptr, size_t pitch, const float* gain, float cscale, bf16_t* dst, int K, int n0, int k0, LAS float* scr, int lane) {
#pragma unroll 8
    for (int i = 0; i < 32; ++i) { const int kk = 2 * i + (lane >> 5); float v = colptr ? colptr[(size_t)(k0 + kk) * pitch] : 0.f; if (gain) v *= gain[k0 + kk]; scr[kk * 33 + (lane & 31)] = v * cscale; }
    LDS_WAIT(); asm volatile("" ::: "memory");
    const int c = lane & 7;
#pragma unroll
    for (int j = 0; j < 4; ++j) { const int n = (lane >> 3) + 8 * j; const LAS float* s = scr + (8 * c) * 33 + n;
        u32x4 o; o.x = pk2(s[0 * 33], s[1 * 33]); o.y = pk2(s[2 * 33], s[3 * 33]); o.z = pk2(s[4 * 33], s[5 * 33]); o.w = pk2(s[6 * 33], s[7 * 33]);
        *(u32x4*)(dst + (size_t)(n0 + n) * K + k0 + 8 * c) = o; }
    LDS_WAIT(); asm volatile("" ::: "memory");
}
__device__ __forceinline__ void phase_prep(const Ctx& F, int layer, float* SS) {
    const int gw = F.bid * NWAVES + F.wave, NGW = F.G * NWAVES, lane = F.lane;
    LAS float* scr = (LAS float*)(F.lds + F.wave * 16384);
    bf16_t* XB = (bf16_t*)(F.ws + WS_XB);
    if (layer == 0) {
        for (int m = gw; m < T; m += NGW) {
            const f32x4* xr = (const f32x4*)(F.in[I_X] + (size_t)m * D) + lane; f32x4* orow = (f32x4*)(F.out + (size_t)m * D) + lane; u32x2* xbr = (u32x2*)(XB + (size_t)m * D) + lane;
            float s = 0.f;
#pragma unroll
            for (int j = 0; j < 4; ++j) { const f32x4 v = xr[64 * j]; orow[64 * j] = v; s += (v.x * v.x + v.y * v.y) + (v.z * v.z + v.w * v.w);
                u32x2 w; w.x = cvt_pk_bf16(v.x, v.y); w.y = cvt_pk_bf16(v.z, v.w); xbr[64 * j] = w; }
            s = wave_sum(s);
            if (lane < 16) SS[(size_t)m * 16 + lane] = lane == 0 ? s : 0.f;
        }
    } else {
        const u32x4* src = (const u32x4*)(F.ws + WS_XBT); u32x4* dst = (u32x4*)(F.ws + WS_XB);
        for (size_t i = (size_t)F.bid * NTHREADS + F.tid; i < (size_t)T * D * 2 / 16; i += (size_t)F.G * NTHREADS) dst[i] = src[i];
    }
    const float* w_in = F.in[I_WIN] + (size_t)layer * D * D_IN; const float* g_mix = F.in[I_GMIX] + (size_t)layer * D;
    constexpr int N_WIN = 280 * 16, N_BR = 32 * 8, N_SQ = 32 * 16, N_PP = 32 * 4, N_R = 8 * 16;
    constexpr int NITEMS = N_WIN + 3 * N_BR + 2 * N_SQ + N_PP + N_R;
    for (int it = gw; it < NITEMS; it += NGW) {
        int r = it;
        if (r < N_WIN) { const int nb = r >> 4, kb = r & 15; const int n = nb * 32 + (lane & 31); int src = -1; float cs = 1.f;
            if (n < 2560) { src = n; if (n < 1536) cs = 0.125f; }
            else if (n < 3584) { const int np = n - 2560, q8 = np >> 3, s = (np >> 2) & 1, j = np & 3; src = 2560 + s * 512 + 4 * q8 + j; }
            else if (n < 5640) src = n;
            else if (n < 5888) src = -1;
            else src = 5640 + (n - 5888);
            tr_item(src >= 0 ? w_in + src : nullptr, D_IN, g_mix, cs, (bf16_t*)(F.ws + WS_WIN), 1024, nb * 32, kb * 64, scr, lane); continue; }
        r -= N_WIN;
        if (r < 3 * N_BR) { const int b = r / N_BR; r -= b * N_BR; const int nb = r >> 3, kb = r & 7; const int n = nb * 32 + (lane & 31);
            const float* w = (b == 0 ? F.in[I_WBA] : (b == 1 ? F.in[I_WBC] : F.in[I_WBM])) + (size_t)layer * 512 * 1024;
            tr_item(w + n, 1024, nullptr, 1.f, (bf16_t*)(F.ws + WS_WBR) + (size_t)b * 1024 * 512, 512, nb * 32, kb * 64, scr, lane); continue; }
        r -= 3 * N_BR;
        if (r < 2 * N_SQ) { const int b = r / N_SQ; r -= b * N_SQ; const int nb = r >> 4, kb = r & 15; const int n = nb * 32 + (lane & 31);
            const float* w = (b == 0 ? F.in[I_WOUT] : F.in[I_WPG]) + (size_t)layer * 1024 * 1024;
            tr_item(w + n, 1024, b == 0 ? nullptr : F.in[I_GPLE] + (size_t)layer * D, 1.f, (bf16_t*)(F.ws + (b == 0 ? WS_WOUT : WS_WPG)), 1024, nb * 32, kb * 64, scr, lane); continue; }
        r -= 2 * N_SQ;
        if (r < N_PP) { const int nb = r >> 2, kb = r & 3; const int n = nb * 32 + (lane & 31);
            tr_item(F.in[I_WPP] + (size_t)layer * 256 * 1024 + n, 1024, nullptr, 1.f, (bf16_t*)(F.ws + WS_WPP), 256, nb * 32, kb * 64, scr, lane); continue; }
        r -= N_PP;
        { const int nb = r >> 4, kb = r & 15; const int n = nb * 32 + (lane & 31); const float* cp = nullptr; size_t pitch = 4;
            if (n < 4) { cp = F.in[I_WRG] + (size_t)layer * 1024 * 4 + n; pitch = 4; } else if (n < 36) { cp = F.in[I_WRE] + (size_t)layer * 1024 * 32 + (n - 4); pitch = 32; }
            tr_item(cp, pitch, F.in[I_GFFN] + (size_t)layer * D, 1.f, (bf16_t*)(F.ws + WS_WR), 1024, nb * 32, kb * 64, scr, lane); }
    }
}
__device__ __forceinline__ void phase_prep_experts(const Ctx& F, int layer) {
    const int gw = F.bid * NWAVES + F.wave, NGW = F.G * NWAVES, lane = F.lane;
    LAS float* scr = (LAS float*)(F.lds + F.wave * 16384);
    const float* g_ffn = F.in[I_GFFN] + (size_t)layer * D;
    constexpr int N_UP = 32 * 16 * 16, N_DN = 32 * 32 * 4;
    for (int it = gw; it < N_UP + N_DN; it += NGW) {
        int r = it;
        if (r < N_UP) { const int e = r >> 8; r &= 255; const int nb = r >> 4, kb = r & 15; const int n = nb * 32 + (lane & 31); const int q8 = n >> 3, s = (n >> 2) & 1, j = n & 3;
            const float* w = (s ? F.in[I_WEU] : F.in[I_WEG]) + ((size_t)layer * 32 + e) * 1024 * 256 + 4 * q8 + j;
            tr_item(w, 256, g_ffn, 1.f, (bf16_t*)(F.ws + WS_WEXP) + (size_t)e * 512 * 1024, 1024, nb * 32, kb * 64, scr, lane); continue; }
        r -= N_UP;
        { const int e = r >> 7; r &= 127; const int nb = r >> 2, kb = r & 3; const int n = nb * 32 + (lane & 31);
            const float* w = F.in[I_WED] + ((size_t)layer * 32 + e) * 256 * 1024 + n;
            tr_item(w, 1024, nullptr, 1.f, (bf16_t*)(F.ws + WS_WEXP) + 32ull * 512 * 1024 + (size_t)e * 1024 * 256, 256, nb * 32, kb * 64, scr, lane); }
    }
    const f32x4* p = (const f32x4*)(F.in[I_P] + (size_t)layer * T * 256); u32x2* pb = (u32x2*)(F.ws + WS_PBF);
    for (size_t i = (size_t)F.bid * NTHREADS + F.tid; i < (size_t)T * 256 / 4; i += (size_t)F.G * NTHREADS) { const f32x4 v = p[i]; u32x2 w; w.x = cvt_pk_bf16(v.x, v.y); w.y = cvt_pk_bf16(v.z, v.w); pb[i] = w; }
}

__device__ __forceinline__ void attn_item_v1(const Ctx& F, int tb) {
    const int slot = F.wave, t = tb * 64 + F.lane, s = t & (SEQ - 1);
    const bf16_t* KA = (const bf16_t*)(F.ws + WS_KA); const bf16_t* VA = (const bf16_t*)(F.ws + WS_VA);
    float acc[64];
#pragma unroll
    for (int d = 0; d < 64; ++d) acc[d] = 0.f;
    float mrun = -INFINITY, lrun = 0.f;
    for (int g = 0; g < 3; ++g) {
        const int dl = 1 << (2 * g); const float slope = exp2f(-(float)(g * 8 + slot + 1) * (1.0f / 3.0f)) * (float)dl;
        const bf16_t* Q = (const bf16_t*)(F.ws + (g == 0 ? WS_QA0 : (g == 1 ? WS_QA1 : WS_QA2))) + (size_t)t * 512 + slot * 64;
        float q[64];
#pragma unroll
        for (int c = 0; c < 8; ++c) { const u32x4 w = ((const u32x4*)Q)[c]; q[8 * c] = bf_lo(w.x); q[8 * c + 1] = bf_hi(w.x); q[8 * c + 2] = bf_lo(w.y); q[8 * c + 3] = bf_hi(w.y); q[8 * c + 4] = bf_lo(w.z); q[8 * c + 5] = bf_hi(w.z); q[8 * c + 6] = bf_lo(w.w); q[8 * c + 7] = bf_hi(w.w); }
        int nj = s / dl; if (nj > 128) nj = 128;
        const int njmax = __builtin_amdgcn_readfirstlane((int)wave_max((float)nj));
        for (int j = 0; j <= njmax; ++j) {
            const bool ok = j <= nj; const int tk = ok ? t - dl * j : t;
            const u32x4* kp = (const u32x4*)(KA + (size_t)tk * 512 + slot * 64); const u32x4* vp = (const u32x4*)(VA + (size_t)tk * 512 + slot * 64);
            float dot = 0.f;
#pragma unroll
            for (int c = 0; c < 8; ++c) { const u32x4 w = kp[c];
                dot += q[8 * c] * bf_lo(w.x) + q[8 * c + 1] * bf_hi(w.x) + q[8 * c + 2] * bf_lo(w.y) + q[8 * c + 3] * bf_hi(w.y) + q[8 * c + 4] * bf_lo(w.z) + q[8 * c + 5] * bf_hi(w.z) + q[8 * c + 6] * bf_lo(w.w) + q[8 * c + 7] * bf_hi(w.w); }
            const float sc = ok ? dot - slope * (float)j : -INFINITY;
            const float mn = fmaxf(mrun, sc);
            const float corr = __expf(mrun - mn), pw = __expf(sc - mn);
            lrun = lrun * corr + pw; mrun = mn;
#pragma unroll
            for (int c = 0; c < 8; ++c) { const u32x4 w = vp[c];
                acc[8 * c] = acc[8 * c] * corr + pw * bf_lo(w.x); acc[8 * c + 1] = acc[8 * c + 1] * corr + pw * bf_hi(w.x); acc[8 * c + 2] = acc[8 * c + 2] * corr + pw * bf_lo(w.y); acc[8 * c + 3] = acc[8 * c + 3] * corr + pw * bf_hi(w.y);
                acc[8 * c + 4] = acc[8 * c + 4] * corr + pw * bf_lo(w.z); acc[8 * c + 5] = acc[8 * c + 5] * corr + pw * bf_hi(w.z); acc[8 * c + 6] = acc[8 * c + 6] * corr + pw * bf_lo(w.w); acc[8 * c + 7] = acc[8 * c + 7] * corr + pw * bf_hi(w.w); }
        }
    }
    const float inv = (ABL == 1) ? 0.f : 1.0f / lrun;
    u32x4* o = (u32x4*)((bf16_t*)(F.ws + WS_YATT) + (size_t)t * 512 + slot * 64);
#pragma unroll
    for (int c = 0; c < 8; ++c) { u32x4 w; w.x = cvt_pk_bf16(acc[8 * c] * inv, acc[8 * c + 1] * inv); w.y = cvt_pk_bf16(acc[8 * c + 2] * inv, acc[8 * c + 3] * inv); w.z = cvt_pk_bf16(acc[8 * c + 4] * inv, acc[8 * c + 5] * inv); w.w = cvt_pk_bf16(acc[8 * c + 6] * inv, acc[8 * c + 7] * inv); o[c] = w; }
}

__device__ __forceinline__ void conv_item_v1(const Ctx& F, int layer, int item) {
    const int t0 = item * 32, s0 = t0 & (SEQ - 1), tid = F.tid;
    LAS bf16_t* sin = (LAS bf16_t*)F.lds;
    LAS float* sout = (LAS float*)(F.lds + 65536);
    const bf16_t* YG = (const bf16_t*)(F.ws + WS_YG);
    for (int i = tid; i < 62 * 64; i += NTHREADS) { const int r = i >> 6, c8 = i & 63; const int sp = s0 - 30 + r;
        u32x4 v = (u32x4){0u, 0u, 0u, 0u}; if (sp >= 0) v = *(const u32x4*)(YG + (size_t)(t0 - 30 + r) * 512 + c8 * 8);
        *(LAS u32x4*)(sin + r * 512 + c8 * 8) = v; }
    float w[31];
    const float* cw = F.in[I_CONVW] + (size_t)layer * 31 * 512 + tid;
#pragma unroll
    for (int k = 0; k < 31; ++k) w[k] = cw[k * 512];
    const float cb = F.in[I_CONVB][layer * 512 + tid];
    __syncthreads();
    for (int tt = 0; tt < 32; ++tt) { float a = cb;
#pragma unroll
        for (int k = 0; k < 31; ++k) a += w[k] * bf1(sin[(tt + k) * 512 + tid]);
        sout[tt * 512 + tid] = a; }
    __syncthreads();
    const float* lg = F.in[I_CLNG] + layer * 512 + F.lane * 8; const float* lb = F.in[I_CLNB] + layer * 512 + F.lane * 8;
    for (int tt = F.wave; tt < 32; tt += NWAVES) {
        float v[8]; float s = 0.f;
#pragma unroll
        for (int j = 0; j < 8; ++j) { v[j] = sout[tt * 512 + F.lane * 8 + j]; s += v[j]; }
        const float mu = wave_sum(s) * (1.0f / 512.0f); float q = 0.f;
#pragma unroll
        for (int j = 0; j < 8; ++j) { v[j] -= mu; q += v[j] * v[j]; }
        const float rstd = rsqrtf(wave_sum(q) * (1.0f / 512.0f) + EPS);
        float o[8];
#pragma unroll
        for (int j = 0; j < 8; ++j) o[j] = (ABL == 2) ? 0.f : siluf_(v[j] * rstd * lg[j] + lb[j]);
        u32x4 wv; wv.x = cvt_pk_bf16(o[0], o[1]); wv.y = cvt_pk_bf16(o[2], o[3]); wv.z = cvt_pk_bf16(o[4], o[5]); wv.w = cvt_pk_bf16(o[6], o[7]);
        *(u32x4*)((bf16_t*)(F.ws + WS_YC) + (size_t)(t0 + tt) * 512 + F.lane * 8) = wv;
    }
    __syncthreads();
}

__device__ __forceinline__ float log_sigmoid_(float v) { return fminf(v, 0.f) - log1pf(__expf(-fabsf(v))); }
__device__ __forceinline__ void qk_conv8(const Ctx& F, int layer, const bf16_t* src  , int t, int s, int ch  , int chq, float scale, float* o) {
    const float* cw = F.in[I_MCW] + (size_t)layer * 4 * 1024 + chq; const float* cb = F.in[I_MCB] + (size_t)layer * 1024 + chq;
#pragma unroll
    for (int j = 0; j < 8; ++j) o[j] = cb[j];
#pragma unroll
    for (int k = 0; k < 4; ++k) { if (s - 3 + k >= 0) { const u32x4 w = *(const u32x4*)(src + (size_t)(t - 3 + k) * 512 + ch); const float* wk = cw + k * 1024;
            o[0] += wk[0] * bf_lo(w.x); o[1] += wk[1] * bf_hi(w.x); o[2] += wk[2] * bf_lo(w.y); o[3] += wk[3] * bf_hi(w.y); o[4] += wk[4] * bf_lo(w.z); o[5] += wk[5] * bf_hi(w.z); o[6] += wk[6] * bf_lo(w.w); o[7] += wk[7] * bf_hi(w.w); } }
#pragma unroll
    for (int j = 0; j < 8; ++j) o[j] = siluf_(o[j]) * scale;
}
__device__ __forceinline__ void mlstm_scalars(const Ctx& F, int layer, int t0, int h, LAS float* sIG, LAS float* sBC) {
    if (F.tid < 128) { const float* IFp = (const float*)(F.ws + WS_IF) + (size_t)(t0 + F.tid) * 8;
        sIG[F.tid] = IFp[h] + F.in[I_MIB][layer * 4 + h]; sBC[F.tid] = log_sigmoid_(IFp[4 + h] + F.in[I_MFB][layer * 4 + h]); }
    __syncthreads();
    if (F.tid == 0) { float c = 0.f; for (int l = 0; l < 128; ++l) { c += sBC[l]; sBC[l] = c; } }
    __syncthreads();
}
__device__ __forceinline__ void mlstm_local_v1(const Ctx& F, int layer, int item) {
    const int c = item & 127, bh = item >> 7, h = bh & 3, b = bh >> 2, t0 = b * SEQ + c * 128, tid = F.tid;
    LAS float* EV = (LAS float*)F.lds;
    LAS float* KC = (LAS float*)(F.lds + 65536);
    LAS float* sIG = (LAS float*)(F.lds + 131072); LAS float* sBC = sIG + 128; LAS float* sE = sIG + 256; LAS float* sM = sIG + 384;
    mlstm_scalars(F, layer, t0, h, sIG, sBC);
    if (tid == 0) { const float gt = sBC[127]; float m = -INFINITY; for (int l = 0; l < 128; ++l) m = fmaxf(m, gt - sBC[l] + sIG[l]); sM[0] = m; sM[1] = gt; }
    __syncthreads();
    if (tid < 128) sE[tid] = __expf(sM[1] - sBC[tid] + sIG[tid] - sM[0]);
    __syncthreads();
    const bf16_t* KM = (const bf16_t*)(F.ws + WS_KM); const bf16_t* VM = (const bf16_t*)(F.ws + WS_VM);
    for (int i = tid; i < 128 * 16; i += NTHREADS) { const int l = i >> 4, c8 = (i & 15) * 8; const int t = t0 + l, s = t & (SEQ - 1);
        float o[8]; qk_conv8(F, layer, KM, t, s, h * 128 + c8, 512 + h * 128 + c8, 0.08838834764831845f, o);
#pragma unroll
        for (int j = 0; j < 8; ++j) KC[l * 128 + c8 + j] = o[j];
        const u32x4 w = *(const u32x4*)(VM + (size_t)t * 512 + h * 128 + c8); const float e = sE[l];
        EV[l * 128 + c8] = e * bf_lo(w.x); EV[l * 128 + c8 + 1] = e * bf_hi(w.x); EV[l * 128 + c8 + 2] = e * bf_lo(w.y); EV[l * 128 + c8 + 3] = e * bf_hi(w.y);
        EV[l * 128 + c8 + 4] = e * bf_lo(w.z); EV[l * 128 + c8 + 5] = e * bf_hi(w.z); EV[l * 128 + c8 + 6] = e * bf_lo(w.w); EV[l * 128 + c8 + 7] = e * bf_hi(w.w); }
    __syncthreads();
    { const int v = tid >> 2, kq = tid & 3; float a[32];
#pragma unroll
        for (int i = 0; i < 32; ++i) a[i] = 0.f;
#pragma unroll 1
        for (int l = 0; l < 128; ++l) { const float ev = EV[l * 128 + v];
#pragma unroll
            for (int i = 0; i < 32; ++i) a[i] += ev * KC[l * 128 + kq * 32 + i]; }
        bf16_t* Cp = (bf16_t*)(F.ws + WS_CST) + ((size_t)(bh * 128 + c) << 14) + v * 128 + kq * 32;
#pragma unroll
        for (int i = 0; i < 4; ++i) { u32x4 w; w.x = cvt_pk_bf16(a[8 * i], a[8 * i + 1]); w.y = cvt_pk_bf16(a[8 * i + 2], a[8 * i + 3]); w.z = cvt_pk_bf16(a[8 * i + 4], a[8 * i + 5]); w.w = cvt_pk_bf16(a[8 * i + 6], a[8 * i + 7]); ((u32x4*)Cp)[i] = w; } }
    if (tid < 128) { float n = 0.f; for (int l = 0; l < 128; ++l) n += sE[l] * KC[l * 128 + tid]; ((float*)(F.ws + WS_NST))[(size_t)(bh * 128 + c) * 128 + tid] = n; }
    if (tid == 0) { ((float*)(F.ws + WS_TAB + TAB_MLOC))[bh * 128 + c] = sM[0]; ((float*)(F.ws + WS_TAB + TAB_GTOT))[bh * 128 + c] = sM[1]; }
    __syncthreads();
}
__device__ __forceinline__ void phase_scan(const Ctx& F) {
    const float* GT = (const float*)(F.ws + WS_TAB + TAB_GTOT); const float* ML = (const float*)(F.ws + WS_TAB + TAB_MLOC); float* MS = (float*)(F.ws + WS_TAB + TAB_MST);
    for (int e = F.bid * NTHREADS + F.tid; e < 8 * 16384 + 8 * 128; e += F.G * NTHREADS) {
        const bool isC = e < 8 * 16384; const int bh = isC ? (e >> 14) : ((e - 8 * 16384) >> 7); const int idx = isC ? (e & 16383) : ((e - 8 * 16384) & 127);
        bf16_t* cp = (bf16_t*)(F.ws + WS_CST) + ((size_t)(bh * 128) << 14) + idx; float* np = (float*)(F.ws + WS_NST) + (size_t)(bh * 128) * 128 + idx;
        float mp = 0.f, val = 0.f;
        for (int c = 0; c < 128; ++c) {
            const float gc = GT[bh * 128 + c], ml = ML[bh * 128 + c]; const float mn = fmaxf(gc + mp, ml); const float a = __expf(gc + mp - mn), bb = __expf(ml - mn);
            if (isC) { bf16_t* p = cp + ((size_t)c << 14); const float loc = bf1(*p); *p = (bf16_t)f2bf(val); val = a * val + bb * loc; if (idx == 0) MS[bh * 128 + c] = mp; }
            else { float* p = np + (size_t)c * 128; const float loc = *p; *p = val; val = a * val + bb * loc; }
            mp = mn;
        }
    }
}
__device__ __forceinline__ void mlstm_out_v1(const Ctx& F, int layer, int item) {
    const int c = item & 127, bh = item >> 7, h = bh & 3, b = bh >> 2, t0 = b * SEQ + c * 128, tid = F.tid;
    constexpr int LS = 129;
    LAS float* bA = (LAS float*)F.lds;
    LAS float* bB = (LAS float*)(F.lds + 66560);
    LAS float* sIG = (LAS float*)(F.lds + 133120); LAS float* sBC = sIG + 128; LAS float* sMT = sIG + 256; LAS float* sSI = sIG + 384; LAS float* sNS = sIG + 512;
    mlstm_scalars(F, layer, t0, h, sIG, sBC);
    const float mst = ((const float*)(F.ws + WS_TAB + TAB_MST))[bh * 128 + c];
    if (tid == 0) { float pm = -INFINITY; for (int q = 0; q < 128; ++q) { pm = fmaxf(pm, sIG[q] - sBC[q]); const float ai = sBC[q] + mst; const float mt = fmaxf(ai, sBC[q] + pm); sMT[q] = mt; sSI[q] = __expf(ai - mt); } }
    if (tid < 128) sNS[tid] = ((const float*)(F.ws + WS_NST))[(size_t)(bh * 128 + c) * 128 + tid];
    const bf16_t* QM = (const bf16_t*)(F.ws + WS_QM); const bf16_t* KM = (const bf16_t*)(F.ws + WS_KM); const bf16_t* VM = (const bf16_t*)(F.ws + WS_VM);
    for (int i = tid; i < 128 * 16; i += NTHREADS) { const int l = i >> 4, c8 = (i & 15) * 8; const int t = t0 + l, s = t & (SEQ - 1); float o[8];
        qk_conv8(F, layer, QM, t, s, h * 128 + c8, h * 128 + c8, 1.0f, o);
#pragma unroll
        for (int j = 0; j < 8; ++j) bA[l * LS + c8 + j] = o[j];
        qk_conv8(F, layer, KM, t, s, h * 128 + c8, 512 + h * 128 + c8, 0.08838834764831845f, o);
#pragma unroll
        for (int j = 0; j < 8; ++j) bB[l * LS + c8 + j] = o[j]; }
    __syncthreads();
    const int q = tid >> 2, kq = tid & 3;
    float sc[32], inter[32];
#pragma unroll
    for (int i = 0; i < 32; ++i) sc[i] = 0.f;
#pragma unroll 1
    for (int d = 0; d < 128; ++d) { const float qv = bA[q * LS + d];
#pragma unroll
        for (int i = 0; i < 32; ++i) sc[i] += qv * bB[(4 * i + kq) * LS + d]; }
    float den = 0.f;
    { const float bq = sBC[q], mt = sMT[q];
#pragma unroll
        for (int i = 0; i < 32; ++i) { const int k = 4 * i + kq; const float w = (k <= q) ? __expf(bq - sBC[k] + sIG[k] - mt) : 0.f; sc[i] *= w; den += sc[i]; } }
    __syncthreads();
    { const bf16_t* Cp = (const bf16_t*)(F.ws + WS_CST) + ((size_t)(bh * 128 + c) << 14);
        for (int i = tid; i < 128 * 16; i += NTHREADS) { const int v = i >> 4, c8 = (i & 15) * 8; const u32x4 w = *(const u32x4*)(Cp + v * 128 + c8);
            bB[v * LS + c8] = bf_lo(w.x); bB[v * LS + c8 + 1] = bf_hi(w.x); bB[v * LS + c8 + 2] = bf_lo(w.y); bB[v * LS + c8 + 3] = bf_hi(w.y); bB[v * LS + c8 + 4] = bf_lo(w.z); bB[v * LS + c8 + 5] = bf_hi(w.z); bB[v * LS + c8 + 6] = bf_lo(w.w); bB[v * LS + c8 + 7] = bf_hi(w.w); } }
    __syncthreads();
#pragma unroll
    for (int i = 0; i < 32; ++i) inter[i] = 0.f;
    float dn = 0.f;
#pragma unroll 1
    for (int d = 0; d < 128; ++d) { const float qv = bA[q * LS + d];
#pragma unroll
        for (int i = 0; i < 32; ++i) inter[i] += qv * bB[(4 * i + kq) * LS + d];
        if ((d >> 5) == kq) dn += qv * sNS[d]; }
    __syncthreads();
#pragma unroll
    for (int i = 0; i < 32; ++i) bA[q * LS + 4 * i + kq] = sc[i];
    for (int i = tid; i < 128 * 16; i += NTHREADS) { const int l = i >> 4, c8 = (i & 15) * 8; const u32x4 w = *(const u32x4*)(VM + (size_t)(t0 + l) * 512 + h * 128 + c8);
        bB[l * LS + c8] = bf_lo(w.x); bB[l * LS + c8 + 1] = bf_hi(w.x); bB[l * LS + c8 + 2] = bf_lo(w.y); bB[l * LS + c8 + 3] = bf_hi(w.y); bB[l * LS + c8 + 4] = bf_lo(w.z); bB[l * LS + c8 + 5] = bf_hi(w.z); bB[l * LS + c8 + 6] = bf_lo(w.w); bB[l * LS + c8 + 7] = bf_hi(w.w); }
    __syncthreads();
    float num[32];
#pragma unroll
    for (int i = 0; i < 32; ++i) num[i] = 0.f;
#pragma unroll 1
    for (int k = 0; k < 128; ++k) { const float sv = bA[q * LS + k];
#pragma unroll
        for (int i = 0; i < 32; ++i) num[i] += sv * bB[k * LS + 4 * i + kq]; }
    den += __shfl_xor(den, 1); den += __shfl_xor(den, 2); dn += __shfl_xor(dn, 1); dn += __shfl_xor(dn, 2);
    const float si = sSI[q]; const float dd = den + si * dn; const float inv = (ABL == 3) ? 0.f : 1.0f / fmaxf(fabsf(dd), __expf(-sMT[q]));
    bf16_t* OM = (bf16_t*)(F.ws + WS_OM) + (size_t)(t0 + q) * 512 + h * 128;
#pragma unroll
    for (int i = 0; i < 32; ++i) { const int v = 4 * i + kq; const float hv = (num[i] + si * inter[i]) * inv; OM[v] = (bf16_t)f2bf(bf1(OM[v]) * hv); }
    __syncthreads();
}

__device__ __forceinline__ void phase_route(const Ctx& F, int layer) {
    int* tokl = (int*)(F.ws + WS_LISTS);
    for (int i = F.bid * NTHREADS + F.tid; i < 2 * LISTCAP; i += F.G * NTHREADS) tokl[i] = -1;
    LAS int* hist = (LAS int*)F.lds;
    const float* brg = F.in[I_BRG] + layer * 4; const float* bre = F.in[I_BRE] + layer * 32;
    for (int tile = F.bid; tile < 256; tile += F.G) {
        if (F.tid < 128) { const int t = tile * 128 + F.tid; const float* lg = (const float*)(F.ws + WS_LOGITS) + (size_t)t * 64;
            float g[4]; int gs = 0; float gm;
#pragma unroll
            for (int j = 0; j < 4; ++j) g[j] = lg[j] + brg[j];
            gm = g[0];
#pragma unroll
            for (int j = 1; j < 4; ++j) if (g[j] > gm) { gm = g[j]; gs = j; }
            float se = 0.f;
#pragma unroll
            for (int j = 0; j < 4; ++j) se += __expf(g[j] - gm);
            const float pg = 1.0f / se;
            float le[8];
#pragma unroll
            for (int j = 0; j < 8; ++j) le[j] = lg[4 + gs * 8 + j] + bre[gs * 8 + j];
            int i0 = 0; float v0 = le[0];
#pragma unroll
            for (int j = 1; j < 8; ++j) if (le[j] > v0) { v0 = le[j]; i0 = j; }
            int i1 = -1; float v1 = -INFINITY;
#pragma unroll
            for (int j = 0; j < 8; ++j) if (j != i0 && le[j] > v1) { v1 = le[j]; i1 = j; }
            const float e1 = __expf(v1 - v0); const float wsc = (ABL == 4) ? 0.f : ((ABL == 6) ? 2.f : 1.f); const float w0 = wsc * pg / (1.0f + e1), w1 = wsc * pg * e1 / (1.0f + e1);
            const int x0 = gs * 8 + i0, x1 = gs * 8 + i1;
            ((int*)(F.ws + WS_ROUTE))[2 * t] = x0; ((int*)(F.ws + WS_ROUTE))[2 * t + 1] = x1;
            ((float*)(F.ws + WS_ROUTE))[2 * T + 2 * t] = w0; ((float*)(F.ws + WS_ROUTE))[2 * T + 2 * t + 1] = w1;
            hist[F.tid] = x0; hist[128 + F.tid] = x1;
        }
        __syncthreads();
        if (F.tid < 64) { const int k = F.tid >> 5, e = F.tid & 31; int cnt = 0; for (int j = 0; j < 128; ++j) cnt += (hist[k * 128 + j] == e) ? 1 : 0; ((int*)(F.ws + WS_TAB + TAB_CNT))[tile * 64 + F.tid] = cnt; }
        __syncthreads();
    }
}
__device__ __forceinline__ void phase_dispatch(const Ctx& F) {
    LAS int* sTot = (LAS int*)F.lds; LAS int* sBef = sTot + 64; LAS int* sPs = sTot + 128; LAS int* sE = sTot + 256;
    const int* CNT = (const int*)(F.ws + WS_TAB + TAB_CNT); int* META = (int*)(F.ws + WS_TAB + TAB_META);
    int* tokl = (int*)(F.ws + WS_LISTS); float* wl = (float*)(F.ws + WS_LISTS) + 2 * LISTCAP;
    for (int tile = F.bid; tile < 256; tile += F.G) {
        if (F.tid < 64) { int tot = 0, bef = 0; for (int j = 0; j < 256; ++j) { const int v = CNT[j * 64 + F.tid]; tot += v; bef += (j < tile) ? v : 0; } sTot[F.tid] = tot; sBef[F.tid] = bef; }
        __syncthreads();
        if (F.tid < 2) { int ps = 0; for (int e = 0; e < 32; ++e) { sPs[F.tid * 33 + e] = ps; ps += ((sTot[F.tid * 32 + e] + 255) >> 8) << 8; } sPs[F.tid * 33 + 32] = ps;
            if (tile == 0) { META[F.tid] = ps >> 8; for (int e = 0; e <= 32; ++e) META[16 + 64 * F.tid + e] = sPs[F.tid * 33 + e]; } }
        int e0 = 0, e1 = 0; float w0 = 0.f, w1 = 0.f;
        if (F.tid < 128) { const int t = tile * 128 + F.tid; e0 = ((const int*)(F.ws + WS_ROUTE))[2 * t]; e1 = ((const int*)(F.ws + WS_ROUTE))[2 * t + 1];
            w0 = ((const float*)(F.ws + WS_ROUTE))[2 * T + 2 * t]; w1 = ((const float*)(F.ws + WS_ROUTE))[2 * T + 2 * t + 1]; sE[F.tid] = e0; sE[128 + F.tid] = e1; }
        __syncthreads();
        if (F.tid < 128) { int r0 = 0, r1 = 0; for (int j = 0; j < F.tid; ++j) { r0 += (sE[j] == e0) ? 1 : 0; r1 += (sE[128 + j] == e1) ? 1 : 0; }
            const int p0 = sPs[e0] + sBef[e0] + r0, p1 = sPs[33 + e1] + sBef[32 + e1] + r1;
            tokl[p0] = tile * 128 + F.tid; wl[p0] = w0; tokl[LISTCAP + p1] = tile * 128 + F.tid; wl[LISTCAP + p1] = w1; }
        __syncthreads();
    }
}
__device__ __forceinline__ void phase_final(const Ctx& F, const float* SS) {
    const int gw = F.bid * NWAVES + F.wave, NGW = F.G * NWAVES, lane = F.lane;
    for (int m = gw; m < T; m += NGW) { const float rs = row_rs(SS, m); f32x4* o = (f32x4*)(F.out + (size_t)m * D) + lane; const f32x4* g = (const f32x4*)F.in[I_GFIN] + lane;
#pragma unroll
        for (int j = 0; j < 4; ++j) o[64 * j] = o[64 * j] * rs * g[64 * j]; }
}

constexpr int PH_PER_LAYER = 15, PH_FINAL = DEPTH * PH_PER_LAYER, N_PHASES = PH_FINAL + 1;
struct Args { const float* in[28]; float* out; unsigned char* ws; int ph_lo, ph_hi; };

__device__ __forceinline__ Ctx mkctx(const Args& args, LAS unsigned char* lds, int wave_s) {
    Ctx F; asm volatile("" : "+s"(wave_s)); int tid = wave_s * 64 + lane_id_(); asm volatile("" : "+v"(tid));
    unsigned char* ws = args.ws; asm volatile("" : "+s"(ws)); float* outp = args.out; asm volatile("" : "+s"(outp));
    int bid = blockIdx.x; asm volatile("" : "+s"(bid)); int G = gridDim.x; asm volatile("" : "+s"(G));
    F.in = args.in; F.out = outp; F.ws = ws; F.lds = lds;
    F.tid = tid; F.lane = tid & 63; F.wave = wave_s; F.G = G; F.bid = bid;
    return F;
}
#ifndef ONLY_PHASE
#define ONLY_PHASE -1
#endif
__device__ __forceinline__ void run_phase(const Args& args, LAS unsigned char* lds, int ph, int wave_s) {
    const int layer = ph / PH_PER_LAYER, lp = ph - layer * PH_PER_LAYER;
    const size_t ssin = (layer & 1) ? WS_SS1 : WS_SS0, ssmid = (layer & 1) ? WS_SS0 : WS_SS1;
    if (ph == PH_FINAL) { const Ctx F = mkctx(args, lds, wave_s); phase_final(F, (const float*)(F.ws + WS_SS0)); return; }
    if (ONLY_PHASE >= 0 && lp != ONLY_PHASE) return;
    switch (lp) {
    case 0: { const Ctx F = mkctx(args, lds, wave_s); phase_prep(F, layer, (float*)(F.ws + ssin)); } break;
    case 1: { const Ctx F = mkctx(args, lds, wave_s); PhProj P{(const char*)F.ws + WS_XB, (const char*)F.ws + WS_WIN, (const float*)(F.ws + ssin), F.ws, F.G, F.bid}; pg8::gemm_phase(F.lds, P, F.tid); } break;
    case 2: { const Ctx F = mkctx(args, lds, wave_s);
        for (int it = F.bid; it < 512; it += F.G) attn_item_v1(F, it);
        __syncthreads();
        for (int it = F.bid; it < 1024; it += F.G) mlstm_local_v1(F, layer, it);
        for (int it = F.bid; it < 1024; it += F.G) conv_item_v1(F, layer, it);
    } break;
    case 3: { const Ctx F = mkctx(args, lds, wave_s); phase_scan(F); } break;
    case 4: { const Ctx F = mkctx(args, lds, wave_s); for (int it = F.bid; it < 1024; it += F.G) mlstm_out_v1(F, layer, it); } break;
    case 5: { const Ctx F = mkctx(args, lds, wave_s); PhGates P{(const char*)F.ws + WS_XB, (const char*)F.ws + WS_WIN, (const float*)(F.ws + ssin), F.ws, F.G, F.bid}; pg8::gemm_phase(F.lds, P, F.tid); } break;
    case 6: { const Ctx F = mkctx(args, lds, wave_s); PhMerge P{F.ws, F.G, F.bid}; pg8::gemm_phase(F.lds, P, F.tid); } break;
    case 7: { const Ctx F = mkctx(args, lds, wave_s); PhOut P{F.ws, F.out, (float*)(F.ws + ssmid), F.G, F.bid}; pg8::gemm_phase(F.lds, P, F.tid); } break;
    case 8: { const Ctx F = mkctx(args, lds, wave_s); PhRouter P{F.ws, (const float*)(F.ws + ssmid), F.G, F.bid}; pg8::gemm_phase(F.lds, P, F.tid); phase_prep_experts(F, layer); } break;
    case 9: { const Ctx F = mkctx(args, lds, wave_s); phase_route(F, layer); } break;
    case 10: { const Ctx F = mkctx(args, lds, wave_s); phase_dispatch(F); } break;
    case 11: { const Ctx F = mkctx(args, lds, wave_s); PhUp P{F.ws, (const float*)(F.ws + ssmid), (const int*)(F.ws + WS_TAB + TAB_META), (const int*)(F.ws + WS_LISTS), F.G, F.bid}; pg8::gemm_phase(F.lds, P, F.tid); } break;
    case 12: { const Ctx F = mkctx(args, lds, wave_s); PhDown<1> P{F.ws, F.out, (float*)(F.ws + ssin), (const int*)(F.ws + WS_TAB + TAB_META), (const int*)(F.ws + WS_LISTS), (const float*)(F.ws + WS_LISTS) + 2 * LISTCAP, F.G, F.bid}; pg8::gemm_phase(F.lds, P, F.tid); } break;
    case 13: { const Ctx F = mkctx(args, lds, wave_s); PhDown<0> P{F.ws, F.out, (float*)(F.ws + ssin), (const int*)(F.ws + WS_TAB + TAB_META), (const int*)(F.ws + WS_LISTS), (const float*)(F.ws + WS_LISTS) + 2 * LISTCAP, F.G, F.bid}; pg8::gemm_phase(F.lds, P, F.tid); } break;
    case 14: { const Ctx F = mkctx(args, lds, wave_s); PhPle P{F.ws, F.out, (const float*)(F.ws + ssin), (float*)(F.ws + ssmid), F.G, F.bid}; pg8::gemm_phase(F.lds, P, F.tid); } break;
    }
}

__global__ void __launch_bounds__(NTHREADS, 2) fwd_kernel(Args args) {
    extern __shared__ __attribute__((aligned(16))) unsigned char lds_raw[];
    LAS unsigned char* lds = (LAS unsigned char*)lds_raw;
    volatile LAS unsigned* MISC = (volatile LAS unsigned*)(lds + MISC_OFF);
    const int wave_s = __builtin_amdgcn_readfirstlane((int)threadIdx.x >> 6);
    if (wave_s == 0) MISC[lane_id_()] = 0u;
    __syncthreads();
#if MK_MEGA
    XcdBarrier bar = xcd_barrier_post((unsigned*)(args.ws + WS_CTL) + 4096, MISC + 8, wave_s);
#endif
    for (int ph = args.ph_lo; ph < args.ph_hi; ++ph) {
        run_phase(args, lds, ph, wave_s);
#if MK_MEGA
        if (ph + 1 < args.ph_hi) xcd_barrier(bar);
#endif
    }
}

extern "C" void kernel_launch(void* const* d_in, const int* in_sizes, int n_in, void* d_out, int out_size, void* d_ws, size_t ws_size, hipStream_t stream) {
    static int grid = 0;
    if (grid == 0) {
        if (n_in != 28 || out_size != T * D || ws_size < WS_END) { fprintf(stderr, "kernel_launch: unexpected shapes (n_in %d out %d ws %zu, need %zu)\n", n_in, out_size, ws_size, (size_t)WS_END); grid = -1; return; }
        int dev = 0, cus = 0, per_cu = 0;
        if (hipGetDevice(&dev) != hipSuccess || hipDeviceGetAttribute(&cus, hipDeviceAttributeMultiprocessorCount, dev) != hipSuccess) { grid = -1; return; }
        if (hipFuncSetAttribute((const void*)fwd_kernel, hipFuncAttributeMaxDynamicSharedMemorySize, LDS_BYTES) != hipSuccess) { fprintf(stderr, "kernel_launch: hipFuncSetAttribute failed\n"); grid = -1; return; }
        if (hipOccupancyMaxActiveBlocksPerMultiprocessor(&per_cu, (const void*)fwd_kernel, NTHREADS, LDS_BYTES) != hipSuccess || per_cu < 1) { fprintf(stderr, "kernel_launch: occupancy query says %d blocks per CU\n", per_cu); }
        (void)hipGetLastError();
        grid = cus;
    }
    if (grid < 0) return;
    Args a{};
    for (int i = 0; i < 28; ++i) a.in[i] = (const float*)d_in[i];
    a.out = (float*)d_out; a.ws = (unsigned char*)d_ws;
#if MK_MEGA
    (void)hipMemsetAsync((char*)d_ws + WS_CTL, 0, CTL_ZERO_BYTES, stream);
    a.ph_lo = 0; a.ph_hi = N_PHASES;
    hipLaunchKernelGGL(fwd_kernel, dim3(grid), dim3(NTHREADS), LDS_BYTES, stream, a);
#else
    for (int ph = 0; ph < N_PHASES; ++ph) { a.ph_lo = ph; a.ph_hi = ph + 1; hipLaunchKernelGGL(fwd_kernel, dim3(grid), dim3(NTHREADS), LDS_BYTES, stream, a); }
#endif
}
```

```cpp
#include <hip/hip_runtime.h>
#include <cstdio>
#include <cstdint>

#ifndef MK_MEGA
#define MK_MEGA 1
#endif

#ifndef ABL
#define ABL 0
#endif
#define LAS __attribute__((address_space(3)))
#define GAS __attribute__((address_space(1)))
typedef unsigned short bf16_t;
typedef short bf16x8 __attribute__((ext_vector_type(8)));
typedef float f32x4 __attribute__((ext_vector_type(4)));
typedef float f32x2 __attribute__((ext_vector_type(2)));
typedef unsigned u32x4 __attribute__((ext_vector_type(4)));
typedef unsigned u32x2 __attribute__((ext_vector_type(2)));

constexpr int T = 32768, SEQ = 16384, D = 1024, DEPTH = 2;
constexpr int D_IN = 8712;
constexpr float EPS = 1e-6f;
constexpr int NTHREADS = 512, NWAVES = 8;
constexpr int LISTCAP = 40960;

constexpr size_t MiB = 1u << 20;
constexpr size_t WS_CTL = 0, CTL_ZERO_BYTES = 1 * MiB;
constexpr size_t WS_TAB = 1 * MiB;
constexpr size_t WS_ROUTE = 2 * MiB;
constexpr size_t WS_LISTS = 3 * MiB;
constexpr size_t WS_SS0 = 4 * MiB, WS_SS1 = 6 * MiB;
constexpr size_t WS_IF = 8 * MiB;
constexpr size_t WS_NST = 9 * MiB;
constexpr size_t WS_LOGITS = 10 * MiB;
constexpr size_t WS_WIN = 18 * MiB;
constexpr size_t WS_WBR = WS_WIN + 8960ull * 1024 * 2;
constexpr size_t WS_WOUT = WS_WBR + 3ull * 1024 * 512 * 2;
constexpr size_t WS_WPG = WS_WOUT + 1024ull * 1024 * 2;
constexpr size_t WS_WPP = WS_WPG + 1024ull * 1024 * 2;
constexpr size_t WS_WR = WS_WPP + 1024ull * 256 * 2;
static_assert(WS_WR + 256ull * 1024 * 2 <= 44 * MiB, "small weights");
constexpr size_t WS_XB = 44 * MiB;
constexpr size_t WS_QA0 = 108 * MiB;
constexpr size_t WS_YATT = WS_QA0;
constexpr size_t WS_OM = 140 * MiB;
constexpr size_t WS_YC = 172 * MiB;
constexpr size_t WS_CST = 204 * MiB;
constexpr size_t WS_B = 236 * MiB;
constexpr size_t WS_KA = WS_B, WS_QA1 = WS_B + 32 * MiB, WS_QA2 = WS_B + 64 * MiB, WS_VA = WS_B + 96 * MiB, WS_YG = WS_B + 128 * MiB, WS_QM = WS_B + 160 * MiB, WS_KM = WS_B + 192 * MiB, WS_VM = WS_B + 224 * MiB;
constexpr size_t WS_G0 = WS_B, WS_MERGED = WS_B + 192 * MiB;
constexpr size_t WS_WEXP = WS_B, WS_HB = WS_B + 48 * MiB, WS_PBF = WS_B + 88 * MiB, WS_PE = WS_B + 104 * MiB, WS_YB1 = WS_B + 168 * MiB, WS_XBT = WS_B;
constexpr size_t WS_END = 492 * MiB;
constexpr size_t TAB_CNT = 0;
constexpr size_t TAB_META = 65536;
constexpr size_t TAB_MLOC = 131072, TAB_GTOT = 131072 + 4096, TAB_MST = 131072 + 8192;

constexpr int RING_BYTES = 131072;
constexpr int MISC_OFF = 155648;
constexpr int LDS_BYTES = 156672;

__device__ __forceinline__ unsigned f2bf(float f) { unsigned u = __builtin_bit_cast(unsigned, f); return (u + 0x7fffu + ((u >> 16) & 1u)) >> 16; }
__device__ __forceinline__ unsigned pk2(float lo, float hi) { return f2bf(lo) | (f2bf(hi) << 16); }
__device__ __forceinline__ unsigned cvt_pk_bf16(float lo, float hi) { unsigned r; asm volatile("v_cvt_pk_bf16_f32 %0, %1, %2" : "=v"(r) : "v"(lo), "v"(hi)); return r; }
__device__ __forceinline__ float bf_lo(unsigned w) { return __builtin_bit_cast(float, w << 16); }
__device__ __forceinline__ float bf_hi(unsigned w) { return __builtin_bit_cast(float, w & 0xffff0000u); }
__device__ __forceinline__ float bf1(bf16_t h) { return __builtin_bit_cast(float, ((unsigned)h) << 16); }
__device__ __forceinline__ float sigmoidf_(float v) { return 1.0f / (1.0f + __expf(-v)); }
__device__ __forceinline__ float siluf_(float v) { return v / (1.0f + __expf(-v)); }
__device__ __forceinline__ float wave_sum(float v) {
#pragma unroll
    for (int o = 1; o < 64; o <<= 1) v += __shfl_xor(v, o);
    return v;
}
__device__ __forceinline__ float wave_max(float v) {
#pragma unroll
    for (int o = 1; o < 64; o <<= 1) v = fmaxf(v, __shfl_xor(v, o));
    return v;
}
__device__ __forceinline__ int lane_id_() { int l; asm volatile("v_mbcnt_lo_u32_b32 %0, -1, 0\n\tv_mbcnt_hi_u32_b32 %0, -1, %0" : "=&v"(l)); return l; }
#define LDS_WAIT() asm volatile("s_waitcnt lgkmcnt(0)" ::: "memory")
#define VM_WAIT() asm volatile("s_waitcnt vmcnt(0)" ::: "memory")

#define XB_TMO      128
#define XB_XCNT(j)  (256  + 64 * (j))
#define XB_XSUB(j)  (1280 + 64 * (j))
#define XB_XGEN(j)  (2304 + 64 * (j))
#define XB_TOP      3328
#define XB_TOPGEN   3392
#define XCD_BAR_WORDS 3456
#define XB_SPIN_CAP (1u << 22)
__device__ __forceinline__ unsigned xb_ld(unsigned* p)              { return __hip_atomic_load(p, __ATOMIC_RELAXED, __HIP_MEMORY_SCOPE_AGENT); }
__device__ __forceinline__ unsigned xb_add(unsigned* p, unsigned v) { return __hip_atomic_fetch_add(p, v, __ATOMIC_RELAXED, __HIP_MEMORY_SCOPE_AGENT); }
__device__ __forceinline__ unsigned xb_xcc_id() { return (unsigned)__builtin_amdgcn_s_getreg((3 << 11) | 20) & 0xFu; }
#define XB_SPIN(cond, bar) do { unsigned _sp = 0; while (cond) { __builtin_amdgcn_s_sleep(1); \
    if ((++_sp & 255u) == 0u) { if (xb_ld(&(bar)[XB_TMO])) break; if (_sp > XB_SPIN_CAP) { atomicAdd(&(bar)[XB_TMO], 1u); break; } } } } while (0)
struct XcdBarrier { unsigned* bar; unsigned x; volatile LAS unsigned* st; int wave; };
__device__ __forceinline__ XcdBarrier xcd_barrier_post(unsigned* bar, volatile LAS unsigned* st, int wave) {
    XcdBarrier b; b.bar = bar; b.x = xb_xcc_id(); b.st = st; b.wave = wave;
    if (wave == 0 && lane_id_() == 0) (void)xb_add(&bar[XB_XCNT(b.x)], 1u);
    return b;
}
__device__ __forceinline__ void xcd_barrier_complete(unsigned* bar, unsigned x, unsigned& nloc, unsigned& nx) {
    const unsigned G = gridDim.x * gridDim.y * gridDim.z;
    unsigned sum, cnt, mine, sp = 0u;
    for (;;) {
        sum = 0u; cnt = 0u; mine = 0u;
#pragma unroll
        for (unsigned j = 0; j < 16; ++j) { const unsigned c = xb_ld(&bar[XB_XCNT(j)]); sum += c; cnt += (c > 0u) ? 1u : 0u; mine = (j == x) ? c : mine; }
        if (sum == G) break;
        __builtin_amdgcn_s_sleep(1);
        if ((++sp & 255u) == 0u) { if (xb_ld(&bar[XB_TMO])) break; if (sp > XB_SPIN_CAP) { atomicAdd(&bar[XB_TMO], 1u); break; } }
    }
    nloc = mine > 0u ? mine : 1u; nx = cnt > 0u ? cnt : 1u;
}
__device__ __forceinline__ void xcd_barrier(const XcdBarrier& b) {
    asm volatile("s_waitcnt vmcnt(0)" ::: "memory");
    __syncthreads();
    if (b.wave == 0 && lane_id_() == 0) {
        unsigned* bar = b.bar;
        __builtin_amdgcn_s_waitcnt(0);
        unsigned nloc = b.st[0], nx = b.st[1];
        if (nloc == 0u) { xcd_barrier_complete(bar, b.x, nloc, nx); b.st[0] = nloc; b.st[1] = nx; }
        const unsigned old = xb_add(&bar[XB_XSUB(b.x)], 1u);
        const unsigned gen = old / nloc;
        if (old + 1u == (gen + 1u) * nloc) {
            __builtin_amdgcn_fence(__ATOMIC_RELEASE, "agent");
            asm volatile("s_waitcnt vmcnt(0)" ::: "memory");
            const unsigned og = xb_add(&bar[XB_TOP], 1u);
            const unsigned tg = og / nx;
            if (og + 1u == (tg + 1u) * nx) xb_add(&bar[XB_TOPGEN], 1u);
            else XB_SPIN(xb_ld(&bar[XB_TOPGEN]) == tg, bar);
            __builtin_amdgcn_fence(__ATOMIC_ACQUIRE, "agent");
            xb_add(&bar[XB_XGEN(b.x)], 1u);
            asm volatile("s_waitcnt vmcnt(0)" ::: "memory");
        } else {
            XB_SPIN(xb_ld(&bar[XB_XGEN(b.x)]) == gen, bar);
            __builtin_amdgcn_fence(__ATOMIC_ACQUIRE, "agent");
            asm volatile("s_waitcnt vmcnt(0)" ::: "memory");
        }
    }
    __syncthreads();
}

namespace pg8 {
constexpr int BM = 256, BK = 64, HALF = 128, HTB = HALF * BK * 2, NXCD = 8, WGM = 8;
__device__ __forceinline__ int lds_byte(int r, int c) { const int st = (r >> 4) * 2 + (c >> 5), rr = r & 15, cc = c & 31, ob = rr * 64 + cc * 2; return st * 1024 + (ob ^ (((ob >> 9) & 1) << 5)); }
__device__ __forceinline__ void stage_rc(int b, int& R, int& C) { const int st = b / 1024, sb = b % 1024, swz = sb ^ (((sb >> 9) & 1) << 5); R = (st >> 1) * 16 + swz / 64; C = (st & 1) * 32 + (swz % 64) / 2; }
__device__ __forceinline__ int perm32(int rho) { const int n = rho >> 4, i = rho & 15; return 8 * (i >> 2) + 4 * n + (i & 3); }

struct GUnit { const char* A; const char* B; int pm, pn, a0, a1; };

__device__ __forceinline__ void tile_order(int L, int nM, int nN, int& pm, int& pn) {
    const int nwg = nM * nN; int wgid = L;
    { const int q = nwg / NXCD, r = nwg % NXCD, xcd = wgid % NXCD, off = wgid / NXCD; wgid = (xcd < r ? xcd * (q + 1) : r * (q + 1) + (xcd - r) * q) + off; }
    const int nig = WGM * nN, gid = wgid / nig, fm = gid * WGM, gsz = (nM - fm) < WGM ? (nM - fm) : WGM;
    pm = fm + ((wgid % nig) % gsz); pn = (wgid % nig) / gsz;
}

typedef f32x4 Acc[2][2][4][2];

template <class P>
__device__ __forceinline__ void gemm_phase(LAS unsigned char* lds, const P& S, int tid) {
    asm volatile("" : "+v"(tid));
    const int wid = __builtin_amdgcn_readfirstlane(tid >> 6), lane = tid & 63, wr = wid >> 2, wc = wid & 3, fr = lane & 15, fq = lane >> 4;
    constexpr int K = P::K, nt = K / BK;
    static_assert(nt >= 4 && (nt % 2) == 0, "K multiple of 128, >= 256");
    unsigned voffB[2];
#pragma unroll
    for (int i = 0; i < 2; ++i) { int R, C; stage_rc(tid * 16 + i * 8192, R, C); const int Rb = (R & ~31) + perm32(R & 31); voffB[i] = (unsigned)(Rb * K + C) * 2u; }
    constexpr size_t kstep = (size_t)(BK * 2);
    constexpr size_t hstepB = (size_t)HALF * K * 2;
    const unsigned ldsw = (unsigned)wid * 1024u;
    const int aoff = lds_byte(wr * 64 + fr, fq * 8), boff = lds_byte(wc * 32 + fr, fq * 8);
#define PG8_SA(b, h) (((b) * 2 + (h)) * HTB)
#define PG8_SB(b, h) ((4 + (b) * 2 + (h)) * HTB)
#define PG8_STAGE(bufoff, gbase, voff) do { _Pragma("unroll") for (int _i = 0; _i < 2; ++_i) \
        __builtin_amdgcn_global_load_lds((const unsigned*)((const char*)(gbase) + (voff)[_i]), (LAS unsigned*)(lds + (bufoff) + ldsw + _i * 8192), 16, 0, 0); } while (0)
#define PG8_LDA(dst, b, h) do { _Pragma("unroll") for (int m = 0; m < 4; ++m) _Pragma("unroll") for (int k = 0; k < 2; ++k) dst[m][k] = *(const LAS bf16x8*)(lds + PG8_SA(b, h) + aoff + m * 2048 + k * 1024); } while (0)
#define PG8_LDB(dst, b, h) do { _Pragma("unroll") for (int n = 0; n < 2; ++n) _Pragma("unroll") for (int k = 0; k < 2; ++k) dst[n][k] = *(const LAS bf16x8*)(lds + PG8_SB(b, h) + boff + n * 2048 + k * 1024); } while (0)
#define PG8_MMA(ai, bj, At, Bt) do { __builtin_amdgcn_s_setprio(1); _Pragma("unroll") for (int m = 0; m < 4; ++m) _Pragma("unroll") for (int n = 0; n < 2; ++n) _Pragma("unroll") for (int k = 0; k < 2; ++k) \
        acc[ai][bj][m][n] = __builtin_amdgcn_mfma_f32_16x16x32_bf16(Bt[n][k], At[m][k], acc[ai][bj][m][n], 0, 0, 0); __builtin_amdgcn_s_setprio(0); } while (0)
#define PG8_WAIT_V(n) asm volatile("s_waitcnt vmcnt(" #n ")" ::: "memory")
#define PG8_WAIT_L(n) asm volatile("s_waitcnt lgkmcnt(" #n ")" ::: "memory")
#define PG8_BAR __builtin_amdgcn_s_barrier()
#define PG8_SCHED __builtin_amdgcn_sched_barrier(0)
#define PG8_VOA(dst, u) do { _Pragma("unroll") for (int _h = 0; _h < 2; ++_h) _Pragma("unroll") for (int _i = 0; _i < 2; ++_i) { int _R, _C; stage_rc(tid * 16 + _i * 8192, _R, _C); \
        if constexpr (P::GATHER) dst[_h][_i] = (S.arow(u, _h * HALF + _R) * (unsigned)K + (unsigned)_C) * 2u; \
        else dst[_h][_i] = (unsigned)((_h * HALF + _R) * K + _C) * 2u; } } while (0)
    GUnit cur, nxt; int ui = 0;
    if (!S.next(0, cur)) return;
    Acc acc;
#pragma unroll
    for (int a = 0; a < 2; ++a)
#pragma unroll
        for (int b = 0; b < 2; ++b)
#pragma unroll
            for (int m = 0; m < 4; ++m)
#pragma unroll
                for (int n = 0; n < 2; ++n) acc[a][b][m][n] = (f32x4){0.f, 0.f, 0.f, 0.f};
    bf16x8 At[4][2], B0[2][2], B1[2][2];
    unsigned voA[2][2], voAn[2][2];
    PG8_VOA(voA, cur);
    const char* cA = cur.A; const char* cB = cur.B;
    PG8_STAGE(PG8_SB(0, 0), cB, voffB); PG8_STAGE(PG8_SB(0, 1), cB + hstepB, voffB); PG8_STAGE(PG8_SA(0, 0), cA, voA[0]); PG8_STAGE(PG8_SA(0, 1), cA, voA[1]);
    if (wr == 1) PG8_BAR;
    PG8_WAIT_V(2); PG8_BAR;
    PG8_STAGE(PG8_SB(1, 0), cB + kstep, voffB); PG8_STAGE(PG8_SA(1, 0), cA + kstep, voA[0]); PG8_STAGE(PG8_SB(1, 1), cB + hstepB + kstep, voffB);
    PG8_WAIT_V(6); PG8_BAR;
    for (;;) {
        const bool has_next = S.next(ui + 1, nxt);
        const char* nA = has_next ? nxt.A : cA; const char* nB = has_next ? nxt.B : cB;
        if constexpr (P::GATHER) {
            if (has_next) { PG8_VOA(voAn, nxt); }
            else {
#pragma unroll
                for (int h = 0; h < 2; ++h)
#pragma unroll
                    for (int i = 0; i < 2; ++i) voAn[h][i] = voA[h][i];
            }
        }
#pragma unroll 1
        for (int t = 0; t < nt; t += 2) {
            const bool last = (t == nt - 2);
            const char* a1 = cA + (size_t)(t + 1) * kstep;
            const char* a2 = last ? nA : cA + (size_t)(t + 2) * kstep; const char* b2 = last ? nB : cB + (size_t)(t + 2) * kstep;
            const char* a3 = a2 + kstep; const char* b3 = b2 + kstep;
            unsigned s0[2], s1[2];
#pragma unroll
            for (int i = 0; i < 2; ++i) {
                if constexpr (P::GATHER) { s0[i] = last ? voAn[0][i] : voA[0][i]; s1[i] = last ? voAn[1][i] : voA[1][i]; }
                else { s0[i] = voA[0][i]; s1[i] = voA[1][i]; }
            }
            PG8_LDB(B0, 0, 0); PG8_LDB(B1, 0, 1); PG8_SCHED; PG8_LDA(At, 0, 0); PG8_STAGE(PG8_SA(1, 1), a1, voA[1]);
            PG8_WAIT_V(8); PG8_WAIT_L(0); PG8_BAR; PG8_MMA(0, 0, At, B0); PG8_MMA(0, 1, At, B1); PG8_BAR; PG8_SCHED;
            PG8_LDA(At, 0, 1); PG8_STAGE(PG8_SB(0, 0), b2, voffB); PG8_STAGE(PG8_SB(0, 1), b2 + hstepB, voffB); PG8_STAGE(PG8_SA(0, 0), a2, s0);
            PG8_WAIT_V(8); PG8_WAIT_L(0); PG8_BAR; PG8_MMA(1, 0, At, B0); PG8_MMA(1, 1, At, B1); PG8_BAR; PG8_SCHED;
            PG8_LDB(B0, 1, 0); PG8_LDB(B1, 1, 1); PG8_SCHED; PG8_LDA(At, 1, 0); PG8_STAGE(PG8_SA(0, 1), a2, s1);
            PG8_WAIT_V(8); PG8_WAIT_L(0); PG8_BAR; PG8_MMA(0, 0, At, B0); PG8_MMA(0, 1, At, B1); PG8_BAR; PG8_SCHED;
            PG8_LDA(At, 1, 1); PG8_STAGE(PG8_SB(1, 0), b3, voffB); PG8_STAGE(PG8_SB(1, 1), b3 + hstepB, voffB); PG8_STAGE(PG8_SA(1, 0), a3, s0);
            PG8_WAIT_V(8); PG8_WAIT_L(0); PG8_BAR; PG8_MMA(1, 0, At, B0); PG8_MMA(1, 1, At, B1); PG8_BAR; PG8_SCHED;
        }
        if (wr == 0) PG8_BAR;
        const bool zero = S.epi(acc, cur, wr, wc, fr, fq);
        if (!has_next) break;
        if (zero) {
#pragma unroll
            for (int a = 0; a < 2; ++a)
#pragma unroll
                for (int b = 0; b < 2; ++b)
#pragma unroll
                    for (int m = 0; m < 4; ++m)
#pragma unroll
                        for (int n = 0; n < 2; ++n) acc[a][b][m][n] = (f32x4){0.f, 0.f, 0.f, 0.f};
        }
        cur = nxt; cA = nA; cB = nB; ++ui;
        if constexpr (P::GATHER) {
#pragma unroll
            for (int h = 0; h < 2; ++h)
#pragma unroll
                for (int i = 0; i < 2; ++i) voA[h][i] = voAn[h][i];
        }
        if (wr == 1) PG8_BAR;
    }
    PG8_WAIT_V(0);
    PG8_BAR;
#undef PG8_SA
#undef PG8_SB
#undef PG8_STAGE
#undef PG8_LDA
#undef PG8_LDB
#undef PG8_MMA
#undef PG8_WAIT_V
#undef PG8_WAIT_L
#undef PG8_BAR
#undef PG8_SCHED
#undef PG8_VOA
}
}
using pg8::GUnit; using pg8::Acc;

__device__ __forceinline__ float row_rs(const float* SS, int row) {
    const f32x4* p = (const f32x4*)(SS + (size_t)row * 16);
    const f32x4 a = p[0], b = p[1], c = p[2], d = p[3];
    const float s = (((a.x + a.y) + (a.z + a.w)) + ((b.x + b.y) + (b.z + b.w))) + (((c.x + c.y) + (c.z + c.w)) + ((d.x + d.y) + (d.z + d.w)));
    return rsqrtf(s * (1.0f / 1024.0f) + EPS);
}
__device__ __forceinline__ u32x4 pack8(const f32x4 v0, const f32x4 v1) { u32x4 w; w.x = cvt_pk_bf16(v0[0], v0[1]); w.y = cvt_pk_bf16(v0[2], v0[3]); w.z = cvt_pk_bf16(v1[0], v1[1]); w.w = cvt_pk_bf16(v1[2], v1[3]); return w; }
__device__ __forceinline__ void unpack8(const u32x4 w, f32x4& v0, f32x4& v1) { v0 = (f32x4){bf_lo(w.x), bf_hi(w.x), bf_lo(w.y), bf_hi(w.y)}; v1 = (f32x4){bf_lo(w.z), bf_hi(w.z), bf_lo(w.w), bf_hi(w.w)}; }
__device__ __forceinline__ f32x4 sig4(const f32x4 v) { return (f32x4){sigmoidf_(v[0]), sigmoidf_(v[1]), sigmoidf_(v[2]), sigmoidf_(v[3])}; }
__device__ __forceinline__ f32x4 gate4(const f32x4 v) { f32x4 s = sig4(v); return (f32x4){fmaxf(s[0], 1e-6f), fmaxf(s[1], 1e-6f), fmaxf(s[2], 1e-6f), fmaxf(s[3], 1e-6f)}; }

struct PhProj {
    static constexpr int K = 1024; static constexpr bool GATHER = false;
    const char* xb; const char* W; const float* SS; unsigned char* ws; int G, c;
    __device__ __forceinline__ bool next(int i, GUnit& u) const {
        const long L = (long)i * G + c; if (L >= 128 * 23) return false;
        pg8::tile_order((int)L, 128, 23, u.pm, u.pn);
        u.A = xb + (size_t)u.pm * 256 * K * 2; u.B = W + (size_t)u.pn * 256 * K * 2; u.a0 = 0; u.a1 = 0; return true;
    }
    __device__ __forceinline__ unsigned arow(const GUnit&, int) const { return 0u; }
    __device__ __forceinline__ bool epi(Acc& acc, const GUnit& u, int wr, int wc, int fr, int fq) const {
        const int pn = u.pn; const int row0 = u.pm * 256 + wr * 64 + fr;
        if (pn == 22) {
            if (wc == 0 && fq == 0) {
                float* IFp = (float*)(ws + WS_IF);
#pragma unroll
                for (int ai = 0; ai < 2; ++ai)
#pragma unroll
                    for (int m = 0; m < 4; ++m) { const int row = row0 + ai * 128 + m * 16; const float rs = row_rs(SS, row);
                        *(f32x4*)(IFp + (size_t)row * 8) = acc[ai][0][m][0] * rs; *(f32x4*)(IFp + (size_t)row * 8 + 4) = acc[ai][0][m][1] * rs; }
            }
            return true;
        }
        if (pn >= 10 && pn < 14) {
            bf16_t* Y = (bf16_t*)(ws + WS_YG);
#pragma unroll
            for (int ai = 0; ai < 2; ++ai)
#pragma unroll
                for (int m = 0; m < 4; ++m) { const int row = row0 + ai * 128 + m * 16; const float rs = row_rs(SS, row);
#pragma unroll
                    for (int bj = 0; bj < 2; ++bj) { const f32x4 a = acc[ai][bj][m][0] * rs, g = sig4(acc[ai][bj][m][1] * rs), y = a * g;
                        u32x2 w; w.x = cvt_pk_bf16(y[0], y[1]); w.y = cvt_pk_bf16(y[2], y[3]);
                        *(u32x2*)(Y + (size_t)row * 512 + (pn - 10) * 128 + bj * 64 + wc * 16 + fq * 4) = w; } }
            return true;
        }
        bf16_t* dst; int col0; bool sg = false;
        if (pn < 6) { dst = (bf16_t*)(ws + (pn < 2 ? WS_QA0 : (pn < 4 ? WS_QA1 : WS_QA2))); col0 = (pn & 1) * 256; }
        else if (pn < 8) { dst = (bf16_t*)(ws + WS_KA); col0 = (pn - 6) * 256; }
        else if (pn < 10) { dst = (bf16_t*)(ws + WS_VA); col0 = (pn - 8) * 256; }
        else if (pn < 16) { dst = (bf16_t*)(ws + WS_QM); col0 = (pn - 14) * 256; }
        else if (pn < 18) { dst = (bf16_t*)(ws + WS_KM); col0 = (pn - 16) * 256; }
        else if (pn < 20) { dst = (bf16_t*)(ws + WS_VM); col0 = (pn - 18) * 256; }
        else { dst = (bf16_t*)(ws + WS_OM); col0 = (pn - 20) * 256; sg = true; }
        col0 += wc * 32 + fq * 8;
#pragma unroll
        for (int ai = 0; ai < 2; ++ai)
#pragma unroll
            for (int m = 0; m < 4; ++m) { const int row = row0 + ai * 128 + m * 16; const float rs = row_rs(SS, row);
#pragma unroll
                for (int bj = 0; bj < 2; ++bj) { f32x4 v0 = acc[ai][bj][m][0] * rs, v1 = acc[ai][bj][m][1] * rs;
                    if (sg) { v0 = sig4(v0); v1 = sig4(v1); }
                    *(u32x4*)(dst + (size_t)row * 512 + col0 + bj * 128) = pack8(v0, v1); } }
        return true;
    }
};
struct PhGates {
    static constexpr int K = 1024; static constexpr bool GATHER = false;
    const char* xb; const char* W; const float* SS; unsigned char* ws; int G, c;
    __device__ __forceinline__ bool next(int i, GUnit& u) const {
        const long L = (long)i * G + c; if (L >= 128 * 12) return false;
        pg8::tile_order((int)L, 128, 12, u.pm, u.pn);
        u.A = xb + (size_t)u.pm * 256 * K * 2; u.B = W + (size_t)(5888 + u.pn * 256) * K * 2; u.a0 = 0; u.a1 = 0; return true;
    }
    __device__ __forceinline__ unsigned arow(const GUnit&, int) const { return 0u; }
    __device__ __forceinline__ bool epi(Acc& acc, const GUnit& u, int wr, int wc, int fr, int fq) const {
        const int row0 = u.pm * 256 + wr * 64 + fr;
        bf16_t* dst = (bf16_t*)(ws + WS_G0 + (size_t)(u.pn >> 2) * 64 * MiB); const int col0 = (u.pn & 3) * 256 + wc * 32 + fq * 8;
#pragma unroll
        for (int ai = 0; ai < 2; ++ai)
#pragma unroll
            for (int m = 0; m < 4; ++m) { const int row = row0 + ai * 128 + m * 16; const float rs = row_rs(SS, row);
#pragma unroll
                for (int bj = 0; bj < 2; ++bj) *(u32x4*)(dst + (size_t)row * 1024 + col0 + bj * 128) = pack8(gate4(acc[ai][bj][m][0] * rs), gate4(acc[ai][bj][m][1] * rs)); }
        return true;
    }
};
struct PhMerge {
    static constexpr int K = 512; static constexpr bool GATHER = false;
    unsigned char* ws; int G, c;
    __device__ __forceinline__ bool next(int i, GUnit& u) const {
        const int ti = i / 3, seg = i - ti * 3; const long L = (long)ti * G + c; if (L >= 128 * 4) return false;
        pg8::tile_order((int)L, 128, 4, u.pm, u.pn);
        const size_t ya = seg == 0 ? WS_YATT : (seg == 1 ? WS_YC : WS_OM);
        u.A = (const char*)ws + ya + (size_t)u.pm * 256 * K * 2; u.B = (const char*)ws + WS_WBR + (size_t)seg * 1024 * 512 * 2 + (size_t)u.pn * 256 * K * 2; u.a0 = seg; u.a1 = 0; return true;
    }
    __device__ __forceinline__ unsigned arow(const GUnit&, int) const { return 0u; }
    __device__ __forceinline__ bool epi(Acc& acc, const GUnit& u, int wr, int wc, int fr, int fq) const {
        const int seg = u.a0; const int row0 = u.pm * 256 + wr * 64 + fr; const int col0 = u.pn * 256 + wc * 32 + fq * 8;
        const bf16_t* Gn = (const bf16_t*)(ws + WS_G0 + (size_t)seg * 64 * MiB);
        const bf16_t* Gd = (const bf16_t*)(ws + WS_G0 + (size_t)(seg + 1) * 64 * MiB);
        bf16_t* Mo = (bf16_t*)(ws + WS_MERGED);
#pragma unroll
        for (int ai = 0; ai < 2; ++ai)
#pragma unroll
            for (int m = 0; m < 4; ++m) { const size_t off = (size_t)(row0 + ai * 128 + m * 16) * 1024 + col0;
#pragma unroll
                for (int bj = 0; bj < 2; ++bj) {
                    f32x4 n0, n1; unpack8(*(const u32x4*)(Gn + off + bj * 128), n0, n1);
                    if (seg < 2) { f32x4 d0, d1; unpack8(*(const u32x4*)(Gd + off + bj * 128), d0, d1);
#pragma unroll
                        for (int j = 0; j < 4; ++j) { acc[ai][bj][m][0][j] *= n0[j] * __builtin_amdgcn_rcpf(d0[j]); acc[ai][bj][m][1][j] *= n1[j] * __builtin_amdgcn_rcpf(d1[j]); } }
                    else *(u32x4*)(Mo + off + bj * 128) = pack8(acc[ai][bj][m][0] * n0, acc[ai][bj][m][1] * n1);
                } }
        return seg == 2;
    }
};
__device__ __forceinline__ float store_x8(float* xp, bf16_t* xbp, const f32x4 v0, const f32x4 v1) {
    *(f32x4*)xp = v0; *(f32x4*)(xp + 4) = v1; *(u32x4*)xbp = pack8(v0, v1);
    return ((v0[0] * v0[0] + v0[1] * v0[1]) + (v0[2] * v0[2] + v0[3] * v0[3])) + ((v1[0] * v1[0] + v1[1] * v1[1]) + (v1[2] * v1[2] + v1[3] * v1[3]));
}
struct PhOut {
    static constexpr int K = 1024; static constexpr bool GATHER = false;
    unsigned char* ws; float* x; float* SSo; int G, c;
    __device__ __forceinline__ bool next(int i, GUnit& u) const {
        const long L = (long)i * G + c; if (L >= 128 * 4) return false;
        pg8::tile_order((int)L, 128, 4, u.pm, u.pn);
        u.A = (const char*)ws + WS_MERGED + (size_t)u.pm * 256 * K * 2; u.B = (const char*)ws + WS_WOUT + (size_t)u.pn * 256 * K * 2; u.a0 = 0; u.a1 = 0; return true;
    }
    __device__ __forceinline__ unsigned arow(const GUnit&, int) const { return 0u; }
    __device__ __forceinline__ bool epi(Acc& acc, const GUnit& u, int wr, int wc, int fr, int fq) const {
        const int row0 = u.pm * 256 + wr * 64 + fr; const int col0 = u.pn * 256 + wc * 32 + fq * 8; bf16_t* XB = (bf16_t*)(ws + WS_XB);
#pragma unroll
        for (int ai = 0; ai < 2; ++ai)
#pragma unroll
            for (int m = 0; m < 4; ++m) { const int row = row0 + ai * 128 + m * 16; const size_t off = (size_t)row * 1024 + col0; float ss = 0.f;
#pragma unroll
                for (int bj = 0; bj < 2; ++bj) { float* xp = x + off + bj * 128; const f32x4 v0 = *(const f32x4*)xp + acc[ai][bj][m][0], v1 = *(const f32x4*)(xp + 4) + acc[ai][bj][m][1];
                    ss += store_x8(xp, XB + off + bj * 128, v0, v1); }
                ss += __shfl_xor(ss, 16); ss += __shfl_xor(ss, 32);
                if (fq == 0) SSo[(size_t)row * 16 + u.pn * 4 + wc] = ss; }
        return true;
    }
};
struct PhRouter {
    static constexpr int K = 1024; static constexpr bool GATHER = false;
    unsigned char* ws; const float* SS; int G, c;
    __device__ __forceinline__ bool next(int i, GUnit& u) const {
        const long L = (long)i * G + c; if (L >= 128) return false;
        u.pm = (int)L; u.pn = 0; u.A = (const char*)ws + WS_XB + (size_t)u.pm * 256 * K * 2; u.B = (const char*)ws + WS_WR; u.a0 = 0; u.a1 = 0; return true;
    }
    __device__ __forceinline__ unsigned arow(const GUnit&, int) const { return 0u; }
    __device__ __forceinline__ bool epi(Acc& acc, const GUnit& u, int wr, int wc, int fr, int fq) const {
        if (wc < 2) { float* Lg = (float*)(ws + WS_LOGITS); const int row0 = u.pm * 256 + wr * 64 + fr;
#pragma unroll
            for (int ai = 0; ai < 2; ++ai)
#pragma unroll
                for (int m = 0; m < 4; ++m) { const int row = row0 + ai * 128 + m * 16; const float rs = row_rs(SS, row); float* p = Lg + (size_t)row * 64 + wc * 32 + fq * 8;
                    *(f32x4*)p = acc[ai][0][m][0] * rs; *(f32x4*)(p + 4) = acc[ai][0][m][1] * rs; } }
        return true;
    }
};
__device__ __forceinline__ int moe_expert_of(const int* META, int k, int rb) {
    const int r = rb * 256; int e = 0;
    for (int j = 1; j < 32; ++j) e += (META[16 + 64 * k + j] <= r) ? 1 : 0;
    return __builtin_amdgcn_readfirstlane(e);
}
struct PhUp {
    static constexpr int K = 1024; static constexpr bool GATHER = true;
    unsigned char* ws; const float* SS; const int* META; const int* tok; int G, c;
    __device__ __forceinline__ bool next(int i, GUnit& u) const {
        const int nb0 = __builtin_amdgcn_readfirstlane(META[0]), nb1 = __builtin_amdgcn_readfirstlane(META[1]); const long L = (long)i * G + c; if (L >= 2L * (nb0 + nb1)) return false;
        int blk = (int)(L >> 1); u.pn = (int)(L & 1); int k = 0; if (blk >= nb0) { k = 1; blk -= nb0; }
        const int e = moe_expert_of(META, k, blk);
        u.pm = blk; u.a0 = k; u.a1 = e; u.A = (const char*)ws + WS_XB; u.B = (const char*)ws + WS_WEXP + (size_t)e * 512 * 1024 * 2 + (size_t)u.pn * 256 * K * 2; return true;
    }
    __device__ __forceinline__ unsigned arow(const GUnit& u, int r) const { const int t = tok[u.a0 * LISTCAP + u.pm * 256 + r]; return t < 0 ? 0u : (unsigned)t; }
    __device__ __forceinline__ bool epi(Acc& acc, const GUnit& u, int wr, int wc, int fr, int fq) const {
        const int lr0 = u.a0 * LISTCAP + u.pm * 256 + wr * 64 + fr; bf16_t* HB = (bf16_t*)(ws + WS_HB);
#pragma unroll
        for (int ai = 0; ai < 2; ++ai)
#pragma unroll
            for (int m = 0; m < 4; ++m) { const int lr = lr0 + ai * 128 + m * 16; const int t = tok[lr]; const float rs = t < 0 ? 0.f : row_rs(SS, t < 0 ? 0 : t);
#pragma unroll
                for (int bj = 0; bj < 2; ++bj) { const f32x4 g = acc[ai][bj][m][0] * rs, uu = acc[ai][bj][m][1] * rs;
                    f32x4 h = (f32x4){siluf_(g[0]) * uu[0], siluf_(g[1]) * uu[1], siluf_(g[2]) * uu[2], siluf_(g[3]) * uu[3]}; if (ABL == 8) h = (f32x4){1.f, 1.f, 1.f, 1.f};
                    u32x2 w; w.x = cvt_pk_bf16(h[0], h[1]); w.y = cvt_pk_bf16(h[2], h[3]);
                    *(u32x2*)(HB + (size_t)lr * 256 + u.pn * 128 + bj * 64 + wc * 16 + fq * 4) = w; }
                asm volatile("" ::: "memory"); }
        return true;
    }
};
template <int KL> struct PhDown {
    static constexpr int K = 256; static constexpr bool GATHER = false;
    unsigned char* ws; float* x; float* SSo; const int* META; const int* tok; const float* wl; int G, c;
    __device__ __forceinline__ bool next(int i, GUnit& u) const {
        const int nb = __builtin_amdgcn_readfirstlane(META[KL]); const long L = (long)i * G + c;
        if (L < 4L * nb) { const int blk = (int)(L >> 2); u.pn = (int)(L & 3); const int e = moe_expert_of(META, KL, blk); u.pm = blk; u.a0 = 0; u.a1 = e;
            u.A = (const char*)ws + WS_HB + (size_t)(KL * LISTCAP + blk * 256) * 256 * 2; u.B = (const char*)ws + WS_WEXP + 32ull * 512 * 1024 * 2 + (size_t)e * 1024 * 256 * 2 + (size_t)u.pn * 256 * K * 2; return true; }
        if (KL == 1) { const long L2 = L - 4L * nb; if (L2 >= 128 * 4) return false;
            pg8::tile_order((int)L2, 128, 4, u.pm, u.pn); u.a0 = 1; u.a1 = 0;
            u.A = (const char*)ws + WS_PBF + (size_t)u.pm * 256 * K * 2; u.B = (const char*)ws + WS_WPP + (size_t)u.pn * 256 * K * 2; return true; }
        return false;
    }
    __device__ __forceinline__ unsigned arow(const GUnit&, int) const { return 0u; }
    __device__ __forceinline__ bool epi(Acc& acc, const GUnit& u, int wr, int wc, int fr, int fq) const {
        const int col0 = u.pn * 256 + wc * 32 + fq * 8;
        if (KL == 1 && u.a0 == 1) {
            bf16_t* PE = (bf16_t*)(ws + WS_PE); const int row0 = u.pm * 256 + wr * 64 + fr;
#pragma unroll
            for (int ai = 0; ai < 2; ++ai)
#pragma unroll
                for (int m = 0; m < 4; ++m)
#pragma unroll
                    for (int bj = 0; bj < 2; ++bj) *(u32x4*)(PE + (size_t)(row0 + ai * 128 + m * 16) * 1024 + col0 + bj * 128) = pack8(acc[ai][bj][m][0], acc[ai][bj][m][1]);
            return true;
        }
        const int lr0 = KL * LISTCAP + u.pm * 256 + wr * 64 + fr; bf16_t* YB = (bf16_t*)(ws + WS_YB1); bf16_t* XB = (bf16_t*)(ws + WS_XB);
#pragma unroll
        for (int ai = 0; ai < 2; ++ai)
#pragma unroll
            for (int m = 0; m < 4; ++m) { const int lr = lr0 + ai * 128 + m * 16; const int t = tok[lr]; const float w = (ABL == 9) ? 1.0f : wl[lr]; const size_t off = (size_t)(t < 0 ? 0 : t) * 1024 + col0;
                if (KL == 1) { if (t >= 0) {
#pragma unroll
                        for (int bj = 0; bj < 2; ++bj) *(u32x4*)(YB + off + bj * 128) = pack8(acc[ai][bj][m][0] * w, acc[ai][bj][m][1] * w); } }
                else { float ss = 0.f;
                    if (t >= 0) {
#pragma unroll
                        for (int bj = 0; bj < 2; ++bj) { float* xp = x + off + bj * 128; f32x4 y0, y1; unpack8(*(const u32x4*)(YB + off + bj * 128), y0, y1);
                            f32x4 v0 = (*(const f32x4*)xp + y0) + acc[ai][bj][m][0] * w, v1 = (*(const f32x4*)(xp + 4) + y1) + acc[ai][bj][m][1] * w; if (ABL == 7) { v0 = v0 + 1.0f; v1 = v1 + 1.0f; }
                            ss += store_x8(xp, XB + off + bj * 128, v0, v1); } }
                    ss += __shfl_xor(ss, 16); ss += __shfl_xor(ss, 32);
                    if (fq == 0 && t >= 0) SSo[(size_t)t * 16 + u.pn * 4 + wc] = ss; }
                asm volatile("" ::: "memory"); }
        return true;
    }
};
struct PhPle {
    static constexpr int K = 1024; static constexpr bool GATHER = false;
    unsigned char* ws; float* x; const float* SSi; float* SSo; int G, c;
    __device__ __forceinline__ bool next(int i, GUnit& u) const {
        const long L = (long)i * G + c; if (L >= 128 * 4) return false;
        pg8::tile_order((int)L, 128, 4, u.pm, u.pn);
        u.A = (const char*)ws + WS_XB + (size_t)u.pm * 256 * K * 2; u.B = (const char*)ws + WS_WPG + (size_t)u.pn * 256 * K * 2; u.a0 = 0; u.a1 = 0; return true;
    }
    __device__ __forceinline__ unsigned arow(const GUnit&, int) const { return 0u; }
    __device__ __forceinline__ bool epi(Acc& acc, const GUnit& u, int wr, int wc, int fr, int fq) const {
        const int row0 = u.pm * 256 + wr * 64 + fr; const int col0 = u.pn * 256 + wc * 32 + fq * 8; bf16_t* XT = (bf16_t*)(ws + WS_XBT); const bf16_t* PE = (const bf16_t*)(ws + WS_PE);
#pragma unroll
        for (int ai = 0; ai < 2; ++ai)
#pragma unroll
            for (int m = 0; m < 4; ++m) { const int row = row0 + ai * 128 + m * 16; const size_t off = (size_t)row * 1024 + col0; const float rs = row_rs(SSi, row); float ss = 0.f;
#pragma unroll
                for (int bj = 0; bj < 2; ++bj) { float* xp = x + off + bj * 128; f32x4 p0, p1; unpack8(*(const u32x4*)(PE + off + bj * 128), p0, p1); if (ABL == 5) { p0 = p0 * 0.f; p1 = p1 * 0.f; }
                    const f32x4 v0 = *(const f32x4*)xp + sig4(acc[ai][bj][m][0] * rs) * p0, v1 = *(const f32x4*)(xp + 4) + sig4(acc[ai][bj][m][1] * rs) * p1;
                    ss += store_x8(xp, XT + off + bj * 128, v0, v1); }
                ss += __shfl_xor(ss, 16); ss += __shfl_xor(ss, 32);
                if (fq == 0) SSo[(size_t)row * 16 + u.pn * 4 + wc] = ss; }
        return true;
    }
};

struct Ctx {
    const float* const* in; float* out; unsigned char* ws; LAS unsigned char* lds;
    int tid, lane, wave, G, bid;
};
enum { I_X = 0, I_P, I_GMIX, I_WIN, I_CONVW, I_CONVB, I_CLNG, I_CLNB, I_MCW, I_MCB, I_MIB, I_MFB, I_WBA, I_WBC, I_WBM, I_WOUT, I_GFFN, I_WRG, I_BRG, I_WRE, I_BRE,
       I_WEG, I_WEU, I_WED, I_GPLE, I_WPG, I_WPP, I_GFIN };

__device__ __forceinline__ void tr_item(const float* colptr, size_t pitch, const float* gain, float cscale, bf16_t* dst, int K, int n0, int k0, LAS float* scr, int lane) {
#pragma unroll 8
    for (int i = 0; i < 32; ++i) { const int kk = 2 * i + (lane >> 5); float v = colptr ? colptr[(size_t)(k0 + kk) * pitch] : 0.f; if (gain) v *= gain[k0 + kk]; scr[kk * 33 + (lane & 31)] = v * cscale; }
    LDS_WAIT(); asm volatile("" ::: "memory");
    const int c = lane & 7;
#pragma unroll
    for (int j = 0; j < 4; ++j) { const int n = (lane >> 3) + 8 * j; const LAS float* s = scr + (8 * c) * 33 + n;
        u32x4 o; o.x = pk2(s[0 * 33], s[1 * 33]); o.y = pk2(s[2 * 33], s[3 * 33]); o.z = pk2(s[4 * 33], s[5 * 33]); o.w = pk2(s[6 * 33], s[7 * 33]);
        *(u32x4*)(dst + (size_t)(n0 + n) * K + k0 + 8 * c) = o; }
    LDS_WAIT(); asm volatile("" ::: "memory");
}
__device__ __forceinline__ void phase_prep(const Ctx& F, int layer, float* SS) {
    const int gw = F.bid * NWAVES + F.wave, NGW = F.G * NWAVES, lane = F.lane;
    LAS float* scr = (LAS float*)(F.lds + F.wave * 16384);
    bf16_t* XB = (bf16_t*)(F.ws + WS_XB);
    if (layer == 0) {
        for (int m = gw; m < T; m += NGW) {
            const f32x4* xr = (const f32x4*)(F.in[I_X] + (size_t)m * D) + lane; f32x4* orow = (f32x4*)(F.out + (size_t)m * D) + lane; u32x2* xbr = (u32x2*)(XB + (size_t)m * D) + lane;
            float s = 0.f;
#pragma unroll
            for (int j = 0; j < 4; ++j) { const f32x4 v = xr[64 * j]; orow[64 * j] = v; s += (v.x * v.x + v.y * v.y) + (v.z * v.z + v.w * v.w);
                u32x2 w; w.x = cvt_pk_bf16(v.x, v.y); w.y = cvt_pk_bf16(v.z, v.w); xbr[64 * j] = w; }
            s = wave_sum(s);
            if (lane < 16) SS[(size_t)m * 16 + lane] = lane == 0 ? s : 0.f;
        }
    } else {
        const u32x4* src = (const u32x4*)(F.ws + WS_XBT); u32x4* dst = (u32x4*)(F.ws + WS_XB);
        for (size_t i = (size_t)F.bid * NTHREADS + F.tid; i < (size_t)T * D * 2 / 16; i += (size_t)F.G * NTHREADS) dst[i] = src[i];
    }
    const float* w_in = F.in[I_WIN] + (size_t)layer * D * D_IN; const float* g_mix = F.in[I_GMIX] + (size_t)layer * D;
    constexpr int N_WIN = 280 * 16, N_BR = 32 * 8, N_SQ = 32 * 16, N_PP = 32 * 4, N_R = 8 * 16;
    constexpr int NITEMS = N_WIN + 3 * N_BR + 2 * N_SQ + N_PP + N_R;
    for (int it = gw; it < NITEMS; it += NGW) {
        int r = it;
        if (r < N_WIN) { const int nb = r >> 4, kb = r & 15; const int n = nb * 32 + (lane & 31); int src = -1; float cs = 1.f;
            if (n < 2560) { src = n; if (n < 1536) cs = 0.125f; }
            else if (n < 3584) { const int np = n - 2560, q8 = np >> 3, s = (np >> 2) & 1, j = np & 3; src = 2560 + s * 512 + 4 * q8 + j; }
            else if (n < 5640) src = n;
            else if (n < 5888) src = -1;
            else src = 5640 + (n - 5888);
            tr_item(src >= 0 ? w_in + src : nullptr, D_IN, g_mix, cs, (bf16_t*)(F.ws + WS_WIN), 1024, nb * 32, kb * 64, scr, lane); continue; }
        r -= N_WIN;
        if (r < 3 * N_BR) { const int b = r / N_BR; r -= b * N_BR; const int nb = r >> 3, kb = r & 7; const int n = nb * 32 + (lane & 31);
            const float* w = (b == 0 ? F.in[I_WBA] : (b == 1 ? F.in[I_WBC] : F.in[I_WBM])) + (size_t)layer * 512 * 1024;
            tr_item(w + n, 1024, nullptr, 1.f, (bf16_t*)(F.ws + WS_WBR) + (size_t)b * 1024 * 512, 512, nb * 32, kb * 64, scr, lane); continue; }
        r -= 3 * N_BR;
        if (r < 2 * N_SQ) { const int b = r / N_SQ; r -= b * N_SQ; const int nb = r >> 4, kb = r & 15; const int n = nb * 32 + (lane & 31);
            const float* w = (b == 0 ? F.in[I_WOUT] : F.in[I_WPG]) + (size_t)layer * 1024 * 1024;
            tr_item(w + n, 1024, b == 0 ? nullptr : F.in[I_GPLE] + (size_t)layer * D, 1.f, (bf16_t*)(F.ws + (b == 0 ? WS_WOUT : WS_WPG)), 1024, nb * 32, kb * 64, scr, lane); continue; }
        r -= 2 * N_SQ;
        if (r < N_PP) { const int nb = r >> 2, kb = r & 3; const int n = nb * 32 + (lane & 31);
            tr_item(F.in[I_WPP] + (size_t)layer * 256 * 1024 + n, 1024, nullptr, 1.f, (bf16_t*)(F.ws + WS_WPP), 256, nb * 32, kb * 64, scr, lane); continue; }
        r -= N_PP;
        { const int nb = r >> 4, kb = r & 15; const int n = nb * 32 + (lane & 31); const float* cp = nullptr; size_t pitch = 4;
            if (n < 4) { cp = F.in[I_WRG] + (size_t)layer * 1024 * 4 + n; pitch = 4; } else if (n < 36) { cp = F.in[I_WRE] + (size_t)layer * 1024 * 32 + (n - 4); pitch = 32; }
            tr_item(cp, pitch, F.in[I_GFFN] + (size_t)layer * D, 1.f, (bf16_t*)(F.ws + WS_WR), 1024, nb * 32, kb * 64, scr, lane); }
    }
}
__device__ __forceinline__ void phase_prep_experts(const Ctx& F, int layer) {
    const int gw = F.bid * NWAVES + F.wave, NGW = F.G * NWAVES, lane = F.lane;
    LAS float* scr = (LAS float*)(F.lds + F.wave * 16384);
    const float* g_ffn = F.in[I_GFFN] + (size_t)layer * D;
    constexpr int N_UP = 32 * 16 * 16, N_DN = 32 * 32 * 4;
    for (int it = gw; it < N_UP + N_DN; it += NGW) {
        int r = it;
        if (r < N_UP) { const int e = r >> 8; r &= 255; const int nb = r >> 4, kb = r & 15; const int n = nb * 32 + (lane & 31); const int q8 = n >> 3, s = (n >> 2) & 1, j = n & 3;
            const float* w = (s ? F.in[I_WEU] : F.in[I_WEG]) + ((size_t)layer * 32 + e) * 1024 * 256 + 4 * q8 + j;
            tr_item(w, 256, g_ffn, 1.f, (bf16_t*)(F.ws + WS_WEXP) + (size_t)e * 512 * 1024, 1024, nb * 32, kb * 64, scr, lane); continue; }
        r -= N_UP;
        { const int e = r >> 7; r &= 127; const int nb = r >> 2, kb = r & 3; const int n = nb * 32 + (lane & 31);
            const float* w = F.in[I_WED] + ((size_t)layer * 32 + e) * 256 * 1024 + n;
            tr_item(w, 1024, nullptr, 1.f, (bf16_t*)(F.ws + WS_WEXP) + 32ull * 512 * 1024 + (size_t)e * 1024 * 256, 256, nb * 32, kb * 64, scr, lane); }
    }
    const f32x4* p = (const f32x4*)(F.in[I_P] + (size_t)layer * T * 256); u32x2* pb = (u32x2*)(F.ws + WS_PBF);
    for (size_t i = (size_t)F.bid * NTHREADS + F.tid; i < (size_t)T * 256 / 4; i += (size_t)F.G * NTHREADS) { const f32x4 v = p[i]; u32x2 w; w.x = cvt_pk_bf16(v.x, v.y); w.y = cvt_pk_bf16(v.z, v.w); pb[i] = w; }
}

__device__ __forceinline__ void attn_item_v1(const Ctx& F, int tb) {
    const int slot = F.wave, t = tb * 64 + F.lane, s = t & (SEQ - 1);
    const bf16_t* KA = (const bf16_t*)(F.ws + WS_KA); const bf16_t* VA = (const bf16_t*)(F.ws + WS_VA);
    float acc[64];
#pragma unroll
    for (int d = 0; d < 64; ++d) acc[d] = 0.f;
    float mrun = -INFINITY, lrun = 0.f;
    for (int g = 0; g < 3; ++g) {
        const int dl = 1 << (2 * g); const float slope = exp2f(-(float)(g * 8 + slot + 1) * (1.0f / 3.0f)) * (float)dl;
        const bf16_t* Q = (const bf16_t*)(F.ws + (g == 0 ? WS_QA0 : (g == 1 ? WS_QA1 : WS_QA2))) + (size_t)t * 512 + slot * 64;
        float q[64];
#pragma unroll
        for (int c = 0; c < 8; ++c) { const u32x4 w = ((const u32x4*)Q)[c]; q[8 * c] = bf_lo(w.x); q[8 * c + 1] = bf_hi(w.x); q[8 * c + 2] = bf_lo(w.y); q[8 * c + 3] = bf_hi(w.y); q[8 * c + 4] = bf_lo(w.z); q[8 * c + 5] = bf_hi(w.z); q[8 * c + 6] = bf_lo(w.w); q[8 * c + 7] = bf_hi(w.w); }
        int nj = s / dl; if (nj > 128) nj = 128;
        const int njmax = __builtin_amdgcn_readfirstlane((int)wave_max((float)nj));
        for (int j = 0; j <= njmax; ++j) {
            const bool ok = j <= nj; const int tk = ok ? t - dl * j : t;
            const u32x4* kp = (const u32x4*)(KA + (size_t)tk * 512 + slot * 64); const u32x4* vp = (const u32x4*)(VA + (size_t)tk * 512 + slot * 64);
            float dot = 0.f;
#pragma unroll
            for (int c = 0; c < 8; ++c) { const u32x4 w = kp[c];
                dot += q[8 * c] * bf_lo(w.x) + q[8 * c + 1] * bf_hi(w.x) + q[8 * c + 2] * bf_lo(w.y) + q[8 * c + 3] * bf_hi(w.y) + q[8 * c + 4] * bf_lo(w.z) + q[8 * c + 5] * bf_hi(w.z) + q[8 * c + 6] * bf_lo(w.w) + q[8 * c + 7] * bf_hi(w.w); }
            const float sc = ok ? dot - slope * (float)j : -INFINITY;
            const float mn = fmaxf(mrun, sc);
            const float corr = __expf(mrun - mn), pw = __expf(sc - mn);
            lrun = lrun * corr + pw; mrun = mn;
#pragma unroll
            for (int c = 0; c < 8; ++c) { const u32x4 w = vp[c];
                acc[8 * c] = acc[8 * c] * corr + pw * bf_lo(w.x); acc[8 * c + 1] = acc[8 * c + 1] * corr + pw * bf_hi(w.x); acc[8 * c + 2] = acc[8 * c + 2] * corr + pw * bf_lo(w.y); acc[8 * c + 3] = acc[8 * c + 3] * corr + pw * bf_hi(w.y);
                acc[8 * c + 4] = acc[8 * c + 4] * corr + pw * bf_lo(w.z); acc[8 * c + 5] = acc[8 * c + 5] * corr + pw * bf_hi(w.z); acc[8 * c + 6] = acc[8 * c + 6] * corr + pw * bf_lo(w.w); acc[8 * c + 7] = acc[8 * c + 7] * corr + pw * bf_hi(w.w); }
        }
    }
    const float inv = (ABL == 1) ? 0.f : 1.0f / lrun;
    u32x4* o = (u32x4*)((bf16_t*)(F.ws + WS_YATT) + (size_t)t * 512 + slot * 64);
#pragma unroll
    for (int c = 0; c < 8; ++c) { u32x4 w; w.x = cvt_pk_bf16(acc[8 * c] * inv, acc[8 * c + 1] * inv); w.y = cvt_pk_bf16(acc[8 * c + 2] * inv, acc[8 * c + 3] * inv); w.z = cvt_pk_bf16(acc[8 * c + 4] * inv, acc[8 * c + 5] * inv); w.w = cvt_pk_bf16(acc[8 * c + 6] * inv, acc[8 * c + 7] * inv); o[c] = w; }
}

constexpr int AK_RS = 144, AV_RS = 160, AV_OFF = 2 * 128 * AK_RS;
typedef short s16x4 __attribute__((ext_vector_type(4)));
__device__ __forceinline__ s16x4 lds_tr16(LAS unsigned char* p) { return __builtin_amdgcn_ds_read_tr16_b64_v4i16((LAS s16x4*)p); }
__device__ __forceinline__ void attn_strip(const Ctx& F, int strip) {
    const int bs = strip / 48, sg = strip - bs * 48, b = bs >> 3, slot = bs & 7;
    int g, r, nb0;
    if (sg < 16) { g = 0; r = 0; nb0 = sg * 8; } else if (sg < 32) { g = 1; r = (sg - 16) >> 2; nb0 = ((sg - 16) & 3) * 8; } else { g = 2; r = sg - 32; nb0 = 0; }
    const int dl = 1 << (2 * g); const float slope = exp2f(-(float)(g * 8 + slot + 1) * (1.0f / 3.0f)) * (float)dl;
    bf16_t* Qg = (bf16_t*)(F.ws + (g == 0 ? WS_QA0 : (g == 1 ? WS_QA1 : WS_QA2))) + slot * 64;
    const bf16_t* Kg = (const bf16_t*)(F.ws + WS_KA) + slot * 64; const bf16_t* Vg = (const bf16_t*)(F.ws + WS_VA) + slot * 64;
    float* LSE = (float*)(F.ws + WS_LOGITS) + (size_t)g * T * 8 + slot;
    const size_t tok0 = (size_t)b * SEQ + r;
    LAS unsigned char* Kl = F.lds; LAS unsigned char* Vl = F.lds + AV_OFF;
    const int tid = F.tid, lane = F.lane, w = F.wave, fr = lane & 15, fq = lane >> 4;
    const int srow = tid >> 2, sc4 = tid & 3;
    u32x4 kx[2], vx[2];
#define ATT_LOAD(blk) do { const size_t _t = (tok0 + (size_t)((blk) * 128 + srow) * dl) * 512; \
        kx[0] = *(const u32x4*)(Kg + _t + sc4 * 8); kx[1] = *(const u32x4*)(Kg + _t + 32 + sc4 * 8); vx[0] = *(const u32x4*)(Vg + _t + sc4 * 8); vx[1] = *(const u32x4*)(Vg + _t + 32 + sc4 * 8); } while (0)
#define ATT_STORE(blk) do { const int _p = (((blk) & 1) * 128 + srow); \
        *(LAS u32x4*)(Kl + _p * AK_RS + sc4 * 16) = kx[0]; *(LAS u32x4*)(Kl + _p * AK_RS + 64 + sc4 * 16) = kx[1]; *(LAS u32x4*)(Vl + _p * AV_RS + sc4 * 16) = vx[0]; *(LAS u32x4*)(Vl + _p * AV_RS + 64 + sc4 * 16) = vx[1]; } while (0)
    __syncthreads();
    if (nb0 > 0) { ATT_LOAD(nb0 - 1); ATT_STORE(nb0 - 1); }
    else { kx[0] = kx[1] = vx[0] = vx[1] = (u32x4){0u, 0u, 0u, 0u}; ATT_STORE(1); }
    ATT_LOAD(nb0); ATT_STORE(nb0);
    __syncthreads();
    for (int nb = nb0; nb < nb0 + 8; ++nb) {
        const bool more = nb + 1 < nb0 + 8;
        if (more) ATT_LOAD(nb + 1);
        const size_t qoff = (tok0 + (size_t)(nb * 128 + 16 * w + fr) * dl) * 512;
        const bf16x8 q0 = *(const bf16x8*)(Qg + qoff + fq * 8), q1 = *(const bf16x8*)(Qg + qoff + 32 + fq * 8);
        const int pslot = (nb - 1) & 1;
        f32x4 S[10];
#pragma unroll
        for (int kbi = 0; kbi < 10; ++kbi) {
            int kb = w + kbi; if (kb > 15) kb = 15;
            const int ki = kb * 16 + fr; const int phys = ((pslot + (ki >> 7)) & 1) * 128 + (ki & 127);
            const bf16x8 k0 = *(const LAS bf16x8*)(Kl + phys * AK_RS + fq * 16), k1 = *(const LAS bf16x8*)(Kl + phys * AK_RS + 64 + fq * 16);
            f32x4 a = (f32x4){0.f, 0.f, 0.f, 0.f};
            a = __builtin_amdgcn_mfma_f32_16x16x32_bf16(k0, q0, a, 0, 0, 0);
            S[kbi] = __builtin_amdgcn_mfma_f32_16x16x32_bf16(k1, q1, a, 0, 0, 0);
        }
        float mx = -INFINITY;
#pragma unroll
        for (int kbi = 0; kbi < 10; ++kbi)
#pragma unroll
            for (int j = 0; j < 4; ++j) { const int ki = (w + kbi) * 16 + 4 * fq + j; const int dist = 16 * w + fr + 128 - ki;
                const bool ok = dist >= 0 && dist <= 128 && (nb > 0 || ki >= 128) && (w + kbi) < 16;
                const float sc = ok ? S[kbi][j] - slope * (float)dist : -INFINITY; S[kbi][j] = sc; mx = fmaxf(mx, sc); }
        mx = fmaxf(mx, __shfl_xor(mx, 16)); mx = fmaxf(mx, __shfl_xor(mx, 32));
        float ls = 0.f;
#pragma unroll
        for (int kbi = 0; kbi < 10; ++kbi)
#pragma unroll
            for (int j = 0; j < 4; ++j) { const float p = __expf(S[kbi][j] - mx); S[kbi][j] = p; ls += p; }
        ls += __shfl_xor(ls, 16); ls += __shfl_xor(ls, 32);
        f32x4 O[4];
#pragma unroll
        for (int db = 0; db < 4; ++db) O[db] = (f32x4){0.f, 0.f, 0.f, 0.f};
#pragma unroll
        for (int k2 = 0; k2 < 5; ++k2) {
            u32x4 pw; pw.x = cvt_pk_bf16(S[2 * k2][0], S[2 * k2][1]); pw.y = cvt_pk_bf16(S[2 * k2][2], S[2 * k2][3]); pw.z = cvt_pk_bf16(S[2 * k2 + 1][0], S[2 * k2 + 1][1]); pw.w = cvt_pk_bf16(S[2 * k2 + 1][2], S[2 * k2 + 1][3]);
            const bf16x8 pf = __builtin_bit_cast(bf16x8, pw);
            int kb0 = w + 2 * k2, kb1 = kb0 + 1; if (kb1 > 15) kb1 = 15; if (kb0 > 15) kb0 = 15;
            const int r0 = kb0 * 16 + 4 * fq + (fr >> 2), r1 = kb1 * 16 + 4 * fq + (fr >> 2);
            const int p0 = ((pslot + (r0 >> 7)) & 1) * 128 + (r0 & 127), p1 = ((pslot + (r1 >> 7)) & 1) * 128 + (r1 & 127);
#pragma unroll
            for (int db = 0; db < 4; ++db) {
                const s16x4 v0 = lds_tr16(Vl + p0 * AV_RS + (db * 16 + 4 * (fr & 3)) * 2), v1 = lds_tr16(Vl + p1 * AV_RS + (db * 16 + 4 * (fr & 3)) * 2);
                const bf16x8 vf = (bf16x8){v0[0], v0[1], v0[2], v0[3], v1[0], v1[1], v1[2], v1[3]};
                O[db] = __builtin_amdgcn_mfma_f32_16x16x32_bf16(vf, pf, O[db], 0, 0, 0);
            }
        }
        const float inv = 1.0f / ls;
#pragma unroll
        for (int db = 0; db < 4; ++db) { u32x2 ow; ow.x = cvt_pk_bf16(O[db][0] * inv, O[db][1] * inv); ow.y = cvt_pk_bf16(O[db][2] * inv, O[db][3] * inv);
            *(u32x2*)(Qg + qoff + db * 16 + 4 * fq) = ow; }
        if (fq == 0) LSE[(qoff >> 9) * 8] = mx + __logf(ls);
        __syncthreads();
        if (more) ATT_STORE(nb + 1);
        __syncthreads();
    }
#undef ATT_LOAD
#undef ATT_STORE
}
__device__ __forceinline__ void attn_combine(const Ctx& F) {
    const float* LSE = (const float*)(F.ws + WS_LOGITS);
    for (int i = F.bid * NTHREADS + F.tid; i < T * 64; i += F.G * NTHREADS) {
        const int t = i >> 6, c8 = i & 63, slot = c8 >> 3;
        const float l0 = LSE[(size_t)t * 8 + slot], l1 = LSE[(size_t)T * 8 + (size_t)t * 8 + slot], l2 = LSE[(size_t)2 * T * 8 + (size_t)t * 8 + slot];
        const float m = fmaxf(l0, fmaxf(l1, l2)); float w0 = __expf(l0 - m), w1 = __expf(l1 - m), w2 = __expf(l2 - m); const float inv = 1.0f / (w0 + w1 + w2); w0 *= inv; w1 *= inv; w2 *= inv;
        u32x4* p0 = (u32x4*)(F.ws + WS_QA0) + i; const u32x4 a = *p0, bb = ((const u32x4*)(F.ws + WS_QA1))[i], cc = ((const u32x4*)(F.ws + WS_QA2))[i];
        f32x4 a0, a1, b0, b1, c0, c1; unpack8(a, a0, a1); unpack8(bb, b0, b1); unpack8(cc, c0, c1);
        *p0 = pack8(a0 * w0 + b0 * w1 + c0 * w2, a1 * w0 + b1 * w1 + c1 * w2);
    }
}

__device__ __forceinline__ void conv_item_v1(const Ctx& F, int layer, int item) {
    const int t0 = item * 32, s0 = t0 & (SEQ - 1), tid = F.tid;
    LAS bf16_t* sin = (LAS bf16_t*)F.lds;
    LAS float* sout = (LAS float*)(F.lds + 65536);
    const bf16_t* YG = (const bf16_t*)(F.ws + WS_YG);
    for (int i = tid; i < 62 * 64; i += NTHREADS) { const int r = i >> 6, c8 = i & 63; const int sp = s0 - 30 + r;
        u32x4 v = (u32x4){0u, 0u, 0u, 0u}; if (sp >= 0) v = *(const u32x4*)(YG + (size_t)(t0 - 30 + r) * 512 + c8 * 8);
        *(LAS u32x4*)(sin + r * 512 + c8 * 8) = v; }
    float w[31];
    const float* cw = F.in[I_CONVW] + (size_t)layer * 31 * 512 + tid;
#pragma unroll
    for (int k = 0; k < 31; ++k) w[k] = cw[k * 512];
    const float cb = F.in[I_CONVB][layer * 512 + tid];
    __syncthreads();
    for (int tt = 0; tt < 32; ++tt) { float a = cb;
#pragma unroll
        for (int k = 0; k < 31; ++k) a += w[k] * bf1(sin[(tt + k) * 512 + tid]);
        sout[tt * 512 + tid] = a; }
    __syncthreads();
    const float* lg = F.in[I_CLNG] + layer * 512 + F.lane * 8; const float* lb = F.in[I_CLNB] + layer * 512 + F.lane * 8;
    for (int tt = F.wave; tt < 32; tt += NWAVES) {
        float v[8]; float s = 0.f;
#pragma unroll
        for (int j = 0; j < 8; ++j) { v[j] = sout[tt * 512 + F.lane * 8 + j]; s += v[j]; }
        const float mu = wave_sum(s) * (1.0f / 512.0f); float q = 0.f;
#pragma unroll
        for (int j = 0; j < 8; ++j) { v[j] -= mu; q += v[j] * v[j]; }
        const float rstd = rsqrtf(wave_sum(q) * (1.0f / 512.0f) + EPS);
        float o[8];
#pragma unroll
        for (int j = 0; j < 8; ++j) o[j] = (ABL == 2) ? 0.f : siluf_(v[j] * rstd * lg[j] + lb[j]);
        u32x4 wv; wv.x = cvt_pk_bf16(o[0], o[1]); wv.y = cvt_pk_bf16(o[2], o[3]); wv.z = cvt_pk_bf16(o[4], o[5]); wv.w = cvt_pk_bf16(o[6], o[7]);
        *(u32x4*)((bf16_t*)(F.ws + WS_YC) + (size_t)(t0 + tt) * 512 + F.lane * 8) = wv;
    }
    __syncthreads();
}

__device__ __forceinline__ float log_sigmoid_(float v) { return fminf(v, 0.f) - log1pf(__expf(-fabsf(v))); }
__device__ __forceinline__ void qk_conv8(const Ctx& F, int layer, const bf16_t* src  , int t, int s, int ch  , int chq, float scale, float* o) {
    const float* cw = F.in[I_MCW] + (size_t)layer * 4 * 1024 + chq; const float* cb = F.in[I_MCB] + (size_t)layer * 1024 + chq;
#pragma unroll
    for (int j = 0; j < 8; ++j) o[j] = cb[j];
#pragma unroll
    for (int k = 0; k < 4; ++k) { if (s - 3 + k >= 0) { const u32x4 w = *(const u32x4*)(src + (size_t)(t - 3 + k) * 512 + ch); const float* wk = cw + k * 1024;
            o[0] += wk[0] * bf_lo(w.x); o[1] += wk[1] * bf_hi(w.x); o[2] += wk[2] * bf_lo(w.y); o[3] += wk[3] * bf_hi(w.y); o[4] += wk[4] * bf_lo(w.z); o[5] += wk[5] * bf_hi(w.z); o[6] += wk[6] * bf_lo(w.w); o[7] += wk[7] * bf_hi(w.w); } }
#pragma unroll
    for (int j = 0; j < 8; ++j) o[j] = siluf_(o[j]) * scale;
}
__device__ __forceinline__ void mlstm_scalars(const Ctx& F, int layer, int t0, int h, LAS float* sIG, LAS float* sBC) {
    if (F.tid < 128) { const float* IFp = (const float*)(F.ws + WS_IF) + (size_t)(t0 + F.tid) * 8;
        sIG[F.tid] = IFp[h] + F.in[I_MIB][layer * 4 + h]; sBC[F.tid] = log_sigmoid_(IFp[4 + h] + F.in[I_MFB][layer * 4 + h]); }
    __syncthreads();
    if (F.tid == 0) { float c = 0.f; for (int l = 0; l < 128; ++l) { c += sBC[l]; sBC[l] = c; } }
    __syncthreads();
}
__device__ __forceinline__ void mlstm_local_v1(const Ctx& F, int layer, int item) {
    const int c = item & 127, bh = item >> 7, h = bh & 3, b = bh >> 2, t0 = b * SEQ + c * 128, tid = F.tid;
    LAS float* EV = (LAS float*)F.lds;
    LAS float* KC = (LAS float*)(F.lds + 65536);
    LAS float* sIG = (LAS float*)(F.lds + 131072); LAS float* sBC = sIG + 128; LAS float* sE = sIG + 256; LAS float* sM = sIG + 384;
    mlstm_scalars(F, layer, t0, h, sIG, sBC);
    if (tid == 0) { const float gt = sBC[127]; float m = -INFINITY; for (int l = 0; l < 128; ++l) m = fmaxf(m, gt - sBC[l] + sIG[l]); sM[0] = m; sM[1] = gt; }
    __syncthreads();
    if (tid < 128) sE[tid] = __expf(sM[1] - sBC[tid] + sIG[tid] - sM[0]);
    __syncthreads();
    const bf16_t* KM = (const bf16_t*)(F.ws + WS_KM); const bf16_t* VM = (const bf16_t*)(F.ws + WS_VM);
    for (int i = tid; i < 128 * 16; i += NTHREADS) { const int l = i >> 4, c8 = (i & 15) * 8; const int t = t0 + l, s = t & (SEQ - 1);
        float o[8]; qk_conv8(F, layer, KM, t, s, h * 128 + c8, 512 + h * 128 + c8, 0.08838834764831845f, o);
#pragma unroll
        for (int j = 0; j < 8; ++j) KC[l * 128 + c8 + j] = o[j];
        const u32x4 w = *(const u32x4*)(VM + (size_t)t * 512 + h * 128 + c8); const float e = sE[l];
        EV[l * 128 + c8] = e * bf_lo(w.x); EV[l * 128 + c8 + 1] = e * bf_hi(w.x); EV[l * 128 + c8 + 2] = e * bf_lo(w.y); EV[l * 128 + c8 + 3] = e * bf_hi(w.y);
        EV[l * 128 + c8 + 4] = e * bf_lo(w.z); EV[l * 128 + c8 + 5] = e * bf_hi(w.z); EV[l * 128 + c8 + 6] = e * bf_lo(w.w); EV[l * 128 + c8 + 7] = e * bf_hi(w.w); }
    __syncthreads();
    { const int v = tid >> 2, kq = tid & 3; float a[32];
#pragma unroll
        for (int i = 0; i < 32; ++i) a[i] = 0.f;
#pragma unroll 1
        for (int l = 0; l < 128; ++l) { const float ev = EV[l * 128 + v];
#pragma unroll
            for (int i = 0; i < 32; ++i) a[i] += ev * KC[l * 128 + kq * 32 + i]; }
        bf16_t* Cp = (bf16_t*)(F.ws + WS_CST) + ((size_t)(bh * 128 + c) << 14) + v * 128 + kq * 32;
#pragma unroll
        for (int i = 0; i < 4; ++i) { u32x4 w; w.x = cvt_pk_bf16(a[8 * i], a[8 * i + 1]); w.y = cvt_pk_bf16(a[8 * i + 2], a[8 * i + 3]); w.z = cvt_pk_bf16(a[8 * i + 4], a[8 * i + 5]); w.w = cvt_pk_bf16(a[8 * i + 6], a[8 * i + 7]); ((u32x4*)Cp)[i] = w; } }
    if (tid < 128) { float n = 0.f; for (int l = 0; l < 128; ++l) n += sE[l] * KC[l * 128 + tid]; ((float*)(F.ws + WS_NST))[(size_t)(bh * 128 + c) * 128 + tid] = n; }
    if (tid == 0) { ((float*)(F.ws + WS_TAB + TAB_MLOC))[bh * 128 + c] = sM[0]; ((float*)(F.ws + WS_TAB + TAB_GTOT))[bh * 128 + c] = sM[1]; }
    __syncthreads();
}
__device__ __forceinline__ void phase_scan(const Ctx& F) {
    const float* GT = (const float*)(F.ws + WS_TAB + TAB_GTOT); const float* ML = (const float*)(F.ws + WS_TAB + TAB_MLOC); float* MS = (float*)(F.ws + WS_TAB + TAB_MST);
    for (int e = F.bid * NTHREADS + F.tid; e < 8 * 16384 + 8 * 128; e += F.G * NTHREADS) {
        const bool isC = e < 8 * 16384; const int bh = isC ? (e >> 14) : ((e - 8 * 16384) >> 7); const int idx = isC ? (e & 16383) : ((e - 8 * 16384) & 127);
        bf16_t* cp = (bf16_t*)(F.ws + WS_CST) + ((size_t)(bh * 128) << 14) + idx; float* np = (float*)(F.ws + WS_NST) + (size_t)(bh * 128) * 128 + idx;
        float mp = 0.f, val = 0.f;
        for (int c = 0; c < 128; ++c) {
            const float gc = GT[bh * 128 + c], ml = ML[bh * 128 + c]; const float mn = fmaxf(gc + mp, ml); const float a = __expf(gc + mp - mn), bb = __expf(ml - mn);
            if (isC) { bf16_t* p = cp + ((size_t)c << 14); const float loc = bf1(*p); *p = (bf16_t)f2bf(val); val = a * val + bb * loc; if (idx == 0) MS[bh * 128 + c] = mp; }
            else { float* p = np + (size_t)c * 128; const float loc = *p; *p = val; val = a * val + bb * loc; }
            mp = mn;
        }
    }
}
__device__ __forceinline__ void mlstm_out_v1(const Ctx& F, int layer, int item) {
    const int c = item & 127, bh = item >> 7, h = bh & 3, b = bh >> 2, t0 = b * SEQ + c * 128, tid = F.tid;
    constexpr int LS = 129;
    LAS float* bA = (LAS float*)F.lds;
    LAS float* bB = (LAS float*)(F.lds + 66560);
    LAS float* sIG = (LAS float*)(F.lds + 133120); LAS float* sBC = sIG + 128; LAS float* sMT = sIG + 256; LAS float* sSI = sIG + 384; LAS float* sNS = sIG + 512;
    mlstm_scalars(F, layer, t0, h, sIG, sBC);
    const float mst = ((const float*)(F.ws + WS_TAB + TAB_MST))[bh * 128 + c];
    if (tid == 0) { float pm = -INFINITY; for (int q = 0; q < 128; ++q) { pm = fmaxf(pm, sIG[q] - sBC[q]); const float ai = sBC[q] + mst; const float mt = fmaxf(ai, sBC[q] + pm); sMT[q] = mt; sSI[q] = __expf(ai - mt); } }
    if (tid < 128) sNS[tid] = ((const float*)(F.ws + WS_NST))[(size_t)(bh * 128 + c) * 128 + tid];
    const bf16_t* QM = (const bf16_t*)(F.ws + WS_QM); const bf16_t* KM = (const bf16_t*)(F.ws + WS_KM); const bf16_t* VM = (const bf16_t*)(F.ws + WS_VM);
    for (int i = tid; i < 128 * 16; i += NTHREADS) { const int l = i >> 4, c8 = (i & 15) * 8; const int t = t0 + l, s = t & (SEQ - 1); float o[8];
        qk_conv8(F, layer, QM, t, s, h * 128 + c8, h * 128 + c8, 1.0f, o);
#pragma unroll
        for (int j = 0; j < 8; ++j) bA[l * LS + c8 + j] = o[j];
        qk_conv8(F, layer, KM, t, s, h * 128 + c8, 512 + h * 128 + c8, 0.08838834764831845f, o);
#pragma unroll
        for (int j = 0; j < 8; ++j) bB[l * LS + c8 + j] = o[j]; }
    __syncthreads();
    const int q = tid >> 2, kq = tid & 3;
    float sc[32], inter[32];
#pragma unroll
    for (int i = 0; i < 32; ++i) sc[i] = 0.f;
#pragma unroll 1
    for (int d = 0; d < 128; ++d) { const float qv = bA[q * LS + d];
#pragma unroll
        for (int i = 0; i < 32; ++i) sc[i] += qv * bB[(4 * i + kq) * LS + d]; }
    float den = 0.f;
    { const float bq = sBC[q], mt = sMT[q];
#pragma unroll
        for (int i = 0; i < 32; ++i) { const int k = 4 * i + kq; const float w = (k <= q) ? __expf(bq - sBC[k] + sIG[k] - mt) : 0.f; sc[i] *= w; den += sc[i]; } }
    __syncthreads();
    { const bf16_t* Cp = (const bf16_t*)(F.ws + WS_CST) + ((size_t)(bh * 128 + c) << 14);
        for (int i = tid; i < 128 * 16; i += NTHREADS) { const int v = i >> 4, c8 = (i & 15) * 8; const u32x4 w = *(const u32x4*)(Cp + v * 128 + c8);
            bB[v * LS + c8] = bf_lo(w.x); bB[v * LS + c8 + 1] = bf_hi(w.x); bB[v * LS + c8 + 2] = bf_lo(w.y); bB[v * LS + c8 + 3] = bf_hi(w.y); bB[v * LS + c8 + 4] = bf_lo(w.z); bB[v * LS + c8 + 5] = bf_hi(w.z); bB[v * LS + c8 + 6] = bf_lo(w.w); bB[v * LS + c8 + 7] = bf_hi(w.w); } }
    __syncthreads();
#pragma unroll
    for (int i = 0; i < 32; ++i) inter[i] = 0.f;
    float dn = 0.f;
#pragma unroll 1
    for (int d = 0; d < 128; ++d) { const float qv = bA[q * LS + d];
#pragma unroll
        for (int i = 0; i < 32; ++i) inter[i] += qv * bB[(4 * i + kq) * LS + d];
        if ((d >> 5) == kq) dn += qv * sNS[d]; }
    __syncthreads();
#pragma unroll
    for (int i = 0; i < 32; ++i) bA[q * LS + 4 * i + kq] = sc[i];
    for (int i = tid; i < 128 * 16; i += NTHREADS) { const int l = i >> 4, c8 = (i & 15) * 8; const u32x4 w = *(const u32x4*)(VM + (size_t)(t0 + l) * 512 + h * 128 + c8);
        bB[l * LS + c8] = bf_lo(w.x); bB[l * LS + c8 + 1] = bf_hi(w.x); bB[l * LS + c8 + 2] = bf_lo(w.y); bB[l * LS + c8 + 3] = bf_hi(w.y); bB[l * LS + c8 + 4] = bf_lo(w.z); bB[l * LS + c8 + 5] = bf_hi(w.z); bB[l * LS + c8 + 6] = bf_lo(w.w); bB[l * LS + c8 + 7] = bf_hi(w.w); }
    __syncthreads();
    float num[32];
#pragma unroll
    for (int i = 0; i < 32; ++i) num[i] = 0.f;
#pragma unroll 1
    for (int k = 0; k < 128; ++k) { const float sv = bA[q * LS + k];
#pragma unroll
        for (int i = 0; i < 32; ++i) num[i] += sv * bB[k * LS + 4 * i + kq]; }
    den += __shfl_xor(den, 1); den += __shfl_xor(den, 2); dn += __shfl_xor(dn, 1); dn += __shfl_xor(dn, 2);
    const float si = sSI[q]; const float dd = den + si * dn; const float inv = (ABL == 3) ? 0.f : 1.0f / fmaxf(fabsf(dd), __expf(-sMT[q]));
    bf16_t* OM = (bf16_t*)(F.ws + WS_OM) + (size_t)(t0 + q) * 512 + h * 128;
#pragma unroll
    for (int i = 0; i < 32; ++i) { const int v = 4 * i + kq; const float hv = (num[i] + si * inter[i]) * inv; OM[v] = (bf16_t)f2bf(bf1(OM[v]) * hv); }
    __syncthreads();
}

__device__ __forceinline__ void phase_route(const Ctx& F, int layer) {
    int* tokl = (int*)(F.ws + WS_LISTS);
    for (int i = F.bid * NTHREADS + F.tid; i < 2 * LISTCAP; i += F.G * NTHREADS) tokl[i] = -1;
    LAS int* hist = (LAS int*)F.lds;
    const float* brg = F.in[I_BRG] + layer * 4; const float* bre = F.in[I_BRE] + layer * 32;
    for (int tile = F.bid; tile < 256; tile += F.G) {
        if (F.tid < 128) { const int t = tile * 128 + F.tid; const float* lg = (const float*)(F.ws + WS_LOGITS) + (size_t)t * 64;
            float g[4]; int gs = 0; float gm;
#pragma unroll
            for (int j = 0; j < 4; ++j) g[j] = lg[j] + brg[j];
            gm = g[0];
#pragma unroll
            for (int j = 1; j < 4; ++j) if (g[j] > gm) { gm = g[j]; gs = j; }
            float se = 0.f;
#pragma unroll
            for (int j = 0; j < 4; ++j) se += __expf(g[j] - gm);
            const float pg = 1.0f / se;
            float le[8];
#pragma unroll
            for (int j = 0; j < 8; ++j) le[j] = lg[4 + gs * 8 + j] + bre[gs * 8 + j];
            int i0 = 0; float v0 = le[0];
#pragma unroll
            for (int j = 1; j < 8; ++j) if (le[j] > v0) { v0 = le[j]; i0 = j; }
            int i1 = -1; float v1 = -INFINITY;
#pragma unroll
            for (int j = 0; j < 8; ++j) if (j != i0 && le[j] > v1) { v1 = le[j]; i1 = j; }
            const float e1 = __expf(v1 - v0); const float wsc = (ABL == 4) ? 0.f : ((ABL == 6) ? 2.f : 1.f); const float w0 = wsc * pg / (1.0f + e1), w1 = wsc * pg * e1 / (1.0f + e1);
            const int x0 = gs * 8 + i0, x1 = gs * 8 + i1;
            ((int*)(F.ws + WS_ROUTE))[2 * t] = x0; ((int*)(F.ws + WS_ROUTE))[2 * t + 1] = x1;
            ((float*)(F.ws + WS_ROUTE))[2 * T + 2 * t] = w0; ((float*)(F.ws + WS_ROUTE))[2 * T + 2 * t + 1] = w1;
            hist[F.tid] = x0; hist[128 + F.tid] = x1;
        }
        __syncthreads();
        if (F.tid < 64) { const int k = F.tid >> 5, e = F.tid & 31; int cnt = 0; for (int j = 0; j < 128; ++j) cnt += (hist[k * 128 + j] == e) ? 1 : 0; ((int*)(F.ws + WS_TAB + TAB_CNT))[tile * 64 + F.tid] = cnt; }
        __syncthreads();
    }
}
__device__ __forceinline__ void phase_dispatch(const Ctx& F) {
    LAS int* sTot = (LAS int*)F.lds; LAS int* sBef = sTot + 64; LAS int* sPs = sTot + 128; LAS int* sE = sTot + 256;
    const int* CNT = (const int*)(F.ws + WS_TAB + TAB_CNT); int* META = (int*)(F.ws + WS_TAB + TAB_META);
    int* tokl = (int*)(F.ws + WS_LISTS); float* wl = (float*)(F.ws + WS_LISTS) + 2 * LISTCAP;
    for (int tile = F.bid; tile < 256; tile += F.G) {
        if (F.tid < 64) { int tot = 0, bef = 0; for (int j = 0; j < 256; ++j) { const int v = CNT[j * 64 + F.tid]; tot += v; bef += (j < tile) ? v : 0; } sTot[F.tid] = tot; sBef[F.tid] = bef; }
        __syncthreads();
        if (F.tid < 2) { int ps = 0; for (int e = 0; e < 32; ++e) { sPs[F.tid * 33 + e] = ps; ps += ((sTot[F.tid * 32 + e] + 255) >> 8) << 8; } sPs[F.tid * 33 + 32] = ps;
            if (tile == 0) { META[F.tid] = ps >> 8; for (int e = 0; e <= 32; ++e) META[16 + 64 * F.tid + e] = sPs[F.tid * 33 + e]; } }
        int e0 = 0, e1 = 0; float w0 = 0.f, w1 = 0.f;
        if (F.tid < 128) { const int t = tile * 128 + F.tid; e0 = ((const int*)(F.ws + WS_ROUTE))[2 * t]; e1 = ((const int*)(F.ws + WS_ROUTE))[2 * t + 1];
            w0 = ((const float*)(F.ws + WS_ROUTE))[2 * T + 2 * t]; w1 = ((const float*)(F.ws + WS_ROUTE))[2 * T + 2 * t + 1]; sE[F.tid] = e0; sE[128 + F.tid] = e1; }
        __syncthreads();
        if (F.tid < 128) { int r0 = 0, r1 = 0; for (int j = 0; j < F.tid; ++j) { r0 += (sE[j] == e0) ? 1 : 0; r1 += (sE[128 + j] == e1) ? 1 : 0; }
            const int p0 = sPs[e0] + sBef[e0] + r0, p1 = sPs[33 + e1] + sBef[32 + e1] + r1;
            tokl[p0] = tile * 128 + F.tid; wl[p0] = w0; tokl[LISTCAP + p1] = tile * 128 + F.tid; wl[LISTCAP + p1] = w1; }
        __syncthreads();
    }
}
__device__ __forceinline__ void phase_final(const Ctx& F, const float* SS) {
    const int gw = F.bid * NWAVES + F.wave, NGW = F.G * NWAVES, lane = F.lane;
    for (int m = gw; m < T; m += NGW) { const float rs = row_rs(SS, m); f32x4* o = (f32x4*)(F.out + (size_t)m * D) + lane; const f32x4* g = (const f32x4*)F.in[I_GFIN] + lane;
#pragma unroll
        for (int j = 0; j < 4; ++j) o[64 * j] = o[64 * j] * rs * g[64 * j]; }
}

constexpr int PH_PER_LAYER = 15, PH_FINAL = DEPTH * PH_PER_LAYER, N_PHASES = PH_FINAL + 1;
struct Args { const float* in[28]; float* out; unsigned char* ws; int ph_lo, ph_hi; };

__device__ __forceinline__ Ctx mkctx(const Args& args, LAS unsigned char* lds, int wave_s) {
    Ctx F; asm volatile("" : "+s"(wave_s)); int tid = wave_s * 64 + lane_id_(); asm volatile("" : "+v"(tid));
    unsigned char* ws = args.ws; asm volatile("" : "+s"(ws)); float* outp = args.out; asm volatile("" : "+s"(outp));
    int bid = blockIdx.x; asm volatile("" : "+s"(bid)); int G = gridDim.x; asm volatile("" : "+s"(G));
    F.in = args.in; F.out = outp; F.ws = ws; F.lds = lds;
    F.tid = tid; F.lane = tid & 63; F.wave = wave_s; F.G = G; F.bid = bid;
    return F;
}
#ifndef ONLY_PHASE
#define ONLY_PHASE -1
#endif
__device__ __forceinline__ void run_phase(const Args& args, LAS unsigned char* lds, int ph, int wave_s) {
    const int layer = ph / PH_PER_LAYER, lp = ph - layer * PH_PER_LAYER;
    const size_t ssin = (layer & 1) ? WS_SS1 : WS_SS0, ssmid = (layer & 1) ? WS_SS0 : WS_SS1;
    if (ph == PH_FINAL) { const Ctx F = mkctx(args, lds, wave_s); phase_final(F, (const float*)(F.ws + WS_SS0)); return; }
    if (ONLY_PHASE >= 0 && lp != ONLY_PHASE) return;
    switch (lp) {
    case 0: { const Ctx F = mkctx(args, lds, wave_s); phase_prep(F, layer, (float*)(F.ws + ssin)); } break;
    case 1: { const Ctx F = mkctx(args, lds, wave_s); PhProj P{(const char*)F.ws + WS_XB, (const char*)F.ws + WS_WIN, (const float*)(F.ws + ssin), F.ws, F.G, F.bid}; pg8::gemm_phase(F.lds, P, F.tid); } break;
    case 2: { const Ctx F = mkctx(args, lds, wave_s);
        for (int it = F.bid; it < 768; it += F.G) attn_strip(F, it);
        __syncthreads();
        for (int it = F.bid; it < 1024; it += F.G) mlstm_local_v1(F, layer, it);
        for (int it = F.bid; it < 1024; it += F.G) conv_item_v1(F, layer, it);
    } break;
    case 3: { const Ctx F = mkctx(args, lds, wave_s); phase_scan(F); attn_combine(F); } break;
    case 4: { const Ctx F = mkctx(args, lds, wave_s); for (int it = F.bid; it < 1024; it += F.G) mlstm_out_v1(F, layer, it); } break;
    case 5: { const Ctx F = mkctx(args, lds, wave_s); PhGates P{(const char*)F.ws + WS_XB, (const char*)F.ws + WS_WIN, (const float*)(F.ws + ssin), F.ws, F.G, F.bid}; pg8::gemm_phase(F.lds, P, F.tid); } break;
    case 6: { const Ctx F = mkctx(args, lds, wave_s); PhMerge P{F.ws, F.G, F.bid}; pg8::gemm_phase(F.lds, P, F.tid); } break;
    case 7: { const Ctx F = mkctx(args, lds, wave_s); PhOut P{F.ws, F.out, (float*)(F.ws + ssmid), F.G, F.bid}; pg8::gemm_phase(F.lds, P, F.tid); } break;
    case 8: { const Ctx F = mkctx(args, lds, wave_s); PhRouter P{F.ws, (const float*)(F.ws + ssmid), F.G, F.bid}; pg8::gemm_phase(F.lds, P, F.tid); phase_prep_experts(F, layer); } break;
    case 9: { const Ctx F = mkctx(args, lds, wave_s); phase_route(F, layer); } break;
    case 10: { const Ctx F = mkctx(args, lds, wave_s); phase_dispatch(F); } break;
    case 11: { const Ctx F = mkctx(args, lds, wave_s); PhUp P{F.ws, (const float*)(F.ws + ssmid), (const int*)(F.ws + WS_TAB + TAB_META), (const int*)(F.ws + WS_LISTS), F.G, F.bid}; pg8::gemm_phase(F.lds, P, F.tid); } break;
    case 12: { const Ctx F = mkctx(args, lds, wave_s); PhDown<1> P{F.ws, F.out, (float*)(F.ws + ssin), (const int*)(F.ws + WS_TAB + TAB_META), (const int*)(F.ws + WS_LISTS), (const float*)(F.ws + WS_LISTS) + 2 * LISTCAP, F.G, F.bid}; pg8::gemm_phase(F.lds, P, F.tid); } break;
    case 13: { const Ctx F = mkctx(args, lds, wave_s); PhDown<0> P{F.ws, F.out, (float*)(F.ws + ssin), (const int*)(F.ws + WS_TAB + TAB_META), (const int*)(F.ws + WS_LISTS), (const float*)(F.ws + WS_LISTS) + 2 * LISTCAP, F.G, F.bid}; pg8::gemm_phase(F.lds, P, F.tid); } break;
    case 14: { const Ctx F = mkctx(args, lds, wave_s); PhPle P{F.ws, F.out, (const float*)(F.ws + ssin), (float*)(F.ws + ssmid), F.G, F.bid}; pg8::gemm_phase(F.lds, P, F.tid); } break;
    }
}

__global__ void __launch_bounds__(NTHREADS, 2) fwd_kernel(Args args) {
    extern __shared__ __attribute__((aligned(16))) unsigned char lds_raw[];
    LAS unsigned char* lds = (LAS unsigned char*)lds_raw;
    volatile LAS unsigned* MISC = (volatile LAS unsigned*)(lds + MISC_OFF);
    const int wave_s = __builtin_amdgcn_readfirstlane((int)threadIdx.x >> 6);
    if (wave_s == 0) MISC[lane_id_()] = 0u;
    __syncthreads();
#if MK_MEGA
    XcdBarrier bar = xcd_barrier_post((unsigned*)(args.ws + WS_CTL) + 4096, MISC + 8, wave_s);
#endif
    for (int ph = args.ph_lo; ph < args.ph_hi; ++ph) {
        run_phase(args, lds, ph, wave_s);
#if MK_MEGA
        if (ph + 1 < args.ph_hi) xcd_barrier(bar);
#endif
    }
}

extern "C" void kernel_launch(void* const* d_in, const int* in_sizes, int n_in, void* d_out, int out_size, void* d_ws, size_t ws_size, hipStream_t stream) {
    static int grid = 0;
    if (grid == 0) {
        if (n_in != 28 || out_size != T * D || ws_size < WS_END) { fprintf(stderr, "kernel_launch: unexpected shapes (n_in %d out %d ws %zu, need %zu)\n", n_in, out_size, ws_size, (size_t)WS_END); grid = -1; return; }
        int dev = 0, cus = 0, per_cu = 0;
        if (hipGetDevice(&dev) != hipSuccess || hipDeviceGetAttribute(&cus, hipDeviceAttributeMultiprocessorCount, dev) != hipSuccess) { grid = -1; return; }
        if (hipFuncSetAttribute((const void*)fwd_kernel, hipFuncAttributeMaxDynamicSharedMemorySize, LDS_BYTES) != hipSuccess) { fprintf(stderr, "kernel_launch: hipFuncSetAttribute failed\n"); grid = -1; return; }
        if (hipOccupancyMaxActiveBlocksPerMultiprocessor(&per_cu, (const void*)fwd_kernel, NTHREADS, LDS_BYTES) != hipSuccess || per_cu < 1) { fprintf(stderr, "kernel_launch: occupancy query says %d blocks per CU\n", per_cu); }
        (void)hipGetLastError();
        grid = cus;
    }
    if (grid < 0) return;
    Args a{};
    for (int i = 0; i < 28; ++i) a.in[i] = (const float*)d_in[i];
    a.out = (float*)d_out; a.ws = (unsigned char*)d_ws;
#if MK_MEGA
    (void)hipMemsetAsync((char*)d_ws + WS_CTL, 0, CTL_ZERO_BYTES, stream);
    a.ph_lo = 0; a.ph_hi = N_PHASES;
    hipLaunchKernelGGL(fwd_kernel, dim3(grid), dim3(NTHREADS), LDS_BYTES, stream, a);
#else
    for (int ph = 0; ph < N_PHASES; ++ph) { a.ph_lo = ph; a.ph_hi = ph + 1; hipLaunchKernelGGL(fwd_kernel, dim3(grid), dim3(NTHREADS), LDS_BYTES, stream, a); }
#endif
}
```

```cpp
#include <hip/hip_runtime.h>
#include <cstdio>
#include <cstdint>

#ifndef MK_MEGA
#define MK_MEGA 1
#endif

#ifndef ABL
#define ABL 0
#endif
#define LAS __attribute__((address_space(3)))
#define GAS __attribute__((address_space(1)))
typedef unsigned short bf16_t;
typedef short bf16x8 __attribute__((ext_vector_type(8)));
typedef float f32x4 __attribute__((ext_vector_type(4)));
typedef float f32x2 __attribute__((ext_vector_type(2)));
typedef unsigned u32x4 __attribute__((ext_vector_type(4)));
typedef unsigned u32x2 __attribute__((ext_vector_type(2)));

constexpr int T = 32768, SEQ = 16384, D = 1024, DEPTH = 2;
constexpr int D_IN = 8712;
constexpr float EPS = 1e-6f;
constexpr int NTHREADS = 512, NWAVES = 8;
constexpr int LISTCAP = 40960;

constexpr size_t MiB = 1u << 20;
constexpr size_t WS_CTL = 0, CTL_ZERO_BYTES = 1 * MiB;
constexpr size_t WS_TAB = 1 * MiB;
constexpr size_t WS_ROUTE = 2 * MiB;
constexpr size_t WS_LISTS = 3 * MiB;
constexpr size_t WS_SS0 = 4 * MiB, WS_SS1 = 6 * MiB;
constexpr size_t WS_IF = 8 * MiB;
constexpr size_t WS_NST = 9 * MiB;
constexpr size_t WS_LOGITS = 10 * MiB;
constexpr size_t WS_WIN = 18 * MiB;
constexpr size_t WS_WBR = WS_WIN + 8960ull * 1024 * 2;
constexpr size_t WS_WOUT = WS_WBR + 3ull * 1024 * 512 * 2;
constexpr size_t WS_WPG = WS_WOUT + 1024ull * 1024 * 2;
constexpr size_t WS_WPP = WS_WPG + 1024ull * 1024 * 2;
constexpr size_t WS_WR = WS_WPP + 1024ull * 256 * 2;
static_assert(WS_WR + 256ull * 1024 * 2 <= 44 * MiB, "small weights");
constexpr size_t WS_XB = 44 * MiB;
constexpr size_t WS_QA0 = 108 * MiB;
constexpr size_t WS_YATT = WS_QA0;
constexpr size_t WS_OM = 140 * MiB;
constexpr size_t WS_YC = 172 * MiB;
constexpr size_t WS_CST = 204 * MiB;
constexpr size_t WS_B = 236 * MiB;
constexpr size_t WS_KA = WS_B, WS_QA1 = WS_B + 32 * MiB, WS_QA2 = WS_B + 64 * MiB, WS_VA = WS_B + 96 * MiB, WS_YG = WS_B + 128 * MiB, WS_QM = WS_B + 160 * MiB, WS_KM = WS_B + 192 * MiB, WS_VM = WS_B + 224 * MiB;
constexpr size_t WS_G0 = WS_B, WS_MERGED = WS_B + 192 * MiB;
constexpr size_t WS_WEXP = WS_B, WS_HB = WS_B + 48 * MiB, WS_PBF = WS_B + 88 * MiB, WS_PE = WS_B + 104 * MiB, WS_YB1 = WS_B + 168 * MiB, WS_XBT = WS_B;
constexpr size_t WS_END = 492 * MiB;
constexpr size_t TAB_CNT = 0;
constexpr size_t TAB_META = 65536;
constexpr size_t TAB_MLOC = 131072, TAB_GTOT = 131072 + 4096, TAB_MST = 131072 + 8192;

constexpr int RING_BYTES = 131072;
constexpr int MISC_OFF = 155648;
constexpr int LDS_BYTES = 156672;

__device__ __forceinline__ unsigned f2bf(float f) { unsigned u = __builtin_bit_cast(unsigned, f); return (u + 0x7fffu + ((u >> 16) & 1u)) >> 16; }
__device__ __forceinline__ unsigned pk2(float lo, float hi) { return f2bf(lo) | (f2bf(hi) << 16); }
__device__ __forceinline__ unsigned cvt_pk_bf16(float lo, float hi) { unsigned r; asm volatile("v_cvt_pk_bf16_f32 %0, %1, %2" : "=v"(r) : "v"(lo), "v"(hi)); return r; }
__device__ __forceinline__ float bf_lo(unsigned w) { return __builtin_bit_cast(float, w << 16); }
__device__ __forceinline__ float bf_hi(unsigned w) { return __builtin_bit_cast(float, w & 0xffff0000u); }
__device__ __forceinline__ float bf1(bf16_t h) { return __builtin_bit_cast(float, ((unsigned)h) << 16); }
__device__ __forceinline__ float sigmoidf_(float v) { return 1.0f / (1.0f + __expf(-v)); }
__device__ __forceinline__ float siluf_(float v) { return v / (1.0f + __expf(-v)); }
__device__ __forceinline__ float wave_sum(float v) {
#pragma unroll
    for (int o = 1; o < 64; o <<= 1) v += __shfl_xor(v, o);
    return v;
}
__device__ __forceinline__ float wave_max(float v) {
#pragma unroll
    for (int o = 1; o < 64; o <<= 1) v = fmaxf(v, __shfl_xor(v, o));
    return v;
}
__device__ __forceinline__ int lane_id_() { int l; asm volatile("v_mbcnt_lo_u32_b32 %0, -1, 0\n\tv_mbcnt_hi_u32_b32 %0, -1, %0" : "=&v"(l)); return l; }
#define LDS_WAIT() asm volatile("s_waitcnt lgkmcnt(0)" ::: "memory")
#define VM_WAIT() asm volatile("s_waitcnt vmcnt(0)" ::: "memory")

#define XB_TMO      128
#define XB_XCNT(j)  (256  + 64 * (j))
#define XB_XSUB(j)  (1280 + 64 * (j))
#define XB_XGEN(j)  (2304 + 64 * (j))
#define XB_TOP      3328
#define XB_TOPGEN   3392
#define XCD_BAR_WORDS 3456
#define XB_SPIN_CAP (1u << 22)
__device__ __forceinline__ unsigned xb_ld(unsigned* p)              { return __hip_atomic_load(p, __ATOMIC_RELAXED, __HIP_MEMORY_SCOPE_AGENT); }
__device__ __forceinline__ unsigned xb_add(unsigned* p, unsigned v) { return __hip_atomic_fetch_add(p, v, __ATOMIC_RELAXED, __HIP_MEMORY_SCOPE_AGENT); }
__device__ __forceinline__ unsigned xb_xcc_id() { return (unsigned)__builtin_amdgcn_s_getreg((3 << 11) | 20) & 0xFu; }
#define XB_SPIN(cond, bar) do { unsigned _sp = 0; while (cond) { __builtin_amdgcn_s_sleep(1); \
    if ((++_sp & 255u) == 0u) { if (xb_ld(&(bar)[XB_TMO])) break; if (_sp > XB_SPIN_CAP) { atomicAdd(&(bar)[XB_TMO], 1u); break; } } } } while (0)
struct XcdBarrier { unsigned* bar; unsigned x; volatile LAS unsigned* st; int wave; };
__device__ __forceinline__ XcdBarrier xcd_barrier_post(unsigned* bar, volatile LAS unsigned* st, int wave) {
    XcdBarrier b; b.bar = bar; b.x = xb_xcc_id(); b.st = st; b.wave = wave;
    if (wave == 0 && lane_id_() == 0) (void)xb_add(&bar[XB_XCNT(b.x)], 1u);
    return b;
}
__device__ __forceinline__ void xcd_barrier_complete(unsigned* bar, unsigned x, unsigned& nloc, unsigned& nx) {
    const unsigned G = gridDim.x * gridDim.y * gridDim.z;
    unsigned sum, cnt, mine, sp = 0u;
    for (;;) {
        sum = 0u; cnt = 0u; mine = 0u;
#pragma unroll
        for (unsigned j = 0; j < 16; ++j) { const unsigned c = xb_ld(&bar[XB_XCNT(j)]); sum += c; cnt += (c > 0u) ? 1u : 0u; mine = (j == x) ? c : mine; }
        if (sum == G) break;
        __builtin_amdgcn_s_sleep(1);
        if ((++sp & 255u) == 0u) { if (xb_ld(&bar[XB_TMO])) break; if (sp > XB_SPIN_CAP) { atomicAdd(&bar[XB_TMO], 1u); break; } }
    }
    nloc = mine > 0u ? mine : 1u; nx = cnt > 0u ? cnt : 1u;
}
__device__ __forceinline__ void xcd_barrier(const XcdBarrier& b) {
    asm volatile("s_waitcnt vmcnt(0)" ::: "memory");
    __syncthreads();
    if (b.wave == 0 && lane_id_() == 0) {
        unsigned* bar = b.bar;
        __builtin_amdgcn_s_waitcnt(0);
        unsigned nloc = b.st[0], nx = b.st[1];
        if (nloc == 0u) { xcd_barrier_complete(bar, b.x, nloc, nx); b.st[0] = nloc; b.st[1] = nx; }
        const unsigned old = xb_add(&bar[XB_XSUB(b.x)], 1u);
        const unsigned gen = old / nloc;
        if (old + 1u == (gen + 1u) * nloc) {
            __builtin_amdgcn_fence(__ATOMIC_RELEASE, "agent");
            asm volatile("s_waitcnt vmcnt(0)" ::: "memory");
            const unsigned og = xb_add(&bar[XB_TOP], 1u);
            const unsigned tg = og / nx;
            if (og + 1u == (tg + 1u) * nx) xb_add(&bar[XB_TOPGEN], 1u);
            else XB_SPIN(xb_ld(&bar[XB_TOPGEN]) == tg, bar);
            __builtin_amdgcn_fence(__ATOMIC_ACQUIRE, "agent");
            xb_add(&bar[XB_XGEN(b.x)], 1u);
            asm volatile("s_waitcnt vmcnt(0)" ::: "memory");
        } else {
            XB_SPIN(xb_ld(&bar[XB_XGEN(b.x)]) == gen, bar);
            __builtin_amdgcn_fence(__ATOMIC_ACQUIRE, "agent");
            asm volatile("s_waitcnt vmcnt(0)" ::: "memory");
        }
    }
    __syncthreads();
}

namespace pg8 {
constexpr int BM = 256, BK = 64, HALF = 128, HTB = HALF * BK * 2, NXCD = 8, WGM = 8;
__device__ __forceinline__ int lds_byte(int r, int c) { const int st = (r >> 4) * 2 + (c >> 5), rr = r & 15, cc = c & 31, ob = rr * 64 + cc * 2; return st * 1024 + (ob ^ (((ob >> 9) & 1) << 5)); }
__device__ __forceinline__ void stage_rc(int b, int& R, int& C) { const int st = b / 1024, sb = b % 1024, swz = sb ^ (((sb >> 9) & 1) << 5); R = (st >> 1) * 16 + swz / 64; C = (st & 1) * 32 + (swz % 64) / 2; }
__device__ __forceinline__ int perm32(int rho) { const int n = rho >> 4, i = rho & 15; return 8 * (i >> 2) + 4 * n + (i & 3); }

struct GUnit { const char* A; const char* B; int pm, pn, a0, a1; };

__device__ __forceinline__ void tile_order(int L, int nM, int nN, int& pm, int& pn) {
    const int nwg = nM * nN; int wgid = L;
    { const int q = nwg / NXCD, r = nwg % NXCD, xcd = wgid % NXCD, off = wgid / NXCD; wgid = (xcd < r ? xcd * (q + 1) : r * (q + 1) + (xcd - r) * q) + off; }
    const int nig = WGM * nN, gid = wgid / nig, fm = gid * WGM, gsz = (nM - fm) < WGM ? (nM - fm) : WGM;
    pm = fm + ((wgid % nig) % gsz); pn = (wgid % nig) / gsz;
}

typedef f32x4 Acc[2][2][4][2];

template <class P>
__device__ __forceinline__ void gemm_phase(LAS unsigned char* lds, const P& S, int tid) {
    asm volatile("" : "+v"(tid));
    const int wid = __builtin_amdgcn_readfirstlane(tid >> 6), lane = tid & 63, wr = wid >> 2, wc = wid & 3, fr = lane & 15, fq = lane >> 4;
    constexpr int K = P::K, nt = K / BK;
    static_assert(nt >= 4 && (nt % 2) == 0, "K multiple of 128, >= 256");
    unsigned voffB[2];
#pragma unroll
    for (int i = 0; i < 2; ++i) { int R, C; stage_rc(tid * 16 + i * 8192, R, C); const int Rb = (R & ~31) + perm32(R & 31); voffB[i] = (unsigned)(Rb * K + C) * 2u; }
    constexpr size_t kstep = (size_t)(BK * 2);
    constexpr size_t hstepB = (size_t)HALF * K * 2;
    const unsigned ldsw = (unsigned)wid * 1024u;
    const int aoff = lds_byte(wr * 64 + fr, fq * 8), boff = lds_byte(wc * 32 + fr, fq * 8);
#define PG8_SA(b, h) (((b) * 2 + (h)) * HTB)
#define PG8_SB(b, h) ((4 + (b) * 2 + (h)) * HTB)
#define PG8_STAGE(bufoff, gbase, voff) do { _Pragma("unroll") for (int _i = 0; _i < 2; ++_i) \
        __builtin_amdgcn_global_load_lds((const unsigned*)((const char*)(gbase) + (voff)[_i]), (LAS unsigned*)(lds + (bufoff) + ldsw + _i * 8192), 16, 0, 0); } while (0)
#define PG8_LDA(dst, b, h) do { _Pragma("unroll") for (int m = 0; m < 4; ++m) _Pragma("unroll") for (int k = 0; k < 2; ++k) dst[m][k] = *(const LAS bf16x8*)(lds + PG8_SA(b, h) + aoff + m * 2048 + k * 1024); } while (0)
#define PG8_LDB(dst, b, h) do { _Pragma("unroll") for (int n = 0; n < 2; ++n) _Pragma("unroll") for (int k = 0; k < 2; ++k) dst[n][k] = *(const LAS bf16x8*)(lds + PG8_SB(b, h) + boff + n * 2048 + k * 1024); } while (0)
#define PG8_MMA(ai, bj, At, Bt) do { __builtin_amdgcn_s_setprio(1); _Pragma("unroll") for (int m = 0; m < 4; ++m) _Pragma("unroll") for (int n = 0; n < 2; ++n) _Pragma("unroll") for (int k = 0; k < 2; ++k) \
        acc[ai][bj][m][n] = __builtin_amdgcn_mfma_f32_16x16x32_bf16(Bt[n][k], At[m][k], acc[ai][bj][m][n], 0, 0, 0); __builtin_amdgcn_s_setprio(0); } while (0)
#define PG8_WAIT_V(n) asm volatile("s_waitcnt vmcnt(" #n ")" ::: "memory")
#define PG8_WAIT_L(n) asm volatile("s_waitcnt lgkmcnt(" #n ")" ::: "memory")
#define PG8_BAR __builtin_amdgcn_s_barrier()
#define PG8_SCHED __builtin_amdgcn_sched_barrier(0)
#define PG8_VOA(dst, u) do { _Pragma("unroll") for (int _h = 0; _h < 2; ++_h) _Pragma("unroll") for (int _i = 0; _i < 2; ++_i) { int _R, _C; stage_rc(tid * 16 + _i * 8192, _R, _C); \
        if constexpr (P::GATHER) dst[_h][_i] = (S.arow(u, _h * HALF + _R) * (unsigned)K + (unsigned)_C) * 2u; \
        else dst[_h][_i] = (unsigned)((_h * HALF + _R) * K + _C) * 2u; } } while (0)
    GUnit cur, nxt; int ui = 0;
    if (!S.next(0, cur)) return;
    Acc acc;
#pragma unroll
    for (int a = 0; a < 2; ++a)
#pragma unroll
        for (int b = 0; b < 2; ++b)
#pragma unroll
            for (int m = 0; m < 4; ++m)
#pragma unroll
                for (int n = 0; n < 2; ++n) acc[a][b][m][n] = (f32x4){0.f, 0.f, 0.f, 0.f};
    bf16x8 At[4][2], B0[2][2], B1[2][2];
    unsigned voA[2][2], voAn[2][2];
    PG8_VOA(voA, cur);
    const char* cA = cur.A; const char* cB = cur.B;
    PG8_STAGE(PG8_SB(0, 0), cB, voffB); PG8_STAGE(PG8_SB(0, 1), cB + hstepB, voffB); PG8_STAGE(PG8_SA(0, 0), cA, voA[0]); PG8_STAGE(PG8_SA(0, 1), cA, voA[1]);
    if (wr == 1) PG8_BAR;
    PG8_WAIT_V(2); PG8_BAR;
    PG8_STAGE(PG8_SB(1, 0), cB + kstep, voffB); PG8_STAGE(PG8_SA(1, 0), cA + kstep, voA[0]); PG8_STAGE(PG8_SB(1, 1), cB + hstepB + kstep, voffB);
    PG8_WAIT_V(6); PG8_BAR;
    for (;;) {
        const bool has_next = S.next(ui + 1, nxt);
        const char* nA = has_next ? nxt.A : cA; const char* nB = has_next ? nxt.B : cB;
        if constexpr (P::GATHER) {
            if (has_next) { PG8_VOA(voAn, nxt); }
            else {
#pragma unroll
                for (int h = 0; h < 2; ++h)
#pragma unroll
                    for (int i = 0; i < 2; ++i) voAn[h][i] = voA[h][i];
            }
        }
#pragma unroll 1
        for (int t = 0; t < nt; t += 2) {
            const bool last = (t == nt - 2);
            const char* a1 = cA + (size_t)(t + 1) * kstep;
            const char* a2 = last ? nA : cA + (size_t)(t + 2) * kstep; const char* b2 = last ? nB : cB + (size_t)(t + 2) * kstep;
            const char* a3 = a2 + kstep; const char* b3 = b2 + kstep;
            unsigned s0[2], s1[2];
#pragma unroll
            for (int i = 0; i < 2; ++i) {
                if constexpr (P::GATHER) { s0[i] = last ? voAn[0][i] : voA[0][i]; s1[i] = last ? voAn[1][i] : voA[1][i]; }
                else { s0[i] = voA[0][i]; s1[i] = voA[1][i]; }
            }
            PG8_LDB(B0, 0, 0); PG8_LDB(B1, 0, 1); PG8_SCHED; PG8_LDA(At, 0, 0); PG8_STAGE(PG8_SA(1, 1), a1, voA[1]);
            PG8_WAIT_V(8); PG8_WAIT_L(0); PG8_BAR; PG8_MMA(0, 0, At, B0); PG8_MMA(0, 1, At, B1); PG8_BAR; PG8_SCHED;
            PG8_LDA(At, 0, 1); PG8_STAGE(PG8_SB(0, 0), b2, voffB); PG8_STAGE(PG8_SB(0, 1), b2 + hstepB, voffB); PG8_STAGE(PG8_SA(0, 0), a2, s0);
            PG8_WAIT_V(8); PG8_WAIT_L(0); PG8_BAR; PG8_MMA(1, 0, At, B0); PG8_MMA(1, 1, At, B1); PG8_BAR; PG8_SCHED;
            PG8_LDB(B0, 1, 0); PG8_LDB(B1, 1, 1); PG8_SCHED; PG8_LDA(At, 1, 0); PG8_STAGE(PG8_SA(0, 1), a2, s1);
            PG8_WAIT_V(8); PG8_WAIT_L(0); PG8_BAR; PG8_MMA(0, 0, At, B0); PG8_MMA(0, 1, At, B1); PG8_BAR; PG8_SCHED;
            PG8_LDA(At, 1, 1); PG8_STAGE(PG8_SB(1, 0), b3, voffB); PG8_STAGE(PG8_SB(1, 1), b3 + hstepB, voffB); PG8_STAGE(PG8_SA(1, 0), a3, s0);
            PG8_WAIT_V(8); PG8_WAIT_L(0); PG8_BAR; PG8_MMA(1, 0, At, B0); PG8_MMA(1, 1, At, B1); PG8_BAR; PG8_SCHED;
        }
        if (wr == 0) PG8_BAR;
        const bool zero = S.epi(acc, cur, wr, wc, fr, fq);
        if (!has_next) break;
        if (zero) {
#pragma unroll
            for (int a = 0; a < 2; ++a)
#pragma unroll
                for (int b = 0; b < 2; ++b)
#pragma unroll
                    for (int m = 0; m < 4; ++m)
#pragma unroll
                        for (int n = 0; n < 2; ++n) acc[a][b][m][n] = (f32x4){0.f, 0.f, 0.f, 0.f};
        }
        cur = nxt; cA = nA; cB = nB; ++ui;
        if constexpr (P::GATHER) {
#pragma unroll
            for (int h = 0; h < 2; ++h)
#pragma unroll
                for (int i = 0; i < 2; ++i) voA[h][i] = voAn[h][i];
        }
        if (wr == 1) PG8_BAR;
    }
    PG8_WAIT_V(0);
    PG8_BAR;
#undef PG8_SA
#undef PG8_SB
#undef PG8_STAGE
#undef PG8_LDA
#undef PG8_LDB
#undef PG8_MMA
#undef PG8_WAIT_V
#undef PG8_WAIT_L
#undef PG8_BAR
#undef PG8_SCHED
#undef PG8_VOA
}
}
using pg8::GUnit; using pg8::Acc;

__device__ __forceinline__ float row_rs(const float* SS, int row) {
    const f32x4* p = (const f32x4*)(SS + (size_t)row * 16);
    const f32x4 a = p[0], b = p[1], c = p[2], d = p[3];
    const float s = (((a.x + a.y) + (a.z + a.w)) + ((b.x + b.y) + (b.z + b.w))) + (((c.x + c.y) + (c.z + c.w)) + ((d.x + d.y) + (d.z + d.w)));
    return rsqrtf(s * (1.0f / 1024.0f) + EPS);
}
__device__ __forceinline__ u32x4 pack8(const f32x4 v0, const f32x4 v1) { u32x4 w; w.x = cvt_pk_bf16(v0[0], v0[1]); w.y = cvt_pk_bf16(v0[2], v0[3]); w.z = cvt_pk_bf16(v1[0], v1[1]); w.w = cvt_pk_bf16(v1[2], v1[3]); return w; }
__device__ __forceinline__ void unpack8(const u32x4 w, f32x4& v0, f32x4& v1) { v0 = (f32x4){bf_lo(w.x), bf_hi(w.x), bf_lo(w.y), bf_hi(w.y)}; v1 = (f32x4){bf_lo(w.z), bf_hi(w.z), bf_lo(w.w), bf_hi(w.w)}; }
__device__ __forceinline__ f32x4 sig4(const f32x4 v) { return (f32x4){sigmoidf_(v[0]), sigmoidf_(v[1]), sigmoidf_(v[2]), sigmoidf_(v[3])}; }
__device__ __forceinline__ f32x4 gate4(const f32x4 v) { f32x4 s = sig4(v); return (f32x4){fmaxf(s[0], 1e-6f), fmaxf(s[1], 1e-6f), fmaxf(s[2], 1e-6f), fmaxf(s[3], 1e-6f)}; }

struct PhProj {
    static constexpr int K = 1024; static constexpr bool GATHER = false;
    const char* xb; const char* W; const float* SS; unsigned char* ws; int G, c;
    __device__ __forceinline__ bool next(int i, GUnit& u) const {
        const long L = (long)i * G + c; if (L >= 128 * 23) return false;
        pg8::tile_order((int)L, 128, 23, u.pm, u.pn);
        u.A = xb + (size_t)u.pm * 256 * K * 2; u.B = W + (size_t)u.pn * 256 * K * 2; u.a0 = 0; u.a1 = 0; return true;
    }
    __device__ __forceinline__ unsigned arow(const GUnit&, int) const { return 0u; }
    __device__ __forceinline__ bool epi(Acc& acc, const GUnit& u, int wr, int wc, int fr, int fq) const {
        const int pn = u.pn; const int row0 = u.pm * 256 + wr * 64 + fr;
        if (pn == 22) {
            if (wc == 0 && fq == 0) {
                float* IFp = (float*)(ws + WS_IF);
#pragma unroll
                for (int ai = 0; ai < 2; ++ai)
#pragma unroll
                    for (int m = 0; m < 4; ++m) { const int row = row0 + ai * 128 + m * 16; const float rs = row_rs(SS, row);
                        *(f32x4*)(IFp + (size_t)row * 8) = acc[ai][0][m][0] * rs; *(f32x4*)(IFp + (size_t)row * 8 + 4) = acc[ai][0][m][1] * rs; }
            }
            return true;
        }
        if (pn >= 10 && pn < 14) {
            bf16_t* Y = (bf16_t*)(ws + WS_YG);
#pragma unroll
            for (int ai = 0; ai < 2; ++ai)
#pragma unroll
                for (int m = 0; m < 4; ++m) { const int row = row0 + ai * 128 + m * 16; const float rs = row_rs(SS, row);
#pragma unroll
                    for (int bj = 0; bj < 2; ++bj) { const f32x4 a = acc[ai][bj][m][0] * rs, g = sig4(acc[ai][bj][m][1] * rs), y = a * g;
                        u32x2 w; w.x = cvt_pk_bf16(y[0], y[1]); w.y = cvt_pk_bf16(y[2], y[3]);
                        *(u32x2*)(Y + (size_t)row * 512 + (pn - 10) * 128 + bj * 64 + wc * 16 + fq * 4) = w; } }
            return true;
        }
        bf16_t* dst; int col0; bool sg = false;
        if (pn < 6) { dst = (bf16_t*)(ws + (pn < 2 ? WS_QA0 : (pn < 4 ? WS_QA1 : WS_QA2))); col0 = (pn & 1) * 256; }
        else if (pn < 8) { dst = (bf16_t*)(ws + WS_KA); col0 = (pn - 6) * 256; }
        else if (pn < 10) { dst = (bf16_t*)(ws + WS_VA); col0 = (pn - 8) * 256; }
        else if (pn < 16) { dst = (bf16_t*)(ws + WS_QM); col0 = (pn - 14) * 256; }
        else if (pn < 18) { dst = (bf16_t*)(ws + WS_KM); col0 = (pn - 16) * 256; }
        else if (pn < 20) { dst = (bf16_t*)(ws + WS_VM); col0 = (pn - 18) * 256; }
        else { dst = (bf16_t*)(ws + WS_OM); col0 = (pn - 20) * 256; sg = true; }
        col0 += wc * 32 + fq * 8;
#pragma unroll
        for (int ai = 0; ai < 2; ++ai)
#pragma unroll
            for (int m = 0; m < 4; ++m) { const int row = row0 + ai * 128 + m * 16; const float rs = row_rs(SS, row);
#pragma unroll
                for (int bj = 0; bj < 2; ++bj) { f32x4 v0 = acc[ai][bj][m][0] * rs, v1 = acc[ai][bj][m][1] * rs;
                    if (sg) { v0 = sig4(v0); v1 = sig4(v1); }
                    *(u32x4*)(dst + (size_t)row * 512 + col0 + bj * 128) = pack8(v0, v1); } }
        return true;
    }
};
struct PhGates {
    static constexpr int K = 1024; static constexpr bool GATHER = false;
    const char* xb; const char* W; const float* SS; unsigned char* ws; int G, c;
    __device__ __forceinline__ bool next(int i, GUnit& u) const {
        const long L = (long)i * G + c; if (L >= 128 * 12) return false;
        pg8::tile_order((int)L, 128, 12, u.pm, u.pn);
        u.A = xb + (size_t)u.pm * 256 * K * 2; u.B = W + (size_t)(5888 + u.pn * 256) * K * 2; u.a0 = 0; u.a1 = 0; return true;
    }
    __device__ __forceinline__ unsigned arow(const GUnit&, int) const { return 0u; }
    __device__ __forceinline__ bool epi(Acc& acc, const GUnit& u, int wr, int wc, int fr, int fq) const {
        const int row0 = u.pm * 256 + wr * 64 + fr;
        bf16_t* dst = (bf16_t*)(ws + WS_G0 + (size_t)(u.pn >> 2) * 64 * MiB); const int col0 = (u.pn & 3) * 256 + wc * 32 + fq * 8;
#pragma unroll
        for (int ai = 0; ai < 2; ++ai)
#pragma unroll
            for (int m = 0; m < 4; ++m) { const int row = row0 + ai * 128 + m * 16; const float rs = row_rs(SS, row);
#pragma unroll
                for (int bj = 0; bj < 2; ++bj) *(u32x4*)(dst + (size_t)row * 1024 + col0 + bj * 128) = pack8(gate4(acc[ai][bj][m][0] * rs), gate4(acc[ai][bj][m][1] * rs)); }
        return true;
    }
};
struct PhMerge {
    static constexpr int K = 512; static constexpr bool GATHER = false;
    unsigned char* ws; int G, c;
    __device__ __forceinline__ bool next(int i, GUnit& u) const {
        const int ti = i / 3, seg = i - ti * 3; const long L = (long)ti * G + c; if (L >= 128 * 4) return false;
        pg8::tile_order((int)L, 128, 4, u.pm, u.pn);
        const size_t ya = seg == 0 ? WS_YATT : (seg == 1 ? WS_YC : WS_OM);
        u.A = (const char*)ws + ya + (size_t)u.pm * 256 * K * 2; u.B = (const char*)ws + WS_WBR + (size_t)seg * 1024 * 512 * 2 + (size_t)u.pn * 256 * K * 2; u.a0 = seg; u.a1 = 0; return true;
    }
    __device__ __forceinline__ unsigned arow(const GUnit&, int) const { return 0u; }
    __device__ __forceinline__ bool epi(Acc& acc, const GUnit& u, int wr, int wc, int fr, int fq) const {
        const int seg = u.a0; const int row0 = u.pm * 256 + wr * 64 + fr; const int col0 = u.pn * 256 + wc * 32 + fq * 8;
        const bf16_t* Gn = (const bf16_t*)(ws + WS_G0 + (size_t)seg * 64 * MiB);
        const bf16_t* Gd = (const bf16_t*)(ws + WS_G0 + (size_t)(seg + 1) * 64 * MiB);
        bf16_t* Mo = (bf16_t*)(ws + WS_MERGED);
#pragma unroll
        for (int ai = 0; ai < 2; ++ai)
#pragma unroll
            for (int m = 0; m < 4; ++m) { const size_t off = (size_t)(row0 + ai * 128 + m * 16) * 1024 + col0;
#pragma unroll
                for (int bj = 0; bj < 2; ++bj) {
                    f32x4 n0, n1; unpack8(*(const u32x4*)(Gn + off + bj * 128), n0, n1);
                    if (seg < 2) { f32x4 d0, d1; unpack8(*(const u32x4*)(Gd + off + bj * 128), d0, d1);
#pragma unroll
                        for (int j = 0; j < 4; ++j) { acc[ai][bj][m][0][j] *= n0[j] * __builtin_amdgcn_rcpf(d0[j]); acc[ai][bj][m][1][j] *= n1[j] * __builtin_amdgcn_rcpf(d1[j]); } }
                    else *(u32x4*)(Mo + off + bj * 128) = pack8(acc[ai][bj][m][0] * n0, acc[ai][bj][m][1] * n1);
                } }
        return seg == 2;
    }
};
__device__ __forceinline__ float store_x8(float* xp, bf16_t* xbp, const f32x4 v0, const f32x4 v1) {
    *(f32x4*)xp = v0; *(f32x4*)(xp + 4) = v1; *(u32x4*)xbp = pack8(v0, v1);
    return ((v0[0] * v0[0] + v0[1] * v0[1]) + (v0[2] * v0[2] + v0[3] * v0[3])) + ((v1[0] * v1[0] + v1[1] * v1[1]) + (v1[2] * v1[2] + v1[3] * v1[3]));
}
struct PhOut {
    static constexpr int K = 1024; static constexpr bool GATHER = false;
    unsigned char* ws; float* x; float* SSo; int G, c;
    __device__ __forceinline__ bool next(int i, GUnit& u) const {
        const long L = (long)i * G + c; if (L >= 128 * 4) return false;
        pg8::tile_order((int)L, 128, 4, u.pm, u.pn);
        u.A = (const char*)ws + WS_MERGED + (size_t)u.pm * 256 * K * 2; u.B = (const char*)ws + WS_WOUT + (size_t)u.pn * 256 * K * 2; u.a0 = 0; u.a1 = 0; return true;
    }
    __device__ __forceinline__ unsigned arow(const GUnit&, int) const { return 0u; }
    __device__ __forceinline__ bool epi(Acc& acc, const GUnit& u, int wr, int wc, int fr, int fq) const {
        const int row0 = u.pm * 256 + wr * 64 + fr; const int col0 = u.pn * 256 + wc * 32 + fq * 8; bf16_t* XB = (bf16_t*)(ws + WS_XB);
#pragma unroll
        for (int ai = 0; ai < 2; ++ai)
#pragma unroll
            for (int m = 0; m < 4; ++m) { const int row = row0 + ai * 128 + m * 16; const size_t off = (size_t)row * 1024 + col0; float ss = 0.f;
#pragma unroll
                for (int bj = 0; bj < 2; ++bj) { float* xp = x + off + bj * 128; const f32x4 v0 = *(const f32x4*)xp + acc[ai][bj][m][0], v1 = *(const f32x4*)(xp + 4) + acc[ai][bj][m][1];
                    ss += store_x8(xp, XB + off + bj * 128, v0, v1); }
                ss += __shfl_xor(ss, 16); ss += __shfl_xor(ss, 32);
                if (fq == 0) SSo[(size_t)row * 16 + u.pn * 4 + wc] = ss; }
        return true;
    }
};
struct PhRouter {
    static constexpr int K = 1024; static constexpr bool GATHER = false;
    unsigned char* ws; const float* SS; int G, c;
    __device__ __forceinline__ bool next(int i, GUnit& u) const {
        const long L = (long)i * G + c; if (L >= 128) return false;
        u.pm = (int)L; u.pn = 0; u.A = (const char*)ws + WS_XB + (size_t)u.pm * 256 * K * 2; u.B = (const char*)ws + WS_WR; u.a0 = 0; u.a1 = 0; return true;
    }
    __device__ __forceinline__ unsigned arow(const GUnit&, int) const { return 0u; }
    __device__ __forceinline__ bool epi(Acc& acc, const GUnit& u, int wr, int wc, int fr, int fq) const {
        if (wc < 2) { float* Lg = (float*)(ws + WS_LOGITS); const int row0 = u.pm * 256 + wr * 64 + fr;
#pragma unroll
            for (int ai = 0; ai < 2; ++ai)
#pragma unroll
                for (int m = 0; m < 4; ++m) { const int row = row0 + ai * 128 + m * 16; const float rs = row_rs(SS, row); float* p = Lg + (size_t)row * 64 + wc * 32 + fq * 8;
                    *(f32x4*)p = acc[ai][0][m][0] * rs; *(f32x4*)(p + 4) = acc[ai][0][m][1] * rs; } }
        return true;
    }
};
__device__ __forceinline__ int moe_expert_of(const int* META, int k, int rb) {
    const int r = rb * 256; int e = 0;
    for (int j = 1; j < 32; ++j) e += (META[16 + 64 * k + j] <= r) ? 1 : 0;
    return __builtin_amdgcn_readfirstlane(e);
}
struct PhUp {
    static constexpr int K = 1024; static constexpr bool GATHER = true;
    unsigned char* ws; const float* SS; const int* META; const int* tok; int G, c;
    __device__ __forceinline__ bool next(int i, GUnit& u) const {
        const int nb0 = __builtin_amdgcn_readfirstlane(META[0]), nb1 = __builtin_amdgcn_readfirstlane(META[1]); const long L = (long)i * G + c; if (L >= 2L * (nb0 + nb1)) return false;
        int blk = (int)(L >> 1); u.pn = (int)(L & 1); int k = 0; if (blk >= nb0) { k = 1; blk -= nb0; }
        const int e = moe_expert_of(META, k, blk);
        u.pm = blk; u.a0 = k; u.a1 = e; u.A = (const char*)ws + WS_XB; u.B = (const char*)ws + WS_WEXP + (size_t)e * 512 * 1024 * 2 + (size_t)u.pn * 256 * K * 2; return true;
    }
    __device__ __forceinline__ unsigned arow(const GUnit& u, int r) const { const int t = tok[u.a0 * LISTCAP + u.pm * 256 + r]; return t < 0 ? 0u : (unsigned)t; }
    __device__ __forceinline__ bool epi(Acc& acc, const GUnit& u, int wr, int wc, int fr, int fq) const {
        const int lr0 = u.a0 * LISTCAP + u.pm * 256 + wr * 64 + fr; bf16_t* HB = (bf16_t*)(ws + WS_HB);
#pragma unroll
        for (int ai = 0; ai < 2; ++ai)
#pragma unroll
            for (int m = 0; m < 4; ++m) { const int lr = lr0 + ai * 128 + m * 16; const int t = tok[lr]; const float rs = t < 0 ? 0.f : row_rs(SS, t < 0 ? 0 : t);
#pragma unroll
                for (int bj = 0; bj < 2; ++bj) { const f32x4 g = acc[ai][bj][m][0] * rs, uu = acc[ai][bj][m][1] * rs;
                    f32x4 h = (f32x4){siluf_(g[0]) * uu[0], siluf_(g[1]) * uu[1], siluf_(g[2]) * uu[2], siluf_(g[3]) * uu[3]}; if (ABL == 8) h = (f32x4){1.f, 1.f, 1.f, 1.f};
                    u32x2 w; w.x = cvt_pk_bf16(h[0], h[1]); w.y = cvt_pk_bf16(h[2], h[3]);
                    *(u32x2*)(HB + (size_t)lr * 256 + u.pn * 128 + bj * 64 + wc * 16 + fq * 4) = w; }
                asm volatile("" ::: "memory"); }
        return true;
    }
};
template <int KL> struct PhDown {
    static constexpr int K = 256; static constexpr bool GATHER = false;
    unsigned char* ws; float* x; float* SSo; const int* META; const int* tok; const float* wl; int G, c;
    __device__ __forceinline__ bool next(int i, GUnit& u) const {
        const int nb = __builtin_amdgcn_readfirstlane(META[KL]); const long L = (long)i * G + c;
        if (L < 4L * nb) { const int blk = (int)(L >> 2); u.pn = (int)(L & 3); const int e = moe_expert_of(META, KL, blk); u.pm = blk; u.a0 = 0; u.a1 = e;
            u.A = (const char*)ws + WS_HB + (size_t)(KL * LISTCAP + blk * 256) * 256 * 2; u.B = (const char*)ws + WS_WEXP + 32ull * 512 * 1024 * 2 + (size_t)e * 1024 * 256 * 2 + (size_t)u.pn * 256 * K * 2; return true; }
        if (KL == 1) { const long L2 = L - 4L * nb; if (L2 >= 128 * 4) return false;
            pg8::tile_order((int)L2, 128, 4, u.pm, u.pn); u.a0 = 1; u.a1 = 0;
            u.A = (const char*)ws + WS_PBF + (size_t)u.pm * 256 * K * 2; u.B = (const char*)ws + WS_WPP + (size_t)u.pn * 256 * K * 2; return true; }
        return false;
    }
    __device__ __forceinline__ unsigned arow(const GUnit&, int) const { return 0u; }
    __device__ __forceinline__ bool epi(Acc& acc, const GUnit& u, int wr, int wc, int fr, int fq) const {
        const int col0 = u.pn * 256 + wc * 32 + fq * 8;
        if (KL == 1 && u.a0 == 1) {
            bf16_t* PE = (bf16_t*)(ws + WS_PE); const int row0 = u.pm * 256 + wr * 64 + fr;
#pragma unroll
            for (int ai = 0; ai < 2; ++ai)
#pragma unroll
                for (int m = 0; m < 4; ++m)
#pragma unroll
                    for (int bj = 0; bj < 2; ++bj) *(u32x4*)(PE + (size_t)(row0 + ai * 128 + m * 16) * 1024 + col0 + bj * 128) = pack8(acc[ai][bj][m][0], acc[ai][bj][m][1]);
            return true;
        }
        const int lr0 = KL * LISTCAP + u.pm * 256 + wr * 64 + fr; bf16_t* YB = (bf16_t*)(ws + WS_YB1); bf16_t* XB = (bf16_t*)(ws + WS_XB);
#pragma unroll
        for (int ai = 0; ai < 2; ++ai)
#pragma unroll
            for (int m = 0; m < 4; ++m) { const int lr = lr0 + ai * 128 + m * 16; const int t = tok[lr]; const float w = (ABL == 9) ? 1.0f : wl[lr]; const size_t off = (size_t)(t < 0 ? 0 : t) * 1024 + col0;
                if (KL == 1) { if (t >= 0) {
#pragma unroll
                        for (int bj = 0; bj < 2; ++bj) *(u32x4*)(YB + off + bj * 128) = pack8(acc[ai][bj][m][0] * w, acc[ai][bj][m][1] * w); } }
                else { float ss = 0.f;
                    if (t >= 0) {
#pragma unroll
                        for (int bj = 0; bj < 2; ++bj) { float* xp = x + off + bj * 128; f32x4 y0, y1; unpack8(*(const u32x4*)(YB + off + bj * 128), y0, y1);
                            f32x4 v0 = (*(const f32x4*)xp + y0) + acc[ai][bj][m][0] * w, v1 = (*(const f32x4*)(xp + 4) + y1) + acc[ai][bj][m][1] * w; if (ABL == 7) { v0 = v0 + 1.0f; v1 = v1 + 1.0f; }
                            ss += store_x8(xp, XB + off + bj * 128, v0, v1); } }
                    ss += __shfl_xor(ss, 16); ss += __shfl_xor(ss, 32);
                    if (fq == 0 && t >= 0) SSo[(size_t)t * 16 + u.pn * 4 + wc] = ss; }
                asm volatile("" ::: "memory"); }
        return true;
    }
};
struct PhPle {
    static constexpr int K = 1024; static constexpr bool GATHER = false;
    unsigned char* ws; float* x; const float* SSi; float* SSo; int G, c;
    __device__ __forceinline__ bool next(int i, GUnit& u) const {
        const long L = (long)i * G + c; if (L >= 128 * 4) return false;
        pg8::tile_order((int)L, 128, 4, u.pm, u.pn);
        u.A = (const char*)ws + WS_XB + (size_t)u.pm * 256 * K * 2; u.B = (const char*)ws + WS_WPG + (size_t)u.pn * 256 * K * 2; u.a0 = 0; u.a1 = 0; return true;
    }
    __device__ __forceinline__ unsigned arow(const GUnit&, int) const { return 0u; }
    __device__ __forceinline__ bool epi(Acc& acc, const GUnit& u, int wr, int wc, int fr, int fq) const {
        const int row0 = u.pm * 256 + wr * 64 + fr; const int col0 = u.pn * 256 + wc * 32 + fq * 8; bf16_t* XT = (bf16_t*)(ws + WS_XBT); const bf16_t* PE = (const bf16_t*)(ws + WS_PE);
#pragma unroll
        for (int ai = 0; ai < 2; ++ai)
#pragma unroll
            for (int m = 0; m < 4; ++m) { const int row = row0 + ai * 128 + m * 16; const size_t off = (size_t)row * 1024 + col0; const float rs = row_rs(SSi, row); float ss = 0.f;
#pragma unroll
                for (int bj = 0; bj < 2; ++bj) { float* xp = x + off + bj * 128; f32x4 p0, p1; unpack8(*(const u32x4*)(PE + off + bj * 128), p0, p1); if (ABL == 5) { p0 = p0 * 0.f; p1 = p1 * 0.f; }
                    const f32x4 v0 = *(const f32x4*)xp + sig4(acc[ai][bj][m][0] * rs) * p0, v1 = *(const f32x4*)(xp + 4) + sig4(acc[ai][bj][m][1] * rs) * p1;
                    ss += store_x8(xp, XT + off + bj * 128, v0, v1); }
                ss += __shfl_xor(ss, 16); ss += __shfl_xor(ss, 32);
                if (fq == 0) SSo[(size_t)row * 16 + u.pn * 4 + wc] = ss; }
        return true;
    }
};

struct Ctx {
    const float* const* in; float* out; unsigned char* ws; LAS unsigned char* lds;
    int tid, lane, wave, G, bid;
};
enum { I_X = 0, I_P, I_GMIX, I_WIN, I_CONVW, I_CONVB, I_CLNG, I_CLNB, I_MCW, I_MCB, I_MIB, I_MFB, I_WBA, I_WBC, I_WBM, I_WOUT, I_GFFN, I_WRG, I_BRG, I_WRE, I_BRE,
       I_WEG, I_WEU, I_WED, I_GPLE, I_WPG, I_WPP, I_GFIN };

__device__ __forceinline__ void tr_item(const float* colptr, size_t pitch, const float* gain, float cscale, bf16_t* dst, int K, int n0, int k0, LAS float* scr, int lane) {
#pragma unroll 8
    for (int i = 0; i < 32; ++i) { const int kk = 2 * i + (lane >> 5); float v = colptr ? colptr[(size_t)(k0 + kk) * pitch] : 0.f; if (gain) v *= gain[k0 + kk]; scr[kk * 33 + (lane & 31)] = v * cscale; }
    LDS_WAIT(); asm volatile("" ::: "memory");
    const int c = lane & 7;
#pragma unroll
    for (int j = 0; j < 4; ++j) { const int n = (lane >> 3) + 8 * j; const LAS float* s = scr + (8 * c) * 33 + n;
        u32x4 o; o.x = pk2(s[0 * 33], s[1 * 33]); o.y = pk2(s[2 * 33], s[3 * 33]); o.z = pk2(s[4 * 33], s[5 * 33]); o.w = pk2(s[6 * 33], s[7 * 33]);
        *(u32x4*)(dst + (size_t)(n0 + n) * K + k0 + 8 * c) = o; }
    LDS_WAIT(); asm volatile("" ::: "memory");
}
__device__ __forceinline__ void phase_prep(const Ctx& F, int layer, float* SS) {
    const int gw = F.bid * NWAVES + F.wave, NGW = F.G * NWAVES, lane = F.lane;
    LAS float* scr = (LAS float*)(F.lds + F.wave * 16384);
    bf16_t* XB = (bf16_t*)(F.ws + WS_XB);
    if (layer == 0) {
        for (int m = gw; m < T; m += NGW) {
            const f32x4* xr = (const f32x4*)(F.in[I_X] + (size_t)m * D) + lane; f32x4* orow = (f32x4*)(F.out + (size_t)m * D) + lane; u32x2* xbr = (u32x2*)(XB + (size_t)m * D) + lane;
            float s = 0.f;
#pragma unroll
            for (int j = 0; j < 4; ++j) { const f32x4 v = xr[64 * j]; orow[64 * j] = v; s += (v.x * v.x + v.y * v.y) + (v.z * v.z + v.w * v.w);
                u32x2 w; w.x = cvt_pk_bf16(v.x, v.y); w.y = cvt_pk_bf16(v.z, v.w); xbr[64 * j] = w; }
            s = wave_sum(s);
            if (lane < 16) SS[(size_t)m * 16 + lane] = lane == 0 ? s : 0.f;
        }
    } else {
        const u32x4* src = (const u32x4*)(F.ws + WS_XBT); u32x4* dst = (u32x4*)(F.ws + WS_XB);
        for (size_t i = (size_t)F.bid * NTHREADS + F.tid; i < (size_t)T * D * 2 / 16; i += (size_t)F.G * NTHREADS) dst[i] = src[i];
    }
    const float* w_in = F.in[I_WIN] + (size_t)layer * D * D_IN; const float* g_mix = F.in[I_GMIX] + (size_t)layer * D;
    constexpr int N_WIN = 280 * 16, N_BR = 32 * 8, N_SQ = 32 * 16, N_PP = 32 * 4, N_R = 8 * 16;
    constexpr int NITEMS = N_WIN + 3 * N_BR + 2 * N_SQ + N_PP + N_R;
    for (int it = gw; it < NITEMS; it += NGW) {
        int r = it;
        if (r < N_WIN) { const int nb = r >> 4, kb = r & 15; const int n = nb * 32 + (lane & 31); int src = -1; float cs = 1.f;
            if (n < 2560) { src = n; if (n < 1536) cs = 0.125f; }
            else if (n < 3584) { const int np = n - 2560, q8 = np >> 3, s = (np >> 2) & 1, j = np & 3; src = 2560 + s * 512 + 4 * q8 + j; }
            else if (n < 5640) src = n;
            else if (n < 5888) src = -1;
            else src = 5640 + (n - 5888);
            tr_item(src >= 0 ? w_in + src : nullptr, D_IN, g_mix, cs, (bf16_t*)(F.ws + WS_WIN), 1024, nb * 32, kb * 64, scr, lane); continue; }
        r -= N_WIN;
        if (r < 3 * N_BR) { const int b = r / N_BR; r -= b * N_BR; const int nb = r >> 3, kb = r & 7; const int n = nb * 32 + (lane & 31);
            const float* w = (b == 0 ? F.in[I_WBA] : (b == 1 ? F.in[I_WBC] : F.in[I_WBM])) + (size_t)layer * 512 * 1024;
            tr_item(w + n, 1024, nullptr, 1.f, (bf16_t*)(F.ws + WS_WBR) + (size_t)b * 1024 * 512, 512, nb * 32, kb * 64, scr, lane); continue; }
        r -= 3 * N_BR;
        if (r < 2 * N_SQ) { const int b = r / N_SQ; r -= b * N_SQ; const int nb = r >> 4, kb = r & 15; const int n = nb * 32 + (lane & 31);
            const float* w = (b == 0 ? F.in[I_WOUT] : F.in[I_WPG]) + (size_t)layer * 1024 * 1024;
            tr_item(w + n, 1024, b == 0 ? nullptr : F.in[I_GPLE] + (size_t)layer * D, 1.f, (bf16_t*)(F.ws + (b == 0 ? WS_WOUT : WS_WPG)), 1024, nb * 32, kb * 64, scr, lane); continue; }
        r -= 2 * N_SQ;
        if (r < N_PP) { const int nb = r >> 2, kb = r & 3; const int n = nb * 32 + (lane & 31);
            tr_item(F.in[I_WPP] + (size_t)layer * 256 * 1024 + n, 1024, nullptr, 1.f, (bf16_t*)(F.ws + WS_WPP), 256, nb * 32, kb * 64, scr, lane); continue; }
        r -= N_PP;
        { const int nb = r >> 4, kb = r & 15; const int n = nb * 32 + (lane & 31); const float* cp = nullptr; size_t pitch = 4;
            if (n < 4) { cp = F.in[I_WRG] + (size_t)layer * 1024 * 4 + n; pitch = 4; } else if (n < 36) { cp = F.in[I_WRE] + (size_t)layer * 1024 * 32 + (n - 4); pitch = 32; }
            tr_item(cp, pitch, F.in[I_GFFN] + (size_t)layer * D, 1.f, (bf16_t*)(F.ws + WS_WR), 1024, nb * 32, kb * 64, scr, lane); }
    }
}
__device__ __forceinline__ void phase_prep_experts(const Ctx& F, int layer) {
    const int gw = F.bid * NWAVES + F.wave, NGW = F.G * NWAVES, lane = F.lane;
    LAS float* scr = (LAS float*)(F.lds + F.wave * 16384);
    const float* g_ffn = F.in[I_GFFN] + (size_t)layer * D;
    constexpr int N_UP = 32 * 16 * 16, N_DN = 32 * 32 * 4;
    for (int it = gw; it < N_UP + N_DN; it += NGW) {
        int r = it;
        if (r < N_UP) { const int e = r >> 8; r &= 255; const int nb = r >> 4, kb = r & 15; const int n = nb * 32 + (lane & 31); const int q8 = n >> 3, s = (n >> 2) & 1, j = n & 3;
            const float* w = (s ? F.in[I_WEU] : F.in[I_WEG]) + ((size_t)layer * 32 + e) * 1024 * 256 + 4 * q8 + j;
            tr_item(w, 256, g_ffn, 1.f, (bf16_t*)(F.ws + WS_WEXP) + (size_t)e * 512 * 1024, 1024, nb * 32, kb * 64, scr, lane); continue; }
        r -= N_UP;
        { const int e = r >> 7; r &= 127; const int nb = r >> 2, kb = r & 3; const int n = nb * 32 + (lane & 31);
            const float* w = F.in[I_WED] + ((size_t)layer * 32 + e) * 256 * 1024 + n;
            tr_item(w, 1024, nullptr, 1.f, (bf16_t*)(F.ws + WS_WEXP) + 32ull * 512 * 1024 + (size_t)e * 1024 * 256, 256, nb * 32, kb * 64, scr, lane); }
    }
    const f32x4* p = (const f32x4*)(F.in[I_P] + (size_t)layer * T * 256); u32x2* pb = (u32x2*)(F.ws + WS_PBF);
    for (size_t i = (size_t)F.bid * NTHREADS + F.tid; i < (size_t)T * 256 / 4; i += (size_t)F.G * NTHREADS) { const f32x4 v = p[i]; u32x2 w; w.x = cvt_pk_bf16(v.x, v.y); w.y = cvt_pk_bf16(v.z, v.w); pb[i] = w; }
}

__device__ __forceinline__ void attn_item_v1(const Ctx& F, int tb) {
    const int slot = F.wave, t = tb * 64 + F.lane, s = t & (SEQ - 1);
    const bf16_t* KA = (const bf16_t*)(F.ws + WS_KA); const bf16_t* VA = (const bf16_t*)(F.ws + WS_VA);
    float acc[64];
#pragma unroll
    for (int d = 0; d < 64; ++d) acc[d] = 0.f;
    float mrun = -INFINITY, lrun = 0.f;
    for (int g = 0; g < 3; ++g) {
        const int dl = 1 << (2 * g); const float slope = exp2f(-(float)(g * 8 + slot + 1) * (1.0f / 3.0f)) * (float)dl;
        const bf16_t* Q = (const bf16_t*)(F.ws + (g == 0 ? WS_QA0 : (g == 1 ? WS_QA1 : WS_QA2))) + (size_t)t * 512 + slot * 64;
        float q[64];
#pragma unroll
        for (int c = 0; c < 8; ++c) { const u32x4 w = ((const u32x4*)Q)[c]; q[8 * c] = bf_lo(w.x); q[8 * c + 1] = bf_hi(w.x); q[8 * c + 2] = bf_lo(w.y); q[8 * c + 3] = bf_hi(w.y); q[8 * c + 4] = bf_lo(w.z); q[8 * c + 5] = bf_hi(w.z); q[8 * c + 6] = bf_lo(w.w); q[8 * c + 7] = bf_hi(w.w); }
        int nj = s / dl; if (nj > 128) nj = 128;
        const int njmax = __builtin_amdgcn_readfirstlane((int)wave_max((float)nj));
        for (int j = 0; j <= njmax; ++j) {
            const bool ok = j <= nj; const int tk = ok ? t - dl * j : t;
            const u32x4* kp = (const u32x4*)(KA + (size_t)tk * 512 + slot * 64); const u32x4* vp = (const u32x4*)(VA + (size_t)tk * 512 + slot * 64);
            float dot = 0.f;
#pragma unroll
            for (int c = 0; c < 8; ++c) { const u32x4 w = kp[c];
                dot += q[8 * c] * bf_lo(w.x) + q[8 * c + 1] * bf_hi(w.x) + q[8 * c + 2] * bf_lo(w.y) + q[8 * c + 3] * bf_hi(w.y) + q[8 * c + 4] * bf_lo(w.z) + q[8 * c + 5] * bf_hi(w.z) + q[8 * c + 6] * bf_lo(w.w) + q[8 * c + 7] * bf_hi(w.w); }
            const float sc = ok ? dot - slope * (float)j : -INFINITY;
            const float mn = fmaxf(mrun, sc);
            const float corr = __expf(mrun - mn), pw = __expf(sc - mn);
            lrun = lrun * corr + pw; mrun = mn;
#pragma unroll
            for (int c = 0; c < 8; ++c) { const u32x4 w = vp[c];
                acc[8 * c] = acc[8 * c] * corr + pw * bf_lo(w.x); acc[8 * c + 1] = acc[8 * c + 1] * corr + pw * bf_hi(w.x); acc[8 * c + 2] = acc[8 * c + 2] * corr + pw * bf_lo(w.y); acc[8 * c + 3] = acc[8 * c + 3] * corr + pw * bf_hi(w.y);
                acc[8 * c + 4] = acc[8 * c + 4] * corr + pw * bf_lo(w.z); acc[8 * c + 5] = acc[8 * c + 5] * corr + pw * bf_hi(w.z); acc[8 * c + 6] = acc[8 * c + 6] * corr + pw * bf_lo(w.w); acc[8 * c + 7] = acc[8 * c + 7] * corr + pw * bf_hi(w.w); }
        }
    }
    const float inv = (ABL == 1) ? 0.f : 1.0f / lrun;
    u32x4* o = (u32x4*)((bf16_t*)(F.ws + WS_YATT) + (size_t)t * 512 + slot * 64);
#pragma unroll
    for (int c = 0; c < 8; ++c) { u32x4 w; w.x = cvt_pk_bf16(acc[8 * c] * inv, acc[8 * c + 1] * inv); w.y = cvt_pk_bf16(acc[8 * c + 2] * inv, acc[8 * c + 3] * inv); w.z = cvt_pk_bf16(acc[8 * c + 4] * inv, acc[8 * c + 5] * inv); w.w = cvt_pk_bf16(acc[8 * c + 6] * inv, acc[8 * c + 7] * inv); o[c] = w; }
}

constexpr int AK_RS = 144, AV_RS = 160, AV_OFF = 2 * 128 * AK_RS;
typedef short s16x4 __attribute__((ext_vector_type(4)));
__device__ __forceinline__ s16x4 lds_tr16(LAS unsigned char* p) { return __builtin_amdgcn_ds_read_tr16_b64_v4i16((LAS s16x4*)p); }
__device__ __forceinline__ void attn_strip(const Ctx& F, int strip) {
    const int bs = strip / 48, sg = strip - bs * 48, b = bs >> 3, slot = bs & 7;
    int g, r, nb0;
    if (sg < 16) { g = 0; r = 0; nb0 = sg * 8; } else if (sg < 32) { g = 1; r = (sg - 16) >> 2; nb0 = ((sg - 16) & 3) * 8; } else { g = 2; r = sg - 32; nb0 = 0; }
    const int dl = 1 << (2 * g); const float slope = exp2f(-(float)(g * 8 + slot + 1) * (1.0f / 3.0f)) * (float)dl;
    bf16_t* Qg = (bf16_t*)(F.ws + (g == 0 ? WS_QA0 : (g == 1 ? WS_QA1 : WS_QA2))) + slot * 64;
    const bf16_t* Kg = (const bf16_t*)(F.ws + WS_KA) + slot * 64; const bf16_t* Vg = (const bf16_t*)(F.ws + WS_VA) + slot * 64;
    float* LSE = (float*)(F.ws + WS_LOGITS) + (size_t)g * T * 8 + slot;
    const size_t tok0 = (size_t)b * SEQ + r;
    LAS unsigned char* Kl = F.lds; LAS unsigned char* Vl = F.lds + AV_OFF;
    const int tid = F.tid, lane = F.lane, w = F.wave, fr = lane & 15, fq = lane >> 4;
    const int srow = tid >> 2, sc4 = tid & 3;
    u32x4 kx[2], vx[2];
#define ATT_LOAD(blk) do { const size_t _t = (tok0 + (size_t)((blk) * 128 + srow) * dl) * 512; \
        kx[0] = *(const u32x4*)(Kg + _t + sc4 * 8); kx[1] = *(const u32x4*)(Kg + _t + 32 + sc4 * 8); vx[0] = *(const u32x4*)(Vg + _t + sc4 * 8); vx[1] = *(const u32x4*)(Vg + _t + 32 + sc4 * 8); } while (0)
#define ATT_STORE(blk) do { const int _p = (((blk) & 1) * 128 + srow); \
        *(LAS u32x4*)(Kl + _p * AK_RS + sc4 * 16) = kx[0]; *(LAS u32x4*)(Kl + _p * AK_RS + 64 + sc4 * 16) = kx[1]; *(LAS u32x4*)(Vl + _p * AV_RS + sc4 * 16) = vx[0]; *(LAS u32x4*)(Vl + _p * AV_RS + 64 + sc4 * 16) = vx[1]; } while (0)
    __syncthreads();
    if (nb0 > 0) { ATT_LOAD(nb0 - 1); ATT_STORE(nb0 - 1); }
    else { kx[0] = kx[1] = vx[0] = vx[1] = (u32x4){0u, 0u, 0u, 0u}; ATT_STORE(1); }
    ATT_LOAD(nb0); ATT_STORE(nb0);
    __syncthreads();
    for (int nb = nb0; nb < nb0 + 8; ++nb) {
        const bool more = nb + 1 < nb0 + 8;
        if (more) ATT_LOAD(nb + 1);
        const size_t qoff = (tok0 + (size_t)(nb * 128 + 16 * w + fr) * dl) * 512;
        const bf16x8 q0 = *(const bf16x8*)(Qg + qoff + fq * 8), q1 = *(const bf16x8*)(Qg + qoff + 32 + fq * 8);
        const int pslot = (nb - 1) & 1;
        f32x4 S[10];
#pragma unroll
        for (int kbi = 0; kbi < 10; ++kbi) {
            int kb = w + kbi; if (kb > 15) kb = 15;
            const int ki = kb * 16 + fr; const int phys = ((pslot + (ki >> 7)) & 1) * 128 + (ki & 127);
            const bf16x8 k0 = *(const LAS bf16x8*)(Kl + phys * AK_RS + fq * 16), k1 = *(const LAS bf16x8*)(Kl + phys * AK_RS + 64 + fq * 16);
            f32x4 a = (f32x4){0.f, 0.f, 0.f, 0.f};
            a = __builtin_amdgcn_mfma_f32_16x16x32_bf16(k0, q0, a, 0, 0, 0);
            S[kbi] = __builtin_amdgcn_mfma_f32_16x16x32_bf16(k1, q1, a, 0, 0, 0);
        }
        float mx = -INFINITY;
#pragma unroll
        for (int kbi = 0; kbi < 10; ++kbi)
#pragma unroll
            for (int j = 0; j < 4; ++j) { const int ki = (w + kbi) * 16 + 4 * fq + j; const int dist = 16 * w + fr + 128 - ki;
                const bool ok = dist >= 0 && dist <= 128 && (nb > 0 || ki >= 128) && (w + kbi) < 16;
                const float sc = ok ? S[kbi][j] - slope * (float)dist : -INFINITY; S[kbi][j] = sc; mx = fmaxf(mx, sc); }
        mx = fmaxf(mx, __shfl_xor(mx, 16)); mx = fmaxf(mx, __shfl_xor(mx, 32));
        float ls = 0.f;
#pragma unroll
        for (int kbi = 0; kbi < 10; ++kbi)
#pragma unroll
            for (int j = 0; j < 4; ++j) { const float p = __expf(S[kbi][j] - mx); S[kbi][j] = p; ls += p; }
        ls += __shfl_xor(ls, 16); ls += __shfl_xor(ls, 32);
        f32x4 O[4];
#pragma unroll
        for (int db = 0; db < 4; ++db) O[db] = (f32x4){0.f, 0.f, 0.f, 0.f};
#pragma unroll
        for (int k2 = 0; k2 < 5; ++k2) {
            u32x4 pw; pw.x = cvt_pk_bf16(S[2 * k2][0], S[2 * k2][1]); pw.y = cvt_pk_bf16(S[2 * k2][2], S[2 * k2][3]); pw.z = cvt_pk_bf16(S[2 * k2 + 1][0], S[2 * k2 + 1][1]); pw.w = cvt_pk_bf16(S[2 * k2 + 1][2], S[2 * k2 + 1][3]);
            const bf16x8 pf = __builtin_bit_cast(bf16x8, pw);
            int kb0 = w + 2 * k2, kb1 = kb0 + 1; if (kb1 > 15) kb1 = 15; if (kb0 > 15) kb0 = 15;
            const int r0 = kb0 * 16 + 4 * fq + (fr >> 2), r1 = kb1 * 16 + 4 * fq + (fr >> 2);
            const int p0 = ((pslot + (r0 >> 7)) & 1) * 128 + (r0 & 127), p1 = ((pslot + (r1 >> 7)) & 1) * 128 + (r1 & 127);
#pragma unroll
            for (int db = 0; db < 4; ++db) {
                const s16x4 v0 = lds_tr16(Vl + p0 * AV_RS + (db * 16 + 4 * (fr & 3)) * 2), v1 = lds_tr16(Vl + p1 * AV_RS + (db * 16 + 4 * (fr & 3)) * 2);
                const bf16x8 vf = (bf16x8){v0[0], v0[1], v0[2], v0[3], v1[0], v1[1], v1[2], v1[3]};
                O[db] = __builtin_amdgcn_mfma_f32_16x16x32_bf16(vf, pf, O[db], 0, 0, 0);
            }
        }
        const float inv = 1.0f / ls;
#pragma unroll
        for (int db = 0; db < 4; ++db) { u32x2 ow; ow.x = cvt_pk_bf16(O[db][0] * inv, O[db][1] * inv); ow.y = cvt_pk_bf16(O[db][2] * inv, O[db][3] * inv);
            *(u32x2*)(Qg + qoff + db * 16 + 4 * fq) = ow; }
        if (fq == 0) LSE[(qoff >> 9) * 8] = mx + __logf(ls);
        __syncthreads();
        if (more) ATT_STORE(nb + 1);
        __syncthreads();
    }
#undef ATT_LOAD
#undef ATT_STORE
}
__device__ __forceinline__ void attn_combine(const Ctx& F) {
    const float* LSE = (const float*)(F.ws + WS_LOGITS);
    for (int i = F.bid * NTHREADS + F.tid; i < T * 64; i += F.G * NTHREADS) {
        const int t = i >> 6, c8 = i & 63, slot = c8 >> 3;
        const float l0 = LSE[(size_t)t * 8 + slot], l1 = LSE[(size_t)T * 8 + (size_t)t * 8 + slot], l2 = LSE[(size_t)2 * T * 8 + (size_t)t * 8 + slot];
        const float m = fmaxf(l0, fmaxf(l1, l2)); float w0 = __expf(l0 - m), w1 = __expf(l1 - m), w2 = __expf(l2 - m); const float inv = 1.0f / (w0 + w1 + w2); w0 *= inv; w1 *= inv; w2 *= inv;
        u32x4* p0 = (u32x4*)(F.ws + WS_QA0) + i; const u32x4 a = *p0, bb = ((const u32x4*)(F.ws + WS_QA1))[i], cc = ((const u32x4*)(F.ws + WS_QA2))[i];
        f32x4 a0, a1, b0, b1, c0, c1; unpack8(a, a0, a1); unpack8(bb, b0, b1); unpack8(cc, c0, c1);
        *p0 = pack8(a0 * w0 + b0 * w1 + c0 * w2, a1 * w0 + b1 * w1 + c1 * w2);
    }
}

__device__ __forceinline__ void conv_item_v1(const Ctx& F, int layer, int item) {
    const int t0 = item * 32, s0 = t0 & (SEQ - 1), tid = F.tid;
    LAS bf16_t* sin = (LAS bf16_t*)F.lds;
    LAS float* sout = (LAS float*)(F.lds + 65536);
    const bf16_t* YG = (const bf16_t*)(F.ws + WS_YG);
    __syncthreads();
    for (int i = tid; i < 62 * 64; i += NTHREADS) { const int r = i >> 6, c8 = i & 63; const int sp = s0 - 30 + r;
        u32x4 v = (u32x4){0u, 0u, 0u, 0u}; if (sp >= 0) v = *(const u32x4*)(YG + (size_t)(t0 - 30 + r) * 512 + c8 * 8);
        *(LAS u32x4*)(sin + r * 512 + c8 * 8) = v; }
    float w[31];
    const float* cw = F.in[I_CONVW] + (size_t)layer * 31 * 512 + tid;
#pragma unroll
    for (int k = 0; k < 31; ++k) w[k] = cw[k * 512];
    const float cb = F.in[I_CONVB][layer * 512 + tid];
    __syncthreads();
    for (int tt = 0; tt < 32; ++tt) { float a = cb;
#pragma unroll
        for (int k = 0; k < 31; ++k) a += w[k] * bf1(sin[(tt + k) * 512 + tid]);
        sout[tt * 512 + tid] = a; }
    __syncthreads();
    const float* lg = F.in[I_CLNG] + layer * 512 + F.lane * 8; const float* lb = F.in[I_CLNB] + layer * 512 + F.lane * 8;
    for (int tt = F.wave; tt < 32; tt += NWAVES) {
        float v[8]; float s = 0.f;
#pragma unroll
        for (int j = 0; j < 8; ++j) { v[j] = sout[tt * 512 + F.lane * 8 + j]; s += v[j]; }
        const float mu = wave_sum(s) * (1.0f / 512.0f); float q = 0.f;
#pragma unroll
        for (int j = 0; j < 8; ++j) { v[j] -= mu; q += v[j] * v[j]; }
        const float rstd = rsqrtf(wave_sum(q) * (1.0f / 512.0f) + EPS);
        float o[8];
#pragma unroll
        for (int j = 0; j < 8; ++j) o[j] = (ABL == 2) ? 0.f : siluf_(v[j] * rstd * lg[j] + lb[j]);
        u32x4 wv; wv.x = cvt_pk_bf16(o[0], o[1]); wv.y = cvt_pk_bf16(o[2], o[3]); wv.z = cvt_pk_bf16(o[4], o[5]); wv.w = cvt_pk_bf16(o[6], o[7]);
        *(u32x4*)((bf16_t*)(F.ws + WS_YC) + (size_t)(t0 + tt) * 512 + F.lane * 8) = wv;
    }
    __syncthreads();
}

__device__ __forceinline__ float log_sigmoid_(float v) { return fminf(v, 0.f) - log1pf(__expf(-fabsf(v))); }
__device__ __forceinline__ void qk_conv8(const Ctx& F, int layer, const bf16_t* src  , int t, int s, int ch  , int chq, float scale, float* o) {
    const float* cw = F.in[I_MCW] + (size_t)layer * 4 * 1024 + chq; const float* cb = F.in[I_MCB] + (size_t)layer * 1024 + chq;
#pragma unroll
    for (int j = 0; j < 8; ++j) o[j] = cb[j];
#pragma unroll
    for (int k = 0; k < 4; ++k) { if (s - 3 + k >= 0) { const u32x4 w = *(const u32x4*)(src + (size_t)(t - 3 + k) * 512 + ch); const float* wk = cw + k * 1024;
            o[0] += wk[0] * bf_lo(w.x); o[1] += wk[1] * bf_hi(w.x); o[2] += wk[2] * bf_lo(w.y); o[3] += wk[3] * bf_hi(w.y); o[4] += wk[4] * bf_lo(w.z); o[5] += wk[5] * bf_hi(w.z); o[6] += wk[6] * bf_lo(w.w); o[7] += wk[7] * bf_hi(w.w); } }
#pragma unroll
    for (int j = 0; j < 8; ++j) o[j] = siluf_(o[j]) * scale;
}
__device__ __forceinline__ void mlstm_scalars(const Ctx& F, int layer, int t0, int h, LAS float* sIG, LAS float* sBC) {
    if (F.tid < 128) { const float* IFp = (const float*)(F.ws + WS_IF) + (size_t)(t0 + F.tid) * 8;
        sIG[F.tid] = IFp[h] + F.in[I_MIB][layer * 4 + h]; sBC[F.tid] = log_sigmoid_(IFp[4 + h] + F.in[I_MFB][layer * 4 + h]); }
    __syncthreads();
    if (F.tid == 0) { float c = 0.f; for (int l = 0; l < 128; ++l) { c += sBC[l]; sBC[l] = c; } }
    __syncthreads();
}
__device__ __forceinline__ void mlstm_local_v1(const Ctx& F, int layer, int item) {
    const int c = item & 127, bh = item >> 7, h = bh & 3, b = bh >> 2, t0 = b * SEQ + c * 128, tid = F.tid;
    LAS float* EV = (LAS float*)F.lds;
    LAS float* KC = (LAS float*)(F.lds + 65536);
    LAS float* sIG = (LAS float*)(F.lds + 131072); LAS float* sBC = sIG + 128; LAS float* sE = sIG + 256; LAS float* sM = sIG + 384;
    mlstm_scalars(F, layer, t0, h, sIG, sBC);
    if (tid == 0) { const float gt = sBC[127]; float m = -INFINITY; for (int l = 0; l < 128; ++l) m = fmaxf(m, gt - sBC[l] + sIG[l]); sM[0] = m; sM[1] = gt; }
    __syncthreads();
    if (tid < 128) sE[tid] = __expf(sM[1] - sBC[tid] + sIG[tid] - sM[0]);
    __syncthreads();
    const bf16_t* KM = (const bf16_t*)(F.ws + WS_KM); const bf16_t* VM = (const bf16_t*)(F.ws + WS_VM);
    for (int i = tid; i < 128 * 16; i += NTHREADS) { const int l = i >> 4, c8 = (i & 15) * 8; const int t = t0 + l, s = t & (SEQ - 1);
        float o[8]; qk_conv8(F, layer, KM, t, s, h * 128 + c8, 512 + h * 128 + c8, 0.08838834764831845f, o);
#pragma unroll
        for (int j = 0; j < 8; ++j) KC[l * 128 + c8 + j] = o[j];
        const u32x4 w = *(const u32x4*)(VM + (size_t)t * 512 + h * 128 + c8); const float e = sE[l];
        EV[l * 128 + c8] = e * bf_lo(w.x); EV[l * 128 + c8 + 1] = e * bf_hi(w.x); EV[l * 128 + c8 + 2] = e * bf_lo(w.y); EV[l * 128 + c8 + 3] = e * bf_hi(w.y);
        EV[l * 128 + c8 + 4] = e * bf_lo(w.z); EV[l * 128 + c8 + 5] = e * bf_hi(w.z); EV[l * 128 + c8 + 6] = e * bf_lo(w.w); EV[l * 128 + c8 + 7] = e * bf_hi(w.w); }
    __syncthreads();
    { const int v = tid >> 2, kq = tid & 3; float a[32];
#pragma unroll
        for (int i = 0; i < 32; ++i) a[i] = 0.f;
#pragma unroll 1
        for (int l = 0; l < 128; ++l) { const float ev = EV[l * 128 + v];
#pragma unroll
            for (int i = 0; i < 32; ++i) a[i] += ev * KC[l * 128 + kq * 32 + i]; }
        bf16_t* Cp = (bf16_t*)(F.ws + WS_CST) + ((size_t)(bh * 128 + c) << 14) + v * 128 + kq * 32;
#pragma unroll
        for (int i = 0; i < 4; ++i) { u32x4 w; w.x = cvt_pk_bf16(a[8 * i], a[8 * i + 1]); w.y = cvt_pk_bf16(a[8 * i + 2], a[8 * i + 3]); w.z = cvt_pk_bf16(a[8 * i + 4], a[8 * i + 5]); w.w = cvt_pk_bf16(a[8 * i + 6], a[8 * i + 7]); ((u32x4*)Cp)[i] = w; } }
    if (tid < 128) { float n = 0.f; for (int l = 0; l < 128; ++l) n += sE[l] * KC[l * 128 + tid]; ((float*)(F.ws + WS_NST))[(size_t)(bh * 128 + c) * 128 + tid] = n; }
    if (tid == 0) { ((float*)(F.ws + WS_TAB + TAB_MLOC))[bh * 128 + c] = sM[0]; ((float*)(F.ws + WS_TAB + TAB_GTOT))[bh * 128 + c] = sM[1]; }
    __syncthreads();
}
constexpr int ML_KRS = 288, ML_ERS = 352, ML_E = 128 * ML_KRS, ML_S = ML_E + 128 * ML_ERS;
__device__ __forceinline__ void mlstm_local_mfma(const Ctx& F, int layer, int item) {
    const int c = item & 127, bh = item >> 7, h = bh & 3, b = bh >> 2, t0 = b * SEQ + c * 128, tid = F.tid, lane = F.lane, w = F.wave, fr = lane & 15, fq = lane >> 4;
    LAS unsigned char* L = F.lds;
    LAS float* sIG = (LAS float*)(L + ML_S); LAS float* sBC = sIG + 128; LAS float* sE = sIG + 256; LAS float* sM = sIG + 384;
    __syncthreads();
    mlstm_scalars(F, layer, t0, h, sIG, sBC);
    if (tid == 0) { const float gt = sBC[127]; float m = -INFINITY; for (int l = 0; l < 128; ++l) m = fmaxf(m, gt - sBC[l] + sIG[l]); sM[0] = m; sM[1] = gt; }
    __syncthreads();
    if (tid < 128) sE[tid] = __expf(sM[1] - sBC[tid] + sIG[tid] - sM[0]);
    __syncthreads();
    const bf16_t* KM = (const bf16_t*)(F.ws + WS_KM); const bf16_t* VM = (const bf16_t*)(F.ws + WS_VM);
    for (int i = tid; i < 128 * 16; i += NTHREADS) { const int l = i >> 4, c8 = (i & 15) * 8; const int t = t0 + l, s = t & (SEQ - 1);
        float o[8]; qk_conv8(F, layer, KM, t, s, h * 128 + c8, 512 + h * 128 + c8, 0.08838834764831845f, o);
        *(LAS u32x4*)(L + l * ML_KRS + c8 * 2) = pack8((f32x4){o[0], o[1], o[2], o[3]}, (f32x4){o[4], o[5], o[6], o[7]});
        f32x4 v0, v1; unpack8(*(const u32x4*)(VM + (size_t)t * 512 + h * 128 + c8), v0, v1); const float e = sE[l];
        *(LAS u32x4*)(L + ML_E + l * ML_ERS + c8 * 2) = pack8(v0 * e, v1 * e); }
    if (tid < 128) { u32x4 z; z.x = f2bf(sE[tid]); z.y = 0u; z.z = 0u; z.w = 0u; *(LAS u32x4*)(L + ML_E + tid * ML_ERS + 256) = z; z.x = 0u; *(LAS u32x4*)(L + ML_E + tid * ML_ERS + 272) = z; }
    __syncthreads();
    bf16x8 af[4];
#pragma unroll
    for (int ks = 0; ks < 4; ++ks) { const int ra = ks * 32 + 4 * fq + (fr >> 2);
        const s16x4 a0 = lds_tr16(L + ra * ML_KRS + (w * 16 + 4 * (fr & 3)) * 2), a1 = lds_tr16(L + (ra + 16) * ML_KRS + (w * 16 + 4 * (fr & 3)) * 2);
        af[ks] = (bf16x8){a0[0], a0[1], a0[2], a0[3], a1[0], a1[1], a1[2], a1[3]}; }
    bf16_t* Cp = (bf16_t*)(F.ws + WS_CST) + ((size_t)(bh * 128 + c) << 14);
#pragma unroll
    for (int vb = 0; vb < 9; ++vb) { f32x4 d = (f32x4){0.f, 0.f, 0.f, 0.f};
#pragma unroll
        for (int ks = 0; ks < 4; ++ks) { const int rb = ks * 32 + 4 * fq + (fr >> 2);
            const s16x4 b0 = lds_tr16(L + ML_E + rb * ML_ERS + (vb * 16 + 4 * (fr & 3)) * 2), b1 = lds_tr16(L + ML_E + (rb + 16) * ML_ERS + (vb * 16 + 4 * (fr & 3)) * 2);
            const bf16x8 bfr = (bf16x8){b0[0], b0[1], b0[2], b0[3], b1[0], b1[1], b1[2], b1[3]};
            d = __builtin_amdgcn_mfma_f32_16x16x32_bf16(af[ks], bfr, d, 0, 0, 0); }
        if (vb < 8) { u32x2 o; o.x = pk2(d[0], d[1]); o.y = pk2(d[2], d[3]); *(u32x2*)(Cp + (size_t)(vb * 16 + fr) * 128 + w * 16 + 4 * fq) = o; }
        else if (fr == 0) *(f32x4*)((float*)(F.ws + WS_NST) + (size_t)(bh * 128 + c) * 128 + w * 16 + 4 * fq) = d;
    }
    if (tid == 0) { ((float*)(F.ws + WS_TAB + TAB_MLOC))[bh * 128 + c] = sM[0]; ((float*)(F.ws + WS_TAB + TAB_GTOT))[bh * 128 + c] = sM[1]; }
}
__device__ __forceinline__ void phase_scan(const Ctx& F) {
    const float* GT = (const float*)(F.ws + WS_TAB + TAB_GTOT); const float* ML = (const float*)(F.ws + WS_TAB + TAB_MLOC); float* MS = (float*)(F.ws + WS_TAB + TAB_MST);
    for (int e = F.bid * NTHREADS + F.tid; e < 8 * 16384 + 8 * 128; e += F.G * NTHREADS) {
        const bool isC = e < 8 * 16384; const int bh = isC ? (e >> 14) : ((e - 8 * 16384) >> 7); const int idx = isC ? (e & 16383) : ((e - 8 * 16384) & 127);
        bf16_t* cp = (bf16_t*)(F.ws + WS_CST) + ((size_t)(bh * 128) << 14) + idx; float* np = (float*)(F.ws + WS_NST) + (size_t)(bh * 128) * 128 + idx;
        float mp = 0.f, val = 0.f;
        for (int c = 0; c < 128; ++c) {
            const float gc = GT[bh * 128 + c], ml = ML[bh * 128 + c]; const float mn = fmaxf(gc + mp, ml); const float a = __expf(gc + mp - mn), bb = __expf(ml - mn);
            if (isC) { bf16_t* p = cp + ((size_t)c << 14); const float loc = bf1(*p); *p = (bf16_t)f2bf(val); val = a * val + bb * loc; if (idx == 0) MS[bh * 128 + c] = mp; }
            else { float* p = np + (size_t)c * 128; const float loc = *p; *p = val; val = a * val + bb * loc; }
            mp = mn;
        }
    }
}
__device__ __forceinline__ void mlstm_out_v1(const Ctx& F, int layer, int item) {
    const int c = item & 127, bh = item >> 7, h = bh & 3, b = bh >> 2, t0 = b * SEQ + c * 128, tid = F.tid;
    constexpr int LS = 129;
    LAS float* bA = (LAS float*)F.lds;
    LAS float* bB = (LAS float*)(F.lds + 66560);
    LAS float* sIG = (LAS float*)(F.lds + 133120); LAS float* sBC = sIG + 128; LAS float* sMT = sIG + 256; LAS float* sSI = sIG + 384; LAS float* sNS = sIG + 512;
    mlstm_scalars(F, layer, t0, h, sIG, sBC);
    const float mst = ((const float*)(F.ws + WS_TAB + TAB_MST))[bh * 128 + c];
    if (tid == 0) { float pm = -INFINITY; for (int q = 0; q < 128; ++q) { pm = fmaxf(pm, sIG[q] - sBC[q]); const float ai = sBC[q] + mst; const float mt = fmaxf(ai, sBC[q] + pm); sMT[q] = mt; sSI[q] = __expf(ai - mt); } }
    if (tid < 128) sNS[tid] = ((const float*)(F.ws + WS_NST))[(size_t)(bh * 128 + c) * 128 + tid];
    const bf16_t* QM = (const bf16_t*)(F.ws + WS_QM); const bf16_t* KM = (const bf16_t*)(F.ws + WS_KM); const bf16_t* VM = (const bf16_t*)(F.ws + WS_VM);
    for (int i = tid; i < 128 * 16; i += NTHREADS) { const int l = i >> 4, c8 = (i & 15) * 8; const int t = t0 + l, s = t & (SEQ - 1); float o[8];
        qk_conv8(F, layer, QM, t, s, h * 128 + c8, h * 128 + c8, 1.0f, o);
#pragma unroll
        for (int j = 0; j < 8; ++j) bA[l * LS + c8 + j] = o[j];
        qk_conv8(F, layer, KM, t, s, h * 128 + c8, 512 + h * 128 + c8, 0.08838834764831845f, o);
#pragma unroll
        for (int j = 0; j < 8; ++j) bB[l * LS + c8 + j] = o[j]; }
    __syncthreads();
    const int q = tid >> 2, kq = tid & 3;
    float sc[32], inter[32];
#pragma unroll
    for (int i = 0; i < 32; ++i) sc[i] = 0.f;
#pragma unroll 1
    for (int d = 0; d < 128; ++d) { const float qv = bA[q * LS + d];
#pragma unroll
        for (int i = 0; i < 32; ++i) sc[i] += qv * bB[(4 * i + kq) * LS + d]; }
    float den = 0.f;
    { const float bq = sBC[q], mt = sMT[q];
#pragma unroll
        for (int i = 0; i < 32; ++i) { const int k = 4 * i + kq; const float w = (k <= q) ? __expf(bq - sBC[k] + sIG[k] - mt) : 0.f; sc[i] *= w; den += sc[i]; } }
    __syncthreads();
    { const bf16_t* Cp = (const bf16_t*)(F.ws + WS_CST) + ((size_t)(bh * 128 + c) << 14);
        for (int i = tid; i < 128 * 16; i += NTHREADS) { const int v = i >> 4, c8 = (i & 15) * 8; const u32x4 w = *(const u32x4*)(Cp + v * 128 + c8);
            bB[v * LS + c8] = bf_lo(w.x); bB[v * LS + c8 + 1] = bf_hi(w.x); bB[v * LS + c8 + 2] = bf_lo(w.y); bB[v * LS + c8 + 3] = bf_hi(w.y); bB[v * LS + c8 + 4] = bf_lo(w.z); bB[v * LS + c8 + 5] = bf_hi(w.z); bB[v * LS + c8 + 6] = bf_lo(w.w); bB[v * LS + c8 + 7] = bf_hi(w.w); } }
    __syncthreads();
#pragma unroll
    for (int i = 0; i < 32; ++i) inter[i] = 0.f;
    float dn = 0.f;
#pragma unroll 1
    for (int d = 0; d < 128; ++d) { const float qv = bA[q * LS + d];
#pragma unroll
        for (int i = 0; i < 32; ++i) inter[i] += qv * bB[(4 * i + kq) * LS + d];
        if ((d >> 5) == kq) dn += qv * sNS[d]; }
    __syncthreads();
#pragma unroll
    for (int i = 0; i < 32; ++i) bA[q * LS + 4 * i + kq] = sc[i];
    for (int i = tid; i < 128 * 16; i += NTHREADS) { const int l = i >> 4, c8 = (i & 15) * 8; const u32x4 w = *(const u32x4*)(VM + (size_t)(t0 + l) * 512 + h * 128 + c8);
        bB[l * LS + c8] = bf_lo(w.x); bB[l * LS + c8 + 1] = bf_hi(w.x); bB[l * LS + c8 + 2] = bf_lo(w.y); bB[l * LS + c8 + 3] = bf_hi(w.y); bB[l * LS + c8 + 4] = bf_lo(w.z); bB[l * LS + c8 + 5] = bf_hi(w.z); bB[l * LS + c8 + 6] = bf_lo(w.w); bB[l * LS + c8 + 7] = bf_hi(w.w); }
    __syncthreads();
    float num[32];
#pragma unroll
    for (int i = 0; i < 32; ++i) num[i] = 0.f;
#pragma unroll 1
    for (int k = 0; k < 128; ++k) { const float sv = bA[q * LS + k];
#pragma unroll
        for (int i = 0; i < 32; ++i) num[i] += sv * bB[k * LS + 4 * i + kq]; }
    den += __shfl_xor(den, 1); den += __shfl_xor(den, 2); dn += __shfl_xor(dn, 1); dn += __shfl_xor(dn, 2);
    const float si = sSI[q]; const float dd = den + si * dn; const float inv = (ABL == 3) ? 0.f : 1.0f / fmaxf(fabsf(dd), __expf(-sMT[q]));
    bf16_t* OM = (bf16_t*)(F.ws + WS_OM) + (size_t)(t0 + q) * 512 + h * 128;
#pragma unroll
    for (int i = 0; i < 32; ++i) { const int v = 4 * i + kq; const float hv = (num[i] + si * inter[i]) * inv; OM[v] = (bf16_t)f2bf(bf1(OM[v]) * hv); }
    __syncthreads();
}

constexpr int MO_RS = 272, MO_VRS = 288;
constexpr int MO_Q = 0, MO_K = 128 * MO_RS, MO_C = 2 * 128 * MO_RS, MO_V = MO_C + 144 * MO_RS, MO_S = MO_V + 128 * MO_VRS;
static_assert(MO_S + 2560 <= MISC_OFF, "mlstm_out LDS");
__device__ __forceinline__ void mlstm_out_mfma(const Ctx& F, int layer, int item) {
    const int c = item & 127, bh = item >> 7, h = bh & 3, b = bh >> 2, t0 = b * SEQ + c * 128, tid = F.tid, lane = F.lane, w = F.wave, fr = lane & 15, fq = lane >> 4;
    LAS unsigned char* L = F.lds;
    LAS float* sIG = (LAS float*)(L + MO_S); LAS float* sBC = sIG + 128; LAS float* sMT = sIG + 256; LAS float* sSI = sIG + 384;
    __syncthreads();
    mlstm_scalars(F, layer, t0, h, sIG, sBC);
    const float mst = ((const float*)(F.ws + WS_TAB + TAB_MST))[bh * 128 + c];
    if (tid == 0) { float pm = -INFINITY; for (int q = 0; q < 128; ++q) { pm = fmaxf(pm, sIG[q] - sBC[q]); const float ai = sBC[q] + mst; const float mt = fmaxf(ai, sBC[q] + pm); sMT[q] = mt; sSI[q] = __expf(ai - mt); } }
    const bf16_t* QM = (const bf16_t*)(F.ws + WS_QM); const bf16_t* KM = (const bf16_t*)(F.ws + WS_KM); const bf16_t* VM = (const bf16_t*)(F.ws + WS_VM);
    const bf16_t* Cp = (const bf16_t*)(F.ws + WS_CST) + ((size_t)(bh * 128 + c) << 14);
    for (int i = tid; i < 128 * 16; i += NTHREADS) { const int l = i >> 4, c8 = (i & 15) * 8; const int t = t0 + l, s = t & (SEQ - 1); float o[8];
        qk_conv8(F, layer, QM, t, s, h * 128 + c8, h * 128 + c8, 1.0f, o);
        *(LAS u32x4*)(L + MO_Q + l * MO_RS + c8 * 2) = pack8((f32x4){o[0], o[1], o[2], o[3]}, (f32x4){o[4], o[5], o[6], o[7]});
        qk_conv8(F, layer, KM, t, s, h * 128 + c8, 512 + h * 128 + c8, 0.08838834764831845f, o);
        *(LAS u32x4*)(L + MO_K + l * MO_RS + c8 * 2) = pack8((f32x4){o[0], o[1], o[2], o[3]}, (f32x4){o[4], o[5], o[6], o[7]});
        *(LAS u32x4*)(L + MO_V + l * MO_VRS + c8 * 2) = *(const u32x4*)(VM + (size_t)t * 512 + h * 128 + c8);
        *(LAS u32x4*)(L + MO_C + l * MO_RS + c8 * 2) = *(const u32x4*)(Cp + l * 128 + c8); }
    if (tid < 16) { const float* np = (const float*)(F.ws + WS_NST) + (size_t)(bh * 128 + c) * 128 + tid * 8;
        *(LAS u32x4*)(L + MO_C + 128 * MO_RS + tid * 16) = pack8(*(const f32x4*)np, *(const f32x4*)(np + 4)); }
    __syncthreads();
    const int q = 16 * w + fr;
    bf16x8 qf[4];
#pragma unroll
    for (int ks = 0; ks < 4; ++ks) qf[ks] = *(const LAS bf16x8*)(L + MO_Q + q * MO_RS + ks * 64 + fq * 16);
    f32x4 O[9];
#pragma unroll
    for (int vb = 0; vb < 9; ++vb) { f32x4 a = (f32x4){0.f, 0.f, 0.f, 0.f};
#pragma unroll
        for (int ks = 0; ks < 4; ++ks) { const bf16x8 cf = *(const LAS bf16x8*)(L + MO_C + (vb * 16 + fr) * MO_RS + ks * 64 + fq * 16); a = __builtin_amdgcn_mfma_f32_16x16x32_bf16(cf, qf[ks], a, 0, 0, 0); }
        O[vb] = a; }
    const float si = sSI[q], mt = sMT[q], bq = sBC[q];
    const float dn = __shfl(O[8][0], fr);
#pragma unroll
    for (int vb = 0; vb < 8; ++vb) O[vb] = O[vb] * si;
    float den = 0.f;
    for (int k2 = 0; k2 <= (w >> 1); ++k2) {
        f32x4 P[2];
#pragma unroll
        for (int u = 0; u < 2; ++u) { const int kb = 2 * k2 + u; f32x4 a = (f32x4){0.f, 0.f, 0.f, 0.f};
            const int kr = (kb > 7 ? 7 : kb) * 16 + fr;
#pragma unroll
            for (int ks = 0; ks < 4; ++ks) { const bf16x8 kf = *(const LAS bf16x8*)(L + MO_K + kr * MO_RS + ks * 64 + fq * 16); a = __builtin_amdgcn_mfma_f32_16x16x32_bf16(kf, qf[ks], a, 0, 0, 0); }
#pragma unroll
            for (int j = 0; j < 4; ++j) { const int k = kb * 16 + 4 * fq + j; const int kc = k > 127 ? 127 : k; const float wgt = (k <= q) ? __expf(bq - sBC[kc] + sIG[kc] - mt) : 0.f; a[j] *= wgt; den += a[j]; }
            P[u] = a; }
        u32x4 pw; pw.x = cvt_pk_bf16(P[0][0], P[0][1]); pw.y = cvt_pk_bf16(P[0][2], P[0][3]); pw.z = cvt_pk_bf16(P[1][0], P[1][1]); pw.w = cvt_pk_bf16(P[1][2], P[1][3]);
        const bf16x8 pf = __builtin_bit_cast(bf16x8, pw);
        const int kb1 = (2 * k2 + 1 > 7) ? 7 : 2 * k2 + 1;
        const int r0 = 2 * k2 * 16 + 4 * fq + (fr >> 2), r1 = kb1 * 16 + 4 * fq + (fr >> 2);
#pragma unroll
        for (int vb = 0; vb < 8; ++vb) {
            const s16x4 v0 = lds_tr16(L + MO_V + r0 * MO_VRS + (vb * 16 + 4 * (fr & 3)) * 2), v1 = lds_tr16(L + MO_V + r1 * MO_VRS + (vb * 16 + 4 * (fr & 3)) * 2);
            const bf16x8 vf = (bf16x8){v0[0], v0[1], v0[2], v0[3], v1[0], v1[1], v1[2], v1[3]};
            O[vb] = __builtin_amdgcn_mfma_f32_16x16x32_bf16(vf, pf, O[vb], 0, 0, 0);
        }
    }
    den += __shfl_xor(den, 16); den += __shfl_xor(den, 32);
    const float dd = den + si * dn; const float inv = 1.0f / fmaxf(fabsf(dd), __expf(-mt));
    bf16_t* OM = (bf16_t*)(F.ws + WS_OM) + (size_t)(t0 + q) * 512 + h * 128;
#pragma unroll
    for (int vb = 0; vb < 8; ++vb) { u32x2* p = (u32x2*)(OM + vb * 16 + 4 * fq); const u32x2 g = *p;
        u32x2 o; o.x = cvt_pk_bf16(bf_lo(g.x) * O[vb][0] * inv, bf_hi(g.x) * O[vb][1] * inv); o.y = cvt_pk_bf16(bf_lo(g.y) * O[vb][2] * inv, bf_hi(g.y) * O[vb][3] * inv); *p = o; }
}

__device__ __forceinline__ void phase_route(const Ctx& F, int layer) {
    int* tokl = (int*)(F.ws + WS_LISTS);
    for (int i = F.bid * NTHREADS + F.tid; i < 2 * LISTCAP; i += F.G * NTHREADS) tokl[i] = -1;
    LAS int* hist = (LAS int*)F.lds;
    const float* brg = F.in[I_BRG] + layer * 4; const float* bre = F.in[I_BRE] + layer * 32;
    for (int tile = F.bid; tile < 256; tile += F.G) {
        if (F.tid < 128) { const int t = tile * 128 + F.tid; const float* lg = (const float*)(F.ws + WS_LOGITS) + (size_t)t * 64;
            float g[4]; int gs = 0; float gm;
#pragma unroll
            for (int j = 0; j < 4; ++j) g[j] = lg[j] + brg[j];
            gm = g[0];
#pragma unroll
            for (int j = 1; j < 4; ++j) if (g[j] > gm) { gm = g[j]; gs = j; }
            float se = 0.f;
#pragma unroll
            for (int j = 0; j < 4; ++j) se += __expf(g[j] - gm);
            const float pg = 1.0f / se;
            float le[8];
#pragma unroll
            for (int j = 0; j < 8; ++j) le[j] = lg[4 + gs * 8 + j] + bre[gs * 8 + j];
            int i0 = 0; float v0 = le[0];
#pragma unroll
            for (int j = 1; j < 8; ++j) if (le[j] > v0) { v0 = le[j]; i0 = j; }
            int i1 = -1; float v1 = -INFINITY;
#pragma unroll
            for (int j = 0; j < 8; ++j) if (j != i0 && le[j] > v1) { v1 = le[j]; i1 = j; }
            const float e1 = __expf(v1 - v0); const float wsc = (ABL == 4) ? 0.f : ((ABL == 6) ? 2.f : 1.f); const float w0 = wsc * pg / (1.0f + e1), w1 = wsc * pg * e1 / (1.0f + e1);
            const int x0 = gs * 8 + i0, x1 = gs * 8 + i1;
            ((int*)(F.ws + WS_ROUTE))[2 * t] = x0; ((int*)(F.ws + WS_ROUTE))[2 * t + 1] = x1;
            ((float*)(F.ws + WS_ROUTE))[2 * T + 2 * t] = w0; ((float*)(F.ws + WS_ROUTE))[2 * T + 2 * t + 1] = w1;
            hist[F.tid] = x0; hist[128 + F.tid] = x1;
        }
        __syncthreads();
        if (F.tid < 64) { const int k = F.tid >> 5, e = F.tid & 31; int cnt = 0; for (int j = 0; j < 128; ++j) cnt += (hist[k * 128 + j] == e) ? 1 : 0; ((int*)(F.ws + WS_TAB + TAB_CNT))[tile * 64 + F.tid] = cnt; }
        __syncthreads();
    }
}
__device__ __forceinline__ void phase_dispatch(const Ctx& F) {
    LAS int* sTot = (LAS int*)F.lds; LAS int* sBef = sTot + 64; LAS int* sPs = sTot + 128; LAS int* sE = sTot + 256;
    const int* CNT = (const int*)(F.ws + WS_TAB + TAB_CNT); int* META = (int*)(F.ws + WS_TAB + TAB_META);
    int* tokl = (int*)(F.ws + WS_LISTS); float* wl = (float*)(F.ws + WS_LISTS) + 2 * LISTCAP;
    for (int tile = F.bid; tile < 256; tile += F.G) {
        if (F.tid < 64) { int tot = 0, bef = 0; for (int j = 0; j < 256; ++j) { const int v = CNT[j * 64 + F.tid]; tot += v; bef += (j < tile) ? v : 0; } sTot[F.tid] = tot; sBef[F.tid] = bef; }
        __syncthreads();
        if (F.tid < 2) { int ps = 0; for (int e = 0; e < 32; ++e) { sPs[F.tid * 33 + e] = ps; ps += ((sTot[F.tid * 32 + e] + 255) >> 8) << 8; } sPs[F.tid * 33 + 32] = ps;
            if (tile == 0) { META[F.tid] = ps >> 8; for (int e = 0; e <= 32; ++e) META[16 + 64 * F.tid + e] = sPs[F.tid * 33 + e]; } }
        int e0 = 0, e1 = 0; float w0 = 0.f, w1 = 0.f;
        if (F.tid < 128) { const int t = tile * 128 + F.tid; e0 = ((const int*)(F.ws + WS_ROUTE))[2 * t]; e1 = ((const int*)(F.ws + WS_ROUTE))[2 * t + 1];
            w0 = ((const float*)(F.ws + WS_ROUTE))[2 * T + 2 * t]; w1 = ((const float*)(F.ws + WS_ROUTE))[2 * T + 2 * t + 1]; sE[F.tid] = e0; sE[128 + F.tid] = e1; }
        __syncthreads();
        if (F.tid < 128) { int r0 = 0, r1 = 0; for (int j = 0; j < F.tid; ++j) { r0 += (sE[j] == e0) ? 1 : 0; r1 += (sE[128 + j] == e1) ? 1 : 0; }
            const int p0 = sPs[e0] + sBef[e0] + r0, p1 = sPs[33 + e1] + sBef[32 + e1] + r1;
            tokl[p0] = tile * 128 + F.tid; wl[p0] = w0; tokl[LISTCAP + p1] = tile * 128 + F.tid; wl[LISTCAP + p1] = w1; }
        __syncthreads();
    }
}
__device__ __forceinline__ void phase_final(const Ctx& F, const float* SS) {
    const int gw = F.bid * NWAVES + F.wave, NGW = F.G * NWAVES, lane = F.lane;
    for (int m = gw; m < T; m += NGW) { const float rs = row_rs(SS, m); f32x4* o = (f32x4*)(F.out + (size_t)m * D) + lane; const f32x4* g = (const f32x4*)F.in[I_GFIN] + lane;
#pragma unroll
        for (int j = 0; j < 4; ++j) o[64 * j] = o[64 * j] * rs * g[64 * j]; }
}

constexpr int PH_PER_LAYER = 15, PH_FINAL = DEPTH * PH_PER_LAYER, N_PHASES = PH_FINAL + 1;
struct Args { const float* in[28]; float* out; unsigned char* ws; int ph_lo, ph_hi; };

__device__ __forceinline__ Ctx mkctx(const Args& args, LAS unsigned char* lds, int wave_s) {
    Ctx F; asm volatile("" : "+s"(wave_s)); int tid = wave_s * 64 + lane_id_(); asm volatile("" : "+v"(tid));
    unsigned char* ws = args.ws; asm volatile("" : "+s"(ws)); float* outp = args.out; asm volatile("" : "+s"(outp));
    int bid = blockIdx.x; asm volatile("" : "+s"(bid)); int G = gridDim.x; asm volatile("" : "+s"(G));
    F.in = args.in; F.out = outp; F.ws = ws; F.lds = lds;
    F.tid = tid; F.lane = tid & 63; F.wave = wave_s; F.G = G; F.bid = bid;
    return F;
}
#ifndef ONLY_PHASE
#define ONLY_PHASE -1
#endif
__device__ __forceinline__ void run_phase(const Args& args, LAS unsigned char* lds, int ph, int wave_s) {
    const int layer = ph / PH_PER_LAYER, lp = ph - layer * PH_PER_LAYER;
    const size_t ssin = (layer & 1) ? WS_SS1 : WS_SS0, ssmid = (layer & 1) ? WS_SS0 : WS_SS1;
    if (ph == PH_FINAL) { const Ctx F = mkctx(args, lds, wave_s); phase_final(F, (const float*)(F.ws + WS_SS0)); return; }
    if (ONLY_PHASE >= 0 && lp != ONLY_PHASE) return;
    switch (lp) {
    case 0: { const Ctx F = mkctx(args, lds, wave_s); phase_prep(F, layer, (float*)(F.ws + ssin)); } break;
    case 1: { const Ctx F = mkctx(args, lds, wave_s); PhProj P{(const char*)F.ws + WS_XB, (const char*)F.ws + WS_WIN, (const float*)(F.ws + ssin), F.ws, F.G, F.bid}; pg8::gemm_phase(F.lds, P, F.tid); } break;
    case 2: { const Ctx F = mkctx(args, lds, wave_s);
        for (int it = F.bid; it < 768; it += F.G) attn_strip(F, it);
        __syncthreads();
        for (int it = F.bid; it < 1024; it += F.G) mlstm_local_mfma(F, layer, it);
        for (int it = F.bid; it < 1024; it += F.G) conv_item_v1(F, layer, it);
    } break;
    case 3: { const Ctx F = mkctx(args, lds, wave_s); phase_scan(F); attn_combine(F); } break;
    case 4: { const Ctx F = mkctx(args, lds, wave_s); for (int it = F.bid; it < 1024; it += F.G) mlstm_out_mfma(F, layer, it); } break;
    case 5: { const Ctx F = mkctx(args, lds, wave_s); PhGates P{(const char*)F.ws + WS_XB, (const char*)F.ws + WS_WIN, (const float*)(F.ws + ssin), F.ws, F.G, F.bid}; pg8::gemm_phase(F.lds, P, F.tid); } break;
    case 6: { const Ctx F = mkctx(args, lds, wave_s); PhMerge P{F.ws, F.G, F.bid}; pg8::gemm_phase(F.lds, P, F.tid); } break;
    case 7: { const Ctx F = mkctx(args, lds, wave_s); PhOut P{F.ws, F.out, (float*)(F.ws + ssmid), F.G, F.bid}; pg8::gemm_phase(F.lds, P, F.tid); } break;
    case 8: { const Ctx F = mkctx(args, lds, wave_s); PhRouter P{F.ws, (const float*)(F.ws + ssmid), F.G, F.bid}; pg8::gemm_phase(F.lds, P, F.tid); phase_prep_experts(F, layer); } break;
    case 9: { const Ctx F = mkctx(args, lds, wave_s); phase_route(F, layer); } break;
    case 10: { const Ctx F = mkctx(args, lds, wave_s); phase_dispatch(F); } break;
    case 11: { const Ctx F = mkctx(args, lds, wave_s); PhUp P{F.ws, (const float*)(F.ws + ssmid), (const int*)(F.ws + WS_TAB + TAB_META), (const int*)(F.ws + WS_LISTS), F.G, F.bid}; pg8::gemm_phase(F.lds, P, F.tid); } break;
    case 12: { const Ctx F = mkctx(args, lds, wave_s); PhDown<1> P{F.ws, F.out, (float*)(F.ws + ssin), (const int*)(F.ws + WS_TAB + TAB_META), (const int*)(F.ws + WS_LISTS), (const float*)(F.ws + WS_LISTS) + 2 * LISTCAP, F.G, F.bid}; pg8::gemm_phase(F.lds, P, F.tid); } break;
    case 13: { const Ctx F = mkctx(args, lds, wave_s); PhDown<0> P{F.ws, F.out, (float*)(F.ws + ssin), (const int*)(F.ws + WS_TAB + TAB_META), (const int*)(F.ws + WS_LISTS), (const float*)(F.ws + WS_LISTS) + 2 * LISTCAP, F.G, F.bid}; pg8::gemm_phase(F.lds, P, F.tid); } break;
    case 14: { const Ctx F = mkctx(args, lds, wave_s); PhPle P{F.ws, F.out, (const float*)(F.ws + ssin), (float*)(F.ws + ssmid), F.G, F.bid}; pg8::gemm_phase(F.lds, P, F.tid); } break;
    }
}

__global__ void __launch_bounds__(NTHREADS, 2) fwd_kernel(Args args) {
    extern __shared__ __attribute__((aligned(16))) unsigned char lds_raw[];
    LAS unsigned char* lds = (LAS unsigned char*)lds_raw;
    volatile LAS unsigned* MISC = (volatile LAS unsigned*)(lds + MISC_OFF);
    const int wave_s = __builtin_amdgcn_readfirstlane((int)threadIdx.x >> 6);
    if (wave_s == 0) MISC[lane_id_()] = 0u;
    __syncthreads();
#if MK_MEGA
    XcdBarrier bar = xcd_barrier_post((unsigned*)(args.ws + WS_CTL) + 4096, MISC + 8, wave_s);
#endif
#ifndef PROBE_SEL
#define PROBE_SEL 0
#endif
    unsigned long long extra = 0ull;
    for (int ph = args.ph_lo; ph < args.ph_hi; ++ph) {
        const unsigned long long t0 = PROBE_SEL ? __builtin_amdgcn_s_memrealtime() : 0ull;
        run_phase(args, lds, ph, wave_s);
#if MK_MEGA
        if (ph + 1 < args.ph_hi) xcd_barrier(bar);
#endif
        if (PROBE_SEL) { const int lp = ph % PH_PER_LAYER; if (ph < PH_FINAL && ((PROBE_SEL >> lp) & 1)) extra += __builtin_amdgcn_s_memrealtime() - t0; }
    }
    if (PROBE_SEL && blockIdx.x == 0) { const unsigned long long te = __builtin_amdgcn_s_memrealtime(); while (__builtin_amdgcn_s_memrealtime() - te < extra) __builtin_amdgcn_s_sleep(8); }
}

extern "C" void kernel_launch(void* const* d_in, const int* in_sizes, int n_in, void* d_out, int out_size, void* d_ws, size_t ws_size, hipStream_t stream) {
    static int grid = 0;
    if (grid == 0) {
        if (n_in != 28 || out_size != T * D || ws_size < WS_END) { fprintf(stderr, "kernel_launch: unexpected shapes (n_in %d out %d ws %zu, need %zu)\n", n_in, out_size, ws_size, (size_t)WS_END); grid = -1; return; }
        int dev = 0, cus = 0, per_cu = 0;
        if (hipGetDevice(&dev) != hipSuccess || hipDeviceGetAttribute(&cus, hipDeviceAttributeMultiprocessorCount, dev) != hipSuccess) { grid = -1; return; }
        if (hipFuncSetAttribute((const void*)fwd_kernel, hipFuncAttributeMaxDynamicSharedMemorySize, LDS_BYTES) != hipSuccess) { fprintf(stderr, "kernel_launch: hipFuncSetAttribute failed\n"); grid = -1; return; }
        if (hipOccupancyMaxActiveBlocksPerMultiprocessor(&per_cu, (const void*)fwd_kernel, NTHREADS, LDS_BYTES) != hipSuccess || per_cu < 1) { fprintf(stderr, "kernel_launch: occupancy query says %d blocks per CU\n", per_cu); }
        (void)hipGetLastError();
        grid = cus;
    }
    if (grid < 0) return;
    Args a{};
    for (int i = 0; i < 28; ++i) a.in[i] = (const float*)d_in[i];
    a.out = (float*)d_out; a.ws = (unsigned char*)d_ws;
#if MK_MEGA
    (void)hipMemsetAsync((char*)d_ws + WS_CTL, 0, CTL_ZERO_BYTES, stream);
    a.ph_lo = 0; a.ph_hi = N_PHASES;
    hipLaunchKernelGGL(fwd_kernel, dim3(grid), dim3(NTHREADS), LDS_BYTES, stream, a);
#else
    for (int ph = 0; ph < N_PHASES; ++ph) { a.ph_lo = ph; a.ph_hi = ph + 1; hipLaunchKernelGGL(fwd_kernel, dim3(grid), dim3(NTHREADS), LDS_BYTES, stream, a); }
#endif
}
```

```cpp
#include <hip/hip_runtime.h>
#include <cstdio>
#include <cstdint>

#ifndef MK_MEGA
#define MK_MEGA 1
#endif

#ifndef ABL
#define ABL 0
#endif
#define LAS __attribute__((address_space(3)))
#define GAS __attribute__((address_space(1)))
typedef unsigned short bf16_t;
typedef short bf16x8 __attribute__((ext_vector_type(8)));
typedef float f32x4 __attribute__((ext_vector_type(4)));
typedef float f32x2 __attribute__((ext_vector_type(2)));
typedef unsigned u32x4 __attribute__((ext_vector_type(4)));
typedef unsigned u32x2 __attribute__((ext_vector_type(2)));

constexpr int T = 32768, SEQ = 16384, D = 1024, DEPTH = 2;
constexpr int D_IN = 8712;
constexpr float EPS = 1e-6f;
constexpr int NTHREADS = 512, NWAVES = 8;
constexpr int LISTCAP = 40960;

constexpr size_t MiB = 1u << 20;
constexpr size_t WS_CTL = 0, CTL_ZERO_BYTES = 1 * MiB;
constexpr size_t WS_TAB = 1 * MiB;
constexpr size_t WS_ROUTE = 2 * MiB;
constexpr size_t WS_LISTS = 3 * MiB;
constexpr size_t WS_SS0 = 4 * MiB, WS_SS1 = 6 * MiB;
constexpr size_t WS_IF = 8 * MiB;
constexpr size_t WS_NST = 9 * MiB;
constexpr size_t WS_LOGITS = 10 * MiB;
constexpr size_t WS_WIN = 18 * MiB;
constexpr size_t WS_WBR = WS_WIN + 8960ull * 1024 * 2;
constexpr size_t WS_WOUT = WS_WBR + 3ull * 1024 * 512 * 2;
constexpr size_t WS_WPG = WS_WOUT + 1024ull * 1024 * 2;
constexpr size_t WS_WPP = WS_WPG + 1024ull * 1024 * 2;
constexpr size_t WS_WR = WS_WPP + 1024ull * 256 * 2;
static_assert(WS_WR + 256ull * 1024 * 2 <= 44 * MiB, "small weights");
constexpr size_t WS_XB = 44 * MiB;
constexpr size_t WS_QA0 = 108 * MiB;
constexpr size_t WS_YATT = WS_QA0;
constexpr size_t WS_OM = 140 * MiB;
constexpr size_t WS_YC = 172 * MiB;
constexpr size_t WS_CST = 204 * MiB;
constexpr size_t WS_B = 236 * MiB;
constexpr size_t WS_KA = WS_B, WS_QA1 = WS_B + 32 * MiB, WS_QA2 = WS_B + 64 * MiB, WS_VA = WS_B + 96 * MiB, WS_YG = WS_B + 128 * MiB, WS_QM = WS_B + 160 * MiB, WS_KM = WS_B + 192 * MiB, WS_VM = WS_B + 224 * MiB;
constexpr size_t WS_G0 = WS_B, WS_MERGED = WS_B + 192 * MiB;
constexpr size_t WS_WEXP = WS_B, WS_HB = WS_B + 48 * MiB, WS_PBF = WS_B + 88 * MiB, WS_PE = WS_B + 104 * MiB, WS_YB1 = WS_B + 168 * MiB, WS_XBT = WS_B;
constexpr size_t WS_END = 492 * MiB;
constexpr size_t TAB_CNT = 0;
constexpr size_t TAB_META = 65536;
constexpr size_t TAB_MLOC = 131072, TAB_GTOT = 131072 + 4096, TAB_MST = 131072 + 8192;

constexpr int RING_BYTES = 131072;
constexpr int MISC_OFF = 155648;
constexpr int LDS_BYTES = 156672;

__device__ __forceinline__ unsigned f2bf(float f) { unsigned u = __builtin_bit_cast(unsigned, f); return (u + 0x7fffu + ((u >> 16) & 1u)) >> 16; }
__device__ __forceinline__ unsigned pk2(float lo, float hi) { return f2bf(lo) | (f2bf(hi) << 16); }
__device__ __forceinline__ unsigned cvt_pk_bf16(float lo, float hi) { unsigned r; asm volatile("v_cvt_pk_bf16_f32 %0, %1, %2" : "=v"(r) : "v"(lo), "v"(hi)); return r; }
__device__ __forceinline__ float bf_lo(unsigned w) { return __builtin_bit_cast(float, w << 16); }
__device__ __forceinline__ float bf_hi(unsigned w) { return __builtin_bit_cast(float, w & 0xffff0000u); }
__device__ __forceinline__ float bf1(bf16_t h) { return __builtin_bit_cast(float, ((unsigned)h) << 16); }
__device__ __forceinline__ float sigmoidf_(float v) { return 1.0f / (1.0f + __expf(-v)); }
__device__ __forceinline__ float siluf_(float v) { return v / (1.0f + __expf(-v)); }
__device__ __forceinline__ float wave_sum(float v) {
#pragma unroll
    for (int o = 1; o < 64; o <<= 1) v += __shfl_xor(v, o);
    return v;
}
__device__ __forceinline__ float wave_max(float v) {
#pragma unroll
    for (int o = 1; o < 64; o <<= 1) v = fmaxf(v, __shfl_xor(v, o));
    return v;
}
__device__ __forceinline__ int lane_id_() { int l; asm volatile("v_mbcnt_lo_u32_b32 %0, -1, 0\n\tv_mbcnt_hi_u32_b32 %0, -1, %0" : "=&v"(l)); return l; }
#define LDS_WAIT() asm volatile("s_waitcnt lgkmcnt(0)" ::: "memory")
#define VM_WAIT() asm volatile("s_waitcnt vmcnt(0)" ::: "memory")

#define XB_TMO      128
#define XB_XCNT(j)  (256  + 64 * (j))
#define XB_XSUB(j)  (1280 + 64 * (j))
#define XB_XGEN(j)  (2304 + 64 * (j))
#define XB_TOP      3328
#define XB_TOPGEN   3392
#define XCD_BAR_WORDS 3456
#define XB_SPIN_CAP (1u << 22)
__device__ __forceinline__ unsigned xb_ld(unsigned* p)              { return __hip_atomic_load(p, __ATOMIC_RELAXED, __HIP_MEMORY_SCOPE_AGENT); }
__device__ __forceinline__ unsigned xb_add(unsigned* p, unsigned v) { return __hip_atomic_fetch_add(p, v, __ATOMIC_RELAXED, __HIP_MEMORY_SCOPE_AGENT); }
__device__ __forceinline__ unsigned xb_xcc_id() { return (unsigned)__builtin_amdgcn_s_getreg((3 << 11) | 20) & 0xFu; }
#define XB_SPIN(cond, bar) do { unsigned _sp = 0; while (cond) { __builtin_amdgcn_s_sleep(1); \
    if ((++_sp & 255u) == 0u) { if (xb_ld(&(bar)[XB_TMO])) break; if (_sp > XB_SPIN_CAP) { atomicAdd(&(bar)[XB_TMO], 1u); break; } } } } while (0)
struct XcdBarrier { unsigned* bar; unsigned x; volatile LAS unsigned* st; int wave; };
__device__ __forceinline__ XcdBarrier xcd_barrier_post(unsigned* bar, volatile LAS unsigned* st, int wave) {
    XcdBarrier b; b.bar = bar; b.x = xb_xcc_id(); b.st = st; b.wave = wave;
    if (wave == 0 && lane_id_() == 0) (void)xb_add(&bar[XB_XCNT(b.x)], 1u);
    return b;
}
__device__ __forceinline__ void xcd_barrier_complete(unsigned* bar, unsigned x, unsigned& nloc, unsigned& nx) {
    const unsigned G = gridDim.x * gridDim.y * gridDim.z;
    unsigned sum, cnt, mine, sp = 0u;
    for (;;) {
        sum = 0u; cnt = 0u; mine = 0u;
#pragma unroll
        for (unsigned j = 0; j < 16; ++j) { const unsigned c = xb_ld(&bar[XB_XCNT(j)]); sum += c; cnt += (c > 0u) ? 1u : 0u; mine = (j == x) ? c : mine; }
        if (sum == G) break;
        __builtin_amdgcn_s_sleep(1);
        if ((++sp & 255u) == 0u) { if (xb_ld(&bar[XB_TMO])) break; if (sp > XB_SPIN_CAP) { atomicAdd(&bar[XB_TMO], 1u); break; } }
    }
    nloc = mine > 0u ? mine : 1u; nx = cnt > 0u ? cnt : 1u;
}
__device__ __forceinline__ void xcd_barrier(const XcdBarrier& b) {
    asm volatile("s_waitcnt vmcnt(0)" ::: "memory");
    __syncthreads();
    if (b.wave == 0 && lane_id_() == 0) {
        unsigned* bar = b.bar;
        __builtin_amdgcn_s_waitcnt(0);
        unsigned nloc = b.st[0], nx = b.st[1];
        if (nloc == 0u) { xcd_barrier_complete(bar, b.x, nloc, nx); b.st[0] = nloc; b.st[1] = nx; }
        const unsigned old = xb_add(&bar[XB_XSUB(b.x)], 1u);
        const unsigned gen = old / nloc;
        if (old + 1u == (gen + 1u) * nloc) {
            __builtin_amdgcn_fence(__ATOMIC_RELEASE, "agent");
            asm volatile("s_waitcnt vmcnt(0)" ::: "memory");
            const unsigned og = xb_add(&bar[XB_TOP], 1u);
            const unsigned tg = og / nx;
            if (og + 1u == (tg + 1u) * nx) xb_add(&bar[XB_TOPGEN], 1u);
            else XB_SPIN(xb_ld(&bar[XB_TOPGEN]) == tg, bar);
            __builtin_amdgcn_fence(__ATOMIC_ACQUIRE, "agent");
            xb_add(&bar[XB_XGEN(b.x)], 1u);
            asm volatile("s_waitcnt vmcnt(0)" ::: "memory");
        } else {
            XB_SPIN(xb_ld(&bar[XB_XGEN(b.x)]) == gen, bar);
            __builtin_amdgcn_fence(__ATOMIC_ACQUIRE, "agent");
            asm volatile("s_waitcnt vmcnt(0)" ::: "memory");
        }
    }
    __syncthreads();
}

namespace pg8 {
constexpr int BM = 256, BK = 64, HALF = 128, HTB = HALF * BK * 2, NXCD = 8, WGM = 8;
__device__ __forceinline__ int lds_byte(int r, int c) { const int st = (r >> 4) * 2 + (c >> 5), rr = r & 15, cc = c & 31, ob = rr * 64 + cc * 2; return st * 1024 + (ob ^ (((ob >> 9) & 1) << 5)); }
__device__ __forceinline__ void stage_rc(int b, int& R, int& C) { const int st = b / 1024, sb = b % 1024, swz = sb ^ (((sb >> 9) & 1) << 5); R = (st >> 1) * 16 + swz / 64; C = (st & 1) * 32 + (swz % 64) / 2; }
__device__ __forceinline__ int perm32(int rho) { const int n = rho >> 4, i = rho & 15; return 8 * (i >> 2) + 4 * n + (i & 3); }

struct GUnit { const char* A; const char* B; int pm, pn, a0, a1; };

__device__ __forceinline__ void tile_order(int L, int nM, int nN, int& pm, int& pn) {
    const int nwg = nM * nN; int wgid = L;
    { const int q = nwg / NXCD, r = nwg % NXCD, xcd = wgid % NXCD, off = wgid / NXCD; wgid = (xcd < r ? xcd * (q + 1) : r * (q + 1) + (xcd - r) * q) + off; }
    const int nig = WGM * nN, gid = wgid / nig, fm = gid * WGM, gsz = (nM - fm) < WGM ? (nM - fm) : WGM;
    pm = fm + ((wgid % nig) % gsz); pn = (wgid % nig) / gsz;
}

typedef f32x4 Acc[2][2][4][2];

template <class P>
__device__ __forceinline__ void gemm_phase(LAS unsigned char* lds, const P& S, int tid) {
    asm volatile("" : "+v"(tid));
    const int wid = __builtin_amdgcn_readfirstlane(tid >> 6), lane = tid & 63, wr = wid >> 2, wc = wid & 3, fr = lane & 15, fq = lane >> 4;
    constexpr int K = P::K, nt = K / BK;
    static_assert(nt >= 4 && (nt % 2) == 0, "K multiple of 128, >= 256");
    unsigned voffB[2];
#pragma unroll
    for (int i = 0; i < 2; ++i) { int R, C; stage_rc(tid * 16 + i * 8192, R, C); const int Rb = (R & ~31) + perm32(R & 31); voffB[i] = (unsigned)(Rb * K + C) * 2u; }
    constexpr size_t kstep = (size_t)(BK * 2);
    constexpr size_t hstepB = (size_t)HALF * K * 2;
    const unsigned ldsw = (unsigned)wid * 1024u;
    const int aoff = lds_byte(wr * 64 + fr, fq * 8), boff = lds_byte(wc * 32 + fr, fq * 8);
#define PG8_SA(b, h) (((b) * 2 + (h)) * HTB)
#define PG8_SB(b, h) ((4 + (b) * 2 + (h)) * HTB)
#define PG8_STAGE(bufoff, gbase, voff) do { _Pragma("unroll") for (int _i = 0; _i < 2; ++_i) \
        __builtin_amdgcn_global_load_lds((const unsigned*)((const char*)(gbase) + (voff)[_i]), (LAS unsigned*)(lds + (bufoff) + ldsw + _i * 8192), 16, 0, 0); } while (0)
#define PG8_LDA(dst, b, h) do { _Pragma("unroll") for (int m = 0; m < 4; ++m) _Pragma("unroll") for (int k = 0; k < 2; ++k) dst[m][k] = *(const LAS bf16x8*)(lds + PG8_SA(b, h) + aoff + m * 2048 + k * 1024); } while (0)
#define PG8_LDB(dst, b, h) do { _Pragma("unroll") for (int n = 0; n < 2; ++n) _Pragma("unroll") for (int k = 0; k < 2; ++k) dst[n][k] = *(const LAS bf16x8*)(lds + PG8_SB(b, h) + boff + n * 2048 + k * 1024); } while (0)
#define PG8_MMA(ai, bj, At, Bt) do { __builtin_amdgcn_s_setprio(1); _Pragma("unroll") for (int m = 0; m < 4; ++m) _Pragma("unroll") for (int n = 0; n < 2; ++n) _Pragma("unroll") for (int k = 0; k < 2; ++k) \
        acc[ai][bj][m][n] = __builtin_amdgcn_mfma_f32_16x16x32_bf16(Bt[n][k], At[m][k], acc[ai][bj][m][n], 0, 0, 0); __builtin_amdgcn_s_setprio(0); } while (0)
#define PG8_WAIT_V(n) asm volatile("s_waitcnt vmcnt(" #n ")" ::: "memory")
#define PG8_WAIT_L(n) asm volatile("s_waitcnt lgkmcnt(" #n ")" ::: "memory")
#define PG8_BAR __builtin_amdgcn_s_barrier()
#define PG8_SCHED __builtin_amdgcn_sched_barrier(0)
#define PG8_VOA(dst, u) do { _Pragma("unroll") for (int _h = 0; _h < 2; ++_h) _Pragma("unroll") for (int _i = 0; _i < 2; ++_i) { int _R, _C; stage_rc(tid * 16 + _i * 8192, _R, _C); \
        if constexpr (P::GATHER) dst[_h][_i] = (S.arow(u, _h * HALF + _R) * (unsigned)K + (unsigned)_C) * 2u; \
        else dst[_h][_i] = (unsigned)((_h * HALF + _R) * K + _C) * 2u; } } while (0)
    GUnit cur, nxt; int ui = 0;
    if (!S.next(0, cur)) return;
    Acc acc;
#pragma unroll
    for (int a = 0; a < 2; ++a)
#pragma unroll
        for (int b = 0; b < 2; ++b)
#pragma unroll
            for (int m = 0; m < 4; ++m)
#pragma unroll
                for (int n = 0; n < 2; ++n) acc[a][b][m][n] = (f32x4){0.f, 0.f, 0.f, 0.f};
    bf16x8 At[4][2], B0[2][2], B1[2][2];
    unsigned voA[2][2], voAn[2][2];
    PG8_VOA(voA, cur);
    const char* cA = cur.A; const char* cB = cur.B;
    PG8_STAGE(PG8_SB(0, 0), cB, voffB); PG8_STAGE(PG8_SB(0, 1), cB + hstepB, voffB); PG8_STAGE(PG8_SA(0, 0), cA, voA[0]); PG8_STAGE(PG8_SA(0, 1), cA, voA[1]);
    if (wr == 1) PG8_BAR;
    PG8_WAIT_V(2); PG8_BAR;
    PG8_STAGE(PG8_SB(1, 0), cB + kstep, voffB); PG8_STAGE(PG8_SA(1, 0), cA + kstep, voA[0]); PG8_STAGE(PG8_SB(1, 1), cB + hstepB + kstep, voffB);
    PG8_WAIT_V(6); PG8_BAR;
    for (;;) {
        const bool has_next = S.next(ui + 1, nxt);
        const char* nA = has_next ? nxt.A : cA; const char* nB = has_next ? nxt.B : cB;
        if constexpr (P::GATHER) {
            if (has_next) { PG8_VOA(voAn, nxt); }
            else {
#pragma unroll
                for (int h = 0; h < 2; ++h)
#pragma unroll
                    for (int i = 0; i < 2; ++i) voAn[h][i] = voA[h][i];
            }
        }
#pragma unroll 1
        for (int t = 0; t < nt; t += 2) {
            const bool last = (t == nt - 2);
            const char* a1 = cA + (size_t)(t + 1) * kstep;
            const char* a2 = last ? nA : cA + (size_t)(t + 2) * kstep; const char* b2 = last ? nB : cB + (size_t)(t + 2) * kstep;
            const char* a3 = a2 + kstep; const char* b3 = b2 + kstep;
            unsigned s0[2], s1[2];
#pragma unroll
            for (int i = 0; i < 2; ++i) {
                if constexpr (P::GATHER) { s0[i] = last ? voAn[0][i] : voA[0][i]; s1[i] = last ? voAn[1][i] : voA[1][i]; }
                else { s0[i] = voA[0][i]; s1[i] = voA[1][i]; }
            }
            PG8_LDB(B0, 0, 0); PG8_LDB(B1, 0, 1); PG8_SCHED; PG8_LDA(At, 0, 0); PG8_STAGE(PG8_SA(1, 1), a1, voA[1]);
            PG8_WAIT_V(8); PG8_WAIT_L(0); PG8_BAR; PG8_MMA(0, 0, At, B0); PG8_MMA(0, 1, At, B1); PG8_BAR; PG8_SCHED;
            PG8_LDA(At, 0, 1); PG8_STAGE(PG8_SB(0, 0), b2, voffB); PG8_STAGE(PG8_SB(0, 1), b2 + hstepB, voffB); PG8_STAGE(PG8_SA(0, 0), a2, s0);
            PG8_WAIT_V(8); PG8_WAIT_L(0); PG8_BAR; PG8_MMA(1, 0, At, B0); PG8_MMA(1, 1, At, B1); PG8_BAR; PG8_SCHED;
            PG8_LDB(B0, 1, 0); PG8_LDB(B1, 1, 1); PG8_SCHED; PG8_LDA(At, 1, 0); PG8_STAGE(PG8_SA(0, 1), a2, s1);
            PG8_WAIT_V(8); PG8_WAIT_L(0); PG8_BAR; PG8_MMA(0, 0, At, B0); PG8_MMA(0, 1, At, B1); PG8_BAR; PG8_SCHED;
            PG8_LDA(At, 1, 1); PG8_STAGE(PG8_SB(1, 0), b3, voffB); PG8_STAGE(PG8_SB(1, 1), b3 + hstepB, voffB); PG8_STAGE(PG8_SA(1, 0), a3, s0);
            PG8_WAIT_V(8); PG8_WAIT_L(0); PG8_BAR; PG8_MMA(1, 0, At, B0); PG8_MMA(1, 1, At, B1); PG8_BAR; PG8_SCHED;
        }
        if (wr == 0) PG8_BAR;
        const bool zero = S.epi(acc, cur, wr, wc, fr, fq);
        if (!has_next) break;
        if (zero) {
#pragma unroll
            for (int a = 0; a < 2; ++a)
#pragma unroll
                for (int b = 0; b < 2; ++b)
#pragma unroll
                    for (int m = 0; m < 4; ++m)
#pragma unroll
                        for (int n = 0; n < 2; ++n) acc[a][b][m][n] = (f32x4){0.f, 0.f, 0.f, 0.f};
        }
        cur = nxt; cA = nA; cB = nB; ++ui;
        if constexpr (P::GATHER) {
#pragma unroll
            for (int h = 0; h < 2; ++h)
#pragma unroll
                for (int i = 0; i < 2; ++i) voA[h][i] = voAn[h][i];
        }
        if (wr == 1) PG8_BAR;
    }
    PG8_WAIT_V(0);
    PG8_BAR;
#undef PG8_SA
#undef PG8_SB
#undef PG8_STAGE
#undef PG8_LDA
#undef PG8_LDB
#undef PG8_MMA
#undef PG8_WAIT_V
#undef PG8_WAIT_L
#undef PG8_BAR
#undef PG8_SCHED
#undef PG8_VOA
}
}
using pg8::GUnit; using pg8::Acc;

__device__ __forceinline__ float row_rs(const float* SS, int row) {
    const f32x4* p = (const f32x4*)(SS + (size_t)row * 16);
    const f32x4 a = p[0], b = p[1], c = p[2], d = p[3];
    const float s = (((a.x + a.y) + (a.z + a.w)) + ((b.x + b.y) + (b.z + b.w))) + (((c.x + c.y) + (c.z + c.w)) + ((d.x + d.y) + (d.z + d.w)));
    return rsqrtf(s * (1.0f / 1024.0f) + EPS);
}
__device__ __forceinline__ u32x4 pack8(const f32x4 v0, const f32x4 v1) { u32x4 w; w.x = cvt_pk_bf16(v0[0], v0[1]); w.y = cvt_pk_bf16(v0[2], v0[3]); w.z = cvt_pk_bf16(v1[0], v1[1]); w.w = cvt_pk_bf16(v1[2], v1[3]); return w; }
__device__ __forceinline__ void unpack8(const u32x4 w, f32x4& v0, f32x4& v1) { v0 = (f32x4){bf_lo(w.x), bf_hi(w.x), bf_lo(w.y), bf_hi(w.y)}; v1 = (f32x4){bf_lo(w.z), bf_hi(w.z), bf_lo(w.w), bf_hi(w.w)}; }
__device__ __forceinline__ f32x4 sig4(const f32x4 v) { return (f32x4){sigmoidf_(v[0]), sigmoidf_(v[1]), sigmoidf_(v[2]), sigmoidf_(v[3])}; }
__device__ __forceinline__ f32x4 gate4(const f32x4 v) { f32x4 s = sig4(v); return (f32x4){fmaxf(s[0], 1e-6f), fmaxf(s[1], 1e-6f), fmaxf(s[2], 1e-6f), fmaxf(s[3], 1e-6f)}; }

struct PhProj {
    static constexpr int K = 1024; static constexpr bool GATHER = false;
    const char* xb; const char* W; const float* SS; unsigned char* ws; int G, c;
    __device__ __forceinline__ bool next(int i, GUnit& u) const {
        const long L = (long)i * G + c; if (L >= 128 * 23) return false;
        pg8::tile_order((int)L, 128, 23, u.pm, u.pn);
        u.A = xb + (size_t)u.pm * 256 * K * 2; u.B = W + (size_t)u.pn * 256 * K * 2; u.a0 = 0; u.a1 = 0; return true;
    }
    __device__ __forceinline__ unsigned arow(const GUnit&, int) const { return 0u; }
    __device__ __forceinline__ bool epi(Acc& acc, const GUnit& u, int wr, int wc, int fr, int fq) const {
        const int pn = u.pn; const int row0 = u.pm * 256 + wr * 64 + fr;
        if (pn == 22) {
            if (wc == 0 && fq == 0) {
                float* IFp = (float*)(ws + WS_IF);
#pragma unroll
                for (int ai = 0; ai < 2; ++ai)
#pragma unroll
                    for (int m = 0; m < 4; ++m) { const int row = row0 + ai * 128 + m * 16; const float rs = row_rs(SS, row);
                        *(f32x4*)(IFp + (size_t)row * 8) = acc[ai][0][m][0] * rs; *(f32x4*)(IFp + (size_t)row * 8 + 4) = acc[ai][0][m][1] * rs; }
            }
            return true;
        }
        if (pn >= 10 && pn < 14) {
            bf16_t* Y = (bf16_t*)(ws + WS_YG);
#pragma unroll
            for (int ai = 0; ai < 2; ++ai)
#pragma unroll
                for (int m = 0; m < 4; ++m) { const int row = row0 + ai * 128 + m * 16; const float rs = row_rs(SS, row);
#pragma unroll
                    for (int bj = 0; bj < 2; ++bj) { const f32x4 a = acc[ai][bj][m][0] * rs, g = sig4(acc[ai][bj][m][1] * rs), y = a * g;
                        u32x2 w; w.x = cvt_pk_bf16(y[0], y[1]); w.y = cvt_pk_bf16(y[2], y[3]);
                        *(u32x2*)(Y + (size_t)row * 512 + (pn - 10) * 128 + bj * 64 + wc * 16 + fq * 4) = w; } }
            return true;
        }
        bf16_t* dst; int col0; bool sg = false;
        if (pn < 6) { dst = (bf16_t*)(ws + (pn < 2 ? WS_QA0 : (pn < 4 ? WS_QA1 : WS_QA2))); col0 = (pn & 1) * 256; }
        else if (pn < 8) { dst = (bf16_t*)(ws + WS_KA); col0 = (pn - 6) * 256; }
        else if (pn < 10) { dst = (bf16_t*)(ws + WS_VA); col0 = (pn - 8) * 256; }
        else if (pn < 16) { dst = (bf16_t*)(ws + WS_QM); col0 = (pn - 14) * 256; }
        else if (pn < 18) { dst = (bf16_t*)(ws + WS_KM); col0 = (pn - 16) * 256; }
        else if (pn < 20) { dst = (bf16_t*)(ws + WS_VM); col0 = (pn - 18) * 256; }
        else { dst = (bf16_t*)(ws + WS_OM); col0 = (pn - 20) * 256; sg = true; }
        col0 += wc * 32 + fq * 8;
#pragma unroll
        for (int ai = 0; ai < 2; ++ai)
#pragma unroll
            for (int m = 0; m < 4; ++m) { const int row = row0 + ai * 128 + m * 16; const float rs = row_rs(SS, row);
#pragma unroll
                for (int bj = 0; bj < 2; ++bj) { f32x4 v0 = acc[ai][bj][m][0] * rs, v1 = acc[ai][bj][m][1] * rs;
                    if (sg) { v0 = sig4(v0); v1 = sig4(v1); }
                    *(u32x4*)(dst + (size_t)row * 512 + col0 + bj * 128) = pack8(v0, v1); } }
        return true;
    }
};
struct PhGates {
    static constexpr int K = 1024; static constexpr bool GATHER = false;
    const char* xb; const char* W; const float* SS; unsigned char* ws; int G, c;
    __device__ __forceinline__ bool next(int i, GUnit& u) const {
        const long L = (long)i * G + c; if (L >= 128 * 12) return false;
        pg8::tile_order((int)L, 128, 12, u.pm, u.pn);
        u.A = xb + (size_t)u.pm * 256 * K * 2; u.B = W + (size_t)(5888 + u.pn * 256) * K * 2; u.a0 = 0; u.a1 = 0; return true;
    }
    __device__ __forceinline__ unsigned arow(const GUnit&, int) const { return 0u; }
    __device__ __forceinline__ bool epi(Acc& acc, const GUnit& u, int wr, int wc, int fr, int fq) const {
        const int row0 = u.pm * 256 + wr * 64 + fr;
        bf16_t* dst = (bf16_t*)(ws + WS_G0 + (size_t)(u.pn >> 2) * 64 * MiB); const int col0 = (u.pn & 3) * 256 + wc * 32 + fq * 8;
#pragma unroll
        for (int ai = 0; ai < 2; ++ai)
#pragma unroll
            for (int m = 0; m < 4; ++m) { const int row = row0 + ai * 128 + m * 16; const float rs = row_rs(SS, row);
#pragma unroll
                for (int bj = 0; bj < 2; ++bj) *(u32x4*)(dst + (size_t)row * 1024 + col0 + bj * 128) = pack8(gate4(acc[ai][bj][m][0] * rs), gate4(acc[ai][bj][m][1] * rs)); }
        return true;
    }
};
struct PhMerge {
    static constexpr int K = 512; static constexpr bool GATHER = false;
    unsigned char* ws; int G, c;
    __device__ __forceinline__ bool next(int i, GUnit& u) const {
        const int ti = i / 3, seg = i - ti * 3; const long L = (long)ti * G + c; if (L >= 128 * 4) return false;
        pg8::tile_order((int)L, 128, 4, u.pm, u.pn);
        const size_t ya = seg == 0 ? WS_YATT : (seg == 1 ? WS_YC : WS_OM);
        u.A = (const char*)ws + ya + (size_t)u.pm * 256 * K * 2; u.B = (const char*)ws + WS_WBR + (size_t)seg * 1024 * 512 * 2 + (size_t)u.pn * 256 * K * 2; u.a0 = seg; u.a1 = 0; return true;
    }
    __device__ __forceinline__ unsigned arow(const GUnit&, int) const { return 0u; }
    __device__ __forceinline__ bool epi(Acc& acc, const GUnit& u, int wr, int wc, int fr, int fq) const {
        const int seg = u.a0; const int row0 = u.pm * 256 + wr * 64 + fr; const int col0 = u.pn * 256 + wc * 32 + fq * 8;
        const bf16_t* Gn = (const bf16_t*)(ws + WS_G0 + (size_t)seg * 64 * MiB);
        const bf16_t* Gd = (const bf16_t*)(ws + WS_G0 + (size_t)(seg + 1) * 64 * MiB);
        bf16_t* Mo = (bf16_t*)(ws + WS_MERGED);
#pragma unroll
        for (int ai = 0; ai < 2; ++ai)
#pragma unroll
            for (int m = 0; m < 4; ++m) { const size_t off = (size_t)(row0 + ai * 128 + m * 16) * 1024 + col0;
#pragma unroll
                for (int bj = 0; bj < 2; ++bj) {
                    f32x4 n0, n1; unpack8(*(const u32x4*)(Gn + off + bj * 128), n0, n1);
                    if (seg < 2) { f32x4 d0, d1; unpack8(*(const u32x4*)(Gd + off + bj * 128), d0, d1);
#pragma unroll
                        for (int j = 0; j < 4; ++j) { acc[ai][bj][m][0][j] *= n0[j] * __builtin_amdgcn_rcpf(d0[j]); acc[ai][bj][m][1][j] *= n1[j] * __builtin_amdgcn_rcpf(d1[j]); } }
                    else *(u32x4*)(Mo + off + bj * 128) = pack8(acc[ai][bj][m][0] * n0, acc[ai][bj][m][1] * n1);
                } }
        return seg == 2;
    }
};
__device__ __forceinline__ float store_x8(float* xp, bf16_t* xbp, const f32x4 v0, const f32x4 v1) {
    *(f32x4*)xp = v0; *(f32x4*)(xp + 4) = v1; *(u32x4*)xbp = pack8(v0, v1);
    return ((v0[0] * v0[0] + v0[1] * v0[1]) + (v0[2] * v0[2] + v0[3] * v0[3])) + ((v1[0] * v1[0] + v1[1] * v1[1]) + (v1[2] * v1[2] + v1[3] * v1[3]));
}
struct PhOut {
    static constexpr int K = 1024; static constexpr bool GATHER = false;
    unsigned char* ws; const float* xin; float* x; float* SSo; int G, c;
    __device__ __forceinline__ bool next(int i, GUnit& u) const {
        const long L = (long)i * G + c; if (L >= 128 * 4) return false;
        pg8::tile_order((int)L, 128, 4, u.pm, u.pn);
        u.A = (const char*)ws + WS_MERGED + (size_t)u.pm * 256 * K * 2; u.B = (const char*)ws + WS_WOUT + (size_t)u.pn * 256 * K * 2; u.a0 = 0; u.a1 = 0; return true;
    }
    __device__ __forceinline__ unsigned arow(const GUnit&, int) const { return 0u; }
    __device__ __forceinline__ bool epi(Acc& acc, const GUnit& u, int wr, int wc, int fr, int fq) const {
        const int row0 = u.pm * 256 + wr * 64 + fr; const int col0 = u.pn * 256 + wc * 32 + fq * 8; bf16_t* XB = (bf16_t*)(ws + WS_XB);
#pragma unroll
        for (int ai = 0; ai < 2; ++ai)
#pragma unroll
            for (int m = 0; m < 4; ++m) { const int row = row0 + ai * 128 + m * 16; const size_t off = (size_t)row * 1024 + col0; float ss = 0.f;
#pragma unroll
                for (int bj = 0; bj < 2; ++bj) { float* xp = x + off + bj * 128; const float* xi = xin + off + bj * 128; const f32x4 v0 = *(const f32x4*)xi + acc[ai][bj][m][0], v1 = *(const f32x4*)(xi + 4) + acc[ai][bj][m][1];
                    ss += store_x8(xp, XB + off + bj * 128, v0, v1); }
                ss += __shfl_xor(ss, 16); ss += __shfl_xor(ss, 32);
                if (fq == 0) SSo[(size_t)row * 16 + u.pn * 4 + wc] = ss; }
        return true;
    }
};
struct PhRouter {
    static constexpr int K = 1024; static constexpr bool GATHER = false;
    unsigned char* ws; const float* SS; int G, c;
    __device__ __forceinline__ bool next(int i, GUnit& u) const {
        const long L = (long)i * G + c; if (L >= 128) return false;
        u.pm = (int)L; u.pn = 0; u.A = (const char*)ws + WS_XB + (size_t)u.pm * 256 * K * 2; u.B = (const char*)ws + WS_WR; u.a0 = 0; u.a1 = 0; return true;
    }
    __device__ __forceinline__ unsigned arow(const GUnit&, int) const { return 0u; }
    __device__ __forceinline__ bool epi(Acc& acc, const GUnit& u, int wr, int wc, int fr, int fq) const {
        if (wc < 2) { float* Lg = (float*)(ws + WS_LOGITS); const int row0 = u.pm * 256 + wr * 64 + fr;
#pragma unroll
            for (int ai = 0; ai < 2; ++ai)
#pragma unroll
                for (int m = 0; m < 4; ++m) { const int row = row0 + ai * 128 + m * 16; const float rs = row_rs(SS, row); float* p = Lg + (size_t)row * 64 + wc * 32 + fq * 8;
                    *(f32x4*)p = acc[ai][0][m][0] * rs; *(f32x4*)(p + 4) = acc[ai][0][m][1] * rs; } }
        return true;
    }
};
__device__ __forceinline__ int moe_expert_of(const int* META, int k, int rb) {
    const int r = rb * 256; int e = 0;
    for (int j = 1; j < 32; ++j) e += (META[16 + 64 * k + j] <= r) ? 1 : 0;
    return __builtin_amdgcn_readfirstlane(e);
}
struct PhUp {
    static constexpr int K = 1024; static constexpr bool GATHER = true;
    unsigned char* ws; const float* SS; const int* META; const int* tok; int G, c;
    __device__ __forceinline__ bool next(int i, GUnit& u) const {
        const int nb0 = __builtin_amdgcn_readfirstlane(META[0]), nb1 = __builtin_amdgcn_readfirstlane(META[1]); const long L = (long)i * G + c; if (L >= 2L * (nb0 + nb1)) return false;
        int blk = (int)(L >> 1); u.pn = (int)(L & 1); int k = 0; if (blk >= nb0) { k = 1; blk -= nb0; }
        const int e = moe_expert_of(META, k, blk);
        u.pm = blk; u.a0 = k; u.a1 = e; u.A = (const char*)ws + WS_XB; u.B = (const char*)ws + WS_WEXP + (size_t)e * 512 * 1024 * 2 + (size_t)u.pn * 256 * K * 2; return true;
    }
    __device__ __forceinline__ unsigned arow(const GUnit& u, int r) const { const int t = tok[u.a0 * LISTCAP + u.pm * 256 + r]; return t < 0 ? 0u : (unsigned)t; }
    __device__ __forceinline__ bool epi(Acc& acc, const GUnit& u, int wr, int wc, int fr, int fq) const {
        const int lr0 = u.a0 * LISTCAP + u.pm * 256 + wr * 64 + fr; bf16_t* HB = (bf16_t*)(ws + WS_HB);
#pragma unroll
        for (int ai = 0; ai < 2; ++ai)
#pragma unroll
            for (int m = 0; m < 4; ++m) { const int lr = lr0 + ai * 128 + m * 16; const int t = tok[lr]; const float rs = t < 0 ? 0.f : row_rs(SS, t < 0 ? 0 : t);
#pragma unroll
                for (int bj = 0; bj < 2; ++bj) { const f32x4 g = acc[ai][bj][m][0] * rs, uu = acc[ai][bj][m][1] * rs;
                    f32x4 h = (f32x4){siluf_(g[0]) * uu[0], siluf_(g[1]) * uu[1], siluf_(g[2]) * uu[2], siluf_(g[3]) * uu[3]}; if (ABL == 8) h = (f32x4){1.f, 1.f, 1.f, 1.f};
                    u32x2 w; w.x = cvt_pk_bf16(h[0], h[1]); w.y = cvt_pk_bf16(h[2], h[3]);
                    *(u32x2*)(HB + (size_t)lr * 256 + u.pn * 128 + bj * 64 + wc * 16 + fq * 4) = w; }
                asm volatile("" ::: "memory"); }
        return true;
    }
};
template <int KL> struct PhDown {
    static constexpr int K = 256; static constexpr bool GATHER = false;
    unsigned char* ws; float* x; float* SSo; const int* META; const int* tok; const float* wl; int G, c;
    __device__ __forceinline__ bool next(int i, GUnit& u) const {
        const int nb = __builtin_amdgcn_readfirstlane(META[KL]); const long L = (long)i * G + c;
        if (L < 4L * nb) { const int blk = (int)(L >> 2); u.pn = (int)(L & 3); const int e = moe_expert_of(META, KL, blk); u.pm = blk; u.a0 = 0; u.a1 = e;
            u.A = (const char*)ws + WS_HB + (size_t)(KL * LISTCAP + blk * 256) * 256 * 2; u.B = (const char*)ws + WS_WEXP + 32ull * 512 * 1024 * 2 + (size_t)e * 1024 * 256 * 2 + (size_t)u.pn * 256 * K * 2; return true; }
        if (KL == 1) { const long L2 = L - 4L * nb; if (L2 >= 128 * 4) return false;
            pg8::tile_order((int)L2, 128, 4, u.pm, u.pn); u.a0 = 1; u.a1 = 0;
            u.A = (const char*)ws + WS_PBF + (size_t)u.pm * 256 * K * 2; u.B = (const char*)ws + WS_WPP + (size_t)u.pn * 256 * K * 2; return true; }
        return false;
    }
    __device__ __forceinline__ unsigned arow(const GUnit&, int) const { return 0u; }
    __device__ __forceinline__ bool epi(Acc& acc, const GUnit& u, int wr, int wc, int fr, int fq) const {
        const int col0 = u.pn * 256 + wc * 32 + fq * 8;
        if (KL == 1 && u.a0 == 1) {
            bf16_t* PE = (bf16_t*)(ws + WS_PE); const int row0 = u.pm * 256 + wr * 64 + fr;
#pragma unroll
            for (int ai = 0; ai < 2; ++ai)
#pragma unroll
                for (int m = 0; m < 4; ++m)
#pragma unroll
                    for (int bj = 0; bj < 2; ++bj) *(u32x4*)(PE + (size_t)(row0 + ai * 128 + m * 16) * 1024 + col0 + bj * 128) = pack8(acc[ai][bj][m][0], acc[ai][bj][m][1]);
            return true;
        }
        const int lr0 = KL * LISTCAP + u.pm * 256 + wr * 64 + fr; bf16_t* YB = (bf16_t*)(ws + WS_YB1); bf16_t* XB = (bf16_t*)(ws + WS_XB);
#pragma unroll
        for (int ai = 0; ai < 2; ++ai)
#pragma unroll
            for (int m = 0; m < 4; ++m) { const int lr = lr0 + ai * 128 + m * 16; const int t = tok[lr]; const float w = (ABL == 9) ? 1.0f : wl[lr]; const size_t off = (size_t)(t < 0 ? 0 : t) * 1024 + col0;
                if (KL == 1) { if (t >= 0) {
#pragma unroll
                        for (int bj = 0; bj < 2; ++bj) *(u32x4*)(YB + off + bj * 128) = pack8(acc[ai][bj][m][0] * w, acc[ai][bj][m][1] * w); } }
                else { float ss = 0.f;
                    if (t >= 0) {
#pragma unroll
                        for (int bj = 0; bj < 2; ++bj) { float* xp = x + off + bj * 128; f32x4 y0, y1; unpack8(*(const u32x4*)(YB + off + bj * 128), y0, y1);
                            f32x4 v0 = (*(const f32x4*)xp + y0) + acc[ai][bj][m][0] * w, v1 = (*(const f32x4*)(xp + 4) + y1) + acc[ai][bj][m][1] * w; if (ABL == 7) { v0 = v0 + 1.0f; v1 = v1 + 1.0f; }
                            ss += store_x8(xp, XB + off + bj * 128, v0, v1); } }
                    ss += __shfl_xor(ss, 16); ss += __shfl_xor(ss, 32);
                    if (fq == 0 && t >= 0) SSo[(size_t)t * 16 + u.pn * 4 + wc] = ss; }
                if (m & 1) asm volatile("" ::: "memory"); }
        return true;
    }
};
struct PhPle {
    static constexpr int K = 1024; static constexpr bool GATHER = false;
    unsigned char* ws; float* x; const float* SSi; float* SSo; int G, c;
    __device__ __forceinline__ bool next(int i, GUnit& u) const {
        const long L = (long)i * G + c; if (L >= 128 * 4) return false;
        pg8::tile_order((int)L, 128, 4, u.pm, u.pn);
        u.A = (const char*)ws + WS_XB + (size_t)u.pm * 256 * K * 2; u.B = (const char*)ws + WS_WPG + (size_t)u.pn * 256 * K * 2; u.a0 = 0; u.a1 = 0; return true;
    }
    __device__ __forceinline__ unsigned arow(const GUnit&, int) const { return 0u; }
    __device__ __forceinline__ bool epi(Acc& acc, const GUnit& u, int wr, int wc, int fr, int fq) const {
        const int row0 = u.pm * 256 + wr * 64 + fr; const int col0 = u.pn * 256 + wc * 32 + fq * 8; bf16_t* XT = (bf16_t*)(ws + WS_XBT); const bf16_t* PE = (const bf16_t*)(ws + WS_PE);
#pragma unroll
        for (int ai = 0; ai < 2; ++ai)
#pragma unroll
            for (int m = 0; m < 4; ++m) { const int row = row0 + ai * 128 + m * 16; const size_t off = (size_t)row * 1024 + col0; const float rs = row_rs(SSi, row); float ss = 0.f;
#pragma unroll
                for (int bj = 0; bj < 2; ++bj) { float* xp = x + off + bj * 128; f32x4 p0, p1; unpack8(*(const u32x4*)(PE + off + bj * 128), p0, p1); if (ABL == 5) { p0 = p0 * 0.f; p1 = p1 * 0.f; }
                    const f32x4 v0 = *(const f32x4*)xp + sig4(acc[ai][bj][m][0] * rs) * p0, v1 = *(const f32x4*)(xp + 4) + sig4(acc[ai][bj][m][1] * rs) * p1;
                    ss += store_x8(xp, XT + off + bj * 128, v0, v1); }
                ss += __shfl_xor(ss, 16); ss += __shfl_xor(ss, 32);
                if (fq == 0) SSo[(size_t)row * 16 + u.pn * 4 + wc] = ss; }
        return true;
    }
};

struct Ctx {
    const float* const* in; float* out; unsigned char* ws; LAS unsigned char* lds;
    int tid, lane, wave, G, bid;
};
enum { I_X = 0, I_P, I_GMIX, I_WIN, I_CONVW, I_CONVB, I_CLNG, I_CLNB, I_MCW, I_MCB, I_MIB, I_MFB, I_WBA, I_WBC, I_WBM, I_WOUT, I_GFFN, I_WRG, I_BRG, I_WRE, I_BRE,
       I_WEG, I_WEU, I_WED, I_GPLE, I_WPG, I_WPP, I_GFIN };

constexpr int TR_LDS = 64 * 65 * 4;
__device__ __forceinline__ void tr_item64(const float* colptr4, size_t pitch, const float* gain, float cscale, bf16_t* dst, int K, int n0, int k0, LAS float* scr, int lane) {
    const int g = lane & 15, r = lane >> 4;
#pragma unroll 4
    for (int i = 0; i < 16; ++i) { const int kk = 4 * i + r; f32x4 v = (f32x4){0.f, 0.f, 0.f, 0.f}; if (colptr4) v = *(const f32x4*)(colptr4 + (size_t)(k0 + kk) * pitch);
        const float gs = (gain ? gain[k0 + kk] : 1.0f) * cscale; LAS float* p = scr + kk * 65 + 4 * g; p[0] = v.x * gs; p[1] = v.y * gs; p[2] = v.z * gs; p[3] = v.w * gs; }
    LDS_WAIT(); asm volatile("" ::: "memory");
    const int c = lane & 7, n8 = lane >> 3;
#pragma unroll
    for (int j = 0; j < 8; ++j) { const int n = n8 + 8 * j; const LAS float* sp = scr + (8 * c) * 65 + n;
        u32x4 o; o.x = pk2(sp[0 * 65], sp[1 * 65]); o.y = pk2(sp[2 * 65], sp[3 * 65]); o.z = pk2(sp[4 * 65], sp[5 * 65]); o.w = pk2(sp[6 * 65], sp[7 * 65]);
        *(u32x4*)(dst + (size_t)(n0 + n) * K + k0 + 8 * c) = o; }
    LDS_WAIT(); asm volatile("" ::: "memory");
}
__device__ __forceinline__ void phase_prep(const Ctx& F, int layer, float* SS) {
    const int gw = F.bid * NWAVES + F.wave, NGW = F.G * NWAVES, lane = F.lane;
    LAS float* scr = (LAS float*)(F.lds + F.wave * TR_LDS);
    bf16_t* XB = (bf16_t*)(F.ws + WS_XB);
    if (layer == 0) {
        for (int m = gw; m < T; m += NGW) {
            const f32x4* xr = (const f32x4*)(F.in[I_X] + (size_t)m * D) + lane; u32x2* xbr = (u32x2*)(XB + (size_t)m * D) + lane;
            float sq = 0.f;
#pragma unroll
            for (int j = 0; j < 4; ++j) { const f32x4 v = xr[64 * j]; sq += (v.x * v.x + v.y * v.y) + (v.z * v.z + v.w * v.w);
                u32x2 w; w.x = cvt_pk_bf16(v.x, v.y); w.y = cvt_pk_bf16(v.z, v.w); xbr[64 * j] = w; }
            sq = wave_sum(sq);
            if (lane < 16) SS[(size_t)m * 16 + lane] = lane == 0 ? sq : 0.f;
        }
    } else {
        const u32x4* src = (const u32x4*)(F.ws + WS_XBT); u32x4* dst = (u32x4*)(F.ws + WS_XB);
        for (size_t i = (size_t)F.bid * NTHREADS + F.tid; i < (size_t)T * D * 2 / 16; i += (size_t)F.G * NTHREADS) dst[i] = src[i];
    }
    const float* w_in = F.in[I_WIN] + (size_t)layer * D * D_IN; const float* g_mix = F.in[I_GMIX] + (size_t)layer * D;
    constexpr int N_WIN = 140 * 16, N_BR = 16 * 8, N_SQ = 16 * 16, N_PP = 16 * 4, N_R = 4 * 16;
    constexpr int NITEMS = N_WIN + 3 * N_BR + 2 * N_SQ + N_PP + N_R;
    const int g4 = 4 * (lane & 15);
    for (int it = gw; it < NITEMS; it += NGW) {
        int r = it;
        if (r < N_WIN) { const int nb = r >> 4, kb = r & 15; const int n = nb * 64 + g4; int src = -1; float cs = 1.f;
            if (n < 2560) { src = n; if (n < 1536) cs = 0.125f; }
            else if (n < 3584) { const int np = n - 2560, q8 = np >> 3, sg = (np >> 2) & 1; src = 2560 + sg * 512 + 4 * q8; }
            else if (n < 5640) src = n;
            else if (n < 5888) src = -1;
            else src = 5640 + (n - 5888);
            tr_item64(src >= 0 ? w_in + src : nullptr, D_IN, g_mix, cs, (bf16_t*)(F.ws + WS_WIN), 1024, nb * 64, kb * 64, scr, lane); continue; }
        r -= N_WIN;
        if (r < 3 * N_BR) { const int b = r / N_BR; r -= b * N_BR; const int nb = r >> 3, kb = r & 7; const int n = nb * 64 + g4;
            const float* w = (b == 0 ? F.in[I_WBA] : (b == 1 ? F.in[I_WBC] : F.in[I_WBM])) + (size_t)layer * 512 * 1024;
            tr_item64(w + n, 1024, nullptr, 1.f, (bf16_t*)(F.ws + WS_WBR) + (size_t)b * 1024 * 512, 512, nb * 64, kb * 64, scr, lane); continue; }
        r -= 3 * N_BR;
        if (r < 2 * N_SQ) { const int b = r / N_SQ; r -= b * N_SQ; const int nb = r >> 4, kb = r & 15; const int n = nb * 64 + g4;
            const float* w = (b == 0 ? F.in[I_WOUT] : F.in[I_WPG]) + (size_t)layer * 1024 * 1024;
            tr_item64(w + n, 1024, b == 0 ? nullptr : F.in[I_GPLE] + (size_t)layer * D, 1.f, (bf16_t*)(F.ws + (b == 0 ? WS_WOUT : WS_WPG)), 1024, nb * 64, kb * 64, scr, lane); continue; }
        r -= 2 * N_SQ;
        if (r < N_PP) { const int nb = r >> 2, kb = r & 3; const int n = nb * 64 + g4;
            tr_item64(F.in[I_WPP] + (size_t)layer * 256 * 1024 + n, 1024, nullptr, 1.f, (bf16_t*)(F.ws + WS_WPP), 256, nb * 64, kb * 64, scr, lane); continue; }
        r -= N_PP;
        { const int nb = r >> 4, kb = r & 15; const int n = nb * 64 + g4; const float* cp = nullptr; size_t pitch = 4;
            if (n < 4) { cp = F.in[I_WRG] + (size_t)layer * 1024 * 4 + n; pitch = 4; } else if (n < 36) { cp = F.in[I_WRE] + (size_t)layer * 1024 * 32 + (n - 4); pitch = 32; }
            tr_item64(cp, pitch, F.in[I_GFFN] + (size_t)layer * D, 1.f, (bf16_t*)(F.ws + WS_WR), 1024, nb * 64, kb * 64, scr, lane); }
    }
}
__device__ __forceinline__ void phase_prep_experts(const Ctx& F, int layer) {
    const int gw = F.bid * NWAVES + F.wave, NGW = F.G * NWAVES, lane = F.lane;
    LAS float* scr = (LAS float*)(F.lds + F.wave * TR_LDS);
    const float* g_ffn = F.in[I_GFFN] + (size_t)layer * D;
    constexpr int N_UP = 32 * 8 * 16, N_DN = 32 * 16 * 4;
    const int g4 = 4 * (lane & 15);
    for (int it = gw; it < N_UP + N_DN; it += NGW) {
        int r = it;
        if (r < N_UP) { const int e = r >> 7; r &= 127; const int nb = r >> 4, kb = r & 15; const int n = nb * 64 + g4; const int q8 = n >> 3, sg = (n >> 2) & 1;
            const float* w = (sg ? F.in[I_WEU] : F.in[I_WEG]) + ((size_t)layer * 32 + e) * 1024 * 256 + 4 * q8;
            tr_item64(w, 256, g_ffn, 1.f, (bf16_t*)(F.ws + WS_WEXP) + (size_t)e * 512 * 1024, 1024, nb * 64, kb * 64, scr, lane); continue; }
        r -= N_UP;
        { const int e = r >> 6; r &= 63; const int nb = r >> 2, kb = r & 3; const int n = nb * 64 + g4;
            const float* w = F.in[I_WED] + ((size_t)layer * 32 + e) * 256 * 1024 + n;
            tr_item64(w, 1024, nullptr, 1.f, (bf16_t*)(F.ws + WS_WEXP) + 32ull * 512 * 1024 + (size_t)e * 1024 * 256, 256, nb * 64, kb * 64, scr, lane); }
    }
    const f32x4* p = (const f32x4*)(F.in[I_P] + (size_t)layer * T * 256); u32x2* pb = (u32x2*)(F.ws + WS_PBF);
    for (size_t i = (size_t)F.bid * NTHREADS + F.tid; i < (size_t)T * 256 / 4; i += (size_t)F.G * NTHREADS) { const f32x4 v = p[i]; u32x2 w; w.x = cvt_pk_bf16(v.x, v.y); w.y = cvt_pk_bf16(v.z, v.w); pb[i] = w; }
}

__device__ __forceinline__ void attn_item_v1(const Ctx& F, int tb) {
    const int slot = F.wave, t = tb * 64 + F.lane, s = t & (SEQ - 1);
    const bf16_t* KA = (const bf16_t*)(F.ws + WS_KA); const bf16_t* VA = (const bf16_t*)(F.ws + WS_VA);
    float acc[64];
#pragma unroll
    for (int d = 0; d < 64; ++d) acc[d] = 0.f;
    float mrun = -INFINITY, lrun = 0.f;
    for (int g = 0; g < 3; ++g) {
        const int dl = 1 << (2 * g); const float slope = exp2f(-(float)(g * 8 + slot + 1) * (1.0f / 3.0f)) * (float)dl;
        const bf16_t* Q = (const bf16_t*)(F.ws + (g == 0 ? WS_QA0 : (g == 1 ? WS_QA1 : WS_QA2))) + (size_t)t * 512 + slot * 64;
        float q[64];
#pragma unroll
        for (int c = 0; c < 8; ++c) { const u32x4 w = ((const u32x4*)Q)[c]; q[8 * c] = bf_lo(w.x); q[8 * c + 1] = bf_hi(w.x); q[8 * c + 2] = bf_lo(w.y); q[8 * c + 3] = bf_hi(w.y); q[8 * c + 4] = bf_lo(w.z); q[8 * c + 5] = bf_hi(w.z); q[8 * c + 6] = bf_lo(w.w); q[8 * c + 7] = bf_hi(w.w); }
        int nj = s / dl; if (nj > 128) nj = 128;
        const int njmax = __builtin_amdgcn_readfirstlane((int)wave_max((float)nj));
        for (int j = 0; j <= njmax; ++j) {
            const bool ok = j <= nj; const int tk = ok ? t - dl * j : t;
            const u32x4* kp = (const u32x4*)(KA + (size_t)tk * 512 + slot * 64); const u32x4* vp = (const u32x4*)(VA + (size_t)tk * 512 + slot * 64);
            float dot = 0.f;
#pragma unroll
            for (int c = 0; c < 8; ++c) { const u32x4 w = kp[c];
                dot += q[8 * c] * bf_lo(w.x) + q[8 * c + 1] * bf_hi(w.x) + q[8 * c + 2] * bf_lo(w.y) + q[8 * c + 3] * bf_hi(w.y) + q[8 * c + 4] * bf_lo(w.z) + q[8 * c + 5] * bf_hi(w.z) + q[8 * c + 6] * bf_lo(w.w) + q[8 * c + 7] * bf_hi(w.w); }
            const float sc = ok ? dot - slope * (float)j : -INFINITY;
            const float mn = fmaxf(mrun, sc);
            const float corr = __expf(mrun - mn), pw = __expf(sc - mn);
            lrun = lrun * corr + pw; mrun = mn;
#pragma unroll
            for (int c = 0; c < 8; ++c) { const u32x4 w = vp[c];
                acc[8 * c] = acc[8 * c] * corr + pw * bf_lo(w.x); acc[8 * c + 1] = acc[8 * c + 1] * corr + pw * bf_hi(w.x); acc[8 * c + 2] = acc[8 * c + 2] * corr + pw * bf_lo(w.y); acc[8 * c + 3] = acc[8 * c + 3] * corr + pw * bf_hi(w.y);
                acc[8 * c + 4] = acc[8 * c + 4] * corr + pw * bf_lo(w.z); acc[8 * c + 5] = acc[8 * c + 5] * corr + pw * bf_hi(w.z); acc[8 * c + 6] = acc[8 * c + 6] * corr + pw * bf_lo(w.w); acc[8 * c + 7] = acc[8 * c + 7] * corr + pw * bf_hi(w.w); }
        }
    }
    const float inv = (ABL == 1) ? 0.f : 1.0f / lrun;
    u32x4* o = (u32x4*)((bf16_t*)(F.ws + WS_YATT) + (size_t)t * 512 + slot * 64);
#pragma unroll
    for (int c = 0; c < 8; ++c) { u32x4 w; w.x = cvt_pk_bf16(acc[8 * c] * inv, acc[8 * c + 1] * inv); w.y = cvt_pk_bf16(acc[8 * c + 2] * inv, acc[8 * c + 3] * inv); w.z = cvt_pk_bf16(acc[8 * c + 4] * inv, acc[8 * c + 5] * inv); w.w = cvt_pk_bf16(acc[8 * c + 6] * inv, acc[8 * c + 7] * inv); o[c] = w; }
}

constexpr int AK_RS = 144, AV_RS = 160, AV_OFF = 2 * 128 * AK_RS;
typedef short s16x4 __attribute__((ext_vector_type(4)));
__device__ __forceinline__ s16x4 lds_tr16(LAS unsigned char* p) { return __builtin_amdgcn_ds_read_tr16_b64_v4i16((LAS s16x4*)p); }
__device__ __forceinline__ void attn_strip(const Ctx& F, int strip) {
    const int bs = strip / 48, sg = strip - bs * 48, b = bs >> 3, slot = bs & 7;
    int g, r, nb0;
    if (sg < 16) { g = 0; r = 0; nb0 = sg * 8; } else if (sg < 32) { g = 1; r = (sg - 16) >> 2; nb0 = ((sg - 16) & 3) * 8; } else { g = 2; r = sg - 32; nb0 = 0; }
    const int dl = 1 << (2 * g); const float slope = exp2f(-(float)(g * 8 + slot + 1) * (1.0f / 3.0f)) * (float)dl;
    bf16_t* Qg = (bf16_t*)(F.ws + (g == 0 ? WS_QA0 : (g == 1 ? WS_QA1 : WS_QA2))) + slot * 64;
    const bf16_t* Kg = (const bf16_t*)(F.ws + WS_KA) + slot * 64; const bf16_t* Vg = (const bf16_t*)(F.ws + WS_VA) + slot * 64;
    float* LSE = (float*)(F.ws + WS_LOGITS) + (size_t)g * T * 8 + slot;
    const size_t tok0 = (size_t)b * SEQ + r;
    LAS unsigned char* Kl = F.lds; LAS unsigned char* Vl = F.lds + AV_OFF;
    const int tid = F.tid, lane = F.lane, w = F.wave, fr = lane & 15, fq = lane >> 4;
    const int srow = tid >> 2, sc4 = tid & 3;
    u32x4 kx[2], vx[2];
#define ATT_LOAD(blk) do { const size_t _t = (tok0 + (size_t)((blk) * 128 + srow) * dl) * 512; \
        kx[0] = *(const u32x4*)(Kg + _t + sc4 * 8); kx[1] = *(const u32x4*)(Kg + _t + 32 + sc4 * 8); vx[0] = *(const u32x4*)(Vg + _t + sc4 * 8); vx[1] = *(const u32x4*)(Vg + _t + 32 + sc4 * 8); } while (0)
#define ATT_STORE(blk) do { const int _p = (((blk) & 1) * 128 + srow); \
        *(LAS u32x4*)(Kl + _p * AK_RS + sc4 * 16) = kx[0]; *(LAS u32x4*)(Kl + _p * AK_RS + 64 + sc4 * 16) = kx[1]; *(LAS u32x4*)(Vl + _p * AV_RS + sc4 * 16) = vx[0]; *(LAS u32x4*)(Vl + _p * AV_RS + 64 + sc4 * 16) = vx[1]; } while (0)
    __syncthreads();
    if (nb0 > 0) { ATT_LOAD(nb0 - 1); ATT_STORE(nb0 - 1); }
    else { kx[0] = kx[1] = vx[0] = vx[1] = (u32x4){0u, 0u, 0u, 0u}; ATT_STORE(1); }
    ATT_LOAD(nb0); ATT_STORE(nb0);
    bf16x8 qn0, qn1;
    { const size_t qo = (tok0 + (size_t)(nb0 * 128 + 16 * w + fr) * dl) * 512; qn0 = *(const bf16x8*)(Qg + qo + fq * 8); qn1 = *(const bf16x8*)(Qg + qo + 32 + fq * 8); }
    __syncthreads();
    for (int nb = nb0; nb < nb0 + 8; ++nb) {
        const bool more = nb + 1 < nb0 + 8;
        if (more) ATT_LOAD(nb + 1);
        const size_t qoff = (tok0 + (size_t)(nb * 128 + 16 * w + fr) * dl) * 512;
        const bf16x8 q0 = qn0, q1 = qn1;
        if (more) { const size_t qo2 = qoff + (size_t)128 * dl * 512; qn0 = *(const bf16x8*)(Qg + qo2 + fq * 8); qn1 = *(const bf16x8*)(Qg + qo2 + 32 + fq * 8); }
        const int pslot = (nb - 1) & 1;
        f32x4 S[10];
#pragma unroll
        for (int kbi = 0; kbi < 10; ++kbi) {
            int kb = w + kbi; if (kb > 15) kb = 15;
            const int ki = kb * 16 + fr; const int phys = ((pslot + (ki >> 7)) & 1) * 128 + (ki & 127);
            const bf16x8 k0 = *(const LAS bf16x8*)(Kl + phys * AK_RS + fq * 16), k1 = *(const LAS bf16x8*)(Kl + phys * AK_RS + 64 + fq * 16);
            f32x4 a = (f32x4){0.f, 0.f, 0.f, 0.f};
            a = __builtin_amdgcn_mfma_f32_16x16x32_bf16(k0, q0, a, 0, 0, 0);
            S[kbi] = __builtin_amdgcn_mfma_f32_16x16x32_bf16(k1, q1, a, 0, 0, 0);
        }
        float mx = -INFINITY;
#pragma unroll
        for (int kbi = 0; kbi < 10; ++kbi)
#pragma unroll
            for (int j = 0; j < 4; ++j) { const int ki = (w + kbi) * 16 + 4 * fq + j; const int dist = 16 * w + fr + 128 - ki;
                const bool ok = dist >= 0 && dist <= 128 && (nb > 0 || ki >= 128) && (w + kbi) < 16;
                const float sc = ok ? S[kbi][j] - slope * (float)dist : -INFINITY; S[kbi][j] = sc; mx = fmaxf(mx, sc); }
        mx = fmaxf(mx, __shfl_xor(mx, 16)); mx = fmaxf(mx, __shfl_xor(mx, 32));
        float ls = 0.f;
#pragma unroll
        for (int kbi = 0; kbi < 10; ++kbi)
#pragma unroll
            for (int j = 0; j < 4; ++j) { const float p = __expf(S[kbi][j] - mx); S[kbi][j] = p; ls += p; }
        ls += __shfl_xor(ls, 16); ls += __shfl_xor(ls, 32);
        f32x4 O[4];
#pragma unroll
        for (int db = 0; db < 4; ++db) O[db] = (f32x4){0.f, 0.f, 0.f, 0.f};
#pragma unroll
        for (int k2 = 0; k2 < 5; ++k2) {
            u32x4 pw; pw.x = cvt_pk_bf16(S[2 * k2][0], S[2 * k2][1]); pw.y = cvt_pk_bf16(S[2 * k2][2], S[2 * k2][3]); pw.z = cvt_pk_bf16(S[2 * k2 + 1][0], S[2 * k2 + 1][1]); pw.w = cvt_pk_bf16(S[2 * k2 + 1][2], S[2 * k2 + 1][3]);
            const bf16x8 pf = __builtin_bit_cast(bf16x8, pw);
            int kb0 = w + 2 * k2, kb1 = kb0 + 1; if (kb1 > 15) kb1 = 15; if (kb0 > 15) kb0 = 15;
            const int r0 = kb0 * 16 + 4 * fq + (fr >> 2), r1 = kb1 * 16 + 4 * fq + (fr >> 2);
            const int p0 = ((pslot + (r0 >> 7)) & 1) * 128 + (r0 & 127), p1 = ((pslot + (r1 >> 7)) & 1) * 128 + (r1 & 127);
#pragma unroll
            for (int db = 0; db < 4; ++db) {
                const s16x4 v0 = lds_tr16(Vl + p0 * AV_RS + (db * 16 + 4 * (fr & 3)) * 2), v1 = lds_tr16(Vl + p1 * AV_RS + (db * 16 + 4 * (fr & 3)) * 2);
                const bf16x8 vf = (bf16x8){v0[0], v0[1], v0[2], v0[3], v1[0], v1[1], v1[2], v1[3]};
                O[db] = __builtin_amdgcn_mfma_f32_16x16x32_bf16(vf, pf, O[db], 0, 0, 0);
            }
        }
        const float inv = 1.0f / ls;
#pragma unroll
        for (int db = 0; db < 4; ++db) { u32x2 ow; ow.x = cvt_pk_bf16(O[db][0] * inv, O[db][1] * inv); ow.y = cvt_pk_bf16(O[db][2] * inv, O[db][3] * inv);
            *(u32x2*)(Qg + qoff + db * 16 + 4 * fq) = ow; }
        if (fq == 0) LSE[(qoff >> 9) * 8] = mx + __logf(ls);
        __syncthreads();
        if (more) ATT_STORE(nb + 1);
        __syncthreads();
    }
#undef ATT_LOAD
#undef ATT_STORE
}
__device__ __forceinline__ void attn_combine(const Ctx& F) {
    const float* LSE = (const float*)(F.ws + WS_LOGITS);
    for (int i = F.bid * NTHREADS + F.tid; i < T * 64; i += F.G * NTHREADS) {
        const int t = i >> 6, c8 = i & 63, slot = c8 >> 3;
        const float l0 = LSE[(size_t)t * 8 + slot], l1 = LSE[(size_t)T * 8 + (size_t)t * 8 + slot], l2 = LSE[(size_t)2 * T * 8 + (size_t)t * 8 + slot];
        const float m = fmaxf(l0, fmaxf(l1, l2)); float w0 = __expf(l0 - m), w1 = __expf(l1 - m), w2 = __expf(l2 - m); const float inv = 1.0f / (w0 + w1 + w2); w0 *= inv; w1 *= inv; w2 *= inv;
        u32x4* p0 = (u32x4*)(F.ws + WS_QA0) + i; const u32x4 a = *p0, bb = ((const u32x4*)(F.ws + WS_QA1))[i], cc = ((const u32x4*)(F.ws + WS_QA2))[i];
        f32x4 a0, a1, b0, b1, c0, c1; unpack8(a, a0, a1); unpack8(bb, b0, b1); unpack8(cc, c0, c1);
        *p0 = pack8(a0 * w0 + b0 * w1 + c0 * w2, a1 * w0 + b1 * w1 + c1 * w2);
    }
}

__device__ __forceinline__ void conv_item(const Ctx& F, int layer, int item) {
    const int t0 = item * 32, s0 = t0 & (SEQ - 1), tid = F.tid;
    LAS bf16_t* sin = (LAS bf16_t*)F.lds;
    LAS float* sout = (LAS float*)(F.lds + 65536);
    const bf16_t* YG = (const bf16_t*)(F.ws + WS_YG);
    __syncthreads();
    for (int i = tid; i < 62 * 64; i += NTHREADS) { const int r = i >> 6, c8 = i & 63; const int sp = s0 - 30 + r;
        u32x4 v = (u32x4){0u, 0u, 0u, 0u}; if (sp >= 0) v = *(const u32x4*)(YG + (size_t)(t0 - 30 + r) * 512 + c8 * 8);
        *(LAS u32x4*)(sin + r * 512 + c8 * 8) = v; }
    const int cp = tid & 255, hf = tid >> 8;
    f32x2 w[31];
    const float* cw = F.in[I_CONVW] + (size_t)layer * 31 * 512 + 2 * cp;
#pragma unroll
    for (int k = 0; k < 31; ++k) w[k] = *(const f32x2*)(cw + k * 512);
    const f32x2 cb = *(const f32x2*)(F.in[I_CONVB] + layer * 512 + 2 * cp);
    __syncthreads();
#pragma unroll 1
    for (int ps = 0; ps < 2; ++ps) { const int tb = 16 * hf + 8 * ps;
        f32x2 xin[38];
#pragma unroll
        for (int r = 0; r < 38; ++r) { const unsigned u = *(const LAS unsigned*)(sin + (tb + r) * 512 + 2 * cp); xin[r] = (f32x2){bf_lo(u), bf_hi(u)}; }
#pragma unroll
        for (int tt = 0; tt < 8; ++tt) { f32x2 a = cb;
#pragma unroll
            for (int k = 0; k < 31; ++k) a += w[k] * xin[tt + k];
            *(LAS f32x2*)(sout + (tb + tt) * 512 + 2 * cp) = a; } }
    __syncthreads();
    const float* lg = F.in[I_CLNG] + layer * 512 + F.lane * 8; const float* lb = F.in[I_CLNB] + layer * 512 + F.lane * 8;
    for (int tt = F.wave; tt < 32; tt += NWAVES) {
        float v[8]; float sm = 0.f;
#pragma unroll
        for (int j = 0; j < 8; ++j) { v[j] = sout[tt * 512 + F.lane * 8 + j]; sm += v[j]; }
        const float mu = wave_sum(sm) * (1.0f / 512.0f); float q = 0.f;
#pragma unroll
        for (int j = 0; j < 8; ++j) { v[j] -= mu; q += v[j] * v[j]; }
        const float rstd = rsqrtf(wave_sum(q) * (1.0f / 512.0f) + EPS);
        float o[8];
#pragma unroll
        for (int j = 0; j < 8; ++j) o[j] = siluf_(v[j] * rstd * lg[j] + lb[j]);
        u32x4 wv; wv.x = cvt_pk_bf16(o[0], o[1]); wv.y = cvt_pk_bf16(o[2], o[3]); wv.z = cvt_pk_bf16(o[4], o[5]); wv.w = cvt_pk_bf16(o[6], o[7]);
        *(u32x4*)((bf16_t*)(F.ws + WS_YC) + (size_t)(t0 + tt) * 512 + F.lane * 8) = wv;
    }
}

__device__ __forceinline__ float log_sigmoid_(float v) { return fminf(v, 0.f) - log1pf(__expf(-fabsf(v))); }
__device__ __forceinline__ void qk_conv8(const Ctx& F, int layer, const bf16_t* src  , int t, int s, int ch  , int chq, float scale, float* o) {
    const float* cw = F.in[I_MCW] + (size_t)layer * 4 * 1024 + chq; const float* cb = F.in[I_MCB] + (size_t)layer * 1024 + chq;
#pragma unroll
    for (int j = 0; j < 8; ++j) o[j] = cb[j];
#pragma unroll
    for (int k = 0; k < 4; ++k) { if (s - 3 + k >= 0) { const u32x4 w = *(const u32x4*)(src + (size_t)(t - 3 + k) * 512 + ch); const float* wk = cw + k * 1024;
            o[0] += wk[0] * bf_lo(w.x); o[1] += wk[1] * bf_hi(w.x); o[2] += wk[2] * bf_lo(w.y); o[3] += wk[3] * bf_hi(w.y); o[4] += wk[4] * bf_lo(w.z); o[5] += wk[5] * bf_hi(w.z); o[6] += wk[6] * bf_lo(w.w); o[7] += wk[7] * bf_hi(w.w); } }
#pragma unroll
    for (int j = 0; j < 8; ++j) o[j] = siluf_(o[j]) * scale;
}
__device__ __forceinline__ void mlstm_scalars(const Ctx& F, int layer, int t0, int h, LAS float* sIG, LAS float* sBC) {
    if (F.tid < 128) { const float* IFp = (const float*)(F.ws + WS_IF) + (size_t)(t0 + F.tid) * 8;
        sIG[F.tid] = IFp[h] + F.in[I_MIB][layer * 4 + h]; sBC[F.tid] = log_sigmoid_(IFp[4 + h] + F.in[I_MFB][layer * 4 + h]); }
    __syncthreads();
    if (F.wave == 0) { const float a = sBC[2 * F.lane], bb = sBC[2 * F.lane + 1]; float sc = a + bb;
#pragma unroll
        for (int off = 1; off < 64; off <<= 1) { const float t = __shfl_up(sc, off); if (F.lane >= off) sc += t; }
        sBC[2 * F.lane] = sc - bb; sBC[2 * F.lane + 1] = sc; }
    __syncthreads();
}
__device__ __forceinline__ void mlstm_local_v1(const Ctx& F, int layer, int item) {
    const int c = item & 127, bh = item >> 7, h = bh & 3, b = bh >> 2, t0 = b * SEQ + c * 128, tid = F.tid;
    LAS float* EV = (LAS float*)F.lds;
    LAS float* KC = (LAS float*)(F.lds + 65536);
    LAS float* sIG = (LAS float*)(F.lds + 131072); LAS float* sBC = sIG + 128; LAS float* sE = sIG + 256; LAS float* sM = sIG + 384;
    mlstm_scalars(F, layer, t0, h, sIG, sBC);
    if (tid == 0) { const float gt = sBC[127]; float m = -INFINITY; for (int l = 0; l < 128; ++l) m = fmaxf(m, gt - sBC[l] + sIG[l]); sM[0] = m; sM[1] = gt; }
    __syncthreads();
    if (tid < 128) sE[tid] = __expf(sM[1] - sBC[tid] + sIG[tid] - sM[0]);
    __syncthreads();
    const bf16_t* KM = (const bf16_t*)(F.ws + WS_KM); const bf16_t* VM = (const bf16_t*)(F.ws + WS_VM);
    for (int i = tid; i < 128 * 16; i += NTHREADS) { const int l = i >> 4, c8 = (i & 15) * 8; const int t = t0 + l, s = t & (SEQ - 1);
        float o[8]; qk_conv8(F, layer, KM, t, s, h * 128 + c8, 512 + h * 128 + c8, 0.08838834764831845f, o);
#pragma unroll
        for (int j = 0; j < 8; ++j) KC[l * 128 + c8 + j] = o[j];
        const u32x4 w = *(const u32x4*)(VM + (size_t)t * 512 + h * 128 + c8); const float e = sE[l];
        EV[l * 128 + c8] = e * bf_lo(w.x); EV[l * 128 + c8 + 1] = e * bf_hi(w.x); EV[l * 128 + c8 + 2] = e * bf_lo(w.y); EV[l * 128 + c8 + 3] = e * bf_hi(w.y);
        EV[l * 128 + c8 + 4] = e * bf_lo(w.z); EV[l * 128 + c8 + 5] = e * bf_hi(w.z); EV[l * 128 + c8 + 6] = e * bf_lo(w.w); EV[l * 128 + c8 + 7] = e * bf_hi(w.w); }
    __syncthreads();
    { const int v = tid >> 2, kq = tid & 3; float a[32];
#pragma unroll
        for (int i = 0; i < 32; ++i) a[i] = 0.f;
#pragma unroll 1
        for (int l = 0; l < 128; ++l) { const float ev = EV[l * 128 + v];
#pragma unroll
            for (int i = 0; i < 32; ++i) a[i] += ev * KC[l * 128 + kq * 32 + i]; }
        bf16_t* Cp = (bf16_t*)(F.ws + WS_CST) + ((size_t)(bh * 128 + c) << 14) + v * 128 + kq * 32;
#pragma unroll
        for (int i = 0; i < 4; ++i) { u32x4 w; w.x = cvt_pk_bf16(a[8 * i], a[8 * i + 1]); w.y = cvt_pk_bf16(a[8 * i + 2], a[8 * i + 3]); w.z = cvt_pk_bf16(a[8 * i + 4], a[8 * i + 5]); w.w = cvt_pk_bf16(a[8 * i + 6], a[8 * i + 7]); ((u32x4*)Cp)[i] = w; } }
    if (tid < 128) { float n = 0.f; for (int l = 0; l < 128; ++l) n += sE[l] * KC[l * 128 + tid]; ((float*)(F.ws + WS_NST))[(size_t)(bh * 128 + c) * 128 + tid] = n; }
    if (tid == 0) { ((float*)(F.ws + WS_TAB + TAB_MLOC))[bh * 128 + c] = sM[0]; ((float*)(F.ws + WS_TAB + TAB_GTOT))[bh * 128 + c] = sM[1]; }
    __syncthreads();
}
constexpr int ML_KRS = 288, ML_ERS = 352, ML_E = 128 * ML_KRS, ML_S = ML_E + 128 * ML_ERS;
__device__ __forceinline__ void mlstm_local_mfma(const Ctx& F, int layer, int item) {
    const int c = item & 127, bh = item >> 7, h = bh & 3, b = bh >> 2, t0 = b * SEQ + c * 128, tid = F.tid, lane = F.lane, w = F.wave, fr = lane & 15, fq = lane >> 4;
    LAS unsigned char* L = F.lds;
    LAS float* sIG = (LAS float*)(L + ML_S); LAS float* sBC = sIG + 128; LAS float* sE = sIG + 256; LAS float* sM = sIG + 384;
    __syncthreads();
    mlstm_scalars(F, layer, t0, h, sIG, sBC);
    if (w == 0) { const float gt = sBC[127]; const float m = wave_max(fmaxf(gt - sBC[lane] + sIG[lane], gt - sBC[lane + 64] + sIG[lane + 64])); if (lane == 0) { sM[0] = m; sM[1] = gt; } }
    __syncthreads();
    if (tid < 128) sE[tid] = __expf(sM[1] - sBC[tid] + sIG[tid] - sM[0]);
    __syncthreads();
    const bf16_t* KM = (const bf16_t*)(F.ws + WS_KM); const bf16_t* VM = (const bf16_t*)(F.ws + WS_VM);
    for (int i = tid; i < 128 * 16; i += NTHREADS) { const int l = i >> 4, c8 = (i & 15) * 8; const int t = t0 + l, s = t & (SEQ - 1);
        float o[8]; qk_conv8(F, layer, KM, t, s, h * 128 + c8, 512 + h * 128 + c8, 0.08838834764831845f, o);
        *(LAS u32x4*)(L + l * ML_KRS + c8 * 2) = pack8((f32x4){o[0], o[1], o[2], o[3]}, (f32x4){o[4], o[5], o[6], o[7]});
        f32x4 v0, v1; unpack8(*(const u32x4*)(VM + (size_t)t * 512 + h * 128 + c8), v0, v1); const float e = sE[l];
        *(LAS u32x4*)(L + ML_E + l * ML_ERS + c8 * 2) = pack8(v0 * e, v1 * e); }
    if (tid < 128) { u32x4 z; z.x = f2bf(sE[tid]); z.y = 0u; z.z = 0u; z.w = 0u; *(LAS u32x4*)(L + ML_E + tid * ML_ERS + 256) = z; z.x = 0u; *(LAS u32x4*)(L + ML_E + tid * ML_ERS + 272) = z; }
    __syncthreads();
    bf16x8 af[4];
#pragma unroll
    for (int ks = 0; ks < 4; ++ks) { const int ra = ks * 32 + 4 * fq + (fr >> 2);
        const s16x4 a0 = lds_tr16(L + ra * ML_KRS + (w * 16 + 4 * (fr & 3)) * 2), a1 = lds_tr16(L + (ra + 16) * ML_KRS + (w * 16 + 4 * (fr & 3)) * 2);
        af[ks] = (bf16x8){a0[0], a0[1], a0[2], a0[3], a1[0], a1[1], a1[2], a1[3]}; }
    bf16_t* Cp = (bf16_t*)(F.ws + WS_CST) + ((size_t)(bh * 128 + c) << 14);
#pragma unroll
    for (int vb = 0; vb < 9; ++vb) { f32x4 d = (f32x4){0.f, 0.f, 0.f, 0.f};
#pragma unroll
        for (int ks = 0; ks < 4; ++ks) { const int rb = ks * 32 + 4 * fq + (fr >> 2);
            const s16x4 b0 = lds_tr16(L + ML_E + rb * ML_ERS + (vb * 16 + 4 * (fr & 3)) * 2), b1 = lds_tr16(L + ML_E + (rb + 16) * ML_ERS + (vb * 16 + 4 * (fr & 3)) * 2);
            const bf16x8 bfr = (bf16x8){b0[0], b0[1], b0[2], b0[3], b1[0], b1[1], b1[2], b1[3]};
            d = __builtin_amdgcn_mfma_f32_16x16x32_bf16(af[ks], bfr, d, 0, 0, 0); }
        if (vb < 8) { u32x2 o; o.x = pk2(d[0], d[1]); o.y = pk2(d[2], d[3]); *(u32x2*)(Cp + (size_t)(vb * 16 + fr) * 128 + w * 16 + 4 * fq) = o; }
        else if (fr == 0) *(f32x4*)((float*)(F.ws + WS_NST) + (size_t)(bh * 128 + c) * 128 + w * 16 + 4 * fq) = d;
    }
    if (tid == 0) { ((float*)(F.ws + WS_TAB + TAB_MLOC))[bh * 128 + c] = sM[0]; ((float*)(F.ws + WS_TAB + TAB_GTOT))[bh * 128 + c] = sM[1]; }
}
__device__ __forceinline__ void phase_scan(const Ctx& F) {
    const float* GT = (const float*)(F.ws + WS_TAB + TAB_GTOT); const float* ML = (const float*)(F.ws + WS_TAB + TAB_MLOC); float* MS = (float*)(F.ws + WS_TAB + TAB_MST);
    LAS float* sA = (LAS float*)F.lds; LAS float* sB = sA + 128;
    for (int blk = F.bid; blk < 8 * 32 + 8; blk += F.G) {
        const bool isC = blk < 256; const int bh = isC ? (blk >> 5) : (blk - 256);
        __syncthreads();
        if (F.tid < 128) { sA[F.tid] = GT[bh * 128 + F.tid]; sB[F.tid] = ML[bh * 128 + F.tid]; }
        __syncthreads();
        if (F.tid == 0) { float mp = 0.f;
            for (int c = 0; c < 128; ++c) { const float gc = sA[c], ml = sB[c]; const float mn = fmaxf(gc + mp, ml); sA[c] = __expf(gc + mp - mn); sB[c] = __expf(ml - mn);
                if (isC && (blk & 31) == 0) MS[bh * 128 + c] = mp; mp = mn; } }
        __syncthreads();
        if (isC) { bf16_t* cp = (bf16_t*)(F.ws + WS_CST) + ((size_t)(bh * 128) << 14) + (blk & 31) * 512 + F.tid; float val = 0.f;
            for (int c0 = 0; c0 < 128; c0 += 16) { float loc[16];
#pragma unroll
                for (int j = 0; j < 16; ++j) loc[j] = bf1(cp[(size_t)(c0 + j) << 14]);
#pragma unroll
                for (int j = 0; j < 16; ++j) { cp[(size_t)(c0 + j) << 14] = (bf16_t)f2bf(val); val = sA[c0 + j] * val + sB[c0 + j] * loc[j]; } } }
        else if (F.tid < 128) { float* np = (float*)(F.ws + WS_NST) + (size_t)(bh * 128) * 128 + F.tid; float val = 0.f;
            for (int c0 = 0; c0 < 128; c0 += 16) { float loc[16];
#pragma unroll
                for (int j = 0; j < 16; ++j) loc[j] = np[(size_t)(c0 + j) * 128];
#pragma unroll
                for (int j = 0; j < 16; ++j) { np[(size_t)(c0 + j) * 128] = val; val = sA[c0 + j] * val + sB[c0 + j] * loc[j]; } } }
    }
    __syncthreads();
}
__device__ __forceinline__ void mlstm_out_v1(const Ctx& F, int layer, int item) {
    const int c = item & 127, bh = item >> 7, h = bh & 3, b = bh >> 2, t0 = b * SEQ + c * 128, tid = F.tid;
    constexpr int LS = 129;
    LAS float* bA = (LAS float*)F.lds;
    LAS float* bB = (LAS float*)(F.lds + 66560);
    LAS float* sIG = (LAS float*)(F.lds + 133120); LAS float* sBC = sIG + 128; LAS float* sMT = sIG + 256; LAS float* sSI = sIG + 384; LAS float* sNS = sIG + 512;
    mlstm_scalars(F, layer, t0, h, sIG, sBC);
    const float mst = ((const float*)(F.ws + WS_TAB + TAB_MST))[bh * 128 + c];
    if (tid == 0) { float pm = -INFINITY; for (int q = 0; q < 128; ++q) { pm = fmaxf(pm, sIG[q] - sBC[q]); const float ai = sBC[q] + mst; const float mt = fmaxf(ai, sBC[q] + pm); sMT[q] = mt; sSI[q] = __expf(ai - mt); } }
    if (tid < 128) sNS[tid] = ((const float*)(F.ws + WS_NST))[(size_t)(bh * 128 + c) * 128 + tid];
    const bf16_t* QM = (const bf16_t*)(F.ws + WS_QM); const bf16_t* KM = (const bf16_t*)(F.ws + WS_KM); const bf16_t* VM = (const bf16_t*)(F.ws + WS_VM);
    for (int i = tid; i < 128 * 16; i += NTHREADS) { const int l = i >> 4, c8 = (i & 15) * 8; const int t = t0 + l, s = t & (SEQ - 1); float o[8];
        qk_conv8(F, layer, QM, t, s, h * 128 + c8, h * 128 + c8, 1.0f, o);
#pragma unroll
        for (int j = 0; j < 8; ++j) bA[l * LS + c8 + j] = o[j];
        qk_conv8(F, layer, KM, t, s, h * 128 + c8, 512 + h * 128 + c8, 0.08838834764831845f, o);
#pragma unroll
        for (int j = 0; j < 8; ++j) bB[l * LS + c8 + j] = o[j]; }
    __syncthreads();
    const int q = tid >> 2, kq = tid & 3;
    float sc[32], inter[32];
#pragma unroll
    for (int i = 0; i < 32; ++i) sc[i] = 0.f;
#pragma unroll 1
    for (int d = 0; d < 128; ++d) { const float qv = bA[q * LS + d];
#pragma unroll
        for (int i = 0; i < 32; ++i) sc[i] += qv * bB[(4 * i + kq) * LS + d]; }
    float den = 0.f;
    { const float bq = sBC[q], mt = sMT[q];
#pragma unroll
        for (int i = 0; i < 32; ++i) { const int k = 4 * i + kq; const float w = (k <= q) ? __expf(bq - sBC[k] + sIG[k] - mt) : 0.f; sc[i] *= w; den += sc[i]; } }
    __syncthreads();
    { const bf16_t* Cp = (const bf16_t*)(F.ws + WS_CST) + ((size_t)(bh * 128 + c) << 14);
        for (int i = tid; i < 128 * 16; i += NTHREADS) { const int v = i >> 4, c8 = (i & 15) * 8; const u32x4 w = *(const u32x4*)(Cp + v * 128 + c8);
            bB[v * LS + c8] = bf_lo(w.x); bB[v * LS + c8 + 1] = bf_hi(w.x); bB[v * LS + c8 + 2] = bf_lo(w.y); bB[v * LS + c8 + 3] = bf_hi(w.y); bB[v * LS + c8 + 4] = bf_lo(w.z); bB[v * LS + c8 + 5] = bf_hi(w.z); bB[v * LS + c8 + 6] = bf_lo(w.w); bB[v * LS + c8 + 7] = bf_hi(w.w); } }
    __syncthreads();
#pragma unroll
    for (int i = 0; i < 32; ++i) inter[i] = 0.f;
    float dn = 0.f;
#pragma unroll 1
    for (int d = 0; d < 128; ++d) { const float qv = bA[q * LS + d];
#pragma unroll
        for (int i = 0; i < 32; ++i) inter[i] += qv * bB[(4 * i + kq) * LS + d];
        if ((d >> 5) == kq) dn += qv * sNS[d]; }
    __syncthreads();
#pragma unroll
    for (int i = 0; i < 32; ++i) bA[q * LS + 4 * i + kq] = sc[i];
    for (int i = tid; i < 128 * 16; i += NTHREADS) { const int l = i >> 4, c8 = (i & 15) * 8; const u32x4 w = *(const u32x4*)(VM + (size_t)(t0 + l) * 512 + h * 128 + c8);
        bB[l * LS + c8] = bf_lo(w.x); bB[l * LS + c8 + 1] = bf_hi(w.x); bB[l * LS + c8 + 2] = bf_lo(w.y); bB[l * LS + c8 + 3] = bf_hi(w.y); bB[l * LS + c8 + 4] = bf_lo(w.z); bB[l * LS + c8 + 5] = bf_hi(w.z); bB[l * LS + c8 + 6] = bf_lo(w.w); bB[l * LS + c8 + 7] = bf_hi(w.w); }
    __syncthreads();
    float num[32];
#pragma unroll
    for (int i = 0; i < 32; ++i) num[i] = 0.f;
#pragma unroll 1
    for (int k = 0; k < 128; ++k) { const float sv = bA[q * LS + k];
#pragma unroll
        for (int i = 0; i < 32; ++i) num[i] += sv * bB[k * LS + 4 * i + kq]; }
    den += __shfl_xor(den, 1); den += __shfl_xor(den, 2); dn += __shfl_xor(dn, 1); dn += __shfl_xor(dn, 2);
    const float si = sSI[q]; const float dd = den + si * dn; const float inv = (ABL == 3) ? 0.f : 1.0f / fmaxf(fabsf(dd), __expf(-sMT[q]));
    bf16_t* OM = (bf16_t*)(F.ws + WS_OM) + (size_t)(t0 + q) * 512 + h * 128;
#pragma unroll
    for (int i = 0; i < 32; ++i) { const int v = 4 * i + kq; const float hv = (num[i] + si * inter[i]) * inv; OM[v] = (bf16_t)f2bf(bf1(OM[v]) * hv); }
    __syncthreads();
}

constexpr int MO_RS = 272, MO_VRS = 288;
constexpr int MO_Q = 0, MO_K = 128 * MO_RS, MO_C = 2 * 128 * MO_RS, MO_V = MO_C + 144 * MO_RS, MO_S = MO_V + 128 * MO_VRS;
static_assert(MO_S + 2560 <= MISC_OFF, "mlstm_out LDS");
__device__ __forceinline__ void mlstm_out_mfma(const Ctx& F, int layer, int item) {
    const int c = item & 127, bh = item >> 7, h = bh & 3, b = bh >> 2, t0 = b * SEQ + c * 128, tid = F.tid, lane = F.lane, w = F.wave, fr = lane & 15, fq = lane >> 4;
    LAS unsigned char* L = F.lds;
    LAS float* sIG = (LAS float*)(L + MO_S); LAS float* sBC = sIG + 128; LAS float* sMT = sIG + 256; LAS float* sSI = sIG + 384;
    __syncthreads();
    mlstm_scalars(F, layer, t0, h, sIG, sBC);
    const float mst = ((const float*)(F.ws + WS_TAB + TAB_MST))[bh * 128 + c];
    if (w == 0) { const float a = sIG[2 * lane] - sBC[2 * lane], bb = sIG[2 * lane + 1] - sBC[2 * lane + 1]; float pm = fmaxf(a, bb);
#pragma unroll
        for (int off = 1; off < 64; off <<= 1) { const float t = __shfl_up(pm, off); if (lane >= off) pm = fmaxf(pm, t); }
        float pl = __shfl_up(pm, 1); if (lane == 0) pl = -INFINITY;
        const float p0 = fmaxf(pl, a), p1 = pm;
        { const float ai = sBC[2 * lane] + mst, mt = fmaxf(ai, sBC[2 * lane] + p0); sMT[2 * lane] = mt; sSI[2 * lane] = __expf(ai - mt); }
        { const float ai = sBC[2 * lane + 1] + mst, mt = fmaxf(ai, sBC[2 * lane + 1] + p1); sMT[2 * lane + 1] = mt; sSI[2 * lane + 1] = __expf(ai - mt); } }
    const bf16_t* QM = (const bf16_t*)(F.ws + WS_QM); const bf16_t* KM = (const bf16_t*)(F.ws + WS_KM); const bf16_t* VM = (const bf16_t*)(F.ws + WS_VM);
    const bf16_t* Cp = (const bf16_t*)(F.ws + WS_CST) + ((size_t)(bh * 128 + c) << 14);
    for (int i = tid; i < 128 * 16; i += NTHREADS) { const int l = i >> 4, c8 = (i & 15) * 8; const int t = t0 + l, s = t & (SEQ - 1); float o[8];
        qk_conv8(F, layer, QM, t, s, h * 128 + c8, h * 128 + c8, 1.0f, o);
        *(LAS u32x4*)(L + MO_Q + l * MO_RS + c8 * 2) = pack8((f32x4){o[0], o[1], o[2], o[3]}, (f32x4){o[4], o[5], o[6], o[7]});
        qk_conv8(F, layer, KM, t, s, h * 128 + c8, 512 + h * 128 + c8, 0.08838834764831845f, o);
        *(LAS u32x4*)(L + MO_K + l * MO_RS + c8 * 2) = pack8((f32x4){o[0], o[1], o[2], o[3]}, (f32x4){o[4], o[5], o[6], o[7]});
        *(LAS u32x4*)(L + MO_V + l * MO_VRS + c8 * 2) = *(const u32x4*)(VM + (size_t)t * 512 + h * 128 + c8);
        *(LAS u32x4*)(L + MO_C + l * MO_RS + c8 * 2) = *(const u32x4*)(Cp + l * 128 + c8); }
    if (tid < 16) { const float* np = (const float*)(F.ws + WS_NST) + (size_t)(bh * 128 + c) * 128 + tid * 8;
        *(LAS u32x4*)(L + MO_C + 128 * MO_RS + tid * 16) = pack8(*(const f32x4*)np, *(const f32x4*)(np + 4)); }
    __syncthreads();
    const int q = 16 * w + fr;
    bf16x8 qf[4];
#pragma unroll
    for (int ks = 0; ks < 4; ++ks) qf[ks] = *(const LAS bf16x8*)(L + MO_Q + q * MO_RS + ks * 64 + fq * 16);
    f32x4 O[9];
#pragma unroll
    for (int vb = 0; vb < 9; ++vb) { f32x4 a = (f32x4){0.f, 0.f, 0.f, 0.f};
#pragma unroll
        for (int ks = 0; ks < 4; ++ks) { const bf16x8 cf = *(const LAS bf16x8*)(L + MO_C + (vb * 16 + fr) * MO_RS + ks * 64 + fq * 16); a = __builtin_amdgcn_mfma_f32_16x16x32_bf16(cf, qf[ks], a, 0, 0, 0); }
        O[vb] = a; }
    const float si = sSI[q], mt = sMT[q], bq = sBC[q];
    const float dn = __shfl(O[8][0], fr);
#pragma unroll
    for (int vb = 0; vb < 8; ++vb) O[vb] = O[vb] * si;
    float den = 0.f;
    for (int k2 = 0; k2 <= (w >> 1); ++k2) {
        f32x4 P[2];
#pragma unroll
        for (int u = 0; u < 2; ++u) { const int kb = 2 * k2 + u; f32x4 a = (f32x4){0.f, 0.f, 0.f, 0.f};
            const int kr = (kb > 7 ? 7 : kb) * 16 + fr;
#pragma unroll
            for (int ks = 0; ks < 4; ++ks) { const bf16x8 kf = *(const LAS bf16x8*)(L + MO_K + kr * MO_RS + ks * 64 + fq * 16); a = __builtin_amdgcn_mfma_f32_16x16x32_bf16(kf, qf[ks], a, 0, 0, 0); }
#pragma unroll
            for (int j = 0; j < 4; ++j) { const int k = kb * 16 + 4 * fq + j; const int kc = k > 127 ? 127 : k; const float wgt = (k <= q) ? __expf(bq - sBC[kc] + sIG[kc] - mt) : 0.f; a[j] *= wgt; den += a[j]; }
            P[u] = a; }
        u32x4 pw; pw.x = cvt_pk_bf16(P[0][0], P[0][1]); pw.y = cvt_pk_bf16(P[0][2], P[0][3]); pw.z = cvt_pk_bf16(P[1][0], P[1][1]); pw.w = cvt_pk_bf16(P[1][2], P[1][3]);
        const bf16x8 pf = __builtin_bit_cast(bf16x8, pw);
        const int kb1 = (2 * k2 + 1 > 7) ? 7 : 2 * k2 + 1;
        const int r0 = 2 * k2 * 16 + 4 * fq + (fr >> 2), r1 = kb1 * 16 + 4 * fq + (fr >> 2);
#pragma unroll
        for (int vb = 0; vb < 8; ++vb) {
            const s16x4 v0 = lds_tr16(L + MO_V + r0 * MO_VRS + (vb * 16 + 4 * (fr & 3)) * 2), v1 = lds_tr16(L + MO_V + r1 * MO_VRS + (vb * 16 + 4 * (fr & 3)) * 2);
            const bf16x8 vf = (bf16x8){v0[0], v0[1], v0[2], v0[3], v1[0], v1[1], v1[2], v1[3]};
            O[vb] = __builtin_amdgcn_mfma_f32_16x16x32_bf16(vf, pf, O[vb], 0, 0, 0);
        }
    }
    den += __shfl_xor(den, 16); den += __shfl_xor(den, 32);
    const float dd = den + si * dn; const float inv = 1.0f / fmaxf(fabsf(dd), __expf(-mt));
    bf16_t* OM = (bf16_t*)(F.ws + WS_OM) + (size_t)(t0 + q) * 512 + h * 128;
#pragma unroll
    for (int vb = 0; vb < 8; ++vb) { u32x2* p = (u32x2*)(OM + vb * 16 + 4 * fq); const u32x2 g = *p;
        u32x2 o; o.x = cvt_pk_bf16(bf_lo(g.x) * O[vb][0] * inv, bf_hi(g.x) * O[vb][1] * inv); o.y = cvt_pk_bf16(bf_lo(g.y) * O[vb][2] * inv, bf_hi(g.y) * O[vb][3] * inv); *p = o; }
}

__device__ __forceinline__ void phase_route(const Ctx& F, int layer) {
    int* tokl = (int*)(F.ws + WS_LISTS);
    for (int i = F.bid * NTHREADS + F.tid; i < 2 * LISTCAP; i += F.G * NTHREADS) tokl[i] = -1;
    LAS int* hist = (LAS int*)F.lds;
    const float* brg = F.in[I_BRG] + layer * 4; const float* bre = F.in[I_BRE] + layer * 32;
    for (int tile = F.bid; tile < 256; tile += F.G) {
        if (F.tid < 128) { const int t = tile * 128 + F.tid; const float* lg = (const float*)(F.ws + WS_LOGITS) + (size_t)t * 64;
            float g[4]; int gs = 0; float gm;
#pragma unroll
            for (int j = 0; j < 4; ++j) g[j] = lg[j] + brg[j];
            gm = g[0];
#pragma unroll
            for (int j = 1; j < 4; ++j) if (g[j] > gm) { gm = g[j]; gs = j; }
            float se = 0.f;
#pragma unroll
            for (int j = 0; j < 4; ++j) se += __expf(g[j] - gm);
            const float pg = 1.0f / se;
            float le[8];
#pragma unroll
            for (int j = 0; j < 8; ++j) le[j] = lg[4 + gs * 8 + j] + bre[gs * 8 + j];
            int i0 = 0; float v0 = le[0];
#pragma unroll
            for (int j = 1; j < 8; ++j) if (le[j] > v0) { v0 = le[j]; i0 = j; }
            int i1 = -1; float v1 = -INFINITY;
#pragma unroll
            for (int j = 0; j < 8; ++j) if (j != i0 && le[j] > v1) { v1 = le[j]; i1 = j; }
            const float e1 = __expf(v1 - v0); const float wsc = (ABL == 4) ? 0.f : ((ABL == 6) ? 2.f : 1.f); const float w0 = wsc * pg / (1.0f + e1), w1 = wsc * pg * e1 / (1.0f + e1);
            const int x0 = gs * 8 + i0, x1 = gs * 8 + i1;
            ((int*)(F.ws + WS_ROUTE))[2 * t] = x0; ((int*)(F.ws + WS_ROUTE))[2 * t + 1] = x1;
            ((float*)(F.ws + WS_ROUTE))[2 * T + 2 * t] = w0; ((float*)(F.ws + WS_ROUTE))[2 * T + 2 * t + 1] = w1;
            hist[F.tid] = x0; hist[128 + F.tid] = x1;
        }
        __syncthreads();
        if (F.tid < 64) { const int k = F.tid >> 5, e = F.tid & 31; int cnt = 0; for (int j = 0; j < 128; ++j) cnt += (hist[k * 128 + j] == e) ? 1 : 0; ((int*)(F.ws + WS_TAB + TAB_CNT))[tile * 64 + F.tid] = cnt; }
        __syncthreads();
    }
}
__device__ __forceinline__ void phase_dispatch(const Ctx& F) {
    LAS int* sTot = (LAS int*)F.lds; LAS int* sBef = sTot + 64; LAS int* sPs = sTot + 128; LAS int* sE = sTot + 256;
    const int* CNT = (const int*)(F.ws + WS_TAB + TAB_CNT); int* META = (int*)(F.ws + WS_TAB + TAB_META);
    int* tokl = (int*)(F.ws + WS_LISTS); float* wl = (float*)(F.ws + WS_LISTS) + 2 * LISTCAP;
    for (int tile = F.bid; tile < 256; tile += F.G) {
        if (F.tid < 64) { int tot = 0, bef = 0; for (int j = 0; j < 256; ++j) { const int v = CNT[j * 64 + F.tid]; tot += v; bef += (j < tile) ? v : 0; } sTot[F.tid] = tot; sBef[F.tid] = bef; }
        __syncthreads();
        if (F.tid < 2) { int ps = 0; for (int e = 0; e < 32; ++e) { sPs[F.tid * 33 + e] = ps; ps += ((sTot[F.tid * 32 + e] + 255) >> 8) << 8; } sPs[F.tid * 33 + 32] = ps;
            if (tile == 0) { META[F.tid] = ps >> 8; for (int e = 0; e <= 32; ++e) META[16 + 64 * F.tid + e] = sPs[F.tid * 33 + e]; } }
        int e0 = 0, e1 = 0; float w0 = 0.f, w1 = 0.f;
        if (F.tid < 128) { const int t = tile * 128 + F.tid; e0 = ((const int*)(F.ws + WS_ROUTE))[2 * t]; e1 = ((const int*)(F.ws + WS_ROUTE))[2 * t + 1];
            w0 = ((const float*)(F.ws + WS_ROUTE))[2 * T + 2 * t]; w1 = ((const float*)(F.ws + WS_ROUTE))[2 * T + 2 * t + 1]; sE[F.tid] = e0; sE[128 + F.tid] = e1; }
        __syncthreads();
        if (F.tid < 128) { int r0 = 0, r1 = 0; for (int j = 0; j < F.tid; ++j) { r0 += (sE[j] == e0) ? 1 : 0; r1 += (sE[128 + j] == e1) ? 1 : 0; }
            const int p0 = sPs[e0] + sBef[e0] + r0, p1 = sPs[33 + e1] + sBef[32 + e1] + r1;
            tokl[p0] = tile * 128 + F.tid; wl[p0] = w0; tokl[LISTCAP + p1] = tile * 128 + F.tid; wl[LISTCAP + p1] = w1; }
        __syncthreads();
    }
}
__device__ __forceinline__ void phase_final(const Ctx& F, const float* SS) {
    const int gw = F.bid * NWAVES + F.wave, NGW = F.G * NWAVES, lane = F.lane;
    for (int m = gw; m < T; m += NGW) { const float rs = row_rs(SS, m); f32x4* o = (f32x4*)(F.out + (size_t)m * D) + lane; const f32x4* g = (const f32x4*)F.in[I_GFIN] + lane;
#pragma unroll
        for (int j = 0; j < 4; ++j) o[64 * j] = o[64 * j] * rs * g[64 * j]; }
}

constexpr int PH_PER_LAYER = 15, PH_FINAL = DEPTH * PH_PER_LAYER, N_PHASES = PH_FINAL + 1;
struct Args { const float* in[28]; float* out; unsigned char* ws; int ph_lo, ph_hi; };

__device__ __forceinline__ Ctx mkctx(const Args& args, LAS unsigned char* lds, int wave_s) {
    Ctx F; asm volatile("" : "+s"(wave_s)); int tid = wave_s * 64 + lane_id_(); asm volatile("" : "+v"(tid));
    unsigned char* ws = args.ws; asm volatile("" : "+s"(ws)); float* outp = args.out; asm volatile("" : "+s"(outp));
    int bid = blockIdx.x; asm volatile("" : "+s"(bid)); int G = gridDim.x; asm volatile("" : "+s"(G));
    F.in = args.in; F.out = outp; F.ws = ws; F.lds = lds;
    F.tid = tid; F.lane = tid & 63; F.wave = wave_s; F.G = G; F.bid = bid;
    return F;
}
#ifndef ONLY_PHASE
#define ONLY_PHASE -1
#endif
__device__ __forceinline__ void run_phase(const Args& args, LAS unsigned char* lds, int ph, int wave_s) {
    const int layer = ph / PH_PER_LAYER, lp = ph - layer * PH_PER_LAYER;
    const size_t ssin = (layer & 1) ? WS_SS1 : WS_SS0, ssmid = (layer & 1) ? WS_SS0 : WS_SS1;
    if (ph == PH_FINAL) { const Ctx F = mkctx(args, lds, wave_s); phase_final(F, (const float*)(F.ws + WS_SS0)); return; }
    if (ONLY_PHASE >= 0 && lp != ONLY_PHASE) return;
    switch (lp) {
    case 0: { const Ctx F = mkctx(args, lds, wave_s); phase_prep(F, layer, (float*)(F.ws + ssin)); } break;
    case 1: { const Ctx F = mkctx(args, lds, wave_s); PhProj P{(const char*)F.ws + WS_XB, (const char*)F.ws + WS_WIN, (const float*)(F.ws + ssin), F.ws, F.G, F.bid}; pg8::gemm_phase(F.lds, P, F.tid); } break;
    case 2: { const Ctx F = mkctx(args, lds, wave_s);
        for (int it = F.bid; it < 768; it += F.G) attn_strip(F, it);
        __syncthreads();
        for (int it = F.bid; it < 1024; it += F.G) mlstm_local_mfma(F, layer, it);
        for (int it = F.bid; it < 1024; it += F.G) conv_item(F, layer, it);
    } break;
    case 3: { const Ctx F = mkctx(args, lds, wave_s); phase_scan(F); attn_combine(F); } break;
    case 4: { const Ctx F = mkctx(args, lds, wave_s); for (int it = F.bid; it < 1024; it += F.G) mlstm_out_mfma(F, layer, it); } break;
    case 5: { const Ctx F = mkctx(args, lds, wave_s); PhGates P{(const char*)F.ws + WS_XB, (const char*)F.ws + WS_WIN, (const float*)(F.ws + ssin), F.ws, F.G, F.bid}; pg8::gemm_phase(F.lds, P, F.tid); } break;
    case 6: { const Ctx F = mkctx(args, lds, wave_s); PhMerge P{F.ws, F.G, F.bid}; pg8::gemm_phase(F.lds, P, F.tid); } break;
    case 7: { const Ctx F = mkctx(args, lds, wave_s); PhOut P{F.ws, layer == 0 ? F.in[I_X] : (const float*)F.out, F.out, (float*)(F.ws + ssmid), F.G, F.bid}; pg8::gemm_phase(F.lds, P, F.tid); } break;
    case 8: { const Ctx F = mkctx(args, lds, wave_s); PhRouter P{F.ws, (const float*)(F.ws + ssmid), F.G, F.bid}; pg8::gemm_phase(F.lds, P, F.tid); phase_prep_experts(F, layer); } break;
    case 9: { const Ctx F = mkctx(args, lds, wave_s); phase_route(F, layer); } break;
    case 10: { const Ctx F = mkctx(args, lds, wave_s); phase_dispatch(F); } break;
    case 11: { const Ctx F = mkctx(args, lds, wave_s); PhUp P{F.ws, (const float*)(F.ws + ssmid), (const int*)(F.ws + WS_TAB + TAB_META), (const int*)(F.ws + WS_LISTS), F.G, F.bid}; pg8::gemm_phase(F.lds, P, F.tid); } break;
    case 12: { const Ctx F = mkctx(args, lds, wave_s); PhDown<1> P{F.ws, F.out, (float*)(F.ws + ssin), (const int*)(F.ws + WS_TAB + TAB_META), (const int*)(F.ws + WS_LISTS), (const float*)(F.ws + WS_LISTS) + 2 * LISTCAP, F.G, F.bid}; pg8::gemm_phase(F.lds, P, F.tid); } break;
    case 13: { const Ctx F = mkctx(args, lds, wave_s); PhDown<0> P{F.ws, F.out, (float*)(F.ws + ssin), (const int*)(F.ws + WS_TAB + TAB_META), (const int*)(F.ws + WS_LISTS), (const float*)(F.ws + WS_LISTS) + 2 * LISTCAP, F.G, F.bid}; pg8::gemm_phase(F.lds, P, F.tid); } break;
    case 14: { const Ctx F = mkctx(args, lds, wave_s); PhPle P{F.ws, F.out, (const float*)(F.ws + ssin), (float*)(F.ws + ssmid), F.G, F.bid}; pg8::gemm_phase(F.lds, P, F.tid); } break;
    }
}

__global__ void __launch_bounds__(NTHREADS, 2) fwd_kernel(Args args) {
    extern __shared__ __attribute__((aligned(16))) unsigned char lds_raw[];
    LAS unsigned char* lds = (LAS unsigned char*)lds_raw;
    volatile LAS unsigned* MISC = (volatile LAS unsigned*)(lds + MISC_OFF);
    const int wave_s = __builtin_amdgcn_readfirstlane((int)threadIdx.x >> 6);
    if (wave_s == 0) MISC[lane_id_()] = 0u;
    __syncthreads();
#if MK_MEGA
    XcdBarrier bar = xcd_barrier_post((unsigned*)(args.ws + WS_CTL) + 4096, MISC + 8, wave_s);
#endif
#ifndef PROBE_SEL
#define PROBE_SEL 0
#endif
    unsigned long long extra = 0ull;
    for (int ph = args.ph_lo; ph < args.ph_hi; ++ph) {
        const unsigned long long t0 = PROBE_SEL ? __builtin_amdgcn_s_memrealtime() : 0ull;
        run_phase(args, lds, ph, wave_s);
#if MK_MEGA
        if (ph + 1 < args.ph_hi) xcd_barrier(bar);
#endif
        if (PROBE_SEL) { const int lp = ph % PH_PER_LAYER; if (ph < PH_FINAL && ((PROBE_SEL >> lp) & 1)) extra += __builtin_amdgcn_s_memrealtime() - t0; }
    }
    if (PROBE_SEL && blockIdx.x == 0) { const unsigned long long te = __builtin_amdgcn_s_memrealtime(); while (__builtin_amdgcn_s_memrealtime() - te < extra) __builtin_amdgcn_s_sleep(8); }
}

extern "C" void kernel_launch(void* const* d_in, const int* in_sizes, int n_in, void* d_out, int out_size, void* d_ws, size_t ws_size, hipStream_t stream) {
    static int grid = 0;
    if (grid == 0) {
        if (n_in != 28 || out_size != T * D || ws_size < WS_END) { fprintf(stderr, "kernel_launch: unexpected shapes (n_in %d out %d ws %zu, need %zu)\n", n_in, out_size, ws_size, (size_t)WS_END); grid = -1; return; }
        int dev = 0, cus = 0, per_cu = 0;
        if (hipGetDevice(&dev) != hipSuccess || hipDeviceGetAttribute(&cus, hipDeviceAttributeMultiprocessorCount, dev) != hipSuccess) { grid = -1; return; }
        if (hipFuncSetAttribute((const void*)fwd_kernel, hipFuncAttributeMaxDynamicSharedMemorySize, LDS_BYTES) != hipSuccess) { fprintf(stderr, "kernel_launch: hipFuncSetAttribute failed\n"); grid = -1; return; }
        if (hipOccupancyMaxActiveBlocksPerMultiprocessor(&per_cu, (const void*)fwd_kernel, NTHREADS, LDS_BYTES) != hipSuccess || per_cu < 1) { fprintf(stderr, "kernel_launch: occupancy query says %d blocks per CU\n", per_cu); }
        (void)hipGetLastError();
        grid = cus;
    }
    if (grid < 0) return;
    Args a{};
    for (int i = 0; i < 28; ++i) a.in[i] = (const float*)d_in[i];
    a.out = (float*)d_out; a.ws = (unsigned char*)d_ws;
#if MK_MEGA
    (void)hipMemsetAsync((char*)d_ws + WS_CTL, 0, CTL_ZERO_BYTES, stream);
    a.ph_lo = 0; a.ph_hi = N_PHASES;
    hipLaunchKernelGGL(fwd_kernel, dim3(grid), dim3(NTHREADS), LDS_BYTES, stream, a);
#else
    for (int ph = 0; ph < N_PHASES; ++ph) { a.ph_lo = ph; a.ph_hi = ph + 1; hipLaunchKernelGGL(fwd_kernel, dim3(grid), dim3(NTHREADS), LDS_BYTES, stream, a); }
#endif
}
```

```cpp
#include <hip/hip_runtime.h>
#include <cstdio>
#include <cstdint>

#ifndef MK_MEGA
#define MK_MEGA 1
#endif

#ifndef ABL
#define ABL 0
#endif
#define LAS __attribute__((address_space(3)))
#define GAS __attribute__((address_space(1)))
typedef unsigned short bf16_t;
typedef short bf16x8 __attribute__((ext_vector_type(8)));
typedef float f32x4 __attribute__((ext_vector_type(4)));
typedef float f32x2 __attribute__((ext_vector_type(2)));
typedef unsigned u32x4 __attribute__((ext_vector_type(4)));
typedef unsigned u32x2 __attribute__((ext_vector_type(2)));

constexpr int T = 32768, SEQ = 16384, D = 1024, DEPTH = 2;
constexpr int D_IN = 8712;
constexpr float EPS = 1e-6f;
constexpr int NTHREADS = 512, NWAVES = 8;
constexpr int LISTCAP = 40960;

constexpr size_t MiB = 1u << 20;
constexpr size_t WS_CTL = 0, CTL_ZERO_BYTES = 1 * MiB;
constexpr size_t WS_TAB = 1 * MiB;
constexpr size_t WS_ROUTE = 2 * MiB;
constexpr size_t WS_LISTS = 3 * MiB;
constexpr size_t WS_SS0 = 4 * MiB, WS_SS1 = 6 * MiB;
constexpr size_t WS_IF = 8 * MiB;
constexpr size_t WS_NST = 9 * MiB;
constexpr size_t WS_LOGITS = 10 * MiB;
constexpr size_t WS_WIN = 18 * MiB;
constexpr size_t WS_WBR = WS_WIN + 8960ull * 1024 * 2;
constexpr size_t WS_WOUT = WS_WBR + 3ull * 1024 * 512 * 2;
constexpr size_t WS_WPG = WS_WOUT + 1024ull * 1024 * 2;
constexpr size_t WS_WPP = WS_WPG + 1024ull * 1024 * 2;
constexpr size_t WS_WR = WS_WPP + 1024ull * 256 * 2;
static_assert(WS_WR + 256ull * 1024 * 2 <= 44 * MiB, "small weights");
constexpr size_t WS_XB = 44 * MiB;
constexpr size_t WS_QA0 = 108 * MiB;
constexpr size_t WS_YATT = WS_QA0;
constexpr size_t WS_OM = 140 * MiB;
constexpr size_t WS_YC = 172 * MiB;
constexpr size_t WS_CST = 204 * MiB;
constexpr size_t WS_B = 236 * MiB;
constexpr size_t WS_KA = WS_B, WS_QA1 = WS_B + 32 * MiB, WS_QA2 = WS_B + 64 * MiB, WS_VA = WS_B + 96 * MiB, WS_YG = WS_B + 128 * MiB, WS_QM = WS_B + 160 * MiB, WS_KM = WS_B + 192 * MiB, WS_VM = WS_B + 224 * MiB;
constexpr size_t WS_G0 = WS_B, WS_MERGED = WS_B + 192 * MiB;
constexpr size_t WS_WEXP = WS_B, WS_HB = WS_B + 48 * MiB, WS_PBF = WS_B + 88 * MiB, WS_PE = WS_B + 104 * MiB, WS_YB1 = WS_B + 168 * MiB, WS_XBT = WS_B;
constexpr size_t WS_END = 492 * MiB;
constexpr size_t TAB_CNT = 0;
constexpr size_t TAB_META = 65536;
constexpr size_t TAB_MLOC = 131072, TAB_GTOT = 131072 + 4096, TAB_MST = 131072 + 8192;

constexpr int RING_BYTES = 131072;
constexpr int MISC_OFF = 155648;
constexpr int LDS_BYTES = 156672;

__device__ __forceinline__ unsigned f2bf(float f) { unsigned u = __builtin_bit_cast(unsigned, f); return (u + 0x7fffu + ((u >> 16) & 1u)) >> 16; }
__device__ __forceinline__ unsigned pk2(float lo, float hi) { return f2bf(lo) | (f2bf(hi) << 16); }
__device__ __forceinline__ unsigned cvt_pk_bf16(float lo, float hi) { unsigned r; asm volatile("v_cvt_pk_bf16_f32 %0, %1, %2" : "=v"(r) : "v"(lo), "v"(hi)); return r; }
__device__ __forceinline__ float bf_lo(unsigned w) { return __builtin_bit_cast(float, w << 16); }
__device__ __forceinline__ float bf_hi(unsigned w) { return __builtin_bit_cast(float, w & 0xffff0000u); }
__device__ __forceinline__ float bf1(bf16_t h) { return __builtin_bit_cast(float, ((unsigned)h) << 16); }
__device__ __forceinline__ float sigmoidf_(float v) { return 1.0f / (1.0f + __expf(-v)); }
__device__ __forceinline__ float siluf_(float v) { return v / (1.0f + __expf(-v)); }
__device__ __forceinline__ float wave_sum(float v) {
#pragma unroll
    for (int o = 1; o < 64; o <<= 1) v += __shfl_xor(v, o);
    return v;
}
__device__ __forceinline__ float wave_max(float v) {
#pragma unroll
    for (int o = 1; o < 64; o <<= 1) v = fmaxf(v, __shfl_xor(v, o));
    return v;
}
__device__ __forceinline__ int lane_id_() { int l; asm volatile("v_mbcnt_lo_u32_b32 %0, -1, 0\n\tv_mbcnt_hi_u32_b32 %0, -1, %0" : "=&v"(l)); return l; }
#define LDS_WAIT() asm volatile("s_waitcnt lgkmcnt(0)" ::: "memory")
#define VM_WAIT() asm volatile("s_waitcnt vmcnt(0)" ::: "memory")

#define XB_TMO      128
#define XB_XCNT(j)  (256  + 64 * (j))
#define XB_XSUB(j)  (1280 + 64 * (j))
#define XB_XGEN(j)  (2304 + 64 * (j))
#define XB_TOP      3328
#define XB_TOPGEN   3392
#define XCD_BAR_WORDS 3456
#define XB_SPIN_CAP (1u << 22)
__device__ __forceinline__ unsigned xb_ld(unsigned* p)              { return __hip_atomic_load(p, __ATOMIC_RELAXED, __HIP_MEMORY_SCOPE_AGENT); }
__device__ __forceinline__ unsigned xb_add(unsigned* p, unsigned v) { return __hip_atomic_fetch_add(p, v, __ATOMIC_RELAXED, __HIP_MEMORY_SCOPE_AGENT); }
__device__ __forceinline__ unsigned xb_xcc_id() { return (unsigned)__builtin_amdgcn_s_getreg((3 << 11) | 20) & 0xFu; }
#define XB_SPIN(cond, bar) do { unsigned _sp = 0; while (cond) { __builtin_amdgcn_s_sleep(1); \
    if ((++_sp & 255u) == 0u) { if (xb_ld(&(bar)[XB_TMO])) break; if (_sp > XB_SPIN_CAP) { atomicAdd(&(bar)[XB_TMO], 1u); break; } } } } while (0)
struct XcdBarrier { unsigned* bar; unsigned x; volatile LAS unsigned* st; int wave; };
__device__ __forceinline__ XcdBarrier xcd_barrier_post(unsigned* bar, volatile LAS unsigned* st, int wave) {
    XcdBarrier b; b.bar = bar; b.x = xb_xcc_id(); b.st = st; b.wave = wave;
    if (wave == 0 && lane_id_() == 0) (void)xb_add(&bar[XB_XCNT(b.x)], 1u);
    return b;
}
__device__ __forceinline__ void xcd_barrier_complete(unsigned* bar, unsigned x, unsigned& nloc, unsigned& nx) {
    const unsigned G = gridDim.x * gridDim.y * gridDim.z;
    unsigned sum, cnt, mine, sp = 0u;
    for (;;) {
        sum = 0u; cnt = 0u; mine = 0u;
#pragma unroll
        for (unsigned j = 0; j < 16; ++j) { const unsigned c = xb_ld(&bar[XB_XCNT(j)]); sum += c; cnt += (c > 0u) ? 1u : 0u; mine = (j == x) ? c : mine; }
        if (sum == G) break;
        __builtin_amdgcn_s_sleep(1);
        if ((++sp & 255u) == 0u) { if (xb_ld(&bar[XB_TMO])) break; if (sp > XB_SPIN_CAP) { atomicAdd(&bar[XB_TMO], 1u); break; } }
    }
    nloc = mine > 0u ? mine : 1u; nx = cnt > 0u ? cnt : 1u;
}
__device__ __forceinline__ void xcd_barrier(const XcdBarrier& b) {
    asm volatile("s_waitcnt vmcnt(0)" ::: "memory");
    __syncthreads();
    if (b.wave == 0 && lane_id_() == 0) {
        unsigned* bar = b.bar;
        __builtin_amdgcn_s_waitcnt(0);
        unsigned nloc = b.st[0], nx = b.st[1];
        if (nloc == 0u) { xcd_barrier_complete(bar, b.x, nloc, nx); b.st[0] = nloc; b.st[1] = nx; }
        const unsigned old = xb_add(&bar[XB_XSUB(b.x)], 1u);
        const unsigned gen = old / nloc;
        if (old + 1u == (gen + 1u) * nloc) {
            __builtin_amdgcn_fence(__ATOMIC_RELEASE, "agent");
            asm volatile("s_waitcnt vmcnt(0)" ::: "memory");
            const unsigned og = xb_add(&bar[XB_TOP], 1u);
            const unsigned tg = og / nx;
            if (og + 1u == (tg + 1u) * nx) xb_add(&bar[XB_TOPGEN], 1u);
            else XB_SPIN(xb_ld(&bar[XB_TOPGEN]) == tg, bar);
            __builtin_amdgcn_fence(__ATOMIC_ACQUIRE, "agent");
            xb_add(&bar[XB_XGEN(b.x)], 1u);
            asm volatile("s_waitcnt vmcnt(0)" ::: "memory");
        } else {
            XB_SPIN(xb_ld(&bar[XB_XGEN(b.x)]) == gen, bar);
            __builtin_amdgcn_fence(__ATOMIC_ACQUIRE, "agent");
            asm volatile("s_waitcnt vmcnt(0)" ::: "memory");
        }
    }
    __syncthreads();
}

namespace pg8 {
constexpr int BM = 256, BK = 64, HALF = 128, HTB = HALF * BK * 2, NXCD = 8, WGM = 8;
__device__ __forceinline__ int lds_byte(int r, int c) { const int st = (r >> 4) * 2 + (c >> 5), rr = r & 15, cc = c & 31, ob = rr * 64 + cc * 2; return st * 1024 + (ob ^ (((ob >> 9) & 1) << 5)); }
__device__ __forceinline__ void stage_rc(int b, int& R, int& C) { const int st = b / 1024, sb = b % 1024, swz = sb ^ (((sb >> 9) & 1) << 5); R = (st >> 1) * 16 + swz / 64; C = (st & 1) * 32 + (swz % 64) / 2; }
__device__ __forceinline__ int perm32(int rho) { const int n = rho >> 4, i = rho & 15; return 8 * (i >> 2) + 4 * n + (i & 3); }

struct GUnit { const char* A; const char* B; int pm, pn, a0, a1; };

__device__ __forceinline__ void tile_order(int L, int nM, int nN, int& pm, int& pn) {
    const int nwg = nM * nN; int wgid = L;
    { const int q = nwg / NXCD, r = nwg % NXCD, xcd = wgid % NXCD, off = wgid / NXCD; wgid = (xcd < r ? xcd * (q + 1) : r * (q + 1) + (xcd - r) * q) + off; }
    const int nig = WGM * nN, gid = wgid / nig, fm = gid * WGM, gsz = (nM - fm) < WGM ? (nM - fm) : WGM;
    pm = fm + ((wgid % nig) % gsz); pn = (wgid % nig) / gsz;
}

typedef f32x4 Acc[2][2][4][2];

template <class P>
__device__ __forceinline__ void gemm_phase(LAS unsigned char* lds, const P& S, int tid) {
    asm volatile("" : "+v"(tid));
    const int wid = __builtin_amdgcn_readfirstlane(tid >> 6), lane = tid & 63, wr = wid >> 2, wc = wid & 3, fr = lane & 15, fq = lane >> 4;
    constexpr int K = P::K, nt = K / BK;
    static_assert(nt >= 4 && (nt % 2) == 0, "K multiple of 128, >= 256");
    unsigned voffB[2];
#pragma unroll
    for (int i = 0; i < 2; ++i) { int R, C; stage_rc(tid * 16 + i * 8192, R, C); const int Rb = (R & ~31) + perm32(R & 31); voffB[i] = (unsigned)(Rb * K + C) * 2u; }
    constexpr size_t kstep = (size_t)(BK * 2);
    constexpr size_t hstepB = (size_t)HALF * K * 2;
    const unsigned ldsw = (unsigned)wid * 1024u;
    const int aoff = lds_byte(wr * 64 + fr, fq * 8), boff = lds_byte(wc * 32 + fr, fq * 8);
#define PG8_SA(b, h) (((b) * 2 + (h)) * HTB)
#define PG8_SB(b, h) ((4 + (b) * 2 + (h)) * HTB)
#define PG8_STAGE(bufoff, gbase, voff) do { _Pragma("unroll") for (int _i = 0; _i < 2; ++_i) \
        __builtin_amdgcn_global_load_lds((const unsigned*)((const char*)(gbase) + (voff)[_i]), (LAS unsigned*)(lds + (bufoff) + ldsw + _i * 8192), 16, 0, 0); } while (0)
#define PG8_LDA(dst, b, h) do { _Pragma("unroll") for (int m = 0; m < 4; ++m) _Pragma("unroll") for (int k = 0; k < 2; ++k) dst[m][k] = *(const LAS bf16x8*)(lds + PG8_SA(b, h) + aoff + m * 2048 + k * 1024); } while (0)
#define PG8_LDB(dst, b, h) do { _Pragma("unroll") for (int n = 0; n < 2; ++n) _Pragma("unroll") for (int k = 0; k < 2; ++k) dst[n][k] = *(const LAS bf16x8*)(lds + PG8_SB(b, h) + boff + n * 2048 + k * 1024); } while (0)
#define PG8_MMA(ai, bj, At, Bt) do { __builtin_amdgcn_s_setprio(1); _Pragma("unroll") for (int m = 0; m < 4; ++m) _Pragma("unroll") for (int n = 0; n < 2; ++n) _Pragma("unroll") for (int k = 0; k < 2; ++k) \
        acc[ai][bj][m][n] = __builtin_amdgcn_mfma_f32_16x16x32_bf16(Bt[n][k], At[m][k], acc[ai][bj][m][n], 0, 0, 0); __builtin_amdgcn_s_setprio(0); } while (0)
#define PG8_WAIT_V(n) asm volatile("s_waitcnt vmcnt(" #n ")" ::: "memory")
#define PG8_WAIT_L(n) asm volatile("s_waitcnt lgkmcnt(" #n ")" ::: "memory")
#define PG8_BAR __builtin_amdgcn_s_barrier()
#define PG8_SCHED __builtin_amdgcn_sched_barrier(0)
#define PG8_VOA(dst, u) do { _Pragma("unroll") for (int _h = 0; _h < 2; ++_h) _Pragma("unroll") for (int _i = 0; _i < 2; ++_i) { int _R, _C; stage_rc(tid * 16 + _i * 8192, _R, _C); \
        if constexpr (P::GATHER) dst[_h][_i] = (S.arow(u, _h * HALF + _R) * (unsigned)K + (unsigned)_C) * 2u; \
        else dst[_h][_i] = (unsigned)((_h * HALF + _R) * K + _C) * 2u; } } while (0)
    GUnit cur, nxt; int ui = 0;
    if (!S.next(0, cur)) return;
    Acc acc;
#pragma unroll
    for (int a = 0; a < 2; ++a)
#pragma unroll
        for (int b = 0; b < 2; ++b)
#pragma unroll
            for (int m = 0; m < 4; ++m)
#pragma unroll
                for (int n = 0; n < 2; ++n) acc[a][b][m][n] = (f32x4){0.f, 0.f, 0.f, 0.f};
    bf16x8 At[4][2], B0[2][2], B1[2][2];
    unsigned voA[2][2], voAn[2][2];
    PG8_VOA(voA, cur);
    const char* cA = cur.A; const char* cB = cur.B;
    PG8_STAGE(PG8_SB(0, 0), cB, voffB); PG8_STAGE(PG8_SB(0, 1), cB + hstepB, voffB); PG8_STAGE(PG8_SA(0, 0), cA, voA[0]); PG8_STAGE(PG8_SA(0, 1), cA, voA[1]);
    if (wr == 1) PG8_BAR;
    PG8_WAIT_V(2); PG8_BAR;
    PG8_STAGE(PG8_SB(1, 0), cB + kstep, voffB); PG8_STAGE(PG8_SA(1, 0), cA + kstep, voA[0]); PG8_STAGE(PG8_SB(1, 1), cB + hstepB + kstep, voffB);
    PG8_WAIT_V(6); PG8_BAR;
    for (;;) {
        const bool has_next = S.next(ui + 1, nxt);
        const char* nA = has_next ? nxt.A : cA; const char* nB = has_next ? nxt.B : cB;
        if constexpr (P::GATHER) {
            if (has_next) { PG8_VOA(voAn, nxt); }
            else {
#pragma unroll
                for (int h = 0; h < 2; ++h)
#pragma unroll
                    for (int i = 0; i < 2; ++i) voAn[h][i] = voA[h][i];
            }
        }
#pragma unroll 1
        for (int t = 0; t < nt; t += 2) {
            const bool last = (t == nt - 2);
            const char* a1 = cA + (size_t)(t + 1) * kstep;
            const char* a2 = last ? nA : cA + (size_t)(t + 2) * kstep; const char* b2 = last ? nB : cB + (size_t)(t + 2) * kstep;
            const char* a3 = a2 + kstep; const char* b3 = b2 + kstep;
            unsigned s0[2], s1[2];
#pragma unroll
            for (int i = 0; i < 2; ++i) {
                if constexpr (P::GATHER) { s0[i] = last ? voAn[0][i] : voA[0][i]; s1[i] = last ? voAn[1][i] : voA[1][i]; }
                else { s0[i] = voA[0][i]; s1[i] = voA[1][i]; }
            }
            PG8_LDB(B0, 0, 0); PG8_LDB(B1, 0, 1); PG8_SCHED; PG8_LDA(At, 0, 0); PG8_STAGE(PG8_SA(1, 1), a1, voA[1]);
            PG8_WAIT_V(8); PG8_WAIT_L(0); PG8_BAR; PG8_MMA(0, 0, At, B0); PG8_MMA(0, 1, At, B1); PG8_BAR; PG8_SCHED;
            PG8_LDA(At, 0, 1); PG8_STAGE(PG8_SB(0, 0), b2, voffB); PG8_STAGE(PG8_SB(0, 1), b2 + hstepB, voffB); PG8_STAGE(PG8_SA(0, 0), a2, s0);
            PG8_WAIT_V(8); PG8_WAIT_L(0); PG8_BAR; PG8_MMA(1, 0, At, B0); PG8_MMA(1, 1, At, B1); PG8_BAR; PG8_SCHED;
            PG8_LDB(B0, 1, 0); PG8_LDB(B1, 1, 1); PG8_SCHED; PG8_LDA(At, 1, 0); PG8_STAGE(PG8_SA(0, 1), a2, s1);
            PG8_WAIT_V(8); PG8_WAIT_L(0); PG8_BAR; PG8_MMA(0, 0, At, B0); PG8_MMA(0, 1, At, B1); PG8_BAR; PG8_SCHED;
            PG8_LDA(At, 1, 1); PG8_STAGE(PG8_SB(1, 0), b3, voffB); PG8_STAGE(PG8_SB(1, 1), b3 + hstepB, voffB); PG8_STAGE(PG8_SA(1, 0), a3, s0);
            PG8_WAIT_V(8); PG8_WAIT_L(0); PG8_BAR; PG8_MMA(1, 0, At, B0); PG8_MMA(1, 1, At, B1); PG8_BAR; PG8_SCHED;
        }
        if (wr == 0) PG8_BAR;
        const bool zero = S.epi(acc, cur, wr, wc, fr, fq);
        if (!has_next) break;
        if (zero) {
#pragma unroll
            for (int a = 0; a < 2; ++a)
#pragma unroll
                for (int b = 0; b < 2; ++b)
#pragma unroll
                    for (int m = 0; m < 4; ++m)
#pragma unroll
                        for (int n = 0; n < 2; ++n) acc[a][b][m][n] = (f32x4){0.f, 0.f, 0.f, 0.f};
        }
        cur = nxt; cA = nA; cB = nB; ++ui;
        if constexpr (P::GATHER) {
#pragma unroll
            for (int h = 0; h < 2; ++h)
#pragma unroll
                for (int i = 0; i < 2; ++i) voA[h][i] = voAn[h][i];
        }
        if (wr == 1) PG8_BAR;
    }
    PG8_WAIT_V(0);
    PG8_BAR;
#undef PG8_SA
#undef PG8_SB
#undef PG8_STAGE
#undef PG8_LDA
#undef PG8_LDB
#undef PG8_MMA
#undef PG8_WAIT_V
#undef PG8_WAIT_L
#undef PG8_BAR
#undef PG8_SCHED
#undef PG8_VOA
}
}
using pg8::GUnit; using pg8::Acc;

__device__ __forceinline__ float row_rs(const float* SS, int row) {
    const f32x4* p = (const f32x4*)(SS + (size_t)row * 16);
    const f32x4 a = p[0], b = p[1], c = p[2], d = p[3];
    const float s = (((a.x + a.y) + (a.z + a.w)) + ((b.x + b.y) + (b.z + b.w))) + (((c.x + c.y) + (c.z + c.w)) + ((d.x + d.y) + (d.z + d.w)));
    return rsqrtf(s * (1.0f / 1024.0f) + EPS);
}
__device__ __forceinline__ u32x4 pack8(const f32x4 v0, const f32x4 v1) { u32x4 w; w.x = cvt_pk_bf16(v0[0], v0[1]); w.y = cvt_pk_bf16(v0[2], v0[3]); w.z = cvt_pk_bf16(v1[0], v1[1]); w.w = cvt_pk_bf16(v1[2], v1[3]); return w; }
__device__ __forceinline__ void unpack8(const u32x4 w, f32x4& v0, f32x4& v1) { v0 = (f32x4){bf_lo(w.x), bf_hi(w.x), bf_lo(w.y), bf_hi(w.y)}; v1 = (f32x4){bf_lo(w.z), bf_hi(w.z), bf_lo(w.w), bf_hi(w.w)}; }
__device__ __forceinline__ f32x4 sig4(const f32x4 v) { return (f32x4){sigmoidf_(v[0]), sigmoidf_(v[1]), sigmoidf_(v[2]), sigmoidf_(v[3])}; }
__device__ __forceinline__ f32x4 gate4(const f32x4 v) { f32x4 s = sig4(v); return (f32x4){fmaxf(s[0], 1e-6f), fmaxf(s[1], 1e-6f), fmaxf(s[2], 1e-6f), fmaxf(s[3], 1e-6f)}; }

struct PhProj {
    static constexpr int K = 1024; static constexpr bool GATHER = false;
    const char* xb; const char* W; const float* SS; unsigned char* ws; int G, c;
    __device__ __forceinline__ bool next(int i, GUnit& u) const {
        const long L = (long)i * G + c; if (L >= 128 * 23) return false;
        pg8::tile_order((int)L, 128, 23, u.pm, u.pn);
        u.A = xb + (size_t)u.pm * 256 * K * 2; u.B = W + (size_t)u.pn * 256 * K * 2; u.a0 = 0; u.a1 = 0; return true;
    }
    __device__ __forceinline__ unsigned arow(const GUnit&, int) const { return 0u; }
    __device__ __forceinline__ bool epi(Acc& acc, const GUnit& u, int wr, int wc, int fr, int fq) const {
        const int pn = u.pn; const int row0 = u.pm * 256 + wr * 64 + fr;
        if (pn == 22) {
            if (wc == 0 && fq == 0) {
                float* IFp = (float*)(ws + WS_IF);
#pragma unroll
                for (int ai = 0; ai < 2; ++ai)
#pragma unroll
                    for (int m = 0; m < 4; ++m) { const int row = row0 + ai * 128 + m * 16; const float rs = row_rs(SS, row);
                        *(f32x4*)(IFp + (size_t)row * 8) = acc[ai][0][m][0] * rs; *(f32x4*)(IFp + (size_t)row * 8 + 4) = acc[ai][0][m][1] * rs; }
            }
            return true;
        }
        if (pn >= 10 && pn < 14) {
            bf16_t* Y = (bf16_t*)(ws + WS_YG);
#pragma unroll
            for (int ai = 0; ai < 2; ++ai)
#pragma unroll
                for (int m = 0; m < 4; ++m) { const int row = row0 + ai * 128 + m * 16; const float rs = row_rs(SS, row);
#pragma unroll
                    for (int bj = 0; bj < 2; ++bj) { const f32x4 a = acc[ai][bj][m][0] * rs, g = sig4(acc[ai][bj][m][1] * rs), y = a * g;
                        u32x2 w; w.x = cvt_pk_bf16(y[0], y[1]); w.y = cvt_pk_bf16(y[2], y[3]);
                        *(u32x2*)(Y + (size_t)row * 512 + (pn - 10) * 128 + bj * 64 + wc * 16 + fq * 4) = w; } }
            return true;
        }
        bf16_t* dst; int col0; bool sg = false;
        if (pn < 6) { dst = (bf16_t*)(ws + (pn < 2 ? WS_QA0 : (pn < 4 ? WS_QA1 : WS_QA2))); col0 = (pn & 1) * 256; }
        else if (pn < 8) { dst = (bf16_t*)(ws + WS_KA); col0 = (pn - 6) * 256; }
        else if (pn < 10) { dst = (bf16_t*)(ws + WS_VA); col0 = (pn - 8) * 256; }
        else if (pn < 16) { dst = (bf16_t*)(ws + WS_QM); col0 = (pn - 14) * 256; }
        else if (pn < 18) { dst = (bf16_t*)(ws + WS_KM); col0 = (pn - 16) * 256; }
        else if (pn < 20) { dst = (bf16_t*)(ws + WS_VM); col0 = (pn - 18) * 256; }
        else { dst = (bf16_t*)(ws + WS_OM); col0 = (pn - 20) * 256; sg = true; }
        col0 += wc * 32 + fq * 8;
#pragma unroll
        for (int ai = 0; ai < 2; ++ai)
#pragma unroll
            for (int m = 0; m < 4; ++m) { const int row = row0 + ai * 128 + m * 16; const float rs = row_rs(SS, row);
#pragma unroll
                for (int bj = 0; bj < 2; ++bj) { f32x4 v0 = acc[ai][bj][m][0] * rs, v1 = acc[ai][bj][m][1] * rs;
                    if (sg) { v0 = sig4(v0); v1 = sig4(v1); }
                    *(u32x4*)(dst + (size_t)row * 512 + col0 + bj * 128) = pack8(v0, v1); } }
        return true;
    }
};
struct PhGates {
    static constexpr int K = 1024; static constexpr bool GATHER = false;
    const char* xb; const char* W; const float* SS; unsigned char* ws; int G, c;
    __device__ __forceinline__ bool next(int i, GUnit& u) const {
        const long L = (long)i * G + c; if (L >= 128 * 12) return false;
        pg8::tile_order((int)L, 128, 12, u.pm, u.pn);
        u.A = xb + (size_t)u.pm * 256 * K * 2; u.B = W + (size_t)(5888 + u.pn * 256) * K * 2; u.a0 = 0; u.a1 = 0; return true;
    }
    __device__ __forceinline__ unsigned arow(const GUnit&, int) const { return 0u; }
    __device__ __forceinline__ bool epi(Acc& acc, const GUnit& u, int wr, int wc, int fr, int fq) const {
        const int row0 = u.pm * 256 + wr * 64 + fr;
        bf16_t* dst = (bf16_t*)(ws + WS_G0 + (size_t)(u.pn >> 2) * 64 * MiB); const int col0 = (u.pn & 3) * 256 + wc * 32 + fq * 8;
#pragma unroll
        for (int ai = 0; ai < 2; ++ai)
#pragma unroll
            for (int m = 0; m < 4; ++m) { const int row = row0 + ai * 128 + m * 16; const float rs = row_rs(SS, row);
#pragma unroll
                for (int bj = 0; bj < 2; ++bj) *(u32x4*)(dst + (size_t)row * 1024 + col0 + bj * 128) = pack8(gate4(acc[ai][bj][m][0] * rs), gate4(acc[ai][bj][m][1] * rs)); }
        return true;
    }
};
struct PhMerge {
    static constexpr int K = 512; static constexpr bool GATHER = false;
    unsigned char* ws; int G, c;
    __device__ __forceinline__ bool next(int i, GUnit& u) const {
        const int ti = i / 3, seg = i - ti * 3; const long L = (long)ti * G + c; if (L >= 128 * 4) return false;
        pg8::tile_order((int)L, 128, 4, u.pm, u.pn);
        const size_t ya = seg == 0 ? WS_YATT : (seg == 1 ? WS_YC : WS_OM);
        u.A = (const char*)ws + ya + (size_t)u.pm * 256 * K * 2; u.B = (const char*)ws + WS_WBR + (size_t)seg * 1024 * 512 * 2 + (size_t)u.pn * 256 * K * 2; u.a0 = seg; u.a1 = 0; return true;
    }
    __device__ __forceinline__ unsigned arow(const GUnit&, int) const { return 0u; }
    __device__ __forceinline__ bool epi(Acc& acc, const GUnit& u, int wr, int wc, int fr, int fq) const {
        const int seg = u.a0; const int row0 = u.pm * 256 + wr * 64 + fr; const int col0 = u.pn * 256 + wc * 32 + fq * 8;
        const bf16_t* Gn = (const bf16_t*)(ws + WS_G0 + (size_t)seg * 64 * MiB);
        const bf16_t* Gd = (const bf16_t*)(ws + WS_G0 + (size_t)(seg + 1) * 64 * MiB);
        bf16_t* Mo = (bf16_t*)(ws + WS_MERGED);
#pragma unroll
        for (int ai = 0; ai < 2; ++ai)
#pragma unroll
            for (int m = 0; m < 4; ++m) { const size_t off = (size_t)(row0 + ai * 128 + m * 16) * 1024 + col0;
#pragma unroll
                for (int bj = 0; bj < 2; ++bj) {
                    f32x4 n0, n1; unpack8(*(const u32x4*)(Gn + off + bj * 128), n0, n1);
                    if (seg < 2) { f32x4 d0, d1; unpack8(*(const u32x4*)(Gd + off + bj * 128), d0, d1);
#pragma unroll
                        for (int j = 0; j < 4; ++j) { acc[ai][bj][m][0][j] *= n0[j] * __builtin_amdgcn_rcpf(d0[j]); acc[ai][bj][m][1][j] *= n1[j] * __builtin_amdgcn_rcpf(d1[j]); } }
                    else *(u32x4*)(Mo + off + bj * 128) = pack8(acc[ai][bj][m][0] * n0, acc[ai][bj][m][1] * n1);
                } }
        return seg == 2;
    }
};
__device__ __forceinline__ float store_x8(bf16_t* xbp, const f32x4 v0, const f32x4 v1) {
    *(u32x4*)xbp = pack8(v0, v1);
    return ((v0[0] * v0[0] + v0[1] * v0[1]) + (v0[2] * v0[2] + v0[3] * v0[3])) + ((v1[0] * v1[0] + v1[1] * v1[1]) + (v1[2] * v1[2] + v1[3] * v1[3]));
}
struct PhOut {
    static constexpr int K = 1024; static constexpr bool GATHER = false;
    unsigned char* ws; float* SSo; int G, c;
    __device__ __forceinline__ bool next(int i, GUnit& u) const {
        const long L = (long)i * G + c; if (L >= 128 * 4) return false;
        pg8::tile_order((int)L, 128, 4, u.pm, u.pn);
        u.A = (const char*)ws + WS_MERGED + (size_t)u.pm * 256 * K * 2; u.B = (const char*)ws + WS_WOUT + (size_t)u.pn * 256 * K * 2; u.a0 = 0; u.a1 = 0; return true;
    }
    __device__ __forceinline__ unsigned arow(const GUnit&, int) const { return 0u; }
    __device__ __forceinline__ bool epi(Acc& acc, const GUnit& u, int wr, int wc, int fr, int fq) const {
        const int row0 = u.pm * 256 + wr * 64 + fr; const int col0 = u.pn * 256 + wc * 32 + fq * 8; bf16_t* XB = (bf16_t*)(ws + WS_XB);
#pragma unroll
        for (int ai = 0; ai < 2; ++ai)
#pragma unroll
            for (int m = 0; m < 4; ++m) { const int row = row0 + ai * 128 + m * 16; const size_t off = (size_t)row * 1024 + col0; float ss = 0.f;
#pragma unroll
                for (int bj = 0; bj < 2; ++bj) { bf16_t* xp = XB + off + bj * 128; f32x4 x0, x1; unpack8(*(const u32x4*)xp, x0, x1); ss += store_x8(xp, x0 + acc[ai][bj][m][0], x1 + acc[ai][bj][m][1]); }
                ss += __shfl_xor(ss, 16); ss += __shfl_xor(ss, 32);
                if (fq == 0) SSo[(size_t)row * 16 + u.pn * 4 + wc] = ss; }
        return true;
    }
};
struct PhRouter {
    static constexpr int K = 1024; static constexpr bool GATHER = false;
    unsigned char* ws; const float* SS; int G, c;
    __device__ __forceinline__ bool next(int i, GUnit& u) const {
        const long L = (long)i * G + c; if (L >= 128) return false;
        u.pm = (int)L; u.pn = 0; u.A = (const char*)ws + WS_XB + (size_t)u.pm * 256 * K * 2; u.B = (const char*)ws + WS_WR; u.a0 = 0; u.a1 = 0; return true;
    }
    __device__ __forceinline__ unsigned arow(const GUnit&, int) const { return 0u; }
    __device__ __forceinline__ bool epi(Acc& acc, const GUnit& u, int wr, int wc, int fr, int fq) const {
        if (wc < 2) { float* Lg = (float*)(ws + WS_LOGITS); const int row0 = u.pm * 256 + wr * 64 + fr;
#pragma unroll
            for (int ai = 0; ai < 2; ++ai)
#pragma unroll
                for (int m = 0; m < 4; ++m) { const int row = row0 + ai * 128 + m * 16; const float rs = row_rs(SS, row); float* p = Lg + (size_t)row * 64 + wc * 32 + fq * 8;
                    *(f32x4*)p = acc[ai][0][m][0] * rs; *(f32x4*)(p + 4) = acc[ai][0][m][1] * rs; } }
        return true;
    }
};
__device__ __forceinline__ int moe_expert_of(const int* META, int k, int rb) {
    const int r = rb * 256; int e = 0;
    for (int j = 1; j < 32; ++j) e += (META[16 + 64 * k + j] <= r) ? 1 : 0;
    return __builtin_amdgcn_readfirstlane(e);
}
struct PhUp {
    static constexpr int K = 1024; static constexpr bool GATHER = true;
    unsigned char* ws; const float* SS; const int* META; const int* tok; int G, c;
    __device__ __forceinline__ bool next(int i, GUnit& u) const {
        const int nb0 = __builtin_amdgcn_readfirstlane(META[0]), nb1 = __builtin_amdgcn_readfirstlane(META[1]); const long L = (long)i * G + c; if (L >= 2L * (nb0 + nb1)) return false;
        int blk = (int)(L >> 1); u.pn = (int)(L & 1); int k = 0; if (blk >= nb0) { k = 1; blk -= nb0; }
        const int e = moe_expert_of(META, k, blk);
        u.pm = blk; u.a0 = k; u.a1 = e; u.A = (const char*)ws + WS_XB; u.B = (const char*)ws + WS_WEXP + (size_t)e * 512 * 1024 * 2 + (size_t)u.pn * 256 * K * 2; return true;
    }
    __device__ __forceinline__ unsigned arow(const GUnit& u, int r) const { const int t = tok[u.a0 * LISTCAP + u.pm * 256 + r]; return t < 0 ? 0u : (unsigned)t; }
    __device__ __forceinline__ bool epi(Acc& acc, const GUnit& u, int wr, int wc, int fr, int fq) const {
        const int lr0 = u.a0 * LISTCAP + u.pm * 256 + wr * 64 + fr; bf16_t* HB = (bf16_t*)(ws + WS_HB);
#pragma unroll
        for (int ai = 0; ai < 2; ++ai)
#pragma unroll
            for (int m = 0; m < 4; ++m) { const int lr = lr0 + ai * 128 + m * 16; const int t = tok[lr]; const float rs = t < 0 ? 0.f : row_rs(SS, t < 0 ? 0 : t);
#pragma unroll
                for (int bj = 0; bj < 2; ++bj) { const f32x4 g = acc[ai][bj][m][0] * rs, uu = acc[ai][bj][m][1] * rs;
                    f32x4 h = (f32x4){siluf_(g[0]) * uu[0], siluf_(g[1]) * uu[1], siluf_(g[2]) * uu[2], siluf_(g[3]) * uu[3]}; if (ABL == 8) h = (f32x4){1.f, 1.f, 1.f, 1.f};
                    u32x2 w; w.x = cvt_pk_bf16(h[0], h[1]); w.y = cvt_pk_bf16(h[2], h[3]);
                    *(u32x2*)(HB + (size_t)lr * 256 + u.pn * 128 + bj * 64 + wc * 16 + fq * 4) = w; }
                asm volatile("" ::: "memory"); }
        return true;
    }
};
template <int KL> struct PhDown {
    static constexpr int K = 256; static constexpr bool GATHER = false;
    unsigned char* ws; float* SSo; const int* META; const int* tok; const float* wl; int G, c;
    __device__ __forceinline__ bool next(int i, GUnit& u) const {
        const int nb = __builtin_amdgcn_readfirstlane(META[KL]); const long L = (long)i * G + c;
        if (L < 4L * nb) { const int blk = (int)(L >> 2); u.pn = (int)(L & 3); const int e = moe_expert_of(META, KL, blk); u.pm = blk; u.a0 = 0; u.a1 = e;
            u.A = (const char*)ws + WS_HB + (size_t)(KL * LISTCAP + blk * 256) * 256 * 2; u.B = (const char*)ws + WS_WEXP + 32ull * 512 * 1024 * 2 + (size_t)e * 1024 * 256 * 2 + (size_t)u.pn * 256 * K * 2; return true; }
        if (KL == 1) { const long L2 = L - 4L * nb; if (L2 >= 128 * 4) return false;
            pg8::tile_order((int)L2, 128, 4, u.pm, u.pn); u.a0 = 1; u.a1 = 0;
            u.A = (const char*)ws + WS_PBF + (size_t)u.pm * 256 * K * 2; u.B = (const char*)ws + WS_WPP + (size_t)u.pn * 256 * K * 2; return true; }
        return false;
    }
    __device__ __forceinline__ unsigned arow(const GUnit&, int) const { return 0u; }
    __device__ __forceinline__ bool epi(Acc& acc, const GUnit& u, int wr, int wc, int fr, int fq) const {
        const int col0 = u.pn * 256 + wc * 32 + fq * 8;
        if (KL == 1 && u.a0 == 1) {
            bf16_t* PE = (bf16_t*)(ws + WS_PE); const int row0 = u.pm * 256 + wr * 64 + fr;
#pragma unroll
            for (int ai = 0; ai < 2; ++ai)
#pragma unroll
                for (int m = 0; m < 4; ++m)
#pragma unroll
                    for (int bj = 0; bj < 2; ++bj) *(u32x4*)(PE + (size_t)(row0 + ai * 128 + m * 16) * 1024 + col0 + bj * 128) = pack8(acc[ai][bj][m][0], acc[ai][bj][m][1]);
            return true;
        }
        const int lr0 = KL * LISTCAP + u.pm * 256 + wr * 64 + fr; bf16_t* YB = (bf16_t*)(ws + WS_YB1); bf16_t* XB = (bf16_t*)(ws + WS_XB);
#pragma unroll
        for (int ai = 0; ai < 2; ++ai)
#pragma unroll
            for (int m = 0; m < 4; ++m) { const int lr = lr0 + ai * 128 + m * 16; const int t = tok[lr]; const float w = (ABL == 9) ? 1.0f : wl[lr]; const size_t off = (size_t)(t < 0 ? 0 : t) * 1024 + col0;
                if (KL == 1) { if (t >= 0) {
#pragma unroll
                        for (int bj = 0; bj < 2; ++bj) *(u32x4*)(YB + off + bj * 128) = pack8(acc[ai][bj][m][0] * w, acc[ai][bj][m][1] * w); } }
                else { float ss = 0.f;
                    if (t >= 0) {
#pragma unroll
                        for (int bj = 0; bj < 2; ++bj) { bf16_t* xp = XB + off + bj * 128; f32x4 x0, x1, y0, y1; unpack8(*(const u32x4*)xp, x0, x1); unpack8(*(const u32x4*)(YB + off + bj * 128), y0, y1);
                            ss += store_x8(xp, (x0 + y0) + acc[ai][bj][m][0] * w, (x1 + y1) + acc[ai][bj][m][1] * w); } }
                    ss += __shfl_xor(ss, 16); ss += __shfl_xor(ss, 32);
                    if (fq == 0 && t >= 0) SSo[(size_t)t * 16 + u.pn * 4 + wc] = ss; }
                if (m & 1) asm volatile("" ::: "memory"); }
        return true;
    }
};
struct PhPle {
    static constexpr int K = 1024; static constexpr bool GATHER = false;
    unsigned char* ws; const float* SSi; float* SSo; int G, c;
    __device__ __forceinline__ bool next(int i, GUnit& u) const {
        const long L = (long)i * G + c; if (L >= 128 * 4) return false;
        pg8::tile_order((int)L, 128, 4, u.pm, u.pn);
        u.A = (const char*)ws + WS_XB + (size_t)u.pm * 256 * K * 2; u.B = (const char*)ws + WS_WPG + (size_t)u.pn * 256 * K * 2; u.a0 = 0; u.a1 = 0; return true;
    }
    __device__ __forceinline__ unsigned arow(const GUnit&, int) const { return 0u; }
    __device__ __forceinline__ bool epi(Acc& acc, const GUnit& u, int wr, int wc, int fr, int fq) const {
        const int row0 = u.pm * 256 + wr * 64 + fr; const int col0 = u.pn * 256 + wc * 32 + fq * 8; bf16_t* XT = (bf16_t*)(ws + WS_XBT); const bf16_t* PE = (const bf16_t*)(ws + WS_PE); const bf16_t* XBc = (const bf16_t*)(ws + WS_XB);
#pragma unroll
        for (int ai = 0; ai < 2; ++ai)
#pragma unroll
            for (int m = 0; m < 4; ++m) { const int row = row0 + ai * 128 + m * 16; const size_t off = (size_t)row * 1024 + col0; const float rs = row_rs(SSi, row); float ss = 0.f;
#pragma unroll
                for (int bj = 0; bj < 2; ++bj) { f32x4 p0, p1, x0, x1; unpack8(*(const u32x4*)(PE + off + bj * 128), p0, p1); unpack8(*(const u32x4*)(XBc + off + bj * 128), x0, x1);
                    ss += store_x8(XT + off + bj * 128, x0 + sig4(acc[ai][bj][m][0] * rs) * p0, x1 + sig4(acc[ai][bj][m][1] * rs) * p1); }
                ss += __shfl_xor(ss, 16); ss += __shfl_xor(ss, 32);
                if (fq == 0) SSo[(size_t)row * 16 + u.pn * 4 + wc] = ss; }
        return true;
    }
};

struct InPtrs { const float* const* p; __device__ __forceinline__ const float* operator[](int i) const { return (const float*)(GAS const float*)p[i]; } };
struct Ctx {
    InPtrs in; float* out; unsigned char* ws; LAS unsigned char* lds;
    int tid, lane, wave, G, bid;
};
enum { I_X = 0, I_P, I_GMIX, I_WIN, I_CONVW, I_CONVB, I_CLNG, I_CLNB, I_MCW, I_MCB, I_MIB, I_MFB, I_WBA, I_WBC, I_WBM, I_WOUT, I_GFFN, I_WRG, I_BRG, I_WRE, I_BRE,
       I_WEG, I_WEU, I_WED, I_GPLE, I_WPG, I_WPP, I_GFIN };

constexpr int TR_LDS = 64 * 65 * 4;
__device__ __forceinline__ void tr_item64(const float* colptr4, size_t pitch, const float* gain, float cscale, bf16_t* dst, int K, int n0, int k0, LAS float* scr, int lane) {
    const int g = lane & 15, r = lane >> 4;
#pragma unroll
    for (int i = 0; i < 16; ++i) { const int kk = 4 * i + r; f32x4 v = (f32x4){0.f, 0.f, 0.f, 0.f}; if (colptr4) v = *(const f32x4*)(colptr4 + (size_t)(k0 + kk) * pitch);
        const float gs = (gain ? gain[k0 + kk] : 1.0f) * cscale; LAS float* p = scr + kk * 65 + 4 * g; p[0] = v.x * gs; p[1] = v.y * gs; p[2] = v.z * gs; p[3] = v.w * gs; }
    LDS_WAIT(); asm volatile("" ::: "memory");
    const int c = lane & 7, n8 = lane >> 3;
#pragma unroll
    for (int j = 0; j < 8; ++j) { const int n = n8 + 8 * j; const LAS float* sp = scr + (8 * c) * 65 + n;
        u32x4 o; o.x = pk2(sp[0 * 65], sp[1 * 65]); o.y = pk2(sp[2 * 65], sp[3 * 65]); o.z = pk2(sp[4 * 65], sp[5 * 65]); o.w = pk2(sp[6 * 65], sp[7 * 65]);
        *(u32x4*)(dst + (size_t)(n0 + n) * K + k0 + 8 * c) = o; }
    LDS_WAIT(); asm volatile("" ::: "memory");
}
__device__ __forceinline__ void phase_prep(const Ctx& F, int layer, float* SS) {
    const int gw = F.bid * NWAVES + F.wave, NGW = F.G * NWAVES, lane = F.lane;
    LAS float* scr = (LAS float*)(F.lds + F.wave * TR_LDS);
    bf16_t* XB = (bf16_t*)(F.ws + WS_XB);
    if (layer == 0) {
        for (int m = gw; m < T; m += NGW) {
            const f32x4* xr = (const f32x4*)(F.in[I_X] + (size_t)m * D) + lane; u32x2* xbr = (u32x2*)(XB + (size_t)m * D) + lane;
            float sq = 0.f;
#pragma unroll
            for (int j = 0; j < 4; ++j) { const f32x4 v = xr[64 * j]; sq += (v.x * v.x + v.y * v.y) + (v.z * v.z + v.w * v.w);
                u32x2 w; w.x = cvt_pk_bf16(v.x, v.y); w.y = cvt_pk_bf16(v.z, v.w); xbr[64 * j] = w; }
            sq = wave_sum(sq);
            if (lane < 16) SS[(size_t)m * 16 + lane] = lane == 0 ? sq : 0.f;
        }
    } else {
        const u32x4* src = (const u32x4*)(F.ws + WS_XBT); u32x4* dst = (u32x4*)(F.ws + WS_XB);
        for (size_t i = (size_t)F.bid * NTHREADS + F.tid; i < (size_t)T * D * 2 / 16; i += (size_t)F.G * NTHREADS) dst[i] = src[i];
    }
    const float* w_in = F.in[I_WIN] + (size_t)layer * D * D_IN; const float* g_mix = F.in[I_GMIX] + (size_t)layer * D;
    constexpr int N_WIN = 140 * 16, N_BR = 16 * 8, N_SQ = 16 * 16, N_PP = 16 * 4, N_R = 4 * 16;
    constexpr int NITEMS = N_WIN + 3 * N_BR + 2 * N_SQ + N_PP + N_R;
    const int g4 = 4 * (lane & 15);
    for (int it = gw; it < NITEMS; it += NGW) {
        int r = it;
        if (r < N_WIN) { const int nb = r >> 4, kb = r & 15; const int n = nb * 64 + g4; int src = -1; float cs = 1.f;
            if (n < 2560) { src = n; if (n < 1536) cs = 0.125f; }
            else if (n < 3584) { const int np = n - 2560, q8 = np >> 3, sg = (np >> 2) & 1; src = 2560 + sg * 512 + 4 * q8; }
            else if (n < 5640) src = n;
            else if (n < 5888) src = -1;
            else src = 5640 + (n - 5888);
            tr_item64(src >= 0 ? w_in + src : nullptr, D_IN, g_mix, cs, (bf16_t*)(F.ws + WS_WIN), 1024, nb * 64, kb * 64, scr, lane); continue; }
        r -= N_WIN;
        if (r < 3 * N_BR) { const int b = r / N_BR; r -= b * N_BR; const int nb = r >> 3, kb = r & 7; const int n = nb * 64 + g4;
            const float* w = (b == 0 ? F.in[I_WBA] : (b == 1 ? F.in[I_WBC] : F.in[I_WBM])) + (size_t)layer * 512 * 1024;
            tr_item64(w + n, 1024, nullptr, 1.f, (bf16_t*)(F.ws + WS_WBR) + (size_t)b * 1024 * 512, 512, nb * 64, kb * 64, scr, lane); continue; }
        r -= 3 * N_BR;
        if (r < 2 * N_SQ) { const int b = r / N_SQ; r -= b * N_SQ; const int nb = r >> 4, kb = r & 15; const int n = nb * 64 + g4;
            const float* w = (b == 0 ? F.in[I_WOUT] : F.in[I_WPG]) + (size_t)layer * 1024 * 1024;
            tr_item64(w + n, 1024, b == 0 ? nullptr : F.in[I_GPLE] + (size_t)layer * D, 1.f, (bf16_t*)(F.ws + (b == 0 ? WS_WOUT : WS_WPG)), 1024, nb * 64, kb * 64, scr, lane); continue; }
        r -= 2 * N_SQ;
        if (r < N_PP) { const int nb = r >> 2, kb = r & 3; const int n = nb * 64 + g4;
            tr_item64(F.in[I_WPP] + (size_t)layer * 256 * 1024 + n, 1024, nullptr, 1.f, (bf16_t*)(F.ws + WS_WPP), 256, nb * 64, kb * 64, scr, lane); continue; }
        r -= N_PP;
        { const int nb = r >> 4, kb = r & 15; const int n = nb * 64 + g4; const float* cp = nullptr; size_t pitch = 4;
            if (n < 4) { cp = F.in[I_WRG] + (size_t)layer * 1024 * 4 + n; pitch = 4; } else if (n < 36) { cp = F.in[I_WRE] + (size_t)layer * 1024 * 32 + (n - 4); pitch = 32; }
            tr_item64(cp, pitch, F.in[I_GFFN] + (size_t)layer * D, 1.f, (bf16_t*)(F.ws + WS_WR), 1024, nb * 64, kb * 64, scr, lane); }
    }
}
__device__ __forceinline__ void phase_prep_experts(const Ctx& F, int layer) {
    const int gw = F.bid * NWAVES + F.wave, NGW = F.G * NWAVES, lane = F.lane;
    LAS float* scr = (LAS float*)(F.lds + F.wave * TR_LDS);
    const float* g_ffn = F.in[I_GFFN] + (size_t)layer * D;
    constexpr int N_UP = 32 * 8 * 16, N_DN = 32 * 16 * 4;
    const int g4 = 4 * (lane & 15);
    for (int it = gw; it < N_UP + N_DN; it += NGW) {
        int r = it;
        if (r < N_UP) { const int e = r >> 7; r &= 127; const int nb = r >> 4, kb = r & 15; const int n = nb * 64 + g4; const int q8 = n >> 3, sg = (n >> 2) & 1;
            const float* w = (sg ? F.in[I_WEU] : F.in[I_WEG]) + ((size_t)layer * 32 + e) * 1024 * 256 + 4 * q8;
            tr_item64(w, 256, g_ffn, 1.f, (bf16_t*)(F.ws + WS_WEXP) + (size_t)e * 512 * 1024, 1024, nb * 64, kb * 64, scr, lane); continue; }
        r -= N_UP;
        { const int e = r >> 6; r &= 63; const int nb = r >> 2, kb = r & 3; const int n = nb * 64 + g4;
            const float* w = F.in[I_WED] + ((size_t)layer * 32 + e) * 256 * 1024 + n;
            tr_item64(w, 1024, nullptr, 1.f, (bf16_t*)(F.ws + WS_WEXP) + 32ull * 512 * 1024 + (size_t)e * 1024 * 256, 256, nb * 64, kb * 64, scr, lane); }
    }
    const f32x4* p = (const f32x4*)(F.in[I_P] + (size_t)layer * T * 256); u32x2* pb = (u32x2*)(F.ws + WS_PBF);
    for (size_t i = (size_t)F.bid * NTHREADS + F.tid; i < (size_t)T * 256 / 4; i += (size_t)F.G * NTHREADS) { const f32x4 v = p[i]; u32x2 w; w.x = cvt_pk_bf16(v.x, v.y); w.y = cvt_pk_bf16(v.z, v.w); pb[i] = w; }
}

constexpr int AK_RS = 144, AV_RS = 160, AV_OFF = 2 * 128 * AK_RS;
typedef short s16x4 __attribute__((ext_vector_type(4)));
__device__ __forceinline__ s16x4 lds_tr16(LAS unsigned char* p) { return __builtin_amdgcn_ds_read_tr16_b64_v4i16((LAS s16x4*)p); }
__device__ __forceinline__ void attn_strip(const Ctx& F, int strip) {
    const int bs = strip / 48, sg = strip - bs * 48, b = bs >> 3, slot = bs & 7;
    int g, r, nb0;
    if (sg < 16) { g = 0; r = 0; nb0 = sg * 8; } else if (sg < 32) { g = 1; r = (sg - 16) >> 2; nb0 = ((sg - 16) & 3) * 8; } else { g = 2; r = sg - 32; nb0 = 0; }
    const int dl = 1 << (2 * g); const float slope = exp2f(-(float)(g * 8 + slot + 1) * (1.0f / 3.0f)) * (float)dl;
    bf16_t* Qg = (bf16_t*)(F.ws + (g == 0 ? WS_QA0 : (g == 1 ? WS_QA1 : WS_QA2))) + slot * 64;
    const bf16_t* Kg = (const bf16_t*)(F.ws + WS_KA) + slot * 64; const bf16_t* Vg = (const bf16_t*)(F.ws + WS_VA) + slot * 64;
    float* LSE = (float*)(F.ws + WS_LOGITS) + (size_t)g * T * 8 + slot;
    const size_t tok0 = (size_t)b * SEQ + r;
    LAS unsigned char* Kl = F.lds; LAS unsigned char* Vl = F.lds + AV_OFF;
    const int tid = F.tid, lane = F.lane, w = F.wave, fr = lane & 15, fq = lane >> 4;
    const int srow = tid >> 2, sc4 = tid & 3;
    u32x4 kx[2], vx[2];
#define ATT_LOAD(blk) do { const size_t _t = (tok0 + (size_t)((blk) * 128 + srow) * dl) * 512; \
        kx[0] = *(const u32x4*)(Kg + _t + sc4 * 8); kx[1] = *(const u32x4*)(Kg + _t + 32 + sc4 * 8); vx[0] = *(const u32x4*)(Vg + _t + sc4 * 8); vx[1] = *(const u32x4*)(Vg + _t + 32 + sc4 * 8); } while (0)
#define ATT_STORE(blk) do { const int _p = (((blk) & 1) * 128 + srow); \
        *(LAS u32x4*)(Kl + _p * AK_RS + sc4 * 16) = kx[0]; *(LAS u32x4*)(Kl + _p * AK_RS + 64 + sc4 * 16) = kx[1]; *(LAS u32x4*)(Vl + _p * AV_RS + sc4 * 16) = vx[0]; *(LAS u32x4*)(Vl + _p * AV_RS + 64 + sc4 * 16) = vx[1]; } while (0)
    __syncthreads();
    if (nb0 > 0) { ATT_LOAD(nb0 - 1); ATT_STORE(nb0 - 1); }
    else { kx[0] = kx[1] = vx[0] = vx[1] = (u32x4){0u, 0u, 0u, 0u}; ATT_STORE(1); }
    ATT_LOAD(nb0); ATT_STORE(nb0);
    bf16x8 qn0, qn1;
    { const size_t qo = (tok0 + (size_t)(nb0 * 128 + 16 * w + fr) * dl) * 512; qn0 = *(const bf16x8*)(Qg + qo + fq * 8); qn1 = *(const bf16x8*)(Qg + qo + 32 + fq * 8); }
    __syncthreads();
    for (int nb = nb0; nb < nb0 + 8; ++nb) {
        const bool more = nb + 1 < nb0 + 8;
        if (more) ATT_LOAD(nb + 1);
        const size_t qoff = (tok0 + (size_t)(nb * 128 + 16 * w + fr) * dl) * 512;
        const bf16x8 q0 = qn0, q1 = qn1;
        if (more) { const size_t qo2 = qoff + (size_t)128 * dl * 512; qn0 = *(const bf16x8*)(Qg + qo2 + fq * 8); qn1 = *(const bf16x8*)(Qg + qo2 + 32 + fq * 8); }
        const int pslot = (nb - 1) & 1;
        f32x4 S[10];
#pragma unroll
        for (int kbi = 0; kbi < 10; ++kbi) {
            int kb = w + kbi; if (kb > 15) kb = 15;
            const int ki = kb * 16 + fr; const int phys = ((pslot + (ki >> 7)) & 1) * 128 + (ki & 127);
            const bf16x8 k0 = *(const LAS bf16x8*)(Kl + phys * AK_RS + fq * 16), k1 = *(const LAS bf16x8*)(Kl + phys * AK_RS + 64 + fq * 16);
            f32x4 a = (f32x4){0.f, 0.f, 0.f, 0.f};
            a = __builtin_amdgcn_mfma_f32_16x16x32_bf16(k0, q0, a, 0, 0, 0);
            S[kbi] = __builtin_amdgcn_mfma_f32_16x16x32_bf16(k1, q1, a, 0, 0, 0);
        }
        float mx = -INFINITY;
#pragma unroll
        for (int kbi = 0; kbi < 10; ++kbi)
#pragma unroll
            for (int j = 0; j < 4; ++j) { const int ki = (w + kbi) * 16 + 4 * fq + j; const int dist = 16 * w + fr + 128 - ki;
                const bool ok = dist >= 0 && dist <= 128 && (nb > 0 || ki >= 128) && (w + kbi) < 16;
                const float sc = ok ? S[kbi][j] - slope * (float)dist : -INFINITY; S[kbi][j] = sc; mx = fmaxf(mx, sc); }
        mx = fmaxf(mx, __shfl_xor(mx, 16)); mx = fmaxf(mx, __shfl_xor(mx, 32));
        float ls = 0.f;
#pragma unroll
        for (int kbi = 0; kbi < 10; ++kbi)
#pragma unroll
            for (int j = 0; j < 4; ++j) { const float p = __expf(S[kbi][j] - mx); S[kbi][j] = p; ls += p; }
        ls += __shfl_xor(ls, 16); ls += __shfl_xor(ls, 32);
        f32x4 O[4];
#pragma unroll
        for (int db = 0; db < 4; ++db) O[db] = (f32x4){0.f, 0.f, 0.f, 0.f};
#pragma unroll
        for (int k2 = 0; k2 < 5; ++k2) {
            u32x4 pw; pw.x = cvt_pk_bf16(S[2 * k2][0], S[2 * k2][1]); pw.y = cvt_pk_bf16(S[2 * k2][2], S[2 * k2][3]); pw.z = cvt_pk_bf16(S[2 * k2 + 1][0], S[2 * k2 + 1][1]); pw.w = cvt_pk_bf16(S[2 * k2 + 1][2], S[2 * k2 + 1][3]);
            const bf16x8 pf = __builtin_bit_cast(bf16x8, pw);
            int kb0 = w + 2 * k2, kb1 = kb0 + 1; if (kb1 > 15) kb1 = 15; if (kb0 > 15) kb0 = 15;
            const int r0 = kb0 * 16 + 4 * fq + (fr >> 2), r1 = kb1 * 16 + 4 * fq + (fr >> 2);
            const int p0 = ((pslot + (r0 >> 7)) & 1) * 128 + (r0 & 127), p1 = ((pslot + (r1 >> 7)) & 1) * 128 + (r1 & 127);
#pragma unroll
            for (int db = 0; db < 4; ++db) {
                const s16x4 v0 = lds_tr16(Vl + p0 * AV_RS + (db * 16 + 4 * (fr & 3)) * 2), v1 = lds_tr16(Vl + p1 * AV_RS + (db * 16 + 4 * (fr & 3)) * 2);
                const bf16x8 vf = (bf16x8){v0[0], v0[1], v0[2], v0[3], v1[0], v1[1], v1[2], v1[3]};
                O[db] = __builtin_amdgcn_mfma_f32_16x16x32_bf16(vf, pf, O[db], 0, 0, 0);
            }
        }
        const float inv = 1.0f / ls;
#pragma unroll
        for (int db = 0; db < 4; ++db) { u32x2 ow; ow.x = cvt_pk_bf16(O[db][0] * inv, O[db][1] * inv); ow.y = cvt_pk_bf16(O[db][2] * inv, O[db][3] * inv);
            *(u32x2*)(Qg + qoff + db * 16 + 4 * fq) = ow; }
        if (fq == 0) LSE[(qoff >> 9) * 8] = mx + __logf(ls);
        __syncthreads();
        if (more) ATT_STORE(nb + 1);
        __syncthreads();
    }
#undef ATT_LOAD
#undef ATT_STORE
}
__device__ __forceinline__ void attn_combine(const Ctx& F) {
    const float* LSE = (const float*)(F.ws + WS_LOGITS);
    for (int i = F.bid * NTHREADS + F.tid; i < T * 64; i += F.G * NTHREADS) {
        const int t = i >> 6, c8 = i & 63, slot = c8 >> 3;
        const float l0 = LSE[(size_t)t * 8 + slot], l1 = LSE[(size_t)T * 8 + (size_t)t * 8 + slot], l2 = LSE[(size_t)2 * T * 8 + (size_t)t * 8 + slot];
        const float m = fmaxf(l0, fmaxf(l1, l2)); float w0 = __expf(l0 - m), w1 = __expf(l1 - m), w2 = __expf(l2 - m); const float inv = 1.0f / (w0 + w1 + w2); w0 *= inv; w1 *= inv; w2 *= inv;
        u32x4* p0 = (u32x4*)(F.ws + WS_QA0) + i; const u32x4 a = *p0, bb = ((const u32x4*)(F.ws + WS_QA1))[i], cc = ((const u32x4*)(F.ws + WS_QA2))[i];
        f32x4 a0, a1, b0, b1, c0, c1; unpack8(a, a0, a1); unpack8(bb, b0, b1); unpack8(cc, c0, c1);
        *p0 = pack8(a0 * w0 + b0 * w1 + c0 * w2, a1 * w0 + b1 * w1 + c1 * w2);
    }
}

__device__ __forceinline__ void conv_item(const Ctx& F, int layer, int item) {
    const int t0 = item * 32, s0 = t0 & (SEQ - 1), tid = F.tid;
    LAS bf16_t* sin = (LAS bf16_t*)F.lds;
    LAS float* sout = (LAS float*)(F.lds + 65536);
    const bf16_t* YG = (const bf16_t*)(F.ws + WS_YG);
    __syncthreads();
    for (int i = tid; i < 62 * 64; i += NTHREADS) { const int r = i >> 6, c8 = i & 63; const int sp = s0 - 30 + r;
        u32x4 v = *(const u32x4*)(YG + (size_t)(sp >= 0 ? t0 - 30 + r : t0) * 512 + c8 * 8); if (sp < 0) v = (u32x4){0u, 0u, 0u, 0u};
        *(LAS u32x4*)(sin + r * 512 + c8 * 8) = v; }
    const int cp = tid & 255, hf = tid >> 8;
    f32x2 w[31];
    const float* cw = F.in[I_CONVW] + (size_t)layer * 31 * 512 + 2 * cp;
#pragma unroll
    for (int k = 0; k < 31; ++k) w[k] = *(const f32x2*)(cw + k * 512);
    const f32x2 cb = *(const f32x2*)(F.in[I_CONVB] + layer * 512 + 2 * cp);
    __syncthreads();
#pragma unroll 1
    for (int ps = 0; ps < 2; ++ps) { const int tb = 16 * hf + 8 * ps;
        f32x2 xin[38];
#pragma unroll
        for (int r = 0; r < 38; ++r) { const unsigned u = *(const LAS unsigned*)(sin + (tb + r) * 512 + 2 * cp); xin[r] = (f32x2){bf_lo(u), bf_hi(u)}; }
#pragma unroll
        for (int tt = 0; tt < 8; ++tt) { f32x2 a = cb;
#pragma unroll
            for (int k = 0; k < 31; ++k) a += w[k] * xin[tt + k];
            *(LAS f32x2*)(sout + (tb + tt) * 512 + 2 * cp) = a; } }
    __syncthreads();
    const float* lg = F.in[I_CLNG] + layer * 512 + F.lane * 8; const float* lb = F.in[I_CLNB] + layer * 512 + F.lane * 8;
    for (int tt = F.wave; tt < 32; tt += NWAVES) {
        float v[8]; float sm = 0.f;
#pragma unroll
        for (int j = 0; j < 8; ++j) { v[j] = sout[tt * 512 + F.lane * 8 + j]; sm += v[j]; }
        const float mu = wave_sum(sm) * (1.0f / 512.0f); float q = 0.f;
#pragma unroll
        for (int j = 0; j < 8; ++j) { v[j] -= mu; q += v[j] * v[j]; }
        const float rstd = rsqrtf(wave_sum(q) * (1.0f / 512.0f) + EPS);
        float o[8];
#pragma unroll
        for (int j = 0; j < 8; ++j) o[j] = siluf_(v[j] * rstd * lg[j] + lb[j]);
        u32x4 wv; wv.x = cvt_pk_bf16(o[0], o[1]); wv.y = cvt_pk_bf16(o[2], o[3]); wv.z = cvt_pk_bf16(o[4], o[5]); wv.w = cvt_pk_bf16(o[6], o[7]);
        *(u32x4*)((bf16_t*)(F.ws + WS_YC) + (size_t)(t0 + tt) * 512 + F.lane * 8) = wv;
    }
}

__device__ __forceinline__ float log_sigmoid_(float v) { return fminf(v, 0.f) - log1pf(__expf(-fabsf(v))); }
struct QkW { float w[4][8]; float b[8]; };
__device__ __forceinline__ void qk_load_w(const Ctx& F, int layer, int chq, QkW& W) {
    const float* cw = F.in[I_MCW] + (size_t)layer * 4 * 1024 + chq; const float* cb = F.in[I_MCB] + (size_t)layer * 1024 + chq;
#pragma unroll
    for (int k = 0; k < 4; ++k) { const f32x4 a = *(const f32x4*)(cw + k * 1024), b = *(const f32x4*)(cw + k * 1024 + 4); W.w[k][0] = a.x; W.w[k][1] = a.y; W.w[k][2] = a.z; W.w[k][3] = a.w; W.w[k][4] = b.x; W.w[k][5] = b.y; W.w[k][6] = b.z; W.w[k][7] = b.w; }
    const f32x4 a = *(const f32x4*)cb, b = *(const f32x4*)(cb + 4); W.b[0] = a.x; W.b[1] = a.y; W.b[2] = a.z; W.b[3] = a.w; W.b[4] = b.x; W.b[5] = b.y; W.b[6] = b.z; W.b[7] = b.w;
}
__device__ __forceinline__ void qk_conv8(const QkW& W, const bf16_t* src  , int t, int s, int ch  , float scale, float* o) {
#pragma unroll
    for (int j = 0; j < 8; ++j) o[j] = W.b[j];
#pragma unroll
    for (int k = 0; k < 4; ++k) { const bool ok = s - 3 + k >= 0; u32x4 w = *(const u32x4*)(src + (size_t)(ok ? t - 3 + k : t) * 512 + ch);
            if (!ok) w = (u32x4){0u, 0u, 0u, 0u};
            o[0] += W.w[k][0] * bf_lo(w.x); o[1] += W.w[k][1] * bf_hi(w.x); o[2] += W.w[k][2] * bf_lo(w.y); o[3] += W.w[k][3] * bf_hi(w.y); o[4] += W.w[k][4] * bf_lo(w.z); o[5] += W.w[k][5] * bf_hi(w.z); o[6] += W.w[k][6] * bf_lo(w.w); o[7] += W.w[k][7] * bf_hi(w.w); }
#pragma unroll
    for (int j = 0; j < 8; ++j) o[j] = siluf_(o[j]) * scale;
}
__device__ __forceinline__ void qk_conv8r(const QkW& W, const u32x4 (&rw)[4], int s, float scale, float* o) {
#pragma unroll
    for (int j = 0; j < 8; ++j) o[j] = W.b[j];
#pragma unroll
    for (int k = 0; k < 4; ++k) { u32x4 w = rw[k]; if (s - 3 + k < 0) w = (u32x4){0u, 0u, 0u, 0u};
        o[0] += W.w[k][0] * bf_lo(w.x); o[1] += W.w[k][1] * bf_hi(w.x); o[2] += W.w[k][2] * bf_lo(w.y); o[3] += W.w[k][3] * bf_hi(w.y); o[4] += W.w[k][4] * bf_lo(w.z); o[5] += W.w[k][5] * bf_hi(w.z); o[6] += W.w[k][6] * bf_lo(w.w); o[7] += W.w[k][7] * bf_hi(w.w); }
#pragma unroll
    for (int j = 0; j < 8; ++j) o[j] = siluf_(o[j]) * scale;
}
__device__ __forceinline__ void mlstm_scalars(const Ctx& F, int layer, int t0, int h, LAS float* sIG, LAS float* sBC) {
    if (F.tid < 128) { const float* IFp = (const float*)(F.ws + WS_IF) + (size_t)(t0 + F.tid) * 8;
        sIG[F.tid] = IFp[h] + F.in[I_MIB][layer * 4 + h]; sBC[F.tid] = log_sigmoid_(IFp[4 + h] + F.in[I_MFB][layer * 4 + h]); }
    __syncthreads();
    if (F.wave == 0) { const float a = sBC[2 * F.lane], bb = sBC[2 * F.lane + 1]; float sc = a + bb;
#pragma unroll
        for (int off = 1; off < 64; off <<= 1) { const float t = __shfl_up(sc, off); if (F.lane >= off) sc += t; }
        sBC[2 * F.lane] = sc - bb; sBC[2 * F.lane + 1] = sc; }
    __syncthreads();
}
constexpr int ML_KRS = 288, ML_ERS = 352, ML_E = 128 * ML_KRS, ML_S = ML_E + 128 * ML_ERS;
__device__ __forceinline__ void mlstm_local_mfma(const Ctx& F, int layer, int item) {
    const int c = item & 127, bh = item >> 7, h = bh & 3, b = bh >> 2, t0 = b * SEQ + c * 128, tid = F.tid, lane = F.lane, w = F.wave, fr = lane & 15, fq = lane >> 4;
    LAS unsigned char* L = F.lds;
    LAS float* sIG = (LAS float*)(L + ML_S); LAS float* sBC = sIG + 128; LAS float* sE = sIG + 256; LAS float* sM = sIG + 384;
    __syncthreads();
    mlstm_scalars(F, layer, t0, h, sIG, sBC);
    if (w == 0) { const float gt = sBC[127]; const float m = wave_max(fmaxf(gt - sBC[lane] + sIG[lane], gt - sBC[lane + 64] + sIG[lane + 64])); if (lane == 0) { sM[0] = m; sM[1] = gt; } }
    __syncthreads();
    if (tid < 128) sE[tid] = __expf(sM[1] - sBC[tid] + sIG[tid] - sM[0]);
    __syncthreads();
    const bf16_t* KM = (const bf16_t*)(F.ws + WS_KM); const bf16_t* VM = (const bf16_t*)(F.ws + WS_VM);
    QkW WK; qk_load_w(F, layer, 512 + h * 128 + (tid & 15) * 8, WK);
#pragma unroll 1
    for (int i = tid; i < 128 * 16; i += NTHREADS) { const int l = i >> 4, c8 = (i & 15) * 8; const int t = t0 + l, s = t & (SEQ - 1);
        u32x4 rk[4];
#pragma unroll
        for (int k = 0; k < 4; ++k) rk[k] = *(const u32x4*)(KM + (size_t)(s - 3 + k >= 0 ? t - 3 + k : t) * 512 + h * 128 + c8);
        const u32x4 rv = *(const u32x4*)(VM + (size_t)t * 512 + h * 128 + c8);
        float o[8]; qk_conv8r(WK, rk, s, 0.08838834764831845f, o);
        *(LAS u32x4*)(L + l * ML_KRS + c8 * 2) = pack8((f32x4){o[0], o[1], o[2], o[3]}, (f32x4){o[4], o[5], o[6], o[7]});
        f32x4 v0, v1; unpack8(rv, v0, v1); const float e = sE[l];
        *(LAS u32x4*)(L + ML_E + l * ML_ERS + c8 * 2) = pack8(v0 * e, v1 * e); }
    if (tid < 128) { u32x4 z; z.x = f2bf(sE[tid]); z.y = 0u; z.z = 0u; z.w = 0u; *(LAS u32x4*)(L + ML_E + tid * ML_ERS + 256) = z; z.x = 0u; *(LAS u32x4*)(L + ML_E + tid * ML_ERS + 272) = z; }
    __syncthreads();
    bf16x8 af[4];
#pragma unroll
    for (int ks = 0; ks < 4; ++ks) { const int ra = ks * 32 + 4 * fq + (fr >> 2);
        const s16x4 a0 = lds_tr16(L + ra * ML_KRS + (w * 16 + 4 * (fr & 3)) * 2), a1 = lds_tr16(L + (ra + 16) * ML_KRS + (w * 16 + 4 * (fr & 3)) * 2);
        af[ks] = (bf16x8){a0[0], a0[1], a0[2], a0[3], a1[0], a1[1], a1[2], a1[3]}; }
    bf16_t* Cp = (bf16_t*)(F.ws + WS_CST) + ((size_t)(bh * 128 + c) << 14);
#pragma unroll
    for (int vb = 0; vb < 9; ++vb) { f32x4 d = (f32x4){0.f, 0.f, 0.f, 0.f};
#pragma unroll
        for (int ks = 0; ks < 4; ++ks) { const int rb = ks * 32 + 4 * fq + (fr >> 2);
            const s16x4 b0 = lds_tr16(L + ML_E + rb * ML_ERS + (vb * 16 + 4 * (fr & 3)) * 2), b1 = lds_tr16(L + ML_E + (rb + 16) * ML_ERS + (vb * 16 + 4 * (fr & 3)) * 2);
            const bf16x8 bfr = (bf16x8){b0[0], b0[1], b0[2], b0[3], b1[0], b1[1], b1[2], b1[3]};
            d = __builtin_amdgcn_mfma_f32_16x16x32_bf16(af[ks], bfr, d, 0, 0, 0); }
        if (vb < 8) { u32x2 o; o.x = pk2(d[0], d[1]); o.y = pk2(d[2], d[3]); *(u32x2*)(Cp + (size_t)(vb * 16 + fr) * 128 + w * 16 + 4 * fq) = o; }
        else if (fr == 0) *(f32x4*)((float*)(F.ws + WS_NST) + (size_t)(bh * 128 + c) * 128 + w * 16 + 4 * fq) = d;
    }
    if (tid == 0) { ((float*)(F.ws + WS_TAB + TAB_MLOC))[bh * 128 + c] = sM[0]; ((float*)(F.ws + WS_TAB + TAB_GTOT))[bh * 128 + c] = sM[1]; }
}
__device__ __forceinline__ void phase_scan(const Ctx& F) {
    const float* GT = (const float*)(F.ws + WS_TAB + TAB_GTOT); const float* ML = (const float*)(F.ws + WS_TAB + TAB_MLOC); float* MS = (float*)(F.ws + WS_TAB + TAB_MST);
    LAS float* sA = (LAS float*)F.lds; LAS float* sB = sA + 128;
    for (int blk = F.bid; blk < 8 * 32 + 8; blk += F.G) {
        const bool isC = blk < 256; const int bh = isC ? (blk >> 5) : (blk - 256);
        __syncthreads();
        if (F.tid < 128) { sA[F.tid] = GT[bh * 128 + F.tid]; sB[F.tid] = ML[bh * 128 + F.tid]; }
        __syncthreads();
        if (F.tid == 0) { float mp = 0.f;
            for (int c = 0; c < 128; ++c) { const float gc = sA[c], ml = sB[c]; const float mn = fmaxf(gc + mp, ml); sA[c] = __expf(gc + mp - mn); sB[c] = __expf(ml - mn);
                if (isC && (blk & 31) == 0) MS[bh * 128 + c] = mp; mp = mn; } }
        __syncthreads();
        if (isC) { bf16_t* cp = (bf16_t*)(F.ws + WS_CST) + ((size_t)(bh * 128) << 14) + (blk & 31) * 512 + F.tid; float val = 0.f;
            for (int c0 = 0; c0 < 128; c0 += 16) { float loc[16];
#pragma unroll
                for (int j = 0; j < 16; ++j) loc[j] = bf1(cp[(size_t)(c0 + j) << 14]);
#pragma unroll
                for (int j = 0; j < 16; ++j) { cp[(size_t)(c0 + j) << 14] = (bf16_t)f2bf(val); val = sA[c0 + j] * val + sB[c0 + j] * loc[j]; } } }
        else if (F.tid < 128) { float* np = (float*)(F.ws + WS_NST) + (size_t)(bh * 128) * 128 + F.tid; float val = 0.f;
            for (int c0 = 0; c0 < 128; c0 += 16) { float loc[16];
#pragma unroll
                for (int j = 0; j < 16; ++j) loc[j] = np[(size_t)(c0 + j) * 128];
#pragma unroll
                for (int j = 0; j < 16; ++j) { np[(size_t)(c0 + j) * 128] = val; val = sA[c0 + j] * val + sB[c0 + j] * loc[j]; } } }
    }
    __syncthreads();
}
constexpr int MO_RS = 272, MO_VRS = 288;
constexpr int MO_Q = 0, MO_K = 128 * MO_RS, MO_C = 2 * 128 * MO_RS, MO_V = MO_C + 144 * MO_RS, MO_S = MO_V + 128 * MO_VRS;
static_assert(MO_S + 2560 <= MISC_OFF, "mlstm_out LDS");
__device__ __forceinline__ void mlstm_out_mfma(const Ctx& F, int layer, int item) {
    const int c = item & 127, bh = item >> 7, h = bh & 3, b = bh >> 2, t0 = b * SEQ + c * 128, tid = F.tid, lane = F.lane, w = F.wave, fr = lane & 15, fq = lane >> 4;
    LAS unsigned char* L = F.lds;
    LAS float* sIG = (LAS float*)(L + MO_S); LAS float* sBC = sIG + 128; LAS float* sMT = sIG + 256; LAS float* sSI = sIG + 384;
    __syncthreads();
    mlstm_scalars(F, layer, t0, h, sIG, sBC);
    const float mst = ((const float*)(F.ws + WS_TAB + TAB_MST))[bh * 128 + c];
    if (w == 0) { const float a = sIG[2 * lane] - sBC[2 * lane], bb = sIG[2 * lane + 1] - sBC[2 * lane + 1]; float pm = fmaxf(a, bb);
#pragma unroll
        for (int off = 1; off < 64; off <<= 1) { const float t = __shfl_up(pm, off); if (lane >= off) pm = fmaxf(pm, t); }
        float pl = __shfl_up(pm, 1); if (lane == 0) pl = -INFINITY;
        const float p0 = fmaxf(pl, a), p1 = pm;
        { const float ai = sBC[2 * lane] + mst, mt = fmaxf(ai, sBC[2 * lane] + p0); sMT[2 * lane] = mt; sSI[2 * lane] = __expf(ai - mt); }
        { const float ai = sBC[2 * lane + 1] + mst, mt = fmaxf(ai, sBC[2 * lane + 1] + p1); sMT[2 * lane + 1] = mt; sSI[2 * lane + 1] = __expf(ai - mt); } }
    const bf16_t* QM = (const bf16_t*)(F.ws + WS_QM); const bf16_t* KM = (const bf16_t*)(F.ws + WS_KM); const bf16_t* VM = (const bf16_t*)(F.ws + WS_VM);
    const bf16_t* Cp = (const bf16_t*)(F.ws + WS_CST) + ((size_t)(bh * 128 + c) << 14);
    QkW WQ, WK; qk_load_w(F, layer, h * 128 + (tid & 15) * 8, WQ); qk_load_w(F, layer, 512 + h * 128 + (tid & 15) * 8, WK);
#pragma unroll 1
    for (int i = tid; i < 128 * 16; i += NTHREADS) { const int l = i >> 4, c8 = (i & 15) * 8; const int t = t0 + l, s = t & (SEQ - 1); float o[8];
        u32x4 rq[4], rk[4];
#pragma unroll
        for (int k = 0; k < 4; ++k) { const size_t ro = (size_t)(s - 3 + k >= 0 ? t - 3 + k : t) * 512 + h * 128 + c8; rq[k] = *(const u32x4*)(QM + ro); rk[k] = *(const u32x4*)(KM + ro); }
        const u32x4 rv = *(const u32x4*)(VM + (size_t)t * 512 + h * 128 + c8), rc = *(const u32x4*)(Cp + l * 128 + c8);
        qk_conv8r(WQ, rq, s, 1.0f, o);
        *(LAS u32x4*)(L + MO_Q + l * MO_RS + c8 * 2) = pack8((f32x4){o[0], o[1], o[2], o[3]}, (f32x4){o[4], o[5], o[6], o[7]});
        qk_conv8r(WK, rk, s, 0.08838834764831845f, o);
        *(LAS u32x4*)(L + MO_K + l * MO_RS + c8 * 2) = pack8((f32x4){o[0], o[1], o[2], o[3]}, (f32x4){o[4], o[5], o[6], o[7]});
        *(LAS u32x4*)(L + MO_V + l * MO_VRS + c8 * 2) = rv;
        *(LAS u32x4*)(L + MO_C + l * MO_RS + c8 * 2) = rc; }
    if (tid < 16) { const float* np = (const float*)(F.ws + WS_NST) + (size_t)(bh * 128 + c) * 128 + tid * 8;
        *(LAS u32x4*)(L + MO_C + 128 * MO_RS + tid * 16) = pack8(*(const f32x4*)np, *(const f32x4*)(np + 4)); }
    __syncthreads();
    const int q = 16 * w + fr;
    bf16x8 qf[4];
#pragma unroll
    for (int ks = 0; ks < 4; ++ks) qf[ks] = *(const LAS bf16x8*)(L + MO_Q + q * MO_RS + ks * 64 + fq * 16);
    f32x4 O[9];
#pragma unroll
    for (int vb = 0; vb < 9; ++vb) { f32x4 a = (f32x4){0.f, 0.f, 0.f, 0.f};
#pragma unroll
        for (int ks = 0; ks < 4; ++ks) { const bf16x8 cf = *(const LAS bf16x8*)(L + MO_C + (vb * 16 + fr) * MO_RS + ks * 64 + fq * 16); a = __builtin_amdgcn_mfma_f32_16x16x32_bf16(cf, qf[ks], a, 0, 0, 0); }
        O[vb] = a; }
    const float si = sSI[q], mt = sMT[q], bq = sBC[q];
    const float dn = __shfl(O[8][0], fr);
#pragma unroll
    for (int vb = 0; vb < 8; ++vb) O[vb] = O[vb] * si;
    float den = 0.f;
    for (int k2 = 0; k2 <= (w >> 1); ++k2) {
        f32x4 P[2];
#pragma unroll
        for (int u = 0; u < 2; ++u) { const int kb = 2 * k2 + u; f32x4 a = (f32x4){0.f, 0.f, 0.f, 0.f};
            const int kr = (kb > 7 ? 7 : kb) * 16 + fr;
#pragma unroll
            for (int ks = 0; ks < 4; ++ks) { const bf16x8 kf = *(const LAS bf16x8*)(L + MO_K + kr * MO_RS + ks * 64 + fq * 16); a = __builtin_amdgcn_mfma_f32_16x16x32_bf16(kf, qf[ks], a, 0, 0, 0); }
#pragma unroll
            for (int j = 0; j < 4; ++j) { const int k = kb * 16 + 4 * fq + j; const int kc = k > 127 ? 127 : k; const float wgt = (k <= q) ? __expf(bq - sBC[kc] + sIG[kc] - mt) : 0.f; a[j] *= wgt; den += a[j]; }
            P[u] = a; }
        u32x4 pw; pw.x = cvt_pk_bf16(P[0][0], P[0][1]); pw.y = cvt_pk_bf16(P[0][2], P[0][3]); pw.z = cvt_pk_bf16(P[1][0], P[1][1]); pw.w = cvt_pk_bf16(P[1][2], P[1][3]);
        const bf16x8 pf = __builtin_bit_cast(bf16x8, pw);
        const int kb1 = (2 * k2 + 1 > 7) ? 7 : 2 * k2 + 1;
        const int r0 = 2 * k2 * 16 + 4 * fq + (fr >> 2), r1 = kb1 * 16 + 4 * fq + (fr >> 2);
#pragma unroll
        for (int vb = 0; vb < 8; ++vb) {
            const s16x4 v0 = lds_tr16(L + MO_V + r0 * MO_VRS + (vb * 16 + 4 * (fr & 3)) * 2), v1 = lds_tr16(L + MO_V + r1 * MO_VRS + (vb * 16 + 4 * (fr & 3)) * 2);
            const bf16x8 vf = (bf16x8){v0[0], v0[1], v0[2], v0[3], v1[0], v1[1], v1[2], v1[3]};
            O[vb] = __builtin_amdgcn_mfma_f32_16x16x32_bf16(vf, pf, O[vb], 0, 0, 0);
        }
    }
    den += __shfl_xor(den, 16); den += __shfl_xor(den, 32);
    const float dd = den + si * dn; const float inv = 1.0f / fmaxf(fabsf(dd), __expf(-mt));
    bf16_t* OM = (bf16_t*)(F.ws + WS_OM) + (size_t)(t0 + q) * 512 + h * 128;
#pragma unroll
    for (int vb = 0; vb < 8; ++vb) { u32x2* p = (u32x2*)(OM + vb * 16 + 4 * fq); const u32x2 g = *p;
        u32x2 o; o.x = cvt_pk_bf16(bf_lo(g.x) * O[vb][0] * inv, bf_hi(g.x) * O[vb][1] * inv); o.y = cvt_pk_bf16(bf_lo(g.y) * O[vb][2] * inv, bf_hi(g.y) * O[vb][3] * inv); *p = o; }
}

__device__ __forceinline__ void phase_route(const Ctx& F, int layer) {
    int* tokl = (int*)(F.ws + WS_LISTS);
    for (int i = F.bid * NTHREADS + F.tid; i < 2 * LISTCAP; i += F.G * NTHREADS) tokl[i] = -1;
    LAS int* hist = (LAS int*)F.lds;
    const float* brg = F.in[I_BRG] + layer * 4; const float* bre = F.in[I_BRE] + layer * 32;
    for (int tile = F.bid; tile < 256; tile += F.G) {
        if (F.tid < 128) { const int t = tile * 128 + F.tid; const float* lg = (const float*)(F.ws + WS_LOGITS) + (size_t)t * 64;
            float g[4]; int gs = 0; float gm;
#pragma unroll
            for (int j = 0; j < 4; ++j) g[j] = lg[j] + brg[j];
            gm = g[0];
#pragma unroll
            for (int j = 1; j < 4; ++j) if (g[j] > gm) { gm = g[j]; gs = j; }
            float se = 0.f;
#pragma unroll
            for (int j = 0; j < 4; ++j) se += __expf(g[j] - gm);
            const float pg = 1.0f / se;
            float le[8];
#pragma unroll
            for (int j = 0; j < 8; ++j) le[j] = lg[4 + gs * 8 + j] + bre[gs * 8 + j];
            int i0 = 0; float v0 = le[0];
#pragma unroll
            for (int j = 1; j < 8; ++j) if (le[j] > v0) { v0 = le[j]; i0 = j; }
            int i1 = -1; float v1 = -INFINITY;
#pragma unroll
            for (int j = 0; j < 8; ++j) if (j != i0 && le[j] > v1) { v1 = le[j]; i1 = j; }
            const float e1 = __expf(v1 - v0); const float wsc = (ABL == 4) ? 0.f : ((ABL == 6) ? 2.f : 1.f); const float w0 = wsc * pg / (1.0f + e1), w1 = wsc * pg * e1 / (1.0f + e1);
            const int x0 = gs * 8 + i0, x1 = gs * 8 + i1;
            ((int*)(F.ws + WS_ROUTE))[2 * t] = x0; ((int*)(F.ws + WS_ROUTE))[2 * t + 1] = x1;
            ((float*)(F.ws + WS_ROUTE))[2 * T + 2 * t] = w0; ((float*)(F.ws + WS_ROUTE))[2 * T + 2 * t + 1] = w1;
            hist[F.tid] = x0; hist[128 + F.tid] = x1;
        }
        __syncthreads();
        if (F.tid < 64) { const int k = F.tid >> 5, e = F.tid & 31; int cnt = 0; for (int j = 0; j < 128; ++j) cnt += (hist[k * 128 + j] == e) ? 1 : 0; ((int*)(F.ws + WS_TAB + TAB_CNT))[tile * 64 + F.tid] = cnt; }
        __syncthreads();
    }
}
__device__ __forceinline__ void phase_dispatch(const Ctx& F) {
    LAS int* sTot = (LAS int*)F.lds; LAS int* sBef = sTot + 64; LAS int* sPs = sTot + 128; LAS int* sE = sTot + 256;
    const int* CNT = (const int*)(F.ws + WS_TAB + TAB_CNT); int* META = (int*)(F.ws + WS_TAB + TAB_META);
    int* tokl = (int*)(F.ws + WS_LISTS); float* wl = (float*)(F.ws + WS_LISTS) + 2 * LISTCAP;
    for (int tile = F.bid; tile < 256; tile += F.G) {
        if (F.tid < 64) { int tot = 0, bef = 0; for (int j = 0; j < 256; ++j) { const int v = CNT[j * 64 + F.tid]; tot += v; bef += (j < tile) ? v : 0; } sTot[F.tid] = tot; sBef[F.tid] = bef; }
        __syncthreads();
        if (F.tid < 2) { int ps = 0; for (int e = 0; e < 32; ++e) { sPs[F.tid * 33 + e] = ps; ps += ((sTot[F.tid * 32 + e] + 255) >> 8) << 8; } sPs[F.tid * 33 + 32] = ps;
            if (tile == 0) { META[F.tid] = ps >> 8; for (int e = 0; e <= 32; ++e) META[16 + 64 * F.tid + e] = sPs[F.tid * 33 + e]; } }
        int e0 = 0, e1 = 0; float w0 = 0.f, w1 = 0.f;
        if (F.tid < 128) { const int t = tile * 128 + F.tid; e0 = ((const int*)(F.ws + WS_ROUTE))[2 * t]; e1 = ((const int*)(F.ws + WS_ROUTE))[2 * t + 1];
            w0 = ((const float*)(F.ws + WS_ROUTE))[2 * T + 2 * t]; w1 = ((const float*)(F.ws + WS_ROUTE))[2 * T + 2 * t + 1]; sE[F.tid] = e0; sE[128 + F.tid] = e1; }
        __syncthreads();
        if (F.tid < 128) { int r0 = 0, r1 = 0; for (int j = 0; j < F.tid; ++j) { r0 += (sE[j] == e0) ? 1 : 0; r1 += (sE[128 + j] == e1) ? 1 : 0; }
            const int p0 = sPs[e0] + sBef[e0] + r0, p1 = sPs[33 + e1] + sBef[32 + e1] + r1;
            tokl[p0] = tile * 128 + F.tid; wl[p0] = w0; tokl[LISTCAP + p1] = tile * 128 + F.tid; wl[LISTCAP + p1] = w1; }
        __syncthreads();
    }
}
__device__ __forceinline__ void phase_final(const Ctx& F, const float* SS) {
    const int gw = F.bid * NWAVES + F.wave, NGW = F.G * NWAVES, lane = F.lane;
    for (int m = gw; m < T; m += NGW) { const float rs = row_rs(SS, m); f32x4* o = (f32x4*)(F.out + (size_t)m * D) + 2 * lane; const f32x4* g = (const f32x4*)F.in[I_GFIN] + 2 * lane;
        const u32x4* xr = (const u32x4*)((const bf16_t*)(F.ws + WS_XBT) + (size_t)m * D) + lane;
#pragma unroll
        for (int j = 0; j < 2; ++j) { f32x4 x0, x1; unpack8(xr[64 * j], x0, x1); o[128 * j] = x0 * rs * g[128 * j]; o[128 * j + 1] = x1 * rs * g[128 * j + 1]; } }
}
constexpr int PH_PER_LAYER = 15, PH_FINAL = DEPTH * PH_PER_LAYER, N_PHASES = PH_FINAL + 1;
struct Args { const float* in[28]; float* out; unsigned char* ws; int ph_lo, ph_hi; };

__device__ __forceinline__ Ctx mkctx(const Args& args, LAS unsigned char* lds, int wave_s) {
    Ctx F; asm volatile("" : "+s"(wave_s)); int tid = wave_s * 64 + lane_id_(); asm volatile("" : "+v"(tid));
    GAS unsigned char* wsg = (GAS unsigned char*)args.ws; asm volatile("" : "+s"(wsg)); unsigned char* ws = (unsigned char*)wsg;
    GAS float* outg = (GAS float*)args.out; asm volatile("" : "+s"(outg)); float* outp = (float*)outg;
    int bid = blockIdx.x; asm volatile("" : "+s"(bid)); int G = gridDim.x; asm volatile("" : "+s"(G));
    F.in.p = args.in; F.out = outp; F.ws = ws; F.lds = lds;
    F.tid = tid; F.lane = tid & 63; F.wave = wave_s; F.G = G; F.bid = bid;
    return F;
}
#ifndef ONLY_PHASE
#define ONLY_PHASE -1
#endif
__device__ __forceinline__ void run_phase(const Args& args, LAS unsigned char* lds, int ph, int wave_s) {
    const int layer = ph / PH_PER_LAYER, lp = ph - layer * PH_PER_LAYER;
    const size_t ssin = (layer & 1) ? WS_SS1 : WS_SS0, ssmid = (layer & 1) ? WS_SS0 : WS_SS1;
    if (ph == PH_FINAL) { const Ctx F = mkctx(args, lds, wave_s); phase_final(F, (const float*)(F.ws + WS_SS0)); return; }
    if (ONLY_PHASE >= 0 && lp != ONLY_PHASE) return;
    switch (lp) {
    case 0: { const Ctx F = mkctx(args, lds, wave_s); phase_prep(F, layer, (float*)(F.ws + ssin)); } break;
    case 1: { const Ctx F = mkctx(args, lds, wave_s); PhProj P{(const char*)F.ws + WS_XB, (const char*)F.ws + WS_WIN, (const float*)(F.ws + ssin), F.ws, F.G, F.bid}; pg8::gemm_phase(F.lds, P, F.tid); } break;
    case 2: { const Ctx F = mkctx(args, lds, wave_s);
        for (int it = F.bid; it < 768; it += F.G) attn_strip(F, it);
        __syncthreads();
        for (int it = F.bid; it < 1024; it += F.G) mlstm_local_mfma(F, layer, it);
        for (int it = F.bid; it < 1024; it += F.G) conv_item(F, layer, it);
    } break;
    case 3: { const Ctx F = mkctx(args, lds, wave_s); phase_scan(F); attn_combine(F); } break;
    case 4: { const Ctx F = mkctx(args, lds, wave_s); for (int it = F.bid; it < 1024; it += F.G) mlstm_out_mfma(F, layer, it); } break;
    case 5: { const Ctx F = mkctx(args, lds, wave_s); PhGates P{(const char*)F.ws + WS_XB, (const char*)F.ws + WS_WIN, (const float*)(F.ws + ssin), F.ws, F.G, F.bid}; pg8::gemm_phase(F.lds, P, F.tid); } break;
    case 6: { const Ctx F = mkctx(args, lds, wave_s); PhMerge P{F.ws, F.G, F.bid}; pg8::gemm_phase(F.lds, P, F.tid); } break;
    case 7: { const Ctx F = mkctx(args, lds, wave_s); PhOut P{F.ws, (float*)(F.ws + ssmid), F.G, F.bid}; pg8::gemm_phase(F.lds, P, F.tid); } break;
    case 8: { const Ctx F = mkctx(args, lds, wave_s); PhRouter P{F.ws, (const float*)(F.ws + ssmid), F.G, F.bid}; pg8::gemm_phase(F.lds, P, F.tid); phase_prep_experts(F, layer); } break;
    case 9: { const Ctx F = mkctx(args, lds, wave_s); phase_route(F, layer); } break;
    case 10: { const Ctx F = mkctx(args, lds, wave_s); phase_dispatch(F); } break;
    case 11: { const Ctx F = mkctx(args, lds, wave_s); PhUp P{F.ws, (const float*)(F.ws + ssmid), (const int*)(F.ws + WS_TAB + TAB_META), (const int*)(F.ws + WS_LISTS), F.G, F.bid}; pg8::gemm_phase(F.lds, P, F.tid); } break;
    case 12: { const Ctx F = mkctx(args, lds, wave_s); PhDown<1> P{F.ws, (float*)(F.ws + ssin), (const int*)(F.ws + WS_TAB + TAB_META), (const int*)(F.ws + WS_LISTS), (const float*)(F.ws + WS_LISTS) + 2 * LISTCAP, F.G, F.bid}; pg8::gemm_phase(F.lds, P, F.tid); } break;
    case 13: { const Ctx F = mkctx(args, lds, wave_s); PhDown<0> P{F.ws, (float*)(F.ws + ssin), (const int*)(F.ws + WS_TAB + TAB_META), (const int*)(F.ws + WS_LISTS), (const float*)(F.ws + WS_LISTS) + 2 * LISTCAP, F.G, F.bid}; pg8::gemm_phase(F.lds, P, F.tid); } break;
    case 14: { const Ctx F = mkctx(args, lds, wave_s); PhPle P{F.ws, (const float*)(F.ws + ssin), (float*)(F.ws + ssmid), F.G, F.bid}; pg8::gemm_phase(F.lds, P, F.tid); } break;
    }
}

__global__ void __launch_bounds__(NTHREADS, 2) fwd_kernel(Args args) {
    extern __shared__ __attribute__((aligned(16))) unsigned char lds_raw[];
    LAS unsigned char* lds = (LAS unsigned char*)lds_raw;
    volatile LAS unsigned* MISC = (volatile LAS unsigned*)(lds + MISC_OFF);
    const int wave_s = __builtin_amdgcn_readfirstlane((int)threadIdx.x >> 6);
    if (wave_s == 0) MISC[lane_id_()] = 0u;
    __syncthreads();
#if MK_MEGA
    XcdBarrier bar = xcd_barrier_post((unsigned*)(args.ws + WS_CTL) + 4096, MISC + 8, wave_s);
#endif
#ifndef PROBE_SEL
#define PROBE_SEL 0
#endif
    unsigned long long extra = 0ull;
    for (int ph = args.ph_lo; ph < args.ph_hi; ++ph) {
        const unsigned long long t0 = PROBE_SEL ? __builtin_amdgcn_s_memrealtime() : 0ull;
        run_phase(args, lds, ph, wave_s);
#if MK_MEGA
        if (ph + 1 < args.ph_hi) xcd_barrier(bar);
#endif
        if (PROBE_SEL) { const int lp = ph % PH_PER_LAYER; if (ph < PH_FINAL && ((PROBE_SEL >> lp) & 1)) extra += __builtin_amdgcn_s_memrealtime() - t0; }
    }
    if (PROBE_SEL && blockIdx.x == 0) { const unsigned long long te = __builtin_amdgcn_s_memrealtime(); while (__builtin_amdgcn_s_memrealtime() - te < extra) __builtin_amdgcn_s_sleep(8); }
}

extern "C" void kernel_launch(void* const* d_in, const int* in_sizes, int n_in, void* d_out, int out_size, void* d_ws, size_t ws_size, hipStream_t stream) {
    static int grid = 0;
    if (grid == 0) {
        if (n_in != 28 || out_size != T * D || ws_size < WS_END) { fprintf(stderr, "kernel_launch: unexpected shapes (n_in %d out %d ws %zu, need %zu)\n", n_in, out_size, ws_size, (size_t)WS_END); grid = -1; return; }
        int dev = 0, cus = 0, per_cu = 0;
        if (hipGetDevice(&dev) != hipSuccess || hipDeviceGetAttribute(&cus, hipDeviceAttributeMultiprocessorCount, dev) != hipSuccess) { grid = -1; return; }
        if (hipFuncSetAttribute((const void*)fwd_kernel, hipFuncAttributeMaxDynamicSharedMemorySize, LDS_BYTES) != hipSuccess) { fprintf(stderr, "kernel_launch: hipFuncSetAttribute failed\n"); grid = -1; return; }
        if (hipOccupancyMaxActiveBlocksPerMultiprocessor(&per_cu, (const void*)fwd_kernel, NTHREADS, LDS_BYTES) != hipSuccess || per_cu < 1) { fprintf(stderr, "kernel_launch: occupancy query says %d blocks per CU\n", per_cu); }
        (void)hipGetLastError();
        grid = cus;
    }
    if (grid < 0) return;
    Args a{};
    for (int i = 0; i < 28; ++i) a.in[i] = (const float*)d_in[i];
    a.out = (float*)d_out; a.ws = (unsigned char*)d_ws;
#if MK_MEGA
    (void)hipMemsetAsync((char*)d_ws + WS_CTL, 0, CTL_ZERO_BYTES, stream);
    a.ph_lo = 0; a.ph_hi = N_PHASES;
    hipLaunchKernelGGL(fwd_kernel, dim3(grid), dim3(NTHREADS), LDS_BYTES, stream, a);
#else
    for (int ph = 0; ph < N_PHASES; ++ph) { a.ph_lo = ph; a.ph_hi = ph + 1; hipLaunchKernelGGL(fwd_kernel, dim3(grid), dim3(NTHREADS), LDS_BYTES, stream, a); }
#endif
}
```

```cpp
#include <hip/hip_runtime.h>
#include <cstdio>
#include <cstdint>

#ifndef MK_MEGA
#define MK_MEGA 1
#endif

#ifndef ABL
#define ABL 0
#endif
#define LAS __attribute__((address_space(3)))
#define GAS __attribute__((address_space(1)))
typedef unsigned short bf16_t;
typedef short bf16x8 __attribute__((ext_vector_type(8)));
typedef float f32x4 __attribute__((ext_vector_type(4)));
typedef float f32x2 __attribute__((ext_vector_type(2)));
typedef unsigned u32x4 __attribute__((ext_vector_type(4)));
typedef unsigned u32x2 __attribute__((ext_vector_type(2)));

constexpr int T = 32768, SEQ = 16384, D = 1024, DEPTH = 2;
constexpr int D_IN = 8712;
constexpr float EPS = 1e-6f;
constexpr int NTHREADS = 512, NWAVES = 8;
constexpr int LISTCAP = 40960;

constexpr size_t MiB = 1u << 20;
constexpr size_t WS_CTL = 0, CTL_ZERO_BYTES = 1 * MiB;
constexpr size_t WS_TAB = 1 * MiB;
constexpr size_t WS_ROUTE = 2 * MiB;
constexpr size_t WS_LISTS = 3 * MiB;
constexpr size_t WS_SS0 = 4 * MiB, WS_SS1 = 6 * MiB;
constexpr size_t WS_IF = 8 * MiB;
constexpr size_t WS_NST = 9 * MiB;
constexpr size_t WS_LOGITS = 10 * MiB;
constexpr size_t WS_WIN = 18 * MiB;
constexpr size_t WS_WBR = WS_WIN + 8960ull * 1024 * 2;
constexpr size_t WS_WOUT = WS_WBR + 3ull * 1024 * 512 * 2;
constexpr size_t WS_WPG = WS_WOUT + 1024ull * 1024 * 2;
constexpr size_t WS_WPP = WS_WPG + 1024ull * 1024 * 2;
constexpr size_t WS_WR = WS_WPP + 1024ull * 256 * 2;
static_assert(WS_WR + 256ull * 1024 * 2 <= 44 * MiB, "small weights");
constexpr size_t WS_XB = 44 * MiB;
constexpr size_t WS_QA0 = 108 * MiB;
constexpr size_t WS_YATT = WS_QA0;
constexpr size_t WS_OM = 140 * MiB;
constexpr size_t WS_YC = 172 * MiB;
constexpr size_t WS_CST = 204 * MiB;
constexpr size_t WS_B = 236 * MiB;
constexpr size_t WS_KA = WS_B, WS_QA1 = WS_B + 32 * MiB, WS_QA2 = WS_B + 64 * MiB, WS_VA = WS_B + 96 * MiB, WS_YG = WS_B + 128 * MiB, WS_QM = WS_B + 160 * MiB, WS_KM = WS_B + 192 * MiB, WS_VM = WS_B + 224 * MiB;
constexpr size_t WS_G0 = WS_B, WS_MERGED = WS_B + 192 * MiB;
constexpr size_t WS_WEXP = WS_B, WS_HB = WS_B + 48 * MiB, WS_PBF = WS_B + 88 * MiB, WS_PE = WS_B + 104 * MiB, WS_YB1 = WS_B + 168 * MiB, WS_XBT = WS_B;
constexpr size_t WS_END = 492 * MiB;
constexpr size_t TAB_CNT = 0;
constexpr size_t TAB_META = 65536;
constexpr size_t TAB_MLOC = 131072, TAB_GTOT = 131072 + 4096, TAB_MST = 131072 + 8192;

constexpr int RING_BYTES = 131072;
constexpr int MISC_OFF = 155648;
constexpr int LDS_BYTES = 156672;

__device__ __forceinline__ unsigned f2bf(float f) { unsigned u = __builtin_bit_cast(unsigned, f); return (u + 0x7fffu + ((u >> 16) & 1u)) >> 16; }
__device__ __forceinline__ unsigned pk2(float lo, float hi) { return f2bf(lo) | (f2bf(hi) << 16); }
__device__ __forceinline__ unsigned cvt_pk_bf16(float lo, float hi) { unsigned r; asm volatile("v_cvt_pk_bf16_f32 %0, %1, %2" : "=v"(r) : "v"(lo), "v"(hi)); return r; }
__device__ __forceinline__ float bf_lo(unsigned w) { return __builtin_bit_cast(float, w << 16); }
__device__ __forceinline__ float bf_hi(unsigned w) { return __builtin_bit_cast(float, w & 0xffff0000u); }
__device__ __forceinline__ float bf1(bf16_t h) { return __builtin_bit_cast(float, ((unsigned)h) << 16); }
__device__ __forceinline__ float sigmoidf_(float v) { return 1.0f / (1.0f + __expf(-v)); }
__device__ __forceinline__ float siluf_(float v) { return v / (1.0f + __expf(-v)); }
__device__ __forceinline__ float wave_sum(float v) {
#pragma unroll
    for (int o = 1; o < 64; o <<= 1) v += __shfl_xor(v, o);
    return v;
}
__device__ __forceinline__ float wave_max(float v) {
#pragma unroll
    for (int o = 1; o < 64; o <<= 1) v = fmaxf(v, __shfl_xor(v, o));
    return v;
}
__device__ __forceinline__ int lane_id_() { int l; asm volatile("v_mbcnt_lo_u32_b32 %0, -1, 0\n\tv_mbcnt_hi_u32_b32 %0, -1, %0" : "=&v"(l)); return l; }
#define LDS_WAIT() asm volatile("s_waitcnt lgkmcnt(0)" ::: "memory")
#define VM_WAIT() asm volatile("s_waitcnt vmcnt(0)" ::: "memory")

#define XB_TMO      128
#define XB_XCNT(j)  (256  + 64 * (j))
#define XB_XSUB(j)  (1280 + 64 * (j))
#define XB_XGEN(j)  (2304 + 64 * (j))
#define XB_TOP      3328
#define XB_TOPGEN   3392
#define XCD_BAR_WORDS 3456
#define XB_SPIN_CAP (1u << 22)
__device__ __forceinline__ unsigned xb_ld(unsigned* p)              { return __hip_atomic_load(p, __ATOMIC_RELAXED, __HIP_MEMORY_SCOPE_AGENT); }
__device__ __forceinline__ unsigned xb_add(unsigned* p, unsigned v) { return __hip_atomic_fetch_add(p, v, __ATOMIC_RELAXED, __HIP_MEMORY_SCOPE_AGENT); }
__device__ __forceinline__ unsigned xb_xcc_id() { return (unsigned)__builtin_amdgcn_s_getreg((3 << 11) | 20) & 0xFu; }
#define XB_SPIN(cond, bar) do { unsigned _sp = 0; while (cond) { __builtin_amdgcn_s_sleep(1); \
    if ((++_sp & 255u) == 0u) { if (xb_ld(&(bar)[XB_TMO])) break; if (_sp > XB_SPIN_CAP) { atomicAdd(&(bar)[XB_TMO], 1u); break; } } } } while (0)
struct XcdBarrier { unsigned* bar; unsigned x; volatile LAS unsigned* st; int wave; };
__device__ __forceinline__ XcdBarrier xcd_barrier_post(unsigned* bar, volatile LAS unsigned* st, int wave) {
    XcdBarrier b; b.bar = bar; b.x = xb_xcc_id(); b.st = st; b.wave = wave;
    if (wave == 0 && lane_id_() == 0) (void)xb_add(&bar[XB_XCNT(b.x)], 1u);
    return b;
}
__device__ __forceinline__ void xcd_barrier_complete(unsigned* bar, unsigned x, unsigned& nloc, unsigned& nx) {
    const unsigned G = gridDim.x * gridDim.y * gridDim.z;
    unsigned sum, cnt, mine, sp = 0u;
    for (;;) {
        sum = 0u; cnt = 0u; mine = 0u;
#pragma unroll
        for (unsigned j = 0; j < 16; ++j) { const unsigned c = xb_ld(&bar[XB_XCNT(j)]); sum += c; cnt += (c > 0u) ? 1u : 0u; mine = (j == x) ? c : mine; }
        if (sum == G) break;
        __builtin_amdgcn_s_sleep(1);
        if ((++sp & 255u) == 0u) { if (xb_ld(&bar[XB_TMO])) break; if (sp > XB_SPIN_CAP) { atomicAdd(&bar[XB_TMO], 1u); break; } }
    }
    nloc = mine > 0u ? mine : 1u; nx = cnt > 0u ? cnt : 1u;
}
__device__ __forceinline__ void xcd_barrier(const XcdBarrier& b) {
    asm volatile("s_waitcnt vmcnt(0)" ::: "memory");
    __syncthreads();
    if (b.wave == 0 && lane_id_() == 0) {
        unsigned* bar = b.bar;
        __builtin_amdgcn_s_waitcnt(0);
        unsigned nloc = b.st[0], nx = b.st[1];
        if (nloc == 0u) { xcd_barrier_complete(bar, b.x, nloc, nx); b.st[0] = nloc; b.st[1] = nx; }
        const unsigned old = xb_add(&bar[XB_XSUB(b.x)], 1u);
        const unsigned gen = old / nloc;
        if (old + 1u == (gen + 1u) * nloc) {
            __builtin_amdgcn_fence(__ATOMIC_RELEASE, "agent");
            asm volatile("s_waitcnt vmcnt(0)" ::: "memory");
            const unsigned og = xb_add(&bar[XB_TOP], 1u);
            const unsigned tg = og / nx;
            if (og + 1u == (tg + 1u) * nx) xb_add(&bar[XB_TOPGEN], 1u);
            else XB_SPIN(xb_ld(&bar[XB_TOPGEN]) == tg, bar);
            __builtin_amdgcn_fence(__ATOMIC_ACQUIRE, "agent");
            xb_add(&bar[XB_XGEN(b.x)], 1u);
            asm volatile("s_waitcnt vmcnt(0)" ::: "memory");
        } else {
            XB_SPIN(xb_ld(&bar[XB_XGEN(b.x)]) == gen, bar);
            __builtin_amdgcn_fence(__ATOMIC_ACQUIRE, "agent");
            asm volatile("s_waitcnt vmcnt(0)" ::: "memory");
        }
    }
    __syncthreads();
}

namespace pg8 {
constexpr int BM = 256, BK = 64, HALF = 128, HTB = HALF * BK * 2, NXCD = 8, WGM = 8;
__device__ __forceinline__ int lds_byte(int r, int c) { const int st = (r >> 4) * 2 + (c >> 5), rr = r & 15, cc = c & 31, ob = rr * 64 + cc * 2; return st * 1024 + (ob ^ (((ob >> 9) & 1) << 5)); }
__device__ __forceinline__ void stage_rc(int b, int& R, int& C) { const int st = b / 1024, sb = b % 1024, swz = sb ^ (((sb >> 9) & 1) << 5); R = (st >> 1) * 16 + swz / 64; C = (st & 1) * 32 + (swz % 64) / 2; }
__device__ __forceinline__ int perm32(int rho) { const int n = rho >> 4, i = rho & 15; return 8 * (i >> 2) + 4 * n + (i & 3); }

struct GUnit { const char* A; const char* B; int pm, pn, a0, a1; };

__device__ __forceinline__ void tile_order(int L, int nM, int nN, int& pm, int& pn) {
    const int nwg = nM * nN; int wgid = L;
    { const int q = nwg / NXCD, r = nwg % NXCD, xcd = wgid % NXCD, off = wgid / NXCD; wgid = (xcd < r ? xcd * (q + 1) : r * (q + 1) + (xcd - r) * q) + off; }
    const int nig = WGM * nN, gid = wgid / nig, fm = gid * WGM, gsz = (nM - fm) < WGM ? (nM - fm) : WGM;
    pm = fm + ((wgid % nig) % gsz); pn = (wgid % nig) / gsz;
}

typedef f32x4 Acc[2][2][4][2];

template <class P>
__device__ __forceinline__ void gemm_phase(LAS unsigned char* lds, const P& S, int tid) {
    asm volatile("" : "+v"(tid));
    const int wid = __builtin_amdgcn_readfirstlane(tid >> 6), lane = tid & 63, wr = wid >> 2, wc = wid & 3, fr = lane & 15, fq = lane >> 4;
    constexpr int K = P::K, nt = K / BK;
    static_assert(nt >= 4 && (nt % 2) == 0, "K multiple of 128, >= 256");
    unsigned voffB[2];
#pragma unroll
    for (int i = 0; i < 2; ++i) { int R, C; stage_rc(tid * 16 + i * 8192, R, C); const int Rb = (R & ~31) + perm32(R & 31); voffB[i] = (unsigned)(Rb * K + C) * 2u; }
    constexpr size_t kstep = (size_t)(BK * 2);
    constexpr size_t hstepB = (size_t)HALF * K * 2;
    const unsigned ldsw = (unsigned)wid * 1024u;
    const int aoff = lds_byte(wr * 64 + fr, fq * 8), boff = lds_byte(wc * 32 + fr, fq * 8);
#define PG8_SA(b, h) (((b) * 2 + (h)) * HTB)
#define PG8_SB(b, h) ((4 + (b) * 2 + (h)) * HTB)
#define PG8_STAGE(bufoff, gbase, voff) do { _Pragma("unroll") for (int _i = 0; _i < 2; ++_i) \
        __builtin_amdgcn_global_load_lds((const unsigned*)((const char*)(gbase) + (voff)[_i]), (LAS unsigned*)(lds + (bufoff) + ldsw + _i * 8192), 16, 0, 0); } while (0)
#define PG8_LDA(dst, b, h) do { _Pragma("unroll") for (int m = 0; m < 4; ++m) _Pragma("unroll") for (int k = 0; k < 2; ++k) dst[m][k] = *(const LAS bf16x8*)(lds + PG8_SA(b, h) + aoff + m * 2048 + k * 1024); } while (0)
#define PG8_LDB(dst, b, h) do { _Pragma("unroll") for (int n = 0; n < 2; ++n) _Pragma("unroll") for (int k = 0; k < 2; ++k) dst[n][k] = *(const LAS bf16x8*)(lds + PG8_SB(b, h) + boff + n * 2048 + k * 1024); } while (0)
#define PG8_MMA(ai, bj, At, Bt) do { __builtin_amdgcn_s_setprio(1); _Pragma("unroll") for (int m = 0; m < 4; ++m) _Pragma("unroll") for (int n = 0; n < 2; ++n) _Pragma("unroll") for (int k = 0; k < 2; ++k) \
        acc[ai][bj][m][n] = __builtin_amdgcn_mfma_f32_16x16x32_bf16(Bt[n][k], At[m][k], acc[ai][bj][m][n], 0, 0, 0); __builtin_amdgcn_s_setprio(0); } while (0)
#define PG8_WAIT_V(n) asm volatile("s_waitcnt vmcnt(" #n ")" ::: "memory")
#define PG8_WAIT_L(n) asm volatile("s_waitcnt lgkmcnt(" #n ")" ::: "memory")
#define PG8_BAR __builtin_amdgcn_s_barrier()
#define PG8_SCHED __builtin_amdgcn_sched_barrier(0)
#define PG8_VOA(dst, u) do { _Pragma("unroll") for (int _h = 0; _h < 2; ++_h) _Pragma("unroll") for (int _i = 0; _i < 2; ++_i) { int _R, _C; stage_rc(tid * 16 + _i * 8192, _R, _C); \
        if constexpr (P::GATHER) dst[_h][_i] = (S.arow(u, _h * HALF + _R) * (unsigned)K + (unsigned)_C) * 2u; \
        else dst[_h][_i] = (unsigned)((_h * HALF + _R) * K + _C) * 2u; } } while (0)
    GUnit cur, nxt; int ui = 0;
    if (!S.next(0, cur)) return;
    Acc acc;
#pragma unroll
    for (int a = 0; a < 2; ++a)
#pragma unroll
        for (int b = 0; b < 2; ++b)
#pragma unroll
            for (int m = 0; m < 4; ++m)
#pragma unroll
                for (int n = 0; n < 2; ++n) acc[a][b][m][n] = (f32x4){0.f, 0.f, 0.f, 0.f};
    bf16x8 At[4][2], B0[2][2], B1[2][2];
    unsigned voA[2][2], voAn[2][2];
    PG8_VOA(voA, cur);
    const char* cA = cur.A; const char* cB = cur.B;
    PG8_STAGE(PG8_SB(0, 0), cB, voffB); PG8_STAGE(PG8_SB(0, 1), cB + hstepB, voffB); PG8_STAGE(PG8_SA(0, 0), cA, voA[0]); PG8_STAGE(PG8_SA(0, 1), cA, voA[1]);
    if (wr == 1) PG8_BAR;
    PG8_WAIT_V(2); PG8_BAR;
    PG8_STAGE(PG8_SB(1, 0), cB + kstep, voffB); PG8_STAGE(PG8_SA(1, 0), cA + kstep, voA[0]); PG8_STAGE(PG8_SB(1, 1), cB + hstepB + kstep, voffB);
    PG8_WAIT_V(6); PG8_BAR;
    for (;;) {
        const bool has_next = S.next(ui + 1, nxt);
        const char* nA = has_next ? nxt.A : cA; const char* nB = has_next ? nxt.B : cB;
        if constexpr (P::GATHER) {
            if (has_next) { PG8_VOA(voAn, nxt); }
            else {
#pragma unroll
                for (int h = 0; h < 2; ++h)
#pragma unroll
                    for (int i = 0; i < 2; ++i) voAn[h][i] = voA[h][i];
            }
        }
#pragma unroll 1
        for (int t = 0; t < nt; t += 2) {
            const bool last = (t == nt - 2);
            const char* a1 = cA + (size_t)(t + 1) * kstep;
            const char* a2 = last ? nA : cA + (size_t)(t + 2) * kstep; const char* b2 = last ? nB : cB + (size_t)(t + 2) * kstep;
            const char* a3 = a2 + kstep; const char* b3 = b2 + kstep;
            unsigned s0[2], s1[2];
#pragma unroll
            for (int i = 0; i < 2; ++i) {
                if constexpr (P::GATHER) { s0[i] = last ? voAn[0][i] : voA[0][i]; s1[i] = last ? voAn[1][i] : voA[1][i]; }
                else { s0[i] = voA[0][i]; s1[i] = voA[1][i]; }
            }
            PG8_LDB(B0, 0, 0); PG8_LDB(B1, 0, 1); PG8_SCHED; PG8_LDA(At, 0, 0); PG8_STAGE(PG8_SA(1, 1), a1, voA[1]);
            PG8_WAIT_V(8); PG8_WAIT_L(0); PG8_BAR; PG8_MMA(0, 0, At, B0); PG8_MMA(0, 1, At, B1); PG8_BAR; PG8_SCHED;
            PG8_LDA(At, 0, 1); PG8_STAGE(PG8_SB(0, 0), b2, voffB); PG8_STAGE(PG8_SB(0, 1), b2 + hstepB, voffB); PG8_STAGE(PG8_SA(0, 0), a2, s0);
            PG8_WAIT_V(8); PG8_WAIT_L(0); PG8_BAR; PG8_MMA(1, 0, At, B0); PG8_MMA(1, 1, At, B1); PG8_BAR; PG8_SCHED;
            PG8_LDB(B0, 1, 0); PG8_LDB(B1, 1, 1); PG8_SCHED; PG8_LDA(At, 1, 0); PG8_STAGE(PG8_SA(0, 1), a2, s1);
            PG8_WAIT_V(8); PG8_WAIT_L(0); PG8_BAR; PG8_MMA(0, 0, At, B0); PG8_MMA(0, 1, At, B1); PG8_BAR; PG8_SCHED;
            PG8_LDA(At, 1, 1); PG8_STAGE(PG8_SB(1, 0), b3, voffB); PG8_STAGE(PG8_SB(1, 1), b3 + hstepB, voffB); PG8_STAGE(PG8_SA(1, 0), a3, s0);
            PG8_WAIT_V(8); PG8_WAIT_L(0); PG8_BAR; PG8_MMA(1, 0, At, B0); PG8_MMA(1, 1, At, B1); PG8_BAR; PG8_SCHED;
        }
        if (wr == 0) PG8_BAR;
        const bool zero = S.epi(acc, cur, wr, wc, fr, fq);
        if (!has_next) break;
        if (zero) {
#pragma unroll
            for (int a = 0; a < 2; ++a)
#pragma unroll
                for (int b = 0; b < 2; ++b)
#pragma unroll
                    for (int m = 0; m < 4; ++m)
#pragma unroll
                        for (int n = 0; n < 2; ++n) acc[a][b][m][n] = (f32x4){0.f, 0.f, 0.f, 0.f};
        }
        cur = nxt; cA = nA; cB = nB; ++ui;
        if constexpr (P::GATHER) {
#pragma unroll
            for (int h = 0; h < 2; ++h)
#pragma unroll
                for (int i = 0; i < 2; ++i) voA[h][i] = voAn[h][i];
        }
        if (wr == 1) PG8_BAR;
    }
    PG8_WAIT_V(0);
    PG8_BAR;
#undef PG8_SA
#undef PG8_SB
#undef PG8_STAGE
#undef PG8_LDA
#undef PG8_LDB
#undef PG8_MMA
#undef PG8_WAIT_V
#undef PG8_WAIT_L
#undef PG8_BAR
#undef PG8_SCHED
#undef PG8_VOA
}
}
using pg8::GUnit; using pg8::Acc;

__device__ __forceinline__ float row_rs(const float* SS, int row) {
    const f32x4* p = (const f32x4*)(SS + (size_t)row * 16);
    const f32x4 a = p[0], b = p[1], c = p[2], d = p[3];
    const float s = (((a.x + a.y) + (a.z + a.w)) + ((b.x + b.y) + (b.z + b.w))) + (((c.x + c.y) + (c.z + c.w)) + ((d.x + d.y) + (d.z + d.w)));
    return rsqrtf(s * (1.0f / 1024.0f) + EPS);
}
#define PIN1(a) asm volatile("" : "+v"(a))
#define PIN2(a, b) asm volatile("" : "+v"(a), "+v"(b))
#define PIN4(a, b, c, d) asm volatile("" : "+v"(a), "+v"(b), "+v"(c), "+v"(d))
#define PIN8(a, b, c, d, e, f, g, h) asm volatile("" : "+v"(a), "+v"(b), "+v"(c), "+v"(d), "+v"(e), "+v"(f), "+v"(g), "+v"(h))
__device__ __forceinline__ void row_rs8(const float* SS, int row0, float (&rs)[8]) {
#pragma unroll
    for (int hh = 0; hh < 4; ++hh) { f32x4 a[2], b[2], c[2], d[2];
#pragma unroll
        for (int g = 0; g < 2; ++g) { const f32x4* p = (const f32x4*)(SS + (size_t)(row0 + (hh >> 1) * 128 + ((hh & 1) * 2 + g) * 16) * 16); a[g] = p[0]; b[g] = p[1]; c[g] = p[2]; d[g] = p[3]; }
#pragma unroll
        for (int g = 0; g < 2; ++g) { const f32x4 t = (a[g] + b[g]) + (c[g] + d[g]); rs[hh * 2 + g] = rsqrtf(((t.x + t.y) + (t.z + t.w)) * (1.0f / 1024.0f) + EPS); }
        PIN2(rs[hh * 2], rs[hh * 2 + 1]); }
}
__device__ __forceinline__ u32x4 pack8(const f32x4 v0, const f32x4 v1) { u32x4 w; w.x = cvt_pk_bf16(v0[0], v0[1]); w.y = cvt_pk_bf16(v0[2], v0[3]); w.z = cvt_pk_bf16(v1[0], v1[1]); w.w = cvt_pk_bf16(v1[2], v1[3]); return w; }
__device__ __forceinline__ void unpack8(const u32x4 w, f32x4& v0, f32x4& v1) { v0 = (f32x4){bf_lo(w.x), bf_hi(w.x), bf_lo(w.y), bf_hi(w.y)}; v1 = (f32x4){bf_lo(w.z), bf_hi(w.z), bf_lo(w.w), bf_hi(w.w)}; }
__device__ __forceinline__ f32x4 sig4(const f32x4 v) { return (f32x4){sigmoidf_(v[0]), sigmoidf_(v[1]), sigmoidf_(v[2]), sigmoidf_(v[3])}; }
__device__ __forceinline__ f32x4 gate4(const f32x4 v) { f32x4 s = sig4(v); return (f32x4){fmaxf(s[0], 1e-6f), fmaxf(s[1], 1e-6f), fmaxf(s[2], 1e-6f), fmaxf(s[3], 1e-6f)}; }

struct PhProj {
    static constexpr int K = 1024; static constexpr bool GATHER = false;
    const char* xb; const char* W; const float* SS; unsigned char* ws; int G, c;
    __device__ __forceinline__ bool next(int i, GUnit& u) const {
        const long L = (long)i * G + c; if (L >= 128 * 23) return false;
        pg8::tile_order((int)L, 128, 23, u.pm, u.pn);
        u.A = xb + (size_t)u.pm * 256 * K * 2; u.B = W + (size_t)u.pn * 256 * K * 2; u.a0 = 0; u.a1 = 0; return true;
    }
    __device__ __forceinline__ unsigned arow(const GUnit&, int) const { return 0u; }
    __device__ __forceinline__ bool epi(Acc& acc, const GUnit& u, int wr, int wc, int fr, int fq) const {
        const int pn = u.pn; const int row0 = u.pm * 256 + wr * 64 + fr;
        float rs8[8]; row_rs8(SS, row0, rs8);
        if (pn == 22) {
            if (wc == 0 && fq == 0) {
                float* IFp = (float*)(ws + WS_IF);
#pragma unroll
                for (int ai = 0; ai < 2; ++ai)
#pragma unroll
                    for (int m = 0; m < 4; ++m) { const int row = row0 + ai * 128 + m * 16; const float rs = rs8[ai * 4 + m];
                        *(f32x4*)(IFp + (size_t)row * 8) = acc[ai][0][m][0] * rs; *(f32x4*)(IFp + (size_t)row * 8 + 4) = acc[ai][0][m][1] * rs; }
            }
            return true;
        }
        if (pn >= 10 && pn < 14) {
            bf16_t* Y = (bf16_t*)(ws + WS_YG);
#pragma unroll
            for (int ai = 0; ai < 2; ++ai)
#pragma unroll
                for (int m = 0; m < 4; ++m) { const int row = row0 + ai * 128 + m * 16; const float rs = rs8[ai * 4 + m];
#pragma unroll
                    for (int bj = 0; bj < 2; ++bj) { const f32x4 a = acc[ai][bj][m][0] * rs, g = sig4(acc[ai][bj][m][1] * rs), y = a * g;
                        u32x2 w; w.x = cvt_pk_bf16(y[0], y[1]); w.y = cvt_pk_bf16(y[2], y[3]);
                        *(u32x2*)(Y + (size_t)row * 512 + (pn - 10) * 128 + bj * 64 + wc * 16 + fq * 4) = w; } }
            return true;
        }
        bf16_t* dst; int col0; bool sg = false;
        if (pn < 6) { dst = (bf16_t*)(ws + (pn < 2 ? WS_QA0 : (pn < 4 ? WS_QA1 : WS_QA2))); col0 = (pn & 1) * 256; }
        else if (pn < 8) { dst = (bf16_t*)(ws + WS_KA); col0 = (pn - 6) * 256; }
        else if (pn < 10) { dst = (bf16_t*)(ws + WS_VA); col0 = (pn - 8) * 256; }
        else if (pn < 16) { dst = (bf16_t*)(ws + WS_QM); col0 = (pn - 14) * 256; }
        else if (pn < 18) { dst = (bf16_t*)(ws + WS_KM); col0 = (pn - 16) * 256; }
        else if (pn < 20) { dst = (bf16_t*)(ws + WS_VM); col0 = (pn - 18) * 256; }
        else { dst = (bf16_t*)(ws + WS_OM); col0 = (pn - 20) * 256; sg = true; }
        col0 += wc * 32 + fq * 8;
#pragma unroll
        for (int ai = 0; ai < 2; ++ai)
#pragma unroll
            for (int m = 0; m < 4; ++m) { const int row = row0 + ai * 128 + m * 16; const float rs = rs8[ai * 4 + m];
#pragma unroll
                for (int bj = 0; bj < 2; ++bj) { f32x4 v0 = acc[ai][bj][m][0] * rs, v1 = acc[ai][bj][m][1] * rs;
                    if (sg) { v0 = sig4(v0); v1 = sig4(v1); }
                    *(u32x4*)(dst + (size_t)row * 512 + col0 + bj * 128) = pack8(v0, v1); } }
        return true;
    }
};
struct PhGates {
    static constexpr int K = 1024; static constexpr bool GATHER = false;
    const char* xb; const char* W; const float* SS; unsigned char* ws; int G, c;
    __device__ __forceinline__ bool next(int i, GUnit& u) const {
        const long L = (long)i * G + c; if (L >= 128 * 12) return false;
        pg8::tile_order((int)L, 128, 12, u.pm, u.pn);
        u.A = xb + (size_t)u.pm * 256 * K * 2; u.B = W + (size_t)(5888 + u.pn * 256) * K * 2; u.a0 = 0; u.a1 = 0; return true;
    }
    __device__ __forceinline__ unsigned arow(const GUnit&, int) const { return 0u; }
    __device__ __forceinline__ bool epi(Acc& acc, const GUnit& u, int wr, int wc, int fr, int fq) const {
        const int row0 = u.pm * 256 + wr * 64 + fr;
        float rs8[8]; row_rs8(SS, row0, rs8);
        bf16_t* dst = (bf16_t*)(ws + WS_G0 + (size_t)(u.pn >> 2) * 64 * MiB); const int col0 = (u.pn & 3) * 256 + wc * 32 + fq * 8;
#pragma unroll
        for (int ai = 0; ai < 2; ++ai)
#pragma unroll
            for (int m = 0; m < 4; ++m) { const int row = row0 + ai * 128 + m * 16; const float rs = rs8[ai * 4 + m];
#pragma unroll
                for (int bj = 0; bj < 2; ++bj) *(u32x4*)(dst + (size_t)row * 1024 + col0 + bj * 128) = pack8(gate4(acc[ai][bj][m][0] * rs), gate4(acc[ai][bj][m][1] * rs)); }
        return true;
    }
};
struct PhMerge {
    static constexpr int K = 512; static constexpr bool GATHER = false;
    unsigned char* ws; int G, c;
    __device__ __forceinline__ bool next(int i, GUnit& u) const {
        const int ti = i / 3, seg = i - ti * 3; const long L = (long)ti * G + c; if (L >= 128 * 4) return false;
        pg8::tile_order((int)L, 128, 4, u.pm, u.pn);
        const size_t ya = seg == 0 ? WS_YATT : (seg == 1 ? WS_YC : WS_OM);
        u.A = (const char*)ws + ya + (size_t)u.pm * 256 * K * 2; u.B = (const char*)ws + WS_WBR + (size_t)seg * 1024 * 512 * 2 + (size_t)u.pn * 256 * K * 2; u.a0 = seg; u.a1 = 0; return true;
    }
    __device__ __forceinline__ unsigned arow(const GUnit&, int) const { return 0u; }
    __device__ __forceinline__ bool epi(Acc& acc, const GUnit& u, int wr, int wc, int fr, int fq) const {
        const int seg = u.a0; const int row0 = u.pm * 256 + wr * 64 + fr; const int col0 = u.pn * 256 + wc * 32 + fq * 8;
        const bf16_t* Gn = (const bf16_t*)(ws + WS_G0 + (size_t)seg * 64 * MiB);
        const bf16_t* Gd = (const bf16_t*)(ws + WS_G0 + (size_t)(seg < 2 ? seg + 1 : seg) * 64 * MiB);
        bf16_t* Mo = (bf16_t*)(ws + WS_MERGED);
#pragma unroll
        for (int ai = 0; ai < 2; ++ai)
#pragma unroll
            for (int mp = 0; mp < 2; ++mp) {
                u32x4 gn[2][2], gd[2][2];
#pragma unroll
                for (int mm = 0; mm < 2; ++mm)
#pragma unroll
                    for (int bj = 0; bj < 2; ++bj) { const size_t off = (size_t)(row0 + ai * 128 + (2 * mp + mm) * 16) * 1024 + col0 + bj * 128; gn[mm][bj] = *(const u32x4*)(Gn + off); gd[mm][bj] = *(const u32x4*)(Gd + off); }
                PIN8(gn[0][0], gn[0][1], gn[1][0], gn[1][1], gd[0][0], gd[0][1], gd[1][0], gd[1][1]);
#pragma unroll
                for (int mm = 0; mm < 2; ++mm)
#pragma unroll
                    for (int bj = 0; bj < 2; ++bj) { const int m = 2 * mp + mm; const size_t off = (size_t)(row0 + ai * 128 + m * 16) * 1024 + col0 + bj * 128;
                        f32x4 n0, n1, d0, d1; unpack8(gn[mm][bj], n0, n1); unpack8(gd[mm][bj], d0, d1);
                        if (seg < 2) {
#pragma unroll
                            for (int j = 0; j < 4; ++j) { acc[ai][bj][m][0][j] *= n0[j] * __builtin_amdgcn_rcpf(d0[j]); acc[ai][bj][m][1][j] *= n1[j] * __builtin_amdgcn_rcpf(d1[j]); } }
                        else *(u32x4*)(Mo + off) = pack8(acc[ai][bj][m][0] * n0, acc[ai][bj][m][1] * n1); }
            }
        return seg == 2;
    }
};
__device__ __forceinline__ float store_x8(bf16_t* xbp, const f32x4 v0, const f32x4 v1) {
    *(u32x4*)xbp = pack8(v0, v1);
    return ((v0[0] * v0[0] + v0[1] * v0[1]) + (v0[2] * v0[2] + v0[3] * v0[3])) + ((v1[0] * v1[0] + v1[1] * v1[1]) + (v1[2] * v1[2] + v1[3] * v1[3]));
}
struct PhOut {
    static constexpr int K = 1024; static constexpr bool GATHER = false;
    unsigned char* ws; float* SSo; int G, c;
    __device__ __forceinline__ bool next(int i, GUnit& u) const {
        const long L = (long)i * G + c; if (L >= 128 * 4) return false;
        pg8::tile_order((int)L, 128, 4, u.pm, u.pn);
        u.A = (const char*)ws + WS_MERGED + (size_t)u.pm * 256 * K * 2; u.B = (const char*)ws + WS_WOUT + (size_t)u.pn * 256 * K * 2; u.a0 = 0; u.a1 = 0; return true;
    }
    __device__ __forceinline__ unsigned arow(const GUnit&, int) const { return 0u; }
    __device__ __forceinline__ bool epi(Acc& acc, const GUnit& u, int wr, int wc, int fr, int fq) const {
        const int row0 = u.pm * 256 + wr * 64 + fr; const int col0 = u.pn * 256 + wc * 32 + fq * 8; bf16_t* XB = (bf16_t*)(ws + WS_XB);
#pragma unroll
        for (int ai = 0; ai < 2; ++ai) {
            u32x4 xr[4][2];
#pragma unroll
            for (int m = 0; m < 4; ++m)
#pragma unroll
                for (int bj = 0; bj < 2; ++bj) xr[m][bj] = *(const u32x4*)(XB + (size_t)(row0 + ai * 128 + m * 16) * 1024 + col0 + bj * 128);
            PIN8(xr[0][0], xr[0][1], xr[1][0], xr[1][1], xr[2][0], xr[2][1], xr[3][0], xr[3][1]);
#pragma unroll
            for (int m = 0; m < 4; ++m) { const int row = row0 + ai * 128 + m * 16; const size_t off = (size_t)row * 1024 + col0; float ss = 0.f;
#pragma unroll
                for (int bj = 0; bj < 2; ++bj) { f32x4 x0, x1; unpack8(xr[m][bj], x0, x1); ss += store_x8(XB + off + bj * 128, x0 + acc[ai][bj][m][0], x1 + acc[ai][bj][m][1]); }
                ss += __shfl_xor(ss, 16); ss += __shfl_xor(ss, 32);
                if (fq == 0) SSo[(size_t)row * 16 + u.pn * 4 + wc] = ss; } }
        return true;
    }
};
struct PhRouter {
    static constexpr int K = 1024; static constexpr bool GATHER = false;
    unsigned char* ws; const float* SS; int G, c;
    __device__ __forceinline__ bool next(int i, GUnit& u) const {
        const long L = (long)i * G + c; if (L >= 128) return false;
        u.pm = (int)L; u.pn = 0; u.A = (const char*)ws + WS_XB + (size_t)u.pm * 256 * K * 2; u.B = (const char*)ws + WS_WR; u.a0 = 0; u.a1 = 0; return true;
    }
    __device__ __forceinline__ unsigned arow(const GUnit&, int) const { return 0u; }
    __device__ __forceinline__ bool epi(Acc& acc, const GUnit& u, int wr, int wc, int fr, int fq) const {
        if (wc < 2) { float* Lg = (float*)(ws + WS_LOGITS); const int row0 = u.pm * 256 + wr * 64 + fr;
            float rs8[8]; row_rs8(SS, row0, rs8);
#pragma unroll
            for (int ai = 0; ai < 2; ++ai)
#pragma unroll
                for (int m = 0; m < 4; ++m) { const int row = row0 + ai * 128 + m * 16; const float rs = rs8[ai * 4 + m]; float* p = Lg + (size_t)row * 64 + wc * 32 + fq * 8;
                    *(f32x4*)p = acc[ai][0][m][0] * rs; *(f32x4*)(p + 4) = acc[ai][0][m][1] * rs; } }
        return true;
    }
};
__device__ __forceinline__ int moe_expert_of(const int* META, int k, int rb) {
    const int r = rb * 256; int e = 0;
    for (int j = 1; j < 32; ++j) e += (META[16 + 64 * k + j] <= r) ? 1 : 0;
    return __builtin_amdgcn_readfirstlane(e);
}
struct PhUp {
    static constexpr int K = 1024; static constexpr bool GATHER = true;
    unsigned char* ws; const float* SS; const int* META; const int* tok; int G, c;
    __device__ __forceinline__ bool next(int i, GUnit& u) const {
        const int nb0 = __builtin_amdgcn_readfirstlane(META[0]), nb1 = __builtin_amdgcn_readfirstlane(META[1]); const long L = (long)i * G + c; if (L >= 2L * (nb0 + nb1)) return false;
        int blk = (int)(L >> 1); u.pn = (int)(L & 1); int k = 0; if (blk >= nb0) { k = 1; blk -= nb0; }
        const int e = moe_expert_of(META, k, blk);
        u.pm = blk; u.a0 = k; u.a1 = e; u.A = (const char*)ws + WS_XB; u.B = (const char*)ws + WS_WEXP + (size_t)e * 512 * 1024 * 2 + (size_t)u.pn * 256 * K * 2; return true;
    }
    __device__ __forceinline__ unsigned arow(const GUnit& u, int r) const { const int t = tok[u.a0 * LISTCAP + u.pm * 256 + r]; return t < 0 ? 0u : (unsigned)t; }
    __device__ __forceinline__ bool epi(Acc& acc, const GUnit& u, int wr, int wc, int fr, int fq) const {
        const int lr0 = u.a0 * LISTCAP + u.pm * 256 + wr * 64 + fr; bf16_t* HB = (bf16_t*)(ws + WS_HB);
        int tk[8]; float rs8[8];
#pragma unroll
        for (int g = 0; g < 8; ++g) tk[g] = tok[lr0 + (g >> 2) * 128 + (g & 3) * 16];
        PIN8(tk[0], tk[1], tk[2], tk[3], tk[4], tk[5], tk[6], tk[7]);
#pragma unroll
        for (int hh = 0; hh < 4; ++hh) { f32x4 a[2], b[2], c[2], d[2];
#pragma unroll
            for (int g = 0; g < 2; ++g) { const int t = tk[hh * 2 + g]; const f32x4* p = (const f32x4*)(SS + (size_t)(t < 0 ? 0 : t) * 16); a[g] = p[0]; b[g] = p[1]; c[g] = p[2]; d[g] = p[3]; }
#pragma unroll
            for (int g = 0; g < 2; ++g) { const f32x4 tt = (a[g] + b[g]) + (c[g] + d[g]); rs8[hh * 2 + g] = tk[hh * 2 + g] < 0 ? 0.f : rsqrtf(((tt.x + tt.y) + (tt.z + tt.w)) * (1.0f / 1024.0f) + EPS); }
            PIN2(rs8[hh * 2], rs8[hh * 2 + 1]); }
#pragma unroll
        for (int ai = 0; ai < 2; ++ai)
#pragma unroll
            for (int m = 0; m < 4; ++m) { const int lr = lr0 + ai * 128 + m * 16; const float rs = rs8[ai * 4 + m];
#pragma unroll
                for (int bj = 0; bj < 2; ++bj) { const f32x4 g = acc[ai][bj][m][0] * rs, uu = acc[ai][bj][m][1] * rs;
                    f32x4 h = (f32x4){siluf_(g[0]) * uu[0], siluf_(g[1]) * uu[1], siluf_(g[2]) * uu[2], siluf_(g[3]) * uu[3]}; if (ABL == 8) h = (f32x4){1.f, 1.f, 1.f, 1.f};
                    u32x2 w; w.x = cvt_pk_bf16(h[0], h[1]); w.y = cvt_pk_bf16(h[2], h[3]);
                    *(u32x2*)(HB + (size_t)lr * 256 + u.pn * 128 + bj * 64 + wc * 16 + fq * 4) = w; }
                asm volatile("" ::: "memory"); }
        return true;
    }
};
template <int KL> struct PhDown {
    static constexpr int K = 256; static constexpr bool GATHER = false;
    unsigned char* ws; float* SSo; const int* META; const int* tok; const float* wl; int G, c;
    __device__ __forceinline__ bool next(int i, GUnit& u) const {
        const int nb = __builtin_amdgcn_readfirstlane(META[KL]); const long L = (long)i * G + c;
        if (L < 4L * nb) { const int blk = (int)(L >> 2); u.pn = (int)(L & 3); const int e = moe_expert_of(META, KL, blk); u.pm = blk; u.a0 = 0; u.a1 = e;
            u.A = (const char*)ws + WS_HB + (size_t)(KL * LISTCAP + blk * 256) * 256 * 2; u.B = (const char*)ws + WS_WEXP + 32ull * 512 * 1024 * 2 + (size_t)e * 1024 * 256 * 2 + (size_t)u.pn * 256 * K * 2; return true; }
        if (KL == 1) { const long L2 = L - 4L * nb; if (L2 >= 128 * 4) return false;
            pg8::tile_order((int)L2, 128, 4, u.pm, u.pn); u.a0 = 1; u.a1 = 0;
            u.A = (const char*)ws + WS_PBF + (size_t)u.pm * 256 * K * 2; u.B = (const char*)ws + WS_WPP + (size_t)u.pn * 256 * K * 2; return true; }
        return false;
    }
    __device__ __forceinline__ unsigned arow(const GUnit&, int) const { return 0u; }
    __device__ __forceinline__ bool epi(Acc& acc, const GUnit& u, int wr, int wc, int fr, int fq) const {
        const int col0 = u.pn * 256 + wc * 32 + fq * 8;
        if (KL == 1 && u.a0 == 1) {
            bf16_t* PE = (bf16_t*)(ws + WS_PE); const int row0 = u.pm * 256 + wr * 64 + fr;
#pragma unroll
            for (int ai = 0; ai < 2; ++ai)
#pragma unroll
                for (int m = 0; m < 4; ++m)
#pragma unroll
                    for (int bj = 0; bj < 2; ++bj) *(u32x4*)(PE + (size_t)(row0 + ai * 128 + m * 16) * 1024 + col0 + bj * 128) = pack8(acc[ai][bj][m][0], acc[ai][bj][m][1]);
            return true;
        }
        const int lr0 = KL * LISTCAP + u.pm * 256 + wr * 64 + fr; bf16_t* YB = (bf16_t*)(ws + WS_YB1); bf16_t* XB = (bf16_t*)(ws + WS_XB);
        int tk[8]; float wk[8];
#pragma unroll
        for (int g = 0; g < 8; ++g) { const int lr = lr0 + (g >> 2) * 128 + (g & 3) * 16; tk[g] = tok[lr]; wk[g] = wl[lr]; }
        PIN8(tk[0], tk[1], tk[2], tk[3], tk[4], tk[5], tk[6], tk[7]); PIN8(wk[0], wk[1], wk[2], wk[3], wk[4], wk[5], wk[6], wk[7]);
#pragma unroll
        for (int ai = 0; ai < 2; ++ai)
#pragma unroll
            for (int m = 0; m < 4; ++m) { const int t = tk[ai * 4 + m]; const float w = wk[ai * 4 + m]; const size_t off = (size_t)(t < 0 ? 0 : t) * 1024 + col0;
                if (KL == 1) { if (t >= 0) {
#pragma unroll
                        for (int bj = 0; bj < 2; ++bj) *(u32x4*)(YB + off + bj * 128) = pack8(acc[ai][bj][m][0] * w, acc[ai][bj][m][1] * w); } }
                else { float ss = 0.f;
                    if (t >= 0) {
                        u32x4 xr[2], yr[2];
#pragma unroll
                        for (int bj = 0; bj < 2; ++bj) { xr[bj] = *(const u32x4*)(XB + off + bj * 128); yr[bj] = *(const u32x4*)(YB + off + bj * 128); }
                        PIN4(xr[0], xr[1], yr[0], yr[1]);
#pragma unroll
                        for (int bj = 0; bj < 2; ++bj) { f32x4 x0, x1, y0, y1; unpack8(xr[bj], x0, x1); unpack8(yr[bj], y0, y1);
                            ss += store_x8(XB + off + bj * 128, (x0 + y0) + acc[ai][bj][m][0] * w, (x1 + y1) + acc[ai][bj][m][1] * w); } }
                    ss += __shfl_xor(ss, 16); ss += __shfl_xor(ss, 32);
                    if (fq == 0 && t >= 0) SSo[(size_t)t * 16 + u.pn * 4 + wc] = ss; }
                if (m & 1) asm volatile("" ::: "memory"); }
        return true;
    }
};
struct PhPle {
    static constexpr int K = 1024; static constexpr bool GATHER = false;
    unsigned char* ws; const float* SSi; float* SSo; int G, c;
    __device__ __forceinline__ bool next(int i, GUnit& u) const {
        const long L = (long)i * G + c; if (L >= 128 * 4) return false;
        pg8::tile_order((int)L, 128, 4, u.pm, u.pn);
        u.A = (const char*)ws + WS_XB + (size_t)u.pm * 256 * K * 2; u.B = (const char*)ws + WS_WPG + (size_t)u.pn * 256 * K * 2; u.a0 = 0; u.a1 = 0; return true;
    }
    __device__ __forceinline__ unsigned arow(const GUnit&, int) const { return 0u; }
    __device__ __forceinline__ bool epi(Acc& acc, const GUnit& u, int wr, int wc, int fr, int fq) const {
        const int row0 = u.pm * 256 + wr * 64 + fr; const int col0 = u.pn * 256 + wc * 32 + fq * 8; bf16_t* XT = (bf16_t*)(ws + WS_XBT); const bf16_t* PE = (const bf16_t*)(ws + WS_PE); const bf16_t* XBc = (const bf16_t*)(ws + WS_XB);
        float rs8[8]; row_rs8(SSi, row0, rs8);
#pragma unroll
        for (int ai = 0; ai < 2; ++ai)
#pragma unroll
            for (int m = 0; m < 4; ++m) { const int row = row0 + ai * 128 + m * 16; const size_t off = (size_t)row * 1024 + col0; const float rs = rs8[ai * 4 + m]; float ss = 0.f;
                u32x4 xr[2], pr[2];
#pragma unroll
                for (int bj = 0; bj < 2; ++bj) { xr[bj] = *(const u32x4*)(XBc + off + bj * 128); pr[bj] = *(const u32x4*)(PE + off + bj * 128); }
                PIN4(xr[0], xr[1], pr[0], pr[1]);
#pragma unroll
                for (int bj = 0; bj < 2; ++bj) { f32x4 p0, p1, x0, x1; unpack8(pr[bj], p0, p1); unpack8(xr[bj], x0, x1);
                    ss += store_x8(XT + off + bj * 128, x0 + sig4(acc[ai][bj][m][0] * rs) * p0, x1 + sig4(acc[ai][bj][m][1] * rs) * p1); }
                ss += __shfl_xor(ss, 16); ss += __shfl_xor(ss, 32);
                if (fq == 0) SSo[(size_t)row * 16 + u.pn * 4 + wc] = ss; }
        return true;
    }
};

struct InPtrs { const float* const* p; __device__ __forceinline__ const float* operator[](int i) const { return (const float*)(GAS const float*)p[i]; } };
struct Ctx {
    InPtrs in; float* out; unsigned char* ws; LAS unsigned char* lds;
    int tid, lane, wave, G, bid;
};
enum { I_X = 0, I_P, I_GMIX, I_WIN, I_CONVW, I_CONVB, I_CLNG, I_CLNB, I_MCW, I_MCB, I_MIB, I_MFB, I_WBA, I_WBC, I_WBM, I_WOUT, I_GFFN, I_WRG, I_BRG, I_WRE, I_BRE,
       I_WEG, I_WEU, I_WED, I_GPLE, I_WPG, I_WPP, I_GFIN };

constexpr int TR_LDS = 64 * 65 * 4;
template <bool GAIN>
__device__ __forceinline__ void tr_item64(const float* colptr4, size_t pitch, const float* gainp, float cscale, bf16_t* dst, int K, int n0, int k0, LAS float* scr, int lane, const float* gain_or_valid) {
    const float* gain = GAIN ? gainp : nullptr;
    const int g = lane & 15, r = lane >> 4;
    f32x4 v[16]; float gs[16];
    const float* cp = colptr4 ? colptr4 : gain_or_valid;
#pragma unroll
    for (int i = 0; i < 16; ++i) { const int kk = 4 * i + r; v[i] = *(const f32x4*)(cp + (colptr4 ? (size_t)(k0 + kk) * pitch : 0)); gs[i] = gain ? gain[k0 + kk] : 1.0f; }
    PIN8(v[0], v[1], v[2], v[3], v[4], v[5], v[6], v[7]); PIN8(v[8], v[9], v[10], v[11], v[12], v[13], v[14], v[15]);
    const float zs = colptr4 ? cscale : 0.f;
#pragma unroll
    for (int i = 0; i < 16; ++i) { const int kk = 4 * i + r; const float m = gs[i] * zs; LAS float* p = scr + kk * 65 + 4 * g; p[0] = v[i].x * m; p[1] = v[i].y * m; p[2] = v[i].z * m; p[3] = v[i].w * m; }
    LDS_WAIT(); asm volatile("" ::: "memory");
    const int c = lane & 7, n8 = lane >> 3;
#pragma unroll
    for (int j = 0; j < 8; ++j) { const int n = n8 + 8 * j; const LAS float* sp = scr + (8 * c) * 65 + n;
        u32x4 o; o.x = pk2(sp[0 * 65], sp[1 * 65]); o.y = pk2(sp[2 * 65], sp[3 * 65]); o.z = pk2(sp[4 * 65], sp[5 * 65]); o.w = pk2(sp[6 * 65], sp[7 * 65]);
        *(u32x4*)(dst + (size_t)(n0 + n) * K + k0 + 8 * c) = o; }
    LDS_WAIT(); asm volatile("" ::: "memory");
}
__device__ __forceinline__ void phase_prep(const Ctx& F, int layer, float* SS) {
    const int gw = F.bid * NWAVES + F.wave, NGW = F.G * NWAVES, lane = F.lane;
    LAS float* scr = (LAS float*)(F.lds + F.wave * TR_LDS);
    bf16_t* XB = (bf16_t*)(F.ws + WS_XB);
    if (layer == 0) {
        for (int m = gw; m < T; m += NGW) {
            const f32x4* xr = (const f32x4*)(F.in[I_X] + (size_t)m * D) + lane; u32x2* xbr = (u32x2*)(XB + (size_t)m * D) + lane;
            float sq = 0.f;
#pragma unroll
            for (int j = 0; j < 4; ++j) { const f32x4 v = xr[64 * j]; sq += (v.x * v.x + v.y * v.y) + (v.z * v.z + v.w * v.w);
                u32x2 w; w.x = cvt_pk_bf16(v.x, v.y); w.y = cvt_pk_bf16(v.z, v.w); xbr[64 * j] = w; }
            sq = wave_sum(sq);
            if (lane < 16) SS[(size_t)m * 16 + lane] = lane == 0 ? sq : 0.f;
        }
    } else {
        const u32x4* src = (const u32x4*)(F.ws + WS_XBT); u32x4* dst = (u32x4*)(F.ws + WS_XB);
        for (size_t i = (size_t)F.bid * NTHREADS + F.tid; i < (size_t)T * D * 2 / 16; i += (size_t)F.G * NTHREADS) dst[i] = src[i];
    }
    const float* w_in = F.in[I_WIN] + (size_t)layer * D * D_IN; const float* g_mix = F.in[I_GMIX] + (size_t)layer * D;
    constexpr int N_WIN = 140 * 16, N_BR = 16 * 8, N_SQ = 16 * 16, N_PP = 16 * 4, N_R = 4 * 16;
    constexpr int NITEMS = N_WIN + 3 * N_BR + 2 * N_SQ + N_PP + N_R;
    const int g4 = 4 * (lane & 15);
    for (int it = gw; it < NITEMS; it += NGW) {
        int r = it;
        if (r < N_WIN) { const int nb = r >> 4, kb = r & 15; const int n = nb * 64 + g4; int src = -1; float cs = 1.f;
            if (n < 2560) { src = n; if (n < 1536) cs = 0.125f; }
            else if (n < 3584) { const int np = n - 2560, q8 = np >> 3, sg = (np >> 2) & 1; src = 2560 + sg * 512 + 4 * q8; }
            else if (n < 5640) src = n;
            else if (n < 5888) src = -1;
            else src = 5640 + (n - 5888);
            tr_item64<true>(src >= 0 ? w_in + src : nullptr, D_IN, g_mix, cs, (bf16_t*)(F.ws + WS_WIN), 1024, nb * 64, kb * 64, scr, lane, g_mix); continue; }
        r -= N_WIN;
        if (r < 3 * N_BR) { const int b = r / N_BR; r -= b * N_BR; const int nb = r >> 3, kb = r & 7; const int n = nb * 64 + g4;
            const float* w = (b == 0 ? F.in[I_WBA] : (b == 1 ? F.in[I_WBC] : F.in[I_WBM])) + (size_t)layer * 512 * 1024;
            tr_item64<false>(w + n, 1024, nullptr, 1.f, (bf16_t*)(F.ws + WS_WBR) + (size_t)b * 1024 * 512, 512, nb * 64, kb * 64, scr, lane, g_mix); continue; }
        r -= 3 * N_BR;
        if (r < 2 * N_SQ) { const int b = r / N_SQ; r -= b * N_SQ; const int nb = r >> 4, kb = r & 15; const int n = nb * 64 + g4;
            const float* w = (b == 0 ? F.in[I_WOUT] : F.in[I_WPG]) + (size_t)layer * 1024 * 1024;
            if (b == 0) tr_item64<false>(w + n, 1024, nullptr, 1.f, (bf16_t*)(F.ws + WS_WOUT), 1024, nb * 64, kb * 64, scr, lane, g_mix);
            else tr_item64<true>(w + n, 1024, F.in[I_GPLE] + (size_t)layer * D, 1.f, (bf16_t*)(F.ws + WS_WPG), 1024, nb * 64, kb * 64, scr, lane, g_mix);
            continue; }
        r -= 2 * N_SQ;
        if (r < N_PP) { const int nb = r >> 2, kb = r & 3; const int n = nb * 64 + g4;
            tr_item64<false>(F.in[I_WPP] + (size_t)layer * 256 * 1024 + n, 1024, nullptr, 1.f, (bf16_t*)(F.ws + WS_WPP), 256, nb * 64, kb * 64, scr, lane, g_mix); continue; }
        r -= N_PP;
        { const int nb = r >> 4, kb = r & 15; const int n = nb * 64 + g4; const float* cp = nullptr; size_t pitch = 4;
            if (n < 4) { cp = F.in[I_WRG] + (size_t)layer * 1024 * 4 + n; pitch = 4; } else if (n < 36) { cp = F.in[I_WRE] + (size_t)layer * 1024 * 32 + (n - 4); pitch = 32; }
            tr_item64<true>(cp, pitch, F.in[I_GFFN] + (size_t)layer * D, 1.f, (bf16_t*)(F.ws + WS_WR), 1024, nb * 64, kb * 64, scr, lane, g_mix); }
    }
}
__device__ __forceinline__ void phase_prep_experts(const Ctx& F, int layer) {
    const int gw = F.bid * NWAVES + F.wave, NGW = F.G * NWAVES, lane = F.lane;
    LAS float* scr = (LAS float*)(F.lds + F.wave * TR_LDS);
    const float* g_ffn = F.in[I_GFFN] + (size_t)layer * D;
    constexpr int N_UP = 32 * 8 * 16, N_DN = 32 * 16 * 4;
    const int g4 = 4 * (lane & 15);
    for (int it = gw; it < N_UP + N_DN; it += NGW) {
        int r = it;
        if (r < N_UP) { const int e = r >> 7; r &= 127; const int nb = r >> 4, kb = r & 15; const int n = nb * 64 + g4; const int q8 = n >> 3, sg = (n >> 2) & 1;
            const float* w = (sg ? F.in[I_WEU] : F.in[I_WEG]) + ((size_t)layer * 32 + e) * 1024 * 256 + 4 * q8;
            tr_item64<true>(w, 256, g_ffn, 1.f, (bf16_t*)(F.ws + WS_WEXP) + (size_t)e * 512 * 1024, 1024, nb * 64, kb * 64, scr, lane, g_ffn); continue; }
        r -= N_UP;
        { const int e = r >> 6; r &= 63; const int nb = r >> 2, kb = r & 3; const int n = nb * 64 + g4;
            const float* w = F.in[I_WED] + ((size_t)layer * 32 + e) * 256 * 1024 + n;
            tr_item64<false>(w, 1024, nullptr, 1.f, (bf16_t*)(F.ws + WS_WEXP) + 32ull * 512 * 1024 + (size_t)e * 1024 * 256, 256, nb * 64, kb * 64, scr, lane, g_ffn); }
    }
    const f32x4* p = (const f32x4*)(F.in[I_P] + (size_t)layer * T * 256); u32x2* pb = (u32x2*)(F.ws + WS_PBF);
    for (size_t i = (size_t)F.bid * NTHREADS + F.tid; i < (size_t)T * 256 / 4; i += (size_t)F.G * NTHREADS) { const f32x4 v = p[i]; u32x2 w; w.x = cvt_pk_bf16(v.x, v.y); w.y = cvt_pk_bf16(v.z, v.w); pb[i] = w; }
}

constexpr int AK_RS = 144, AV_RS = 160, AV_OFF = 2 * 128 * AK_RS;
typedef short s16x4 __attribute__((ext_vector_type(4)));
__device__ __forceinline__ s16x4 lds_tr16(LAS unsigned char* p) { return __builtin_amdgcn_ds_read_tr16_b64_v4i16((LAS s16x4*)p); }
__device__ __forceinline__ void attn_strip(const Ctx& F, int strip) {
    const int bs = strip / 48, sg = strip - bs * 48, b = bs >> 3, slot = bs & 7;
    int g, r, nb0;
    if (sg < 16) { g = 0; r = 0; nb0 = sg * 8; } else if (sg < 32) { g = 1; r = (sg - 16) >> 2; nb0 = ((sg - 16) & 3) * 8; } else { g = 2; r = sg - 32; nb0 = 0; }
    const int dl = 1 << (2 * g); const float slope = exp2f(-(float)(g * 8 + slot + 1) * (1.0f / 3.0f)) * (float)dl;
    bf16_t* Qg = (bf16_t*)(F.ws + (g == 0 ? WS_QA0 : (g == 1 ? WS_QA1 : WS_QA2))) + slot * 64;
    const bf16_t* Kg = (const bf16_t*)(F.ws + WS_KA) + slot * 64; const bf16_t* Vg = (const bf16_t*)(F.ws + WS_VA) + slot * 64;
    float* LSE = (float*)(F.ws + WS_LOGITS) + (size_t)g * T * 8 + slot;
    const size_t tok0 = (size_t)b * SEQ + r;
    LAS unsigned char* Kl = F.lds; LAS unsigned char* Vl = F.lds + AV_OFF;
    const int tid = F.tid, lane = F.lane, w = F.wave, fr = lane & 15, fq = lane >> 4;
    const int srow = tid >> 2, sc4 = tid & 3;
    u32x4 kx[2], vx[2];
#define ATT_LOAD(blk) do { const size_t _t = (tok0 + (size_t)((blk) * 128 + srow) * dl) * 512; \
        kx[0] = *(const u32x4*)(Kg + _t + sc4 * 8); kx[1] = *(const u32x4*)(Kg + _t + 32 + sc4 * 8); vx[0] = *(const u32x4*)(Vg + _t + sc4 * 8); vx[1] = *(const u32x4*)(Vg + _t + 32 + sc4 * 8); } while (0)
#define ATT_STORE(blk) do { const int _p = (((blk) & 1) * 128 + srow); \
        *(LAS u32x4*)(Kl + _p * AK_RS + sc4 * 16) = kx[0]; *(LAS u32x4*)(Kl + _p * AK_RS + 64 + sc4 * 16) = kx[1]; *(LAS u32x4*)(Vl + _p * AV_RS + sc4 * 16) = vx[0]; *(LAS u32x4*)(Vl + _p * AV_RS + 64 + sc4 * 16) = vx[1]; } while (0)
    __syncthreads();
    if (nb0 > 0) { ATT_LOAD(nb0 - 1); ATT_STORE(nb0 - 1); }
    else { kx[0] = kx[1] = vx[0] = vx[1] = (u32x4){0u, 0u, 0u, 0u}; ATT_STORE(1); }
    ATT_LOAD(nb0); ATT_STORE(nb0);
    bf16x8 qn0, qn1;
    { const size_t qo = (tok0 + (size_t)(nb0 * 128 + 16 * w + fr) * dl) * 512; qn0 = *(const bf16x8*)(Qg + qo + fq * 8); qn1 = *(const bf16x8*)(Qg + qo + 32 + fq * 8); }
    __syncthreads();
    for (int nb = nb0; nb < nb0 + 8; ++nb) {
        const bool more = nb + 1 < nb0 + 8;
        if (more) ATT_LOAD(nb + 1);
        const size_t qoff = (tok0 + (size_t)(nb * 128 + 16 * w + fr) * dl) * 512;
        const bf16x8 q0 = qn0, q1 = qn1;
        if (more) { const size_t qo2 = qoff + (size_t)128 * dl * 512; qn0 = *(const bf16x8*)(Qg + qo2 + fq * 8); qn1 = *(const bf16x8*)(Qg + qo2 + 32 + fq * 8); }
        const int pslot = (nb - 1) & 1;
        f32x4 S[10];
#pragma unroll
        for (int kbi = 0; kbi < 10; ++kbi) {
            int kb = w + kbi; if (kb > 15) kb = 15;
            const int ki = kb * 16 + fr; const int phys = ((pslot + (ki >> 7)) & 1) * 128 + (ki & 127);
            const bf16x8 k0 = *(const LAS bf16x8*)(Kl + phys * AK_RS + fq * 16), k1 = *(const LAS bf16x8*)(Kl + phys * AK_RS + 64 + fq * 16);
            f32x4 a = (f32x4){0.f, 0.f, 0.f, 0.f};
            a = __builtin_amdgcn_mfma_f32_16x16x32_bf16(k0, q0, a, 0, 0, 0);
            S[kbi] = __builtin_amdgcn_mfma_f32_16x16x32_bf16(k1, q1, a, 0, 0, 0);
        }
        float mx = -INFINITY;
#pragma unroll
        for (int kbi = 0; kbi < 10; ++kbi)
#pragma unroll
            for (int j = 0; j < 4; ++j) { const int ki = (w + kbi) * 16 + 4 * fq + j; const int dist = 16 * w + fr + 128 - ki;
                const bool ok = dist >= 0 && dist <= 128 && (nb > 0 || ki >= 128) && (w + kbi) < 16;
                const float sc = ok ? S[kbi][j] - slope * (float)dist : -INFINITY; S[kbi][j] = sc; mx = fmaxf(mx, sc); }
        mx = fmaxf(mx, __shfl_xor(mx, 16)); mx = fmaxf(mx, __shfl_xor(mx, 32));
        float ls = 0.f;
#pragma unroll
        for (int kbi = 0; kbi < 10; ++kbi)
#pragma unroll
            for (int j = 0; j < 4; ++j) { const float p = __expf(S[kbi][j] - mx); S[kbi][j] = p; ls += p; }
        ls += __shfl_xor(ls, 16); ls += __shfl_xor(ls, 32);
        f32x4 O[4];
#pragma unroll
        for (int db = 0; db < 4; ++db) O[db] = (f32x4){0.f, 0.f, 0.f, 0.f};
#pragma unroll
        for (int k2 = 0; k2 < 5; ++k2) {
            u32x4 pw; pw.x = cvt_pk_bf16(S[2 * k2][0], S[2 * k2][1]); pw.y = cvt_pk_bf16(S[2 * k2][2], S[2 * k2][3]); pw.z = cvt_pk_bf16(S[2 * k2 + 1][0], S[2 * k2 + 1][1]); pw.w = cvt_pk_bf16(S[2 * k2 + 1][2], S[2 * k2 + 1][3]);
            const bf16x8 pf = __builtin_bit_cast(bf16x8, pw);
            int kb0 = w + 2 * k2, kb1 = kb0 + 1; if (kb1 > 15) kb1 = 15; if (kb0 > 15) kb0 = 15;
            const int r0 = kb0 * 16 + 4 * fq + (fr >> 2), r1 = kb1 * 16 + 4 * fq + (fr >> 2);
            const int p0 = ((pslot + (r0 >> 7)) & 1) * 128 + (r0 & 127), p1 = ((pslot + (r1 >> 7)) & 1) * 128 + (r1 & 127);
#pragma unroll
            for (int db = 0; db < 4; ++db) {
                const s16x4 v0 = lds_tr16(Vl + p0 * AV_RS + (db * 16 + 4 * (fr & 3)) * 2), v1 = lds_tr16(Vl + p1 * AV_RS + (db * 16 + 4 * (fr & 3)) * 2);
                const bf16x8 vf = (bf16x8){v0[0], v0[1], v0[2], v0[3], v1[0], v1[1], v1[2], v1[3]};
                O[db] = __builtin_amdgcn_mfma_f32_16x16x32_bf16(vf, pf, O[db], 0, 0, 0);
            }
        }
        const float inv = 1.0f / ls;
#pragma unroll
        for (int db = 0; db < 4; ++db) { u32x2 ow; ow.x = cvt_pk_bf16(O[db][0] * inv, O[db][1] * inv); ow.y = cvt_pk_bf16(O[db][2] * inv, O[db][3] * inv);
            *(u32x2*)(Qg + qoff + db * 16 + 4 * fq) = ow; }
        if (fq == 0) LSE[(qoff >> 9) * 8] = mx + __logf(ls);
        __syncthreads();
        if (more) ATT_STORE(nb + 1);
        __syncthreads();
    }
#undef ATT_LOAD
#undef ATT_STORE
}
__device__ __forceinline__ void attn_combine(const Ctx& F) {
    const float* LSE = (const float*)(F.ws + WS_LOGITS);
    for (int i = F.bid * NTHREADS + F.tid; i < T * 64; i += F.G * NTHREADS) {
        const int t = i >> 6, c8 = i & 63, slot = c8 >> 3;
        const float l0 = LSE[(size_t)t * 8 + slot], l1 = LSE[(size_t)T * 8 + (size_t)t * 8 + slot], l2 = LSE[(size_t)2 * T * 8 + (size_t)t * 8 + slot];
        const float m = fmaxf(l0, fmaxf(l1, l2)); float w0 = __expf(l0 - m), w1 = __expf(l1 - m), w2 = __expf(l2 - m); const float inv = 1.0f / (w0 + w1 + w2); w0 *= inv; w1 *= inv; w2 *= inv;
        u32x4* p0 = (u32x4*)(F.ws + WS_QA0) + i; const u32x4 a = *p0, bb = ((const u32x4*)(F.ws + WS_QA1))[i], cc = ((const u32x4*)(F.ws + WS_QA2))[i];
        f32x4 a0, a1, b0, b1, c0, c1; unpack8(a, a0, a1); unpack8(bb, b0, b1); unpack8(cc, c0, c1);
        *p0 = pack8(a0 * w0 + b0 * w1 + c0 * w2, a1 * w0 + b1 * w1 + c1 * w2);
    }
}

__device__ __forceinline__ void conv_item(const Ctx& F, int layer, int item) {
    const int t0 = item * 32, s0 = t0 & (SEQ - 1), tid = F.tid;
    LAS bf16_t* sin = (LAS bf16_t*)F.lds;
    LAS float* sout = (LAS float*)(F.lds + 65536);
    const bf16_t* YG = (const bf16_t*)(F.ws + WS_YG);
    __syncthreads();
    for (int i = tid; i < 62 * 64; i += NTHREADS) { const int r = i >> 6, c8 = i & 63; const int sp = s0 - 30 + r;
        u32x4 v = *(const u32x4*)(YG + (size_t)(sp >= 0 ? t0 - 30 + r : t0) * 512 + c8 * 8); if (sp < 0) v = (u32x4){0u, 0u, 0u, 0u};
        *(LAS u32x4*)(sin + r * 512 + c8 * 8) = v; }
    const int cp = tid & 255, hf = tid >> 8;
    f32x2 w[31];
    const float* cw = F.in[I_CONVW] + (size_t)layer * 31 * 512 + 2 * cp;
#pragma unroll
    for (int k = 0; k < 31; ++k) w[k] = *(const f32x2*)(cw + k * 512);
    const f32x2 cb = *(const f32x2*)(F.in[I_CONVB] + layer * 512 + 2 * cp);
    __syncthreads();
#pragma unroll 1
    for (int ps = 0; ps < 2; ++ps) { const int tb = 16 * hf + 8 * ps;
        f32x2 xin[38];
#pragma unroll
        for (int r = 0; r < 38; ++r) { const unsigned u = *(const LAS unsigned*)(sin + (tb + r) * 512 + 2 * cp); xin[r] = (f32x2){bf_lo(u), bf_hi(u)}; }
#pragma unroll
        for (int tt = 0; tt < 8; ++tt) { f32x2 a = cb;
#pragma unroll
            for (int k = 0; k < 31; ++k) a += w[k] * xin[tt + k];
            *(LAS f32x2*)(sout + (tb + tt) * 512 + 2 * cp) = a; } }
    __syncthreads();
    const float* lg = F.in[I_CLNG] + layer * 512 + F.lane * 8; const float* lb = F.in[I_CLNB] + layer * 512 + F.lane * 8;
    for (int tt = F.wave; tt < 32; tt += NWAVES) {
        float v[8]; float sm = 0.f;
#pragma unroll
        for (int j = 0; j < 8; ++j) { v[j] = sout[tt * 512 + F.lane * 8 + j]; sm += v[j]; }
        const float mu = wave_sum(sm) * (1.0f / 512.0f); float q = 0.f;
#pragma unroll
        for (int j = 0; j < 8; ++j) { v[j] -= mu; q += v[j] * v[j]; }
        const float rstd = rsqrtf(wave_sum(q) * (1.0f / 512.0f) + EPS);
        float o[8];
#pragma unroll
        for (int j = 0; j < 8; ++j) o[j] = siluf_(v[j] * rstd * lg[j] + lb[j]);
        u32x4 wv; wv.x = cvt_pk_bf16(o[0], o[1]); wv.y = cvt_pk_bf16(o[2], o[3]); wv.z = cvt_pk_bf16(o[4], o[5]); wv.w = cvt_pk_bf16(o[6], o[7]);
        *(u32x4*)((bf16_t*)(F.ws + WS_YC) + (size_t)(t0 + tt) * 512 + F.lane * 8) = wv;
    }
}

__device__ __forceinline__ float log_sigmoid_(float v) { return fminf(v, 0.f) - log1pf(__expf(-fabsf(v))); }
struct QkW { float w[4][8]; float b[8]; };
__device__ __forceinline__ void qk_load_w(const Ctx& F, int layer, int chq, QkW& W) {
    const float* cw = F.in[I_MCW] + (size_t)layer * 4 * 1024 + chq; const float* cb = F.in[I_MCB] + (size_t)layer * 1024 + chq;
#pragma unroll
    for (int k = 0; k < 4; ++k) { const f32x4 a = *(const f32x4*)(cw + k * 1024), b = *(const f32x4*)(cw + k * 1024 + 4); W.w[k][0] = a.x; W.w[k][1] = a.y; W.w[k][2] = a.z; W.w[k][3] = a.w; W.w[k][4] = b.x; W.w[k][5] = b.y; W.w[k][6] = b.z; W.w[k][7] = b.w; }
    const f32x4 a = *(const f32x4*)cb, b = *(const f32x4*)(cb + 4); W.b[0] = a.x; W.b[1] = a.y; W.b[2] = a.z; W.b[3] = a.w; W.b[4] = b.x; W.b[5] = b.y; W.b[6] = b.z; W.b[7] = b.w;
}
__device__ __forceinline__ void qk_conv8(const QkW& W, const bf16_t* src  , int t, int s, int ch  , float scale, float* o) {
#pragma unroll
    for (int j = 0; j < 8; ++j) o[j] = W.b[j];
#pragma unroll
    for (int k = 0; k < 4; ++k) { const bool ok = s - 3 + k >= 0; u32x4 w = *(const u32x4*)(src + (size_t)(ok ? t - 3 + k : t) * 512 + ch);
            if (!ok) w = (u32x4){0u, 0u, 0u, 0u};
            o[0] += W.w[k][0] * bf_lo(w.x); o[1] += W.w[k][1] * bf_hi(w.x); o[2] += W.w[k][2] * bf_lo(w.y); o[3] += W.w[k][3] * bf_hi(w.y); o[4] += W.w[k][4] * bf_lo(w.z); o[5] += W.w[k][5] * bf_hi(w.z); o[6] += W.w[k][6] * bf_lo(w.w); o[7] += W.w[k][7] * bf_hi(w.w); }
#pragma unroll
    for (int j = 0; j < 8; ++j) o[j] = siluf_(o[j]) * scale;
}
__device__ __forceinline__ void qk_conv8r(const QkW& W, const u32x4 (&rw)[4], int s, float scale, float* o) {
#pragma unroll
    for (int j = 0; j < 8; ++j) o[j] = W.b[j];
#pragma unroll
    for (int k = 0; k < 4; ++k) { u32x4 w = rw[k]; if (s - 3 + k < 0) w = (u32x4){0u, 0u, 0u, 0u};
        o[0] += W.w[k][0] * bf_lo(w.x); o[1] += W.w[k][1] * bf_hi(w.x); o[2] += W.w[k][2] * bf_lo(w.y); o[3] += W.w[k][3] * bf_hi(w.y); o[4] += W.w[k][4] * bf_lo(w.z); o[5] += W.w[k][5] * bf_hi(w.z); o[6] += W.w[k][6] * bf_lo(w.w); o[7] += W.w[k][7] * bf_hi(w.w); }
#pragma unroll
    for (int j = 0; j < 8; ++j) o[j] = siluf_(o[j]) * scale;
}
__device__ __forceinline__ void mlstm_scalars(const Ctx& F, int layer, int t0, int h, LAS float* sIG, LAS float* sBC) {
    if (F.tid < 128) { const float* IFp = (const float*)(F.ws + WS_IF) + (size_t)(t0 + F.tid) * 8;
        sIG[F.tid] = IFp[h] + F.in[I_MIB][layer * 4 + h]; sBC[F.tid] = log_sigmoid_(IFp[4 + h] + F.in[I_MFB][layer * 4 + h]); }
    __syncthreads();
    if (F.wave == 0) { const float a = sBC[2 * F.lane], bb = sBC[2 * F.lane + 1]; float sc = a + bb;
#pragma unroll
        for (int off = 1; off < 64; off <<= 1) { const float t = __shfl_up(sc, off); if (F.lane >= off) sc += t; }
        sBC[2 * F.lane] = sc - bb; sBC[2 * F.lane + 1] = sc; }
    __syncthreads();
}
constexpr int ML_KRS = 288, ML_ERS = 352, ML_E = 128 * ML_KRS, ML_S = ML_E + 128 * ML_ERS;
__device__ __forceinline__ void mlstm_local_mfma(const Ctx& F, int layer, int item) {
    const int c = item & 127, bh = item >> 7, h = bh & 3, b = bh >> 2, t0 = b * SEQ + c * 128, tid = F.tid, lane = F.lane, w = F.wave, fr = lane & 15, fq = lane >> 4;
    LAS unsigned char* L = F.lds;
    LAS float* sIG = (LAS float*)(L + ML_S); LAS float* sBC = sIG + 128; LAS float* sE = sIG + 256; LAS float* sM = sIG + 384;
    __syncthreads();
    mlstm_scalars(F, layer, t0, h, sIG, sBC);
    if (w == 0) { const float gt = sBC[127]; const float m = wave_max(fmaxf(gt - sBC[lane] + sIG[lane], gt - sBC[lane + 64] + sIG[lane + 64])); if (lane == 0) { sM[0] = m; sM[1] = gt; } }
    __syncthreads();
    if (tid < 128) sE[tid] = __expf(sM[1] - sBC[tid] + sIG[tid] - sM[0]);
    __syncthreads();
    const bf16_t* KM = (const bf16_t*)(F.ws + WS_KM); const bf16_t* VM = (const bf16_t*)(F.ws + WS_VM);
    QkW WK; qk_load_w(F, layer, 512 + h * 128 + (tid & 15) * 8, WK);
#pragma unroll 1
    for (int i = tid; i < 128 * 16; i += NTHREADS) { const int l = i >> 4, c8 = (i & 15) * 8; const int t = t0 + l, s = t & (SEQ - 1);
        u32x4 rk[4];
#pragma unroll
        for (int k = 0; k < 4; ++k) rk[k] = *(const u32x4*)(KM + (size_t)(s - 3 + k >= 0 ? t - 3 + k : t) * 512 + h * 128 + c8);
        const u32x4 rv = *(const u32x4*)(VM + (size_t)t * 512 + h * 128 + c8);
        float o[8]; qk_conv8r(WK, rk, s, 0.08838834764831845f, o);
        *(LAS u32x4*)(L + l * ML_KRS + c8 * 2) = pack8((f32x4){o[0], o[1], o[2], o[3]}, (f32x4){o[4], o[5], o[6], o[7]});
        f32x4 v0, v1; unpack8(rv, v0, v1); const float e = sE[l];
        *(LAS u32x4*)(L + ML_E + l * ML_ERS + c8 * 2) = pack8(v0 * e, v1 * e); }
    if (tid < 128) { unsigned zr = 0u; asm volatile("" : "+v"(zr));
        u32x4 z; z.x = f2bf(sE[tid]); z.y = zr; z.z = zr; z.w = zr; *(LAS u32x4*)(L + ML_E + tid * ML_ERS + 256) = z; z.x = zr; *(LAS u32x4*)(L + ML_E + tid * ML_ERS + 272) = z; }
    __syncthreads();
    bf16x8 af[4];
#pragma unroll
    for (int ks = 0; ks < 4; ++ks) { const int ra = ks * 32 + 4 * fq + (fr >> 2);
        const s16x4 a0 = lds_tr16(L + ra * ML_KRS + (w * 16 + 4 * (fr & 3)) * 2), a1 = lds_tr16(L + (ra + 16) * ML_KRS + (w * 16 + 4 * (fr & 3)) * 2);
        af[ks] = (bf16x8){a0[0], a0[1], a0[2], a0[3], a1[0], a1[1], a1[2], a1[3]}; }
    bf16_t* Cp = (bf16_t*)(F.ws + WS_CST) + ((size_t)(bh * 128 + c) << 14);
#pragma unroll
    for (int vb = 0; vb < 9; ++vb) { f32x4 d = (f32x4){0.f, 0.f, 0.f, 0.f};
#pragma unroll
        for (int ks = 0; ks < 4; ++ks) { const int rb = ks * 32 + 4 * fq + (fr >> 2);
            const s16x4 b0 = lds_tr16(L + ML_E + rb * ML_ERS + (vb * 16 + 4 * (fr & 3)) * 2), b1 = lds_tr16(L + ML_E + (rb + 16) * ML_ERS + (vb * 16 + 4 * (fr & 3)) * 2);
            const bf16x8 bfr = (bf16x8){b0[0], b0[1], b0[2], b0[3], b1[0], b1[1], b1[2], b1[3]};
            d = __builtin_amdgcn_mfma_f32_16x16x32_bf16(af[ks], bfr, d, 0, 0, 0); }
        if (vb < 8) { u32x2 o; o.x = pk2(d[0], d[1]); o.y = pk2(d[2], d[3]); *(u32x2*)(Cp + (size_t)(vb * 16 + fr) * 128 + w * 16 + 4 * fq) = o; }
        else if (fr == 0) *(f32x4*)((float*)(F.ws + WS_NST) + (size_t)(bh * 128 + c) * 128 + w * 16 + 4 * fq) = d;
    }
    if (tid == 0) { ((float*)(F.ws + WS_TAB + TAB_MLOC))[bh * 128 + c] = sM[0]; ((float*)(F.ws + WS_TAB + TAB_GTOT))[bh * 128 + c] = sM[1]; }
}
__device__ __forceinline__ void phase_scan(const Ctx& F) {
    const float* GT = (const float*)(F.ws + WS_TAB + TAB_GTOT); const float* ML = (const float*)(F.ws + WS_TAB + TAB_MLOC); float* MS = (float*)(F.ws + WS_TAB + TAB_MST);
    LAS float* sA = (LAS float*)F.lds; LAS float* sB = sA + 128;
    for (int blk = F.bid; blk < 8 * 32 + 8; blk += F.G) {
        const bool isC = blk < 256; const int bh = isC ? (blk >> 5) : (blk - 256);
        __syncthreads();
        if (F.tid < 128) { sA[F.tid] = GT[bh * 128 + F.tid]; sB[F.tid] = ML[bh * 128 + F.tid]; }
        __syncthreads();
        if (F.wave == 0) {
            const int c0 = 2 * F.lane; const float g0 = sA[c0], m0 = sB[c0], g1 = sA[c0 + 1], m1 = sB[c0 + 1];
            float G = g0 + g1, M = fmaxf(m0 + g1, m1);
#pragma unroll
            for (int off = 1; off < 64; off <<= 1) { const float Gp = __shfl_up(G, off), Mp = __shfl_up(M, off); if (F.lane >= off) { M = fmaxf(Mp + G, M); G = Gp + G; } }
            float Gx = __shfl_up(G, 1), Mx = __shfl_up(M, 1); if (F.lane == 0) { Gx = 0.f; Mx = -INFINITY; }
            const float mA = fmaxf(0.f + Gx, Mx);
            const float mB = fmaxf(mA + g0, m0);
            const float mC = fmaxf(mB + g1, m1);
            sA[c0] = __expf(g0 + mA - mB); sB[c0] = __expf(m0 - mB); sA[c0 + 1] = __expf(g1 + mB - mC); sB[c0 + 1] = __expf(m1 - mC);
            if (isC && (blk & 31) == 0) { MS[bh * 128 + c0] = mA; MS[bh * 128 + c0 + 1] = mB; } }
        __syncthreads();
        if (isC) { bf16_t* cp = (bf16_t*)(F.ws + WS_CST) + ((size_t)(bh * 128) << 14) + (blk & 31) * 512 + F.tid; float val = 0.f;
            for (int c0 = 0; c0 < 128; c0 += 16) { float loc[16];
#pragma unroll
                for (int j = 0; j < 16; ++j) loc[j] = bf1(cp[(size_t)(c0 + j) << 14]);
                PIN8(loc[0], loc[1], loc[2], loc[3], loc[4], loc[5], loc[6], loc[7]); PIN8(loc[8], loc[9], loc[10], loc[11], loc[12], loc[13], loc[14], loc[15]);
#pragma unroll
                for (int j = 0; j < 16; ++j) { cp[(size_t)(c0 + j) << 14] = (bf16_t)f2bf(val); val = sA[c0 + j] * val + sB[c0 + j] * loc[j]; } } }
        else if (F.tid < 128) { float* np = (float*)(F.ws + WS_NST) + (size_t)(bh * 128) * 128 + F.tid; float val = 0.f;
            for (int c0 = 0; c0 < 128; c0 += 16) { float loc[16];
#pragma unroll
                for (int j = 0; j < 16; ++j) loc[j] = np[(size_t)(c0 + j) * 128];
                PIN8(loc[0], loc[1], loc[2], loc[3], loc[4], loc[5], loc[6], loc[7]); PIN8(loc[8], loc[9], loc[10], loc[11], loc[12], loc[13], loc[14], loc[15]);
#pragma unroll
                for (int j = 0; j < 16; ++j) { np[(size_t)(c0 + j) * 128] = val; val = sA[c0 + j] * val + sB[c0 + j] * loc[j]; } } }
    }
    __syncthreads();
}
constexpr int MO_RS = 272, MO_VRS = 288;
constexpr int MO_Q = 0, MO_K = 128 * MO_RS, MO_C = 2 * 128 * MO_RS, MO_V = MO_C + 144 * MO_RS, MO_S = MO_V + 128 * MO_VRS;
static_assert(MO_S + 2560 <= MISC_OFF, "mlstm_out LDS");
__device__ __forceinline__ void mlstm_out_mfma(const Ctx& F, int layer, int item) {
    const int c = item & 127, bh = item >> 7, h = bh & 3, b = bh >> 2, t0 = b * SEQ + c * 128, tid = F.tid, lane = F.lane, w = F.wave, fr = lane & 15, fq = lane >> 4;
    LAS unsigned char* L = F.lds;
    LAS float* sIG = (LAS float*)(L + MO_S); LAS float* sBC = sIG + 128; LAS float* sMT = sIG + 256; LAS float* sSI = sIG + 384;
    __syncthreads();
    mlstm_scalars(F, layer, t0, h, sIG, sBC);
    const float mst = ((const float*)(F.ws + WS_TAB + TAB_MST))[bh * 128 + c];
    if (w == 0) { const float a = sIG[2 * lane] - sBC[2 * lane], bb = sIG[2 * lane + 1] - sBC[2 * lane + 1]; float pm = fmaxf(a, bb);
#pragma unroll
        for (int off = 1; off < 64; off <<= 1) { const float t = __shfl_up(pm, off); if (lane >= off) pm = fmaxf(pm, t); }
        float pl = __shfl_up(pm, 1); if (lane == 0) pl = -INFINITY;
        const float p0 = fmaxf(pl, a), p1 = pm;
        { const float ai = sBC[2 * lane] + mst, mt = fmaxf(ai, sBC[2 * lane] + p0); sMT[2 * lane] = mt; sSI[2 * lane] = __expf(ai - mt); }
        { const float ai = sBC[2 * lane + 1] + mst, mt = fmaxf(ai, sBC[2 * lane + 1] + p1); sMT[2 * lane + 1] = mt; sSI[2 * lane + 1] = __expf(ai - mt); } }
    const bf16_t* QM = (const bf16_t*)(F.ws + WS_QM); const bf16_t* KM = (const bf16_t*)(F.ws + WS_KM); const bf16_t* VM = (const bf16_t*)(F.ws + WS_VM);
    const bf16_t* Cp = (const bf16_t*)(F.ws + WS_CST) + ((size_t)(bh * 128 + c) << 14);
    QkW WQ, WK; qk_load_w(F, layer, h * 128 + (tid & 15) * 8, WQ); qk_load_w(F, layer, 512 + h * 128 + (tid & 15) * 8, WK);
#pragma unroll 1
    for (int i = tid; i < 128 * 16; i += NTHREADS) { const int l = i >> 4, c8 = (i & 15) * 8; const int t = t0 + l, s = t & (SEQ - 1); float o[8];
        u32x4 rq[4], rk[4];
#pragma unroll
        for (int k = 0; k < 4; ++k) { const size_t ro = (size_t)(s - 3 + k >= 0 ? t - 3 + k : t) * 512 + h * 128 + c8; rq[k] = *(const u32x4*)(QM + ro); rk[k] = *(const u32x4*)(KM + ro); }
        const u32x4 rv = *(const u32x4*)(VM + (size_t)t * 512 + h * 128 + c8), rc = *(const u32x4*)(Cp + l * 128 + c8);
        qk_conv8r(WQ, rq, s, 1.0f, o);
        *(LAS u32x4*)(L + MO_Q + l * MO_RS + c8 * 2) = pack8((f32x4){o[0], o[1], o[2], o[3]}, (f32x4){o[4], o[5], o[6], o[7]});
        qk_conv8r(WK, rk, s, 0.08838834764831845f, o);
        *(LAS u32x4*)(L + MO_K + l * MO_RS + c8 * 2) = pack8((f32x4){o[0], o[1], o[2], o[3]}, (f32x4){o[4], o[5], o[6], o[7]});
        *(LAS u32x4*)(L + MO_V + l * MO_VRS + c8 * 2) = rv;
        *(LAS u32x4*)(L + MO_C + l * MO_RS + c8 * 2) = rc; }
    if (tid < 16) { const float* np = (const float*)(F.ws + WS_NST) + (size_t)(bh * 128 + c) * 128 + tid * 8;
        *(LAS u32x4*)(L + MO_C + 128 * MO_RS + tid * 16) = pack8(*(const f32x4*)np, *(const f32x4*)(np + 4)); }
    __syncthreads();
    const int q = 16 * w + fr;
    bf16x8 qf[4];
#pragma unroll
    for (int ks = 0; ks < 4; ++ks) qf[ks] = *(const LAS bf16x8*)(L + MO_Q + q * MO_RS + ks * 64 + fq * 16);
    f32x4 O[9];
#pragma unroll
    for (int vb = 0; vb < 9; ++vb) { f32x4 a = (f32x4){0.f, 0.f, 0.f, 0.f};
#pragma unroll
        for (int ks = 0; ks < 4; ++ks) { const bf16x8 cf = *(const LAS bf16x8*)(L + MO_C + (vb * 16 + fr) * MO_RS + ks * 64 + fq * 16); a = __builtin_amdgcn_mfma_f32_16x16x32_bf16(cf, qf[ks], a, 0, 0, 0); }
        O[vb] = a; }
    const float si = sSI[q], mt = sMT[q], bq = sBC[q];
    const float dn = __shfl(O[8][0], fr);
#pragma unroll
    for (int vb = 0; vb < 8; ++vb) O[vb] = O[vb] * si;
    float den = 0.f;
    for (int k2 = 0; k2 <= (w >> 1); ++k2) {
        f32x4 P[2];
#pragma unroll
        for (int u = 0; u < 2; ++u) { const int kb = 2 * k2 + u; f32x4 a = (f32x4){0.f, 0.f, 0.f, 0.f};
            const int kr = (kb > 7 ? 7 : kb) * 16 + fr;
#pragma unroll
            for (int ks = 0; ks < 4; ++ks) { const bf16x8 kf = *(const LAS bf16x8*)(L + MO_K + kr * MO_RS + ks * 64 + fq * 16); a = __builtin_amdgcn_mfma_f32_16x16x32_bf16(kf, qf[ks], a, 0, 0, 0); }
#pragma unroll
            for (int j = 0; j < 4; ++j) { const int k = kb * 16 + 4 * fq + j; const int kc = k > 127 ? 127 : k; const float wgt = (k <= q) ? __expf(bq - sBC[kc] + sIG[kc] - mt) : 0.f; a[j] *= wgt; den += a[j]; }
            P[u] = a; }
        u32x4 pw; pw.x = cvt_pk_bf16(P[0][0], P[0][1]); pw.y = cvt_pk_bf16(P[0][2], P[0][3]); pw.z = cvt_pk_bf16(P[1][0], P[1][1]); pw.w = cvt_pk_bf16(P[1][2], P[1][3]);
        const bf16x8 pf = __builtin_bit_cast(bf16x8, pw);
        const int kb1 = (2 * k2 + 1 > 7) ? 7 : 2 * k2 + 1;
        const int r0 = 2 * k2 * 16 + 4 * fq + (fr >> 2), r1 = kb1 * 16 + 4 * fq + (fr >> 2);
#pragma unroll
        for (int vb = 0; vb < 8; ++vb) {
            const s16x4 v0 = lds_tr16(L + MO_V + r0 * MO_VRS + (vb * 16 + 4 * (fr & 3)) * 2), v1 = lds_tr16(L + MO_V + r1 * MO_VRS + (vb * 16 + 4 * (fr & 3)) * 2);
            const bf16x8 vf = (bf16x8){v0[0], v0[1], v0[2], v0[3], v1[0], v1[1], v1[2], v1[3]};
            O[vb] = __builtin_amdgcn_mfma_f32_16x16x32_bf16(vf, pf, O[vb], 0, 0, 0);
        }
    }
    den += __shfl_xor(den, 16); den += __shfl_xor(den, 32);
    const float dd = den + si * dn; const float inv = 1.0f / fmaxf(fabsf(dd), __expf(-mt));
    bf16_t* OM = (bf16_t*)(F.ws + WS_OM) + (size_t)(t0 + q) * 512 + h * 128;
#pragma unroll
    for (int vb = 0; vb < 8; ++vb) { u32x2* p = (u32x2*)(OM + vb * 16 + 4 * fq); const u32x2 g = *p;
        u32x2 o; o.x = cvt_pk_bf16(bf_lo(g.x) * O[vb][0] * inv, bf_hi(g.x) * O[vb][1] * inv); o.y = cvt_pk_bf16(bf_lo(g.y) * O[vb][2] * inv, bf_hi(g.y) * O[vb][3] * inv); *p = o; }
}

__device__ __forceinline__ void phase_route(const Ctx& F, int layer, int tile0, int tile1, int tstep) {
    LAS int* hist = (LAS int*)F.lds;
    const float* brg = F.in[I_BRG] + layer * 4; const float* bre = F.in[I_BRE] + layer * 32;
    for (int tile = tile0; tile < tile1; tile += tstep) {
        __syncthreads();
        if (F.tid < 128) { const int t = tile * 128 + F.tid; const float* lg = (const float*)(F.ws + WS_LOGITS) + (size_t)t * 64;
            float g[4]; int gs = 0; float gm;
#pragma unroll
            for (int j = 0; j < 4; ++j) g[j] = lg[j] + brg[j];
            gm = g[0];
#pragma unroll
            for (int j = 1; j < 4; ++j) if (g[j] > gm) { gm = g[j]; gs = j; }
            float se = 0.f;
#pragma unroll
            for (int j = 0; j < 4; ++j) se += __expf(g[j] - gm);
            const float pg = 1.0f / se;
            float le[8];
#pragma unroll
            for (int j = 0; j < 8; ++j) le[j] = lg[4 + gs * 8 + j] + bre[gs * 8 + j];
            int i0 = 0; float v0 = le[0];
#pragma unroll
            for (int j = 1; j < 8; ++j) if (le[j] > v0) { v0 = le[j]; i0 = j; }
            int i1 = -1; float v1 = -INFINITY;
#pragma unroll
            for (int j = 0; j < 8; ++j) if (j != i0 && le[j] > v1) { v1 = le[j]; i1 = j; }
            const float e1 = __expf(v1 - v0); const float wsc = (ABL == 4) ? 0.f : ((ABL == 6) ? 2.f : 1.f); const float w0 = wsc * pg / (1.0f + e1), w1 = wsc * pg * e1 / (1.0f + e1);
            const int x0 = gs * 8 + i0, x1 = gs * 8 + i1;
            ((int*)(F.ws + WS_ROUTE))[2 * t] = x0; ((int*)(F.ws + WS_ROUTE))[2 * t + 1] = x1;
            ((float*)(F.ws + WS_ROUTE))[2 * T + 2 * t] = w0; ((float*)(F.ws + WS_ROUTE))[2 * T + 2 * t + 1] = w1;
            hist[F.tid] = x0; hist[128 + F.tid] = x1;
        }
        __syncthreads();
        if (F.tid < 64) { const int k = F.tid >> 5, e = F.tid & 31; int cnt = 0; for (int j = 0; j < 128; ++j) cnt += (hist[k * 128 + j] == e) ? 1 : 0; ((int*)(F.ws + WS_TAB + TAB_CNT))[tile * 64 + F.tid] = cnt; }
        __syncthreads();
    }
}
__device__ __forceinline__ void phase_dispatch(const Ctx& F) {
    LAS int* sTot = (LAS int*)F.lds; LAS int* sBef = sTot + 64; LAS int* sPs = sTot + 128; LAS int* sE = sTot + 256; LAS int* sPart = sTot + 512;
    const int* CNT = (const int*)(F.ws + WS_TAB + TAB_CNT); int* META = (int*)(F.ws + WS_TAB + TAB_META);
    int* tokl = (int*)(F.ws + WS_LISTS); float* wl = (float*)(F.ws + WS_LISTS) + 2 * LISTCAP;
    for (int tile = F.bid; tile < 256; tile += F.G) {
        { const int ke = F.tid & 63, grp = F.tid >> 6; int cv[32];
#pragma unroll
            for (int i = 0; i < 32; ++i) cv[i] = CNT[(grp + 8 * i) * 64 + ke];
            int tot = 0, bef = 0;
#pragma unroll
            for (int i = 0; i < 32; ++i) { tot += cv[i]; bef += (grp + 8 * i < tile) ? cv[i] : 0; }
            sPart[grp * 64 + ke] = tot; sPart[512 + grp * 64 + ke] = bef; }
        __syncthreads();
        if (F.tid < 64) { int tot = 0, bef = 0;
#pragma unroll
            for (int gI = 0; gI < 8; ++gI) { tot += sPart[gI * 64 + F.tid]; bef += sPart[512 + gI * 64 + F.tid]; }
            sTot[F.tid] = tot; sBef[F.tid] = bef; }
        __syncthreads();
        if (F.tid < 2) { int ps = 0; for (int e = 0; e < 32; ++e) { sPs[F.tid * 33 + e] = ps; ps += ((sTot[F.tid * 32 + e] + 255) >> 8) << 8; } sPs[F.tid * 33 + 32] = ps;
            if (tile == 0) { META[F.tid] = ps >> 8; for (int e = 0; e <= 32; ++e) META[16 + 64 * F.tid + e] = sPs[F.tid * 33 + e]; } }
        int e0 = 0, e1 = 0; float w0 = 0.f, w1 = 0.f;
        if (F.tid < 128) { const int t = tile * 128 + F.tid; e0 = ((const int*)(F.ws + WS_ROUTE))[2 * t]; e1 = ((const int*)(F.ws + WS_ROUTE))[2 * t + 1];
            w0 = ((const float*)(F.ws + WS_ROUTE))[2 * T + 2 * t]; w1 = ((const float*)(F.ws + WS_ROUTE))[2 * T + 2 * t + 1]; sE[F.tid] = e0; sE[128 + F.tid] = e1; }
        __syncthreads();
        if (F.tid < 128) { int r0 = 0, r1 = 0; for (int j = 0; j < F.tid; ++j) { r0 += (sE[j] == e0) ? 1 : 0; r1 += (sE[128 + j] == e1) ? 1 : 0; }
            const int p0 = sPs[e0] + sBef[e0] + r0, p1 = sPs[33 + e1] + sBef[32 + e1] + r1;
            tokl[p0] = tile * 128 + F.tid; wl[p0] = w0; tokl[LISTCAP + p1] = tile * 128 + F.tid; wl[LISTCAP + p1] = w1; }
        __syncthreads();
    }
}
__device__ __forceinline__ void phase_final(const Ctx& F, const float* SS) {
    const int gw = F.bid * NWAVES + F.wave, NGW = F.G * NWAVES, lane = F.lane;
    for (int m = gw; m < T; m += NGW) { const float rs = row_rs(SS, m); f32x4* o = (f32x4*)(F.out + (size_t)m * D) + 2 * lane; const f32x4* g = (const f32x4*)F.in[I_GFIN] + 2 * lane;
        const u32x4* xr = (const u32x4*)((const bf16_t*)(F.ws + WS_XBT) + (size_t)m * D) + lane;
#pragma unroll
        for (int j = 0; j < 2; ++j) { f32x4 x0, x1; unpack8(xr[64 * j], x0, x1); o[128 * j] = x0 * rs * g[128 * j]; o[128 * j + 1] = x1 * rs * g[128 * j + 1]; } }
}
constexpr int PH_PER_LAYER = 15, PH_FINAL = DEPTH * PH_PER_LAYER, N_PHASES = PH_FINAL + 1;
struct Args { const float* in[28]; float* out; unsigned char* ws; int ph_lo, ph_hi; };

__device__ __forceinline__ Ctx mkctx(const Args& args, LAS unsigned char* lds, int wave_s) {
    Ctx F; asm volatile("" : "+s"(wave_s)); int tid = wave_s * 64 + lane_id_(); asm volatile("" : "+v"(tid));
    GAS unsigned char* wsg = (GAS unsigned char*)args.ws; asm volatile("" : "+s"(wsg)); unsigned char* ws = (unsigned char*)wsg;
    GAS float* outg = (GAS float*)args.out; asm volatile("" : "+s"(outg)); float* outp = (float*)outg;
    int bid = blockIdx.x; asm volatile("" : "+s"(bid)); int G = gridDim.x; asm volatile("" : "+s"(G));
    F.in.p = args.in; F.out = outp; F.ws = ws; F.lds = lds;
    F.tid = tid; F.lane = tid & 63; F.wave = wave_s; F.G = G; F.bid = bid;
    return F;
}
#ifndef ONLY_PHASE
#define ONLY_PHASE -1
#endif
#ifndef STAGGER_TICKS
#define STAGGER_TICKS 1300
#endif
__device__ __forceinline__ void run_phase(const Args& args, LAS unsigned char* lds, int ph, int wave_s) {
    const int layer = ph / PH_PER_LAYER, lp = ph - layer * PH_PER_LAYER;
    const size_t ssin = (layer & 1) ? WS_SS1 : WS_SS0, ssmid = (layer & 1) ? WS_SS0 : WS_SS1;
    if (ph == PH_FINAL) { const Ctx F = mkctx(args, lds, wave_s); phase_final(F, (const float*)(F.ws + WS_SS0)); return; }
    if (ONLY_PHASE >= 0 && lp != ONLY_PHASE) return;
    switch (lp) {
    case 0: { const Ctx F = mkctx(args, lds, wave_s); phase_prep(F, layer, (float*)(F.ws + ssin)); } break;
    case 1: { const Ctx F = mkctx(args, lds, wave_s); PhProj P{(const char*)F.ws + WS_XB, (const char*)F.ws + WS_WIN, (const float*)(F.ws + ssin), F.ws, F.G, F.bid}; pg8::gemm_phase(F.lds, P, F.tid); } break;
    case 2: { const Ctx F = mkctx(args, lds, wave_s);
        for (int it = F.bid; it < 768; it += F.G) attn_strip(F, it);
        __syncthreads();
        for (int it = F.bid; it < 1024; it += F.G) mlstm_local_mfma(F, layer, it);
        for (int it = F.bid; it < 1024; it += F.G) conv_item(F, layer, it);
    } break;
    case 3: { const Ctx F = mkctx(args, lds, wave_s); phase_scan(F); attn_combine(F); } break;
    case 4: { const Ctx F = mkctx(args, lds, wave_s); for (int it = F.bid; it < 1024; it += F.G) mlstm_out_mfma(F, layer, it); } break;
    case 5: { const Ctx F = mkctx(args, lds, wave_s); PhGates P{(const char*)F.ws + WS_XB, (const char*)F.ws + WS_WIN, (const float*)(F.ws + ssin), F.ws, F.G, F.bid}; pg8::gemm_phase(F.lds, P, F.tid); } break;
    case 6: { const Ctx F = mkctx(args, lds, wave_s); PhMerge P{F.ws, F.G, F.bid};
        pg8::gemm_phase(F.lds, P, F.tid); } break;
    case 7: { const Ctx F = mkctx(args, lds, wave_s); PhOut P{F.ws, (float*)(F.ws + ssmid), F.G, F.bid}; pg8::gemm_phase(F.lds, P, F.tid); } break;
    case 8: { const Ctx F = mkctx(args, lds, wave_s); PhRouter P{F.ws, (const float*)(F.ws + ssmid), F.G, F.bid}; pg8::gemm_phase(F.lds, P, F.tid);
        { int* tokl = (int*)(F.ws + WS_LISTS); for (int i = F.bid * NTHREADS + F.tid; i < 2 * LISTCAP; i += F.G * NTHREADS) tokl[i] = -1; }
        for (int pm = F.bid; pm < 128; pm += F.G) phase_route(F, layer, 2 * pm, 2 * pm + 2, 1);
        phase_prep_experts(F, layer); } break;
    case 9: break;
    case 10: { const Ctx F = mkctx(args, lds, wave_s); phase_dispatch(F); } break;
    case 11: { const Ctx F = mkctx(args, lds, wave_s); PhUp P{F.ws, (const float*)(F.ws + ssmid), (const int*)(F.ws + WS_TAB + TAB_META), (const int*)(F.ws + WS_LISTS), F.G, F.bid}; pg8::gemm_phase(F.lds, P, F.tid); } break;
    case 12: { const Ctx F = mkctx(args, lds, wave_s); PhDown<1> P{F.ws, (float*)(F.ws + ssin), (const int*)(F.ws + WS_TAB + TAB_META), (const int*)(F.ws + WS_LISTS), (const float*)(F.ws + WS_LISTS) + 2 * LISTCAP, F.G, F.bid}; pg8::gemm_phase(F.lds, P, F.tid); } break;
    case 13: { const Ctx F = mkctx(args, lds, wave_s); PhDown<0> P{F.ws, (float*)(F.ws + ssin), (const int*)(F.ws + WS_TAB + TAB_META), (const int*)(F.ws + WS_LISTS), (const float*)(F.ws + WS_LISTS) + 2 * LISTCAP, F.G, F.bid}; pg8::gemm_phase(F.lds, P, F.tid); } break;
    case 14: { const Ctx F = mkctx(args, lds, wave_s); PhPle P{F.ws, (const float*)(F.ws + ssin), (float*)(F.ws + ssmid), F.G, F.bid}; pg8::gemm_phase(F.lds, P, F.tid); } break;
    }
}

__global__ void __launch_bounds__(NTHREADS, 2) fwd_kernel(Args args) {
    extern __shared__ __attribute__((aligned(16))) unsigned char lds_raw[];
    LAS unsigned char* lds = (LAS unsigned char*)lds_raw;
    volatile LAS unsigned* MISC = (volatile LAS unsigned*)(lds + MISC_OFF);
    const int wave_s = __builtin_amdgcn_readfirstlane((int)threadIdx.x >> 6);
    if (wave_s == 0) MISC[lane_id_()] = 0u;
    __syncthreads();
#if MK_MEGA
    XcdBarrier bar = xcd_barrier_post((unsigned*)(args.ws + WS_CTL) + 4096, MISC + 8, wave_s);
#endif
#ifndef PROBE_SEL
#define PROBE_SEL 0
#endif
    unsigned long long extra = 0ull;
    for (int ph = args.ph_lo; ph < args.ph_hi; ++ph) {
        if (ph < PH_FINAL && (ph % PH_PER_LAYER) == 9) continue;
        const unsigned long long t0 = PROBE_SEL ? __builtin_amdgcn_s_memrealtime() : 0ull;
        run_phase(args, lds, ph, wave_s);
#if MK_MEGA
        if (ph + 1 < args.ph_hi) xcd_barrier(bar);
#endif
        if (PROBE_SEL) { const int lp = ph % PH_PER_LAYER; if (ph < PH_FINAL && ((PROBE_SEL >> lp) & 1)) extra += __builtin_amdgcn_s_memrealtime() - t0; }
    }
    if (PROBE_SEL && blockIdx.x == 0) { const unsigned long long te = __builtin_amdgcn_s_memrealtime(); while (__builtin_amdgcn_s_memrealtime() - te < extra) __builtin_amdgcn_s_sleep(8); }
}

extern "C" void kernel_launch(void* const* d_in, const int* in_sizes, int n_in, void* d_out, int out_size, void* d_ws, size_t ws_size, hipStream_t stream) {
    static int grid = 0;
    if (grid == 0) {
        if (n_in != 28 || out_size != T * D || ws_size < WS_END) { fprintf(stderr, "kernel_launch: unexpected shapes (n_in %d out %d ws %zu, need %zu)\n", n_in, out_size, ws_size, (size_t)WS_END); grid = -1; return; }
        int dev = 0, cus = 0, per_cu = 0;
        if (hipGetDevice(&dev) != hipSuccess || hipDeviceGetAttribute(&cus, hipDeviceAttributeMultiprocessorCount, dev) != hipSuccess) { grid = -1; return; }
        if (hipFuncSetAttribute((const void*)fwd_kernel, hipFuncAttributeMaxDynamicSharedMemorySize, LDS_BYTES) != hipSuccess) { fprintf(stderr, "kernel_launch: hipFuncSetAttribute failed\n"); grid = -1; return; }
        if (hipOccupancyMaxActiveBlocksPerMultiprocessor(&per_cu, (const void*)fwd_kernel, NTHREADS, LDS_BYTES) != hipSuccess || per_cu < 1) { fprintf(stderr, "kernel_launch: occupancy query says %d blocks per CU\n", per_cu); }
        (void)hipGetLastError();
        grid = cus;
    }
    if (grid < 0) return;
    Args a{};
    for (int i = 0; i < 28; ++i) a.in[i] = (const float*)d_in[i];
    a.out = (float*)d_out; a.ws = (unsigned char*)d_ws;
#if MK_MEGA
    (void)hipMemsetAsync((char*)d_ws + WS_CTL, 0, CTL_ZERO_BYTES, stream);
    a.ph_lo = 0; a.ph_hi = N_PHASES;
    hipLaunchKernelGGL(fwd_kernel, dim3(grid), dim3(NTHREADS), LDS_BYTES, stream, a);
#else
    for (int ph = 0; ph < N_PHASES; ++ph) { a.ph_lo = ph; a.ph_hi = ph + 1; hipLaunchKernelGGL(fwd_kernel, dim3(grid), dim3(NTHREADS), LDS_BYTES, stream, a); }
#endif
}
```

```cpp
#include <hip/hip_runtime.h>
#include <cstdio>
#include <cstdint>

#ifndef MK_MEGA
#define MK_MEGA 1
#endif

#ifndef ABL
#define ABL 0
#endif
#define LAS __attribute__((address_space(3)))
#define GAS __attribute__((address_space(1)))
typedef unsigned short bf16_t;
typedef short bf16x8 __attribute__((ext_vector_type(8)));
typedef float f32x4 __attribute__((ext_vector_type(4)));
typedef float f32x2 __attribute__((ext_vector_type(2)));
typedef unsigned u32x4 __attribute__((ext_vector_type(4)));
typedef unsigned u32x2 __attribute__((ext_vector_type(2)));

constexpr int T = 32768, SEQ = 16384, D = 1024, DEPTH = 2;
constexpr int D_IN = 8712;
constexpr float EPS = 1e-6f;
constexpr int NTHREADS = 512, NWAVES = 8;
constexpr int LISTCAP = 40960;

constexpr size_t MiB = 1u << 20;
constexpr size_t WS_CTL = 0, CTL_ZERO_BYTES = 1 * MiB;
constexpr size_t WS_TAB = 1 * MiB;
constexpr size_t WS_ROUTE = 2 * MiB;
constexpr size_t WS_LISTS = 3 * MiB;
constexpr size_t WS_SS0 = 4 * MiB, WS_SS1 = 6 * MiB;
constexpr size_t WS_IF = 8 * MiB;
constexpr size_t WS_NST = 9 * MiB;
constexpr size_t WS_LOGITS = 10 * MiB;
constexpr size_t WS_WIN = 18 * MiB;
constexpr size_t WS_WBR = WS_WIN + 8960ull * 1024 * 2;
constexpr size_t WS_WOUT = WS_WBR + 3ull * 1024 * 512 * 2;
constexpr size_t WS_WPG = WS_WOUT + 1024ull * 1024 * 2;
constexpr size_t WS_WPP = WS_WPG + 1024ull * 1024 * 2;
constexpr size_t WS_WR = WS_WPP + 1024ull * 256 * 2;
static_assert(WS_WR + 256ull * 1024 * 2 <= 44 * MiB, "small weights");
constexpr size_t WS_XB = 44 * MiB;
constexpr size_t WS_QA0 = 108 * MiB;
constexpr size_t WS_YATT = WS_QA0;
constexpr size_t WS_OM = 140 * MiB;
constexpr size_t WS_YC = 172 * MiB;
constexpr size_t WS_CST = 204 * MiB;
constexpr size_t WS_B = 236 * MiB;
constexpr size_t WS_KA = WS_B, WS_QA1 = WS_B + 32 * MiB, WS_QA2 = WS_B + 64 * MiB, WS_VA = WS_B + 96 * MiB, WS_YG = WS_B + 128 * MiB, WS_QM = WS_B + 160 * MiB, WS_KM = WS_B + 192 * MiB, WS_VM = WS_B + 224 * MiB;
constexpr size_t WS_G0 = WS_B, WS_MERGED = WS_B + 192 * MiB;
constexpr size_t WS_WEXP = WS_B, WS_HB = WS_B + 48 * MiB, WS_PBF = WS_B + 88 * MiB, WS_PE = WS_B + 104 * MiB, WS_YB1 = WS_B + 168 * MiB, WS_XBT = WS_B;
constexpr size_t WS_END = 492 * MiB;
constexpr size_t TAB_CNT = 0;
constexpr size_t TAB_META = 65536;
constexpr size_t TAB_MLOC = 131072, TAB_GTOT = 131072 + 4096, TAB_MST = 131072 + 8192;

constexpr int RING_BYTES = 131072;
constexpr int MISC_OFF = 155648;
constexpr int LDS_BYTES = 156672;

__device__ __forceinline__ unsigned f2bf(float f) { unsigned u = __builtin_bit_cast(unsigned, f); return (u + 0x7fffu + ((u >> 16) & 1u)) >> 16; }
__device__ __forceinline__ unsigned pk2(float lo, float hi) { return f2bf(lo) | (f2bf(hi) << 16); }
__device__ __forceinline__ unsigned cvt_pk_bf16(float lo, float hi) { unsigned r; asm volatile("v_cvt_pk_bf16_f32 %0, %1, %2" : "=v"(r) : "v"(lo), "v"(hi)); return r; }
__device__ __forceinline__ float bf_lo(unsigned w) { return __builtin_bit_cast(float, w << 16); }
__device__ __forceinline__ float bf_hi(unsigned w) { return __builtin_bit_cast(float, w & 0xffff0000u); }
__device__ __forceinline__ float bf1(bf16_t h) { return __builtin_bit_cast(float, ((unsigned)h) << 16); }
__device__ __forceinline__ float sigmoidf_(float v) { return __builtin_amdgcn_rcpf(1.0f + __expf(-v)); }
__device__ __forceinline__ float siluf_(float v) { return v * __builtin_amdgcn_rcpf(1.0f + __expf(-v)); }
__device__ __forceinline__ float wave_sum(float v) {
#pragma unroll
    for (int o = 1; o < 64; o <<= 1) v += __shfl_xor(v, o);
    return v;
}
__device__ __forceinline__ float wave_max(float v) {
#pragma unroll
    for (int o = 1; o < 64; o <<= 1) v = fmaxf(v, __shfl_xor(v, o));
    return v;
}
__device__ __forceinline__ int lane_id_() { int l; asm volatile("v_mbcnt_lo_u32_b32 %0, -1, 0\n\tv_mbcnt_hi_u32_b32 %0, -1, %0" : "=&v"(l)); return l; }
#define LDS_WAIT() asm volatile("s_waitcnt lgkmcnt(0)" ::: "memory")
#define VM_WAIT() asm volatile("s_waitcnt vmcnt(0)" ::: "memory")

#define XB_TMO      128
#define XB_XCNT(j)  (256  + 64 * (j))
#define XB_XSUB(j)  (1280 + 64 * (j))
#define XB_XGEN(j)  (2304 + 64 * (j))
#define XB_TOP      3328
#define XB_TOPGEN   3392
#define XCD_BAR_WORDS 3456
#define XB_SPIN_CAP (1u << 22)
__device__ __forceinline__ unsigned xb_ld(unsigned* p)              { return __hip_atomic_load(p, __ATOMIC_RELAXED, __HIP_MEMORY_SCOPE_AGENT); }
__device__ __forceinline__ unsigned xb_add(unsigned* p, unsigned v) { return __hip_atomic_fetch_add(p, v, __ATOMIC_RELAXED, __HIP_MEMORY_SCOPE_AGENT); }
__device__ __forceinline__ unsigned xb_xcc_id() { return (unsigned)__builtin_amdgcn_s_getreg((3 << 11) | 20) & 0xFu; }
#define XB_SPIN(cond, bar) do { unsigned _sp = 0; while (cond) { __builtin_amdgcn_s_sleep(1); \
    if ((++_sp & 255u) == 0u) { if (xb_ld(&(bar)[XB_TMO])) break; if (_sp > XB_SPIN_CAP) { atomicAdd(&(bar)[XB_TMO], 1u); break; } } } } while (0)
struct XcdBarrier { unsigned* bar; unsigned x; volatile LAS unsigned* st; int wave; };
__device__ __forceinline__ XcdBarrier xcd_barrier_post(unsigned* bar, volatile LAS unsigned* st, int wave) {
    XcdBarrier b; b.bar = bar; b.x = xb_xcc_id(); b.st = st; b.wave = wave;
    if (wave == 0 && lane_id_() == 0) (void)xb_add(&bar[XB_XCNT(b.x)], 1u);
    return b;
}
__device__ __forceinline__ void xcd_barrier_complete(unsigned* bar, unsigned x, unsigned& nloc, unsigned& nx) {
    const unsigned G = gridDim.x * gridDim.y * gridDim.z;
    unsigned sum, cnt, mine, sp = 0u;
    for (;;) {
        sum = 0u; cnt = 0u; mine = 0u;
#pragma unroll
        for (unsigned j = 0; j < 16; ++j) { const unsigned c = xb_ld(&bar[XB_XCNT(j)]); sum += c; cnt += (c > 0u) ? 1u : 0u; mine = (j == x) ? c : mine; }
        if (sum == G) break;
        __builtin_amdgcn_s_sleep(1);
        if ((++sp & 255u) == 0u) { if (xb_ld(&bar[XB_TMO])) break; if (sp > XB_SPIN_CAP) { atomicAdd(&bar[XB_TMO], 1u); break; } }
    }
    nloc = mine > 0u ? mine : 1u; nx = cnt > 0u ? cnt : 1u;
}
__device__ __forceinline__ void xcd_barrier(const XcdBarrier& b) {
    asm volatile("s_waitcnt vmcnt(0)" ::: "memory");
    __syncthreads();
    if (b.wave == 0 && lane_id_() == 0) {
        unsigned* bar = b.bar;
        __builtin_amdgcn_s_waitcnt(0);
        unsigned nloc = b.st[0], nx = b.st[1];
        if (nloc == 0u) { xcd_barrier_complete(bar, b.x, nloc, nx); b.st[0] = nloc; b.st[1] = nx; }
        const unsigned old = xb_add(&bar[XB_XSUB(b.x)], 1u);
        const unsigned gen = old / nloc;
        if (old + 1u == (gen + 1u) * nloc) {
            __builtin_amdgcn_fence(__ATOMIC_RELEASE, "agent");
            asm volatile("s_waitcnt vmcnt(0)" ::: "memory");
            const unsigned og = xb_add(&bar[XB_TOP], 1u);
            const unsigned tg = og / nx;
            if (og + 1u == (tg + 1u) * nx) xb_add(&bar[XB_TOPGEN], 1u);
            else XB_SPIN(xb_ld(&bar[XB_TOPGEN]) == tg, bar);
            __builtin_amdgcn_fence(__ATOMIC_ACQUIRE, "agent");
            xb_add(&bar[XB_XGEN(b.x)], 1u);
            asm volatile("s_waitcnt vmcnt(0)" ::: "memory");
        } else {
            XB_SPIN(xb_ld(&bar[XB_XGEN(b.x)]) == gen, bar);
            __builtin_amdgcn_fence(__ATOMIC_ACQUIRE, "agent");
            asm volatile("s_waitcnt vmcnt(0)" ::: "memory");
        }
    }
    __syncthreads();
}

namespace pg8 {
constexpr int BM = 256, BK = 64, HALF = 128, HTB = HALF * BK * 2, NXCD = 8, WGM = 8;
__device__ __forceinline__ int lds_byte(int r, int c) { const int st = (r >> 4) * 2 + (c >> 5), rr = r & 15, cc = c & 31, ob = rr * 64 + cc * 2; return st * 1024 + (ob ^ (((ob >> 9) & 1) << 5)); }
__device__ __forceinline__ void stage_rc(int b, int& R, int& C) { const int st = b / 1024, sb = b % 1024, swz = sb ^ (((sb >> 9) & 1) << 5); R = (st >> 1) * 16 + swz / 64; C = (st & 1) * 32 + (swz % 64) / 2; }
__device__ __forceinline__ int perm32(int rho) { const int n = rho >> 4, i = rho & 15; return 8 * (i >> 2) + 4 * n + (i & 3); }

struct GUnit { const char* A; const char* B; int pm, pn, a0, a1; };

__device__ __forceinline__ void tile_order(int L, int nM, int nN, int& pm, int& pn) {
    const int nwg = nM * nN; int wgid = L;
    { const int q = nwg / NXCD, r = nwg % NXCD, xcd = wgid % NXCD, off = wgid / NXCD; wgid = (xcd < r ? xcd * (q + 1) : r * (q + 1) + (xcd - r) * q) + off; }
    const int nig = WGM * nN, gid = wgid / nig, fm = gid * WGM, gsz = (nM - fm) < WGM ? (nM - fm) : WGM;
    pm = fm + ((wgid % nig) % gsz); pn = (wgid % nig) / gsz;
}

typedef f32x4 Acc[2][2][4][2];

template <class P>
__device__ __forceinline__ void gemm_phase(LAS unsigned char* lds, const P& S, int tid) {
    asm volatile("" : "+v"(tid));
    const int wid = __builtin_amdgcn_readfirstlane(tid >> 6), lane = tid & 63, wr = wid >> 2, wc = wid & 3, fr = lane & 15, fq = lane >> 4;
    constexpr int K = P::K, nt = K / BK;
    static_assert(nt >= 4 && (nt % 2) == 0, "K multiple of 128, >= 256");
    unsigned voffB[2];
#pragma unroll
    for (int i = 0; i < 2; ++i) { int R, C; stage_rc(tid * 16 + i * 8192, R, C); const int Rb = (R & ~31) + perm32(R & 31); voffB[i] = (unsigned)(Rb * K + C) * 2u; }
    constexpr size_t kstep = (size_t)(BK * 2);
    constexpr size_t hstepB = (size_t)HALF * K * 2;
    const unsigned ldsw = (unsigned)wid * 1024u;
    const int aoff = lds_byte(wr * 64 + fr, fq * 8), boff = lds_byte(wc * 32 + fr, fq * 8);
#define PG8_SA(b, h) (((b) * 2 + (h)) * HTB)
#define PG8_SB(b, h) ((4 + (b) * 2 + (h)) * HTB)
#define PG8_STAGE(bufoff, gbase, voff) do { _Pragma("unroll") for (int _i = 0; _i < 2; ++_i) \
        __builtin_amdgcn_global_load_lds((const unsigned*)((const char*)(gbase) + (voff)[_i]), (LAS unsigned*)(lds + (bufoff) + ldsw + _i * 8192), 16, 0, 0); } while (0)
#define PG8_LDA(dst, b, h) do { _Pragma("unroll") for (int m = 0; m < 4; ++m) _Pragma("unroll") for (int k = 0; k < 2; ++k) dst[m][k] = *(const LAS bf16x8*)(lds + PG8_SA(b, h) + aoff + m * 2048 + k * 1024); } while (0)
#define PG8_LDB(dst, b, h) do { _Pragma("unroll") for (int n = 0; n < 2; ++n) _Pragma("unroll") for (int k = 0; k < 2; ++k) dst[n][k] = *(const LAS bf16x8*)(lds + PG8_SB(b, h) + boff + n * 2048 + k * 1024); } while (0)
#define PG8_MMA(ai, bj, At, Bt) do { __builtin_amdgcn_s_setprio(1); _Pragma("unroll") for (int m = 0; m < 4; ++m) _Pragma("unroll") for (int n = 0; n < 2; ++n) _Pragma("unroll") for (int k = 0; k < 2; ++k) \
        acc[ai][bj][m][n] = __builtin_amdgcn_mfma_f32_16x16x32_bf16(Bt[n][k], At[m][k], acc[ai][bj][m][n], 0, 0, 0); __builtin_amdgcn_s_setprio(0); } while (0)
#define PG8_WAIT_V(n) asm volatile("s_waitcnt vmcnt(" #n ")" ::: "memory")
#define PG8_WAIT_L(n) asm volatile("s_waitcnt lgkmcnt(" #n ")" ::: "memory")
#define PG8_BAR __builtin_amdgcn_s_barrier()
#define PG8_SCHED __builtin_amdgcn_sched_barrier(0)
#define PG8_VOA(dst, u) do { _Pragma("unroll") for (int _h = 0; _h < 2; ++_h) _Pragma("unroll") for (int _i = 0; _i < 2; ++_i) { int _R, _C; stage_rc(tid * 16 + _i * 8192, _R, _C); \
        if constexpr (P::GATHER) dst[_h][_i] = (S.arow(u, _h * HALF + _R) * (unsigned)K + (unsigned)_C) * 2u; \
        else dst[_h][_i] = (unsigned)((_h * HALF + _R) * K + _C) * 2u; } } while (0)
    GUnit cur, nxt; int ui = 0;
    if (!S.next(0, cur)) return;
    Acc acc;
#pragma unroll
    for (int a = 0; a < 2; ++a)
#pragma unroll
        for (int b = 0; b < 2; ++b)
#pragma unroll
            for (int m = 0; m < 4; ++m)
#pragma unroll
                for (int n = 0; n < 2; ++n) acc[a][b][m][n] = (f32x4){0.f, 0.f, 0.f, 0.f};
    bf16x8 At[4][2], B0[2][2], B1[2][2];
    unsigned voA[2][2], voAn[2][2];
    PG8_VOA(voA, cur);
    const char* cA = cur.A; const char* cB = cur.B;
    PG8_STAGE(PG8_SB(0, 0), cB, voffB); PG8_STAGE(PG8_SB(0, 1), cB + hstepB, voffB); PG8_STAGE(PG8_SA(0, 0), cA, voA[0]); PG8_STAGE(PG8_SA(0, 1), cA, voA[1]);
    if (wr == 1) PG8_BAR;
    PG8_WAIT_V(2); PG8_BAR;
    PG8_STAGE(PG8_SB(1, 0), cB + kstep, voffB); PG8_STAGE(PG8_SA(1, 0), cA + kstep, voA[0]); PG8_STAGE(PG8_SB(1, 1), cB + hstepB + kstep, voffB);
    PG8_WAIT_V(6); PG8_BAR;
    for (;;) {
        const bool has_next = S.next(ui + 1, nxt);
        const char* nA = has_next ? nxt.A : cA; const char* nB = has_next ? nxt.B : cB;
        if constexpr (P::GATHER) {
            if (has_next) { PG8_VOA(voAn, nxt); }
            else {
#pragma unroll
                for (int h = 0; h < 2; ++h)
#pragma unroll
                    for (int i = 0; i < 2; ++i) voAn[h][i] = voA[h][i];
            }
        }
#pragma unroll 1
        for (int t = 0; t < nt; t += 2) {
            const bool last = (t == nt - 2);
            const char* a1 = cA + (size_t)(t + 1) * kstep;
            const char* a2 = last ? nA : cA + (size_t)(t + 2) * kstep; const char* b2 = last ? nB : cB + (size_t)(t + 2) * kstep;
            const char* a3 = a2 + kstep; const char* b3 = b2 + kstep;
            unsigned s0[2], s1[2];
#pragma unroll
            for (int i = 0; i < 2; ++i) {
                if constexpr (P::GATHER) { s0[i] = last ? voAn[0][i] : voA[0][i]; s1[i] = last ? voAn[1][i] : voA[1][i]; }
                else { s0[i] = voA[0][i]; s1[i] = voA[1][i]; }
            }
            PG8_LDB(B0, 0, 0); PG8_LDB(B1, 0, 1); PG8_SCHED; PG8_LDA(At, 0, 0); PG8_STAGE(PG8_SA(1, 1), a1, voA[1]);
            PG8_WAIT_V(8); PG8_WAIT_L(0); PG8_BAR; PG8_MMA(0, 0, At, B0); PG8_MMA(0, 1, At, B1); PG8_BAR; PG8_SCHED;
            PG8_LDA(At, 0, 1); PG8_STAGE(PG8_SB(0, 0), b2, voffB); PG8_STAGE(PG8_SB(0, 1), b2 + hstepB, voffB); PG8_STAGE(PG8_SA(0, 0), a2, s0);
            PG8_WAIT_V(8); PG8_WAIT_L(0); PG8_BAR; PG8_MMA(1, 0, At, B0); PG8_MMA(1, 1, At, B1); PG8_BAR; PG8_SCHED;
            PG8_LDB(B0, 1, 0); PG8_LDB(B1, 1, 1); PG8_SCHED; PG8_LDA(At, 1, 0); PG8_STAGE(PG8_SA(0, 1), a2, s1);
            PG8_WAIT_V(8); PG8_WAIT_L(0); PG8_BAR; PG8_MMA(0, 0, At, B0); PG8_MMA(0, 1, At, B1); PG8_BAR; PG8_SCHED;
            PG8_LDA(At, 1, 1); PG8_STAGE(PG8_SB(1, 0), b3, voffB); PG8_STAGE(PG8_SB(1, 1), b3 + hstepB, voffB); PG8_STAGE(PG8_SA(1, 0), a3, s0);
            PG8_WAIT_V(8); PG8_WAIT_L(0); PG8_BAR; PG8_MMA(1, 0, At, B0); PG8_MMA(1, 1, At, B1); PG8_BAR; PG8_SCHED;
        }
        if (wr == 0) PG8_BAR;
        const bool zero = S.epi(acc, cur, wr, wc, fr, fq);
        if (!has_next) break;
        if (zero) {
#pragma unroll
            for (int a = 0; a < 2; ++a)
#pragma unroll
                for (int b = 0; b < 2; ++b)
#pragma unroll
                    for (int m = 0; m < 4; ++m)
#pragma unroll
                        for (int n = 0; n < 2; ++n) acc[a][b][m][n] = (f32x4){0.f, 0.f, 0.f, 0.f};
        }
        cur = nxt; cA = nA; cB = nB; ++ui;
        if constexpr (P::GATHER) {
#pragma unroll
            for (int h = 0; h < 2; ++h)
#pragma unroll
                for (int i = 0; i < 2; ++i) voA[h][i] = voAn[h][i];
        }
        if (wr == 1) PG8_BAR;
    }
    PG8_WAIT_V(0);
    PG8_BAR;
#undef PG8_SA
#undef PG8_SB
#undef PG8_STAGE
#undef PG8_LDA
#undef PG8_LDB
#undef PG8_MMA
#undef PG8_WAIT_V
#undef PG8_WAIT_L
#undef PG8_BAR
#undef PG8_SCHED
#undef PG8_VOA
}
}
using pg8::GUnit; using pg8::Acc;

__device__ __forceinline__ float row_rs(const float* SS, int row) {
    const f32x4* p = (const f32x4*)(SS + (size_t)row * 16);
    const f32x4 a = p[0], b = p[1], c = p[2], d = p[3];
    const float s = (((a.x + a.y) + (a.z + a.w)) + ((b.x + b.y) + (b.z + b.w))) + (((c.x + c.y) + (c.z + c.w)) + ((d.x + d.y) + (d.z + d.w)));
    return rsqrtf(s * (1.0f / 1024.0f) + EPS);
}
#define PIN1(a) asm volatile("" : "+v"(a))
#define PIN2(a, b) asm volatile("" : "+v"(a), "+v"(b))
#define PIN4(a, b, c, d) asm volatile("" : "+v"(a), "+v"(b), "+v"(c), "+v"(d))
#define PIN8(a, b, c, d, e, f, g, h) asm volatile("" : "+v"(a), "+v"(b), "+v"(c), "+v"(d), "+v"(e), "+v"(f), "+v"(g), "+v"(h))
__device__ __forceinline__ void row_rs8(const float* SS, int row0, float (&rs)[8]) {
#pragma unroll
    for (int hh = 0; hh < 4; ++hh) { f32x4 a[2], b[2], c[2], d[2];
#pragma unroll
        for (int g = 0; g < 2; ++g) { const f32x4* p = (const f32x4*)(SS + (size_t)(row0 + (hh >> 1) * 128 + ((hh & 1) * 2 + g) * 16) * 16); a[g] = p[0]; b[g] = p[1]; c[g] = p[2]; d[g] = p[3]; }
#pragma unroll
        for (int g = 0; g < 2; ++g) { const f32x4 t = (a[g] + b[g]) + (c[g] + d[g]); rs[hh * 2 + g] = rsqrtf(((t.x + t.y) + (t.z + t.w)) * (1.0f / 1024.0f) + EPS); }
        PIN2(rs[hh * 2], rs[hh * 2 + 1]); }
}
__device__ __forceinline__ u32x4 pack8(const f32x4 v0, const f32x4 v1) { u32x4 w; w.x = cvt_pk_bf16(v0[0], v0[1]); w.y = cvt_pk_bf16(v0[2], v0[3]); w.z = cvt_pk_bf16(v1[0], v1[1]); w.w = cvt_pk_bf16(v1[2], v1[3]); return w; }
__device__ __forceinline__ void unpack8(const u32x4 w, f32x4& v0, f32x4& v1) { v0 = (f32x4){bf_lo(w.x), bf_hi(w.x), bf_lo(w.y), bf_hi(w.y)}; v1 = (f32x4){bf_lo(w.z), bf_hi(w.z), bf_lo(w.w), bf_hi(w.w)}; }
__device__ __forceinline__ f32x4 sig4(const f32x4 v) { return (f32x4){sigmoidf_(v[0]), sigmoidf_(v[1]), sigmoidf_(v[2]), sigmoidf_(v[3])}; }
__device__ __forceinline__ f32x4 gate4(const f32x4 v) { f32x4 s = sig4(v); return (f32x4){fmaxf(s[0], 1e-6f), fmaxf(s[1], 1e-6f), fmaxf(s[2], 1e-6f), fmaxf(s[3], 1e-6f)}; }

struct PhProj {
    static constexpr int K = 1024; static constexpr bool GATHER = false;
    const char* xb; const char* W; const float* SS; unsigned char* ws; int G, c;
    __device__ __forceinline__ bool next(int i, GUnit& u) const {
        const long L = (long)i * G + c; if (L >= 128 * 23) return false;
        pg8::tile_order((int)L, 128, 23, u.pm, u.pn);
        u.A = xb + (size_t)u.pm * 256 * K * 2; u.B = W + (size_t)u.pn * 256 * K * 2; u.a0 = 0; u.a1 = 0; return true;
    }
    __device__ __forceinline__ unsigned arow(const GUnit&, int) const { return 0u; }
    __device__ __forceinline__ bool epi(Acc& acc, const GUnit& u, int wr, int wc, int fr, int fq) const {
        const int pn = u.pn; const int row0 = u.pm * 256 + wr * 64 + fr;
        float rs8[8]; row_rs8(SS, row0, rs8);
        if (pn == 22) {
            if (wc == 0 && fq == 0) {
                float* IFp = (float*)(ws + WS_IF);
#pragma unroll
                for (int ai = 0; ai < 2; ++ai)
#pragma unroll
                    for (int m = 0; m < 4; ++m) { const int row = row0 + ai * 128 + m * 16; const float rs = rs8[ai * 4 + m];
                        *(f32x4*)(IFp + (size_t)row * 8) = acc[ai][0][m][0] * rs; *(f32x4*)(IFp + (size_t)row * 8 + 4) = acc[ai][0][m][1] * rs; }
            }
            return true;
        }
        if (pn >= 10 && pn < 14) {
            bf16_t* Y = (bf16_t*)(ws + WS_YG);
#pragma unroll
            for (int ai = 0; ai < 2; ++ai)
#pragma unroll
                for (int m = 0; m < 4; ++m) { const int row = row0 + ai * 128 + m * 16; const float rs = rs8[ai * 4 + m];
#pragma unroll
                    for (int bj = 0; bj < 2; ++bj) { const f32x4 a = acc[ai][bj][m][0] * rs, g = sig4(acc[ai][bj][m][1] * rs), y = a * g;
                        u32x2 w; w.x = cvt_pk_bf16(y[0], y[1]); w.y = cvt_pk_bf16(y[2], y[3]);
                        *(u32x2*)(Y + (size_t)row * 512 + (pn - 10) * 128 + bj * 64 + wc * 16 + fq * 4) = w; } }
            return true;
        }
        bf16_t* dst; int col0; bool sg = false;
        if (pn < 6) { dst = (bf16_t*)(ws + (pn < 2 ? WS_QA0 : (pn < 4 ? WS_QA1 : WS_QA2))); col0 = (pn & 1) * 256; }
        else if (pn < 8) { dst = (bf16_t*)(ws + WS_KA); col0 = (pn - 6) * 256; }
        else if (pn < 10) { dst = (bf16_t*)(ws + WS_VA); col0 = (pn - 8) * 256; }
        else if (pn < 16) { dst = (bf16_t*)(ws + WS_QM); col0 = (pn - 14) * 256; }
        else if (pn < 18) { dst = (bf16_t*)(ws + WS_KM); col0 = (pn - 16) * 256; }
        else if (pn < 20) { dst = (bf16_t*)(ws + WS_VM); col0 = (pn - 18) * 256; }
        else { dst = (bf16_t*)(ws + WS_OM); col0 = (pn - 20) * 256; sg = true; }
        col0 += wc * 32 + fq * 8;
#pragma unroll
        for (int ai = 0; ai < 2; ++ai)
#pragma unroll
            for (int m = 0; m < 4; ++m) { const int row = row0 + ai * 128 + m * 16; const float rs = rs8[ai * 4 + m];
#pragma unroll
                for (int bj = 0; bj < 2; ++bj) { f32x4 v0 = acc[ai][bj][m][0] * rs, v1 = acc[ai][bj][m][1] * rs;
                    if (sg) { v0 = sig4(v0); v1 = sig4(v1); }
                    *(u32x4*)(dst + (size_t)row * 512 + col0 + bj * 128) = pack8(v0, v1); } }
        return true;
    }
};
struct PhGates {
    static constexpr int K = 1024; static constexpr bool GATHER = false;
    const char* xb; const char* W; const float* SS; unsigned char* ws; int G, c;
    __device__ __forceinline__ bool next(int i, GUnit& u) const {
        const long L = (long)i * G + c; if (L >= 128 * 12) return false;
        pg8::tile_order((int)L, 128, 12, u.pm, u.pn);
        u.A = xb + (size_t)u.pm * 256 * K * 2; u.B = W + (size_t)(5888 + u.pn * 256) * K * 2; u.a0 = 0; u.a1 = 0; return true;
    }
    __device__ __forceinline__ unsigned arow(const GUnit&, int) const { return 0u; }
    __device__ __forceinline__ bool epi(Acc& acc, const GUnit& u, int wr, int wc, int fr, int fq) const {
        const int row0 = u.pm * 256 + wr * 64 + fr;
        float rs8[8]; row_rs8(SS, row0, rs8);
        bf16_t* dst = (bf16_t*)(ws + WS_G0 + (size_t)(u.pn >> 2) * 64 * MiB); const int col0 = (u.pn & 3) * 256 + wc * 32 + fq * 8;
#pragma unroll
        for (int ai = 0; ai < 2; ++ai)
#pragma unroll
            for (int m = 0; m < 4; ++m) { const int row = row0 + ai * 128 + m * 16; const float rs = rs8[ai * 4 + m];
#pragma unroll
                for (int bj = 0; bj < 2; ++bj) *(u32x4*)(dst + (size_t)row * 1024 + col0 + bj * 128) = pack8(gate4(acc[ai][bj][m][0] * rs), gate4(acc[ai][bj][m][1] * rs)); }
        return true;
    }
};
struct PhMerge {
    static constexpr int K = 512; static constexpr bool GATHER = false;
    unsigned char* ws; int G, c;
    __device__ __forceinline__ bool next(int i, GUnit& u) const {
        const int ti = i / 3, seg = i - ti * 3; const long L = (long)ti * G + c; if (L >= 128 * 4) return false;
        pg8::tile_order((int)L, 128, 4, u.pm, u.pn);
        const size_t ya = seg == 0 ? WS_YATT : (seg == 1 ? WS_YC : WS_OM);
        u.A = (const char*)ws + ya + (size_t)u.pm * 256 * K * 2; u.B = (const char*)ws + WS_WBR + (size_t)seg * 1024 * 512 * 2 + (size_t)u.pn * 256 * K * 2; u.a0 = seg; u.a1 = 0; return true;
    }
    __device__ __forceinline__ unsigned arow(const GUnit&, int) const { return 0u; }
    __device__ __forceinline__ bool epi(Acc& acc, const GUnit& u, int wr, int wc, int fr, int fq) const {
        const int seg = u.a0; const int row0 = u.pm * 256 + wr * 64 + fr; const int col0 = u.pn * 256 + wc * 32 + fq * 8;
        const bf16_t* Gn = (const bf16_t*)(ws + WS_G0 + (size_t)seg * 64 * MiB);
        const bf16_t* Gd = (const bf16_t*)(ws + WS_G0 + (size_t)(seg < 2 ? seg + 1 : seg) * 64 * MiB);
        bf16_t* Mo = (bf16_t*)(ws + WS_MERGED);
#pragma unroll
        for (int ai = 0; ai < 2; ++ai)
#pragma unroll
            for (int mp = 0; mp < 2; ++mp) {
                u32x4 gn[2][2], gd[2][2];
#pragma unroll
                for (int mm = 0; mm < 2; ++mm)
#pragma unroll
                    for (int bj = 0; bj < 2; ++bj) { const size_t off = (size_t)(row0 + ai * 128 + (2 * mp + mm) * 16) * 1024 + col0 + bj * 128; gn[mm][bj] = *(const u32x4*)(Gn + off); gd[mm][bj] = *(const u32x4*)(Gd + off); }
                PIN8(gn[0][0], gn[0][1], gn[1][0], gn[1][1], gd[0][0], gd[0][1], gd[1][0], gd[1][1]);
#pragma unroll
                for (int mm = 0; mm < 2; ++mm)
#pragma unroll
                    for (int bj = 0; bj < 2; ++bj) { const int m = 2 * mp + mm; const size_t off = (size_t)(row0 + ai * 128 + m * 16) * 1024 + col0 + bj * 128;
                        f32x4 n0, n1, d0, d1; unpack8(gn[mm][bj], n0, n1); unpack8(gd[mm][bj], d0, d1);
                        if (seg < 2) {
#pragma unroll
                            for (int j = 0; j < 4; ++j) { acc[ai][bj][m][0][j] *= n0[j] * __builtin_amdgcn_rcpf(d0[j]); acc[ai][bj][m][1][j] *= n1[j] * __builtin_amdgcn_rcpf(d1[j]); } }
                        else *(u32x4*)(Mo + off) = pack8(acc[ai][bj][m][0] * n0, acc[ai][bj][m][1] * n1); }
            }
        return seg == 2;
    }
};
__device__ __forceinline__ float store_x8(bf16_t* xbp, const f32x4 v0, const f32x4 v1) {
    *(u32x4*)xbp = pack8(v0, v1);
    return ((v0[0] * v0[0] + v0[1] * v0[1]) + (v0[2] * v0[2] + v0[3] * v0[3])) + ((v1[0] * v1[0] + v1[1] * v1[1]) + (v1[2] * v1[2] + v1[3] * v1[3]));
}
struct PhOut {
    static constexpr int K = 1024; static constexpr bool GATHER = false;
    unsigned char* ws; float* SSo; int G, c;
    __device__ __forceinline__ bool next(int i, GUnit& u) const {
        const long L = (long)i * G + c; if (L >= 128 * 4) return false;
        pg8::tile_order((int)L, 128, 4, u.pm, u.pn);
        u.A = (const char*)ws + WS_MERGED + (size_t)u.pm * 256 * K * 2; u.B = (const char*)ws + WS_WOUT + (size_t)u.pn * 256 * K * 2; u.a0 = 0; u.a1 = 0; return true;
    }
    __device__ __forceinline__ unsigned arow(const GUnit&, int) const { return 0u; }
    __device__ __forceinline__ bool epi(Acc& acc, const GUnit& u, int wr, int wc, int fr, int fq) const {
        const int row0 = u.pm * 256 + wr * 64 + fr; const int col0 = u.pn * 256 + wc * 32 + fq * 8; bf16_t* XB = (bf16_t*)(ws + WS_XB);
#pragma unroll
        for (int ai = 0; ai < 2; ++ai) {
            u32x4 xr[4][2];
#pragma unroll
            for (int m = 0; m < 4; ++m)
#pragma unroll
                for (int bj = 0; bj < 2; ++bj) xr[m][bj] = *(const u32x4*)(XB + (size_t)(row0 + ai * 128 + m * 16) * 1024 + col0 + bj * 128);
            PIN8(xr[0][0], xr[0][1], xr[1][0], xr[1][1], xr[2][0], xr[2][1], xr[3][0], xr[3][1]);
#pragma unroll
            for (int m = 0; m < 4; ++m) { const int row = row0 + ai * 128 + m * 16; const size_t off = (size_t)row * 1024 + col0; float ss = 0.f;
#pragma unroll
                for (int bj = 0; bj < 2; ++bj) { f32x4 x0, x1; unpack8(xr[m][bj], x0, x1); ss += store_x8(XB + off + bj * 128, x0 + acc[ai][bj][m][0], x1 + acc[ai][bj][m][1]); }
                ss += __shfl_xor(ss, 16); ss += __shfl_xor(ss, 32);
                if (fq == 0) SSo[(size_t)row * 16 + u.pn * 4 + wc] = ss; } }
        return true;
    }
};
struct PhRouter {
    static constexpr int K = 1024; static constexpr bool GATHER = false;
    unsigned char* ws; const float* SS; int G, c;
    __device__ __forceinline__ bool next(int i, GUnit& u) const {
        const long L = (long)i * G + c; if (L >= 128) return false;
        u.pm = (int)L; u.pn = 0; u.A = (const char*)ws + WS_XB + (size_t)u.pm * 256 * K * 2; u.B = (const char*)ws + WS_WR; u.a0 = 0; u.a1 = 0; return true;
    }
    __device__ __forceinline__ unsigned arow(const GUnit&, int) const { return 0u; }
    __device__ __forceinline__ bool epi(Acc& acc, const GUnit& u, int wr, int wc, int fr, int fq) const {
        if (wc < 2) { float* Lg = (float*)(ws + WS_LOGITS); const int row0 = u.pm * 256 + wr * 64 + fr;
            float rs8[8]; row_rs8(SS, row0, rs8);
#pragma unroll
            for (int ai = 0; ai < 2; ++ai)
#pragma unroll
                for (int m = 0; m < 4; ++m) { const int row = row0 + ai * 128 + m * 16; const float rs = rs8[ai * 4 + m]; float* p = Lg + (size_t)row * 64 + wc * 32 + fq * 8;
                    *(f32x4*)p = acc[ai][0][m][0] * rs; *(f32x4*)(p + 4) = acc[ai][0][m][1] * rs; } }
        return true;
    }
};
__device__ __forceinline__ int moe_expert_of(const int* META, int k, int rb) {
    const int r = rb * 256; int e = 0;
    for (int j = 1; j < 32; ++j) e += (META[16 + 64 * k + j] <= r) ? 1 : 0;
    return __builtin_amdgcn_readfirstlane(e);
}
struct PhUp {
    static constexpr int K = 1024; static constexpr bool GATHER = true;
    unsigned char* ws; const float* SS; const int* META; const int* tok; int G, c;
    __device__ __forceinline__ bool next(int i, GUnit& u) const {
        const int nb0 = __builtin_amdgcn_readfirstlane(META[0]), nb1 = __builtin_amdgcn_readfirstlane(META[1]); const long L = (long)i * G + c; if (L >= 2L * (nb0 + nb1)) return false;
        int blk = (int)(L >> 1); u.pn = (int)(L & 1); int k = 0; if (blk >= nb0) { k = 1; blk -= nb0; }
        const int e = moe_expert_of(META, k, blk);
        u.pm = blk; u.a0 = k; u.a1 = e; u.A = (const char*)ws + WS_XB; u.B = (const char*)ws + WS_WEXP + (size_t)e * 512 * 1024 * 2 + (size_t)u.pn * 256 * K * 2; return true;
    }
    __device__ __forceinline__ unsigned arow(const GUnit& u, int r) const { const int t = tok[u.a0 * LISTCAP + u.pm * 256 + r]; return t < 0 ? 0u : (unsigned)t; }
    __device__ __forceinline__ bool epi(Acc& acc, const GUnit& u, int wr, int wc, int fr, int fq) const {
        const int lr0 = u.a0 * LISTCAP + u.pm * 256 + wr * 64 + fr; bf16_t* HB = (bf16_t*)(ws + WS_HB);
        int tk[8]; float rs8[8];
#pragma unroll
        for (int g = 0; g < 8; ++g) tk[g] = tok[lr0 + (g >> 2) * 128 + (g & 3) * 16];
        PIN8(tk[0], tk[1], tk[2], tk[3], tk[4], tk[5], tk[6], tk[7]);
#pragma unroll
        for (int hh = 0; hh < 4; ++hh) { f32x4 a[2], b[2], c[2], d[2];
#pragma unroll
            for (int g = 0; g < 2; ++g) { const int t = tk[hh * 2 + g]; const f32x4* p = (const f32x4*)(SS + (size_t)(t < 0 ? 0 : t) * 16); a[g] = p[0]; b[g] = p[1]; c[g] = p[2]; d[g] = p[3]; }
#pragma unroll
            for (int g = 0; g < 2; ++g) { const f32x4 tt = (a[g] + b[g]) + (c[g] + d[g]); rs8[hh * 2 + g] = tk[hh * 2 + g] < 0 ? 0.f : rsqrtf(((tt.x + tt.y) + (tt.z + tt.w)) * (1.0f / 1024.0f) + EPS); }
            PIN2(rs8[hh * 2], rs8[hh * 2 + 1]); }
#pragma unroll
        for (int ai = 0; ai < 2; ++ai)
#pragma unroll
            for (int m = 0; m < 4; ++m) { const int lr = lr0 + ai * 128 + m * 16; const float rs = rs8[ai * 4 + m];
#pragma unroll
                for (int bj = 0; bj < 2; ++bj) { const f32x4 g = acc[ai][bj][m][0] * rs, uu = acc[ai][bj][m][1] * rs;
                    f32x4 h = (f32x4){siluf_(g[0]) * uu[0], siluf_(g[1]) * uu[1], siluf_(g[2]) * uu[2], siluf_(g[3]) * uu[3]}; if (ABL == 8) h = (f32x4){1.f, 1.f, 1.f, 1.f};
                    u32x2 w; w.x = cvt_pk_bf16(h[0], h[1]); w.y = cvt_pk_bf16(h[2], h[3]);
                    *(u32x2*)(HB + (size_t)lr * 256 + u.pn * 128 + bj * 64 + wc * 16 + fq * 4) = w; }
                asm volatile("" ::: "memory"); }
        return true;
    }
};
template <int KL> struct PhDown {
    static constexpr int K = 256; static constexpr bool GATHER = false;
    unsigned char* ws; float* SSo; const int* META; const int* tok; const float* wl; int G, c;
    __device__ __forceinline__ bool next(int i, GUnit& u) const {
        const int nb = __builtin_amdgcn_readfirstlane(META[KL]); const long L = (long)i * G + c;
        if (L < 4L * nb) { const int blk = (int)(L >> 2); u.pn = (int)(L & 3); const int e = moe_expert_of(META, KL, blk); u.pm = blk; u.a0 = 0; u.a1 = e;
            u.A = (const char*)ws + WS_HB + (size_t)(KL * LISTCAP + blk * 256) * 256 * 2; u.B = (const char*)ws + WS_WEXP + 32ull * 512 * 1024 * 2 + (size_t)e * 1024 * 256 * 2 + (size_t)u.pn * 256 * K * 2; return true; }
        if (KL == 1) { const long L2 = L - 4L * nb; if (L2 >= 128 * 4) return false;
            pg8::tile_order((int)L2, 128, 4, u.pm, u.pn); u.a0 = 1; u.a1 = 0;
            u.A = (const char*)ws + WS_PBF + (size_t)u.pm * 256 * K * 2; u.B = (const char*)ws + WS_WPP + (size_t)u.pn * 256 * K * 2; return true; }
        return false;
    }
    __device__ __forceinline__ unsigned arow(const GUnit&, int) const { return 0u; }
    __device__ __forceinline__ bool epi(Acc& acc, const GUnit& u, int wr, int wc, int fr, int fq) const {
        const int col0 = u.pn * 256 + wc * 32 + fq * 8;
        if (KL == 1 && u.a0 == 1) {
            bf16_t* PE = (bf16_t*)(ws + WS_PE); const int row0 = u.pm * 256 + wr * 64 + fr;
#pragma unroll
            for (int ai = 0; ai < 2; ++ai)
#pragma unroll
                for (int m = 0; m < 4; ++m)
#pragma unroll
                    for (int bj = 0; bj < 2; ++bj) *(u32x4*)(PE + (size_t)(row0 + ai * 128 + m * 16) * 1024 + col0 + bj * 128) = pack8(acc[ai][bj][m][0], acc[ai][bj][m][1]);
            return true;
        }
        const int lr0 = KL * LISTCAP + u.pm * 256 + wr * 64 + fr; bf16_t* YB = (bf16_t*)(ws + WS_YB1); bf16_t* XB = (bf16_t*)(ws + WS_XB);
        int tk[8]; float wk[8];
#pragma unroll
        for (int g = 0; g < 8; ++g) { const int lr = lr0 + (g >> 2) * 128 + (g & 3) * 16; tk[g] = tok[lr]; wk[g] = wl[lr]; }
        PIN8(tk[0], tk[1], tk[2], tk[3], tk[4], tk[5], tk[6], tk[7]); PIN8(wk[0], wk[1], wk[2], wk[3], wk[4], wk[5], wk[6], wk[7]);
#pragma unroll
        for (int ai = 0; ai < 2; ++ai)
#pragma unroll
            for (int m = 0; m < 4; ++m) { const int t = tk[ai * 4 + m]; const float w = wk[ai * 4 + m]; const size_t off = (size_t)(t < 0 ? 0 : t) * 1024 + col0;
                if (KL == 1) { if (t >= 0) {
#pragma unroll
                        for (int bj = 0; bj < 2; ++bj) *(u32x4*)(YB + off + bj * 128) = pack8(acc[ai][bj][m][0] * w, acc[ai][bj][m][1] * w); } }
                else { float ss = 0.f;
                    if (t >= 0) {
                        u32x4 xr[2], yr[2];
#pragma unroll
                        for (int bj = 0; bj < 2; ++bj) { xr[bj] = *(const u32x4*)(XB + off + bj * 128); yr[bj] = *(const u32x4*)(YB + off + bj * 128); }
                        PIN4(xr[0], xr[1], yr[0], yr[1]);
#pragma unroll
                        for (int bj = 0; bj < 2; ++bj) { f32x4 x0, x1, y0, y1; unpack8(xr[bj], x0, x1); unpack8(yr[bj], y0, y1);
                            ss += store_x8(XB + off + bj * 128, (x0 + y0) + acc[ai][bj][m][0] * w, (x1 + y1) + acc[ai][bj][m][1] * w); } }
                    ss += __shfl_xor(ss, 16); ss += __shfl_xor(ss, 32);
                    if (fq == 0 && t >= 0) SSo[(size_t)t * 16 + u.pn * 4 + wc] = ss; }
                if (m & 1) asm volatile("" ::: "memory"); }
        return true;
    }
};
struct PhPle {
    static constexpr int K = 1024; static constexpr bool GATHER = false;
    unsigned char* ws; const float* SSi; float* SSo; int G, c;
    __device__ __forceinline__ bool next(int i, GUnit& u) const {
        const long L = (long)i * G + c; if (L >= 128 * 4) return false;
        pg8::tile_order((int)L, 128, 4, u.pm, u.pn);
        u.A = (const char*)ws + WS_XB + (size_t)u.pm * 256 * K * 2; u.B = (const char*)ws + WS_WPG + (size_t)u.pn * 256 * K * 2; u.a0 = 0; u.a1 = 0; return true;
    }
    __device__ __forceinline__ unsigned arow(const GUnit&, int) const { return 0u; }
    __device__ __forceinline__ bool epi(Acc& acc, const GUnit& u, int wr, int wc, int fr, int fq) const {
        const int row0 = u.pm * 256 + wr * 64 + fr; const int col0 = u.pn * 256 + wc * 32 + fq * 8; bf16_t* XT = (bf16_t*)(ws + WS_XBT); const bf16_t* PE = (const bf16_t*)(ws + WS_PE); const bf16_t* XBc = (const bf16_t*)(ws + WS_XB);
        float rs8[8]; row_rs8(SSi, row0, rs8);
#pragma unroll
        for (int ai = 0; ai < 2; ++ai)
#pragma unroll
            for (int m = 0; m < 4; ++m) { const int row = row0 + ai * 128 + m * 16; const size_t off = (size_t)row * 1024 + col0; const float rs = rs8[ai * 4 + m]; float ss = 0.f;
                u32x4 xr[2], pr[2];
#pragma unroll
                for (int bj = 0; bj < 2; ++bj) { xr[bj] = *(const u32x4*)(XBc + off + bj * 128); pr[bj] = *(const u32x4*)(PE + off + bj * 128); }
                PIN4(xr[0], xr[1], pr[0], pr[1]);
#pragma unroll
                for (int bj = 0; bj < 2; ++bj) { f32x4 p0, p1, x0, x1; unpack8(pr[bj], p0, p1); unpack8(xr[bj], x0, x1);
                    ss += store_x8(XT + off + bj * 128, x0 + sig4(acc[ai][bj][m][0] * rs) * p0, x1 + sig4(acc[ai][bj][m][1] * rs) * p1); }
                ss += __shfl_xor(ss, 16); ss += __shfl_xor(ss, 32);
                if (fq == 0) SSo[(size_t)row * 16 + u.pn * 4 + wc] = ss; }
        return true;
    }
};

struct InPtrs { const float* const* p; __device__ __forceinline__ const float* operator[](int i) const { return (const float*)(GAS const float*)p[i]; } };
struct Ctx {
    InPtrs in; float* out; unsigned char* ws; LAS unsigned char* lds;
    int tid, lane, wave, G, bid;
};
enum { I_X = 0, I_P, I_GMIX, I_WIN, I_CONVW, I_CONVB, I_CLNG, I_CLNB, I_MCW, I_MCB, I_MIB, I_MFB, I_WBA, I_WBC, I_WBM, I_WOUT, I_GFFN, I_WRG, I_BRG, I_WRE, I_BRE,
       I_WEG, I_WEU, I_WED, I_GPLE, I_WPG, I_WPP, I_GFIN };

constexpr int TR_LDS = 64 * 65 * 4;
template <bool GAIN>
__device__ __forceinline__ void tr_item64(const float* colptr4, size_t pitch, const float* gainp, float cscale, bf16_t* dst, int K, int n0, int k0, LAS float* scr, int lane, const float* gain_or_valid) {
    const float* gain = GAIN ? gainp : nullptr;
    const int g = lane & 15, r = lane >> 4;
    f32x4 v[16]; float gs[16];
    const float* cp = colptr4 ? colptr4 : gain_or_valid;
#pragma unroll
    for (int i = 0; i < 16; ++i) { const int kk = 4 * i + r; v[i] = *(const f32x4*)(cp + (colptr4 ? (size_t)(k0 + kk) * pitch : 0)); gs[i] = gain ? gain[k0 + kk] : 1.0f; }
    PIN8(v[0], v[1], v[2], v[3], v[4], v[5], v[6], v[7]); PIN8(v[8], v[9], v[10], v[11], v[12], v[13], v[14], v[15]);
    const float zs = colptr4 ? cscale : 0.f;
#pragma unroll
    for (int i = 0; i < 16; ++i) { const int kk = 4 * i + r; const float m = gs[i] * zs; LAS float* p = scr + kk * 65 + 4 * g; p[0] = v[i].x * m; p[1] = v[i].y * m; p[2] = v[i].z * m; p[3] = v[i].w * m; }
    LDS_WAIT(); asm volatile("" ::: "memory");
    const int c = lane & 7, n8 = lane >> 3;
#pragma unroll
    for (int j = 0; j < 8; ++j) { const int n = n8 + 8 * j; const LAS float* sp = scr + (8 * c) * 65 + n;
        u32x4 o; o.x = pk2(sp[0 * 65], sp[1 * 65]); o.y = pk2(sp[2 * 65], sp[3 * 65]); o.z = pk2(sp[4 * 65], sp[5 * 65]); o.w = pk2(sp[6 * 65], sp[7 * 65]);
        *(u32x4*)(dst + (size_t)(n0 + n) * K + k0 + 8 * c) = o; }
    LDS_WAIT(); asm volatile("" ::: "memory");
}
__device__ __forceinline__ void phase_prep(const Ctx& F, int layer, float* SS) {
    const int gw = F.bid * NWAVES + F.wave, NGW = F.G * NWAVES, lane = F.lane;
    LAS float* scr = (LAS float*)(F.lds + F.wave * TR_LDS);
    bf16_t* XB = (bf16_t*)(F.ws + WS_XB);
    if (layer == 0) {
        for (int m0 = gw; m0 < T; m0 += 4 * NGW) {
            f32x4 v[4][4];
#pragma unroll
            for (int r = 0; r < 4; ++r) { const f32x4* xr = (const f32x4*)(F.in[I_X] + (size_t)(m0 + r * NGW) * D) + lane;
#pragma unroll
                for (int j = 0; j < 4; ++j) v[r][j] = xr[64 * j]; }
            PIN8(v[0][0], v[0][1], v[0][2], v[0][3], v[1][0], v[1][1], v[1][2], v[1][3]); PIN8(v[2][0], v[2][1], v[2][2], v[2][3], v[3][0], v[3][1], v[3][2], v[3][3]);
#pragma unroll
            for (int r = 0; r < 4; ++r) { const int m = m0 + r * NGW; u32x2* xbr = (u32x2*)(XB + (size_t)m * D) + lane; float sq = 0.f;
#pragma unroll
                for (int j = 0; j < 4; ++j) { const f32x4 x = v[r][j]; sq += (x.x * x.x + x.y * x.y) + (x.z * x.z + x.w * x.w); u32x2 w; w.x = cvt_pk_bf16(x.x, x.y); w.y = cvt_pk_bf16(x.z, x.w); xbr[64 * j] = w; }
                sq = wave_sum(sq);
                if (lane < 16) SS[(size_t)m * 16 + lane] = lane == 0 ? sq : 0.f; }
        }
    } else {
        const u32x4* src = (const u32x4*)(F.ws + WS_XBT); u32x4* dst = (u32x4*)(F.ws + WS_XB);
        const size_t n = (size_t)T * D * 2 / 16, st = (size_t)F.G * NTHREADS;
        for (size_t i0 = (size_t)F.bid * NTHREADS + F.tid; i0 < n; i0 += 8 * st) { u32x4 v[8];
#pragma unroll
            for (int k = 0; k < 8; ++k) { const size_t i = i0 + k * st; v[k] = src[i < n ? i : 0]; }
            PIN8(v[0], v[1], v[2], v[3], v[4], v[5], v[6], v[7]);
#pragma unroll
            for (int k = 0; k < 8; ++k) { const size_t i = i0 + k * st; if (i < n) dst[i] = v[k]; } }
    }
    const float* w_in = F.in[I_WIN] + (size_t)layer * D * D_IN; const float* g_mix = F.in[I_GMIX] + (size_t)layer * D;
    constexpr int N_WIN = 140 * 16, N_BR = 16 * 8, N_SQ = 16 * 16, N_PP = 16 * 4, N_R = 4 * 16;
    constexpr int NITEMS = N_WIN + 3 * N_BR + 2 * N_SQ + N_PP + N_R;
    const int g4 = 4 * (lane & 15);
    for (int it = gw; it < NITEMS; it += NGW) {
        int r = it;
        if (r < N_WIN) { const int nb = r >> 4, kb = r & 15; const int n = nb * 64 + g4; int src = -1; float cs = 1.f;
            if (n < 2560) { src = n; if (n < 1536) cs = 0.125f; }
            else if (n < 3584) { const int np = n - 2560, q8 = np >> 3, sg = (np >> 2) & 1; src = 2560 + sg * 512 + 4 * q8; }
            else if (n < 5640) src = n;
            else if (n < 5888) src = -1;
            else src = 5640 + (n - 5888);
            tr_item64<true>(src >= 0 ? w_in + src : nullptr, D_IN, g_mix, cs, (bf16_t*)(F.ws + WS_WIN), 1024, nb * 64, kb * 64, scr, lane, g_mix); continue; }
        r -= N_WIN;
        if (r < 3 * N_BR) { const int b = r / N_BR; r -= b * N_BR; const int nb = r >> 3, kb = r & 7; const int n = nb * 64 + g4;
            const float* w = (b == 0 ? F.in[I_WBA] : (b == 1 ? F.in[I_WBC] : F.in[I_WBM])) + (size_t)layer * 512 * 1024;
            tr_item64<false>(w + n, 1024, nullptr, 1.f, (bf16_t*)(F.ws + WS_WBR) + (size_t)b * 1024 * 512, 512, nb * 64, kb * 64, scr, lane, g_mix); continue; }
        r -= 3 * N_BR;
        if (r < 2 * N_SQ) { const int b = r / N_SQ; r -= b * N_SQ; const int nb = r >> 4, kb = r & 15; const int n = nb * 64 + g4;
            const float* w = (b == 0 ? F.in[I_WOUT] : F.in[I_WPG]) + (size_t)layer * 1024 * 1024;
            if (b == 0) tr_item64<false>(w + n, 1024, nullptr, 1.f, (bf16_t*)(F.ws + WS_WOUT), 1024, nb * 64, kb * 64, scr, lane, g_mix);
            else tr_item64<true>(w + n, 1024, F.in[I_GPLE] + (size_t)layer * D, 1.f, (bf16_t*)(F.ws + WS_WPG), 1024, nb * 64, kb * 64, scr, lane, g_mix);
            continue; }
        r -= 2 * N_SQ;
        if (r < N_PP) { const int nb = r >> 2, kb = r & 3; const int n = nb * 64 + g4;
            tr_item64<false>(F.in[I_WPP] + (size_t)layer * 256 * 1024 + n, 1024, nullptr, 1.f, (bf16_t*)(F.ws + WS_WPP), 256, nb * 64, kb * 64, scr, lane, g_mix); continue; }
        r -= N_PP;
        { const int nb = r >> 4, kb = r & 15; const int n = nb * 64 + g4; const float* cp = nullptr; size_t pitch = 4;
            if (n < 4) { cp = F.in[I_WRG] + (size_t)layer * 1024 * 4 + n; pitch = 4; } else if (n < 36) { cp = F.in[I_WRE] + (size_t)layer * 1024 * 32 + (n - 4); pitch = 32; }
            tr_item64<true>(cp, pitch, F.in[I_GFFN] + (size_t)layer * D, 1.f, (bf16_t*)(F.ws + WS_WR), 1024, nb * 64, kb * 64, scr, lane, g_mix); }
    }
}
__device__ __forceinline__ void phase_prep_experts(const Ctx& F, int layer) {
    const int gw = F.bid * NWAVES + F.wave, NGW = F.G * NWAVES, lane = F.lane;
    LAS float* scr = (LAS float*)(F.lds + F.wave * TR_LDS);
    const float* g_ffn = F.in[I_GFFN] + (size_t)layer * D;
    constexpr int N_UP = 32 * 8 * 16, N_DN = 32 * 16 * 4;
    const int g4 = 4 * (lane & 15);
    for (int it = gw; it < N_UP + N_DN; it += NGW) {
        int r = it;
        if (r < N_UP) { const int e = r >> 7; r &= 127; const int nb = r >> 4, kb = r & 15; const int n = nb * 64 + g4; const int q8 = n >> 3, sg = (n >> 2) & 1;
            const float* w = (sg ? F.in[I_WEU] : F.in[I_WEG]) + ((size_t)layer * 32 + e) * 1024 * 256 + 4 * q8;
            tr_item64<true>(w, 256, g_ffn, 1.f, (bf16_t*)(F.ws + WS_WEXP) + (size_t)e * 512 * 1024, 1024, nb * 64, kb * 64, scr, lane, g_ffn); continue; }
        r -= N_UP;
        { const int e = r >> 6; r &= 63; const int nb = r >> 2, kb = r & 3; const int n = nb * 64 + g4;
            const float* w = F.in[I_WED] + ((size_t)layer * 32 + e) * 256 * 1024 + n;
            tr_item64<false>(w, 1024, nullptr, 1.f, (bf16_t*)(F.ws + WS_WEXP) + 32ull * 512 * 1024 + (size_t)e * 1024 * 256, 256, nb * 64, kb * 64, scr, lane, g_ffn); }
    }
    const f32x4* p = (const f32x4*)(F.in[I_P] + (size_t)layer * T * 256); u32x2* pb = (u32x2*)(F.ws + WS_PBF);
    { const size_t n = (size_t)T * 256 / 4, st = (size_t)F.G * NTHREADS;
        for (size_t i0 = (size_t)F.bid * NTHREADS + F.tid; i0 < n; i0 += 8 * st) { f32x4 v[8];
#pragma unroll
            for (int k = 0; k < 8; ++k) { const size_t i = i0 + k * st; v[k] = p[i < n ? i : 0]; }
            PIN8(v[0], v[1], v[2], v[3], v[4], v[5], v[6], v[7]);
#pragma unroll
            for (int k = 0; k < 8; ++k) { const size_t i = i0 + k * st; if (i < n) { u32x2 w; w.x = cvt_pk_bf16(v[k].x, v[k].y); w.y = cvt_pk_bf16(v[k].z, v[k].w); pb[i] = w; } } } }
}

constexpr int AK_RS = 144, AV_RS = 160, AV_OFF = 2 * 128 * AK_RS;
typedef short s16x4 __attribute__((ext_vector_type(4)));
__device__ __forceinline__ s16x4 lds_tr16(LAS unsigned char* p) { return __builtin_amdgcn_ds_read_tr16_b64_v4i16((LAS s16x4*)p); }
__device__ __forceinline__ void attn_strip(const Ctx& F, int strip) {
    const int bs = strip / 48, sg = strip - bs * 48, b = bs >> 3, slot = bs & 7;
    int g, r, nb0;
    if (sg < 16) { g = 0; r = 0; nb0 = sg * 8; } else if (sg < 32) { g = 1; r = (sg - 16) >> 2; nb0 = ((sg - 16) & 3) * 8; } else { g = 2; r = sg - 32; nb0 = 0; }
    const int dl = 1 << (2 * g); const float slope = exp2f(-(float)(g * 8 + slot + 1) * (1.0f / 3.0f)) * (float)dl;
    bf16_t* Qg = (bf16_t*)(F.ws + (g == 0 ? WS_QA0 : (g == 1 ? WS_QA1 : WS_QA2))) + slot * 64;
    const bf16_t* Kg = (const bf16_t*)(F.ws + WS_KA) + slot * 64; const bf16_t* Vg = (const bf16_t*)(F.ws + WS_VA) + slot * 64;
    float* LSE = (float*)(F.ws + WS_LOGITS) + (size_t)g * T * 8 + slot;
    const size_t tok0 = (size_t)b * SEQ + r;
    LAS unsigned char* Kl = F.lds; LAS unsigned char* Vl = F.lds + AV_OFF;
    const int tid = F.tid, lane = F.lane, w = F.wave, fr = lane & 15, fq = lane >> 4;
    const int srow = tid >> 2, sc4 = tid & 3;
    u32x4 kx[2], vx[2];
#define ATT_LOAD(blk) do { const size_t _t = (tok0 + (size_t)((blk) * 128 + srow) * dl) * 512; \
        kx[0] = *(const u32x4*)(Kg + _t + sc4 * 8); kx[1] = *(const u32x4*)(Kg + _t + 32 + sc4 * 8); vx[0] = *(const u32x4*)(Vg + _t + sc4 * 8); vx[1] = *(const u32x4*)(Vg + _t + 32 + sc4 * 8); } while (0)
#define ATT_STORE(blk) do { const int _p = (((blk) & 1) * 128 + srow); \
        *(LAS u32x4*)(Kl + _p * AK_RS + sc4 * 16) = kx[0]; *(LAS u32x4*)(Kl + _p * AK_RS + 64 + sc4 * 16) = kx[1]; *(LAS u32x4*)(Vl + _p * AV_RS + sc4 * 16) = vx[0]; *(LAS u32x4*)(Vl + _p * AV_RS + 64 + sc4 * 16) = vx[1]; } while (0)
    __syncthreads();
    if (nb0 > 0) { ATT_LOAD(nb0 - 1); ATT_STORE(nb0 - 1); }
    else { kx[0] = kx[1] = vx[0] = vx[1] = (u32x4){0u, 0u, 0u, 0u}; ATT_STORE(1); }
    ATT_LOAD(nb0); ATT_STORE(nb0);
    bf16x8 qn0, qn1;
    { const size_t qo = (tok0 + (size_t)(nb0 * 128 + 16 * w + fr) * dl) * 512; qn0 = *(const bf16x8*)(Qg + qo + fq * 8); qn1 = *(const bf16x8*)(Qg + qo + 32 + fq * 8); }
    __syncthreads();
    for (int nb = nb0; nb < nb0 + 8; ++nb) {
        const bool more = nb + 1 < nb0 + 8;
        if (more) ATT_LOAD(nb + 1);
        const size_t qoff = (tok0 + (size_t)(nb * 128 + 16 * w + fr) * dl) * 512;
        const bf16x8 q0 = qn0, q1 = qn1;
        if (more) { const size_t qo2 = qoff + (size_t)128 * dl * 512; qn0 = *(const bf16x8*)(Qg + qo2 + fq * 8); qn1 = *(const bf16x8*)(Qg + qo2 + 32 + fq * 8); }
        const int pslot = (nb - 1) & 1;
        f32x4 S[10];
#pragma unroll
        for (int kbi = 0; kbi < 10; ++kbi) {
            int kb = w + kbi; if (kb > 15) kb = 15;
            const int ki = kb * 16 + fr; const int phys = ((pslot + (ki >> 7)) & 1) * 128 + (ki & 127);
            const bf16x8 k0 = *(const LAS bf16x8*)(Kl + phys * AK_RS + fq * 16), k1 = *(const LAS bf16x8*)(Kl + phys * AK_RS + 64 + fq * 16);
            f32x4 a = (f32x4){0.f, 0.f, 0.f, 0.f};
            a = __builtin_amdgcn_mfma_f32_16x16x32_bf16(k0, q0, a, 0, 0, 0);
            S[kbi] = __builtin_amdgcn_mfma_f32_16x16x32_bf16(k1, q1, a, 0, 0, 0);
        }
        float mx = -INFINITY;
#pragma unroll
        for (int kbi = 0; kbi < 10; ++kbi)
#pragma unroll
            for (int j = 0; j < 4; ++j) { const int ki = (w + kbi) * 16 + 4 * fq + j; const int dist = 16 * w + fr + 128 - ki;
                const bool ok = dist >= 0 && dist <= 128 && (nb > 0 || ki >= 128) && (w + kbi) < 16;
                const float sc = ok ? S[kbi][j] - slope * (float)dist : -INFINITY; S[kbi][j] = sc; mx = fmaxf(mx, sc); }
        mx = fmaxf(mx, __shfl_xor(mx, 16)); mx = fmaxf(mx, __shfl_xor(mx, 32));
        float ls = 0.f;
#pragma unroll
        for (int kbi = 0; kbi < 10; ++kbi)
#pragma unroll
            for (int j = 0; j < 4; ++j) { const float p = __expf(S[kbi][j] - mx); S[kbi][j] = p; ls += p; }
        ls += __shfl_xor(ls, 16); ls += __shfl_xor(ls, 32);
        f32x4 O[4];
#pragma unroll
        for (int db = 0; db < 4; ++db) O[db] = (f32x4){0.f, 0.f, 0.f, 0.f};
#pragma unroll
        for (int k2 = 0; k2 < 5; ++k2) {
            u32x4 pw; pw.x = cvt_pk_bf16(S[2 * k2][0], S[2 * k2][1]); pw.y = cvt_pk_bf16(S[2 * k2][2], S[2 * k2][3]); pw.z = cvt_pk_bf16(S[2 * k2 + 1][0], S[2 * k2 + 1][1]); pw.w = cvt_pk_bf16(S[2 * k2 + 1][2], S[2 * k2 + 1][3]);
            const bf16x8 pf = __builtin_bit_cast(bf16x8, pw);
            int kb0 = w + 2 * k2, kb1 = kb0 + 1; if (kb1 > 15) kb1 = 15; if (kb0 > 15) kb0 = 15;
            const int r0 = kb0 * 16 + 4 * fq + (fr >> 2), r1 = kb1 * 16 + 4 * fq + (fr >> 2);
            const int p0 = ((pslot + (r0 >> 7)) & 1) * 128 + (r0 & 127), p1 = ((pslot + (r1 >> 7)) & 1) * 128 + (r1 & 127);
#pragma unroll
            for (int db = 0; db < 4; ++db) {
                const s16x4 v0 = lds_tr16(Vl + p0 * AV_RS + (db * 16 + 4 * (fr & 3)) * 2), v1 = lds_tr16(Vl + p1 * AV_RS + (db * 16 + 4 * (fr & 3)) * 2);
                const bf16x8 vf = (bf16x8){v0[0], v0[1], v0[2], v0[3], v1[0], v1[1], v1[2], v1[3]};
                O[db] = __builtin_amdgcn_mfma_f32_16x16x32_bf16(vf, pf, O[db], 0, 0, 0);
            }
        }
        const float inv = 1.0f / ls;
#pragma unroll
        for (int db = 0; db < 4; ++db) { u32x2 ow; ow.x = cvt_pk_bf16(O[db][0] * inv, O[db][1] * inv); ow.y = cvt_pk_bf16(O[db][2] * inv, O[db][3] * inv);
            *(u32x2*)(Qg + qoff + db * 16 + 4 * fq) = ow; }
        if (fq == 0) LSE[(qoff >> 9) * 8] = mx + __logf(ls);
        __syncthreads();
        if (more) ATT_STORE(nb + 1);
        __syncthreads();
    }
#undef ATT_LOAD
#undef ATT_STORE
}
__device__ __forceinline__ void attn_combine(const Ctx& F) {
    const float* LSE = (const float*)(F.ws + WS_LOGITS);
    for (int i0 = F.bid * NTHREADS + F.tid; i0 < T * 64; i0 += 4 * F.G * NTHREADS) {
        u32x4 a[4], bb[4], cc[4]; float l0[4], l1[4], l2[4];
#pragma unroll
        for (int k = 0; k < 4; ++k) { const int i = i0 + k * F.G * NTHREADS; const int ic = i < T * 64 ? i : 0; const int t = ic >> 6, slot = (ic & 63) >> 3;
            a[k] = ((const u32x4*)(F.ws + WS_QA0))[ic]; bb[k] = ((const u32x4*)(F.ws + WS_QA1))[ic]; cc[k] = ((const u32x4*)(F.ws + WS_QA2))[ic];
            l0[k] = LSE[(size_t)t * 8 + slot]; l1[k] = LSE[(size_t)T * 8 + (size_t)t * 8 + slot]; l2[k] = LSE[(size_t)2 * T * 8 + (size_t)t * 8 + slot]; }
        PIN4(a[0], a[1], a[2], a[3]); PIN4(bb[0], bb[1], bb[2], bb[3]); PIN4(cc[0], cc[1], cc[2], cc[3]);
#pragma unroll
        for (int k = 0; k < 4; ++k) { const int i = i0 + k * F.G * NTHREADS; if (i < T * 64) {
            const float m = fmaxf(l0[k], fmaxf(l1[k], l2[k])); float w0 = __expf(l0[k] - m), w1 = __expf(l1[k] - m), w2 = __expf(l2[k] - m); const float inv = __builtin_amdgcn_rcpf(w0 + w1 + w2); w0 *= inv; w1 *= inv; w2 *= inv;
            f32x4 a0, a1, b0, b1, c0, c1; unpack8(a[k], a0, a1); unpack8(bb[k], b0, b1); unpack8(cc[k], c0, c1);
            ((u32x4*)(F.ws + WS_QA0))[i] = pack8(a0 * w0 + b0 * w1 + c0 * w2, a1 * w0 + b1 * w1 + c1 * w2); } }
    }
}

__device__ __forceinline__ void conv_item(const Ctx& F, int layer, int item) {
    const int t0 = item * 32, s0 = t0 & (SEQ - 1), tid = F.tid;
    LAS bf16_t* sin = (LAS bf16_t*)F.lds;
    LAS float* sout = (LAS float*)(F.lds + 65536);
    const bf16_t* YG = (const bf16_t*)(F.ws + WS_YG);
    __syncthreads();
#pragma unroll 1
    for (int kb = 0; kb < 2; ++kb) { u32x4 sv[4];
#pragma unroll
        for (int k = 0; k < 4; ++k) { const int i = tid + (kb * 4 + k) * NTHREADS; const int r = i < 62 * 64 ? (i >> 6) : 0, c8 = i & 63; const int sp = s0 - 30 + r;
            sv[k] = *(const u32x4*)(YG + (size_t)(sp >= 0 ? t0 - 30 + r : t0) * 512 + c8 * 8); }
        PIN4(sv[0], sv[1], sv[2], sv[3]);
#pragma unroll
        for (int k = 0; k < 4; ++k) { const int i = tid + (kb * 4 + k) * NTHREADS; const int r = i >> 6, c8 = i & 63; const int sp = s0 - 30 + r;
            if (i < 62 * 64) *(LAS u32x4*)(sin + r * 512 + c8 * 8) = sp >= 0 ? sv[k] : (u32x4){0u, 0u, 0u, 0u}; } }
    const int cp = tid & 255, hf = tid >> 8;
    f32x2 w[31];
    const float* cw = F.in[I_CONVW] + (size_t)layer * 31 * 512 + 2 * cp;
#pragma unroll
    for (int k = 0; k < 31; ++k) w[k] = *(const f32x2*)(cw + k * 512);
    const f32x2 cb = *(const f32x2*)(F.in[I_CONVB] + layer * 512 + 2 * cp);
    __syncthreads();
#pragma unroll 1
    for (int ps = 0; ps < 2; ++ps) { const int tb = 16 * hf + 8 * ps;
        f32x2 xin[38];
#pragma unroll
        for (int r = 0; r < 38; ++r) { const unsigned u = *(const LAS unsigned*)(sin + (tb + r) * 512 + 2 * cp); xin[r] = (f32x2){bf_lo(u), bf_hi(u)}; }
#pragma unroll
        for (int tt = 0; tt < 8; ++tt) { f32x2 a = cb;
#pragma unroll
            for (int k = 0; k < 31; ++k) a += w[k] * xin[tt + k];
            *(LAS f32x2*)(sout + (tb + tt) * 512 + 2 * cp) = a; } }
    __syncthreads();
    const float* lg = F.in[I_CLNG] + layer * 512 + F.lane * 8; const float* lb = F.in[I_CLNB] + layer * 512 + F.lane * 8;
    for (int tt = F.wave; tt < 32; tt += NWAVES) {
        float v[8]; float sm = 0.f;
#pragma unroll
        for (int j = 0; j < 8; ++j) { v[j] = sout[tt * 512 + F.lane * 8 + j]; sm += v[j]; }
        const float mu = wave_sum(sm) * (1.0f / 512.0f); float q = 0.f;
#pragma unroll
        for (int j = 0; j < 8; ++j) { v[j] -= mu; q += v[j] * v[j]; }
        const float rstd = rsqrtf(wave_sum(q) * (1.0f / 512.0f) + EPS);
        float o[8];
#pragma unroll
        for (int j = 0; j < 8; ++j) o[j] = siluf_(v[j] * rstd * lg[j] + lb[j]);
        u32x4 wv; wv.x = cvt_pk_bf16(o[0], o[1]); wv.y = cvt_pk_bf16(o[2], o[3]); wv.z = cvt_pk_bf16(o[4], o[5]); wv.w = cvt_pk_bf16(o[6], o[7]);
        *(u32x4*)((bf16_t*)(F.ws + WS_YC) + (size_t)(t0 + tt) * 512 + F.lane * 8) = wv;
    }
}

__device__ __forceinline__ float log_sigmoid_(float v) { return fminf(v, 0.f) - log1pf(__expf(-fabsf(v))); }
struct QkW { float w[4][8]; float b[8]; };
__device__ __forceinline__ void qk_load_w(const Ctx& F, int layer, int chq, QkW& W) {
    const float* cw = F.in[I_MCW] + (size_t)layer * 4 * 1024 + chq; const float* cb = F.in[I_MCB] + (size_t)layer * 1024 + chq;
#pragma unroll
    for (int k = 0; k < 4; ++k) { const f32x4 a = *(const f32x4*)(cw + k * 1024), b = *(const f32x4*)(cw + k * 1024 + 4); W.w[k][0] = a.x; W.w[k][1] = a.y; W.w[k][2] = a.z; W.w[k][3] = a.w; W.w[k][4] = b.x; W.w[k][5] = b.y; W.w[k][6] = b.z; W.w[k][7] = b.w; }
    const f32x4 a = *(const f32x4*)cb, b = *(const f32x4*)(cb + 4); W.b[0] = a.x; W.b[1] = a.y; W.b[2] = a.z; W.b[3] = a.w; W.b[4] = b.x; W.b[5] = b.y; W.b[6] = b.z; W.b[7] = b.w;
}
__device__ __forceinline__ void qk_conv8(const QkW& W, const bf16_t* src  , int t, int s, int ch  , float scale, float* o) {
#pragma unroll
    for (int j = 0; j < 8; ++j) o[j] = W.b[j];
#pragma unroll
    for (int k = 0; k < 4; ++k) { const bool ok = s - 3 + k >= 0; u32x4 w = *(const u32x4*)(src + (size_t)(ok ? t - 3 + k : t) * 512 + ch);
            if (!ok) w = (u32x4){0u, 0u, 0u, 0u};
            o[0] += W.w[k][0] * bf_lo(w.x); o[1] += W.w[k][1] * bf_hi(w.x); o[2] += W.w[k][2] * bf_lo(w.y); o[3] += W.w[k][3] * bf_hi(w.y); o[4] += W.w[k][4] * bf_lo(w.z); o[5] += W.w[k][5] * bf_hi(w.z); o[6] += W.w[k][6] * bf_lo(w.w); o[7] += W.w[k][7] * bf_hi(w.w); }
#pragma unroll
    for (int j = 0; j < 8; ++j) o[j] = siluf_(o[j]) * scale;
}
__device__ __forceinline__ void qk_conv8r(const QkW& W, const u32x4 (&rw)[4], int s, float scale, float* o) {
#pragma unroll
    for (int j = 0; j < 8; ++j) o[j] = W.b[j];
#pragma unroll
    for (int k = 0; k < 4; ++k) { u32x4 w = rw[k]; if (s - 3 + k < 0) w = (u32x4){0u, 0u, 0u, 0u};
        o[0] += W.w[k][0] * bf_lo(w.x); o[1] += W.w[k][1] * bf_hi(w.x); o[2] += W.w[k][2] * bf_lo(w.y); o[3] += W.w[k][3] * bf_hi(w.y); o[4] += W.w[k][4] * bf_lo(w.z); o[5] += W.w[k][5] * bf_hi(w.z); o[6] += W.w[k][6] * bf_lo(w.w); o[7] += W.w[k][7] * bf_hi(w.w); }
#pragma unroll
    for (int j = 0; j < 8; ++j) o[j] = siluf_(o[j]) * scale;
}
__device__ __forceinline__ void mlstm_scalars(const Ctx& F, int layer, int t0, int h, LAS float* sIG, LAS float* sBC) {
    if (F.tid < 128) { const float* IFp = (const float*)(F.ws + WS_IF) + (size_t)(t0 + F.tid) * 8;
        sIG[F.tid] = IFp[h] + F.in[I_MIB][layer * 4 + h]; sBC[F.tid] = log_sigmoid_(IFp[4 + h] + F.in[I_MFB][layer * 4 + h]); }
    __syncthreads();
    if (F.wave == 0) { const float a = sBC[2 * F.lane], bb = sBC[2 * F.lane + 1]; float sc = a + bb;
#pragma unroll
        for (int off = 1; off < 64; off <<= 1) { const float t = __shfl_up(sc, off); if (F.lane >= off) sc += t; }
        sBC[2 * F.lane] = sc - bb; sBC[2 * F.lane + 1] = sc; }
    __syncthreads();
}
constexpr int ML_KRS = 288, ML_ERS = 352, ML_E = 128 * ML_KRS, ML_S = ML_E + 128 * ML_ERS;
__device__ __forceinline__ void mlstm_local_mfma(const Ctx& F, int layer, int item) {
    const int c = item & 127, bh = item >> 7, h = bh & 3, b = bh >> 2, t0 = b * SEQ + c * 128, tid = F.tid, lane = F.lane, w = F.wave, fr = lane & 15, fq = lane >> 4;
    LAS unsigned char* L = F.lds;
    LAS float* sIG = (LAS float*)(L + ML_S); LAS float* sBC = sIG + 128; LAS float* sE = sIG + 256; LAS float* sM = sIG + 384;
    __syncthreads();
    mlstm_scalars(F, layer, t0, h, sIG, sBC);
    if (w == 0) { const float gt = sBC[127]; const float m = wave_max(fmaxf(gt - sBC[lane] + sIG[lane], gt - sBC[lane + 64] + sIG[lane + 64])); if (lane == 0) { sM[0] = m; sM[1] = gt; } }
    __syncthreads();
    if (tid < 128) sE[tid] = __expf(sM[1] - sBC[tid] + sIG[tid] - sM[0]);
    __syncthreads();
    const bf16_t* KM = (const bf16_t*)(F.ws + WS_KM); const bf16_t* VM = (const bf16_t*)(F.ws + WS_VM);
    QkW WK; qk_load_w(F, layer, 512 + h * 128 + (tid & 15) * 8, WK);
#pragma unroll 1
    for (int i = tid; i < 128 * 16; i += NTHREADS) { const int l = i >> 4, c8 = (i & 15) * 8; const int t = t0 + l, s = t & (SEQ - 1);
        u32x4 rk[4];
#pragma unroll
        for (int k = 0; k < 4; ++k) rk[k] = *(const u32x4*)(KM + (size_t)(s - 3 + k >= 0 ? t - 3 + k : t) * 512 + h * 128 + c8);
        const u32x4 rv = *(const u32x4*)(VM + (size_t)t * 512 + h * 128 + c8);
        float o[8]; qk_conv8r(WK, rk, s, 0.08838834764831845f, o);
        *(LAS u32x4*)(L + l * ML_KRS + c8 * 2) = pack8((f32x4){o[0], o[1], o[2], o[3]}, (f32x4){o[4], o[5], o[6], o[7]});
        f32x4 v0, v1; unpack8(rv, v0, v1); const float e = sE[l];
        *(LAS u32x4*)(L + ML_E + l * ML_ERS + c8 * 2) = pack8(v0 * e, v1 * e); }
    if (tid < 128) { unsigned zr = 0u; asm volatile("" : "+v"(zr));
        u32x4 z; z.x = f2bf(sE[tid]); z.y = zr; z.z = zr; z.w = zr; *(LAS u32x4*)(L + ML_E + tid * ML_ERS + 256) = z; z.x = zr; *(LAS u32x4*)(L + ML_E + tid * ML_ERS + 272) = z; }
    __syncthreads();
    bf16x8 af[4];
#pragma unroll
    for (int ks = 0; ks < 4; ++ks) { const int ra = ks * 32 + 4 * fq + (fr >> 2);
        const s16x4 a0 = lds_tr16(L + ra * ML_KRS + (w * 16 + 4 * (fr & 3)) * 2), a1 = lds_tr16(L + (ra + 16) * ML_KRS + (w * 16 + 4 * (fr & 3)) * 2);
        af[ks] = (bf16x8){a0[0], a0[1], a0[2], a0[3], a1[0], a1[1], a1[2], a1[3]}; }
    bf16_t* Cp = (bf16_t*)(F.ws + WS_CST) + ((size_t)(bh * 128 + c) << 14);
#pragma unroll
    for (int vb = 0; vb < 9; ++vb) { f32x4 d = (f32x4){0.f, 0.f, 0.f, 0.f};
#pragma unroll
        for (int ks = 0; ks < 4; ++ks) { const int rb = ks * 32 + 4 * fq + (fr >> 2);
            const s16x4 b0 = lds_tr16(L + ML_E + rb * ML_ERS + (vb * 16 + 4 * (fr & 3)) * 2), b1 = lds_tr16(L + ML_E + (rb + 16) * ML_ERS + (vb * 16 + 4 * (fr & 3)) * 2);
            const bf16x8 bfr = (bf16x8){b0[0], b0[1], b0[2], b0[3], b1[0], b1[1], b1[2], b1[3]};
            d = __builtin_amdgcn_mfma_f32_16x16x32_bf16(af[ks], bfr, d, 0, 0, 0); }
        if (vb < 8) { u32x2 o; o.x = pk2(d[0], d[1]); o.y = pk2(d[2], d[3]); *(u32x2*)(Cp + (size_t)(vb * 16 + fr) * 128 + w * 16 + 4 * fq) = o; }
        else if (fr == 0) *(f32x4*)((float*)(F.ws + WS_NST) + (size_t)(bh * 128 + c) * 128 + w * 16 + 4 * fq) = d;
    }
    if (tid == 0) { ((float*)(F.ws + WS_TAB + TAB_MLOC))[bh * 128 + c] = sM[0]; ((float*)(F.ws + WS_TAB + TAB_GTOT))[bh * 128 + c] = sM[1]; }
}
__device__ __forceinline__ void phase_scan(const Ctx& F) {
    const float* GT = (const float*)(F.ws + WS_TAB + TAB_GTOT); const float* ML = (const float*)(F.ws + WS_TAB + TAB_MLOC); float* MS = (float*)(F.ws + WS_TAB + TAB_MST);
    LAS float* sA = (LAS float*)F.lds; LAS float* sB = sA + 128;
    for (int blk = F.bid; blk < 8 * 32 + 8; blk += F.G) {
        const bool isC = blk < 256; const int bh = isC ? (blk >> 5) : (blk - 256);
        __syncthreads();
        if (F.tid < 128) { sA[F.tid] = GT[bh * 128 + F.tid]; sB[F.tid] = ML[bh * 128 + F.tid]; }
        __syncthreads();
        if (F.wave == 0) {
            const int c0 = 2 * F.lane; const float g0 = sA[c0], m0 = sB[c0], g1 = sA[c0 + 1], m1 = sB[c0 + 1];
            float G = g0 + g1, M = fmaxf(m0 + g1, m1);
#pragma unroll
            for (int off = 1; off < 64; off <<= 1) { const float Gp = __shfl_up(G, off), Mp = __shfl_up(M, off); if (F.lane >= off) { M = fmaxf(Mp + G, M); G = Gp + G; } }
            float Gx = __shfl_up(G, 1), Mx = __shfl_up(M, 1); if (F.lane == 0) { Gx = 0.f; Mx = -INFINITY; }
            const float mA = fmaxf(0.f + Gx, Mx);
            const float mB = fmaxf(mA + g0, m0);
            const float mC = fmaxf(mB + g1, m1);
            sA[c0] = __expf(g0 + mA - mB); sB[c0] = __expf(m0 - mB); sA[c0 + 1] = __expf(g1 + mB - mC); sB[c0 + 1] = __expf(m1 - mC);
            if (isC && (blk & 31) == 0) { MS[bh * 128 + c0] = mA; MS[bh * 128 + c0 + 1] = mB; } }
        __syncthreads();
        if (isC) { bf16_t* cp = (bf16_t*)(F.ws + WS_CST) + ((size_t)(bh * 128) << 14) + (blk & 31) * 512 + F.tid; float val = 0.f;
            for (int c0 = 0; c0 < 128; c0 += 16) { float loc[16];
#pragma unroll
                for (int j = 0; j < 16; ++j) loc[j] = bf1(cp[(size_t)(c0 + j) << 14]);
                PIN8(loc[0], loc[1], loc[2], loc[3], loc[4], loc[5], loc[6], loc[7]); PIN8(loc[8], loc[9], loc[10], loc[11], loc[12], loc[13], loc[14], loc[15]);
#pragma unroll
                for (int j = 0; j < 16; ++j) { cp[(size_t)(c0 + j) << 14] = (bf16_t)f2bf(val); val = sA[c0 + j] * val + sB[c0 + j] * loc[j]; } } }
        else if (F.tid < 128) { float* np = (float*)(F.ws + WS_NST) + (size_t)(bh * 128) * 128 + F.tid; float val = 0.f;
            for (int c0 = 0; c0 < 128; c0 += 16) { float loc[16];
#pragma unroll
                for (int j = 0; j < 16; ++j) loc[j] = np[(size_t)(c0 + j) * 128];
                PIN8(loc[0], loc[1], loc[2], loc[3], loc[4], loc[5], loc[6], loc[7]); PIN8(loc[8], loc[9], loc[10], loc[11], loc[12], loc[13], loc[14], loc[15]);
#pragma unroll
                for (int j = 0; j < 16; ++j) { np[(size_t)(c0 + j) * 128] = val; val = sA[c0 + j] * val + sB[c0 + j] * loc[j]; } } }
    }
    __syncthreads();
}
constexpr int MO_RS = 272, MO_VRS = 288;
constexpr int MO_Q = 0, MO_K = 128 * MO_RS, MO_C = 2 * 128 * MO_RS, MO_V = MO_C + 144 * MO_RS, MO_S = MO_V + 128 * MO_VRS;
static_assert(MO_S + 2560 <= MISC_OFF, "mlstm_out LDS");
__device__ __forceinline__ void mlstm_out_mfma(const Ctx& F, int layer, int item) {
    const int c = item & 127, bh = item >> 7, h = bh & 3, b = bh >> 2, t0 = b * SEQ + c * 128, tid = F.tid, lane = F.lane, w = F.wave, fr = lane & 15, fq = lane >> 4;
    LAS unsigned char* L = F.lds;
    LAS float* sIG = (LAS float*)(L + MO_S); LAS float* sBC = sIG + 128; LAS float* sMT = sIG + 256; LAS float* sSI = sIG + 384;
    __syncthreads();
    mlstm_scalars(F, layer, t0, h, sIG, sBC);
    const float mst = ((const float*)(F.ws + WS_TAB + TAB_MST))[bh * 128 + c];
    if (w == 0) { const float a = sIG[2 * lane] - sBC[2 * lane], bb = sIG[2 * lane + 1] - sBC[2 * lane + 1]; float pm = fmaxf(a, bb);
#pragma unroll
        for (int off = 1; off < 64; off <<= 1) { const float t = __shfl_up(pm, off); if (lane >= off) pm = fmaxf(pm, t); }
        float pl = __shfl_up(pm, 1); if (lane == 0) pl = -INFINITY;
        const float p0 = fmaxf(pl, a), p1 = pm;
        { const float ai = sBC[2 * lane] + mst, mt = fmaxf(ai, sBC[2 * lane] + p0); sMT[2 * lane] = mt; sSI[2 * lane] = __expf(ai - mt); }
        { const float ai = sBC[2 * lane + 1] + mst, mt = fmaxf(ai, sBC[2 * lane + 1] + p1); sMT[2 * lane + 1] = mt; sSI[2 * lane + 1] = __expf(ai - mt); } }
    const bf16_t* QM = (const bf16_t*)(F.ws + WS_QM); const bf16_t* KM = (const bf16_t*)(F.ws + WS_KM); const bf16_t* VM = (const bf16_t*)(F.ws + WS_VM);
    const bf16_t* Cp = (const bf16_t*)(F.ws + WS_CST) + ((size_t)(bh * 128 + c) << 14);
    QkW WQ, WK; qk_load_w(F, layer, h * 128 + (tid & 15) * 8, WQ); qk_load_w(F, layer, 512 + h * 128 + (tid & 15) * 8, WK);
#pragma unroll 1
    for (int i = tid; i < 128 * 16; i += NTHREADS) { const int l = i >> 4, c8 = (i & 15) * 8; const int t = t0 + l, s = t & (SEQ - 1); float o[8];
        u32x4 rq[4], rk[4];
#pragma unroll
        for (int k = 0; k < 4; ++k) { const size_t ro = (size_t)(s - 3 + k >= 0 ? t - 3 + k : t) * 512 + h * 128 + c8; rq[k] = *(const u32x4*)(QM + ro); rk[k] = *(const u32x4*)(KM + ro); }
        const u32x4 rv = *(const u32x4*)(VM + (size_t)t * 512 + h * 128 + c8), rc = *(const u32x4*)(Cp + l * 128 + c8);
        qk_conv8r(WQ, rq, s, 1.0f, o);
        *(LAS u32x4*)(L + MO_Q + l * MO_RS + c8 * 2) = pack8((f32x4){o[0], o[1], o[2], o[3]}, (f32x4){o[4], o[5], o[6], o[7]});
        qk_conv8r(WK, rk, s, 0.08838834764831845f, o);
        *(LAS u32x4*)(L + MO_K + l * MO_RS + c8 * 2) = pack8((f32x4){o[0], o[1], o[2], o[3]}, (f32x4){o[4], o[5], o[6], o[7]});
        *(LAS u32x4*)(L + MO_V + l * MO_VRS + c8 * 2) = rv;
        *(LAS u32x4*)(L + MO_C + l * MO_RS + c8 * 2) = rc; }
    if (tid < 16) { const float* np = (const float*)(F.ws + WS_NST) + (size_t)(bh * 128 + c) * 128 + tid * 8;
        *(LAS u32x4*)(L + MO_C + 128 * MO_RS + tid * 16) = pack8(*(const f32x4*)np, *(const f32x4*)(np + 4)); }
    __syncthreads();
    const int q = 16 * w + fr;
    bf16x8 qf[4];
#pragma unroll
    for (int ks = 0; ks < 4; ++ks) qf[ks] = *(const LAS bf16x8*)(L + MO_Q + q * MO_RS + ks * 64 + fq * 16);
    f32x4 O[9];
#pragma unroll
    for (int vb = 0; vb < 9; ++vb) { f32x4 a = (f32x4){0.f, 0.f, 0.f, 0.f};
#pragma unroll
        for (int ks = 0; ks < 4; ++ks) { const bf16x8 cf = *(const LAS bf16x8*)(L + MO_C + (vb * 16 + fr) * MO_RS + ks * 64 + fq * 16); a = __builtin_amdgcn_mfma_f32_16x16x32_bf16(cf, qf[ks], a, 0, 0, 0); }
        O[vb] = a; }
    const float si = sSI[q], mt = sMT[q], bq = sBC[q];
    const float dn = __shfl(O[8][0], fr);
#pragma unroll
    for (int vb = 0; vb < 8; ++vb) O[vb] = O[vb] * si;
    float den = 0.f;
    for (int k2 = 0; k2 <= (w >> 1); ++k2) {
        f32x4 P[2];
#pragma unroll
        for (int u = 0; u < 2; ++u) { const int kb = 2 * k2 + u; f32x4 a = (f32x4){0.f, 0.f, 0.f, 0.f};
            const int kr = (kb > 7 ? 7 : kb) * 16 + fr;
#pragma unroll
            for (int ks = 0; ks < 4; ++ks) { const bf16x8 kf = *(const LAS bf16x8*)(L + MO_K + kr * MO_RS + ks * 64 + fq * 16); a = __builtin_amdgcn_mfma_f32_16x16x32_bf16(kf, qf[ks], a, 0, 0, 0); }
#pragma unroll
            for (int j = 0; j < 4; ++j) { const int k = kb * 16 + 4 * fq + j; const int kc = k > 127 ? 127 : k; const float wgt = (k <= q) ? __expf(bq - sBC[kc] + sIG[kc] - mt) : 0.f; a[j] *= wgt; den += a[j]; }
            P[u] = a; }
        u32x4 pw; pw.x = cvt_pk_bf16(P[0][0], P[0][1]); pw.y = cvt_pk_bf16(P[0][2], P[0][3]); pw.z = cvt_pk_bf16(P[1][0], P[1][1]); pw.w = cvt_pk_bf16(P[1][2], P[1][3]);
        const bf16x8 pf = __builtin_bit_cast(bf16x8, pw);
        const int kb1 = (2 * k2 + 1 > 7) ? 7 : 2 * k2 + 1;
        const int r0 = 2 * k2 * 16 + 4 * fq + (fr >> 2), r1 = kb1 * 16 + 4 * fq + (fr >> 2);
#pragma unroll
        for (int vb = 0; vb < 8; ++vb) {
            const s16x4 v0 = lds_tr16(L + MO_V + r0 * MO_VRS + (vb * 16 + 4 * (fr & 3)) * 2), v1 = lds_tr16(L + MO_V + r1 * MO_VRS + (vb * 16 + 4 * (fr & 3)) * 2);
            const bf16x8 vf = (bf16x8){v0[0], v0[1], v0[2], v0[3], v1[0], v1[1], v1[2], v1[3]};
            O[vb] = __builtin_amdgcn_mfma_f32_16x16x32_bf16(vf, pf, O[vb], 0, 0, 0);
        }
    }
    den += __shfl_xor(den, 16); den += __shfl_xor(den, 32);
    const float dd = den + si * dn; const float inv = 1.0f / fmaxf(fabsf(dd), __expf(-mt));
    bf16_t* OM = (bf16_t*)(F.ws + WS_OM) + (size_t)(t0 + q) * 512 + h * 128;
#pragma unroll
    for (int vb = 0; vb < 8; ++vb) { u32x2* p = (u32x2*)(OM + vb * 16 + 4 * fq); const u32x2 g = *p;
        u32x2 o; o.x = cvt_pk_bf16(bf_lo(g.x) * O[vb][0] * inv, bf_hi(g.x) * O[vb][1] * inv); o.y = cvt_pk_bf16(bf_lo(g.y) * O[vb][2] * inv, bf_hi(g.y) * O[vb][3] * inv); *p = o; }
}

__device__ __forceinline__ void phase_route(const Ctx& F, int layer, int tile0, int tile1, int tstep) {
    LAS int* hist = (LAS int*)F.lds;
    const float* brg = F.in[I_BRG] + layer * 4; const float* bre = F.in[I_BRE] + layer * 32;
    for (int tile = tile0; tile < tile1; tile += tstep) {
        __syncthreads();
        if (F.tid < 128) { const int t = tile * 128 + F.tid; const float* lg = (const float*)(F.ws + WS_LOGITS) + (size_t)t * 64;
            float g[4]; int gs = 0; float gm;
#pragma unroll
            for (int j = 0; j < 4; ++j) g[j] = lg[j] + brg[j];
            gm = g[0];
#pragma unroll
            for (int j = 1; j < 4; ++j) if (g[j] > gm) { gm = g[j]; gs = j; }
            float se = 0.f;
#pragma unroll
            for (int j = 0; j < 4; ++j) se += __expf(g[j] - gm);
            const float pg = 1.0f / se;
            float le[8];
#pragma unroll
            for (int j = 0; j < 8; ++j) le[j] = lg[4 + gs * 8 + j] + bre[gs * 8 + j];
            int i0 = 0; float v0 = le[0];
#pragma unroll
            for (int j = 1; j < 8; ++j) if (le[j] > v0) { v0 = le[j]; i0 = j; }
            int i1 = -1; float v1 = -INFINITY;
#pragma unroll
            for (int j = 0; j < 8; ++j) if (j != i0 && le[j] > v1) { v1 = le[j]; i1 = j; }
            const float e1 = __expf(v1 - v0); const float wsc = (ABL == 4) ? 0.f : ((ABL == 6) ? 2.f : 1.f); const float w0 = wsc * pg / (1.0f + e1), w1 = wsc * pg * e1 / (1.0f + e1);
            const int x0 = gs * 8 + i0, x1 = gs * 8 + i1;
            ((int*)(F.ws + WS_ROUTE))[2 * t] = x0; ((int*)(F.ws + WS_ROUTE))[2 * t + 1] = x1;
            ((float*)(F.ws + WS_ROUTE))[2 * T + 2 * t] = w0; ((float*)(F.ws + WS_ROUTE))[2 * T + 2 * t + 1] = w1;
            hist[F.tid] = x0; hist[128 + F.tid] = x1;
        }
        __syncthreads();
        if (F.tid < 64) { const int k = F.tid >> 5, e = F.tid & 31; int cnt = 0; for (int j = 0; j < 128; ++j) cnt += (hist[k * 128 + j] == e) ? 1 : 0; ((int*)(F.ws + WS_TAB + TAB_CNT))[tile * 64 + F.tid] = cnt; }
        __syncthreads();
    }
}
__device__ __forceinline__ void phase_dispatch(const Ctx& F) {
    LAS int* sTot = (LAS int*)F.lds; LAS int* sBef = sTot + 64; LAS int* sPs = sTot + 128; LAS int* sE = sTot + 256; LAS int* sPart = sTot + 512;
    const int* CNT = (const int*)(F.ws + WS_TAB + TAB_CNT); int* META = (int*)(F.ws + WS_TAB + TAB_META);
    int* tokl = (int*)(F.ws + WS_LISTS); float* wl = (float*)(F.ws + WS_LISTS) + 2 * LISTCAP;
    for (int tile = F.bid; tile < 256; tile += F.G) {
        { const int ke = F.tid & 63, grp = F.tid >> 6; int cv[32];
#pragma unroll
            for (int i = 0; i < 32; ++i) cv[i] = CNT[(grp + 8 * i) * 64 + ke];
            int tot = 0, bef = 0;
#pragma unroll
            for (int i = 0; i < 32; ++i) { tot += cv[i]; bef += (grp + 8 * i < tile) ? cv[i] : 0; }
            sPart[grp * 64 + ke] = tot; sPart[512 + grp * 64 + ke] = bef; }
        __syncthreads();
        if (F.tid < 64) { int tot = 0, bef = 0;
#pragma unroll
            for (int gI = 0; gI < 8; ++gI) { tot += sPart[gI * 64 + F.tid]; bef += sPart[512 + gI * 64 + F.tid]; }
            sTot[F.tid] = tot; sBef[F.tid] = bef; }
        __syncthreads();
        if (F.tid < 2) { int ps = 0; for (int e = 0; e < 32; ++e) { sPs[F.tid * 33 + e] = ps; ps += ((sTot[F.tid * 32 + e] + 255) >> 8) << 8; } sPs[F.tid * 33 + 32] = ps;
            if (tile == 0) { META[F.tid] = ps >> 8; for (int e = 0; e <= 32; ++e) META[16 + 64 * F.tid + e] = sPs[F.tid * 33 + e]; } }
        int e0 = 0, e1 = 0; float w0 = 0.f, w1 = 0.f;
        if (F.tid < 128) { const int t = tile * 128 + F.tid; e0 = ((const int*)(F.ws + WS_ROUTE))[2 * t]; e1 = ((const int*)(F.ws + WS_ROUTE))[2 * t + 1];
            w0 = ((const float*)(F.ws + WS_ROUTE))[2 * T + 2 * t]; w1 = ((const float*)(F.ws + WS_ROUTE))[2 * T + 2 * t + 1]; sE[F.tid] = e0; sE[128 + F.tid] = e1; }
        __syncthreads();
        if (F.tid < 128) { int r0 = 0, r1 = 0; for (int j = 0; j < F.tid; ++j) { r0 += (sE[j] == e0) ? 1 : 0; r1 += (sE[128 + j] == e1) ? 1 : 0; }
            const int p0 = sPs[e0] + sBef[e0] + r0, p1 = sPs[33 + e1] + sBef[32 + e1] + r1;
            tokl[p0] = tile * 128 + F.tid; wl[p0] = w0; tokl[LISTCAP + p1] = tile * 128 + F.tid; wl[LISTCAP + p1] = w1; }
        __syncthreads();
    }
}
__device__ __forceinline__ void phase_final(const Ctx& F, const float* SS) {
    const int gw = F.bid * NWAVES + F.wave, NGW = F.G * NWAVES, lane = F.lane;
    const f32x4* g = (const f32x4*)F.in[I_GFIN] + 2 * lane; const f32x4 g00 = g[0], g01 = g[1], g10 = g[128], g11 = g[129];
    for (int m0 = gw; m0 < T; m0 += 4 * NGW) {
        u32x4 xr[4][2]; f32x4 sa[4];
#pragma unroll
        for (int r = 0; r < 4; ++r) { const int m = m0 + r * NGW; const u32x4* xp = (const u32x4*)((const bf16_t*)(F.ws + WS_XBT) + (size_t)m * D) + lane; xr[r][0] = xp[0]; xr[r][1] = xp[64];
            sa[r] = *((const f32x4*)(SS + (size_t)m * 16) + (lane & 3)); }
        PIN8(xr[0][0], xr[0][1], xr[1][0], xr[1][1], xr[2][0], xr[2][1], xr[3][0], xr[3][1]); PIN4(sa[0], sa[1], sa[2], sa[3]);
#pragma unroll
        for (int r = 0; r < 4; ++r) { const int m = m0 + r * NGW; float sq = (sa[r].x + sa[r].y) + (sa[r].z + sa[r].w); sq += __shfl_xor(sq, 1); sq += __shfl_xor(sq, 2);
            const float rs = rsqrtf(sq * (1.0f / 1024.0f) + EPS); f32x4* o = (f32x4*)(F.out + (size_t)m * D) + 2 * lane;
            f32x4 x0, x1; unpack8(xr[r][0], x0, x1); o[0] = x0 * rs * g00; o[1] = x1 * rs * g01; unpack8(xr[r][1], x0, x1); o[128] = x0 * rs * g10; o[129] = x1 * rs * g11; }
    }
}
constexpr int PH_PER_LAYER = 15, PH_FINAL = DEPTH * PH_PER_LAYER, N_PHASES = PH_FINAL + 1;
struct Args { const float* in[28]; float* out; unsigned char* ws; int ph_lo, ph_hi; };

__device__ __forceinline__ Ctx mkctx(const Args& args, LAS unsigned char* lds, int wave_s) {
    Ctx F; asm volatile("" : "+s"(wave_s)); int tid = wave_s * 64 + lane_id_(); asm volatile("" : "+v"(tid));
    GAS unsigned char* wsg = (GAS unsigned char*)args.ws; asm volatile("" : "+s"(wsg)); unsigned char* ws = (unsigned char*)wsg;
    GAS float* outg = (GAS float*)args.out; asm volatile("" : "+s"(outg)); float* outp = (float*)outg;
    int bid = blockIdx.x; asm volatile("" : "+s"(bid)); int G = gridDim.x; asm volatile("" : "+s"(G));
    F.in.p = args.in; F.out = outp; F.ws = ws; F.lds = lds;
    F.tid = tid; F.lane = tid & 63; F.wave = wave_s; F.G = G; F.bid = bid;
    return F;
}
#ifndef ONLY_PHASE
#define ONLY_PHASE -1
#endif
#ifndef STAGGER_TICKS
#define STAGGER_TICKS 1300
#endif
__device__ __forceinline__ void run_phase(const Args& args, LAS unsigned char* lds, int ph, int wave_s) {
    const int layer = ph / PH_PER_LAYER, lp = ph - layer * PH_PER_LAYER;
    const size_t ssin = (layer & 1) ? WS_SS1 : WS_SS0, ssmid = (layer & 1) ? WS_SS0 : WS_SS1;
    if (ph == PH_FINAL) { const Ctx F = mkctx(args, lds, wave_s); phase_final(F, (const float*)(F.ws + WS_SS0)); return; }
    if (ONLY_PHASE >= 0 && lp != ONLY_PHASE) return;
    switch (lp) {
    case 0: { const Ctx F = mkctx(args, lds, wave_s); phase_prep(F, layer, (float*)(F.ws + ssin)); } break;
    case 1: { const Ctx F = mkctx(args, lds, wave_s); PhProj P{(const char*)F.ws + WS_XB, (const char*)F.ws + WS_WIN, (const float*)(F.ws + ssin), F.ws, F.G, F.bid}; pg8::gemm_phase(F.lds, P, F.tid); } break;
    case 2: { const Ctx F = mkctx(args, lds, wave_s);
        for (int it = F.bid; it < 768; it += F.G) attn_strip(F, it);
        __syncthreads();
        for (int it = F.bid; it < 1024; it += F.G) mlstm_local_mfma(F, layer, it);
        for (int it = F.bid; it < 1024; it += F.G) conv_item(F, layer, it);
    } break;
    case 3: { const Ctx F = mkctx(args, lds, wave_s); phase_scan(F); attn_combine(F); } break;
    case 4: { const Ctx F = mkctx(args, lds, wave_s); for (int it = F.bid; it < 1024; it += F.G) mlstm_out_mfma(F, layer, it); } break;
    case 5: { const Ctx F = mkctx(args, lds, wave_s); PhGates P{(const char*)F.ws + WS_XB, (const char*)F.ws + WS_WIN, (const float*)(F.ws + ssin), F.ws, F.G, F.bid}; pg8::gemm_phase(F.lds, P, F.tid); } break;
    case 6: { const Ctx F = mkctx(args, lds, wave_s); PhMerge P{F.ws, F.G, F.bid};
        pg8::gemm_phase(F.lds, P, F.tid); } break;
    case 7: { const Ctx F = mkctx(args, lds, wave_s); PhOut P{F.ws, (float*)(F.ws + ssmid), F.G, F.bid}; pg8::gemm_phase(F.lds, P, F.tid); } break;
    case 8: { const Ctx F = mkctx(args, lds, wave_s); PhRouter P{F.ws, (const float*)(F.ws + ssmid), F.G, F.bid}; pg8::gemm_phase(F.lds, P, F.tid);
        { int* tokl = (int*)(F.ws + WS_LISTS); for (int i = F.bid * NTHREADS + F.tid; i < 2 * LISTCAP; i += F.G * NTHREADS) tokl[i] = -1; }
        for (int pm = F.bid; pm < 128; pm += F.G) phase_route(F, layer, 2 * pm, 2 * pm + 2, 1);
        phase_prep_experts(F, layer); } break;
    case 9: break;
    case 10: { const Ctx F = mkctx(args, lds, wave_s); phase_dispatch(F); } break;
    case 11: { const Ctx F = mkctx(args, lds, wave_s); PhUp P{F.ws, (const float*)(F.ws + ssmid), (const int*)(F.ws + WS_TAB + TAB_META), (const int*)(F.ws + WS_LISTS), F.G, F.bid}; pg8::gemm_phase(F.lds, P, F.tid); } break;
    case 12: { const Ctx F = mkctx(args, lds, wave_s); PhDown<1> P{F.ws, (float*)(F.ws + ssin), (const int*)(F.ws + WS_TAB + TAB_META), (const int*)(F.ws + WS_LISTS), (const float*)(F.ws + WS_LISTS) + 2 * LISTCAP, F.G, F.bid}; pg8::gemm_phase(F.lds, P, F.tid); } break;
    case 13: { const Ctx F = mkctx(args, lds, wave_s); PhDown<0> P{F.ws, (float*)(F.ws + ssin), (const int*)(F.ws + WS_TAB + TAB_META), (const int*)(F.ws + WS_LISTS), (const float*)(F.ws + WS_LISTS) + 2 * LISTCAP, F.G, F.bid}; pg8::gemm_phase(F.lds, P, F.tid); } break;
    case 14: { const Ctx F = mkctx(args, lds, wave_s); PhPle P{F.ws, (const float*)(F.ws + ssin), (float*)(F.ws + ssmid), F.G, F.bid}; pg8::gemm_phase(F.lds, P, F.tid); } break;
    }
}

__global__ void __launch_bounds__(NTHREADS, 2) fwd_kernel(Args args) {
    extern __shared__ __attribute__((aligned(16))) unsigned char lds_raw[];
    LAS unsigned char* lds = (LAS unsigned char*)lds_raw;
    volatile LAS unsigned* MISC = (volatile LAS unsigned*)(lds + MISC_OFF);
    const int wave_s = __builtin_amdgcn_readfirstlane((int)threadIdx.x >> 6);
    if (wave_s == 0) MISC[lane_id_()] = 0u;
    __syncthreads();
#if MK_MEGA
    XcdBarrier bar = xcd_barrier_post((unsigned*)(args.ws + WS_CTL) + 4096, MISC + 8, wave_s);
#endif
#ifndef PROBE_SEL
#define PROBE_SEL 0
#endif
    unsigned long long extra = 0ull;
    for (int ph = args.ph_lo; ph < args.ph_hi; ++ph) {
        if (ph < PH_FINAL && (ph % PH_PER_LAYER) == 9) continue;
        const unsigned long long t0 = PROBE_SEL ? __builtin_amdgcn_s_memrealtime() : 0ull;
        run_phase(args, lds, ph, wave_s);
#if MK_MEGA
        if (ph + 1 < args.ph_hi) xcd_barrier(bar);
#endif
        if (PROBE_SEL) { const int lp = ph % PH_PER_LAYER; if (ph < PH_FINAL && ((PROBE_SEL >> lp) & 1)) extra += __builtin_amdgcn_s_memrealtime() - t0; }
    }
    if (PROBE_SEL && blockIdx.x == 0) { const unsigned long long te = __builtin_amdgcn_s_memrealtime(); while (__builtin_amdgcn_s_memrealtime() - te < extra) __builtin_amdgcn_s_sleep(8); }
}

extern "C" void kernel_launch(void* const* d_in, const int* in_sizes, int n_in, void* d_out, int out_size, void* d_ws, size_t ws_size, hipStream_t stream) {
    static int grid = 0;
    if (grid == 0) {
        if (n_in != 28 || out_size != T * D || ws_size < WS_END) { fprintf(stderr, "kernel_launch: unexpected shapes (n_in %d out %d ws %zu, need %zu)\n", n_in, out_size, ws_size, (size_t)WS_END); grid = -1; return; }
        int dev = 0, cus = 0, per_cu = 0;
        if (hipGetDevice(&dev) != hipSuccess || hipDeviceGetAttribute(&cus, hipDeviceAttributeMultiprocessorCount, dev) != hipSuccess) { grid = -1; return; }
        if (hipFuncSetAttribute((const void*)fwd_kernel, hipFuncAttributeMaxDynamicSharedMemorySize, LDS_BYTES) != hipSuccess) { fprintf(stderr, "kernel_launch: hipFuncSetAttribute failed\n"); grid = -1; return; }
        if (hipOccupancyMaxActiveBlocksPerMultiprocessor(&per_cu, (const void*)fwd_kernel, NTHREADS, LDS_BYTES) != hipSuccess || per_cu < 1) { fprintf(stderr, "kernel_launch: occupancy query says %d blocks per CU\n", per_cu); }
        (void)hipGetLastError();
        grid = cus;
    }
    if (grid < 0) return;
    Args a{};
    for (int i = 0; i < 28; ++i) a.in[i] = (const float*)d_in[i];
    a.out = (float*)d_out; a.ws = (unsigned char*)d_ws;
#if MK_MEGA
    (void)hipMemsetAsync((char*)d_ws + WS_CTL, 0, CTL_ZERO_BYTES, stream);
    a.ph_lo = 0; a.ph_hi = N_PHASES;
    hipLaunchKernelGGL(fwd_kernel, dim3(grid), dim3(NTHREADS), LDS_BYTES, stream, a);
#else
    for (int ph = 0; ph < N_PHASES; ++ph) { a.ph_lo = ph; a.ph_hi = ph + 1; hipLaunchKernelGGL(fwd_kernel, dim3(grid), dim3(NTHREADS), LDS_BYTES, stream, a); }
#endif
}
```

```cpp
#include <hip/hip_runtime.h>
#include <cstdio>
#include <cstdint>

#ifndef MK_MEGA
#define MK_MEGA 1
#endif

#ifndef ABL
#define ABL 0
#endif
#define LAS __attribute__((address_space(3)))
#define GAS __attribute__((address_space(1)))
typedef unsigned short bf16_t;
typedef short bf16x8 __attribute__((ext_vector_type(8)));
typedef float f32x4 __attribute__((ext_vector_type(4)));
typedef float f32x2 __attribute__((ext_vector_type(2)));
typedef unsigned u32x4 __attribute__((ext_vector_type(4)));
typedef unsigned u32x2 __attribute__((ext_vector_type(2)));

constexpr int T = 32768, SEQ = 16384, D = 1024, DEPTH = 2;
constexpr int D_IN = 8712;
constexpr float EPS = 1e-6f;
constexpr int NTHREADS = 512, NWAVES = 8;
constexpr int LISTCAP = 40960;

constexpr size_t MiB = 1u << 20;
constexpr size_t WS_CTL = 0, CTL_ZERO_BYTES = 1 * MiB;
constexpr size_t WS_TAB = 1 * MiB;
constexpr size_t WS_ROUTE = 2 * MiB;
constexpr size_t WS_LISTS = 3 * MiB;
constexpr size_t WS_SS0 = 4 * MiB, WS_SS1 = 6 * MiB;
constexpr size_t WS_IF = 8 * MiB;
constexpr size_t WS_NST = 9 * MiB;
constexpr size_t WS_LOGITS = 10 * MiB;
constexpr size_t WS_WIN = 18 * MiB;
constexpr size_t WS_WBR = WS_WIN + 8960ull * 1024 * 2;
constexpr size_t WS_WOUT = WS_WBR + 3ull * 1024 * 512 * 2;
constexpr size_t WS_WPG = WS_WOUT + 1024ull * 1024 * 2;
constexpr size_t WS_WPP = WS_WPG + 1024ull * 1024 * 2;
constexpr size_t WS_WR = WS_WPP + 1024ull * 256 * 2;
static_assert(WS_WR + 256ull * 1024 * 2 <= 44 * MiB, "small weights");
constexpr size_t WS_XB = 44 * MiB;
constexpr size_t WS_QA0 = 108 * MiB;
constexpr size_t WS_YATT = WS_QA0;
constexpr size_t WS_OM = 140 * MiB;
constexpr size_t WS_YC = 172 * MiB;
constexpr size_t WS_CST = 204 * MiB;
constexpr size_t WS_B = 236 * MiB;
constexpr size_t WS_KA = WS_B, WS_QA1 = WS_B + 32 * MiB, WS_QA2 = WS_B + 64 * MiB, WS_VA = WS_B + 96 * MiB, WS_YG = WS_B + 128 * MiB, WS_QM = WS_B + 160 * MiB, WS_KM = WS_B + 192 * MiB, WS_VM = WS_B + 224 * MiB;
constexpr size_t WS_G0 = WS_B, WS_MERGED = WS_B + 192 * MiB;
constexpr size_t WS_WEXP = WS_B, WS_HB = WS_B + 48 * MiB, WS_PBF = WS_B + 88 * MiB, WS_PE = WS_B + 104 * MiB, WS_YB1 = WS_B + 168 * MiB, WS_XBT = WS_B;
constexpr size_t WS_END = 492 * MiB;
constexpr size_t TAB_CNT = 0;
constexpr size_t TAB_META = 65536;
constexpr size_t TAB_MLOC = 131072, TAB_GTOT = 131072 + 4096, TAB_MST = 131072 + 8192;

constexpr int RING_BYTES = 131072;
constexpr int MISC_OFF = 155648;
constexpr int LDS_BYTES = 156672;

__device__ __forceinline__ unsigned f2bf(float f) { unsigned u = __builtin_bit_cast(unsigned, f); return (u + 0x7fffu + ((u >> 16) & 1u)) >> 16; }
__device__ __forceinline__ unsigned pk2(float lo, float hi) { return f2bf(lo) | (f2bf(hi) << 16); }
__device__ __forceinline__ unsigned cvt_pk_bf16(float lo, float hi) { unsigned r; asm volatile("v_cvt_pk_bf16_f32 %0, %1, %2" : "=v"(r) : "v"(lo), "v"(hi)); return r; }
__device__ __forceinline__ float bf_lo(unsigned w) { return __builtin_bit_cast(float, w << 16); }
__device__ __forceinline__ float bf_hi(unsigned w) { return __builtin_bit_cast(float, w & 0xffff0000u); }
__device__ __forceinline__ float bf1(bf16_t h) { return __builtin_bit_cast(float, ((unsigned)h) << 16); }
__device__ __forceinline__ float sigmoidf_(float v) { return __builtin_amdgcn_rcpf(1.0f + __expf(-v)); }
__device__ __forceinline__ float siluf_(float v) { return v * __builtin_amdgcn_rcpf(1.0f + __expf(-v)); }
__device__ __forceinline__ float wave_sum(float v) {
#pragma unroll
    for (int o = 1; o < 64; o <<= 1) v += __shfl_xor(v, o);
    return v;
}
__device__ __forceinline__ float wave_max(float v) {
#pragma unroll
    for (int o = 1; o < 64; o <<= 1) v = fmaxf(v, __shfl_xor(v, o));
    return v;
}
__device__ __forceinline__ int lane_id_() { int l; asm volatile("v_mbcnt_lo_u32_b32 %0, -1, 0\n\tv_mbcnt_hi_u32_b32 %0, -1, %0" : "=&v"(l)); return l; }
#define LDS_WAIT() asm volatile("s_waitcnt lgkmcnt(0)" ::: "memory")
#define VM_WAIT() asm volatile("s_waitcnt vmcnt(0)" ::: "memory")

#define XB_TMO      128
#define XB_XCNT(j)  (256  + 64 * (j))
#define XB_XSUB(j)  (1280 + 64 * (j))
#define XB_XGEN(j)  (2304 + 64 * (j))
#define XB_TOP      3328
#define XB_TOPGEN   3392
#define XCD_BAR_WORDS 3456
#define XB_SPIN_CAP (1u << 22)
__device__ __forceinline__ unsigned xb_ld(unsigned* p)              { return __hip_atomic_load(p, __ATOMIC_RELAXED, __HIP_MEMORY_SCOPE_AGENT); }
__device__ __forceinline__ unsigned xb_add(unsigned* p, unsigned v) { return __hip_atomic_fetch_add(p, v, __ATOMIC_RELAXED, __HIP_MEMORY_SCOPE_AGENT); }
__device__ __forceinline__ unsigned xb_xcc_id() { return (unsigned)__builtin_amdgcn_s_getreg((3 << 11) | 20) & 0xFu; }
#define XB_SPIN(cond, bar) do { unsigned _sp = 0; while (cond) { __builtin_amdgcn_s_sleep(1); \
    if ((++_sp & 255u) == 0u) { if (xb_ld(&(bar)[XB_TMO])) break; if (_sp > XB_SPIN_CAP) { atomicAdd(&(bar)[XB_TMO], 1u); break; } } } } while (0)
struct XcdBarrier { unsigned* bar; unsigned x; volatile LAS unsigned* st; int wave; };
__device__ __forceinline__ XcdBarrier xcd_barrier_post(unsigned* bar, volatile LAS unsigned* st, int wave) {
    XcdBarrier b; b.bar = bar; b.x = xb_xcc_id(); b.st = st; b.wave = wave;
    if (wave == 0 && lane_id_() == 0) (void)xb_add(&bar[XB_XCNT(b.x)], 1u);
    return b;
}
__device__ __forceinline__ void xcd_barrier_complete(unsigned* bar, unsigned x, unsigned& nloc, unsigned& nx) {
    const unsigned G = gridDim.x * gridDim.y * gridDim.z;
    unsigned sum, cnt, mine, sp = 0u;
    for (;;) {
        sum = 0u; cnt = 0u; mine = 0u;
#pragma unroll
        for (unsigned j = 0; j < 16; ++j) { const unsigned c = xb_ld(&bar[XB_XCNT(j)]); sum += c; cnt += (c > 0u) ? 1u : 0u; mine = (j == x) ? c : mine; }
        if (sum == G) break;
        __builtin_amdgcn_s_sleep(1);
        if ((++sp & 255u) == 0u) { if (xb_ld(&bar[XB_TMO])) break; if (sp > XB_SPIN_CAP) { atomicAdd(&bar[XB_TMO], 1u); break; } }
    }
    nloc = mine > 0u ? mine : 1u; nx = cnt > 0u ? cnt : 1u;
}
__device__ __forceinline__ void xcd_barrier(const XcdBarrier& b) {
    asm volatile("s_waitcnt vmcnt(0)" ::: "memory");
    __syncthreads();
    if (b.wave == 0 && lane_id_() == 0) {
        unsigned* bar = b.bar;
        __builtin_amdgcn_s_waitcnt(0);
        unsigned nloc = b.st[0], nx = b.st[1];
        if (nloc == 0u) { xcd_barrier_complete(bar, b.x, nloc, nx); b.st[0] = nloc; b.st[1] = nx; }
        const unsigned old = xb_add(&bar[XB_XSUB(b.x)], 1u);
        const unsigned gen = old / nloc;
        if (old + 1u == (gen + 1u) * nloc) {
            __builtin_amdgcn_fence(__ATOMIC_RELEASE, "agent");
            asm volatile("s_waitcnt vmcnt(0)" ::: "memory");
            const unsigned og = xb_add(&bar[XB_TOP], 1u);
            const unsigned tg = og / nx;
            if (og + 1u == (tg + 1u) * nx) xb_add(&bar[XB_TOPGEN], 1u);
            else XB_SPIN(xb_ld(&bar[XB_TOPGEN]) == tg, bar);
            __builtin_amdgcn_fence(__ATOMIC_ACQUIRE, "agent");
            xb_add(&bar[XB_XGEN(b.x)], 1u);
            asm volatile("s_waitcnt vmcnt(0)" ::: "memory");
        } else {
            XB_SPIN(xb_ld(&bar[XB_XGEN(b.x)]) == gen, bar);
            __builtin_amdgcn_fence(__ATOMIC_ACQUIRE, "agent");
            asm volatile("s_waitcnt vmcnt(0)" ::: "memory");
        }
    }
    __syncthreads();
}

namespace pg8 {
constexpr int BM = 256, BK = 64, HALF = 128, HTB = HALF * BK * 2, NXCD = 8, WGM = 8;
__device__ __forceinline__ int lds_byte(int r, int c) { const int st = (r >> 4) * 2 + (c >> 5), rr = r & 15, cc = c & 31, ob = rr * 64 + cc * 2; return st * 1024 + (ob ^ (((ob >> 9) & 1) << 5)); }
__device__ __forceinline__ void stage_rc(int b, int& R, int& C) { const int st = b / 1024, sb = b % 1024, swz = sb ^ (((sb >> 9) & 1) << 5); R = (st >> 1) * 16 + swz / 64; C = (st & 1) * 32 + (swz % 64) / 2; }
__device__ __forceinline__ int perm32(int rho) { const int n = rho >> 4, i = rho & 15; return 8 * (i >> 2) + 4 * n + (i & 3); }

struct GUnit { const char* A; const char* B; int pm, pn, a0, a1; };

__device__ __forceinline__ void tile_order(int L, int nM, int nN, int& pm, int& pn) {
    const int nwg = nM * nN; int wgid = L;
    { const int q = nwg / NXCD, r = nwg % NXCD, xcd = wgid % NXCD, off = wgid / NXCD; wgid = (xcd < r ? xcd * (q + 1) : r * (q + 1) + (xcd - r) * q) + off; }
    const int nig = WGM * nN, gid = wgid / nig, fm = gid * WGM, gsz = (nM - fm) < WGM ? (nM - fm) : WGM;
    pm = fm + ((wgid % nig) % gsz); pn = (wgid % nig) / gsz;
}

typedef f32x4 Acc[2][2][4][2];

template <class P>
__device__ __forceinline__ void gemm_phase(LAS unsigned char* lds, const P& S, int tid) {
    asm volatile("" : "+v"(tid));
    const int wid = __builtin_amdgcn_readfirstlane(tid >> 6), lane = tid & 63, wr = wid >> 2, wc = wid & 3, fr = lane & 15, fq = lane >> 4;
    constexpr int K = P::K, nt = K / BK;
    static_assert(nt >= 4 && (nt % 2) == 0, "K multiple of 128, >= 256");
    unsigned voffB[2];
#pragma unroll
    for (int i = 0; i < 2; ++i) { int R, C; stage_rc(tid * 16 + i * 8192, R, C); const int Rb = (R & ~31) + perm32(R & 31); voffB[i] = (unsigned)(Rb * K + C) * 2u; }
    constexpr size_t kstep = (size_t)(BK * 2);
    constexpr size_t hstepB = (size_t)HALF * K * 2;
    const unsigned ldsw = (unsigned)wid * 1024u;
    const int aoff = lds_byte(wr * 64 + fr, fq * 8), boff = lds_byte(wc * 32 + fr, fq * 8);
#define PG8_SA(b, h) (((b) * 2 + (h)) * HTB)
#define PG8_SB(b, h) ((4 + (b) * 2 + (h)) * HTB)
#define PG8_STAGE(bufoff, gbase, voff) do { _Pragma("unroll") for (int _i = 0; _i < 2; ++_i) \
        __builtin_amdgcn_global_load_lds((const unsigned*)((const char*)(gbase) + (voff)[_i]), (LAS unsigned*)(lds + (bufoff) + ldsw + _i * 8192), 16, 0, 0); } while (0)
#define PG8_LDA(dst, b, h) do { _Pragma("unroll") for (int m = 0; m < 4; ++m) _Pragma("unroll") for (int k = 0; k < 2; ++k) dst[m][k] = *(const LAS bf16x8*)(lds + PG8_SA(b, h) + aoff + m * 2048 + k * 1024); } while (0)
#define PG8_LDB(dst, b, h) do { _Pragma("unroll") for (int n = 0; n < 2; ++n) _Pragma("unroll") for (int k = 0; k < 2; ++k) dst[n][k] = *(const LAS bf16x8*)(lds + PG8_SB(b, h) + boff + n * 2048 + k * 1024); } while (0)
#define PG8_MMA(ai, bj, At, Bt) do { __builtin_amdgcn_s_setprio(1); _Pragma("unroll") for (int m = 0; m < 4; ++m) _Pragma("unroll") for (int n = 0; n < 2; ++n) _Pragma("unroll") for (int k = 0; k < 2; ++k) \
        acc[ai][bj][m][n] = __builtin_amdgcn_mfma_f32_16x16x32_bf16(Bt[n][k], At[m][k], acc[ai][bj][m][n], 0, 0, 0); __builtin_amdgcn_s_setprio(0); } while (0)
#define PG8_WAIT_V(n) asm volatile("s_waitcnt vmcnt(" #n ")" ::: "memory")
#define PG8_WAIT_L(n) asm volatile("s_waitcnt lgkmcnt(" #n ")" ::: "memory")
#define PG8_BAR __builtin_amdgcn_s_barrier()
#define PG8_SCHED __builtin_amdgcn_sched_barrier(0)
#define PG8_VOA(dst, u) do { _Pragma("unroll") for (int _h = 0; _h < 2; ++_h) _Pragma("unroll") for (int _i = 0; _i < 2; ++_i) { int _R, _C; stage_rc(tid * 16 + _i * 8192, _R, _C); \
        if constexpr (P::GATHER) dst[_h][_i] = (S.arow(u, _h * HALF + _R) * (unsigned)K + (unsigned)_C) * 2u; \
        else dst[_h][_i] = (unsigned)((_h * HALF + _R) * K + _C) * 2u; } } while (0)
    GUnit cur, nxt; int ui = 0;
    if (!S.next(0, cur)) return;
    Acc acc;
#pragma unroll
    for (int a = 0; a < 2; ++a)
#pragma unroll
        for (int b = 0; b < 2; ++b)
#pragma unroll
            for (int m = 0; m < 4; ++m)
#pragma unroll
                for (int n = 0; n < 2; ++n) acc[a][b][m][n] = (f32x4){0.f, 0.f, 0.f, 0.f};
    bf16x8 At[4][2], B0[2][2], B1[2][2];
    unsigned voA[2][2], voAn[2][2];
    PG8_VOA(voA, cur);
    const char* cA = cur.A; const char* cB = cur.B;
    PG8_STAGE(PG8_SB(0, 0), cB, voffB); PG8_STAGE(PG8_SB(0, 1), cB + hstepB, voffB); PG8_STAGE(PG8_SA(0, 0), cA, voA[0]); PG8_STAGE(PG8_SA(0, 1), cA, voA[1]);
    if (wr == 1) PG8_BAR;
    PG8_WAIT_V(2); PG8_BAR;
    PG8_STAGE(PG8_SB(1, 0), cB + kstep, voffB); PG8_STAGE(PG8_SA(1, 0), cA + kstep, voA[0]); PG8_STAGE(PG8_SB(1, 1), cB + hstepB + kstep, voffB);
    PG8_WAIT_V(6); PG8_BAR;
    for (;;) {
        const bool has_next = S.next(ui + 1, nxt);
        const char* nA = has_next ? nxt.A : cA; const char* nB = has_next ? nxt.B : cB;
        if constexpr (P::GATHER) {
            if (has_next) { PG8_VOA(voAn, nxt); }
            else {
#pragma unroll
                for (int h = 0; h < 2; ++h)
#pragma unroll
                    for (int i = 0; i < 2; ++i) voAn[h][i] = voA[h][i];
            }
        }
#pragma unroll 1
        for (int t = 0; t < nt; t += 2) {
            const bool last = (t == nt - 2);
            const char* a1 = cA + (size_t)(t + 1) * kstep;
            const char* a2 = last ? nA : cA + (size_t)(t + 2) * kstep; const char* b2 = last ? nB : cB + (size_t)(t + 2) * kstep;
            const char* a3 = a2 + kstep; const char* b3 = b2 + kstep;
            unsigned s0[2], s1[2];
#pragma unroll
            for (int i = 0; i < 2; ++i) {
                if constexpr (P::GATHER) { s0[i] = last ? voAn[0][i] : voA[0][i]; s1[i] = last ? voAn[1][i] : voA[1][i]; }
                else { s0[i] = voA[0][i]; s1[i] = voA[1][i]; }
            }
            PG8_LDB(B0, 0, 0); PG8_LDB(B1, 0, 1); PG8_SCHED; PG8_LDA(At, 0, 0); PG8_STAGE(PG8_SA(1, 1), a1, voA[1]);
            PG8_WAIT_V(8); PG8_WAIT_L(0); PG8_BAR; PG8_MMA(0, 0, At, B0); PG8_MMA(0, 1, At, B1); PG8_BAR; PG8_SCHED;
            PG8_LDA(At, 0, 1); PG8_STAGE(PG8_SB(0, 0), b2, voffB); PG8_STAGE(PG8_SB(0, 1), b2 + hstepB, voffB); PG8_STAGE(PG8_SA(0, 0), a2, s0);
            PG8_WAIT_V(8); PG8_WAIT_L(0); PG8_BAR; PG8_MMA(1, 0, At, B0); PG8_MMA(1, 1, At, B1); PG8_BAR; PG8_SCHED;
            PG8_LDB(B0, 1, 0); PG8_LDB(B1, 1, 1); PG8_SCHED; PG8_LDA(At, 1, 0); PG8_STAGE(PG8_SA(0, 1), a2, s1);
            PG8_WAIT_V(8); PG8_WAIT_L(0); PG8_BAR; PG8_MMA(0, 0, At, B0); PG8_MMA(0, 1, At, B1); PG8_BAR; PG8_SCHED;
            PG8_LDA(At, 1, 1); PG8_STAGE(PG8_SB(1, 0), b3, voffB); PG8_STAGE(PG8_SB(1, 1), b3 + hstepB, voffB); PG8_STAGE(PG8_SA(1, 0), a3, s0);
            PG8_WAIT_V(8); PG8_WAIT_L(0); PG8_BAR; PG8_MMA(1, 0, At, B0); PG8_MMA(1, 1, At, B1); PG8_BAR; PG8_SCHED;
        }
        if (wr == 0) PG8_BAR;
        const bool zero = S.epi(acc, cur, wr, wc, fr, fq);
        if (!has_next) break;
        if (zero) {
#pragma unroll
            for (int a = 0; a < 2; ++a)
#pragma unroll
                for (int b = 0; b < 2; ++b)
#pragma unroll
                    for (int m = 0; m < 4; ++m)
#pragma unroll
                        for (int n = 0; n < 2; ++n) acc[a][b][m][n] = (f32x4){0.f, 0.f, 0.f, 0.f};
        }
        cur = nxt; cA = nA; cB = nB; ++ui;
        if constexpr (P::GATHER) {
#pragma unroll
            for (int h = 0; h < 2; ++h)
#pragma unroll
                for (int i = 0; i < 2; ++i) voA[h][i] = voAn[h][i];
        }
        if (wr == 1) PG8_BAR;
    }
    PG8_WAIT_V(0);
    PG8_BAR;
#undef PG8_SA
#undef PG8_SB
#undef PG8_STAGE
#undef PG8_LDA
#undef PG8_LDB
#undef PG8_MMA
#undef PG8_WAIT_V
#undef PG8_WAIT_L
#undef PG8_BAR
#undef PG8_SCHED
#undef PG8_VOA
}
}
using pg8::GUnit; using pg8::Acc;

__device__ __forceinline__ float row_rs(const float* SS, int row) {
    const f32x4* p = (const f32x4*)(SS + (size_t)row * 16);
    const f32x4 a = p[0], b = p[1], c = p[2], d = p[3];
    const float s = (((a.x + a.y) + (a.z + a.w)) + ((b.x + b.y) + (b.z + b.w))) + (((c.x + c.y) + (c.z + c.w)) + ((d.x + d.y) + (d.z + d.w)));
    return rsqrtf(s * (1.0f / 1024.0f) + EPS);
}
#define PIN1(a) asm volatile("" : "+v"(a))
#define PIN2(a, b) asm volatile("" : "+v"(a), "+v"(b))
#define PIN4(a, b, c, d) asm volatile("" : "+v"(a), "+v"(b), "+v"(c), "+v"(d))
#define PIN8(a, b, c, d, e, f, g, h) asm volatile("" : "+v"(a), "+v"(b), "+v"(c), "+v"(d), "+v"(e), "+v"(f), "+v"(g), "+v"(h))
__device__ __forceinline__ void row_rs8(const float* SS, int row0, float (&rs)[8]) {
#pragma unroll
    for (int hh = 0; hh < 4; ++hh) { f32x4 a[2], b[2], c[2], d[2];
#pragma unroll
        for (int g = 0; g < 2; ++g) { const f32x4* p = (const f32x4*)(SS + (size_t)(row0 + (hh >> 1) * 128 + ((hh & 1) * 2 + g) * 16) * 16); a[g] = p[0]; b[g] = p[1]; c[g] = p[2]; d[g] = p[3]; }
#pragma unroll
        for (int g = 0; g < 2; ++g) { const f32x4 t = (a[g] + b[g]) + (c[g] + d[g]); rs[hh * 2 + g] = rsqrtf(((t.x + t.y) + (t.z + t.w)) * (1.0f / 1024.0f) + EPS); }
        PIN2(rs[hh * 2], rs[hh * 2 + 1]); }
}
__device__ __forceinline__ u32x4 pack8(const f32x4 v0, const f32x4 v1) { u32x4 w; w.x = cvt_pk_bf16(v0[0], v0[1]); w.y = cvt_pk_bf16(v0[2], v0[3]); w.z = cvt_pk_bf16(v1[0], v1[1]); w.w = cvt_pk_bf16(v1[2], v1[3]); return w; }
__device__ __forceinline__ void unpack8(const u32x4 w, f32x4& v0, f32x4& v1) { v0 = (f32x4){bf_lo(w.x), bf_hi(w.x), bf_lo(w.y), bf_hi(w.y)}; v1 = (f32x4){bf_lo(w.z), bf_hi(w.z), bf_lo(w.w), bf_hi(w.w)}; }
__device__ __forceinline__ f32x4 sig4(const f32x4 v) { return (f32x4){sigmoidf_(v[0]), sigmoidf_(v[1]), sigmoidf_(v[2]), sigmoidf_(v[3])}; }
__device__ __forceinline__ f32x4 gate4(const f32x4 v) { f32x4 s = sig4(v); return (f32x4){fmaxf(s[0], 1e-6f), fmaxf(s[1], 1e-6f), fmaxf(s[2], 1e-6f), fmaxf(s[3], 1e-6f)}; }

struct PhProj {
    static constexpr int K = 1024; static constexpr bool GATHER = false;
    const char* xb; const char* W; const float* SS; unsigned char* ws; int G, c;
    __device__ __forceinline__ bool next(int i, GUnit& u) const {
        const long L = (long)i * G + c; if (L >= 128 * 23) return false;
        pg8::tile_order((int)L, 128, 23, u.pm, u.pn);
        u.A = xb + (size_t)u.pm * 256 * K * 2; u.B = W + (size_t)u.pn * 256 * K * 2; u.a0 = 0; u.a1 = 0; return true;
    }
    __device__ __forceinline__ unsigned arow(const GUnit&, int) const { return 0u; }
    __device__ __forceinline__ bool epi(Acc& acc, const GUnit& u, int wr, int wc, int fr, int fq) const {
        const int pn = u.pn; const int row0 = u.pm * 256 + wr * 64 + fr;
        float rs8[8]; row_rs8(SS, row0, rs8);
        if (pn == 22) {
            if (wc == 0 && fq == 0) {
                float* IFp = (float*)(ws + WS_IF);
#pragma unroll
                for (int ai = 0; ai < 2; ++ai)
#pragma unroll
                    for (int m = 0; m < 4; ++m) { const int row = row0 + ai * 128 + m * 16; const float rs = rs8[ai * 4 + m];
                        *(f32x4*)(IFp + (size_t)row * 8) = acc[ai][0][m][0] * rs; *(f32x4*)(IFp + (size_t)row * 8 + 4) = acc[ai][0][m][1] * rs; }
            }
            return true;
        }
        if (pn >= 10 && pn < 14) {
            bf16_t* Y = (bf16_t*)(ws + WS_YG);
#pragma unroll
            for (int ai = 0; ai < 2; ++ai)
#pragma unroll
                for (int m = 0; m < 4; ++m) { const int row = row0 + ai * 128 + m * 16; const float rs = rs8[ai * 4 + m];
#pragma unroll
                    for (int bj = 0; bj < 2; ++bj) { const f32x4 a = acc[ai][bj][m][0] * rs, g = sig4(acc[ai][bj][m][1] * rs), y = a * g;
                        u32x2 w; w.x = cvt_pk_bf16(y[0], y[1]); w.y = cvt_pk_bf16(y[2], y[3]);
                        *(u32x2*)(Y + (size_t)row * 512 + (pn - 10) * 128 + bj * 64 + wc * 16 + fq * 4) = w; } }
            return true;
        }
        bf16_t* dst; int col0; bool sg = false;
        if (pn < 6) { dst = (bf16_t*)(ws + (pn < 2 ? WS_QA0 : (pn < 4 ? WS_QA1 : WS_QA2))); col0 = (pn & 1) * 256; }
        else if (pn < 8) { dst = (bf16_t*)(ws + WS_KA); col0 = (pn - 6) * 256; }
        else if (pn < 10) { dst = (bf16_t*)(ws + WS_VA); col0 = (pn - 8) * 256; }
        else if (pn < 16) { dst = (bf16_t*)(ws + WS_QM); col0 = (pn - 14) * 256; }
        else if (pn < 18) { dst = (bf16_t*)(ws + WS_KM); col0 = (pn - 16) * 256; }
        else if (pn < 20) { dst = (bf16_t*)(ws + WS_VM); col0 = (pn - 18) * 256; }
        else { dst = (bf16_t*)(ws + WS_OM); col0 = (pn - 20) * 256; sg = true; }
        col0 += wc * 32 + fq * 8;
#pragma unroll
        for (int ai = 0; ai < 2; ++ai)
#pragma unroll
            for (int m = 0; m < 4; ++m) { const int row = row0 + ai * 128 + m * 16; const float rs = rs8[ai * 4 + m];
#pragma unroll
                for (int bj = 0; bj < 2; ++bj) { f32x4 v0 = acc[ai][bj][m][0] * rs, v1 = acc[ai][bj][m][1] * rs;
                    if (sg) { v0 = sig4(v0); v1 = sig4(v1); }
                    *(u32x4*)(dst + (size_t)row * 512 + col0 + bj * 128) = pack8(v0, v1); } }
        return true;
    }
};
struct PhGates {
    static constexpr int K = 1024; static constexpr bool GATHER = false;
    const char* xb; const char* W; const float* SS; unsigned char* ws; int G, c;
    __device__ __forceinline__ bool next(int i, GUnit& u) const {
        const long L = (long)i * G + c; if (L >= 128 * 12) return false;
        pg8::tile_order((int)L, 128, 12, u.pm, u.pn);
        u.A = xb + (size_t)u.pm * 256 * K * 2; u.B = W + (size_t)(5888 + u.pn * 256) * K * 2; u.a0 = 0; u.a1 = 0; return true;
    }
    __device__ __forceinline__ unsigned arow(const GUnit&, int) const { return 0u; }
    __device__ __forceinline__ bool epi(Acc& acc, const GUnit& u, int wr, int wc, int fr, int fq) const {
        const int row0 = u.pm * 256 + wr * 64 + fr;
        float rs8[8]; row_rs8(SS, row0, rs8);
        bf16_t* dst = (bf16_t*)(ws + WS_G0 + (size_t)(u.pn >> 2) * 64 * MiB); const int col0 = (u.pn & 3) * 256 + wc * 32 + fq * 8;
#pragma unroll
        for (int ai = 0; ai < 2; ++ai)
#pragma unroll
            for (int m = 0; m < 4; ++m) { const int row = row0 + ai * 128 + m * 16; const float rs = rs8[ai * 4 + m];
#pragma unroll
                for (int bj = 0; bj < 2; ++bj) *(u32x4*)(dst + (size_t)row * 1024 + col0 + bj * 128) = pack8(gate4(acc[ai][bj][m][0] * rs), gate4(acc[ai][bj][m][1] * rs)); }
        return true;
    }
};
struct PhMerge {
    static constexpr int K = 512; static constexpr bool GATHER = false;
    unsigned char* ws; int G, c;
    __device__ __forceinline__ bool next(int i, GUnit& u) const {
        const int ti = i / 3, seg = i - ti * 3; const long L = (long)ti * G + c; if (L >= 128 * 4) return false;
        pg8::tile_order((int)L, 128, 4, u.pm, u.pn);
        const size_t ya = seg == 0 ? WS_YATT : (seg == 1 ? WS_YC : WS_OM);
        u.A = (const char*)ws + ya + (size_t)u.pm * 256 * K * 2; u.B = (const char*)ws + WS_WBR + (size_t)seg * 1024 * 512 * 2 + (size_t)u.pn * 256 * K * 2; u.a0 = seg; u.a1 = 0; return true;
    }
    __device__ __forceinline__ unsigned arow(const GUnit&, int) const { return 0u; }
    __device__ __forceinline__ bool epi(Acc& acc, const GUnit& u, int wr, int wc, int fr, int fq) const {
        const int seg = u.a0; const int row0 = u.pm * 256 + wr * 64 + fr; const int col0 = u.pn * 256 + wc * 32 + fq * 8;
        const bf16_t* Gn = (const bf16_t*)(ws + WS_G0 + (size_t)seg * 64 * MiB);
        const bf16_t* Gd = (const bf16_t*)(ws + WS_G0 + (size_t)(seg < 2 ? seg + 1 : seg) * 64 * MiB);
        bf16_t* Mo = (bf16_t*)(ws + WS_MERGED);
#pragma unroll
        for (int ai = 0; ai < 2; ++ai)
#pragma unroll
            for (int mp = 0; mp < 2; ++mp) {
                u32x4 gn[2][2], gd[2][2];
#pragma unroll
                for (int mm = 0; mm < 2; ++mm)
#pragma unroll
                    for (int bj = 0; bj < 2; ++bj) { const size_t off = (size_t)(row0 + ai * 128 + (2 * mp + mm) * 16) * 1024 + col0 + bj * 128; gn[mm][bj] = *(const u32x4*)(Gn + off); gd[mm][bj] = *(const u32x4*)(Gd + off); }
                PIN8(gn[0][0], gn[0][1], gn[1][0], gn[1][1], gd[0][0], gd[0][1], gd[1][0], gd[1][1]);
#pragma unroll
                for (int mm = 0; mm < 2; ++mm)
#pragma unroll
                    for (int bj = 0; bj < 2; ++bj) { const int m = 2 * mp + mm; const size_t off = (size_t)(row0 + ai * 128 + m * 16) * 1024 + col0 + bj * 128;
                        f32x4 n0, n1, d0, d1; unpack8(gn[mm][bj], n0, n1); unpack8(gd[mm][bj], d0, d1);
                        if (seg < 2) {
#pragma unroll
                            for (int j = 0; j < 4; ++j) { acc[ai][bj][m][0][j] *= n0[j] * __builtin_amdgcn_rcpf(d0[j]); acc[ai][bj][m][1][j] *= n1[j] * __builtin_amdgcn_rcpf(d1[j]); } }
                        else *(u32x4*)(Mo + off) = pack8(acc[ai][bj][m][0] * n0, acc[ai][bj][m][1] * n1); }
            }
        return seg == 2;
    }
};
__device__ __forceinline__ float store_x8(bf16_t* xbp, const f32x4 v0, const f32x4 v1) {
    *(u32x4*)xbp = pack8(v0, v1);
    return ((v0[0] * v0[0] + v0[1] * v0[1]) + (v0[2] * v0[2] + v0[3] * v0[3])) + ((v1[0] * v1[0] + v1[1] * v1[1]) + (v1[2] * v1[2] + v1[3] * v1[3]));
}
struct PhOut {
    static constexpr int K = 1024; static constexpr bool GATHER = false;
    unsigned char* ws; float* SSo; int G, c;
    __device__ __forceinline__ bool next(int i, GUnit& u) const {
        const long L = (long)i * G + c; if (L >= 128 * 4) return false;
        pg8::tile_order((int)L, 128, 4, u.pm, u.pn);
        u.A = (const char*)ws + WS_MERGED + (size_t)u.pm * 256 * K * 2; u.B = (const char*)ws + WS_WOUT + (size_t)u.pn * 256 * K * 2; u.a0 = 0; u.a1 = 0; return true;
    }
    __device__ __forceinline__ unsigned arow(const GUnit&, int) const { return 0u; }
    __device__ __forceinline__ bool epi(Acc& acc, const GUnit& u, int wr, int wc, int fr, int fq) const {
        const int row0 = u.pm * 256 + wr * 64 + fr; const int col0 = u.pn * 256 + wc * 32 + fq * 8; bf16_t* XB = (bf16_t*)(ws + WS_XB);
#pragma unroll
        for (int ai = 0; ai < 2; ++ai) {
            u32x4 xr[4][2];
#pragma unroll
            for (int m = 0; m < 4; ++m)
#pragma unroll
                for (int bj = 0; bj < 2; ++bj) xr[m][bj] = *(const u32x4*)(XB + (size_t)(row0 + ai * 128 + m * 16) * 1024 + col0 + bj * 128);
            PIN8(xr[0][0], xr[0][1], xr[1][0], xr[1][1], xr[2][0], xr[2][1], xr[3][0], xr[3][1]);
#pragma unroll
            for (int m = 0; m < 4; ++m) { const int row = row0 + ai * 128 + m * 16; const size_t off = (size_t)row * 1024 + col0; float ss = 0.f;
#pragma unroll
                for (int bj = 0; bj < 2; ++bj) { f32x4 x0, x1; unpack8(xr[m][bj], x0, x1); ss += store_x8(XB + off + bj * 128, x0 + acc[ai][bj][m][0], x1 + acc[ai][bj][m][1]); }
                ss += __shfl_xor(ss, 16); ss += __shfl_xor(ss, 32);
                if (fq == 0) SSo[(size_t)row * 16 + u.pn * 4 + wc] = ss; } }
        return true;
    }
};
struct PhRouter {
    static constexpr int K = 1024; static constexpr bool GATHER = false;
    unsigned char* ws; const float* SS; int G, c;
    __device__ __forceinline__ bool next(int i, GUnit& u) const {
        const long L = (long)i * G + c; if (L >= 128) return false;
        u.pm = (int)L; u.pn = 0; u.A = (const char*)ws + WS_XB + (size_t)u.pm * 256 * K * 2; u.B = (const char*)ws + WS_WR; u.a0 = 0; u.a1 = 0; return true;
    }
    __device__ __forceinline__ unsigned arow(const GUnit&, int) const { return 0u; }
    __device__ __forceinline__ bool epi(Acc& acc, const GUnit& u, int wr, int wc, int fr, int fq) const {
        if (wc < 2) { float* Lg = (float*)(ws + WS_LOGITS); const int row0 = u.pm * 256 + wr * 64 + fr;
            float rs8[8]; row_rs8(SS, row0, rs8);
#pragma unroll
            for (int ai = 0; ai < 2; ++ai)
#pragma unroll
                for (int m = 0; m < 4; ++m) { const int row = row0 + ai * 128 + m * 16; const float rs = rs8[ai * 4 + m]; float* p = Lg + (size_t)row * 64 + wc * 32 + fq * 8;
                    *(f32x4*)p = acc[ai][0][m][0] * rs; *(f32x4*)(p + 4) = acc[ai][0][m][1] * rs; } }
        return true;
    }
};
__device__ __forceinline__ int moe_expert_of(const int* META, int k, int rb) {
    const int r = rb * 256; int e = 0;
    for (int j = 1; j < 32; ++j) e += (META[16 + 64 * k + j] <= r) ? 1 : 0;
    return __builtin_amdgcn_readfirstlane(e);
}
struct PhUp {
    static constexpr int K = 1024; static constexpr bool GATHER = true;
    unsigned char* ws; const float* SS; const int* META; const int* tok; int G, c;
    __device__ __forceinline__ bool next(int i, GUnit& u) const {
        const int nb0 = __builtin_amdgcn_readfirstlane(META[0]), nb1 = __builtin_amdgcn_readfirstlane(META[1]); const long L = (long)i * G + c; if (L >= 2L * (nb0 + nb1)) return false;
        int blk = (int)(L >> 1); u.pn = (int)(L & 1); int k = 0; if (blk >= nb0) { k = 1; blk -= nb0; }
        const int e = moe_expert_of(META, k, blk);
        u.pm = blk; u.a0 = k; u.a1 = e; u.A = (const char*)ws + WS_XB; u.B = (const char*)ws + WS_WEXP + (size_t)e * 512 * 1024 * 2 + (size_t)u.pn * 256 * K * 2; return true;
    }
    __device__ __forceinline__ unsigned arow(const GUnit& u, int r) const { const int t = tok[u.a0 * LISTCAP + u.pm * 256 + r]; return t < 0 ? 0u : (unsigned)t; }
    __device__ __forceinline__ bool epi(Acc& acc, const GUnit& u, int wr, int wc, int fr, int fq) const {
        const int lr0 = u.a0 * LISTCAP + u.pm * 256 + wr * 64 + fr; bf16_t* HB = (bf16_t*)(ws + WS_HB);
        int tk[8]; float rs8[8];
#pragma unroll
        for (int g = 0; g < 8; ++g) tk[g] = tok[lr0 + (g >> 2) * 128 + (g & 3) * 16];
        PIN8(tk[0], tk[1], tk[2], tk[3], tk[4], tk[5], tk[6], tk[7]);
#pragma unroll
        for (int hh = 0; hh < 4; ++hh) { f32x4 a[2], b[2], c[2], d[2];
#pragma unroll
            for (int g = 0; g < 2; ++g) { const int t = tk[hh * 2 + g]; const f32x4* p = (const f32x4*)(SS + (size_t)(t < 0 ? 0 : t) * 16); a[g] = p[0]; b[g] = p[1]; c[g] = p[2]; d[g] = p[3]; }
#pragma unroll
            for (int g = 0; g < 2; ++g) { const f32x4 tt = (a[g] + b[g]) + (c[g] + d[g]); rs8[hh * 2 + g] = tk[hh * 2 + g] < 0 ? 0.f : rsqrtf(((tt.x + tt.y) + (tt.z + tt.w)) * (1.0f / 1024.0f) + EPS); }
            PIN2(rs8[hh * 2], rs8[hh * 2 + 1]); }
#pragma unroll
        for (int ai = 0; ai < 2; ++ai)
#pragma unroll
            for (int m = 0; m < 4; ++m) { const int lr = lr0 + ai * 128 + m * 16; const float rs = rs8[ai * 4 + m];
#pragma unroll
                for (int bj = 0; bj < 2; ++bj) { const f32x4 g = acc[ai][bj][m][0] * rs, uu = acc[ai][bj][m][1] * rs;
                    f32x4 h = (f32x4){siluf_(g[0]) * uu[0], siluf_(g[1]) * uu[1], siluf_(g[2]) * uu[2], siluf_(g[3]) * uu[3]}; if (ABL == 8) h = (f32x4){1.f, 1.f, 1.f, 1.f};
                    u32x2 w; w.x = cvt_pk_bf16(h[0], h[1]); w.y = cvt_pk_bf16(h[2], h[3]);
                    *(u32x2*)(HB + (size_t)lr * 256 + u.pn * 128 + bj * 64 + wc * 16 + fq * 4) = w; }
                asm volatile("" ::: "memory"); }
        return true;
    }
};
template <int KL> struct PhDown {
    static constexpr int K = 256; static constexpr bool GATHER = false;
    unsigned char* ws; float* SSo; const int* META; const int* tok; const float* wl; int G, c;
    __device__ __forceinline__ bool next(int i, GUnit& u) const {
        const int nb = __builtin_amdgcn_readfirstlane(META[KL]); const long L = (long)i * G + c;
        if (L < 4L * nb) { const int blk = (int)(L >> 2); u.pn = (int)(L & 3); const int e = moe_expert_of(META, KL, blk); u.pm = blk; u.a0 = 0; u.a1 = e;
            u.A = (const char*)ws + WS_HB + (size_t)(KL * LISTCAP + blk * 256) * 256 * 2; u.B = (const char*)ws + WS_WEXP + 32ull * 512 * 1024 * 2 + (size_t)e * 1024 * 256 * 2 + (size_t)u.pn * 256 * K * 2; return true; }
        if (KL == 1) { const long L2 = L - 4L * nb; if (L2 >= 128 * 4) return false;
            pg8::tile_order((int)L2, 128, 4, u.pm, u.pn); u.a0 = 1; u.a1 = 0;
            u.A = (const char*)ws + WS_PBF + (size_t)u.pm * 256 * K * 2; u.B = (const char*)ws + WS_WPP + (size_t)u.pn * 256 * K * 2; return true; }
        return false;
    }
    __device__ __forceinline__ unsigned arow(const GUnit&, int) const { return 0u; }
    __device__ __forceinline__ bool epi(Acc& acc, const GUnit& u, int wr, int wc, int fr, int fq) const {
        const int col0 = u.pn * 256 + wc * 32 + fq * 8;
        if (KL == 1 && u.a0 == 1) {
            bf16_t* PE = (bf16_t*)(ws + WS_PE); const int row0 = u.pm * 256 + wr * 64 + fr;
#pragma unroll
            for (int ai = 0; ai < 2; ++ai)
#pragma unroll
                for (int m = 0; m < 4; ++m)
#pragma unroll
                    for (int bj = 0; bj < 2; ++bj) *(u32x4*)(PE + (size_t)(row0 + ai * 128 + m * 16) * 1024 + col0 + bj * 128) = pack8(acc[ai][bj][m][0], acc[ai][bj][m][1]);
            return true;
        }
        const int lr0 = KL * LISTCAP + u.pm * 256 + wr * 64 + fr; bf16_t* YB = (bf16_t*)(ws + WS_YB1); bf16_t* XB = (bf16_t*)(ws + WS_XB);
        int tk[8]; float wk[8];
#pragma unroll
        for (int g = 0; g < 8; ++g) { const int lr = lr0 + (g >> 2) * 128 + (g & 3) * 16; tk[g] = tok[lr]; wk[g] = wl[lr]; }
        PIN8(tk[0], tk[1], tk[2], tk[3], tk[4], tk[5], tk[6], tk[7]); PIN8(wk[0], wk[1], wk[2], wk[3], wk[4], wk[5], wk[6], wk[7]);
#pragma unroll
        for (int ai = 0; ai < 2; ++ai)
#pragma unroll
            for (int m = 0; m < 4; ++m) { const int t = tk[ai * 4 + m]; const float w = wk[ai * 4 + m]; const size_t off = (size_t)(t < 0 ? 0 : t) * 1024 + col0;
                if (KL == 1) { if (t >= 0) {
#pragma unroll
                        for (int bj = 0; bj < 2; ++bj) *(u32x4*)(YB + off + bj * 128) = pack8(acc[ai][bj][m][0] * w, acc[ai][bj][m][1] * w); } }
                else { float ss = 0.f;
                    if (t >= 0) {
                        u32x4 xr[2], yr[2];
#pragma unroll
                        for (int bj = 0; bj < 2; ++bj) { xr[bj] = *(const u32x4*)(XB + off + bj * 128); yr[bj] = *(const u32x4*)(YB + off + bj * 128); }
                        PIN4(xr[0], xr[1], yr[0], yr[1]);
#pragma unroll
                        for (int bj = 0; bj < 2; ++bj) { f32x4 x0, x1, y0, y1; unpack8(xr[bj], x0, x1); unpack8(yr[bj], y0, y1);
                            ss += store_x8(XB + off + bj * 128, (x0 + y0) + acc[ai][bj][m][0] * w, (x1 + y1) + acc[ai][bj][m][1] * w); } }
                    ss += __shfl_xor(ss, 16); ss += __shfl_xor(ss, 32);
                    if (fq == 0 && t >= 0) SSo[(size_t)t * 16 + u.pn * 4 + wc] = ss; }
                if (m & 1) asm volatile("" ::: "memory"); }
        return true;
    }
};
struct PhPle {
    static constexpr int K = 1024; static constexpr bool GATHER = false;
    unsigned char* ws; const float* SSi; float* SSo; int G, c;
    __device__ __forceinline__ bool next(int i, GUnit& u) const {
        const long L = (long)i * G + c; if (L >= 128 * 4) return false;
        pg8::tile_order((int)L, 128, 4, u.pm, u.pn);
        u.A = (const char*)ws + WS_XB + (size_t)u.pm * 256 * K * 2; u.B = (const char*)ws + WS_WPG + (size_t)u.pn * 256 * K * 2; u.a0 = 0; u.a1 = 0; return true;
    }
    __device__ __forceinline__ unsigned arow(const GUnit&, int) const { return 0u; }
    __device__ __forceinline__ bool epi(Acc& acc, const GUnit& u, int wr, int wc, int fr, int fq) const {
        const int row0 = u.pm * 256 + wr * 64 + fr; const int col0 = u.pn * 256 + wc * 32 + fq * 8; bf16_t* XT = (bf16_t*)(ws + WS_XBT); const bf16_t* PE = (const bf16_t*)(ws + WS_PE); const bf16_t* XBc = (const bf16_t*)(ws + WS_XB);
        float rs8[8]; row_rs8(SSi, row0, rs8);
#pragma unroll
        for (int ai = 0; ai < 2; ++ai)
#pragma unroll
            for (int m = 0; m < 4; ++m) { const int row = row0 + ai * 128 + m * 16; const size_t off = (size_t)row * 1024 + col0; const float rs = rs8[ai * 4 + m]; float ss = 0.f;
                u32x4 xr[2], pr[2];
#pragma unroll
                for (int bj = 0; bj < 2; ++bj) { xr[bj] = *(const u32x4*)(XBc + off + bj * 128); pr[bj] = *(const u32x4*)(PE + off + bj * 128); }
                PIN4(xr[0], xr[1], pr[0], pr[1]);
#pragma unroll
                for (int bj = 0; bj < 2; ++bj) { f32x4 p0, p1, x0, x1; unpack8(pr[bj], p0, p1); unpack8(xr[bj], x0, x1);
                    ss += store_x8(XT + off + bj * 128, x0 + sig4(acc[ai][bj][m][0] * rs) * p0, x1 + sig4(acc[ai][bj][m][1] * rs) * p1); }
                ss += __shfl_xor(ss, 16); ss += __shfl_xor(ss, 32);
                if (fq == 0) SSo[(size_t)row * 16 + u.pn * 4 + wc] = ss; }
        return true;
    }
};

struct InPtrs { const float* const* p; __device__ __forceinline__ const float* operator[](int i) const { return (const float*)(GAS const float*)p[i]; } };
struct Ctx {
    InPtrs in; float* out; unsigned char* ws; LAS unsigned char* lds;
    int tid, lane, wave, G, bid;
};
enum { I_X = 0, I_P, I_GMIX, I_WIN, I_CONVW, I_CONVB, I_CLNG, I_CLNB, I_MCW, I_MCB, I_MIB, I_MFB, I_WBA, I_WBC, I_WBM, I_WOUT, I_GFFN, I_WRG, I_BRG, I_WRE, I_BRE,
       I_WEG, I_WEU, I_WED, I_GPLE, I_WPG, I_WPP, I_GFIN };

constexpr int TR_LDS = 64 * 65 * 4;
template <bool GAIN>
__device__ __forceinline__ void tr_item64(const float* colptr4, size_t pitch, const float* gainp, float cscale, bf16_t* dst, int K, int n0, int k0, LAS float* scr, int lane, const float* gain_or_valid) {
    const float* gain = GAIN ? gainp : nullptr;
    const int g = lane & 15, r = lane >> 4;
    f32x4 v[16]; float gs[16];
    const float* cp = colptr4 ? colptr4 : gain_or_valid;
#pragma unroll
    for (int i = 0; i < 16; ++i) { const int kk = 4 * i + r; v[i] = *(const f32x4*)(cp + (colptr4 ? (size_t)(k0 + kk) * pitch : 0)); gs[i] = gain ? gain[k0 + kk] : 1.0f; }
    PIN8(v[0], v[1], v[2], v[3], v[4], v[5], v[6], v[7]); PIN8(v[8], v[9], v[10], v[11], v[12], v[13], v[14], v[15]);
    const float zs = colptr4 ? cscale : 0.f;
#pragma unroll
    for (int i = 0; i < 16; ++i) { const int kk = 4 * i + r; const float m = gs[i] * zs; LAS float* p = scr + kk * 65 + 4 * g; p[0] = v[i].x * m; p[1] = v[i].y * m; p[2] = v[i].z * m; p[3] = v[i].w * m; }
    LDS_WAIT(); asm volatile("" ::: "memory");
    const int c = lane & 7, n8 = lane >> 3;
#pragma unroll
    for (int j = 0; j < 8; ++j) { const int n = n8 + 8 * j; const LAS float* sp = scr + (8 * c) * 65 + n;
        u32x4 o; o.x = pk2(sp[0 * 65], sp[1 * 65]); o.y = pk2(sp[2 * 65], sp[3 * 65]); o.z = pk2(sp[4 * 65], sp[5 * 65]); o.w = pk2(sp[6 * 65], sp[7 * 65]);
        *(u32x4*)(dst + (size_t)(n0 + n) * K + k0 + 8 * c) = o; }
    LDS_WAIT(); asm volatile("" ::: "memory");
}
__device__ __forceinline__ void phase_prep(const Ctx& F, int layer, float* SS) {
    const int gw = F.bid * NWAVES + F.wave, NGW = F.G * NWAVES, lane = F.lane;
    LAS float* scr = (LAS float*)(F.lds + F.wave * TR_LDS);
    bf16_t* XB = (bf16_t*)(F.ws + WS_XB);
    if (layer == 0) {
        for (int m0 = gw; m0 < T; m0 += 4 * NGW) {
            f32x4 v[4][4];
#pragma unroll
            for (int r = 0; r < 4; ++r) { const f32x4* xr = (const f32x4*)(F.in[I_X] + (size_t)(m0 + r * NGW) * D) + lane;
#pragma unroll
                for (int j = 0; j < 4; ++j) v[r][j] = xr[64 * j]; }
            PIN8(v[0][0], v[0][1], v[0][2], v[0][3], v[1][0], v[1][1], v[1][2], v[1][3]); PIN8(v[2][0], v[2][1], v[2][2], v[2][3], v[3][0], v[3][1], v[3][2], v[3][3]);
#pragma unroll
            for (int r = 0; r < 4; ++r) { const int m = m0 + r * NGW; u32x2* xbr = (u32x2*)(XB + (size_t)m * D) + lane; float sq = 0.f;
#pragma unroll
                for (int j = 0; j < 4; ++j) { const f32x4 x = v[r][j]; sq += (x.x * x.x + x.y * x.y) + (x.z * x.z + x.w * x.w); u32x2 w; w.x = cvt_pk_bf16(x.x, x.y); w.y = cvt_pk_bf16(x.z, x.w); xbr[64 * j] = w; }
                sq = wave_sum(sq);
                if (lane < 16) SS[(size_t)m * 16 + lane] = lane == 0 ? sq : 0.f; }
        }
    } else {
        const u32x4* src = (const u32x4*)(F.ws + WS_XBT); u32x4* dst = (u32x4*)(F.ws + WS_XB);
        const size_t n = (size_t)T * D * 2 / 16, st = (size_t)F.G * NTHREADS;
        for (size_t i0 = (size_t)F.bid * NTHREADS + F.tid; i0 < n; i0 += 8 * st) { u32x4 v[8];
#pragma unroll
            for (int k = 0; k < 8; ++k) { const size_t i = i0 + k * st; v[k] = src[i < n ? i : 0]; }
            PIN8(v[0], v[1], v[2], v[3], v[4], v[5], v[6], v[7]);
#pragma unroll
            for (int k = 0; k < 8; ++k) { const size_t i = i0 + k * st; if (i < n) dst[i] = v[k]; } }
    }
    const float* w_in = F.in[I_WIN] + (size_t)layer * D * D_IN; const float* g_mix = F.in[I_GMIX] + (size_t)layer * D;
    constexpr int N_WIN = 140 * 16, N_BR = 16 * 8, N_SQ = 16 * 16, N_PP = 16 * 4, N_R = 4 * 16;
    constexpr int NITEMS = N_WIN + 3 * N_BR + 2 * N_SQ + N_PP + N_R;
    const int g4 = 4 * (lane & 15);
    for (int it = gw; it < NITEMS; it += NGW) {
        int r = it;
        if (r < N_WIN) { const int nb = r >> 4, kb = r & 15; const int n = nb * 64 + g4; int src = -1; float cs = 1.f;
            if (n < 2560) { src = n; if (n < 1536) cs = 0.125f; }
            else if (n < 3584) { const int np = n - 2560, q8 = np >> 3, sg = (np >> 2) & 1; src = 2560 + sg * 512 + 4 * q8; }
            else if (n < 5640) src = n;
            else if (n < 5888) src = -1;
            else src = 5640 + (n - 5888);
            tr_item64<true>(src >= 0 ? w_in + src : nullptr, D_IN, g_mix, cs, (bf16_t*)(F.ws + WS_WIN), 1024, nb * 64, kb * 64, scr, lane, g_mix); continue; }
        r -= N_WIN;
        if (r < 3 * N_BR) { const int b = r / N_BR; r -= b * N_BR; const int nb = r >> 3, kb = r & 7; const int n = nb * 64 + g4;
            const float* w = (b == 0 ? F.in[I_WBA] : (b == 1 ? F.in[I_WBC] : F.in[I_WBM])) + (size_t)layer * 512 * 1024;
            tr_item64<false>(w + n, 1024, nullptr, 1.f, (bf16_t*)(F.ws + WS_WBR) + (size_t)b * 1024 * 512, 512, nb * 64, kb * 64, scr, lane, g_mix); continue; }
        r -= 3 * N_BR;
        if (r < 2 * N_SQ) { const int b = r / N_SQ; r -= b * N_SQ; const int nb = r >> 4, kb = r & 15; const int n = nb * 64 + g4;
            const float* w = (b == 0 ? F.in[I_WOUT] : F.in[I_WPG]) + (size_t)layer * 1024 * 1024;
            if (b == 0) tr_item64<false>(w + n, 1024, nullptr, 1.f, (bf16_t*)(F.ws + WS_WOUT), 1024, nb * 64, kb * 64, scr, lane, g_mix);
            else tr_item64<true>(w + n, 1024, F.in[I_GPLE] + (size_t)layer * D, 1.f, (bf16_t*)(F.ws + WS_WPG), 1024, nb * 64, kb * 64, scr, lane, g_mix);
            continue; }
        r -= 2 * N_SQ;
        if (r < N_PP) { const int nb = r >> 2, kb = r & 3; const int n = nb * 64 + g4;
            tr_item64<false>(F.in[I_WPP] + (size_t)layer * 256 * 1024 + n, 1024, nullptr, 1.f, (bf16_t*)(F.ws + WS_WPP), 256, nb * 64, kb * 64, scr, lane, g_mix); continue; }
        r -= N_PP;
        { const int nb = r >> 4, kb = r & 15; const int n = nb * 64 + g4; const float* cp = nullptr; size_t pitch = 4;
            if (n < 4) { cp = F.in[I_WRG] + (size_t)layer * 1024 * 4 + n; pitch = 4; } else if (n < 36) { cp = F.in[I_WRE] + (size_t)layer * 1024 * 32 + (n - 4); pitch = 32; }
            tr_item64<true>(cp, pitch, F.in[I_GFFN] + (size_t)layer * D, 1.f, (bf16_t*)(F.ws + WS_WR), 1024, nb * 64, kb * 64, scr, lane, g_mix); }
    }
}
__device__ __forceinline__ void phase_prep_experts(const Ctx& F, int layer) {
    const int gw = F.bid * NWAVES + F.wave, NGW = F.G * NWAVES, lane = F.lane;
    LAS float* scr = (LAS float*)(F.lds + F.wave * TR_LDS);
    const float* g_ffn = F.in[I_GFFN] + (size_t)layer * D;
    constexpr int N_UP = 32 * 8 * 16, N_DN = 32 * 16 * 4;
    const int g4 = 4 * (lane & 15);
    for (int it = gw; it < N_UP + N_DN; it += NGW) {
        int r = it;
        if (r < N_UP) { const int e = r >> 7; r &= 127; const int nb = r >> 4, kb = r & 15; const int n = nb * 64 + g4; const int q8 = n >> 3, sg = (n >> 2) & 1;
            const float* w = (sg ? F.in[I_WEU] : F.in[I_WEG]) + ((size_t)layer * 32 + e) * 1024 * 256 + 4 * q8;
            tr_item64<true>(w, 256, g_ffn, 1.f, (bf16_t*)(F.ws + WS_WEXP) + (size_t)e * 512 * 1024, 1024, nb * 64, kb * 64, scr, lane, g_ffn); continue; }
        r -= N_UP;
        { const int e = r >> 6; r &= 63; const int nb = r >> 2, kb = r & 3; const int n = nb * 64 + g4;
            const float* w = F.in[I_WED] + ((size_t)layer * 32 + e) * 256 * 1024 + n;
            tr_item64<false>(w, 1024, nullptr, 1.f, (bf16_t*)(F.ws + WS_WEXP) + 32ull * 512 * 1024 + (size_t)e * 1024 * 256, 256, nb * 64, kb * 64, scr, lane, g_ffn); }
    }
    const f32x4* p = (const f32x4*)(F.in[I_P] + (size_t)layer * T * 256); u32x2* pb = (u32x2*)(F.ws + WS_PBF);
    { const size_t n = (size_t)T * 256 / 4, st = (size_t)F.G * NTHREADS;
        for (size_t i0 = (size_t)F.bid * NTHREADS + F.tid; i0 < n; i0 += 8 * st) { f32x4 v[8];
#pragma unroll
            for (int k = 0; k < 8; ++k) { const size_t i = i0 + k * st; v[k] = p[i < n ? i : 0]; }
            PIN8(v[0], v[1], v[2], v[3], v[4], v[5], v[6], v[7]);
#pragma unroll
            for (int k = 0; k < 8; ++k) { const size_t i = i0 + k * st; if (i < n) { u32x2 w; w.x = cvt_pk_bf16(v[k].x, v[k].y); w.y = cvt_pk_bf16(v[k].z, v[k].w); pb[i] = w; } } } }
}

constexpr int AK_RS = 144, AV_RS = 160, AV_OFF = 2 * 128 * AK_RS;
typedef short s16x4 __attribute__((ext_vector_type(4)));
__device__ __forceinline__ s16x4 lds_tr16(LAS unsigned char* p) { return __builtin_amdgcn_ds_read_tr16_b64_v4i16((LAS s16x4*)p); }
__device__ __forceinline__ void attn_strip(const Ctx& F, int strip) {
    const int bs = strip / 48, sg = strip - bs * 48, b = bs >> 3, slot = bs & 7;
    int g, r, nb0;
    if (sg < 16) { g = 0; r = 0; nb0 = sg * 8; } else if (sg < 32) { g = 1; r = (sg - 16) >> 2; nb0 = ((sg - 16) & 3) * 8; } else { g = 2; r = sg - 32; nb0 = 0; }
    const int dl = 1 << (2 * g); const float slope = exp2f(-(float)(g * 8 + slot + 1) * (1.0f / 3.0f)) * (float)dl;
    bf16_t* Qg = (bf16_t*)(F.ws + (g == 0 ? WS_QA0 : (g == 1 ? WS_QA1 : WS_QA2))) + slot * 64;
    const bf16_t* Kg = (const bf16_t*)(F.ws + WS_KA) + slot * 64; const bf16_t* Vg = (const bf16_t*)(F.ws + WS_VA) + slot * 64;
    float* LSE = (float*)(F.ws + WS_LOGITS) + (size_t)g * T * 8 + slot;
    const size_t tok0 = (size_t)b * SEQ + r;
    LAS unsigned char* Kl = F.lds; LAS unsigned char* Vl = F.lds + AV_OFF;
    const int tid = F.tid, lane = F.lane, w = F.wave, fr = lane & 15, fq = lane >> 4;
    const int srow = tid >> 2, sc4 = tid & 3;
    u32x4 kx[2], vx[2];
#define ATT_LOAD(blk) do { const size_t _t = (tok0 + (size_t)((blk) * 128 + srow) * dl) * 512; \
        kx[0] = *(const u32x4*)(Kg + _t + sc4 * 8); kx[1] = *(const u32x4*)(Kg + _t + 32 + sc4 * 8); vx[0] = *(const u32x4*)(Vg + _t + sc4 * 8); vx[1] = *(const u32x4*)(Vg + _t + 32 + sc4 * 8); } while (0)
#define ATT_STORE(blk) do { const int _p = (((blk) & 1) * 128 + srow); \
        *(LAS u32x4*)(Kl + _p * AK_RS + sc4 * 16) = kx[0]; *(LAS u32x4*)(Kl + _p * AK_RS + 64 + sc4 * 16) = kx[1]; *(LAS u32x4*)(Vl + _p * AV_RS + sc4 * 16) = vx[0]; *(LAS u32x4*)(Vl + _p * AV_RS + 64 + sc4 * 16) = vx[1]; } while (0)
    __syncthreads();
    if (nb0 > 0) { ATT_LOAD(nb0 - 1); ATT_STORE(nb0 - 1); }
    else { kx[0] = kx[1] = vx[0] = vx[1] = (u32x4){0u, 0u, 0u, 0u}; ATT_STORE(1); }
    ATT_LOAD(nb0); ATT_STORE(nb0);
    bf16x8 qn0, qn1;
    { const size_t qo = (tok0 + (size_t)(nb0 * 128 + 16 * w + fr) * dl) * 512; qn0 = *(const bf16x8*)(Qg + qo + fq * 8); qn1 = *(const bf16x8*)(Qg + qo + 32 + fq * 8); }
    __syncthreads();
    for (int nb = nb0; nb < nb0 + 8; ++nb) {
        const bool more = nb + 1 < nb0 + 8;
        if (more) ATT_LOAD(nb + 1);
        const size_t qoff = (tok0 + (size_t)(nb * 128 + 16 * w + fr) * dl) * 512;
        const bf16x8 q0 = qn0, q1 = qn1;
        if (more) { const size_t qo2 = qoff + (size_t)128 * dl * 512; qn0 = *(const bf16x8*)(Qg + qo2 + fq * 8); qn1 = *(const bf16x8*)(Qg + qo2 + 32 + fq * 8); }
        const int pslot = (nb - 1) & 1;
        f32x4 S[10];
#pragma unroll
        for (int kbi = 0; kbi < 10; ++kbi) {
            int kb = w + kbi; if (kb > 15) kb = 15;
            const int ki = kb * 16 + fr; const int phys = ((pslot + (ki >> 7)) & 1) * 128 + (ki & 127);
            const bf16x8 k0 = *(const LAS bf16x8*)(Kl + phys * AK_RS + fq * 16), k1 = *(const LAS bf16x8*)(Kl + phys * AK_RS + 64 + fq * 16);
            f32x4 a = (f32x4){0.f, 0.f, 0.f, 0.f};
            a = __builtin_amdgcn_mfma_f32_16x16x32_bf16(k0, q0, a, 0, 0, 0);
            S[kbi] = __builtin_amdgcn_mfma_f32_16x16x32_bf16(k1, q1, a, 0, 0, 0);
        }
        float mx = -INFINITY;
#pragma unroll
        for (int kbi = 0; kbi < 10; ++kbi)
#pragma unroll
            for (int j = 0; j < 4; ++j) { const int ki = (w + kbi) * 16 + 4 * fq + j; const int dist = 16 * w + fr + 128 - ki;
                const bool ok = dist >= 0 && dist <= 128 && (nb > 0 || ki >= 128) && (w + kbi) < 16;
                const float sc = ok ? S[kbi][j] - slope * (float)dist : -INFINITY; S[kbi][j] = sc; mx = fmaxf(mx, sc); }
        mx = fmaxf(mx, __shfl_xor(mx, 16)); mx = fmaxf(mx, __shfl_xor(mx, 32));
        float ls = 0.f;
#pragma unroll
        for (int kbi = 0; kbi < 10; ++kbi)
#pragma unroll
            for (int j = 0; j < 4; ++j) { const float p = __expf(S[kbi][j] - mx); S[kbi][j] = p; ls += p; }
        ls += __shfl_xor(ls, 16); ls += __shfl_xor(ls, 32);
        f32x4 O[4];
#pragma unroll
        for (int db = 0; db < 4; ++db) O[db] = (f32x4){0.f, 0.f, 0.f, 0.f};
#pragma unroll
        for (int k2 = 0; k2 < 5; ++k2) {
            u32x4 pw; pw.x = cvt_pk_bf16(S[2 * k2][0], S[2 * k2][1]); pw.y = cvt_pk_bf16(S[2 * k2][2], S[2 * k2][3]); pw.z = cvt_pk_bf16(S[2 * k2 + 1][0], S[2 * k2 + 1][1]); pw.w = cvt_pk_bf16(S[2 * k2 + 1][2], S[2 * k2 + 1][3]);
            const bf16x8 pf = __builtin_bit_cast(bf16x8, pw);
            int kb0 = w + 2 * k2, kb1 = kb0 + 1; if (kb1 > 15) kb1 = 15; if (kb0 > 15) kb0 = 15;
            const int r0 = kb0 * 16 + 4 * fq + (fr >> 2), r1 = kb1 * 16 + 4 * fq + (fr >> 2);
            const int p0 = ((pslot + (r0 >> 7)) & 1) * 128 + (r0 & 127), p1 = ((pslot + (r1 >> 7)) & 1) * 128 + (r1 & 127);
#pragma unroll
            for (int db = 0; db < 4; ++db) {
                const s16x4 v0 = lds_tr16(Vl + p0 * AV_RS + (db * 16 + 4 * (fr & 3)) * 2), v1 = lds_tr16(Vl + p1 * AV_RS + (db * 16 + 4 * (fr & 3)) * 2);
                const bf16x8 vf = (bf16x8){v0[0], v0[1], v0[2], v0[3], v1[0], v1[1], v1[2], v1[3]};
                O[db] = __builtin_amdgcn_mfma_f32_16x16x32_bf16(vf, pf, O[db], 0, 0, 0);
            }
        }
        const float inv = 1.0f / ls;
#pragma unroll
        for (int db = 0; db < 4; ++db) { u32x2 ow; ow.x = cvt_pk_bf16(O[db][0] * inv, O[db][1] * inv); ow.y = cvt_pk_bf16(O[db][2] * inv, O[db][3] * inv);
            *(u32x2*)(Qg + qoff + db * 16 + 4 * fq) = ow; }
        if (fq == 0) LSE[(qoff >> 9) * 8] = mx + __logf(ls);
        __syncthreads();
        if (more) ATT_STORE(nb + 1);
        __syncthreads();
    }
#undef ATT_LOAD
#undef ATT_STORE
}
__device__ __forceinline__ void attn_combine(const Ctx& F) {
    const float* LSE = (const float*)(F.ws + WS_LOGITS);
    for (int i0 = F.bid * NTHREADS + F.tid; i0 < T * 64; i0 += 4 * F.G * NTHREADS) {
        u32x4 a[4], bb[4], cc[4]; float l0[4], l1[4], l2[4];
#pragma unroll
        for (int k = 0; k < 4; ++k) { const int i = i0 + k * F.G * NTHREADS; const int ic = i < T * 64 ? i : 0; const int t = ic >> 6, slot = (ic & 63) >> 3;
            a[k] = ((const u32x4*)(F.ws + WS_QA0))[ic]; bb[k] = ((const u32x4*)(F.ws + WS_QA1))[ic]; cc[k] = ((const u32x4*)(F.ws + WS_QA2))[ic];
            l0[k] = LSE[(size_t)t * 8 + slot]; l1[k] = LSE[(size_t)T * 8 + (size_t)t * 8 + slot]; l2[k] = LSE[(size_t)2 * T * 8 + (size_t)t * 8 + slot]; }
        PIN4(a[0], a[1], a[2], a[3]); PIN4(bb[0], bb[1], bb[2], bb[3]); PIN4(cc[0], cc[1], cc[2], cc[3]);
#pragma unroll
        for (int k = 0; k < 4; ++k) { const int i = i0 + k * F.G * NTHREADS; if (i < T * 64) {
            const float m = fmaxf(l0[k], fmaxf(l1[k], l2[k])); float w0 = __expf(l0[k] - m), w1 = __expf(l1[k] - m), w2 = __expf(l2[k] - m); const float inv = __builtin_amdgcn_rcpf(w0 + w1 + w2); w0 *= inv; w1 *= inv; w2 *= inv;
            f32x4 a0, a1, b0, b1, c0, c1; unpack8(a[k], a0, a1); unpack8(bb[k], b0, b1); unpack8(cc[k], c0, c1);
            ((u32x4*)(F.ws + WS_QA0))[i] = pack8(a0 * w0 + b0 * w1 + c0 * w2, a1 * w0 + b1 * w1 + c1 * w2); } }
    }
}

__device__ __forceinline__ void conv_item(const Ctx& F, int layer, int item) {
    const int t0 = item * 32, s0 = t0 & (SEQ - 1), tid = F.tid;
    LAS bf16_t* sin = (LAS bf16_t*)F.lds;
    LAS float* sout = (LAS float*)(F.lds + 65536);
    const bf16_t* YG = (const bf16_t*)(F.ws + WS_YG);
    __syncthreads();
#pragma unroll 1
    for (int kb = 0; kb < 2; ++kb) { u32x4 sv[4];
#pragma unroll
        for (int k = 0; k < 4; ++k) { const int i = tid + (kb * 4 + k) * NTHREADS; const int r = i < 62 * 64 ? (i >> 6) : 0, c8 = i & 63; const int sp = s0 - 30 + r;
            sv[k] = *(const u32x4*)(YG + (size_t)(sp >= 0 ? t0 - 30 + r : t0) * 512 + c8 * 8); }
        PIN4(sv[0], sv[1], sv[2], sv[3]);
#pragma unroll
        for (int k = 0; k < 4; ++k) { const int i = tid + (kb * 4 + k) * NTHREADS; const int r = i >> 6, c8 = i & 63; const int sp = s0 - 30 + r;
            if (i < 62 * 64) *(LAS u32x4*)(sin + r * 512 + c8 * 8) = sp >= 0 ? sv[k] : (u32x4){0u, 0u, 0u, 0u}; } }
    const int cp = tid & 255, hf = tid >> 8;
    f32x2 w[31];
    const float* cw = F.in[I_CONVW] + (size_t)layer * 31 * 512 + 2 * cp;
#pragma unroll
    for (int k = 0; k < 31; ++k) w[k] = *(const f32x2*)(cw + k * 512);
    const f32x2 cb = *(const f32x2*)(F.in[I_CONVB] + layer * 512 + 2 * cp);
    __syncthreads();
#pragma unroll 1
    for (int ps = 0; ps < 2; ++ps) { const int tb = 16 * hf + 8 * ps;
        f32x2 xin[38];
#pragma unroll
        for (int r = 0; r < 38; ++r) { const unsigned u = *(const LAS unsigned*)(sin + (tb + r) * 512 + 2 * cp); xin[r] = (f32x2){bf_lo(u), bf_hi(u)}; }
#pragma unroll
        for (int tt = 0; tt < 8; ++tt) { f32x2 a = cb;
#pragma unroll
            for (int k = 0; k < 31; ++k) a += w[k] * xin[tt + k];
            *(LAS f32x2*)(sout + (tb + tt) * 512 + 2 * cp) = a; } }
    __syncthreads();
    const float* lg = F.in[I_CLNG] + layer * 512 + F.lane * 8; const float* lb = F.in[I_CLNB] + layer * 512 + F.lane * 8;
    for (int tt = F.wave; tt < 32; tt += NWAVES) {
        float v[8]; float sm = 0.f;
#pragma unroll
        for (int j = 0; j < 8; ++j) { v[j] = sout[tt * 512 + F.lane * 8 + j]; sm += v[j]; }
        const float mu = wave_sum(sm) * (1.0f / 512.0f); float q = 0.f;
#pragma unroll
        for (int j = 0; j < 8; ++j) { v[j] -= mu; q += v[j] * v[j]; }
        const float rstd = rsqrtf(wave_sum(q) * (1.0f / 512.0f) + EPS);
        float o[8];
#pragma unroll
        for (int j = 0; j < 8; ++j) o[j] = siluf_(v[j] * rstd * lg[j] + lb[j]);
        u32x4 wv; wv.x = cvt_pk_bf16(o[0], o[1]); wv.y = cvt_pk_bf16(o[2], o[3]); wv.z = cvt_pk_bf16(o[4], o[5]); wv.w = cvt_pk_bf16(o[6], o[7]);
        *(u32x4*)((bf16_t*)(F.ws + WS_YC) + (size_t)(t0 + tt) * 512 + F.lane * 8) = wv;
    }
}

__device__ __forceinline__ float log_sigmoid_(float v) { return fminf(v, 0.f) - log1pf(__expf(-fabsf(v))); }
struct QkW { float w[4][8]; float b[8]; };
__device__ __forceinline__ void qk_load_w(const Ctx& F, int layer, int chq, QkW& W) {
    const float* cw = F.in[I_MCW] + (size_t)layer * 4 * 1024 + chq; const float* cb = F.in[I_MCB] + (size_t)layer * 1024 + chq;
#pragma unroll
    for (int k = 0; k < 4; ++k) { const f32x4 a = *(const f32x4*)(cw + k * 1024), b = *(const f32x4*)(cw + k * 1024 + 4); W.w[k][0] = a.x; W.w[k][1] = a.y; W.w[k][2] = a.z; W.w[k][3] = a.w; W.w[k][4] = b.x; W.w[k][5] = b.y; W.w[k][6] = b.z; W.w[k][7] = b.w; }
    const f32x4 a = *(const f32x4*)cb, b = *(const f32x4*)(cb + 4); W.b[0] = a.x; W.b[1] = a.y; W.b[2] = a.z; W.b[3] = a.w; W.b[4] = b.x; W.b[5] = b.y; W.b[6] = b.z; W.b[7] = b.w;
}
__device__ __forceinline__ void qk_conv8(const QkW& W, const bf16_t* src  , int t, int s, int ch  , float scale, float* o) {
#pragma unroll
    for (int j = 0; j < 8; ++j) o[j] = W.b[j];
#pragma unroll
    for (int k = 0; k < 4; ++k) { const bool ok = s - 3 + k >= 0; u32x4 w = *(const u32x4*)(src + (size_t)(ok ? t - 3 + k : t) * 512 + ch);
            if (!ok) w = (u32x4){0u, 0u, 0u, 0u};
            o[0] += W.w[k][0] * bf_lo(w.x); o[1] += W.w[k][1] * bf_hi(w.x); o[2] += W.w[k][2] * bf_lo(w.y); o[3] += W.w[k][3] * bf_hi(w.y); o[4] += W.w[k][4] * bf_lo(w.z); o[5] += W.w[k][5] * bf_hi(w.z); o[6] += W.w[k][6] * bf_lo(w.w); o[7] += W.w[k][7] * bf_hi(w.w); }
#pragma unroll
    for (int j = 0; j < 8; ++j) o[j] = siluf_(o[j]) * scale;
}
__device__ __forceinline__ void qk_conv8r(const QkW& W, const u32x4 (&rw)[4], int s, float scale, float* o) {
#pragma unroll
    for (int j = 0; j < 8; ++j) o[j] = W.b[j];
#pragma unroll
    for (int k = 0; k < 4; ++k) { u32x4 w = rw[k]; if (s - 3 + k < 0) w = (u32x4){0u, 0u, 0u, 0u};
        o[0] += W.w[k][0] * bf_lo(w.x); o[1] += W.w[k][1] * bf_hi(w.x); o[2] += W.w[k][2] * bf_lo(w.y); o[3] += W.w[k][3] * bf_hi(w.y); o[4] += W.w[k][4] * bf_lo(w.z); o[5] += W.w[k][5] * bf_hi(w.z); o[6] += W.w[k][6] * bf_lo(w.w); o[7] += W.w[k][7] * bf_hi(w.w); }
#pragma unroll
    for (int j = 0; j < 8; ++j) o[j] = siluf_(o[j]) * scale;
}
__device__ __forceinline__ void mlstm_scalars(const Ctx& F, int layer, int t0, int h, LAS float* sIG, LAS float* sBC) {
    if (F.tid < 128) { const float* IFp = (const float*)(F.ws + WS_IF) + (size_t)(t0 + F.tid) * 8;
        sIG[F.tid] = IFp[h] + F.in[I_MIB][layer * 4 + h]; sBC[F.tid] = log_sigmoid_(IFp[4 + h] + F.in[I_MFB][layer * 4 + h]); }
    __syncthreads();
    if (F.wave == 0) { const float a = sBC[2 * F.lane], bb = sBC[2 * F.lane + 1]; float sc = a + bb;
#pragma unroll
        for (int off = 1; off < 64; off <<= 1) { const float t = __shfl_up(sc, off); if (F.lane >= off) sc += t; }
        sBC[2 * F.lane] = sc - bb; sBC[2 * F.lane + 1] = sc; }
    __syncthreads();
}
constexpr int ML_KRS = 288, ML_ERS = 352, ML_E = 128 * ML_KRS, ML_S = ML_E + 128 * ML_ERS;
__device__ __forceinline__ void mlstm_local_mfma(const Ctx& F, int layer, int item) {
    const int c = item & 127, bh = item >> 7, h = bh & 3, b = bh >> 2, t0 = b * SEQ + c * 128, tid = F.tid, lane = F.lane, w = F.wave, fr = lane & 15, fq = lane >> 4;
    LAS unsigned char* L = F.lds;
    LAS float* sIG = (LAS float*)(L + ML_S); LAS float* sBC = sIG + 128; LAS float* sE = sIG + 256; LAS float* sM = sIG + 384;
    __syncthreads();
    mlstm_scalars(F, layer, t0, h, sIG, sBC);
    if (w == 0) { const float gt = sBC[127]; const float m = wave_max(fmaxf(gt - sBC[lane] + sIG[lane], gt - sBC[lane + 64] + sIG[lane + 64])); if (lane == 0) { sM[0] = m; sM[1] = gt; } }
    __syncthreads();
    if (tid < 128) sE[tid] = __expf(sM[1] - sBC[tid] + sIG[tid] - sM[0]);
    __syncthreads();
    const bf16_t* KM = (const bf16_t*)(F.ws + WS_KM); const bf16_t* VM = (const bf16_t*)(F.ws + WS_VM);
    QkW WK; qk_load_w(F, layer, 512 + h * 128 + (tid & 15) * 8, WK);
#pragma unroll 1
    for (int i = tid; i < 128 * 16; i += NTHREADS) { const int l = i >> 4, c8 = (i & 15) * 8; const int t = t0 + l, s = t & (SEQ - 1);
        u32x4 rk[4];
#pragma unroll
        for (int k = 0; k < 4; ++k) rk[k] = *(const u32x4*)(KM + (size_t)(s - 3 + k >= 0 ? t - 3 + k : t) * 512 + h * 128 + c8);
        const u32x4 rv = *(const u32x4*)(VM + (size_t)t * 512 + h * 128 + c8);
        float o[8]; qk_conv8r(WK, rk, s, 0.08838834764831845f, o);
        *(LAS u32x4*)(L + l * ML_KRS + c8 * 2) = pack8((f32x4){o[0], o[1], o[2], o[3]}, (f32x4){o[4], o[5], o[6], o[7]});
        f32x4 v0, v1; unpack8(rv, v0, v1); const float e = sE[l];
        *(LAS u32x4*)(L + ML_E + l * ML_ERS + c8 * 2) = pack8(v0 * e, v1 * e); }
    if (tid < 128) { unsigned zr = 0u; asm volatile("" : "+v"(zr));
        u32x4 z; z.x = f2bf(sE[tid]); z.y = zr; z.z = zr; z.w = zr; *(LAS u32x4*)(L + ML_E + tid * ML_ERS + 256) = z; z.x = zr; *(LAS u32x4*)(L + ML_E + tid * ML_ERS + 272) = z; }
    __syncthreads();
    bf16x8 af[4];
#pragma unroll
    for (int ks = 0; ks < 4; ++ks) { const int ra = ks * 32 + 4 * fq + (fr >> 2);
        const s16x4 a0 = lds_tr16(L + ra * ML_KRS + (w * 16 + 4 * (fr & 3)) * 2), a1 = lds_tr16(L + (ra + 16) * ML_KRS + (w * 16 + 4 * (fr & 3)) * 2);
        af[ks] = (bf16x8){a0[0], a0[1], a0[2], a0[3], a1[0], a1[1], a1[2], a1[3]}; }
    bf16_t* Cp = (bf16_t*)(F.ws + WS_CST) + ((size_t)(bh * 128 + c) << 14);
#pragma unroll
    for (int vb = 0; vb < 9; ++vb) { f32x4 d = (f32x4){0.f, 0.f, 0.f, 0.f};
#pragma unroll
        for (int ks = 0; ks < 4; ++ks) { const int rb = ks * 32 + 4 * fq + (fr >> 2);
            const s16x4 b0 = lds_tr16(L + ML_E + rb * ML_ERS + (vb * 16 + 4 * (fr & 3)) * 2), b1 = lds_tr16(L + ML_E + (rb + 16) * ML_ERS + (vb * 16 + 4 * (fr & 3)) * 2);
            const bf16x8 bfr = (bf16x8){b0[0], b0[1], b0[2], b0[3], b1[0], b1[1], b1[2], b1[3]};
            d = __builtin_amdgcn_mfma_f32_16x16x32_bf16(af[ks], bfr, d, 0, 0, 0); }
        if (vb < 8) { u32x2 o; o.x = pk2(d[0], d[1]); o.y = pk2(d[2], d[3]); *(u32x2*)(Cp + (size_t)(vb * 16 + fr) * 128 + w * 16 + 4 * fq) = o; }
        else if (fr == 0) *(f32x4*)((float*)(F.ws + WS_NST) + (size_t)(bh * 128 + c) * 128 + w * 16 + 4 * fq) = d;
    }
    if (tid == 0) { ((float*)(F.ws + WS_TAB + TAB_MLOC))[bh * 128 + c] = sM[0]; ((float*)(F.ws + WS_TAB + TAB_GTOT))[bh * 128 + c] = sM[1]; }
}
__device__ __forceinline__ void phase_scan(const Ctx& F) {
    const float* GT = (const float*)(F.ws + WS_TAB + TAB_GTOT); const float* ML = (const float*)(F.ws + WS_TAB + TAB_MLOC); float* MS = (float*)(F.ws + WS_TAB + TAB_MST);
    LAS float* sA = (LAS float*)F.lds; LAS float* sB = sA + 128;
    for (int blk = F.bid; blk < 8 * 32; blk += F.G) {
        const int bh = blk >> 5;
        __syncthreads();
        if (F.tid < 128) { sA[F.tid] = GT[bh * 128 + F.tid]; sB[F.tid] = ML[bh * 128 + F.tid]; }
        __syncthreads();
        if (F.wave == 0) {
            const int c0 = 2 * F.lane; const float g0 = sA[c0], m0 = sB[c0], g1 = sA[c0 + 1], m1 = sB[c0 + 1];
            float G = g0 + g1, M = fmaxf(m0 + g1, m1);
#pragma unroll
            for (int off = 1; off < 64; off <<= 1) { const float Gp = __shfl_up(G, off), Mp = __shfl_up(M, off); if (F.lane >= off) { M = fmaxf(Mp + G, M); G = Gp + G; } }
            float Gx = __shfl_up(G, 1), Mx = __shfl_up(M, 1); if (F.lane == 0) { Gx = 0.f; Mx = -INFINITY; }
            const float mA = fmaxf(0.f + Gx, Mx);
            const float mB = fmaxf(mA + g0, m0);
            const float mC = fmaxf(mB + g1, m1);
            sA[c0] = __expf(g0 + mA - mB); sB[c0] = __expf(m0 - mB); sA[c0 + 1] = __expf(g1 + mB - mC); sB[c0 + 1] = __expf(m1 - mC);
            if ((blk & 31) == 0) { MS[bh * 128 + c0] = mA; MS[bh * 128 + c0 + 1] = mB; } }
        __syncthreads();
        bf16_t* cp = (bf16_t*)(F.ws + WS_CST) + ((size_t)(bh * 128) << 14) + (blk & 31) * 512 + F.tid; float val = 0.f;
        const bool hasn = F.tid < 4; float* np = (float*)(F.ws + WS_NST) + (size_t)(bh * 128) * 128 + (hasn ? (blk & 31) * 4 + F.tid : 0); float nval = 0.f;
        for (int c0 = 0; c0 < 128; c0 += 16) { float loc[16], nloc[16];
#pragma unroll
            for (int j = 0; j < 16; ++j) { loc[j] = bf1(cp[(size_t)(c0 + j) << 14]); nloc[j] = np[(size_t)(c0 + j) * 128]; }
            PIN8(loc[0], loc[1], loc[2], loc[3], loc[4], loc[5], loc[6], loc[7]); PIN8(loc[8], loc[9], loc[10], loc[11], loc[12], loc[13], loc[14], loc[15]);
            PIN8(nloc[0], nloc[1], nloc[2], nloc[3], nloc[4], nloc[5], nloc[6], nloc[7]); PIN8(nloc[8], nloc[9], nloc[10], nloc[11], nloc[12], nloc[13], nloc[14], nloc[15]);
#pragma unroll
            for (int j = 0; j < 16; ++j) { const float a = sA[c0 + j], b = sB[c0 + j];
                cp[(size_t)(c0 + j) << 14] = (bf16_t)f2bf(val); val = a * val + b * loc[j];
                if (hasn) np[(size_t)(c0 + j) * 128] = nval; nval = a * nval + b * nloc[j]; } }
    }
    __syncthreads();
}
constexpr int MO_RS = 272, MO_VRS = 288;
constexpr int MO_Q = 0, MO_K = 128 * MO_RS, MO_C = 2 * 128 * MO_RS, MO_V = MO_C + 144 * MO_RS, MO_S = MO_V + 128 * MO_VRS;
static_assert(MO_S + 2560 <= MISC_OFF, "mlstm_out LDS");
__device__ __forceinline__ void mlstm_out_mfma(const Ctx& F, int layer, int item) {
    const int c = item & 127, bh = item >> 7, h = bh & 3, b = bh >> 2, t0 = b * SEQ + c * 128, tid = F.tid, lane = F.lane, w = F.wave, fr = lane & 15, fq = lane >> 4;
    LAS unsigned char* L = F.lds;
    LAS float* sIG = (LAS float*)(L + MO_S); LAS float* sBC = sIG + 128; LAS float* sMT = sIG + 256; LAS float* sSI = sIG + 384;
    __syncthreads();
    mlstm_scalars(F, layer, t0, h, sIG, sBC);
    const float mst = ((const float*)(F.ws + WS_TAB + TAB_MST))[bh * 128 + c];
    if (w == 0) { const float a = sIG[2 * lane] - sBC[2 * lane], bb = sIG[2 * lane + 1] - sBC[2 * lane + 1]; float pm = fmaxf(a, bb);
#pragma unroll
        for (int off = 1; off < 64; off <<= 1) { const float t = __shfl_up(pm, off); if (lane >= off) pm = fmaxf(pm, t); }
        float pl = __shfl_up(pm, 1); if (lane == 0) pl = -INFINITY;
        const float p0 = fmaxf(pl, a), p1 = pm;
        { const float ai = sBC[2 * lane] + mst, mt = fmaxf(ai, sBC[2 * lane] + p0); sMT[2 * lane] = mt; sSI[2 * lane] = __expf(ai - mt); }
        { const float ai = sBC[2 * lane + 1] + mst, mt = fmaxf(ai, sBC[2 * lane + 1] + p1); sMT[2 * lane + 1] = mt; sSI[2 * lane + 1] = __expf(ai - mt); } }
    const bf16_t* QM = (const bf16_t*)(F.ws + WS_QM); const bf16_t* KM = (const bf16_t*)(F.ws + WS_KM); const bf16_t* VM = (const bf16_t*)(F.ws + WS_VM);
    const bf16_t* Cp = (const bf16_t*)(F.ws + WS_CST) + ((size_t)(bh * 128 + c) << 14);
    QkW WQ, WK; qk_load_w(F, layer, h * 128 + (tid & 15) * 8, WQ); qk_load_w(F, layer, 512 + h * 128 + (tid & 15) * 8, WK);
#pragma unroll 1
    for (int i = tid; i < 128 * 16; i += NTHREADS) { const int l = i >> 4, c8 = (i & 15) * 8; const int t = t0 + l, s = t & (SEQ - 1); float o[8];
        u32x4 rq[4], rk[4];
#pragma unroll
        for (int k = 0; k < 4; ++k) { const size_t ro = (size_t)(s - 3 + k >= 0 ? t - 3 + k : t) * 512 + h * 128 + c8; rq[k] = *(const u32x4*)(QM + ro); rk[k] = *(const u32x4*)(KM + ro); }
        const u32x4 rv = *(const u32x4*)(VM + (size_t)t * 512 + h * 128 + c8), rc = *(const u32x4*)(Cp + l * 128 + c8);
        qk_conv8r(WQ, rq, s, 1.0f, o);
        *(LAS u32x4*)(L + MO_Q + l * MO_RS + c8 * 2) = pack8((f32x4){o[0], o[1], o[2], o[3]}, (f32x4){o[4], o[5], o[6], o[7]});
        qk_conv8r(WK, rk, s, 0.08838834764831845f, o);
        *(LAS u32x4*)(L + MO_K + l * MO_RS + c8 * 2) = pack8((f32x4){o[0], o[1], o[2], o[3]}, (f32x4){o[4], o[5], o[6], o[7]});
        *(LAS u32x4*)(L + MO_V + l * MO_VRS + c8 * 2) = rv;
        *(LAS u32x4*)(L + MO_C + l * MO_RS + c8 * 2) = rc; }
    if (tid < 16) { const float* np = (const float*)(F.ws + WS_NST) + (size_t)(bh * 128 + c) * 128 + tid * 8;
        *(LAS u32x4*)(L + MO_C + 128 * MO_RS + tid * 16) = pack8(*(const f32x4*)np, *(const f32x4*)(np + 4)); }
    __syncthreads();
    const int q = 16 * w + fr;
    bf16x8 qf[4];
#pragma unroll
    for (int ks = 0; ks < 4; ++ks) qf[ks] = *(const LAS bf16x8*)(L + MO_Q + q * MO_RS + ks * 64 + fq * 16);
    f32x4 O[9];
#pragma unroll
    for (int vb = 0; vb < 9; ++vb) { f32x4 a = (f32x4){0.f, 0.f, 0.f, 0.f};
#pragma unroll
        for (int ks = 0; ks < 4; ++ks) { const bf16x8 cf = *(const LAS bf16x8*)(L + MO_C + (vb * 16 + fr) * MO_RS + ks * 64 + fq * 16); a = __builtin_amdgcn_mfma_f32_16x16x32_bf16(cf, qf[ks], a, 0, 0, 0); }
        O[vb] = a; }
    const float si = sSI[q], mt = sMT[q], bq = sBC[q];
    const float dn = __shfl(O[8][0], fr);
#pragma unroll
    for (int vb = 0; vb < 8; ++vb) O[vb] = O[vb] * si;
    float den = 0.f;
    for (int k2 = 0; k2 <= (w >> 1); ++k2) {
        f32x4 P[2];
#pragma unroll
        for (int u = 0; u < 2; ++u) { const int kb = 2 * k2 + u; f32x4 a = (f32x4){0.f, 0.f, 0.f, 0.f};
            const int kr = (kb > 7 ? 7 : kb) * 16 + fr;
#pragma unroll
            for (int ks = 0; ks < 4; ++ks) { const bf16x8 kf = *(const LAS bf16x8*)(L + MO_K + kr * MO_RS + ks * 64 + fq * 16); a = __builtin_amdgcn_mfma_f32_16x16x32_bf16(kf, qf[ks], a, 0, 0, 0); }
#pragma unroll
            for (int j = 0; j < 4; ++j) { const int k = kb * 16 + 4 * fq + j; const int kc = k > 127 ? 127 : k; const float wgt = (k <= q) ? __expf(bq - sBC[kc] + sIG[kc] - mt) : 0.f; a[j] *= wgt; den += a[j]; }
            P[u] = a; }
        u32x4 pw; pw.x = cvt_pk_bf16(P[0][0], P[0][1]); pw.y = cvt_pk_bf16(P[0][2], P[0][3]); pw.z = cvt_pk_bf16(P[1][0], P[1][1]); pw.w = cvt_pk_bf16(P[1][2], P[1][3]);
        const bf16x8 pf = __builtin_bit_cast(bf16x8, pw);
        const int kb1 = (2 * k2 + 1 > 7) ? 7 : 2 * k2 + 1;
        const int r0 = 2 * k2 * 16 + 4 * fq + (fr >> 2), r1 = kb1 * 16 + 4 * fq + (fr >> 2);
#pragma unroll
        for (int vb = 0; vb < 8; ++vb) {
            const s16x4 v0 = lds_tr16(L + MO_V + r0 * MO_VRS + (vb * 16 + 4 * (fr & 3)) * 2), v1 = lds_tr16(L + MO_V + r1 * MO_VRS + (vb * 16 + 4 * (fr & 3)) * 2);
            const bf16x8 vf = (bf16x8){v0[0], v0[1], v0[2], v0[3], v1[0], v1[1], v1[2], v1[3]};
            O[vb] = __builtin_amdgcn_mfma_f32_16x16x32_bf16(vf, pf, O[vb], 0, 0, 0);
        }
    }
    den += __shfl_xor(den, 16); den += __shfl_xor(den, 32);
    const float dd = den + si * dn; const float inv = 1.0f / fmaxf(fabsf(dd), __expf(-mt));
    bf16_t* OM = (bf16_t*)(F.ws + WS_OM) + (size_t)(t0 + q) * 512 + h * 128;
#pragma unroll
    for (int vb = 0; vb < 8; ++vb) { u32x2* p = (u32x2*)(OM + vb * 16 + 4 * fq); const u32x2 g = *p;
        u32x2 o; o.x = cvt_pk_bf16(bf_lo(g.x) * O[vb][0] * inv, bf_hi(g.x) * O[vb][1] * inv); o.y = cvt_pk_bf16(bf_lo(g.y) * O[vb][2] * inv, bf_hi(g.y) * O[vb][3] * inv); *p = o; }
}

__device__ __forceinline__ void phase_route(const Ctx& F, int layer, int tile0, int tile1, int tstep) {
    LAS int* hist = (LAS int*)F.lds;
    const float* brg = F.in[I_BRG] + layer * 4; const float* bre = F.in[I_BRE] + layer * 32;
    for (int tile = tile0; tile < tile1; tile += tstep) {
        __syncthreads();
        if (F.tid < 128) { const int t = tile * 128 + F.tid; const float* lg = (const float*)(F.ws + WS_LOGITS) + (size_t)t * 64;
            float g[4]; int gs = 0; float gm;
#pragma unroll
            for (int j = 0; j < 4; ++j) g[j] = lg[j] + brg[j];
            gm = g[0];
#pragma unroll
            for (int j = 1; j < 4; ++j) if (g[j] > gm) { gm = g[j]; gs = j; }
            float se = 0.f;
#pragma unroll
            for (int j = 0; j < 4; ++j) se += __expf(g[j] - gm);
            const float pg = 1.0f / se;
            float le[8];
#pragma unroll
            for (int j = 0; j < 8; ++j) le[j] = lg[4 + gs * 8 + j] + bre[gs * 8 + j];
            int i0 = 0; float v0 = le[0];
#pragma unroll
            for (int j = 1; j < 8; ++j) if (le[j] > v0) { v0 = le[j]; i0 = j; }
            int i1 = -1; float v1 = -INFINITY;
#pragma unroll
            for (int j = 0; j < 8; ++j) if (j != i0 && le[j] > v1) { v1 = le[j]; i1 = j; }
            const float e1 = __expf(v1 - v0); const float wsc = (ABL == 4) ? 0.f : ((ABL == 6) ? 2.f : 1.f); const float w0 = wsc * pg / (1.0f + e1), w1 = wsc * pg * e1 / (1.0f + e1);
            const int x0 = gs * 8 + i0, x1 = gs * 8 + i1;
            ((int*)(F.ws + WS_ROUTE))[2 * t] = x0; ((int*)(F.ws + WS_ROUTE))[2 * t + 1] = x1;
            ((float*)(F.ws + WS_ROUTE))[2 * T + 2 * t] = w0; ((float*)(F.ws + WS_ROUTE))[2 * T + 2 * t + 1] = w1;
            hist[F.tid] = x0; hist[128 + F.tid] = x1;
        }
        __syncthreads();
        if (F.tid < 64) { const int k = F.tid >> 5, e = F.tid & 31; int cnt = 0; for (int j = 0; j < 128; ++j) cnt += (hist[k * 128 + j] == e) ? 1 : 0; ((int*)(F.ws + WS_TAB + TAB_CNT))[tile * 64 + F.tid] = cnt; }
        __syncthreads();
    }
}
__device__ __forceinline__ void phase_dispatch(const Ctx& F) {
    LAS int* sTot = (LAS int*)F.lds; LAS int* sBef = sTot + 64; LAS int* sPs = sTot + 128; LAS int* sE = sTot + 256; LAS int* sPart = sTot + 512;
    const int* CNT = (const int*)(F.ws + WS_TAB + TAB_CNT); int* META = (int*)(F.ws + WS_TAB + TAB_META);
    int* tokl = (int*)(F.ws + WS_LISTS); float* wl = (float*)(F.ws + WS_LISTS) + 2 * LISTCAP;
    for (int tile = F.bid; tile < 256; tile += F.G) {
        { const int ke = F.tid & 63, grp = F.tid >> 6; int cv[32];
#pragma unroll
            for (int i = 0; i < 32; ++i) cv[i] = CNT[(grp + 8 * i) * 64 + ke];
            int tot = 0, bef = 0;
#pragma unroll
            for (int i = 0; i < 32; ++i) { tot += cv[i]; bef += (grp + 8 * i < tile) ? cv[i] : 0; }
            sPart[grp * 64 + ke] = tot; sPart[512 + grp * 64 + ke] = bef; }
        __syncthreads();
        if (F.tid < 64) { int tot = 0, bef = 0;
#pragma unroll
            for (int gI = 0; gI < 8; ++gI) { tot += sPart[gI * 64 + F.tid]; bef += sPart[512 + gI * 64 + F.tid]; }
            sTot[F.tid] = tot; sBef[F.tid] = bef; }
        __syncthreads();
        if (F.tid < 2) { int ps = 0; for (int e = 0; e < 32; ++e) { sPs[F.tid * 33 + e] = ps; ps += ((sTot[F.tid * 32 + e] + 255) >> 8) << 8; } sPs[F.tid * 33 + 32] = ps;
            if (tile == 0) { META[F.tid] = ps >> 8; for (int e = 0; e <= 32; ++e) META[16 + 64 * F.tid + e] = sPs[F.tid * 33 + e]; } }
        int e0 = 0, e1 = 0; float w0 = 0.f, w1 = 0.f;
        if (F.tid < 128) { const int t = tile * 128 + F.tid; e0 = ((const int*)(F.ws + WS_ROUTE))[2 * t]; e1 = ((const int*)(F.ws + WS_ROUTE))[2 * t + 1];
            w0 = ((const float*)(F.ws + WS_ROUTE))[2 * T + 2 * t]; w1 = ((const float*)(F.ws + WS_ROUTE))[2 * T + 2 * t + 1]; sE[F.tid] = e0; sE[128 + F.tid] = e1; }
        __syncthreads();
        if (F.tid < 128) { int r0 = 0, r1 = 0; for (int j = 0; j < F.tid; ++j) { r0 += (sE[j] == e0) ? 1 : 0; r1 += (sE[128 + j] == e1) ? 1 : 0; }
            const int p0 = sPs[e0] + sBef[e0] + r0, p1 = sPs[33 + e1] + sBef[32 + e1] + r1;
            tokl[p0] = tile * 128 + F.tid; wl[p0] = w0; tokl[LISTCAP + p1] = tile * 128 + F.tid; wl[LISTCAP + p1] = w1; }
        __syncthreads();
    }
}
__device__ __forceinline__ void phase_final(const Ctx& F, const float* SS) {
    const int gw = F.bid * NWAVES + F.wave, NGW = F.G * NWAVES, lane = F.lane;
    const f32x4* g = (const f32x4*)F.in[I_GFIN] + 2 * lane; const f32x4 g00 = g[0], g01 = g[1], g10 = g[128], g11 = g[129];
    for (int m0 = gw; m0 < T; m0 += 4 * NGW) {
        u32x4 xr[4][2]; f32x4 sa[4];
#pragma unroll
        for (int r = 0; r < 4; ++r) { const int m = m0 + r * NGW; const u32x4* xp = (const u32x4*)((const bf16_t*)(F.ws + WS_XBT) + (size_t)m * D) + lane; xr[r][0] = xp[0]; xr[r][1] = xp[64];
            sa[r] = *((const f32x4*)(SS + (size_t)m * 16) + (lane & 3)); }
        PIN8(xr[0][0], xr[0][1], xr[1][0], xr[1][1], xr[2][0], xr[2][1], xr[3][0], xr[3][1]); PIN4(sa[0], sa[1], sa[2], sa[3]);
#pragma unroll
        for (int r = 0; r < 4; ++r) { const int m = m0 + r * NGW; float sq = (sa[r].x + sa[r].y) + (sa[r].z + sa[r].w); sq += __shfl_xor(sq, 1); sq += __shfl_xor(sq, 2);
            const float rs = rsqrtf(sq * (1.0f / 1024.0f) + EPS); f32x4* o = (f32x4*)(F.out + (size_t)m * D) + 2 * lane;
            f32x4 x0, x1; unpack8(xr[r][0], x0, x1); o[0] = x0 * rs * g00; o[1] = x1 * rs * g01; unpack8(xr[r][1], x0, x1); o[128] = x0 * rs * g10; o[129] = x1 * rs * g11; }
    }
}
constexpr int PH_PER_LAYER = 15, PH_FINAL = DEPTH * PH_PER_LAYER, N_PHASES = PH_FINAL + 1;
struct Args { const float* in[28]; float* out; unsigned char* ws; int ph_lo, ph_hi; };

__device__ __forceinline__ Ctx mkctx(const Args& args, LAS unsigned char* lds, int wave_s) {
    Ctx F; asm volatile("" : "+s"(wave_s)); int tid = wave_s * 64 + lane_id_(); asm volatile("" : "+v"(tid));
    GAS unsigned char* wsg = (GAS unsigned char*)args.ws; asm volatile("" : "+s"(wsg)); unsigned char* ws = (unsigned char*)wsg;
    GAS float* outg = (GAS float*)args.out; asm volatile("" : "+s"(outg)); float* outp = (float*)outg;
    int bid = blockIdx.x; asm volatile("" : "+s"(bid)); int G = gridDim.x; asm volatile("" : "+s"(G));
    F.in.p = args.in; F.out = outp; F.ws = ws; F.lds = lds;
    F.tid = tid; F.lane = tid & 63; F.wave = wave_s; F.G = G; F.bid = bid;
    return F;
}
#ifndef ONLY_PHASE
#define ONLY_PHASE -1
#endif
#ifndef STAGGER_TICKS
#define STAGGER_TICKS 1300
#endif
__device__ __forceinline__ void run_phase(const Args& args, LAS unsigned char* lds, int ph, int wave_s) {
    const int layer = ph / PH_PER_LAYER, lp = ph - layer * PH_PER_LAYER;
    const size_t ssin = (layer & 1) ? WS_SS1 : WS_SS0, ssmid = (layer & 1) ? WS_SS0 : WS_SS1;
    if (ph == PH_FINAL) { const Ctx F = mkctx(args, lds, wave_s); phase_final(F, (const float*)(F.ws + WS_SS0)); return; }
    if (ONLY_PHASE >= 0 && lp != ONLY_PHASE) return;
    switch (lp) {
    case 0: { const Ctx F = mkctx(args, lds, wave_s); phase_prep(F, layer, (float*)(F.ws + ssin)); } break;
    case 1: { const Ctx F = mkctx(args, lds, wave_s); PhProj P{(const char*)F.ws + WS_XB, (const char*)F.ws + WS_WIN, (const float*)(F.ws + ssin), F.ws, F.G, F.bid}; pg8::gemm_phase(F.lds, P, F.tid); } break;
    case 2: { const Ctx F = mkctx(args, lds, wave_s);
        for (int it = F.bid; it < 768; it += F.G) attn_strip(F, it);
        __syncthreads();
        for (int it = F.bid; it < 1024; it += F.G) mlstm_local_mfma(F, layer, it);
        for (int it = F.bid; it < 1024; it += F.G) conv_item(F, layer, it);
    } break;
    case 3: { const Ctx F = mkctx(args, lds, wave_s); phase_scan(F); attn_combine(F); } break;
    case 4: { const Ctx F = mkctx(args, lds, wave_s); for (int it = F.bid; it < 1024; it += F.G) mlstm_out_mfma(F, layer, it); } break;
    case 5: { const Ctx F = mkctx(args, lds, wave_s); PhGates P{(const char*)F.ws + WS_XB, (const char*)F.ws + WS_WIN, (const float*)(F.ws + ssin), F.ws, F.G, F.bid}; pg8::gemm_phase(F.lds, P, F.tid); } break;
    case 6: { const Ctx F = mkctx(args, lds, wave_s); PhMerge P{F.ws, F.G, F.bid};
        pg8::gemm_phase(F.lds, P, F.tid); } break;
    case 7: { const Ctx F = mkctx(args, lds, wave_s); PhOut P{F.ws, (float*)(F.ws + ssmid), F.G, F.bid}; pg8::gemm_phase(F.lds, P, F.tid); } break;
    case 8: { const Ctx F = mkctx(args, lds, wave_s); PhRouter P{F.ws, (const float*)(F.ws + ssmid), F.G, F.bid}; pg8::gemm_phase(F.lds, P, F.tid);
        { int* tokl = (int*)(F.ws + WS_LISTS); for (int i = F.bid * NTHREADS + F.tid; i < 2 * LISTCAP; i += F.G * NTHREADS) tokl[i] = -1; }
        for (int pm = F.bid; pm < 128; pm += F.G) phase_route(F, layer, 2 * pm, 2 * pm + 2, 1);
        phase_prep_experts(F, layer); } break;
    case 9: break;
    case 10: { const Ctx F = mkctx(args, lds, wave_s); phase_dispatch(F); } break;
    case 11: { const Ctx F = mkctx(args, lds, wave_s); PhUp P{F.ws, (const float*)(F.ws + ssmid), (const int*)(F.ws + WS_TAB + TAB_META), (const int*)(F.ws + WS_LISTS), F.G, F.bid}; pg8::gemm_phase(F.lds, P, F.tid); } break;
    case 12: { const Ctx F = mkctx(args, lds, wave_s); PhDown<1> P{F.ws, (float*)(F.ws + ssin), (const int*)(F.ws + WS_TAB + TAB_META), (const int*)(F.ws + WS_LISTS), (const float*)(F.ws + WS_LISTS) + 2 * LISTCAP, F.G, F.bid}; pg8::gemm_phase(F.lds, P, F.tid); } break;
    case 13: { const Ctx F = mkctx(args, lds, wave_s); PhDown<0> P{F.ws, (float*)(F.ws + ssin), (const int*)(F.ws + WS_TAB + TAB_META), (const int*)(F.ws + WS_LISTS), (const float*)(F.ws + WS_LISTS) + 2 * LISTCAP, F.G, F.bid}; pg8::gemm_phase(F.lds, P, F.tid); } break;
    case 14: { const Ctx F = mkctx(args, lds, wave_s); PhPle P{F.ws, (const float*)(F.ws + ssin), (float*)(F.ws + ssmid), F.G, F.bid}; pg8::gemm_phase(F.lds, P, F.tid); } break;
    }
}

__global__ void __launch_bounds__(NTHREADS, 2) fwd_kernel(Args args) {
    extern __shared__ __attribute__((aligned(16))) unsigned char lds_raw[];
    LAS unsigned char* lds = (LAS unsigned char*)lds_raw;
    volatile LAS unsigned* MISC = (volatile LAS unsigned*)(lds + MISC_OFF);
    const int wave_s = __builtin_amdgcn_readfirstlane((int)threadIdx.x >> 6);
    if (wave_s == 0) MISC[lane_id_()] = 0u;
    __syncthreads();
#if MK_MEGA
    XcdBarrier bar = xcd_barrier_post((unsigned*)(args.ws + WS_CTL) + 4096, MISC + 8, wave_s);
#endif
#ifndef PROBE_SEL
#define PROBE_SEL 0
#endif
    unsigned long long extra = 0ull;
    for (int ph = args.ph_lo; ph < args.ph_hi; ++ph) {
        if (ph < PH_FINAL && (ph % PH_PER_LAYER) == 9) continue;
        const unsigned long long t0 = PROBE_SEL ? __builtin_amdgcn_s_memrealtime() : 0ull;
        run_phase(args, lds, ph, wave_s);
#if MK_MEGA
        if (ph + 1 < args.ph_hi) xcd_barrier(bar);
#endif
        if (PROBE_SEL) { const int lp = ph % PH_PER_LAYER; if (ph < PH_FINAL && ((PROBE_SEL >> lp) & 1)) extra += __builtin_amdgcn_s_memrealtime() - t0; }
    }
    if (PROBE_SEL && blockIdx.x == 0) { const unsigned long long te = __builtin_amdgcn_s_memrealtime(); while (__builtin_amdgcn_s_memrealtime() - te < extra) __builtin_amdgcn_s_sleep(8); }
}

extern "C" void kernel_launch(void* const* d_in, const int* in_sizes, int n_in, void* d_out, int out_size, void* d_ws, size_t ws_size, hipStream_t stream) {
    static int grid = 0;
    if (grid == 0) {
        if (n_in != 28 || out_size != T * D || ws_size < WS_END) { fprintf(stderr, "kernel_launch: unexpected shapes (n_in %d out %d ws %zu, need %zu)\n", n_in, out_size, ws_size, (size_t)WS_END); grid = -1; return; }
        int dev = 0, cus = 0, per_cu = 0;
        if (hipGetDevice(&dev) != hipSuccess || hipDeviceGetAttribute(&cus, hipDeviceAttributeMultiprocessorCount, dev) != hipSuccess) { grid = -1; return; }
        if (hipFuncSetAttribute((const void*)fwd_kernel, hipFuncAttributeMaxDynamicSharedMemorySize, LDS_BYTES) != hipSuccess) { fprintf(stderr, "kernel_launch: hipFuncSetAttribute failed\n"); grid = -1; return; }
        if (hipOccupancyMaxActiveBlocksPerMultiprocessor(&per_cu, (const void*)fwd_kernel, NTHREADS, LDS_BYTES) != hipSuccess || per_cu < 1) { fprintf(stderr, "kernel_launch: occupancy query says %d blocks per CU\n", per_cu); }
        (void)hipGetLastError();
        grid = cus;
    }
    if (grid < 0) return;
    Args a{};
    for (int i = 0; i < 28; ++i) a.in[i] = (const float*)d_in[i];
    a.out = (float*)d_out; a.ws = (unsigned char*)d_ws;
#if MK_MEGA
    (void)hipMemsetAsync((char*)d_ws + WS_CTL, 0, CTL_ZERO_BYTES, stream);
    a.ph_lo = 0; a.ph_hi = N_PHASES;
    hipLaunchKernelGGL(fwd_kernel, dim3(grid), dim3(NTHREADS), LDS_BYTES, stream, a);
#else
    for (int ph = 0; ph < N_PHASES; ++ph) { a.ph_lo = ph; a.ph_hi = ph + 1; hipLaunchKernelGGL(fwd_kernel, dim3(grid), dim3(NTHREADS), LDS_BYTES, stream, a); }
#endif
}
```

```cpp
#include <hip/hip_runtime.h>
#include <cstdio>
#include <cstdint>

#ifndef MK_MEGA
#define MK_MEGA 1
#endif

#ifndef ABL
#define ABL 0
#endif
#define LAS __attribute__((address_space(3)))
#define GAS __attribute__((address_space(1)))
typedef unsigned short bf16_t;
typedef short bf16x8 __attribute__((ext_vector_type(8)));
typedef float f32x4 __attribute__((ext_vector_type(4)));
typedef float f32x2 __attribute__((ext_vector_type(2)));
typedef unsigned u32x4 __attribute__((ext_vector_type(4)));
typedef unsigned u32x2 __attribute__((ext_vector_type(2)));

constexpr int T = 32768, SEQ = 16384, D = 1024, DEPTH = 2;
constexpr int D_IN = 8712;
constexpr float EPS = 1e-6f;
constexpr int NTHREADS = 512, NWAVES = 8;
constexpr int LISTCAP = 40960;

constexpr size_t MiB = 1u << 20;
constexpr size_t WS_CTL = 0, CTL_ZERO_BYTES = 1 * MiB;
constexpr size_t WS_TAB = 1 * MiB;
constexpr size_t WS_ROUTE = 2 * MiB;
constexpr size_t WS_LISTS = 3 * MiB;
constexpr size_t WS_SS0 = 4 * MiB, WS_SS1 = 6 * MiB;
constexpr size_t WS_IF = 8 * MiB;
constexpr size_t WS_NST = 9 * MiB;
constexpr size_t WS_LOGITS = 10 * MiB;
constexpr size_t WS_WIN = 18 * MiB;
constexpr size_t WS_WBR = WS_WIN + 8960ull * 1024 * 2;
constexpr size_t WS_WOUT = WS_WBR + 3ull * 1024 * 512 * 2;
constexpr size_t WS_WPG = WS_WOUT + 1024ull * 1024 * 2;
constexpr size_t WS_WPP = WS_WPG + 1024ull * 1024 * 2;
constexpr size_t WS_WR = WS_WPP + 1024ull * 256 * 2;
static_assert(WS_WR + 256ull * 1024 * 2 <= 44 * MiB, "small weights");
constexpr size_t WS_XB = 44 * MiB;
constexpr size_t WS_QA0 = 108 * MiB;
constexpr size_t WS_YATT = WS_QA0;
constexpr size_t WS_OM = 140 * MiB;
constexpr size_t WS_YC = 172 * MiB;
constexpr size_t WS_CST = 204 * MiB;
constexpr size_t WS_B = 236 * MiB;
constexpr size_t WS_KA = WS_B, WS_QA1 = WS_B + 32 * MiB, WS_QA2 = WS_B + 64 * MiB, WS_VA = WS_B + 96 * MiB, WS_YG = WS_B + 128 * MiB, WS_QM = WS_B + 160 * MiB, WS_KM = WS_B + 192 * MiB, WS_VM = WS_B + 224 * MiB;
constexpr size_t WS_G0 = WS_B, WS_MERGED = WS_B + 192 * MiB;
constexpr size_t WS_WEXP = WS_B, WS_HB = WS_B + 48 * MiB, WS_PBF = WS_B + 88 * MiB, WS_PE = WS_B + 104 * MiB, WS_YB1 = WS_B + 168 * MiB, WS_XBT = WS_B;
constexpr size_t WS_END = 492 * MiB;
constexpr size_t TAB_CNT = 0;
constexpr size_t TAB_META = 65536;
constexpr size_t TAB_MLOC = 131072, TAB_GTOT = 131072 + 4096, TAB_MST = 131072 + 8192;

constexpr int RING_BYTES = 131072;
constexpr int MISC_OFF = 155648;
constexpr int LDS_BYTES = 156672;

__device__ __forceinline__ unsigned f2bf(float f) { unsigned u = __builtin_bit_cast(unsigned, f); return (u + 0x7fffu + ((u >> 16) & 1u)) >> 16; }
__device__ __forceinline__ unsigned pk2(float lo, float hi) { return f2bf(lo) | (f2bf(hi) << 16); }
__device__ __forceinline__ unsigned cvt_pk_bf16(float lo, float hi) { unsigned r; asm volatile("v_cvt_pk_bf16_f32 %0, %1, %2" : "=v"(r) : "v"(lo), "v"(hi)); return r; }
__device__ __forceinline__ float bf_lo(unsigned w) { return __builtin_bit_cast(float, w << 16); }
__device__ __forceinline__ float bf_hi(unsigned w) { return __builtin_bit_cast(float, w & 0xffff0000u); }
__device__ __forceinline__ float bf1(bf16_t h) { return __builtin_bit_cast(float, ((unsigned)h) << 16); }
__device__ __forceinline__ float sigmoidf_(float v) { return __builtin_amdgcn_rcpf(1.0f + __expf(-v)); }
__device__ __forceinline__ float siluf_(float v) { return v * __builtin_amdgcn_rcpf(1.0f + __expf(-v)); }
__device__ __forceinline__ float wave_sum(float v) {
#pragma unroll
    for (int o = 1; o < 64; o <<= 1) v += __shfl_xor(v, o);
    return v;
}
__device__ __forceinline__ float wave_max(float v) {
#pragma unroll
    for (int o = 1; o < 64; o <<= 1) v = fmaxf(v, __shfl_xor(v, o));
    return v;
}
__device__ __forceinline__ int lane_id_() { int l; asm volatile("v_mbcnt_lo_u32_b32 %0, -1, 0\n\tv_mbcnt_hi_u32_b32 %0, -1, %0" : "=&v"(l)); return l; }
#define LDS_WAIT() asm volatile("s_waitcnt lgkmcnt(0)" ::: "memory")
#define VM_WAIT() asm volatile("s_waitcnt vmcnt(0)" ::: "memory")

#define XB_TMO      128
#define XB_XCNT(j)  (256  + 64 * (j))
#define XB_XSUB(j)  (1280 + 64 * (j))
#define XB_XGEN(j)  (2304 + 64 * (j))
#define XB_TOP      3328
#define XB_TOPGEN   3392
#define XCD_BAR_WORDS 3456
#define XB_SPIN_CAP (1u << 22)
__device__ __forceinline__ unsigned xb_ld(unsigned* p)              { return __hip_atomic_load(p, __ATOMIC_RELAXED, __HIP_MEMORY_SCOPE_AGENT); }
__device__ __forceinline__ unsigned xb_add(unsigned* p, unsigned v) { return __hip_atomic_fetch_add(p, v, __ATOMIC_RELAXED, __HIP_MEMORY_SCOPE_AGENT); }
__device__ __forceinline__ unsigned xb_xcc_id() { return (unsigned)__builtin_amdgcn_s_getreg((3 << 11) | 20) & 0xFu; }
#define XB_SPIN(cond, bar) do { unsigned _sp = 0; while (cond) { __builtin_amdgcn_s_sleep(1); \
    if ((++_sp & 255u) == 0u) { if (xb_ld(&(bar)[XB_TMO])) break; if (_sp > XB_SPIN_CAP) { atomicAdd(&(bar)[XB_TMO], 1u); break; } } } } while (0)
struct XcdBarrier { unsigned* bar; unsigned x; volatile LAS unsigned* st; int wave; };
__device__ __forceinline__ XcdBarrier xcd_barrier_post(unsigned* bar, volatile LAS unsigned* st, int wave) {
    XcdBarrier b; b.bar = bar; b.x = xb_xcc_id(); b.st = st; b.wave = wave;
    if (wave == 0 && lane_id_() == 0) (void)xb_add(&bar[XB_XCNT(b.x)], 1u);
    return b;
}
__device__ __forceinline__ void xcd_barrier_complete(unsigned* bar, unsigned x, unsigned& nloc, unsigned& nx) {
    const unsigned G = gridDim.x * gridDim.y * gridDim.z;
    unsigned sum, cnt, mine, sp = 0u;
    for (;;) {
        sum = 0u; cnt = 0u; mine = 0u;
#pragma unroll
        for (unsigned j = 0; j < 16; ++j) { const unsigned c = xb_ld(&bar[XB_XCNT(j)]); sum += c; cnt += (c > 0u) ? 1u : 0u; mine = (j == x) ? c : mine; }
        if (sum == G) break;
        __builtin_amdgcn_s_sleep(1);
        if ((++sp & 255u) == 0u) { if (xb_ld(&bar[XB_TMO])) break; if (sp > XB_SPIN_CAP) { atomicAdd(&bar[XB_TMO], 1u); break; } }
    }
    nloc = mine > 0u ? mine : 1u; nx = cnt > 0u ? cnt : 1u;
}
__device__ __forceinline__ void xcd_barrier(const XcdBarrier& b) {
    asm volatile("s_waitcnt vmcnt(0)" ::: "memory");
    __syncthreads();
    if (b.wave == 0 && lane_id_() == 0) {
        unsigned* bar = b.bar;
        __builtin_amdgcn_s_waitcnt(0);
        unsigned nloc = b.st[0], nx = b.st[1];
        if (nloc == 0u) { xcd_barrier_complete(bar, b.x, nloc, nx); b.st[0] = nloc; b.st[1] = nx; }
        const unsigned old = xb_add(&bar[XB_XSUB(b.x)], 1u);
        const unsigned gen = old / nloc;
        if (old + 1u == (gen + 1u) * nloc) {
            __builtin_amdgcn_fence(__ATOMIC_RELEASE, "agent");
            asm volatile("s_waitcnt vmcnt(0)" ::: "memory");
            const unsigned og = xb_add(&bar[XB_TOP], 1u);
            const unsigned tg = og / nx;
            if (og + 1u == (tg + 1u) * nx) xb_add(&bar[XB_TOPGEN], 1u);
            else XB_SPIN(xb_ld(&bar[XB_TOPGEN]) == tg, bar);
            __builtin_amdgcn_fence(__ATOMIC_ACQUIRE, "agent");
            xb_add(&bar[XB_XGEN(b.x)], 1u);
            asm volatile("s_waitcnt vmcnt(0)" ::: "memory");
        } else {
            XB_SPIN(xb_ld(&bar[XB_XGEN(b.x)]) == gen, bar);
            __builtin_amdgcn_fence(__ATOMIC_ACQUIRE, "agent");
            asm volatile("s_waitcnt vmcnt(0)" ::: "memory");
        }
    }
    __syncthreads();
}

namespace pg8 {
constexpr int BM = 256, BK = 64, HALF = 128, HTB = HALF * BK * 2, NXCD = 8, WGM = 8;
__device__ __forceinline__ int lds_byte(int r, int c) { const int st = (r >> 4) * 2 + (c >> 5), rr = r & 15, cc = c & 31, ob = rr * 64 + cc * 2; return st * 1024 + (ob ^ (((ob >> 9) & 1) << 5)); }
__device__ __forceinline__ void stage_rc(int b, int& R, int& C) { const int st = b / 1024, sb = b % 1024, swz = sb ^ (((sb >> 9) & 1) << 5); R = (st >> 1) * 16 + swz / 64; C = (st & 1) * 32 + (swz % 64) / 2; }
__device__ __forceinline__ int perm32(int rho) { const int n = rho >> 4, i = rho & 15; return 8 * (i >> 2) + 4 * n + (i & 3); }

struct GUnit { const char* A; const char* B; int pm, pn, a0, a1; };

__device__ __forceinline__ void tile_order(int L, int nM, int nN, int& pm, int& pn) {
    const int nwg = nM * nN; int wgid = L;
    { const int q = nwg / NXCD, r = nwg % NXCD, xcd = wgid % NXCD, off = wgid / NXCD; wgid = (xcd < r ? xcd * (q + 1) : r * (q + 1) + (xcd - r) * q) + off; }
    const int nig = WGM * nN, gid = wgid / nig, fm = gid * WGM, gsz = (nM - fm) < WGM ? (nM - fm) : WGM;
    pm = fm + ((wgid % nig) % gsz); pn = (wgid % nig) / gsz;
}

typedef f32x4 Acc[2][2][4][2];

template <class P>
__device__ __forceinline__ void gemm_phase(LAS unsigned char* lds, const P& S, int tid) {
    asm volatile("" : "+v"(tid));
    const int wid = __builtin_amdgcn_readfirstlane(tid >> 6), lane = tid & 63, wr = wid >> 2, wc = wid & 3, fr = lane & 15, fq = lane >> 4;
    constexpr int K = P::K, nt = K / BK;
    static_assert(nt >= 4 && (nt % 2) == 0, "K multiple of 128, >= 256");
    unsigned voffB[2];
#pragma unroll
    for (int i = 0; i < 2; ++i) { int R, C; stage_rc(tid * 16 + i * 8192, R, C); const int Rb = (R & ~31) + perm32(R & 31); voffB[i] = (unsigned)(Rb * K + C) * 2u; }
    constexpr size_t kstep = (size_t)(BK * 2);
    constexpr size_t hstepB = (size_t)HALF * K * 2;
    const unsigned ldsw = (unsigned)wid * 1024u;
    const int aoff = lds_byte(wr * 64 + fr, fq * 8), boff = lds_byte(wc * 32 + fr, fq * 8);
#define PG8_SA(b, h) (((b) * 2 + (h)) * HTB)
#define PG8_SB(b, h) ((4 + (b) * 2 + (h)) * HTB)
#define PG8_STAGE(bufoff, gbase, voff) do { _Pragma("unroll") for (int _i = 0; _i < 2; ++_i) \
        __builtin_amdgcn_global_load_lds((const unsigned*)((const char*)(gbase) + (voff)[_i]), (LAS unsigned*)(lds + (bufoff) + ldsw + _i * 8192), 16, 0, 0); } while (0)
#define PG8_LDA(dst, b, h) do { _Pragma("unroll") for (int m = 0; m < 4; ++m) _Pragma("unroll") for (int k = 0; k < 2; ++k) dst[m][k] = *(const LAS bf16x8*)(lds + PG8_SA(b, h) + aoff + m * 2048 + k * 1024); } while (0)
#define PG8_LDB(dst, b, h) do { _Pragma("unroll") for (int n = 0; n < 2; ++n) _Pragma("unroll") for (int k = 0; k < 2; ++k) dst[n][k] = *(const LAS bf16x8*)(lds + PG8_SB(b, h) + boff + n * 2048 + k * 1024); } while (0)
#define PG8_MMA(ai, bj, At, Bt) do { __builtin_amdgcn_s_setprio(1); _Pragma("unroll") for (int m = 0; m < 4; ++m) _Pragma("unroll") for (int n = 0; n < 2; ++n) _Pragma("unroll") for (int k = 0; k < 2; ++k) \
        acc[ai][bj][m][n] = __builtin_amdgcn_mfma_f32_16x16x32_bf16(Bt[n][k], At[m][k], acc[ai][bj][m][n], 0, 0, 0); __builtin_amdgcn_s_setprio(0); } while (0)
#define PG8_WAIT_V(n) asm volatile("s_waitcnt vmcnt(" #n ")" ::: "memory")
#define PG8_WAIT_L(n) asm volatile("s_waitcnt lgkmcnt(" #n ")" ::: "memory")
#define PG8_BAR __builtin_amdgcn_s_barrier()
#define PG8_SCHED __builtin_amdgcn_sched_barrier(0)
#define PG8_VOA(dst, u) do { _Pragma("unroll") for (int _h = 0; _h < 2; ++_h) _Pragma("unroll") for (int _i = 0; _i < 2; ++_i) { int _R, _C; stage_rc(tid * 16 + _i * 8192, _R, _C); \
        if constexpr (P::GATHER) dst[_h][_i] = (S.arow(u, _h * HALF + _R) * (unsigned)K + (unsigned)_C) * 2u; \
        else dst[_h][_i] = (unsigned)((_h * HALF + _R) * K + _C) * 2u; } } while (0)
    GUnit cur, nxt; int ui = 0;
    if (!S.next(0, cur)) return;
    Acc acc;
#pragma unroll
    for (int a = 0; a < 2; ++a)
#pragma unroll
        for (int b = 0; b < 2; ++b)
#pragma unroll
            for (int m = 0; m < 4; ++m)
#pragma unroll
                for (int n = 0; n < 2; ++n) acc[a][b][m][n] = (f32x4){0.f, 0.f, 0.f, 0.f};
    bf16x8 At[4][2], B0[2][2], B1[2][2];
    unsigned voA[2][2], voAn[2][2];
    PG8_VOA(voA, cur);
    const char* cA = cur.A; const char* cB = cur.B;
    PG8_STAGE(PG8_SB(0, 0), cB, voffB); PG8_STAGE(PG8_SB(0, 1), cB + hstepB, voffB); PG8_STAGE(PG8_SA(0, 0), cA, voA[0]); PG8_STAGE(PG8_SA(0, 1), cA, voA[1]);
    if (wr == 1) PG8_BAR;
    PG8_WAIT_V(2); PG8_BAR;
    PG8_STAGE(PG8_SB(1, 0), cB + kstep, voffB); PG8_STAGE(PG8_SA(1, 0), cA + kstep, voA[0]); PG8_STAGE(PG8_SB(1, 1), cB + hstepB + kstep, voffB);
    PG8_WAIT_V(6); PG8_BAR;
    for (;;) {
        const bool has_next = S.next(ui + 1, nxt);
        const char* nA = has_next ? nxt.A : cA; const char* nB = has_next ? nxt.B : cB;
        if constexpr (P::GATHER) {
            if (has_next) { PG8_VOA(voAn, nxt); }
            else {
#pragma unroll
                for (int h = 0; h < 2; ++h)
#pragma unroll
                    for (int i = 0; i < 2; ++i) voAn[h][i] = voA[h][i];
            }
        }
#pragma unroll 1
        for (int t = 0; t < nt; t += 2) {
            const bool last = (t == nt - 2);
            const char* a1 = cA + (size_t)(t + 1) * kstep;
            const char* a2 = last ? nA : cA + (size_t)(t + 2) * kstep; const char* b2 = last ? nB : cB + (size_t)(t + 2) * kstep;
            const char* a3 = a2 + kstep; const char* b3 = b2 + kstep;
            unsigned s0[2], s1[2];
#pragma unroll
            for (int i = 0; i < 2; ++i) {
                if constexpr (P::GATHER) { s0[i] = last ? voAn[0][i] : voA[0][i]; s1[i] = last ? voAn[1][i] : voA[1][i]; }
                else { s0[i] = voA[0][i]; s1[i] = voA[1][i]; }
            }
            PG8_LDB(B0, 0, 0); PG8_LDB(B1, 0, 1); PG8_SCHED; PG8_LDA(At, 0, 0); PG8_STAGE(PG8_SA(1, 1), a1, voA[1]);
            PG8_WAIT_V(8); PG8_WAIT_L(0); PG8_BAR; PG8_MMA(0, 0, At, B0); PG8_MMA(0, 1, At, B1); PG8_BAR; PG8_SCHED;
            PG8_LDA(At, 0, 1); PG8_STAGE(PG8_SB(0, 0), b2, voffB); PG8_STAGE(PG8_SB(0, 1), b2 + hstepB, voffB); PG8_STAGE(PG8_SA(0, 0), a2, s0);
            PG8_WAIT_V(8); PG8_WAIT_L(0); PG8_BAR; PG8_MMA(1, 0, At, B0); PG8_MMA(1, 1, At, B1); PG8_BAR; PG8_SCHED;
            PG8_LDB(B0, 1, 0); PG8_LDB(B1, 1, 1); PG8_SCHED; PG8_LDA(At, 1, 0); PG8_STAGE(PG8_SA(0, 1), a2, s1);
            PG8_WAIT_V(8); PG8_WAIT_L(0); PG8_BAR; PG8_MMA(0, 0, At, B0); PG8_MMA(0, 1, At, B1); PG8_BAR; PG8_SCHED;
            PG8_LDA(At, 1, 1); PG8_STAGE(PG8_SB(1, 0), b3, voffB); PG8_STAGE(PG8_SB(1, 1), b3 + hstepB, voffB); PG8_STAGE(PG8_SA(1, 0), a3, s0);
            PG8_WAIT_V(8); PG8_WAIT_L(0); PG8_BAR; PG8_MMA(1, 0, At, B0); PG8_MMA(1, 1, At, B1); PG8_BAR; PG8_SCHED;
        }
        if (wr == 0) PG8_BAR;
        const bool zero = S.epi(acc, cur, wr, wc, fr, fq);
        if (!has_next) break;
        if (zero) {
#pragma unroll
            for (int a = 0; a < 2; ++a)
#pragma unroll
                for (int b = 0; b < 2; ++b)
#pragma unroll
                    for (int m = 0; m < 4; ++m)
#pragma unroll
                        for (int n = 0; n < 2; ++n) acc[a][b][m][n] = (f32x4){0.f, 0.f, 0.f, 0.f};
        }
        cur = nxt; cA = nA; cB = nB; ++ui;
        if constexpr (P::GATHER) {
#pragma unroll
            for (int h = 0; h < 2; ++h)
#pragma unroll
                for (int i = 0; i < 2; ++i) voA[h][i] = voAn[h][i];
        }
        if (wr == 1) PG8_BAR;
    }
    PG8_WAIT_V(0);
    PG8_BAR;
#undef PG8_SA
#undef PG8_SB
#undef PG8_STAGE
#undef PG8_LDA
#undef PG8_LDB
#undef PG8_MMA
#undef PG8_WAIT_V
#undef PG8_WAIT_L
#undef PG8_BAR
#undef PG8_SCHED
#undef PG8_VOA
}
}
using pg8::GUnit; using pg8::Acc;

__device__ __forceinline__ float row_rs(const float* SS, int row) {
    const f32x4* p = (const f32x4*)(SS + (size_t)row * 16);
    const f32x4 a = p[0], b = p[1], c = p[2], d = p[3];
    const float s = (((a.x + a.y) + (a.z + a.w)) + ((b.x + b.y) + (b.z + b.w))) + (((c.x + c.y) + (c.z + c.w)) + ((d.x + d.y) + (d.z + d.w)));
    return rsqrtf(s * (1.0f / 1024.0f) + EPS);
}
#define PIN1(a) asm volatile("" : "+v"(a))
#define PIN2(a, b) asm volatile("" : "+v"(a), "+v"(b))
#define PIN4(a, b, c, d) asm volatile("" : "+v"(a), "+v"(b), "+v"(c), "+v"(d))
#define PIN8(a, b, c, d, e, f, g, h) asm volatile("" : "+v"(a), "+v"(b), "+v"(c), "+v"(d), "+v"(e), "+v"(f), "+v"(g), "+v"(h))
__device__ __forceinline__ void row_rs8(const float* SS, int row0, float (&rs)[8]) {
#pragma unroll
    for (int hh = 0; hh < 4; ++hh) { f32x4 a[2], b[2], c[2], d[2];
#pragma unroll
        for (int g = 0; g < 2; ++g) { const f32x4* p = (const f32x4*)(SS + (size_t)(row0 + (hh >> 1) * 128 + ((hh & 1) * 2 + g) * 16) * 16); a[g] = p[0]; b[g] = p[1]; c[g] = p[2]; d[g] = p[3]; }
#pragma unroll
        for (int g = 0; g < 2; ++g) { const f32x4 t = (a[g] + b[g]) + (c[g] + d[g]); rs[hh * 2 + g] = rsqrtf(((t.x + t.y) + (t.z + t.w)) * (1.0f / 1024.0f) + EPS); }
        PIN2(rs[hh * 2], rs[hh * 2 + 1]); }
}
__device__ __forceinline__ u32x4 pack8(const f32x4 v0, const f32x4 v1) { u32x4 w; w.x = cvt_pk_bf16(v0[0], v0[1]); w.y = cvt_pk_bf16(v0[2], v0[3]); w.z = cvt_pk_bf16(v1[0], v1[1]); w.w = cvt_pk_bf16(v1[2], v1[3]); return w; }
__device__ __forceinline__ void unpack8(const u32x4 w, f32x4& v0, f32x4& v1) { v0 = (f32x4){bf_lo(w.x), bf_hi(w.x), bf_lo(w.y), bf_hi(w.y)}; v1 = (f32x4){bf_lo(w.z), bf_hi(w.z), bf_lo(w.w), bf_hi(w.w)}; }
__device__ __forceinline__ f32x4 sig4(const f32x4 v) { return (f32x4){sigmoidf_(v[0]), sigmoidf_(v[1]), sigmoidf_(v[2]), sigmoidf_(v[3])}; }
__device__ __forceinline__ f32x4 gate4(const f32x4 v) { f32x4 s = sig4(v); return (f32x4){fmaxf(s[0], 1e-6f), fmaxf(s[1], 1e-6f), fmaxf(s[2], 1e-6f), fmaxf(s[3], 1e-6f)}; }

struct PhProj {
    static constexpr int K = 1024; static constexpr bool GATHER = false;
    const char* xb; const char* W; const float* SS; unsigned char* ws; int G, c;
    __device__ __forceinline__ bool next(int i, GUnit& u) const {
        const long L = (long)i * G + c; if (L >= 128 * 23) return false;
        pg8::tile_order((int)L, 128, 23, u.pm, u.pn);
        u.A = xb + (size_t)u.pm * 256 * K * 2; u.B = W + (size_t)u.pn * 256 * K * 2; u.a0 = 0; u.a1 = 0; return true;
    }
    __device__ __forceinline__ unsigned arow(const GUnit&, int) const { return 0u; }
    __device__ __forceinline__ bool epi(Acc& acc, const GUnit& u, int wr, int wc, int fr, int fq) const {
        const int pn = u.pn; const int row0 = u.pm * 256 + wr * 64 + fr;
        float rs8[8]; row_rs8(SS, row0, rs8);
        if (pn == 22) {
            if (wc == 0 && fq == 0) {
                float* IFp = (float*)(ws + WS_IF);
#pragma unroll
                for (int ai = 0; ai < 2; ++ai)
#pragma unroll
                    for (int m = 0; m < 4; ++m) { const int row = row0 + ai * 128 + m * 16; const float rs = rs8[ai * 4 + m];
                        *(f32x4*)(IFp + (size_t)row * 8) = acc[ai][0][m][0] * rs; *(f32x4*)(IFp + (size_t)row * 8 + 4) = acc[ai][0][m][1] * rs; }
            }
            return true;
        }
        if (pn >= 10 && pn < 14) {
            bf16_t* Y = (bf16_t*)(ws + WS_YG);
#pragma unroll
            for (int ai = 0; ai < 2; ++ai)
#pragma unroll
                for (int m = 0; m < 4; ++m) { const int row = row0 + ai * 128 + m * 16; const float rs = rs8[ai * 4 + m];
#pragma unroll
                    for (int bj = 0; bj < 2; ++bj) { const f32x4 a = acc[ai][bj][m][0] * rs, g = sig4(acc[ai][bj][m][1] * rs), y = a * g;
                        u32x2 w; w.x = cvt_pk_bf16(y[0], y[1]); w.y = cvt_pk_bf16(y[2], y[3]);
                        *(u32x2*)(Y + (size_t)row * 512 + (pn - 10) * 128 + bj * 64 + wc * 16 + fq * 4) = w; } }
            return true;
        }
        bf16_t* dst; int col0; bool sg = false;
        if (pn < 6) { dst = (bf16_t*)(ws + (pn < 2 ? WS_QA0 : (pn < 4 ? WS_QA1 : WS_QA2))); col0 = (pn & 1) * 256; }
        else if (pn < 8) { dst = (bf16_t*)(ws + WS_KA); col0 = (pn - 6) * 256; }
        else if (pn < 10) { dst = (bf16_t*)(ws + WS_VA); col0 = (pn - 8) * 256; }
        else if (pn < 16) { dst = (bf16_t*)(ws + WS_QM); col0 = (pn - 14) * 256; }
        else if (pn < 18) { dst = (bf16_t*)(ws + WS_KM); col0 = (pn - 16) * 256; }
        else if (pn < 20) { dst = (bf16_t*)(ws + WS_VM); col0 = (pn - 18) * 256; }
        else { dst = (bf16_t*)(ws + WS_OM); col0 = (pn - 20) * 256; sg = true; }
        col0 += wc * 32 + fq * 8;
#pragma unroll
        for (int ai = 0; ai < 2; ++ai)
#pragma unroll
            for (int m = 0; m < 4; ++m) { const int row = row0 + ai * 128 + m * 16; const float rs = rs8[ai * 4 + m];
#pragma unroll
                for (int bj = 0; bj < 2; ++bj) { f32x4 v0 = acc[ai][bj][m][0] * rs, v1 = acc[ai][bj][m][1] * rs;
                    if (sg) { v0 = sig4(v0); v1 = sig4(v1); }
                    *(u32x4*)(dst + (size_t)row * 512 + col0 + bj * 128) = pack8(v0, v1); } }
        return true;
    }
};
struct PhGates {
    static constexpr int K = 1024; static constexpr bool GATHER = false;
    const char* xb; const char* W; const float* SS; unsigned char* ws; int G, c;
    __device__ __forceinline__ bool next(int i, GUnit& u) const {
        const long L = (long)i * G + c; if (L >= 128 * 12) return false;
        pg8::tile_order((int)L, 128, 12, u.pm, u.pn);
        u.A = xb + (size_t)u.pm * 256 * K * 2; u.B = W + (size_t)(5888 + u.pn * 256) * K * 2; u.a0 = 0; u.a1 = 0; return true;
    }
    __device__ __forceinline__ unsigned arow(const GUnit&, int) const { return 0u; }
    __device__ __forceinline__ bool epi(Acc& acc, const GUnit& u, int wr, int wc, int fr, int fq) const {
        const int row0 = u.pm * 256 + wr * 64 + fr;
        float rs8[8]; row_rs8(SS, row0, rs8);
        bf16_t* dst = (bf16_t*)(ws + WS_G0 + (size_t)(u.pn >> 2) * 64 * MiB); const int col0 = (u.pn & 3) * 256 + wc * 32 + fq * 8;
#pragma unroll
        for (int ai = 0; ai < 2; ++ai)
#pragma unroll
            for (int m = 0; m < 4; ++m) { const int row = row0 + ai * 128 + m * 16; const float rs = rs8[ai * 4 + m];
#pragma unroll
                for (int bj = 0; bj < 2; ++bj) *(u32x4*)(dst + (size_t)row * 1024 + col0 + bj * 128) = pack8(gate4(acc[ai][bj][m][0] * rs), gate4(acc[ai][bj][m][1] * rs)); }
        return true;
    }
};
struct PhMerge {
    static constexpr int K = 512; static constexpr bool GATHER = false;
    unsigned char* ws; int G, c;
    __device__ __forceinline__ bool next(int i, GUnit& u) const {
        const int ti = i / 3, seg = i - ti * 3; const long L = (long)ti * G + c; if (L >= 128 * 4) return false;
        pg8::tile_order((int)L, 128, 4, u.pm, u.pn);
        const size_t ya = seg == 0 ? WS_YATT : (seg == 1 ? WS_YC : WS_OM);
        u.A = (const char*)ws + ya + (size_t)u.pm * 256 * K * 2; u.B = (const char*)ws + WS_WBR + (size_t)seg * 1024 * 512 * 2 + (size_t)u.pn * 256 * K * 2; u.a0 = seg; u.a1 = 0; return true;
    }
    __device__ __forceinline__ unsigned arow(const GUnit&, int) const { return 0u; }
    __device__ __forceinline__ bool epi(Acc& acc, const GUnit& u, int wr, int wc, int fr, int fq) const {
        const int seg = u.a0; const int row0 = u.pm * 256 + wr * 64 + fr; const int col0 = u.pn * 256 + wc * 32 + fq * 8;
        const bf16_t* Gn = (const bf16_t*)(ws + WS_G0 + (size_t)seg * 64 * MiB);
        const bf16_t* Gd = (const bf16_t*)(ws + WS_G0 + (size_t)(seg < 2 ? seg + 1 : seg) * 64 * MiB);
        bf16_t* Mo = (bf16_t*)(ws + WS_MERGED);
#pragma unroll
        for (int ai = 0; ai < 2; ++ai)
#pragma unroll
            for (int mp = 0; mp < 2; ++mp) {
                u32x4 gn[2][2], gd[2][2];
#pragma unroll
                for (int mm = 0; mm < 2; ++mm)
#pragma unroll
                    for (int bj = 0; bj < 2; ++bj) { const size_t off = (size_t)(row0 + ai * 128 + (2 * mp + mm) * 16) * 1024 + col0 + bj * 128; gn[mm][bj] = *(const u32x4*)(Gn + off); gd[mm][bj] = *(const u32x4*)(Gd + off); }
                PIN8(gn[0][0], gn[0][1], gn[1][0], gn[1][1], gd[0][0], gd[0][1], gd[1][0], gd[1][1]);
#pragma unroll
                for (int mm = 0; mm < 2; ++mm)
#pragma unroll
                    for (int bj = 0; bj < 2; ++bj) { const int m = 2 * mp + mm; const size_t off = (size_t)(row0 + ai * 128 + m * 16) * 1024 + col0 + bj * 128;
                        f32x4 n0, n1, d0, d1; unpack8(gn[mm][bj], n0, n1); unpack8(gd[mm][bj], d0, d1);
                        if (seg < 2) {
#pragma unroll
                            for (int j = 0; j < 4; ++j) { acc[ai][bj][m][0][j] *= n0[j] * __builtin_amdgcn_rcpf(d0[j]); acc[ai][bj][m][1][j] *= n1[j] * __builtin_amdgcn_rcpf(d1[j]); } }
                        else *(u32x4*)(Mo + off) = pack8(acc[ai][bj][m][0] * n0, acc[ai][bj][m][1] * n1); }
            }
        return seg == 2;
    }
};
__device__ __forceinline__ float store_x8(bf16_t* xbp, const f32x4 v0, const f32x4 v1) {
    *(u32x4*)xbp = pack8(v0, v1);
    return ((v0[0] * v0[0] + v0[1] * v0[1]) + (v0[2] * v0[2] + v0[3] * v0[3])) + ((v1[0] * v1[0] + v1[1] * v1[1]) + (v1[2] * v1[2] + v1[3] * v1[3]));
}
struct PhOut {
    static constexpr int K = 1024; static constexpr bool GATHER = false;
    unsigned char* ws; float* SSo; int G, c;
    __device__ __forceinline__ bool next(int i, GUnit& u) const {
        const long L = (long)i * G + c; if (L >= 128 * 4) return false;
        pg8::tile_order((int)L, 128, 4, u.pm, u.pn);
        u.A = (const char*)ws + WS_MERGED + (size_t)u.pm * 256 * K * 2; u.B = (const char*)ws + WS_WOUT + (size_t)u.pn * 256 * K * 2; u.a0 = 0; u.a1 = 0; return true;
    }
    __device__ __forceinline__ unsigned arow(const GUnit&, int) const { return 0u; }
    __device__ __forceinline__ bool epi(Acc& acc, const GUnit& u, int wr, int wc, int fr, int fq) const {
        const int row0 = u.pm * 256 + wr * 64 + fr; const int col0 = u.pn * 256 + wc * 32 + fq * 8; bf16_t* XB = (bf16_t*)(ws + WS_XB);
#pragma unroll
        for (int ai = 0; ai < 2; ++ai) {
            u32x4 xr[4][2];
#pragma unroll
            for (int m = 0; m < 4; ++m)
#pragma unroll
                for (int bj = 0; bj < 2; ++bj) xr[m][bj] = *(const u32x4*)(XB + (size_t)(row0 + ai * 128 + m * 16) * 1024 + col0 + bj * 128);
            PIN8(xr[0][0], xr[0][1], xr[1][0], xr[1][1], xr[2][0], xr[2][1], xr[3][0], xr[3][1]);
#pragma unroll
            for (int m = 0; m < 4; ++m) { const int row = row0 + ai * 128 + m * 16; const size_t off = (size_t)row * 1024 + col0; float ss = 0.f;
#pragma unroll
                for (int bj = 0; bj < 2; ++bj) { f32x4 x0, x1; unpack8(xr[m][bj], x0, x1); ss += store_x8(XB + off + bj * 128, x0 + acc[ai][bj][m][0], x1 + acc[ai][bj][m][1]); }
                ss += __shfl_xor(ss, 16); ss += __shfl_xor(ss, 32);
                if (fq == 0) SSo[(size_t)row * 16 + u.pn * 4 + wc] = ss; } }
        return true;
    }
};
struct PhRouter {
    static constexpr int K = 1024; static constexpr bool GATHER = false;
    unsigned char* ws; const float* SS; int G, c;
    __device__ __forceinline__ bool next(int i, GUnit& u) const {
        const long L = (long)i * G + c; if (L >= 128) return false;
        u.pm = (int)L; u.pn = 0; u.A = (const char*)ws + WS_XB + (size_t)u.pm * 256 * K * 2; u.B = (const char*)ws + WS_WR; u.a0 = 0; u.a1 = 0; return true;
    }
    __device__ __forceinline__ unsigned arow(const GUnit&, int) const { return 0u; }
    __device__ __forceinline__ bool epi(Acc& acc, const GUnit& u, int wr, int wc, int fr, int fq) const {
        if (wc < 2) { float* Lg = (float*)(ws + WS_LOGITS); const int row0 = u.pm * 256 + wr * 64 + fr;
            float rs8[8]; row_rs8(SS, row0, rs8);
#pragma unroll
            for (int ai = 0; ai < 2; ++ai)
#pragma unroll
                for (int m = 0; m < 4; ++m) { const int row = row0 + ai * 128 + m * 16; const float rs = rs8[ai * 4 + m]; float* p = Lg + (size_t)row * 64 + wc * 32 + fq * 8;
                    *(f32x4*)p = acc[ai][0][m][0] * rs; *(f32x4*)(p + 4) = acc[ai][0][m][1] * rs; } }
        return true;
    }
};
__device__ __forceinline__ int moe_expert_of(const int* META, int k, int rb) {
    const int r = rb * 256; int e = 0;
    for (int j = 1; j < 32; ++j) e += (META[16 + 64 * k + j] <= r) ? 1 : 0;
    return __builtin_amdgcn_readfirstlane(e);
}
struct PhUp {
    static constexpr int K = 1024; static constexpr bool GATHER = true;
    unsigned char* ws; const float* SS; const int* META; const int* tok; int G, c;
    __device__ __forceinline__ bool next(int i, GUnit& u) const {
        const int nb0 = __builtin_amdgcn_readfirstlane(META[0]), nb1 = __builtin_amdgcn_readfirstlane(META[1]); const long L = (long)i * G + c; if (L >= 2L * (nb0 + nb1)) return false;
        int blk = (int)(L >> 1); u.pn = (int)(L & 1); int k = 0; if (blk >= nb0) { k = 1; blk -= nb0; }
        const int e = moe_expert_of(META, k, blk);
        u.pm = blk; u.a0 = k; u.a1 = e; u.A = (const char*)ws + WS_XB; u.B = (const char*)ws + WS_WEXP + (size_t)e * 512 * 1024 * 2 + (size_t)u.pn * 256 * K * 2; return true;
    }
    __device__ __forceinline__ unsigned arow(const GUnit& u, int r) const { const int t = tok[u.a0 * LISTCAP + u.pm * 256 + r]; return t < 0 ? 0u : (unsigned)t; }
    __device__ __forceinline__ bool epi(Acc& acc, const GUnit& u, int wr, int wc, int fr, int fq) const {
        const int lr0 = u.a0 * LISTCAP + u.pm * 256 + wr * 64 + fr; bf16_t* HB = (bf16_t*)(ws + WS_HB);
        int tk[8]; float rs8[8];
#pragma unroll
        for (int g = 0; g < 8; ++g) tk[g] = tok[lr0 + (g >> 2) * 128 + (g & 3) * 16];
        PIN8(tk[0], tk[1], tk[2], tk[3], tk[4], tk[5], tk[6], tk[7]);
#pragma unroll
        for (int hh = 0; hh < 4; ++hh) { f32x4 a[2], b[2], c[2], d[2];
#pragma unroll
            for (int g = 0; g < 2; ++g) { const int t = tk[hh * 2 + g]; const f32x4* p = (const f32x4*)(SS + (size_t)(t < 0 ? 0 : t) * 16); a[g] = p[0]; b[g] = p[1]; c[g] = p[2]; d[g] = p[3]; }
#pragma unroll
            for (int g = 0; g < 2; ++g) { const f32x4 tt = (a[g] + b[g]) + (c[g] + d[g]); rs8[hh * 2 + g] = tk[hh * 2 + g] < 0 ? 0.f : rsqrtf(((tt.x + tt.y) + (tt.z + tt.w)) * (1.0f / 1024.0f) + EPS); }
            PIN2(rs8[hh * 2], rs8[hh * 2 + 1]); }
#pragma unroll
        for (int ai = 0; ai < 2; ++ai)
#pragma unroll
            for (int m = 0; m < 4; ++m) { const int lr = lr0 + ai * 128 + m * 16; const float rs = rs8[ai * 4 + m];
#pragma unroll
                for (int bj = 0; bj < 2; ++bj) { const f32x4 g = acc[ai][bj][m][0] * rs, uu = acc[ai][bj][m][1] * rs;
                    f32x4 h = (f32x4){siluf_(g[0]) * uu[0], siluf_(g[1]) * uu[1], siluf_(g[2]) * uu[2], siluf_(g[3]) * uu[3]}; if (ABL == 8) h = (f32x4){1.f, 1.f, 1.f, 1.f};
                    u32x2 w; w.x = cvt_pk_bf16(h[0], h[1]); w.y = cvt_pk_bf16(h[2], h[3]);
                    *(u32x2*)(HB + (size_t)lr * 256 + u.pn * 128 + bj * 64 + wc * 16 + fq * 4) = w; }
                asm volatile("" ::: "memory"); }
        return true;
    }
};
template <int KL> struct PhDown {
    static constexpr int K = 256; static constexpr bool GATHER = false;
    unsigned char* ws; float* SSo; const int* META; const int* tok; const float* wl; int G, c;
    __device__ __forceinline__ bool next(int i, GUnit& u) const {
        const int nb = __builtin_amdgcn_readfirstlane(META[KL]); const long L = (long)i * G + c;
        if (L < 4L * nb) { const int blk = (int)(L >> 2); u.pn = (int)(L & 3); const int e = moe_expert_of(META, KL, blk); u.pm = blk; u.a0 = 0; u.a1 = e;
            u.A = (const char*)ws + WS_HB + (size_t)(KL * LISTCAP + blk * 256) * 256 * 2; u.B = (const char*)ws + WS_WEXP + 32ull * 512 * 1024 * 2 + (size_t)e * 1024 * 256 * 2 + (size_t)u.pn * 256 * K * 2; return true; }
        if (KL == 1) { const long L2 = L - 4L * nb; if (L2 >= 128 * 4) return false;
            pg8::tile_order((int)L2, 128, 4, u.pm, u.pn); u.a0 = 1; u.a1 = 0;
            u.A = (const char*)ws + WS_PBF + (size_t)u.pm * 256 * K * 2; u.B = (const char*)ws + WS_WPP + (size_t)u.pn * 256 * K * 2; return true; }
        return false;
    }
    __device__ __forceinline__ unsigned arow(const GUnit&, int) const { return 0u; }
    __device__ __forceinline__ bool epi(Acc& acc, const GUnit& u, int wr, int wc, int fr, int fq) const {
        const int col0 = u.pn * 256 + wc * 32 + fq * 8;
        if (KL == 1 && u.a0 == 1) {
            bf16_t* PE = (bf16_t*)(ws + WS_PE); const int row0 = u.pm * 256 + wr * 64 + fr;
#pragma unroll
            for (int ai = 0; ai < 2; ++ai)
#pragma unroll
                for (int m = 0; m < 4; ++m)
#pragma unroll
                    for (int bj = 0; bj < 2; ++bj) *(u32x4*)(PE + (size_t)(row0 + ai * 128 + m * 16) * 1024 + col0 + bj * 128) = pack8(acc[ai][bj][m][0], acc[ai][bj][m][1]);
            return true;
        }
        const int lr0 = KL * LISTCAP + u.pm * 256 + wr * 64 + fr; bf16_t* YB = (bf16_t*)(ws + WS_YB1); bf16_t* XB = (bf16_t*)(ws + WS_XB);
        int tk[8]; float wk[8];
#pragma unroll
        for (int g = 0; g < 8; ++g) { const int lr = lr0 + (g >> 2) * 128 + (g & 3) * 16; tk[g] = tok[lr]; wk[g] = wl[lr]; }
        PIN8(tk[0], tk[1], tk[2], tk[3], tk[4], tk[5], tk[6], tk[7]); PIN8(wk[0], wk[1], wk[2], wk[3], wk[4], wk[5], wk[6], wk[7]);
#pragma unroll
        for (int ai = 0; ai < 2; ++ai)
#pragma unroll
            for (int m = 0; m < 4; ++m) { const int t = tk[ai * 4 + m]; const float w = wk[ai * 4 + m]; const size_t off = (size_t)(t < 0 ? 0 : t) * 1024 + col0;
                if (KL == 1) { if (t >= 0) {
#pragma unroll
                        for (int bj = 0; bj < 2; ++bj) *(u32x4*)(YB + off + bj * 128) = pack8(acc[ai][bj][m][0] * w, acc[ai][bj][m][1] * w); } }
                else { float ss = 0.f;
                    if (t >= 0) {
                        u32x4 xr[2], yr[2];
#pragma unroll
                        for (int bj = 0; bj < 2; ++bj) { xr[bj] = *(const u32x4*)(XB + off + bj * 128); yr[bj] = *(const u32x4*)(YB + off + bj * 128); }
                        PIN4(xr[0], xr[1], yr[0], yr[1]);
#pragma unroll
                        for (int bj = 0; bj < 2; ++bj) { f32x4 x0, x1, y0, y1; unpack8(xr[bj], x0, x1); unpack8(yr[bj], y0, y1);
                            ss += store_x8(XB + off + bj * 128, (x0 + y0) + acc[ai][bj][m][0] * w, (x1 + y1) + acc[ai][bj][m][1] * w); } }
                    ss += __shfl_xor(ss, 16); ss += __shfl_xor(ss, 32);
                    if (fq == 0 && t >= 0) SSo[(size_t)t * 16 + u.pn * 4 + wc] = ss; }
                if (m & 1) asm volatile("" ::: "memory"); }
        return true;
    }
};
struct PhPle {
    static constexpr int K = 1024; static constexpr bool GATHER = false;
    unsigned char* ws; const float* SSi; float* SSo; int G, c;
    __device__ __forceinline__ bool next(int i, GUnit& u) const {
        const long L = (long)i * G + c; if (L >= 128 * 4) return false;
        pg8::tile_order((int)L, 128, 4, u.pm, u.pn);
        u.A = (const char*)ws + WS_XB + (size_t)u.pm * 256 * K * 2; u.B = (const char*)ws + WS_WPG + (size_t)u.pn * 256 * K * 2; u.a0 = 0; u.a1 = 0; return true;
    }
    __device__ __forceinline__ unsigned arow(const GUnit&, int) const { return 0u; }
    __device__ __forceinline__ bool epi(Acc& acc, const GUnit& u, int wr, int wc, int fr, int fq) const {
        const int row0 = u.pm * 256 + wr * 64 + fr; const int col0 = u.pn * 256 + wc * 32 + fq * 8; bf16_t* XT = (bf16_t*)(ws + WS_XBT); const bf16_t* PE = (const bf16_t*)(ws + WS_PE); const bf16_t* XBc = (const bf16_t*)(ws + WS_XB);
        float rs8[8]; row_rs8(SSi, row0, rs8);
#pragma unroll
        for (int ai = 0; ai < 2; ++ai)
#pragma unroll
            for (int m = 0; m < 4; ++m) { const int row = row0 + ai * 128 + m * 16; const size_t off = (size_t)row * 1024 + col0; const float rs = rs8[ai * 4 + m]; float ss = 0.f;
                u32x4 xr[2], pr[2];
#pragma unroll
                for (int bj = 0; bj < 2; ++bj) { xr[bj] = *(const u32x4*)(XBc + off + bj * 128); pr[bj] = *(const u32x4*)(PE + off + bj * 128); }
                PIN4(xr[0], xr[1], pr[0], pr[1]);
#pragma unroll
                for (int bj = 0; bj < 2; ++bj) { f32x4 p0, p1, x0, x1; unpack8(pr[bj], p0, p1); unpack8(xr[bj], x0, x1);
                    ss += store_x8(XT + off + bj * 128, x0 + sig4(acc[ai][bj][m][0] * rs) * p0, x1 + sig4(acc[ai][bj][m][1] * rs) * p1); }
                ss += __shfl_xor(ss, 16); ss += __shfl_xor(ss, 32);
                if (fq == 0) SSo[(size_t)row * 16 + u.pn * 4 + wc] = ss; }
        return true;
    }
};

struct InPtrs { const float* const* p; __device__ __forceinline__ const float* operator[](int i) const { return (const float*)(GAS const float*)p[i]; } };
struct Ctx {
    InPtrs in; float* out; unsigned char* ws; LAS unsigned char* lds;
    int tid, lane, wave, G, bid;
};
enum { I_X = 0, I_P, I_GMIX, I_WIN, I_CONVW, I_CONVB, I_CLNG, I_CLNB, I_MCW, I_MCB, I_MIB, I_MFB, I_WBA, I_WBC, I_WBM, I_WOUT, I_GFFN, I_WRG, I_BRG, I_WRE, I_BRE,
       I_WEG, I_WEU, I_WED, I_GPLE, I_WPG, I_WPP, I_GFIN };

constexpr int TR_LDS = 64 * 65 * 4;
template <bool GAIN>
__device__ __forceinline__ void tr_item64(const float* colptr4, size_t pitch, const float* gainp, float cscale, bf16_t* dst, int K, int n0, int k0, LAS float* scr, int lane, const float* gain_or_valid) {
    const float* gain = GAIN ? gainp : nullptr;
    const int g = lane & 15, r = lane >> 4;
    f32x4 v[16]; float gs[16];
    const float* cp = colptr4 ? colptr4 : gain_or_valid;
#pragma unroll
    for (int i = 0; i < 16; ++i) { const int kk = 4 * i + r; v[i] = *(const f32x4*)(cp + (colptr4 ? (size_t)(k0 + kk) * pitch : 0)); gs[i] = gain ? gain[k0 + kk] : 1.0f; }
    PIN8(v[0], v[1], v[2], v[3], v[4], v[5], v[6], v[7]); PIN8(v[8], v[9], v[10], v[11], v[12], v[13], v[14], v[15]);
    const float zs = colptr4 ? cscale : 0.f;
#pragma unroll
    for (int i = 0; i < 16; ++i) { const int kk = 4 * i + r; const float m = gs[i] * zs; LAS float* p = scr + kk * 65 + 4 * g; p[0] = v[i].x * m; p[1] = v[i].y * m; p[2] = v[i].z * m; p[3] = v[i].w * m; }
    LDS_WAIT(); asm volatile("" ::: "memory");
    const int c = lane & 7, n8 = lane >> 3;
#pragma unroll
    for (int j = 0; j < 8; ++j) { const int n = n8 + 8 * j; const LAS float* sp = scr + (8 * c) * 65 + n;
        u32x4 o; o.x = pk2(sp[0 * 65], sp[1 * 65]); o.y = pk2(sp[2 * 65], sp[3 * 65]); o.z = pk2(sp[4 * 65], sp[5 * 65]); o.w = pk2(sp[6 * 65], sp[7 * 65]);
        *(u32x4*)(dst + (size_t)(n0 + n) * K + k0 + 8 * c) = o; }
    LDS_WAIT(); asm volatile("" ::: "memory");
}
__device__ __forceinline__ void phase_prep(const Ctx& F, int layer, float* SS) {
    const int gw = F.bid * NWAVES + F.wave, NGW = F.G * NWAVES, lane = F.lane;
    LAS float* scr = (LAS float*)(F.lds + F.wave * TR_LDS);
    bf16_t* XB = (bf16_t*)(F.ws + WS_XB);
    if (layer == 0) {
        for (int m0 = gw; m0 < T; m0 += 4 * NGW) {
            f32x4 v[4][4];
#pragma unroll
            for (int r = 0; r < 4; ++r) { const f32x4* xr = (const f32x4*)(F.in[I_X] + (size_t)(m0 + r * NGW) * D) + lane;
#pragma unroll
                for (int j = 0; j < 4; ++j) v[r][j] = xr[64 * j]; }
            PIN8(v[0][0], v[0][1], v[0][2], v[0][3], v[1][0], v[1][1], v[1][2], v[1][3]); PIN8(v[2][0], v[2][1], v[2][2], v[2][3], v[3][0], v[3][1], v[3][2], v[3][3]);
#pragma unroll
            for (int r = 0; r < 4; ++r) { const int m = m0 + r * NGW; u32x2* xbr = (u32x2*)(XB + (size_t)m * D) + lane; float sq = 0.f;
#pragma unroll
                for (int j = 0; j < 4; ++j) { const f32x4 x = v[r][j]; sq += (x.x * x.x + x.y * x.y) + (x.z * x.z + x.w * x.w); u32x2 w; w.x = cvt_pk_bf16(x.x, x.y); w.y = cvt_pk_bf16(x.z, x.w); xbr[64 * j] = w; }
                sq = wave_sum(sq);
                if (lane < 16) SS[(size_t)m * 16 + lane] = lane == 0 ? sq : 0.f; }
        }
    } else {
        const u32x4* src = (const u32x4*)(F.ws + WS_XBT); u32x4* dst = (u32x4*)(F.ws + WS_XB);
        const size_t n = (size_t)T * D * 2 / 16, st = (size_t)F.G * NTHREADS;
        for (size_t i0 = (size_t)F.bid * NTHREADS + F.tid; i0 < n; i0 += 8 * st) { u32x4 v[8];
#pragma unroll
            for (int k = 0; k < 8; ++k) { const size_t i = i0 + k * st; v[k] = src[i < n ? i : 0]; }
            PIN8(v[0], v[1], v[2], v[3], v[4], v[5], v[6], v[7]);
#pragma unroll
            for (int k = 0; k < 8; ++k) { const size_t i = i0 + k * st; if (i < n) dst[i] = v[k]; } }
    }
    const float* w_in = F.in[I_WIN] + (size_t)layer * D * D_IN; const float* g_mix = F.in[I_GMIX] + (size_t)layer * D;
    constexpr int N_WIN = 140 * 16, N_BR = 16 * 8, N_SQ = 16 * 16, N_PP = 16 * 4, N_R = 4 * 16;
    constexpr int NITEMS = N_WIN + 3 * N_BR + 2 * N_SQ + N_PP + N_R;
    const int g4 = 4 * (lane & 15);
    for (int it = gw; it < NITEMS; it += NGW) {
        int r = it;
        if (r < N_WIN) { const int nb = r >> 4, kb = r & 15; const int n = nb * 64 + g4; int src = -1; float cs = 1.f;
            if (n < 2560) { src = n; if (n < 1536) cs = 0.125f * 1.4426950408889634f; }
            else if (n < 3584) { const int np = n - 2560, q8 = np >> 3, sg = (np >> 2) & 1; src = 2560 + sg * 512 + 4 * q8; }
            else if (n < 5640) src = n;
            else if (n < 5888) src = -1;
            else src = 5640 + (n - 5888);
            tr_item64<true>(src >= 0 ? w_in + src : nullptr, D_IN, g_mix, cs, (bf16_t*)(F.ws + WS_WIN), 1024, nb * 64, kb * 64, scr, lane, g_mix); continue; }
        r -= N_WIN;
        if (r < 3 * N_BR) { const int b = r / N_BR; r -= b * N_BR; const int nb = r >> 3, kb = r & 7; const int n = nb * 64 + g4;
            const float* w = (b == 0 ? F.in[I_WBA] : (b == 1 ? F.in[I_WBC] : F.in[I_WBM])) + (size_t)layer * 512 * 1024;
            tr_item64<false>(w + n, 1024, nullptr, 1.f, (bf16_t*)(F.ws + WS_WBR) + (size_t)b * 1024 * 512, 512, nb * 64, kb * 64, scr, lane, g_mix); continue; }
        r -= 3 * N_BR;
        if (r < 2 * N_SQ) { const int b = r / N_SQ; r -= b * N_SQ; const int nb = r >> 4, kb = r & 15; const int n = nb * 64 + g4;
            const float* w = (b == 0 ? F.in[I_WOUT] : F.in[I_WPG]) + (size_t)layer * 1024 * 1024;
            if (b == 0) tr_item64<false>(w + n, 1024, nullptr, 1.f, (bf16_t*)(F.ws + WS_WOUT), 1024, nb * 64, kb * 64, scr, lane, g_mix);
            else tr_item64<true>(w + n, 1024, F.in[I_GPLE] + (size_t)layer * D, 1.f, (bf16_t*)(F.ws + WS_WPG), 1024, nb * 64, kb * 64, scr, lane, g_mix);
            continue; }
        r -= 2 * N_SQ;
        if (r < N_PP) { const int nb = r >> 2, kb = r & 3; const int n = nb * 64 + g4;
            tr_item64<false>(F.in[I_WPP] + (size_t)layer * 256 * 1024 + n, 1024, nullptr, 1.f, (bf16_t*)(F.ws + WS_WPP), 256, nb * 64, kb * 64, scr, lane, g_mix); continue; }
        r -= N_PP;
        { const int nb = r >> 4, kb = r & 15; const int n = nb * 64 + g4; const float* cp = nullptr; size_t pitch = 4;
            if (n < 4) { cp = F.in[I_WRG] + (size_t)layer * 1024 * 4 + n; pitch = 4; } else if (n < 36) { cp = F.in[I_WRE] + (size_t)layer * 1024 * 32 + (n - 4); pitch = 32; }
            tr_item64<true>(cp, pitch, F.in[I_GFFN] + (size_t)layer * D, 1.f, (bf16_t*)(F.ws + WS_WR), 1024, nb * 64, kb * 64, scr, lane, g_mix); }
    }
}
__device__ __forceinline__ void phase_prep_experts(const Ctx& F, int layer) {
    const int gw = F.bid * NWAVES + F.wave, NGW = F.G * NWAVES, lane = F.lane;
    LAS float* scr = (LAS float*)(F.lds + F.wave * TR_LDS);
    const float* g_ffn = F.in[I_GFFN] + (size_t)layer * D;
    constexpr int N_UP = 32 * 8 * 16, N_DN = 32 * 16 * 4;
    const int g4 = 4 * (lane & 15);
    for (int it = gw; it < N_UP + N_DN; it += NGW) {
        int r = it;
        if (r < N_UP) { const int e = r >> 7; r &= 127; const int nb = r >> 4, kb = r & 15; const int n = nb * 64 + g4; const int q8 = n >> 3, sg = (n >> 2) & 1;
            const float* w = (sg ? F.in[I_WEU] : F.in[I_WEG]) + ((size_t)layer * 32 + e) * 1024 * 256 + 4 * q8;
            tr_item64<true>(w, 256, g_ffn, 1.f, (bf16_t*)(F.ws + WS_WEXP) + (size_t)e * 512 * 1024, 1024, nb * 64, kb * 64, scr, lane, g_ffn); continue; }
        r -= N_UP;
        { const int e = r >> 6; r &= 63; const int nb = r >> 2, kb = r & 3; const int n = nb * 64 + g4;
            const float* w = F.in[I_WED] + ((size_t)layer * 32 + e) * 256 * 1024 + n;
            tr_item64<false>(w, 1024, nullptr, 1.f, (bf16_t*)(F.ws + WS_WEXP) + 32ull * 512 * 1024 + (size_t)e * 1024 * 256, 256, nb * 64, kb * 64, scr, lane, g_ffn); }
    }
    const f32x4* p = (const f32x4*)(F.in[I_P] + (size_t)layer * T * 256); u32x2* pb = (u32x2*)(F.ws + WS_PBF);
    { const size_t n = (size_t)T * 256 / 4, st = (size_t)F.G * NTHREADS;
        for (size_t i0 = (size_t)F.bid * NTHREADS + F.tid; i0 < n; i0 += 8 * st) { f32x4 v[8];
#pragma unroll
            for (int k = 0; k < 8; ++k) { const size_t i = i0 + k * st; v[k] = p[i < n ? i : 0]; }
            PIN8(v[0], v[1], v[2], v[3], v[4], v[5], v[6], v[7]);
#pragma unroll
            for (int k = 0; k < 8; ++k) { const size_t i = i0 + k * st; if (i < n) { u32x2 w; w.x = cvt_pk_bf16(v[k].x, v[k].y); w.y = cvt_pk_bf16(v[k].z, v[k].w); pb[i] = w; } } } }
}

constexpr int AK_RS = 144, AV_RS = 160, AV_OFF = 2 * 128 * AK_RS;
typedef short s16x4 __attribute__((ext_vector_type(4)));
__device__ __forceinline__ s16x4 lds_tr16(LAS unsigned char* p) { return __builtin_amdgcn_ds_read_tr16_b64_v4i16((LAS s16x4*)p); }
__device__ __forceinline__ void attn_strip(const Ctx& F, int strip) {
    const int bs = strip / 48, sg = strip - bs * 48, b = bs >> 3, slot = bs & 7;
    int g, r, nb0;
    if (sg < 16) { g = 0; r = 0; nb0 = sg * 8; } else if (sg < 32) { g = 1; r = (sg - 16) >> 2; nb0 = ((sg - 16) & 3) * 8; } else { g = 2; r = sg - 32; nb0 = 0; }
    const int dl = 1 << (2 * g); const float slope = exp2f(-(float)(g * 8 + slot + 1) * (1.0f / 3.0f)) * (float)dl * 1.4426950408889634f;
    bf16_t* Qg = (bf16_t*)(F.ws + (g == 0 ? WS_QA0 : (g == 1 ? WS_QA1 : WS_QA2))) + slot * 64;
    const bf16_t* Kg = (const bf16_t*)(F.ws + WS_KA) + slot * 64; const bf16_t* Vg = (const bf16_t*)(F.ws + WS_VA) + slot * 64;
    float* LSE = (float*)(F.ws + WS_LOGITS) + (size_t)g * T * 8 + slot;
    const size_t tok0 = (size_t)b * SEQ + r;
    LAS unsigned char* Kl = F.lds; LAS unsigned char* Vl = F.lds + AV_OFF;
    const int tid = F.tid, lane = F.lane, w = F.wave, fr = lane & 15, fq = lane >> 4;
    const int srow = tid >> 2, sc4 = tid & 3;
    u32x4 kx[2], vx[2];
#define ATT_LOAD(blk) do { const size_t _t = (tok0 + (size_t)((blk) * 128 + srow) * dl) * 512; \
        kx[0] = *(const u32x4*)(Kg + _t + sc4 * 8); kx[1] = *(const u32x4*)(Kg + _t + 32 + sc4 * 8); vx[0] = *(const u32x4*)(Vg + _t + sc4 * 8); vx[1] = *(const u32x4*)(Vg + _t + 32 + sc4 * 8); } while (0)
#define ATT_STORE(blk) do { const int _p = (((blk) & 1) * 128 + srow); \
        *(LAS u32x4*)(Kl + _p * AK_RS + sc4 * 16) = kx[0]; *(LAS u32x4*)(Kl + _p * AK_RS + 64 + sc4 * 16) = kx[1]; *(LAS u32x4*)(Vl + _p * AV_RS + sc4 * 16) = vx[0]; *(LAS u32x4*)(Vl + _p * AV_RS + 64 + sc4 * 16) = vx[1]; } while (0)
    __syncthreads();
    if (nb0 > 0) { ATT_LOAD(nb0 - 1); ATT_STORE(nb0 - 1); }
    else { kx[0] = kx[1] = vx[0] = vx[1] = (u32x4){0u, 0u, 0u, 0u}; ATT_STORE(1); }
    ATT_LOAD(nb0); ATT_STORE(nb0);
    bf16x8 qn0, qn1;
    { const size_t qo = (tok0 + (size_t)(nb0 * 128 + 16 * w + fr) * dl) * 512; qn0 = *(const bf16x8*)(Qg + qo + fq * 8); qn1 = *(const bf16x8*)(Qg + qo + 32 + fq * 8); }
    __syncthreads();
    for (int nb = nb0; nb < nb0 + 8; ++nb) {
        const bool more = nb + 1 < nb0 + 8;
        if (more) ATT_LOAD(nb + 1);
        const size_t qoff = (tok0 + (size_t)(nb * 128 + 16 * w + fr) * dl) * 512;
        const bf16x8 q0 = qn0, q1 = qn1;
        if (more) { const size_t qo2 = qoff + (size_t)128 * dl * 512; qn0 = *(const bf16x8*)(Qg + qo2 + fq * 8); qn1 = *(const bf16x8*)(Qg + qo2 + 32 + fq * 8); }
        const int pslot = (nb - 1) & 1;
        f32x4 S[10];
#pragma unroll
        for (int kbi = 0; kbi < 10; ++kbi) {
            int kb = w + kbi; if (kb > 15) kb = 15;
            const int ki = kb * 16 + fr; const int phys = ((pslot + (ki >> 7)) & 1) * 128 + (ki & 127);
            const bf16x8 k0 = *(const LAS bf16x8*)(Kl + phys * AK_RS + fq * 16), k1 = *(const LAS bf16x8*)(Kl + phys * AK_RS + 64 + fq * 16);
            f32x4 a = (f32x4){0.f, 0.f, 0.f, 0.f};
            a = __builtin_amdgcn_mfma_f32_16x16x32_bf16(k0, q0, a, 0, 0, 0);
            S[kbi] = __builtin_amdgcn_mfma_f32_16x16x32_bf16(k1, q1, a, 0, 0, 0);
        }
        float mx = -INFINITY;
        const int dbase = fr - 4 * fq + 128; const float fb = slope * (float)dbase; const int kmin = (nb > 0) ? 0 : 128 - (16 * w + 4 * fq);
#pragma unroll
        for (int kbi = 0; kbi < 10; ++kbi)
#pragma unroll
            for (int j = 0; j < 4; ++j) { const int cj = 16 * kbi + j;
                bool ok = (unsigned)(dbase - cj) <= 128u && cj >= kmin; if (kbi == 9) ok = ok && (w < 7);
                const float sc = ok ? __builtin_fmaf(slope, (float)cj, S[kbi][j] - fb) : -INFINITY; S[kbi][j] = sc; mx = fmaxf(mx, sc); }
        mx = fmaxf(mx, __shfl_xor(mx, 16)); mx = fmaxf(mx, __shfl_xor(mx, 32));
        float ls = 0.f;
#pragma unroll
        for (int kbi = 0; kbi < 10; ++kbi)
#pragma unroll
            for (int j = 0; j < 4; ++j) { const float p = __builtin_amdgcn_exp2f(S[kbi][j] - mx); S[kbi][j] = p; ls += p; }
        ls += __shfl_xor(ls, 16); ls += __shfl_xor(ls, 32);
        f32x4 O[4];
#pragma unroll
        for (int db = 0; db < 4; ++db) O[db] = (f32x4){0.f, 0.f, 0.f, 0.f};
#pragma unroll
        for (int k2 = 0; k2 < 5; ++k2) {
            u32x4 pw; pw.x = cvt_pk_bf16(S[2 * k2][0], S[2 * k2][1]); pw.y = cvt_pk_bf16(S[2 * k2][2], S[2 * k2][3]); pw.z = cvt_pk_bf16(S[2 * k2 + 1][0], S[2 * k2 + 1][1]); pw.w = cvt_pk_bf16(S[2 * k2 + 1][2], S[2 * k2 + 1][3]);
            const bf16x8 pf = __builtin_bit_cast(bf16x8, pw);
            int kb0 = w + 2 * k2, kb1 = kb0 + 1; if (kb1 > 15) kb1 = 15; if (kb0 > 15) kb0 = 15;
            const int r0 = kb0 * 16 + 4 * fq + (fr >> 2), r1 = kb1 * 16 + 4 * fq + (fr >> 2);
            const int p0 = ((pslot + (r0 >> 7)) & 1) * 128 + (r0 & 127), p1 = ((pslot + (r1 >> 7)) & 1) * 128 + (r1 & 127);
#pragma unroll
            for (int db = 0; db < 4; ++db) {
                const s16x4 v0 = lds_tr16(Vl + p0 * AV_RS + (db * 16 + 4 * (fr & 3)) * 2), v1 = lds_tr16(Vl + p1 * AV_RS + (db * 16 + 4 * (fr & 3)) * 2);
                const bf16x8 vf = (bf16x8){v0[0], v0[1], v0[2], v0[3], v1[0], v1[1], v1[2], v1[3]};
                O[db] = __builtin_amdgcn_mfma_f32_16x16x32_bf16(vf, pf, O[db], 0, 0, 0);
            }
        }
        const float inv = 1.0f / ls;
#pragma unroll
        for (int db = 0; db < 4; ++db) { u32x2 ow; ow.x = cvt_pk_bf16(O[db][0] * inv, O[db][1] * inv); ow.y = cvt_pk_bf16(O[db][2] * inv, O[db][3] * inv);
            *(u32x2*)(Qg + qoff + db * 16 + 4 * fq) = ow; }
        if (fq == 0) LSE[(qoff >> 9) * 8] = mx + __builtin_amdgcn_logf(ls);
        __syncthreads();
        if (more) ATT_STORE(nb + 1);
        __syncthreads();
    }
#undef ATT_LOAD
#undef ATT_STORE
}
__device__ __forceinline__ void attn_combine(const Ctx& F) {
    const float* LSE = (const float*)(F.ws + WS_LOGITS);
    for (int i0 = F.bid * NTHREADS + F.tid; i0 < T * 64; i0 += 4 * F.G * NTHREADS) {
        u32x4 a[4], bb[4], cc[4]; float l0[4], l1[4], l2[4];
#pragma unroll
        for (int k = 0; k < 4; ++k) { const int i = i0 + k * F.G * NTHREADS; const int ic = i < T * 64 ? i : 0; const int t = ic >> 6, slot = (ic & 63) >> 3;
            a[k] = ((const u32x4*)(F.ws + WS_QA0))[ic]; bb[k] = ((const u32x4*)(F.ws + WS_QA1))[ic]; cc[k] = ((const u32x4*)(F.ws + WS_QA2))[ic];
            l0[k] = LSE[(size_t)t * 8 + slot]; l1[k] = LSE[(size_t)T * 8 + (size_t)t * 8 + slot]; l2[k] = LSE[(size_t)2 * T * 8 + (size_t)t * 8 + slot]; }
        PIN4(a[0], a[1], a[2], a[3]); PIN4(bb[0], bb[1], bb[2], bb[3]); PIN4(cc[0], cc[1], cc[2], cc[3]);
#pragma unroll
        for (int k = 0; k < 4; ++k) { const int i = i0 + k * F.G * NTHREADS; if (i < T * 64) {
            const float m = fmaxf(l0[k], fmaxf(l1[k], l2[k])); float w0 = __builtin_amdgcn_exp2f(l0[k] - m), w1 = __builtin_amdgcn_exp2f(l1[k] - m), w2 = __builtin_amdgcn_exp2f(l2[k] - m); const float inv = __builtin_amdgcn_rcpf(w0 + w1 + w2); w0 *= inv; w1 *= inv; w2 *= inv;
            f32x4 a0, a1, b0, b1, c0, c1; unpack8(a[k], a0, a1); unpack8(bb[k], b0, b1); unpack8(cc[k], c0, c1);
            ((u32x4*)(F.ws + WS_QA0))[i] = pack8(a0 * w0 + b0 * w1 + c0 * w2, a1 * w0 + b1 * w1 + c1 * w2); } }
    }
}

__device__ __forceinline__ void conv_item(const Ctx& F, int layer, int item) {
    const int t0 = item * 32, s0 = t0 & (SEQ - 1), tid = F.tid;
    LAS bf16_t* sin = (LAS bf16_t*)F.lds;
    LAS float* sout = (LAS float*)(F.lds + 65536);
    const bf16_t* YG = (const bf16_t*)(F.ws + WS_YG);
    __syncthreads();
#pragma unroll 1
    for (int kb = 0; kb < 2; ++kb) { u32x4 sv[4];
#pragma unroll
        for (int k = 0; k < 4; ++k) { const int i = tid + (kb * 4 + k) * NTHREADS; const int r = i < 62 * 64 ? (i >> 6) : 0, c8 = i & 63; const int sp = s0 - 30 + r;
            sv[k] = *(const u32x4*)(YG + (size_t)(sp >= 0 ? t0 - 30 + r : t0) * 512 + c8 * 8); }
        PIN4(sv[0], sv[1], sv[2], sv[3]);
#pragma unroll
        for (int k = 0; k < 4; ++k) { const int i = tid + (kb * 4 + k) * NTHREADS; const int r = i >> 6, c8 = i & 63; const int sp = s0 - 30 + r;
            if (i < 62 * 64) *(LAS u32x4*)(sin + r * 512 + c8 * 8) = sp >= 0 ? sv[k] : (u32x4){0u, 0u, 0u, 0u}; } }
    const int cp = tid & 255, hf = tid >> 8;
    f32x2 w[31];
    const float* cw = F.in[I_CONVW] + (size_t)layer * 31 * 512 + 2 * cp;
#pragma unroll
    for (int k = 0; k < 31; ++k) w[k] = *(const f32x2*)(cw + k * 512);
    const f32x2 cb = *(const f32x2*)(F.in[I_CONVB] + layer * 512 + 2 * cp);
    __syncthreads();
#pragma unroll 1
    for (int ps = 0; ps < 2; ++ps) { const int tb = 16 * hf + 8 * ps;
        f32x2 xin[38];
#pragma unroll
        for (int r = 0; r < 38; ++r) { const unsigned u = *(const LAS unsigned*)(sin + (tb + r) * 512 + 2 * cp); xin[r] = (f32x2){bf_lo(u), bf_hi(u)}; }
#pragma unroll
        for (int tt = 0; tt < 8; ++tt) { f32x2 a = cb;
#pragma unroll
            for (int k = 0; k < 31; ++k) a += w[k] * xin[tt + k];
            *(LAS f32x2*)(sout + (tb + tt) * 512 + 2 * cp) = a; } }
    __syncthreads();
    const float* lg = F.in[I_CLNG] + layer * 512 + F.lane * 8; const float* lb = F.in[I_CLNB] + layer * 512 + F.lane * 8;
    for (int tt = F.wave; tt < 32; tt += NWAVES) {
        float v[8]; float sm = 0.f;
#pragma unroll
        for (int j = 0; j < 8; ++j) { v[j] = sout[tt * 512 + F.lane * 8 + j]; sm += v[j]; }
        const float mu = wave_sum(sm) * (1.0f / 512.0f); float q = 0.f;
#pragma unroll
        for (int j = 0; j < 8; ++j) { v[j] -= mu; q += v[j] * v[j]; }
        const float rstd = rsqrtf(wave_sum(q) * (1.0f / 512.0f) + EPS);
        float o[8];
#pragma unroll
        for (int j = 0; j < 8; ++j) o[j] = siluf_(v[j] * rstd * lg[j] + lb[j]);
        u32x4 wv; wv.x = cvt_pk_bf16(o[0], o[1]); wv.y = cvt_pk_bf16(o[2], o[3]); wv.z = cvt_pk_bf16(o[4], o[5]); wv.w = cvt_pk_bf16(o[6], o[7]);
        *(u32x4*)((bf16_t*)(F.ws + WS_YC) + (size_t)(t0 + tt) * 512 + F.lane * 8) = wv;
    }
}

__device__ __forceinline__ float log_sigmoid_(float v) { return fminf(v, 0.f) - log1pf(__expf(-fabsf(v))); }
struct QkW { float w[4][8]; float b[8]; };
__device__ __forceinline__ void qk_load_w(const Ctx& F, int layer, int chq, QkW& W) {
    const float* cw = F.in[I_MCW] + (size_t)layer * 4 * 1024 + chq; const float* cb = F.in[I_MCB] + (size_t)layer * 1024 + chq;
#pragma unroll
    for (int k = 0; k < 4; ++k) { const f32x4 a = *(const f32x4*)(cw + k * 1024), b = *(const f32x4*)(cw + k * 1024 + 4); W.w[k][0] = a.x; W.w[k][1] = a.y; W.w[k][2] = a.z; W.w[k][3] = a.w; W.w[k][4] = b.x; W.w[k][5] = b.y; W.w[k][6] = b.z; W.w[k][7] = b.w; }
    const f32x4 a = *(const f32x4*)cb, b = *(const f32x4*)(cb + 4); W.b[0] = a.x; W.b[1] = a.y; W.b[2] = a.z; W.b[3] = a.w; W.b[4] = b.x; W.b[5] = b.y; W.b[6] = b.z; W.b[7] = b.w;
}
__device__ __forceinline__ void qk_conv8(const QkW& W, const bf16_t* src  , int t, int s, int ch  , float scale, float* o) {
#pragma unroll
    for (int j = 0; j < 8; ++j) o[j] = W.b[j];
#pragma unroll
    for (int k = 0; k < 4; ++k) { const bool ok = s - 3 + k >= 0; u32x4 w = *(const u32x4*)(src + (size_t)(ok ? t - 3 + k : t) * 512 + ch);
            if (!ok) w = (u32x4){0u, 0u, 0u, 0u};
            o[0] += W.w[k][0] * bf_lo(w.x); o[1] += W.w[k][1] * bf_hi(w.x); o[2] += W.w[k][2] * bf_lo(w.y); o[3] += W.w[k][3] * bf_hi(w.y); o[4] += W.w[k][4] * bf_lo(w.z); o[5] += W.w[k][5] * bf_hi(w.z); o[6] += W.w[k][6] * bf_lo(w.w); o[7] += W.w[k][7] * bf_hi(w.w); }
#pragma unroll
    for (int j = 0; j < 8; ++j) o[j] = siluf_(o[j]) * scale;
}
__device__ __forceinline__ void qk_conv8r(const QkW& W, const u32x4 (&rw)[4], int s, float scale, float* o) {
#pragma unroll
    for (int j = 0; j < 8; ++j) o[j] = W.b[j];
#pragma unroll
    for (int k = 0; k < 4; ++k) { u32x4 w = rw[k]; if (s - 3 + k < 0) w = (u32x4){0u, 0u, 0u, 0u};
        o[0] += W.w[k][0] * bf_lo(w.x); o[1] += W.w[k][1] * bf_hi(w.x); o[2] += W.w[k][2] * bf_lo(w.y); o[3] += W.w[k][3] * bf_hi(w.y); o[4] += W.w[k][4] * bf_lo(w.z); o[5] += W.w[k][5] * bf_hi(w.z); o[6] += W.w[k][6] * bf_lo(w.w); o[7] += W.w[k][7] * bf_hi(w.w); }
#pragma unroll
    for (int j = 0; j < 8; ++j) o[j] = siluf_(o[j]) * scale;
}
__device__ __forceinline__ void mlstm_scalars(const Ctx& F, int layer, int t0, int h, LAS float* sIG, LAS float* sBC) {
    if (F.tid < 128) { const float* IFp = (const float*)(F.ws + WS_IF) + (size_t)(t0 + F.tid) * 8;
        sIG[F.tid] = IFp[h] + F.in[I_MIB][layer * 4 + h]; sBC[F.tid] = log_sigmoid_(IFp[4 + h] + F.in[I_MFB][layer * 4 + h]); }
    __syncthreads();
    if (F.wave == 0) { const float a = sBC[2 * F.lane], bb = sBC[2 * F.lane + 1]; float sc = a + bb;
#pragma unroll
        for (int off = 1; off < 64; off <<= 1) { const float t = __shfl_up(sc, off); if (F.lane >= off) sc += t; }
        sBC[2 * F.lane] = sc - bb; sBC[2 * F.lane + 1] = sc; }
    __syncthreads();
}
constexpr int ML_KRS = 288, ML_ERS = 352, ML_E = 128 * ML_KRS, ML_S = ML_E + 128 * ML_ERS;
__device__ __forceinline__ void mlstm_local_mfma(const Ctx& F, int layer, int item) {
    const int c = item & 127, bh = item >> 7, h = bh & 3, b = bh >> 2, t0 = b * SEQ + c * 128, tid = F.tid, lane = F.lane, w = F.wave, fr = lane & 15, fq = lane >> 4;
    LAS unsigned char* L = F.lds;
    LAS float* sIG = (LAS float*)(L + ML_S); LAS float* sBC = sIG + 128; LAS float* sE = sIG + 256; LAS float* sM = sIG + 384;
    __syncthreads();
    mlstm_scalars(F, layer, t0, h, sIG, sBC);
    if (w == 0) { const float gt = sBC[127]; const float m = wave_max(fmaxf(gt - sBC[lane] + sIG[lane], gt - sBC[lane + 64] + sIG[lane + 64])); if (lane == 0) { sM[0] = m; sM[1] = gt; } }
    __syncthreads();
    if (tid < 128) sE[tid] = __expf(sM[1] - sBC[tid] + sIG[tid] - sM[0]);
    __syncthreads();
    const bf16_t* KM = (const bf16_t*)(F.ws + WS_KM); const bf16_t* VM = (const bf16_t*)(F.ws + WS_VM);
    QkW WK; qk_load_w(F, layer, 512 + h * 128 + (tid & 15) * 8, WK);
#pragma unroll 1
    for (int i = tid; i < 128 * 16; i += NTHREADS) { const int l = i >> 4, c8 = (i & 15) * 8; const int t = t0 + l, s = t & (SEQ - 1);
        u32x4 rk[4];
#pragma unroll
        for (int k = 0; k < 4; ++k) rk[k] = *(const u32x4*)(KM + (size_t)(s - 3 + k >= 0 ? t - 3 + k : t) * 512 + h * 128 + c8);
        const u32x4 rv = *(const u32x4*)(VM + (size_t)t * 512 + h * 128 + c8);
        float o[8]; qk_conv8r(WK, rk, s, 0.08838834764831845f, o);
        *(LAS u32x4*)(L + l * ML_KRS + c8 * 2) = pack8((f32x4){o[0], o[1], o[2], o[3]}, (f32x4){o[4], o[5], o[6], o[7]});
        f32x4 v0, v1; unpack8(rv, v0, v1); const float e = sE[l];
        *(LAS u32x4*)(L + ML_E + l * ML_ERS + c8 * 2) = pack8(v0 * e, v1 * e); }
    if (tid < 128) { unsigned zr = 0u; asm volatile("" : "+v"(zr));
        u32x4 z; z.x = f2bf(sE[tid]); z.y = zr; z.z = zr; z.w = zr; *(LAS u32x4*)(L + ML_E + tid * ML_ERS + 256) = z; z.x = zr; *(LAS u32x4*)(L + ML_E + tid * ML_ERS + 272) = z; }
    __syncthreads();
    bf16x8 af[4];
#pragma unroll
    for (int ks = 0; ks < 4; ++ks) { const int ra = ks * 32 + 4 * fq + (fr >> 2);
        const s16x4 a0 = lds_tr16(L + ra * ML_KRS + (w * 16 + 4 * (fr & 3)) * 2), a1 = lds_tr16(L + (ra + 16) * ML_KRS + (w * 16 + 4 * (fr & 3)) * 2);
        af[ks] = (bf16x8){a0[0], a0[1], a0[2], a0[3], a1[0], a1[1], a1[2], a1[3]}; }
    bf16_t* Cp = (bf16_t*)(F.ws + WS_CST) + ((size_t)(bh * 128 + c) << 14);
#pragma unroll
    for (int vb = 0; vb < 9; ++vb) { f32x4 d = (f32x4){0.f, 0.f, 0.f, 0.f};
#pragma unroll
        for (int ks = 0; ks < 4; ++ks) { const int rb = ks * 32 + 4 * fq + (fr >> 2);
            const s16x4 b0 = lds_tr16(L + ML_E + rb * ML_ERS + (vb * 16 + 4 * (fr & 3)) * 2), b1 = lds_tr16(L + ML_E + (rb + 16) * ML_ERS + (vb * 16 + 4 * (fr & 3)) * 2);
            const bf16x8 bfr = (bf16x8){b0[0], b0[1], b0[2], b0[3], b1[0], b1[1], b1[2], b1[3]};
            d = __builtin_amdgcn_mfma_f32_16x16x32_bf16(af[ks], bfr, d, 0, 0, 0); }
        if (vb < 8) { u32x2 o; o.x = pk2(d[0], d[1]); o.y = pk2(d[2], d[3]); *(u32x2*)(Cp + (size_t)(vb * 16 + fr) * 128 + w * 16 + 4 * fq) = o; }
        else if (fr == 0) *(f32x4*)((float*)(F.ws + WS_NST) + (size_t)(bh * 128 + c) * 128 + w * 16 + 4 * fq) = d;
    }
    if (tid == 0) { ((float*)(F.ws + WS_TAB + TAB_MLOC))[bh * 128 + c] = sM[0]; ((float*)(F.ws + WS_TAB + TAB_GTOT))[bh * 128 + c] = sM[1]; }
}
__device__ __forceinline__ void phase_scan(const Ctx& F) {
    const float* GT = (const float*)(F.ws + WS_TAB + TAB_GTOT); const float* ML = (const float*)(F.ws + WS_TAB + TAB_MLOC); float* MS = (float*)(F.ws + WS_TAB + TAB_MST);
    LAS float* sA = (LAS float*)F.lds; LAS float* sB = sA + 128;
    for (int blk = F.bid; blk < 8 * 32; blk += F.G) {
        const int bh = blk >> 5;
        __syncthreads();
        if (F.tid < 128) { sA[F.tid] = GT[bh * 128 + F.tid]; sB[F.tid] = ML[bh * 128 + F.tid]; }
        __syncthreads();
        if (F.wave == 0) {
            const int c0 = 2 * F.lane; const float g0 = sA[c0], m0 = sB[c0], g1 = sA[c0 + 1], m1 = sB[c0 + 1];
            float G = g0 + g1, M = fmaxf(m0 + g1, m1);
#pragma unroll
            for (int off = 1; off < 64; off <<= 1) { const float Gp = __shfl_up(G, off), Mp = __shfl_up(M, off); if (F.lane >= off) { M = fmaxf(Mp + G, M); G = Gp + G; } }
            float Gx = __shfl_up(G, 1), Mx = __shfl_up(M, 1); if (F.lane == 0) { Gx = 0.f; Mx = -INFINITY; }
            const float mA = fmaxf(0.f + Gx, Mx);
            const float mB = fmaxf(mA + g0, m0);
            const float mC = fmaxf(mB + g1, m1);
            sA[c0] = __expf(g0 + mA - mB); sB[c0] = __expf(m0 - mB); sA[c0 + 1] = __expf(g1 + mB - mC); sB[c0 + 1] = __expf(m1 - mC);
            if ((blk & 31) == 0) { MS[bh * 128 + c0] = mA; MS[bh * 128 + c0 + 1] = mB; } }
        __syncthreads();
        bf16_t* cp = (bf16_t*)(F.ws + WS_CST) + ((size_t)(bh * 128) << 14) + (blk & 31) * 512 + F.tid; float val = 0.f;
        const bool hasn = F.tid < 4; float* np = (float*)(F.ws + WS_NST) + (size_t)(bh * 128) * 128 + (hasn ? (blk & 31) * 4 + F.tid : 0); float nval = 0.f;
        for (int c0 = 0; c0 < 128; c0 += 16) { float loc[16], nloc[16];
#pragma unroll
            for (int j = 0; j < 16; ++j) { loc[j] = bf1(cp[(size_t)(c0 + j) << 14]); nloc[j] = np[(size_t)(c0 + j) * 128]; }
            PIN8(loc[0], loc[1], loc[2], loc[3], loc[4], loc[5], loc[6], loc[7]); PIN8(loc[8], loc[9], loc[10], loc[11], loc[12], loc[13], loc[14], loc[15]);
            PIN8(nloc[0], nloc[1], nloc[2], nloc[3], nloc[4], nloc[5], nloc[6], nloc[7]); PIN8(nloc[8], nloc[9], nloc[10], nloc[11], nloc[12], nloc[13], nloc[14], nloc[15]);
#pragma unroll
            for (int j = 0; j < 16; ++j) { const float a = sA[c0 + j], b = sB[c0 + j];
                cp[(size_t)(c0 + j) << 14] = (bf16_t)f2bf(val); val = a * val + b * loc[j];
                if (hasn) np[(size_t)(c0 + j) * 128] = nval; nval = a * nval + b * nloc[j]; } }
    }
    __syncthreads();
}
constexpr int MO_RS = 272, MO_VRS = 288;
constexpr int MO_Q = 0, MO_K = 128 * MO_RS, MO_C = 2 * 128 * MO_RS, MO_V = MO_C + 144 * MO_RS, MO_S = MO_V + 128 * MO_VRS;
static_assert(MO_S + 2560 <= MISC_OFF, "mlstm_out LDS");
__device__ __forceinline__ void mlstm_out_mfma(const Ctx& F, int layer, int item) {
    const int c = item & 127, bh = item >> 7, h = bh & 3, b = bh >> 2, t0 = b * SEQ + c * 128, tid = F.tid, lane = F.lane, w = F.wave, fr = lane & 15, fq = lane >> 4;
    LAS unsigned char* L = F.lds;
    LAS float* sIG = (LAS float*)(L + MO_S); LAS float* sBC = sIG + 128; LAS float* sMT = sIG + 256; LAS float* sSI = sIG + 384; LAS float* sU = sIG + 512;
    __syncthreads();
    mlstm_scalars(F, layer, t0, h, sIG, sBC);
    if (tid < 128) sU[tid] = (sIG[tid] - sBC[tid]) * 1.4426950408889634f;
    const float mst = ((const float*)(F.ws + WS_TAB + TAB_MST))[bh * 128 + c];
    if (w == 0) { const float a = sIG[2 * lane] - sBC[2 * lane], bb = sIG[2 * lane + 1] - sBC[2 * lane + 1]; float pm = fmaxf(a, bb);
#pragma unroll
        for (int off = 1; off < 64; off <<= 1) { const float t = __shfl_up(pm, off); if (lane >= off) pm = fmaxf(pm, t); }
        float pl = __shfl_up(pm, 1); if (lane == 0) pl = -INFINITY;
        const float p0 = fmaxf(pl, a), p1 = pm;
        { const float ai = sBC[2 * lane] + mst, mt = fmaxf(ai, sBC[2 * lane] + p0); sMT[2 * lane] = mt; sSI[2 * lane] = __expf(ai - mt); }
        { const float ai = sBC[2 * lane + 1] + mst, mt = fmaxf(ai, sBC[2 * lane + 1] + p1); sMT[2 * lane + 1] = mt; sSI[2 * lane + 1] = __expf(ai - mt); } }
    const bf16_t* QM = (const bf16_t*)(F.ws + WS_QM); const bf16_t* KM = (const bf16_t*)(F.ws + WS_KM); const bf16_t* VM = (const bf16_t*)(F.ws + WS_VM);
    const bf16_t* Cp = (const bf16_t*)(F.ws + WS_CST) + ((size_t)(bh * 128 + c) << 14);
    QkW WQ, WK; qk_load_w(F, layer, h * 128 + (tid & 15) * 8, WQ); qk_load_w(F, layer, 512 + h * 128 + (tid & 15) * 8, WK);
#pragma unroll 1
    for (int i = tid; i < 128 * 16; i += NTHREADS) { const int l = i >> 4, c8 = (i & 15) * 8; const int t = t0 + l, s = t & (SEQ - 1); float o[8];
        u32x4 rq[4], rk[4];
#pragma unroll
        for (int k = 0; k < 4; ++k) { const size_t ro = (size_t)(s - 3 + k >= 0 ? t - 3 + k : t) * 512 + h * 128 + c8; rq[k] = *(const u32x4*)(QM + ro); rk[k] = *(const u32x4*)(KM + ro); }
        const u32x4 rv = *(const u32x4*)(VM + (size_t)t * 512 + h * 128 + c8), rc = *(const u32x4*)(Cp + l * 128 + c8);
        qk_conv8r(WQ, rq, s, 1.0f, o);
        *(LAS u32x4*)(L + MO_Q + l * MO_RS + c8 * 2) = pack8((f32x4){o[0], o[1], o[2], o[3]}, (f32x4){o[4], o[5], o[6], o[7]});
        qk_conv8r(WK, rk, s, 0.08838834764831845f, o);
        *(LAS u32x4*)(L + MO_K + l * MO_RS + c8 * 2) = pack8((f32x4){o[0], o[1], o[2], o[3]}, (f32x4){o[4], o[5], o[6], o[7]});
        *(LAS u32x4*)(L + MO_V + l * MO_VRS + c8 * 2) = rv;
        *(LAS u32x4*)(L + MO_C + l * MO_RS + c8 * 2) = rc; }
    if (tid < 16) { const float* np = (const float*)(F.ws + WS_NST) + (size_t)(bh * 128 + c) * 128 + tid * 8;
        *(LAS u32x4*)(L + MO_C + 128 * MO_RS + tid * 16) = pack8(*(const f32x4*)np, *(const f32x4*)(np + 4)); }
    __syncthreads();
    const int q = 16 * w + fr;
    bf16x8 qf[4];
#pragma unroll
    for (int ks = 0; ks < 4; ++ks) qf[ks] = *(const LAS bf16x8*)(L + MO_Q + q * MO_RS + ks * 64 + fq * 16);
    f32x4 O[9];
#pragma unroll
    for (int vb = 0; vb < 9; ++vb) { f32x4 a = (f32x4){0.f, 0.f, 0.f, 0.f};
#pragma unroll
        for (int ks = 0; ks < 4; ++ks) { const bf16x8 cf = *(const LAS bf16x8*)(L + MO_C + (vb * 16 + fr) * MO_RS + ks * 64 + fq * 16); a = __builtin_amdgcn_mfma_f32_16x16x32_bf16(cf, qf[ks], a, 0, 0, 0); }
        O[vb] = a; }
    const float si = sSI[q], mt = sMT[q], bq = sBC[q]; const float vq = (bq - mt) * 1.4426950408889634f;
    const float dn = __shfl(O[8][0], fr);
#pragma unroll
    for (int vb = 0; vb < 8; ++vb) O[vb] = O[vb] * si;
    float den = 0.f;
    for (int k2 = 0; k2 <= (w >> 1); ++k2) {
        f32x4 P[2];
#pragma unroll
        for (int u = 0; u < 2; ++u) { const int kb = 2 * k2 + u; f32x4 a = (f32x4){0.f, 0.f, 0.f, 0.f};
            const int kr = (kb > 7 ? 7 : kb) * 16 + fr;
#pragma unroll
            for (int ks = 0; ks < 4; ++ks) { const bf16x8 kf = *(const LAS bf16x8*)(L + MO_K + kr * MO_RS + ks * 64 + fq * 16); a = __builtin_amdgcn_mfma_f32_16x16x32_bf16(kf, qf[ks], a, 0, 0, 0); }
#pragma unroll
            for (int j = 0; j < 4; ++j) { const int k = kb * 16 + 4 * fq + j; const int kc = k > 127 ? 127 : k; const float wgt = (k <= q) ? __builtin_amdgcn_exp2f(sU[kc] + vq) : 0.f; a[j] *= wgt; den += a[j]; }
            P[u] = a; }
        u32x4 pw; pw.x = cvt_pk_bf16(P[0][0], P[0][1]); pw.y = cvt_pk_bf16(P[0][2], P[0][3]); pw.z = cvt_pk_bf16(P[1][0], P[1][1]); pw.w = cvt_pk_bf16(P[1][2], P[1][3]);
        const bf16x8 pf = __builtin_bit_cast(bf16x8, pw);
        const int kb1 = (2 * k2 + 1 > 7) ? 7 : 2 * k2 + 1;
        const int r0 = 2 * k2 * 16 + 4 * fq + (fr >> 2), r1 = kb1 * 16 + 4 * fq + (fr >> 2);
#pragma unroll
        for (int vb = 0; vb < 8; ++vb) {
            const s16x4 v0 = lds_tr16(L + MO_V + r0 * MO_VRS + (vb * 16 + 4 * (fr & 3)) * 2), v1 = lds_tr16(L + MO_V + r1 * MO_VRS + (vb * 16 + 4 * (fr & 3)) * 2);
            const bf16x8 vf = (bf16x8){v0[0], v0[1], v0[2], v0[3], v1[0], v1[1], v1[2], v1[3]};
            O[vb] = __builtin_amdgcn_mfma_f32_16x16x32_bf16(vf, pf, O[vb], 0, 0, 0);
        }
    }
    den += __shfl_xor(den, 16); den += __shfl_xor(den, 32);
    const float dd = den + si * dn; const float inv = 1.0f / fmaxf(fabsf(dd), __expf(-mt));
    bf16_t* OM = (bf16_t*)(F.ws + WS_OM) + (size_t)(t0 + q) * 512 + h * 128;
#pragma unroll
    for (int vb = 0; vb < 8; ++vb) { u32x2* p = (u32x2*)(OM + vb * 16 + 4 * fq); const u32x2 g = *p;
        u32x2 o; o.x = cvt_pk_bf16(bf_lo(g.x) * O[vb][0] * inv, bf_hi(g.x) * O[vb][1] * inv); o.y = cvt_pk_bf16(bf_lo(g.y) * O[vb][2] * inv, bf_hi(g.y) * O[vb][3] * inv); *p = o; }
}

__device__ __forceinline__ void phase_route(const Ctx& F, int layer, int tile0, int tile1, int tstep) {
    LAS int* hist = (LAS int*)F.lds;
    const float* brg = F.in[I_BRG] + layer * 4; const float* bre = F.in[I_BRE] + layer * 32;
    for (int tile = tile0; tile < tile1; tile += tstep) {
        __syncthreads();
        if (F.tid < 128) { const int t = tile * 128 + F.tid; const float* lg = (const float*)(F.ws + WS_LOGITS) + (size_t)t * 64;
            float g[4]; int gs = 0; float gm;
#pragma unroll
            for (int j = 0; j < 4; ++j) g[j] = lg[j] + brg[j];
            gm = g[0];
#pragma unroll
            for (int j = 1; j < 4; ++j) if (g[j] > gm) { gm = g[j]; gs = j; }
            float se = 0.f;
#pragma unroll
            for (int j = 0; j < 4; ++j) se += __expf(g[j] - gm);
            const float pg = 1.0f / se;
            float le[8];
#pragma unroll
            for (int j = 0; j < 8; ++j) le[j] = lg[4 + gs * 8 + j] + bre[gs * 8 + j];
            int i0 = 0; float v0 = le[0];
#pragma unroll
            for (int j = 1; j < 8; ++j) if (le[j] > v0) { v0 = le[j]; i0 = j; }
            int i1 = -1; float v1 = -INFINITY;
#pragma unroll
            for (int j = 0; j < 8; ++j) if (j != i0 && le[j] > v1) { v1 = le[j]; i1 = j; }
            const float e1 = __expf(v1 - v0); const float wsc = (ABL == 4) ? 0.f : ((ABL == 6) ? 2.f : 1.f); const float w0 = wsc * pg / (1.0f + e1), w1 = wsc * pg * e1 / (1.0f + e1);
            const int x0 = gs * 8 + i0, x1 = gs * 8 + i1;
            ((int*)(F.ws + WS_ROUTE))[2 * t] = x0; ((int*)(F.ws + WS_ROUTE))[2 * t + 1] = x1;
            ((float*)(F.ws + WS_ROUTE))[2 * T + 2 * t] = w0; ((float*)(F.ws + WS_ROUTE))[2 * T + 2 * t + 1] = w1;
            hist[F.tid] = x0; hist[128 + F.tid] = x1;
        }
        __syncthreads();
        if (F.tid < 64) { const int k = F.tid >> 5, e = F.tid & 31; int cnt = 0; for (int j = 0; j < 128; ++j) cnt += (hist[k * 128 + j] == e) ? 1 : 0; ((int*)(F.ws + WS_TAB + TAB_CNT))[tile * 64 + F.tid] = cnt; }
        __syncthreads();
    }
}
__device__ __forceinline__ void phase_dispatch(const Ctx& F) {
    LAS int* sTot = (LAS int*)F.lds; LAS int* sBef = sTot + 64; LAS int* sPs = sTot + 128; LAS int* sE = sTot + 256; LAS int* sPart = sTot + 512;
    const int* CNT = (const int*)(F.ws + WS_TAB + TAB_CNT); int* META = (int*)(F.ws + WS_TAB + TAB_META);
    int* tokl = (int*)(F.ws + WS_LISTS); float* wl = (float*)(F.ws + WS_LISTS) + 2 * LISTCAP;
    for (int tile = F.bid; tile < 256; tile += F.G) {
        { const int ke = F.tid & 63, grp = F.tid >> 6; int cv[32];
#pragma unroll
            for (int i = 0; i < 32; ++i) cv[i] = CNT[(grp + 8 * i) * 64 + ke];
            int tot = 0, bef = 0;
#pragma unroll
            for (int i = 0; i < 32; ++i) { tot += cv[i]; bef += (grp + 8 * i < tile) ? cv[i] : 0; }
            sPart[grp * 64 + ke] = tot; sPart[512 + grp * 64 + ke] = bef; }
        __syncthreads();
        if (F.tid < 64) { int tot = 0, bef = 0;
#pragma unroll
            for (int gI = 0; gI < 8; ++gI) { tot += sPart[gI * 64 + F.tid]; bef += sPart[512 + gI * 64 + F.tid]; }
            sTot[F.tid] = tot; sBef[F.tid] = bef; }
        __syncthreads();
        if (F.tid < 2) { int ps = 0; for (int e = 0; e < 32; ++e) { sPs[F.tid * 33 + e] = ps; ps += ((sTot[F.tid * 32 + e] + 255) >> 8) << 8; } sPs[F.tid * 33 + 32] = ps;
            if (tile == 0) { META[F.tid] = ps >> 8; for (int e = 0; e <= 32; ++e) META[16 + 64 * F.tid + e] = sPs[F.tid * 33 + e]; } }
        int e0 = 0, e1 = 0; float w0 = 0.f, w1 = 0.f;
        if (F.tid < 128) { const int t = tile * 128 + F.tid; e0 = ((const int*)(F.ws + WS_ROUTE))[2 * t]; e1 = ((const int*)(F.ws + WS_ROUTE))[2 * t + 1];
            w0 = ((const float*)(F.ws + WS_ROUTE))[2 * T + 2 * t]; w1 = ((const float*)(F.ws + WS_ROUTE))[2 * T + 2 * t + 1]; sE[F.tid] = e0; sE[128 + F.tid] = e1; }
        __syncthreads();
        if (F.tid < 128) { int r0 = 0, r1 = 0; for (int j = 0; j < F.tid; ++j) { r0 += (sE[j] == e0) ? 1 : 0; r1 += (sE[128 + j] == e1) ? 1 : 0; }
            const int p0 = sPs[e0] + sBef[e0] + r0, p1 = sPs[33 + e1] + sBef[32 + e1] + r1;
            tokl[p0] = tile * 128 + F.tid; wl[p0] = w0; tokl[LISTCAP + p1] = tile * 128 + F.tid; wl[LISTCAP + p1] = w1; }
        __syncthreads();
    }
}
__device__ __forceinline__ void phase_final(const Ctx& F, const float* SS) {
    const int gw = F.bid * NWAVES + F.wave, NGW = F.G * NWAVES, lane = F.lane;
    const f32x4* g = (const f32x4*)F.in[I_GFIN] + 2 * lane; const f32x4 g00 = g[0], g01 = g[1], g10 = g[128], g11 = g[129];
    for (int m0 = gw; m0 < T; m0 += 4 * NGW) {
        u32x4 xr[4][2]; f32x4 sa[4];
#pragma unroll
        for (int r = 0; r < 4; ++r) { const int m = m0 + r * NGW; const u32x4* xp = (const u32x4*)((const bf16_t*)(F.ws + WS_XBT) + (size_t)m * D) + lane; xr[r][0] = xp[0]; xr[r][1] = xp[64];
            sa[r] = *((const f32x4*)(SS + (size_t)m * 16) + (lane & 3)); }
        PIN8(xr[0][0], xr[0][1], xr[1][0], xr[1][1], xr[2][0], xr[2][1], xr[3][0], xr[3][1]); PIN4(sa[0], sa[1], sa[2], sa[3]);
#pragma unroll
        for (int r = 0; r < 4; ++r) { const int m = m0 + r * NGW; float sq = (sa[r].x + sa[r].y) + (sa[r].z + sa[r].w); sq += __shfl_xor(sq, 1); sq += __shfl_xor(sq, 2);
            const float rs = rsqrtf(sq * (1.0f / 1024.0f) + EPS); f32x4* o = (f32x4*)(F.out + (size_t)m * D) + 2 * lane;
            f32x4 x0, x1; unpack8(xr[r][0], x0, x1); o[0] = x0 * rs * g00; o[1] = x1 * rs * g01; unpack8(xr[r][1], x0, x1); o[128] = x0 * rs * g10; o[129] = x1 * rs * g11; }
    }
}
constexpr int PH_PER_LAYER = 15, PH_FINAL = DEPTH * PH_PER_LAYER, N_PHASES = PH_FINAL + 1;
struct Args { const float* in[28]; float* out; unsigned char* ws; int ph_lo, ph_hi; };

__device__ __forceinline__ Ctx mkctx(const Args& args, LAS unsigned char* lds, int wave_s) {
    Ctx F; asm volatile("" : "+s"(wave_s)); int tid = wave_s * 64 + lane_id_(); asm volatile("" : "+v"(tid));
    GAS unsigned char* wsg = (GAS unsigned char*)args.ws; asm volatile("" : "+s"(wsg)); unsigned char* ws = (unsigned char*)wsg;
    GAS float* outg = (GAS float*)args.out; asm volatile("" : "+s"(outg)); float* outp = (float*)outg;
    int bid = blockIdx.x; asm volatile("" : "+s"(bid)); int G = gridDim.x; asm volatile("" : "+s"(G));
    F.in.p = args.in; F.out = outp; F.ws = ws; F.lds = lds;
    F.tid = tid; F.lane = tid & 63; F.wave = wave_s; F.G = G; F.bid = bid;
    return F;
}
#ifndef ONLY_PHASE
#define ONLY_PHASE -1
#endif
#ifndef STAGGER_TICKS
#define STAGGER_TICKS 1300
#endif
__device__ __forceinline__ void run_phase(const Args& args, LAS unsigned char* lds, int ph, int wave_s) {
    const int layer = ph / PH_PER_LAYER, lp = ph - layer * PH_PER_LAYER;
    const size_t ssin = (layer & 1) ? WS_SS1 : WS_SS0, ssmid = (layer & 1) ? WS_SS0 : WS_SS1;
    if (ph == PH_FINAL) { const Ctx F = mkctx(args, lds, wave_s); phase_final(F, (const float*)(F.ws + WS_SS0)); return; }
    if (ONLY_PHASE >= 0 && lp != ONLY_PHASE) return;
    switch (lp) {
    case 0: { const Ctx F = mkctx(args, lds, wave_s); phase_prep(F, layer, (float*)(F.ws + ssin)); } break;
    case 1: { const Ctx F = mkctx(args, lds, wave_s); PhProj P{(const char*)F.ws + WS_XB, (const char*)F.ws + WS_WIN, (const float*)(F.ws + ssin), F.ws, F.G, F.bid}; pg8::gemm_phase(F.lds, P, F.tid); } break;
    case 2: { const Ctx F = mkctx(args, lds, wave_s);
        for (int it = F.bid; it < 768; it += F.G) attn_strip(F, it);
        __syncthreads();
        for (int it = F.bid; it < 1024; it += F.G) mlstm_local_mfma(F, layer, it);
        for (int it = F.bid; it < 1024; it += F.G) conv_item(F, layer, it);
    } break;
    case 3: { const Ctx F = mkctx(args, lds, wave_s); phase_scan(F); attn_combine(F); } break;
    case 4: { const Ctx F = mkctx(args, lds, wave_s); for (int it = F.bid; it < 1024; it += F.G) mlstm_out_mfma(F, layer, it); } break;
    case 5: { const Ctx F = mkctx(args, lds, wave_s); PhGates P{(const char*)F.ws + WS_XB, (const char*)F.ws + WS_WIN, (const float*)(F.ws + ssin), F.ws, F.G, F.bid}; pg8::gemm_phase(F.lds, P, F.tid); } break;
    case 6: { const Ctx F = mkctx(args, lds, wave_s); PhMerge P{F.ws, F.G, F.bid};
        pg8::gemm_phase(F.lds, P, F.tid); } break;
    case 7: { const Ctx F = mkctx(args, lds, wave_s); PhOut P{F.ws, (float*)(F.ws + ssmid), F.G, F.bid}; pg8::gemm_phase(F.lds, P, F.tid); } break;
    case 8: { const Ctx F = mkctx(args, lds, wave_s); PhRouter P{F.ws, (const float*)(F.ws + ssmid), F.G, F.bid}; pg8::gemm_phase(F.lds, P, F.tid);
        { int* tokl = (int*)(F.ws + WS_LISTS); for (int i = F.bid * NTHREADS + F.tid; i < 2 * LISTCAP; i += F.G * NTHREADS) tokl[i] = -1; }
        for (int pm = F.bid; pm < 128; pm += F.G) phase_route(F, layer, 2 * pm, 2 * pm + 2, 1);
        phase_prep_experts(F, layer); } break;
    case 9: break;
    case 10: { const Ctx F = mkctx(args, lds, wave_s); phase_dispatch(F); } break;
    case 11: { const Ctx F = mkctx(args, lds, wave_s); PhUp P{F.ws, (const float*)(F.ws + ssmid), (const int*)(F.ws + WS_TAB + TAB_META), (const int*)(F.ws + WS_LISTS), F.G, F.bid}; pg8::gemm_phase(F.lds, P, F.tid); } break;
    case 12: { const Ctx F = mkctx(args, lds, wave_s); PhDown<1> P{F.ws, (float*)(F.ws + ssin), (const int*)(F.ws + WS_TAB + TAB_META), (const int*)(F.ws + WS_LISTS), (const float*)(F.ws + WS_LISTS) + 2 * LISTCAP, F.G, F.bid}; pg8::gemm_phase(F.lds, P, F.tid); } break;
    case 13: { const Ctx F = mkctx(args, lds, wave_s); PhDown<0> P{F.ws, (float*)(F.ws + ssin), (const int*)(F.ws + WS_TAB + TAB_META), (const int*)(F.ws + WS_LISTS), (const float*)(F.ws + WS_LISTS) + 2 * LISTCAP, F.G, F.bid}; pg8::gemm_phase(F.lds, P, F.tid); } break;
    case 14: { const Ctx F = mkctx(args, lds, wave_s); PhPle P{F.ws, (const float*)(F.ws + ssin), (float*)(F.ws + ssmid), F.G, F.bid}; pg8::gemm_phase(F.lds, P, F.tid); } break;
    }
}

__global__ void __launch_bounds__(NTHREADS, 2) fwd_kernel(Args args) {
    extern __shared__ __attribute__((aligned(16))) unsigned char lds_raw[];
    LAS unsigned char* lds = (LAS unsigned char*)lds_raw;
    volatile LAS unsigned* MISC = (volatile LAS unsigned*)(lds + MISC_OFF);
    const int wave_s = __builtin_amdgcn_readfirstlane((int)threadIdx.x >> 6);
    if (wave_s == 0) MISC[lane_id_()] = 0u;
    __syncthreads();
#if MK_MEGA
    XcdBarrier bar = xcd_barrier_post((unsigned*)(args.ws + WS_CTL) + 4096, MISC + 8, wave_s);
#endif
#ifndef PROBE_SEL
#define PROBE_SEL 0
#endif
    unsigned long long extra = 0ull;
    for (int ph = args.ph_lo; ph < args.ph_hi; ++ph) {
        if (ph < PH_FINAL && (ph % PH_PER_LAYER) == 9) continue;
        const unsigned long long t0 = PROBE_SEL ? __builtin_amdgcn_s_memrealtime() : 0ull;
        run_phase(args, lds, ph, wave_s);
#if MK_MEGA
        if (ph + 1 < args.ph_hi) xcd_barrier(bar);
#endif
        if (PROBE_SEL) { const int lp = ph % PH_PER_LAYER; if (ph < PH_FINAL && ((PROBE_SEL >> lp) & 1)) extra += __builtin_amdgcn_s_memrealtime() - t0; }
    }
    if (PROBE_SEL && blockIdx.x == 0) { const unsigned long long te = __builtin_amdgcn_s_memrealtime(); while (__builtin_amdgcn_s_memrealtime() - te < extra) __builtin_amdgcn_s_sleep(8); }
}

extern "C" void kernel_launch(void* const* d_in, const int* in_sizes, int n_in, void* d_out, int out_size, void* d_ws, size_t ws_size, hipStream_t stream) {
    static int grid = 0;
    if (grid == 0) {
        if (n_in != 28 || out_size != T * D || ws_size < WS_END) { fprintf(stderr, "kernel_launch: unexpected shapes (n_in %d out %d ws %zu, need %zu)\n", n_in, out_size, ws_size, (size_t)WS_END); grid = -1; return; }
        int dev = 0, cus = 0, per_cu = 0;
        if (hipGetDevice(&dev) != hipSuccess || hipDeviceGetAttribute(&cus, hipDeviceAttributeMultiprocessorCount, dev) != hipSuccess) { grid = -1; return; }
        if (hipFuncSetAttribute((const void*)fwd_kernel, hipFuncAttributeMaxDynamicSharedMemorySize, LDS_BYTES) != hipSuccess) { fprintf(stderr, "kernel_launch: hipFuncSetAttribute failed\n"); grid = -1; return; }
        if (hipOccupancyMaxActiveBlocksPerMultiprocessor(&per_cu, (const void*)fwd_kernel, NTHREADS, LDS_BYTES) != hipSuccess || per_cu < 1) { fprintf(stderr, "kernel_launch: occupancy query says %d blocks per CU\n", per_cu); }
        (void)hipGetLastError();
        grid = cus;
    }
    if (grid < 0) return;
    Args a{};
    for (int i = 0; i < 28; ++i) a.in[i] = (const float*)d_in[i];
    a.out = (float*)d_out; a.ws = (unsigned char*)d_ws;
#if MK_MEGA
    (void)hipMemsetAsync((char*)d_ws + WS_CTL, 0, CTL_ZERO_BYTES, stream);
    a.ph_lo = 0; a.ph_hi = N_PHASES;
    hipLaunchKernelGGL(fwd_kernel, dim3(grid), dim3(NTHREADS), LDS_BYTES, stream, a);
#else
    for (int ph = 0; ph < N_PHASES; ++ph) { a.ph_lo = ph; a.ph_hi = ph + 1; hipLaunchKernelGGL(fwd_kernel, dim3(grid), dim3(NTHREADS), LDS_BYTES, stream, a); }
#endif
}
```

```cpp
#include <hip/hip_runtime.h>
#include <cstdio>
#include <cstdint>

#ifndef MK_MEGA
#define MK_MEGA 1
#endif

#ifndef ABL
#define ABL 0
#endif
#define LAS __attribute__((address_space(3)))
#define GAS __attribute__((address_space(1)))
typedef unsigned short bf16_t;
typedef short bf16x8 __attribute__((ext_vector_type(8)));
typedef float f32x4 __attribute__((ext_vector_type(4)));
typedef float f32x2 __attribute__((ext_vector_type(2)));
typedef unsigned u32x4 __attribute__((ext_vector_type(4)));
typedef unsigned u32x2 __attribute__((ext_vector_type(2)));

constexpr int T = 32768, SEQ = 16384, D = 1024, DEPTH = 2;
constexpr int D_IN = 8712;
constexpr float EPS = 1e-6f;
constexpr int NTHREADS = 512, NWAVES = 8;
constexpr int LISTCAP = 40960;

constexpr size_t MiB = 1u << 20;
constexpr size_t WS_CTL = 0, CTL_ZERO_BYTES = 1 * MiB;
constexpr size_t WS_TAB = 1 * MiB;
constexpr size_t WS_ROUTE = 2 * MiB;
constexpr size_t WS_LISTS = 3 * MiB;
constexpr size_t WS_SS0 = 4 * MiB, WS_SS1 = 6 * MiB;
constexpr size_t WS_IF = 8 * MiB;
constexpr size_t WS_NST = 9 * MiB;
constexpr size_t WS_LOGITS = 10 * MiB;
constexpr size_t WS_WIN = 18 * MiB;
constexpr size_t WS_WBR = WS_WIN + 8960ull * 1024 * 2;
constexpr size_t WS_WOUT = WS_WBR + 3ull * 1024 * 512 * 2;
constexpr size_t WS_WPG = WS_WOUT + 1024ull * 1024 * 2;
constexpr size_t WS_WPP = WS_WPG + 1024ull * 1024 * 2;
constexpr size_t WS_WR = WS_WPP + 1024ull * 256 * 2;
static_assert(WS_WR + 256ull * 1024 * 2 <= 44 * MiB, "small weights");
constexpr size_t WS_XB = 44 * MiB;
constexpr size_t WS_QA0 = 108 * MiB;
constexpr size_t WS_YATT = WS_QA0;
constexpr size_t WS_OM = 140 * MiB;
constexpr size_t WS_YC = 172 * MiB;
constexpr size_t WS_CST = 204 * MiB;
constexpr size_t WS_B = 236 * MiB;
constexpr size_t WS_KA = WS_B, WS_QA1 = WS_B + 32 * MiB, WS_QA2 = WS_B + 64 * MiB, WS_VA = WS_B + 96 * MiB, WS_YG = WS_B + 128 * MiB, WS_QM = WS_B + 160 * MiB, WS_KM = WS_B + 192 * MiB, WS_VM = WS_B + 224 * MiB;
constexpr size_t WS_G0 = WS_B, WS_MERGED = WS_B + 192 * MiB;
constexpr size_t WS_WEXP = WS_B, WS_HB = WS_B + 48 * MiB, WS_PBF = WS_B + 88 * MiB, WS_PE = WS_B + 104 * MiB, WS_YB1 = WS_B + 168 * MiB, WS_XBT = WS_B;
constexpr size_t WS_END = 492 * MiB;
constexpr size_t TAB_CNT = 0;
constexpr size_t TAB_META = 65536;
constexpr size_t TAB_MLOC = 131072, TAB_GTOT = 131072 + 4096, TAB_MST = 131072 + 8192;

constexpr int RING_BYTES = 131072;
constexpr int MISC_OFF = 155648;
constexpr int LDS_BYTES = 156672;

__device__ __forceinline__ unsigned f2bf(float f) { unsigned u = __builtin_bit_cast(unsigned, f); return (u + 0x7fffu + ((u >> 16) & 1u)) >> 16; }
__device__ __forceinline__ unsigned pk2(float lo, float hi) { return f2bf(lo) | (f2bf(hi) << 16); }
__device__ __forceinline__ unsigned cvt_pk_bf16(float lo, float hi) { unsigned r; asm volatile("v_cvt_pk_bf16_f32 %0, %1, %2" : "=v"(r) : "v"(lo), "v"(hi)); return r; }
__device__ __forceinline__ float bf_lo(unsigned w) { return __builtin_bit_cast(float, w << 16); }
__device__ __forceinline__ float bf_hi(unsigned w) { return __builtin_bit_cast(float, w & 0xffff0000u); }
__device__ __forceinline__ float bf1(bf16_t h) { return __builtin_bit_cast(float, ((unsigned)h) << 16); }
__device__ __forceinline__ float sigmoidf_(float v) { return __builtin_amdgcn_rcpf(1.0f + __expf(-v)); }
__device__ __forceinline__ float siluf_(float v) { return v * __builtin_amdgcn_rcpf(1.0f + __expf(-v)); }
__device__ __forceinline__ float wave_sum(float v) {
#pragma unroll
    for (int o = 1; o < 64; o <<= 1) v += __shfl_xor(v, o);
    return v;
}
__device__ __forceinline__ float wave_max(float v) {
#pragma unroll
    for (int o = 1; o < 64; o <<= 1) v = fmaxf(v, __shfl_xor(v, o));
    return v;
}
__device__ __forceinline__ int lane_id_() { int l; asm volatile("v_mbcnt_lo_u32_b32 %0, -1, 0\n\tv_mbcnt_hi_u32_b32 %0, -1, %0" : "=&v"(l)); return l; }
#define LDS_WAIT() asm volatile("s_waitcnt lgkmcnt(0)" ::: "memory")
#define VM_WAIT() asm volatile("s_waitcnt vmcnt(0)" ::: "memory")

#define XB_TMO      128
#define XB_XCNT(j)  (256  + 64 * (j))
#define XB_XSUB(j)  (1280 + 64 * (j))
#define XB_XGEN(j)  (2304 + 64 * (j))
#define XB_TOP      3328
#define XB_TOPGEN   3392
#define XCD_BAR_WORDS 3456
#define XB_SPIN_CAP (1u << 22)
__device__ __forceinline__ unsigned xb_ld(unsigned* p)              { return __hip_atomic_load(p, __ATOMIC_RELAXED, __HIP_MEMORY_SCOPE_AGENT); }
__device__ __forceinline__ unsigned xb_add(unsigned* p, unsigned v) { return __hip_atomic_fetch_add(p, v, __ATOMIC_RELAXED, __HIP_MEMORY_SCOPE_AGENT); }
__device__ __forceinline__ unsigned xb_xcc_id() { return (unsigned)__builtin_amdgcn_s_getreg((3 << 11) | 20) & 0xFu; }
#define XB_SPIN(cond, bar) do { unsigned _sp = 0; while (cond) { __builtin_amdgcn_s_sleep(1); \
    if ((++_sp & 255u) == 0u) { if (xb_ld(&(bar)[XB_TMO])) break; if (_sp > XB_SPIN_CAP) { atomicAdd(&(bar)[XB_TMO], 1u); break; } } } } while (0)
struct XcdBarrier { unsigned* bar; unsigned x; volatile LAS unsigned* st; int wave; };
__device__ __forceinline__ XcdBarrier xcd_barrier_post(unsigned* bar, volatile LAS unsigned* st, int wave) {
    XcdBarrier b; b.bar = bar; b.x = xb_xcc_id(); b.st = st; b.wave = wave;
    if (wave == 0 && lane_id_() == 0) (void)xb_add(&bar[XB_XCNT(b.x)], 1u);
    return b;
}
__device__ __forceinline__ void xcd_barrier_complete(unsigned* bar, unsigned x, unsigned& nloc, unsigned& nx) {
    const unsigned G = gridDim.x * gridDim.y * gridDim.z;
    unsigned sum, cnt, mine, sp = 0u;
    for (;;) {
        sum = 0u; cnt = 0u; mine = 0u;
#pragma unroll
        for (unsigned j = 0; j < 16; ++j) { const unsigned c = xb_ld(&bar[XB_XCNT(j)]); sum += c; cnt += (c > 0u) ? 1u : 0u; mine = (j == x) ? c : mine; }
        if (sum == G) break;
        __builtin_amdgcn_s_sleep(1);
        if ((++sp & 255u) == 0u) { if (xb_ld(&bar[XB_TMO])) break; if (sp > XB_SPIN_CAP) { atomicAdd(&bar[XB_TMO], 1u); break; } }
    }
    nloc = mine > 0u ? mine : 1u; nx = cnt > 0u ? cnt : 1u;
}
__device__ __forceinline__ void xcd_barrier(const XcdBarrier& b) {
    asm volatile("s_waitcnt vmcnt(0)" ::: "memory");
    __syncthreads();
    if (b.wave == 0 && lane_id_() == 0) {
        unsigned* bar = b.bar;
        __builtin_amdgcn_s_waitcnt(0);
        unsigned nloc = b.st[0], nx = b.st[1];
        if (nloc == 0u) { xcd_barrier_complete(bar, b.x, nloc, nx); b.st[0] = nloc; b.st[1] = nx; }
        const unsigned old = xb_add(&bar[XB_XSUB(b.x)], 1u);
        const unsigned gen = old / nloc;
        if (old + 1u == (gen + 1u) * nloc) {
            __builtin_amdgcn_fence(__ATOMIC_RELEASE, "agent");
            asm volatile("s_waitcnt vmcnt(0)" ::: "memory");
            const unsigned og = xb_add(&bar[XB_TOP], 1u);
            const unsigned tg = og / nx;
            if (og + 1u == (tg + 1u) * nx) xb_add(&bar[XB_TOPGEN], 1u);
            else XB_SPIN(xb_ld(&bar[XB_TOPGEN]) == tg, bar);
            __builtin_amdgcn_fence(__ATOMIC_ACQUIRE, "agent");
            xb_add(&bar[XB_XGEN(b.x)], 1u);
            asm volatile("s_waitcnt vmcnt(0)" ::: "memory");
        } else {
            XB_SPIN(xb_ld(&bar[XB_XGEN(b.x)]) == gen, bar);
            __builtin_amdgcn_fence(__ATOMIC_ACQUIRE, "agent");
            asm volatile("s_waitcnt vmcnt(0)" ::: "memory");
        }
    }
    __syncthreads();
}

namespace pg8 {
constexpr int BM = 256, BK = 64, HALF = 128, HTB = HALF * BK * 2, NXCD = 8, WGM = 8;
__device__ __forceinline__ int lds_byte(int r, int c) { const int st = (r >> 4) * 2 + (c >> 5), rr = r & 15, cc = c & 31, ob = rr * 64 + cc * 2; return st * 1024 + (ob ^ (((ob >> 9) & 1) << 5)); }
__device__ __forceinline__ void stage_rc(int b, int& R, int& C) { const int st = b / 1024, sb = b % 1024, swz = sb ^ (((sb >> 9) & 1) << 5); R = (st >> 1) * 16 + swz / 64; C = (st & 1) * 32 + (swz % 64) / 2; }
__device__ __forceinline__ int perm32(int rho) { const int n = rho >> 4, i = rho & 15; return 8 * (i >> 2) + 4 * n + (i & 3); }

struct GUnit { const char* A; const char* B; int pm, pn, a0, a1; };

__device__ __forceinline__ void tile_order(int L, int nM, int nN, int& pm, int& pn) {
    const int nwg = nM * nN; int wgid = L;
    { const int q = nwg / NXCD, r = nwg % NXCD, xcd = wgid % NXCD, off = wgid / NXCD; wgid = (xcd < r ? xcd * (q + 1) : r * (q + 1) + (xcd - r) * q) + off; }
    const int nig = WGM * nN, gid = wgid / nig, fm = gid * WGM, gsz = (nM - fm) < WGM ? (nM - fm) : WGM;
    pm = fm + ((wgid % nig) % gsz); pn = (wgid % nig) / gsz;
}

typedef f32x4 Acc[2][2][4][2];

template <class P>
__device__ __forceinline__ void gemm_phase(LAS unsigned char* lds, const P& S, int tid) {
    asm volatile("" : "+v"(tid));
    const int wid = __builtin_amdgcn_readfirstlane(tid >> 6), lane = tid & 63, wr = wid >> 2, wc = wid & 3, fr = lane & 15, fq = lane >> 4;
    constexpr int K = P::K, nt = K / BK;
    static_assert(nt >= 4 && (nt % 2) == 0, "K multiple of 128, >= 256");
    unsigned voffB[2];
#pragma unroll
    for (int i = 0; i < 2; ++i) { int R, C; stage_rc(tid * 16 + i * 8192, R, C); const int Rb = (R & ~31) + perm32(R & 31); voffB[i] = (unsigned)(Rb * K + C) * 2u; }
    constexpr size_t kstep = (size_t)(BK * 2);
    constexpr size_t hstepB = (size_t)HALF * K * 2;
    const unsigned ldsw = (unsigned)wid * 1024u;
    const int aoff = lds_byte(wr * 64 + fr, fq * 8), boff = lds_byte(wc * 32 + fr, fq * 8);
#define PG8_SA(b, h) (((b) * 2 + (h)) * HTB)
#define PG8_SB(b, h) ((4 + (b) * 2 + (h)) * HTB)
#define PG8_STAGE(bufoff, gbase, voff) do { _Pragma("unroll") for (int _i = 0; _i < 2; ++_i) \
        __builtin_amdgcn_global_load_lds((const unsigned*)((const char*)(gbase) + (voff)[_i]), (LAS unsigned*)(lds + (bufoff) + ldsw + _i * 8192), 16, 0, 0); } while (0)
#define PG8_LDA(dst, b, h) do { _Pragma("unroll") for (int m = 0; m < 4; ++m) _Pragma("unroll") for (int k = 0; k < 2; ++k) dst[m][k] = *(const LAS bf16x8*)(lds + PG8_SA(b, h) + aoff + m * 2048 + k * 1024); } while (0)
#define PG8_LDB(dst, b, h) do { _Pragma("unroll") for (int n = 0; n < 2; ++n) _Pragma("unroll") for (int k = 0; k < 2; ++k) dst[n][k] = *(const LAS bf16x8*)(lds + PG8_SB(b, h) + boff + n * 2048 + k * 1024); } while (0)
#define PG8_MMA(ai, bj, At, Bt) do { __builtin_amdgcn_s_setprio(1); _Pragma("unroll") for (int m = 0; m < 4; ++m) _Pragma("unroll") for (int n = 0; n < 2; ++n) _Pragma("unroll") for (int k = 0; k < 2; ++k) \
        acc[ai][bj][m][n] = __builtin_amdgcn_mfma_f32_16x16x32_bf16(Bt[n][k], At[m][k], acc[ai][bj][m][n], 0, 0, 0); __builtin_amdgcn_s_setprio(0); } while (0)
#define PG8_WAIT_V(n) asm volatile("s_waitcnt vmcnt(" #n ")" ::: "memory")
#define PG8_WAIT_L(n) asm volatile("s_waitcnt lgkmcnt(" #n ")" ::: "memory")
#define PG8_BAR __builtin_amdgcn_s_barrier()
#define PG8_SCHED __builtin_amdgcn_sched_barrier(0)
#define PG8_VOA(dst, u) do { _Pragma("unroll") for (int _h = 0; _h < 2; ++_h) _Pragma("unroll") for (int _i = 0; _i < 2; ++_i) { int _R, _C; stage_rc(tid * 16 + _i * 8192, _R, _C); \
        if constexpr (P::GATHER) dst[_h][_i] = (S.arow(u, _h * HALF + _R) * (unsigned)K + (unsigned)_C) * 2u; \
        else dst[_h][_i] = (unsigned)((_h * HALF + _R) * K + _C) * 2u; } } while (0)
    GUnit cur, nxt; int ui = 0;
    if (!S.next(0, cur)) return;
    Acc acc;
#pragma unroll
    for (int a = 0; a < 2; ++a)
#pragma unroll
        for (int b = 0; b < 2; ++b)
#pragma unroll
            for (int m = 0; m < 4; ++m)
#pragma unroll
                for (int n = 0; n < 2; ++n) acc[a][b][m][n] = (f32x4){0.f, 0.f, 0.f, 0.f};
    bf16x8 At[4][2], B0[2][2], B1[2][2];
    unsigned voA[2][2], voAn[2][2];
    PG8_VOA(voA, cur);
    const char* cA = cur.A; const char* cB = cur.B;
    PG8_STAGE(PG8_SB(0, 0), cB, voffB); PG8_STAGE(PG8_SB(0, 1), cB + hstepB, voffB); PG8_STAGE(PG8_SA(0, 0), cA, voA[0]); PG8_STAGE(PG8_SA(0, 1), cA, voA[1]);
    if (wr == 1) PG8_BAR;
    PG8_WAIT_V(2); PG8_BAR;
    PG8_STAGE(PG8_SB(1, 0), cB + kstep, voffB); PG8_STAGE(PG8_SA(1, 0), cA + kstep, voA[0]); PG8_STAGE(PG8_SB(1, 1), cB + hstepB + kstep, voffB);
    PG8_WAIT_V(6); PG8_BAR;
    for (;;) {
        const bool has_next = S.next(ui + 1, nxt);
        const char* nA = has_next ? nxt.A : cA; const char* nB = has_next ? nxt.B : cB;
        if constexpr (P::GATHER) {
            if (has_next) { PG8_VOA(voAn, nxt); }
            else {
#pragma unroll
                for (int h = 0; h < 2; ++h)
#pragma unroll
                    for (int i = 0; i < 2; ++i) voAn[h][i] = voA[h][i];
            }
        }
#pragma unroll 1
        for (int t = 0; t < nt; t += 2) {
            const bool last = (t == nt - 2);
            const char* a1 = cA + (size_t)(t + 1) * kstep;
            const char* a2 = last ? nA : cA + (size_t)(t + 2) * kstep; const char* b2 = last ? nB : cB + (size_t)(t + 2) * kstep;
            const char* a3 = a2 + kstep; const char* b3 = b2 + kstep;
            unsigned s0[2], s1[2];
#pragma unroll
            for (int i = 0; i < 2; ++i) {
                if constexpr (P::GATHER) { s0[i] = last ? voAn[0][i] : voA[0][i]; s1[i] = last ? voAn[1][i] : voA[1][i]; }
                else { s0[i] = voA[0][i]; s1[i] = voA[1][i]; }
            }
            PG8_LDB(B0, 0, 0); PG8_LDB(B1, 0, 1); PG8_SCHED; PG8_LDA(At, 0, 0); PG8_STAGE(PG8_SA(1, 1), a1, voA[1]);
            PG8_WAIT_V(8); PG8_WAIT_L(0); PG8_BAR; PG8_MMA(0, 0, At, B0); PG8_MMA(0, 1, At, B1); PG8_BAR; PG8_SCHED;
            PG8_LDA(At, 0, 1); PG8_STAGE(PG8_SB(0, 0), b2, voffB); PG8_STAGE(PG8_SB(0, 1), b2 + hstepB, voffB); PG8_STAGE(PG8_SA(0, 0), a2, s0);
            PG8_WAIT_V(8); PG8_WAIT_L(0); PG8_BAR; PG8_MMA(1, 0, At, B0); PG8_MMA(1, 1, At, B1); PG8_BAR; PG8_SCHED;
            PG8_LDB(B0, 1, 0); PG8_LDB(B1, 1, 1); PG8_SCHED; PG8_LDA(At, 1, 0); PG8_STAGE(PG8_SA(0, 1), a2, s1);
            PG8_WAIT_V(8); PG8_WAIT_L(0); PG8_BAR; PG8_MMA(0, 0, At, B0); PG8_MMA(0, 1, At, B1); PG8_BAR; PG8_SCHED;
            PG8_LDA(At, 1, 1); PG8_STAGE(PG8_SB(1, 0), b3, voffB); PG8_STAGE(PG8_SB(1, 1), b3 + hstepB, voffB); PG8_STAGE(PG8_SA(1, 0), a3, s0);
            PG8_WAIT_V(8); PG8_WAIT_L(0); PG8_BAR; PG8_MMA(1, 0, At, B0); PG8_MMA(1, 1, At, B1); PG8_BAR; PG8_SCHED;
        }
        if (wr == 0) PG8_BAR;
        const bool zero = S.epi(acc, cur, wr, wc, fr, fq);
        if (!has_next) break;
        if (zero) {
#pragma unroll
            for (int a = 0; a < 2; ++a)
#pragma unroll
                for (int b = 0; b < 2; ++b)
#pragma unroll
                    for (int m = 0; m < 4; ++m)
#pragma unroll
                        for (int n = 0; n < 2; ++n) acc[a][b][m][n] = (f32x4){0.f, 0.f, 0.f, 0.f};
        }
        cur = nxt; cA = nA; cB = nB; ++ui;
        if constexpr (P::GATHER) {
#pragma unroll
            for (int h = 0; h < 2; ++h)
#pragma unroll
                for (int i = 0; i < 2; ++i) voA[h][i] = voAn[h][i];
        }
        if (wr == 1) PG8_BAR;
    }
    PG8_WAIT_V(0);
    PG8_BAR;
#undef PG8_SA
#undef PG8_SB
#undef PG8_STAGE
#undef PG8_LDA
#undef PG8_LDB
#undef PG8_MMA
#undef PG8_WAIT_V
#undef PG8_WAIT_L
#undef PG8_BAR
#undef PG8_SCHED
#undef PG8_VOA
}
}
using pg8::GUnit; using pg8::Acc;

__device__ __forceinline__ float row_rs(const float* SS, int row) {
    const f32x4* p = (const f32x4*)(SS + (size_t)row * 16);
    const f32x4 a = p[0], b = p[1], c = p[2], d = p[3];
    const float s = (((a.x + a.y) + (a.z + a.w)) + ((b.x + b.y) + (b.z + b.w))) + (((c.x + c.y) + (c.z + c.w)) + ((d.x + d.y) + (d.z + d.w)));
    return rsqrtf(s * (1.0f / 1024.0f) + EPS);
}
#define PIN1(a) asm volatile("" : "+v"(a))
#define PIN2(a, b) asm volatile("" : "+v"(a), "+v"(b))
#define PIN4(a, b, c, d) asm volatile("" : "+v"(a), "+v"(b), "+v"(c), "+v"(d))
#define PIN8(a, b, c, d, e, f, g, h) asm volatile("" : "+v"(a), "+v"(b), "+v"(c), "+v"(d), "+v"(e), "+v"(f), "+v"(g), "+v"(h))
__device__ __forceinline__ void row_rs8(const float* SS, int row0, float (&rs)[8]) {
#pragma unroll
    for (int hh = 0; hh < 4; ++hh) { f32x4 a[2], b[2], c[2], d[2];
#pragma unroll
        for (int g = 0; g < 2; ++g) { const f32x4* p = (const f32x4*)(SS + (size_t)(row0 + (hh >> 1) * 128 + ((hh & 1) * 2 + g) * 16) * 16); a[g] = p[0]; b[g] = p[1]; c[g] = p[2]; d[g] = p[3]; }
#pragma unroll
        for (int g = 0; g < 2; ++g) { const f32x4 t = (a[g] + b[g]) + (c[g] + d[g]); rs[hh * 2 + g] = rsqrtf(((t.x + t.y) + (t.z + t.w)) * (1.0f / 1024.0f) + EPS); }
        PIN2(rs[hh * 2], rs[hh * 2 + 1]); }
}
__device__ __forceinline__ u32x4 pack8(const f32x4 v0, const f32x4 v1) { u32x4 w; w.x = cvt_pk_bf16(v0[0], v0[1]); w.y = cvt_pk_bf16(v0[2], v0[3]); w.z = cvt_pk_bf16(v1[0], v1[1]); w.w = cvt_pk_bf16(v1[2], v1[3]); return w; }
__device__ __forceinline__ void unpack8(const u32x4 w, f32x4& v0, f32x4& v1) { v0 = (f32x4){bf_lo(w.x), bf_hi(w.x), bf_lo(w.y), bf_hi(w.y)}; v1 = (f32x4){bf_lo(w.z), bf_hi(w.z), bf_lo(w.w), bf_hi(w.w)}; }
__device__ __forceinline__ f32x4 sig4(const f32x4 v) { return (f32x4){sigmoidf_(v[0]), sigmoidf_(v[1]), sigmoidf_(v[2]), sigmoidf_(v[3])}; }
__device__ __forceinline__ f32x4 gate4(const f32x4 v) { f32x4 s = sig4(v); return (f32x4){fmaxf(s[0], 1e-6f), fmaxf(s[1], 1e-6f), fmaxf(s[2], 1e-6f), fmaxf(s[3], 1e-6f)}; }

struct PhProj {
    static constexpr int K = 1024; static constexpr bool GATHER = false;
    const char* xb; const char* W; const float* SS; unsigned char* ws; int G, c;
    __device__ __forceinline__ bool next(int i, GUnit& u) const {
        const long L = (long)i * G + c; if (L >= 128 * 23) return false;
        pg8::tile_order((int)L, 128, 23, u.pm, u.pn);
        u.A = xb + (size_t)u.pm * 256 * K * 2; u.B = W + (size_t)u.pn * 256 * K * 2; u.a0 = 0; u.a1 = 0; return true;
    }
    __device__ __forceinline__ unsigned arow(const GUnit&, int) const { return 0u; }
    __device__ __forceinline__ bool epi(Acc& acc, const GUnit& u, int wr, int wc, int fr, int fq) const {
        const int pn = u.pn; const int row0 = u.pm * 256 + wr * 64 + fr;
        float rs8[8]; row_rs8(SS, row0, rs8);
        if (pn == 22) {
            if (wc == 0 && fq == 0) {
                float* IFp = (float*)(ws + WS_IF);
#pragma unroll
                for (int ai = 0; ai < 2; ++ai)
#pragma unroll
                    for (int m = 0; m < 4; ++m) { const int row = row0 + ai * 128 + m * 16; const float rs = rs8[ai * 4 + m];
                        *(f32x4*)(IFp + (size_t)row * 8) = acc[ai][0][m][0] * rs; *(f32x4*)(IFp + (size_t)row * 8 + 4) = acc[ai][0][m][1] * rs; }
            }
            return true;
        }
        if (pn >= 10 && pn < 14) {
            bf16_t* Y = (bf16_t*)(ws + WS_YG);
#pragma unroll
            for (int ai = 0; ai < 2; ++ai)
#pragma unroll
                for (int m = 0; m < 4; ++m) { const int row = row0 + ai * 128 + m * 16; const float rs = rs8[ai * 4 + m];
#pragma unroll
                    for (int bj = 0; bj < 2; ++bj) { const f32x4 a = acc[ai][bj][m][0] * rs, g = sig4(acc[ai][bj][m][1] * rs), y = a * g;
                        u32x2 w; w.x = cvt_pk_bf16(y[0], y[1]); w.y = cvt_pk_bf16(y[2], y[3]);
                        *(u32x2*)(Y + (size_t)row * 512 + (pn - 10) * 128 + bj * 64 + wc * 16 + fq * 4) = w; } }
            return true;
        }
        bf16_t* dst; int col0; bool sg = false;
        if (pn < 6) { dst = (bf16_t*)(ws + (pn < 2 ? WS_QA0 : (pn < 4 ? WS_QA1 : WS_QA2))); col0 = (pn & 1) * 256; }
        else if (pn < 8) { dst = (bf16_t*)(ws + WS_KA); col0 = (pn - 6) * 256; }
        else if (pn < 10) { dst = (bf16_t*)(ws + WS_VA); col0 = (pn - 8) * 256; }
        else if (pn < 16) { dst = (bf16_t*)(ws + WS_QM); col0 = (pn - 14) * 256; }
        else if (pn < 18) { dst = (bf16_t*)(ws + WS_KM); col0 = (pn - 16) * 256; }
        else if (pn < 20) { dst = (bf16_t*)(ws + WS_VM); col0 = (pn - 18) * 256; }
        else { dst = (bf16_t*)(ws + WS_OM); col0 = (pn - 20) * 256; sg = true; }
        col0 += wc * 32 + fq * 8;
#pragma unroll
        for (int ai = 0; ai < 2; ++ai)
#pragma unroll
            for (int m = 0; m < 4; ++m) { const int row = row0 + ai * 128 + m * 16; const float rs = rs8[ai * 4 + m];
#pragma unroll
                for (int bj = 0; bj < 2; ++bj) { f32x4 v0 = acc[ai][bj][m][0] * rs, v1 = acc[ai][bj][m][1] * rs;
                    if (sg) { v0 = sig4(v0); v1 = sig4(v1); }
                    *(u32x4*)(dst + (size_t)row * 512 + col0 + bj * 128) = pack8(v0, v1); } }
        return true;
    }
};
struct PhGates {
    static constexpr int K = 1024; static constexpr bool GATHER = false;
    const char* xb; const char* W; const float* SS; unsigned char* ws; int G, c;
    __device__ __forceinline__ bool next(int i, GUnit& u) const {
        const long L = (long)i * G + c; if (L >= 128 * 12) return false;
        pg8::tile_order((int)L, 128, 12, u.pm, u.pn);
        u.A = xb + (size_t)u.pm * 256 * K * 2; u.B = W + (size_t)(5888 + u.pn * 256) * K * 2; u.a0 = 0; u.a1 = 0; return true;
    }
    __device__ __forceinline__ unsigned arow(const GUnit&, int) const { return 0u; }
    __device__ __forceinline__ bool epi(Acc& acc, const GUnit& u, int wr, int wc, int fr, int fq) const {
        const int row0 = u.pm * 256 + wr * 64 + fr;
        float rs8[8]; row_rs8(SS, row0, rs8);
        bf16_t* dst = (bf16_t*)(ws + WS_G0 + (size_t)(u.pn >> 2) * 64 * MiB); const int col0 = (u.pn & 3) * 256 + wc * 32 + fq * 8;
#pragma unroll
        for (int ai = 0; ai < 2; ++ai)
#pragma unroll
            for (int m = 0; m < 4; ++m) { const int row = row0 + ai * 128 + m * 16; const float rs = rs8[ai * 4 + m];
#pragma unroll
                for (int bj = 0; bj < 2; ++bj) *(u32x4*)(dst + (size_t)row * 1024 + col0 + bj * 128) = pack8(gate4(acc[ai][bj][m][0] * rs), gate4(acc[ai][bj][m][1] * rs)); }
        return true;
    }
};
struct PhMerge {
    static constexpr int K = 512; static constexpr bool GATHER = false;
    unsigned char* ws; int G, c;
    __device__ __forceinline__ bool next(int i, GUnit& u) const {
        const int ti = i / 3, seg = i - ti * 3; const long L = (long)ti * G + c; if (L >= 128 * 4) return false;
        pg8::tile_order((int)L, 128, 4, u.pm, u.pn);
        const size_t ya = seg == 0 ? WS_YATT : (seg == 1 ? WS_YC : WS_OM);
        u.A = (const char*)ws + ya + (size_t)u.pm * 256 * K * 2; u.B = (const char*)ws + WS_WBR + (size_t)seg * 1024 * 512 * 2 + (size_t)u.pn * 256 * K * 2; u.a0 = seg; u.a1 = 0; return true;
    }
    __device__ __forceinline__ unsigned arow(const GUnit&, int) const { return 0u; }
    __device__ __forceinline__ bool epi(Acc& acc, const GUnit& u, int wr, int wc, int fr, int fq) const {
        const int seg = u.a0; const int row0 = u.pm * 256 + wr * 64 + fr; const int col0 = u.pn * 256 + wc * 32 + fq * 8;
        const bf16_t* Gn = (const bf16_t*)(ws + WS_G0 + (size_t)seg * 64 * MiB);
        const bf16_t* Gd = (const bf16_t*)(ws + WS_G0 + (size_t)(seg < 2 ? seg + 1 : seg) * 64 * MiB);
        bf16_t* Mo = (bf16_t*)(ws + WS_MERGED);
#pragma unroll
        for (int ai = 0; ai < 2; ++ai)
#pragma unroll
            for (int mp = 0; mp < 2; ++mp) {
                u32x4 gn[2][2], gd[2][2];
#pragma unroll
                for (int mm = 0; mm < 2; ++mm)
#pragma unroll
                    for (int bj = 0; bj < 2; ++bj) { const size_t off = (size_t)(row0 + ai * 128 + (2 * mp + mm) * 16) * 1024 + col0 + bj * 128; gn[mm][bj] = *(const u32x4*)(Gn + off); gd[mm][bj] = *(const u32x4*)(Gd + off); }
                PIN8(gn[0][0], gn[0][1], gn[1][0], gn[1][1], gd[0][0], gd[0][1], gd[1][0], gd[1][1]);
#pragma unroll
                for (int mm = 0; mm < 2; ++mm)
#pragma unroll
                    for (int bj = 0; bj < 2; ++bj) { const int m = 2 * mp + mm; const size_t off = (size_t)(row0 + ai * 128 + m * 16) * 1024 + col0 + bj * 128;
                        f32x4 n0, n1, d0, d1; unpack8(gn[mm][bj], n0, n1); unpack8(gd[mm][bj], d0, d1);
                        if (seg < 2) {
#pragma unroll
                            for (int j = 0; j < 4; ++j) { acc[ai][bj][m][0][j] *= n0[j] * __builtin_amdgcn_rcpf(d0[j]); acc[ai][bj][m][1][j] *= n1[j] * __builtin_amdgcn_rcpf(d1[j]); } }
                        else *(u32x4*)(Mo + off) = pack8(acc[ai][bj][m][0] * n0, acc[ai][bj][m][1] * n1); }
            }
        return seg == 2;
    }
};
__device__ __forceinline__ float store_x8(bf16_t* xbp, const f32x4 v0, const f32x4 v1) {
    *(u32x4*)xbp = pack8(v0, v1);
    return ((v0[0] * v0[0] + v0[1] * v0[1]) + (v0[2] * v0[2] + v0[3] * v0[3])) + ((v1[0] * v1[0] + v1[1] * v1[1]) + (v1[2] * v1[2] + v1[3] * v1[3]));
}
struct PhOut {
    static constexpr int K = 1024; static constexpr bool GATHER = false;
    unsigned char* ws; float* SSo; int G, c;
    __device__ __forceinline__ bool next(int i, GUnit& u) const {
        const long L = (long)i * G + c; if (L >= 128 * 4) return false;
        pg8::tile_order((int)L, 128, 4, u.pm, u.pn);
        u.A = (const char*)ws + WS_MERGED + (size_t)u.pm * 256 * K * 2; u.B = (const char*)ws + WS_WOUT + (size_t)u.pn * 256 * K * 2; u.a0 = 0; u.a1 = 0; return true;
    }
    __device__ __forceinline__ unsigned arow(const GUnit&, int) const { return 0u; }
    __device__ __forceinline__ bool epi(Acc& acc, const GUnit& u, int wr, int wc, int fr, int fq) const {
        const int row0 = u.pm * 256 + wr * 64 + fr; const int col0 = u.pn * 256 + wc * 32 + fq * 8; bf16_t* XB = (bf16_t*)(ws + WS_XB);
#pragma unroll
        for (int ai = 0; ai < 2; ++ai) {
            u32x4 xr[4][2];
#pragma unroll
            for (int m = 0; m < 4; ++m)
#pragma unroll
                for (int bj = 0; bj < 2; ++bj) xr[m][bj] = *(const u32x4*)(XB + (size_t)(row0 + ai * 128 + m * 16) * 1024 + col0 + bj * 128);
            PIN8(xr[0][0], xr[0][1], xr[1][0], xr[1][1], xr[2][0], xr[2][1], xr[3][0], xr[3][1]);
#pragma unroll
            for (int m = 0; m < 4; ++m) { const int row = row0 + ai * 128 + m * 16; const size_t off = (size_t)row * 1024 + col0; float ss = 0.f;
#pragma unroll
                for (int bj = 0; bj < 2; ++bj) { f32x4 x0, x1; unpack8(xr[m][bj], x0, x1); ss += store_x8(XB + off + bj * 128, x0 + acc[ai][bj][m][0], x1 + acc[ai][bj][m][1]); }
                ss += __shfl_xor(ss, 16); ss += __shfl_xor(ss, 32);
                if (fq == 0) SSo[(size_t)row * 16 + u.pn * 4 + wc] = ss; } }
        return true;
    }
};
struct PhRouter {
    static constexpr int K = 1024; static constexpr bool GATHER = false;
    unsigned char* ws; const float* SS; int G, c;
    __device__ __forceinline__ bool next(int i, GUnit& u) const {
        const long L = (long)i * G + c; if (L >= 128) return false;
        u.pm = (int)L; u.pn = 0; u.A = (const char*)ws + WS_XB + (size_t)u.pm * 256 * K * 2; u.B = (const char*)ws + WS_WR; u.a0 = 0; u.a1 = 0; return true;
    }
    __device__ __forceinline__ unsigned arow(const GUnit&, int) const { return 0u; }
    __device__ __forceinline__ bool epi(Acc& acc, const GUnit& u, int wr, int wc, int fr, int fq) const {
        if (wc < 2) { float* Lg = (float*)(ws + WS_LOGITS); const int row0 = u.pm * 256 + wr * 64 + fr;
            float rs8[8]; row_rs8(SS, row0, rs8);
#pragma unroll
            for (int ai = 0; ai < 2; ++ai)
#pragma unroll
                for (int m = 0; m < 4; ++m) { const int row = row0 + ai * 128 + m * 16; const float rs = rs8[ai * 4 + m]; float* p = Lg + (size_t)row * 64 + wc * 32 + fq * 8;
                    *(f32x4*)p = acc[ai][0][m][0] * rs; *(f32x4*)(p + 4) = acc[ai][0][m][1] * rs; } }
        return true;
    }
};
__device__ __forceinline__ int moe_expert_of(const int* META, int k, int rb) {
    const int r = rb * 256; int e = 0;
    for (int j = 1; j < 32; ++j) e += (META[16 + 64 * k + j] <= r) ? 1 : 0;
    return __builtin_amdgcn_readfirstlane(e);
}
struct PhUp {
    static constexpr int K = 1024; static constexpr bool GATHER = true;
    unsigned char* ws; const float* SS; const int* META; const int* tok; int G, c;
    __device__ __forceinline__ bool next(int i, GUnit& u) const {
        const int nb0 = __builtin_amdgcn_readfirstlane(META[0]), nb1 = __builtin_amdgcn_readfirstlane(META[1]); const long L = (long)i * G + c; if (L >= 2L * (nb0 + nb1)) return false;
        int blk = (int)(L >> 1); u.pn = (int)(L & 1); int k = 0; if (blk >= nb0) { k = 1; blk -= nb0; }
        const int e = moe_expert_of(META, k, blk);
        u.pm = blk; u.a0 = k; u.a1 = e; u.A = (const char*)ws + WS_XB; u.B = (const char*)ws + WS_WEXP + (size_t)e * 512 * 1024 * 2 + (size_t)u.pn * 256 * K * 2; return true;
    }
    __device__ __forceinline__ unsigned arow(const GUnit& u, int r) const { const int t = tok[u.a0 * LISTCAP + u.pm * 256 + r]; return t < 0 ? 0u : (unsigned)t; }
    __device__ __forceinline__ bool epi(Acc& acc, const GUnit& u, int wr, int wc, int fr, int fq) const {
        const int lr0 = u.a0 * LISTCAP + u.pm * 256 + wr * 64 + fr; bf16_t* HB = (bf16_t*)(ws + WS_HB);
        int tk[8]; float rs8[8];
#pragma unroll
        for (int g = 0; g < 8; ++g) tk[g] = tok[lr0 + (g >> 2) * 128 + (g & 3) * 16];
        PIN8(tk[0], tk[1], tk[2], tk[3], tk[4], tk[5], tk[6], tk[7]);
#pragma unroll
        for (int hh = 0; hh < 4; ++hh) { f32x4 a[2], b[2], c[2], d[2];
#pragma unroll
            for (int g = 0; g < 2; ++g) { const int t = tk[hh * 2 + g]; const f32x4* p = (const f32x4*)(SS + (size_t)(t < 0 ? 0 : t) * 16); a[g] = p[0]; b[g] = p[1]; c[g] = p[2]; d[g] = p[3]; }
#pragma unroll
            for (int g = 0; g < 2; ++g) { const f32x4 tt = (a[g] + b[g]) + (c[g] + d[g]); rs8[hh * 2 + g] = tk[hh * 2 + g] < 0 ? 0.f : rsqrtf(((tt.x + tt.y) + (tt.z + tt.w)) * (1.0f / 1024.0f) + EPS); }
            PIN2(rs8[hh * 2], rs8[hh * 2 + 1]); }
#pragma unroll
        for (int ai = 0; ai < 2; ++ai)
#pragma unroll
            for (int m = 0; m < 4; ++m) { const int lr = lr0 + ai * 128 + m * 16; const float rs = rs8[ai * 4 + m];
#pragma unroll
                for (int bj = 0; bj < 2; ++bj) { const f32x4 g = acc[ai][bj][m][0] * rs, uu = acc[ai][bj][m][1] * rs;
                    f32x4 h = (f32x4){siluf_(g[0]) * uu[0], siluf_(g[1]) * uu[1], siluf_(g[2]) * uu[2], siluf_(g[3]) * uu[3]}; if (ABL == 8) h = (f32x4){1.f, 1.f, 1.f, 1.f};
                    u32x2 w; w.x = cvt_pk_bf16(h[0], h[1]); w.y = cvt_pk_bf16(h[2], h[3]);
                    *(u32x2*)(HB + (size_t)lr * 256 + u.pn * 128 + bj * 64 + wc * 16 + fq * 4) = w; }
                asm volatile("" ::: "memory"); }
        return true;
    }
};
template <int KL> struct PhDown {
    static constexpr int K = 256; static constexpr bool GATHER = false;
    unsigned char* ws; float* SSo; const int* META; const int* tok; const float* wl; int G, c;
    __device__ __forceinline__ bool next(int i, GUnit& u) const {
        const int nb = __builtin_amdgcn_readfirstlane(META[KL]); const long L = (long)i * G + c;
        if (L < 4L * nb) { const int blk = (int)(L >> 2); u.pn = (int)(L & 3); const int e = moe_expert_of(META, KL, blk); u.pm = blk; u.a0 = 0; u.a1 = e;
            u.A = (const char*)ws + WS_HB + (size_t)(KL * LISTCAP + blk * 256) * 256 * 2; u.B = (const char*)ws + WS_WEXP + 32ull * 512 * 1024 * 2 + (size_t)e * 1024 * 256 * 2 + (size_t)u.pn * 256 * K * 2; return true; }
        if (KL == 1) { const long L2 = L - 4L * nb; if (L2 >= 128 * 4) return false;
            pg8::tile_order((int)L2, 128, 4, u.pm, u.pn); u.a0 = 1; u.a1 = 0;
            u.A = (const char*)ws + WS_PBF + (size_t)u.pm * 256 * K * 2; u.B = (const char*)ws + WS_WPP + (size_t)u.pn * 256 * K * 2; return true; }
        return false;
    }
    __device__ __forceinline__ unsigned arow(const GUnit&, int) const { return 0u; }
    __device__ __forceinline__ bool epi(Acc& acc, const GUnit& u, int wr, int wc, int fr, int fq) const {
        const int col0 = u.pn * 256 + wc * 32 + fq * 8;
        if (KL == 1 && u.a0 == 1) {
            bf16_t* PE = (bf16_t*)(ws + WS_PE); const int row0 = u.pm * 256 + wr * 64 + fr;
#pragma unroll
            for (int ai = 0; ai < 2; ++ai)
#pragma unroll
                for (int m = 0; m < 4; ++m)
#pragma unroll
                    for (int bj = 0; bj < 2; ++bj) *(u32x4*)(PE + (size_t)(row0 + ai * 128 + m * 16) * 1024 + col0 + bj * 128) = pack8(acc[ai][bj][m][0], acc[ai][bj][m][1]);
            return true;
        }
        const int lr0 = KL * LISTCAP + u.pm * 256 + wr * 64 + fr; bf16_t* YB = (bf16_t*)(ws + WS_YB1); bf16_t* XB = (bf16_t*)(ws + WS_XB);
        int tk[8]; float wk[8];
#pragma unroll
        for (int g = 0; g < 8; ++g) { const int lr = lr0 + (g >> 2) * 128 + (g & 3) * 16; tk[g] = tok[lr]; wk[g] = wl[lr]; }
        PIN8(tk[0], tk[1], tk[2], tk[3], tk[4], tk[5], tk[6], tk[7]); PIN8(wk[0], wk[1], wk[2], wk[3], wk[4], wk[5], wk[6], wk[7]);
#pragma unroll
        for (int ai = 0; ai < 2; ++ai)
#pragma unroll
            for (int m = 0; m < 4; ++m) { const int t = tk[ai * 4 + m]; const float w = wk[ai * 4 + m]; const size_t off = (size_t)(t < 0 ? 0 : t) * 1024 + col0;
                if (KL == 1) { if (t >= 0) {
#pragma unroll
                        for (int bj = 0; bj < 2; ++bj) *(u32x4*)(YB + off + bj * 128) = pack8(acc[ai][bj][m][0] * w, acc[ai][bj][m][1] * w); } }
                else { float ss = 0.f;
                    if (t >= 0) {
                        u32x4 xr[2], yr[2];
#pragma unroll
                        for (int bj = 0; bj < 2; ++bj) { xr[bj] = *(const u32x4*)(XB + off + bj * 128); yr[bj] = *(const u32x4*)(YB + off + bj * 128); }
                        PIN4(xr[0], xr[1], yr[0], yr[1]);
#pragma unroll
                        for (int bj = 0; bj < 2; ++bj) { f32x4 x0, x1, y0, y1; unpack8(xr[bj], x0, x1); unpack8(yr[bj], y0, y1);
                            ss += store_x8(XB + off + bj * 128, (x0 + y0) + acc[ai][bj][m][0] * w, (x1 + y1) + acc[ai][bj][m][1] * w); } }
                    ss += __shfl_xor(ss, 16); ss += __shfl_xor(ss, 32);
                    if (fq == 0 && t >= 0) SSo[(size_t)t * 16 + u.pn * 4 + wc] = ss; }
                if (m & 1) asm volatile("" ::: "memory"); }
        return true;
    }
};
struct PhPle {
    static constexpr int K = 1024; static constexpr bool GATHER = false;
    unsigned char* ws; const float* SSi; float* SSo; int G, c;
    __device__ __forceinline__ bool next(int i, GUnit& u) const {
        const long L = (long)i * G + c; if (L >= 128 * 4) return false;
        pg8::tile_order((int)L, 128, 4, u.pm, u.pn);
        u.A = (const char*)ws + WS_XB + (size_t)u.pm * 256 * K * 2; u.B = (const char*)ws + WS_WPG + (size_t)u.pn * 256 * K * 2; u.a0 = 0; u.a1 = 0; return true;
    }
    __device__ __forceinline__ unsigned arow(const GUnit&, int) const { return 0u; }
    __device__ __forceinline__ bool epi(Acc& acc, const GUnit& u, int wr, int wc, int fr, int fq) const {
        const int row0 = u.pm * 256 + wr * 64 + fr; const int col0 = u.pn * 256 + wc * 32 + fq * 8; bf16_t* XT = (bf16_t*)(ws + WS_XBT); const bf16_t* PE = (const bf16_t*)(ws + WS_PE); const bf16_t* XBc = (const bf16_t*)(ws + WS_XB);
        float rs8[8]; row_rs8(SSi, row0, rs8);
#pragma unroll
        for (int ai = 0; ai < 2; ++ai)
#pragma unroll
            for (int m = 0; m < 4; ++m) { const int row = row0 + ai * 128 + m * 16; const size_t off = (size_t)row * 1024 + col0; const float rs = rs8[ai * 4 + m]; float ss = 0.f;
                u32x4 xr[2], pr[2];
#pragma unroll
                for (int bj = 0; bj < 2; ++bj) { xr[bj] = *(const u32x4*)(XBc + off + bj * 128); pr[bj] = *(const u32x4*)(PE + off + bj * 128); }
                PIN4(xr[0], xr[1], pr[0], pr[1]);
#pragma unroll
                for (int bj = 0; bj < 2; ++bj) { f32x4 p0, p1, x0, x1; unpack8(pr[bj], p0, p1); unpack8(xr[bj], x0, x1);
                    ss += store_x8(XT + off + bj * 128, x0 + sig4(acc[ai][bj][m][0] * rs) * p0, x1 + sig4(acc[ai][bj][m][1] * rs) * p1); }
                ss += __shfl_xor(ss, 16); ss += __shfl_xor(ss, 32);
                if (fq == 0) SSo[(size_t)row * 16 + u.pn * 4 + wc] = ss; }
        return true;
    }
};

struct InPtrs { const float* const* p; __device__ __forceinline__ const float* operator[](int i) const { return (const float*)(GAS const float*)p[i]; } };
struct Ctx {
    InPtrs in; float* out; unsigned char* ws; LAS unsigned char* lds;
    int tid, lane, wave, G, bid;
};
enum { I_X = 0, I_P, I_GMIX, I_WIN, I_CONVW, I_CONVB, I_CLNG, I_CLNB, I_MCW, I_MCB, I_MIB, I_MFB, I_WBA, I_WBC, I_WBM, I_WOUT, I_GFFN, I_WRG, I_BRG, I_WRE, I_BRE,
       I_WEG, I_WEU, I_WED, I_GPLE, I_WPG, I_WPP, I_GFIN };

constexpr int TR_LDS = 64 * 65 * 4;
template <bool GAIN>
__device__ __forceinline__ void tr_item64(const float* colptr4, size_t pitch, const float* gainp, float cscale, bf16_t* dst, int K, int n0, int k0, LAS float* scr, int lane, const float* gain_or_valid) {
    const float* gain = GAIN ? gainp : nullptr;
    const int g = lane & 15, r = lane >> 4;
    f32x4 v[16]; float gs[16];
    const float* cp = colptr4 ? colptr4 : gain_or_valid;
#pragma unroll
    for (int i = 0; i < 16; ++i) { const int kk = 4 * i + r; v[i] = *(const f32x4*)(cp + (colptr4 ? (size_t)(k0 + kk) * pitch : 0)); gs[i] = gain ? gain[k0 + kk] : 1.0f; }
    PIN8(v[0], v[1], v[2], v[3], v[4], v[5], v[6], v[7]); PIN8(v[8], v[9], v[10], v[11], v[12], v[13], v[14], v[15]);
    const float zs = colptr4 ? cscale : 0.f;
#pragma unroll
    for (int i = 0; i < 16; ++i) { const int kk = 4 * i + r; const float m = gs[i] * zs; LAS float* p = scr + kk * 65 + 4 * g; p[0] = v[i].x * m; p[1] = v[i].y * m; p[2] = v[i].z * m; p[3] = v[i].w * m; }
    LDS_WAIT(); asm volatile("" ::: "memory");
    const int c = lane & 7, n8 = lane >> 3;
#pragma unroll
    for (int j = 0; j < 8; ++j) { const int n = n8 + 8 * j; const LAS float* sp = scr + (8 * c) * 65 + n;
        u32x4 o; o.x = pk2(sp[0 * 65], sp[1 * 65]); o.y = pk2(sp[2 * 65], sp[3 * 65]); o.z = pk2(sp[4 * 65], sp[5 * 65]); o.w = pk2(sp[6 * 65], sp[7 * 65]);
        *(u32x4*)(dst + (size_t)(n0 + n) * K + k0 + 8 * c) = o; }
    LDS_WAIT(); asm volatile("" ::: "memory");
}
__device__ __forceinline__ void phase_prep(const Ctx& F, int layer, float* SS) {
    const int gw = F.bid * NWAVES + F.wave, NGW = F.G * NWAVES, lane = F.lane;
    LAS float* scr = (LAS float*)(F.lds + F.wave * TR_LDS);
    bf16_t* XB = (bf16_t*)(F.ws + WS_XB);
    if (layer == 0) {
        for (int m0 = gw; m0 < T; m0 += 4 * NGW) {
            f32x4 v[4][4];
#pragma unroll
            for (int r = 0; r < 4; ++r) { const f32x4* xr = (const f32x4*)(F.in[I_X] + (size_t)(m0 + r * NGW) * D) + lane;
#pragma unroll
                for (int j = 0; j < 4; ++j) v[r][j] = xr[64 * j]; }
            PIN8(v[0][0], v[0][1], v[0][2], v[0][3], v[1][0], v[1][1], v[1][2], v[1][3]); PIN8(v[2][0], v[2][1], v[2][2], v[2][3], v[3][0], v[3][1], v[3][2], v[3][3]);
#pragma unroll
            for (int r = 0; r < 4; ++r) { const int m = m0 + r * NGW; u32x2* xbr = (u32x2*)(XB + (size_t)m * D) + lane; float sq = 0.f;
#pragma unroll
                for (int j = 0; j < 4; ++j) { const f32x4 x = v[r][j]; sq += (x.x * x.x + x.y * x.y) + (x.z * x.z + x.w * x.w); u32x2 w; w.x = cvt_pk_bf16(x.x, x.y); w.y = cvt_pk_bf16(x.z, x.w); xbr[64 * j] = w; }
                sq = wave_sum(sq);
                if (lane < 16) SS[(size_t)m * 16 + lane] = lane == 0 ? sq : 0.f; }
        }
    } else {
        const u32x4* src = (const u32x4*)(F.ws + WS_XBT); u32x4* dst = (u32x4*)(F.ws + WS_XB);
        const size_t n = (size_t)T * D * 2 / 16, st = (size_t)F.G * NTHREADS;
        for (size_t i0 = (size_t)F.bid * NTHREADS + F.tid; i0 < n; i0 += 8 * st) { u32x4 v[8];
#pragma unroll
            for (int k = 0; k < 8; ++k) { const size_t i = i0 + k * st; v[k] = src[i < n ? i : 0]; }
            PIN8(v[0], v[1], v[2], v[3], v[4], v[5], v[6], v[7]);
#pragma unroll
            for (int k = 0; k < 8; ++k) { const size_t i = i0 + k * st; if (i < n) dst[i] = v[k]; } }
    }
    const float* w_in = F.in[I_WIN] + (size_t)layer * D * D_IN; const float* g_mix = F.in[I_GMIX] + (size_t)layer * D;
    constexpr int N_WIN = 140 * 16, N_BR = 16 * 8, N_SQ = 16 * 16, N_PP = 16 * 4, N_R = 4 * 16;
    constexpr int NITEMS = N_WIN + 3 * N_BR + 2 * N_SQ + N_PP + N_R;
    const int g4 = 4 * (lane & 15);
    for (int it = gw; it < NITEMS; it += NGW) {
        int r = it;
        if (r < N_WIN) { const int nb = r >> 4, kb = r & 15; const int n = nb * 64 + g4; int src = -1; float cs = 1.f;
            if (n < 2560) { src = n; if (n < 1536) cs = 0.125f * 1.4426950408889634f; }
            else if (n < 3584) { const int np = n - 2560, q8 = np >> 3, sg = (np >> 2) & 1; src = 2560 + sg * 512 + 4 * q8; }
            else if (n < 5640) src = n;
            else if (n < 5888) src = -1;
            else src = 5640 + (n - 5888);
            tr_item64<true>(src >= 0 ? w_in + src : nullptr, D_IN, g_mix, cs, (bf16_t*)(F.ws + WS_WIN), 1024, nb * 64, kb * 64, scr, lane, g_mix); continue; }
        r -= N_WIN;
        if (r < 3 * N_BR) { const int b = r / N_BR; r -= b * N_BR; const int nb = r >> 3, kb = r & 7; const int n = nb * 64 + g4;
            const float* w = (b == 0 ? F.in[I_WBA] : (b == 1 ? F.in[I_WBC] : F.in[I_WBM])) + (size_t)layer * 512 * 1024;
            tr_item64<false>(w + n, 1024, nullptr, 1.f, (bf16_t*)(F.ws + WS_WBR) + (size_t)b * 1024 * 512, 512, nb * 64, kb * 64, scr, lane, g_mix); continue; }
        r -= 3 * N_BR;
        if (r < 2 * N_SQ) { const int b = r / N_SQ; r -= b * N_SQ; const int nb = r >> 4, kb = r & 15; const int n = nb * 64 + g4;
            const float* w = (b == 0 ? F.in[I_WOUT] : F.in[I_WPG]) + (size_t)layer * 1024 * 1024;
            if (b == 0) tr_item64<false>(w + n, 1024, nullptr, 1.f, (bf16_t*)(F.ws + WS_WOUT), 1024, nb * 64, kb * 64, scr, lane, g_mix);
            else tr_item64<true>(w + n, 1024, F.in[I_GPLE] + (size_t)layer * D, 1.f, (bf16_t*)(F.ws + WS_WPG), 1024, nb * 64, kb * 64, scr, lane, g_mix);
            continue; }
        r -= 2 * N_SQ;
        if (r < N_PP) { const int nb = r >> 2, kb = r & 3; const int n = nb * 64 + g4;
            tr_item64<false>(F.in[I_WPP] + (size_t)layer * 256 * 1024 + n, 1024, nullptr, 1.f, (bf16_t*)(F.ws + WS_WPP), 256, nb * 64, kb * 64, scr, lane, g_mix); continue; }
        r -= N_PP;
        { const int nb = r >> 4, kb = r & 15; const int n = nb * 64 + g4; const float* cp = nullptr; size_t pitch = 4;
            if (n < 4) { cp = F.in[I_WRG] + (size_t)layer * 1024 * 4 + n; pitch = 4; } else if (n < 36) { cp = F.in[I_WRE] + (size_t)layer * 1024 * 32 + (n - 4); pitch = 32; }
            tr_item64<true>(cp, pitch, F.in[I_GFFN] + (size_t)layer * D, 1.f, (bf16_t*)(F.ws + WS_WR), 1024, nb * 64, kb * 64, scr, lane, g_mix); }
    }
}
__device__ __forceinline__ void phase_prep_experts(const Ctx& F, int layer) {
    const int gw = F.bid * NWAVES + F.wave, NGW = F.G * NWAVES, lane = F.lane;
    LAS float* scr = (LAS float*)(F.lds + F.wave * TR_LDS);
    const float* g_ffn = F.in[I_GFFN] + (size_t)layer * D;
    constexpr int N_UP = 32 * 8 * 16, N_DN = 32 * 16 * 4;
    const int g4 = 4 * (lane & 15);
    for (int it = gw; it < N_UP + N_DN; it += NGW) {
        int r = it;
        if (r < N_UP) { const int e = r >> 7; r &= 127; const int nb = r >> 4, kb = r & 15; const int n = nb * 64 + g4; const int q8 = n >> 3, sg = (n >> 2) & 1;
            const float* w = (sg ? F.in[I_WEU] : F.in[I_WEG]) + ((size_t)layer * 32 + e) * 1024 * 256 + 4 * q8;
            tr_item64<true>(w, 256, g_ffn, 1.f, (bf16_t*)(F.ws + WS_WEXP) + (size_t)e * 512 * 1024, 1024, nb * 64, kb * 64, scr, lane, g_ffn); continue; }
        r -= N_UP;
        { const int e = r >> 6; r &= 63; const int nb = r >> 2, kb = r & 3; const int n = nb * 64 + g4;
            const float* w = F.in[I_WED] + ((size_t)layer * 32 + e) * 256 * 1024 + n;
            tr_item64<false>(w, 1024, nullptr, 1.f, (bf16_t*)(F.ws + WS_WEXP) + 32ull * 512 * 1024 + (size_t)e * 1024 * 256, 256, nb * 64, kb * 64, scr, lane, g_ffn); }
    }
    const f32x4* p = (const f32x4*)(F.in[I_P] + (size_t)layer * T * 256); u32x2* pb = (u32x2*)(F.ws + WS_PBF);
    { const size_t n = (size_t)T * 256 / 4, st = (size_t)F.G * NTHREADS;
        for (size_t i0 = (size_t)F.bid * NTHREADS + F.tid; i0 < n; i0 += 8 * st) { f32x4 v[8];
#pragma unroll
            for (int k = 0; k < 8; ++k) { const size_t i = i0 + k * st; v[k] = p[i < n ? i : 0]; }
            PIN8(v[0], v[1], v[2], v[3], v[4], v[5], v[6], v[7]);
#pragma unroll
            for (int k = 0; k < 8; ++k) { const size_t i = i0 + k * st; if (i < n) { u32x2 w; w.x = cvt_pk_bf16(v[k].x, v[k].y); w.y = cvt_pk_bf16(v[k].z, v[k].w); pb[i] = w; } } } }
}

constexpr int AK_RS = 144, AV_RS = 160, AV_OFF = 2 * 128 * AK_RS;
typedef short s16x4 __attribute__((ext_vector_type(4)));
__device__ __forceinline__ s16x4 lds_tr16(LAS unsigned char* p) { return __builtin_amdgcn_ds_read_tr16_b64_v4i16((LAS s16x4*)p); }
__device__ __forceinline__ void attn_strip(const Ctx& F, int strip) {
    const int bs = strip / 48, sg = strip - bs * 48, b = bs >> 3, slot = bs & 7;
    int g, r, nb0;
    if (sg < 16) { g = 0; r = 0; nb0 = sg * 8; } else if (sg < 32) { g = 1; r = (sg - 16) >> 2; nb0 = ((sg - 16) & 3) * 8; } else { g = 2; r = sg - 32; nb0 = 0; }
    const int dl = 1 << (2 * g); const float slope = exp2f(-(float)(g * 8 + slot + 1) * (1.0f / 3.0f)) * (float)dl * 1.4426950408889634f;
    bf16_t* Qg = (bf16_t*)(F.ws + (g == 0 ? WS_QA0 : (g == 1 ? WS_QA1 : WS_QA2))) + slot * 64;
    const bf16_t* Kg = (const bf16_t*)(F.ws + WS_KA) + slot * 64; const bf16_t* Vg = (const bf16_t*)(F.ws + WS_VA) + slot * 64;
    float* LSE = (float*)(F.ws + WS_LOGITS) + (size_t)g * T * 8 + slot;
    const size_t tok0 = (size_t)b * SEQ + r;
    LAS unsigned char* Kl = F.lds; LAS unsigned char* Vl = F.lds + AV_OFF;
    const int tid = F.tid, lane = F.lane, w = F.wave, fr = lane & 15, fq = lane >> 4;
    const int srow = tid >> 2, sc4 = tid & 3;
    u32x4 kx[2], vx[2];
#define ATT_LOAD(blk) do { const size_t _t = (tok0 + (size_t)((blk) * 128 + srow) * dl) * 512; \
        kx[0] = *(const u32x4*)(Kg + _t + sc4 * 8); kx[1] = *(const u32x4*)(Kg + _t + 32 + sc4 * 8); vx[0] = *(const u32x4*)(Vg + _t + sc4 * 8); vx[1] = *(const u32x4*)(Vg + _t + 32 + sc4 * 8); } while (0)
#define ATT_STORE(blk) do { const int _p = (((blk) & 1) * 128 + srow); \
        *(LAS u32x4*)(Kl + _p * AK_RS + sc4 * 16) = kx[0]; *(LAS u32x4*)(Kl + _p * AK_RS + 64 + sc4 * 16) = kx[1]; *(LAS u32x4*)(Vl + _p * AV_RS + sc4 * 16) = vx[0]; *(LAS u32x4*)(Vl + _p * AV_RS + 64 + sc4 * 16) = vx[1]; } while (0)
    __syncthreads();
    if (nb0 > 0) { ATT_LOAD(nb0 - 1); ATT_STORE(nb0 - 1); }
    else { kx[0] = kx[1] = vx[0] = vx[1] = (u32x4){0u, 0u, 0u, 0u}; ATT_STORE(1); }
    ATT_LOAD(nb0); ATT_STORE(nb0);
    bf16x8 qn0, qn1;
    { const size_t qo = (tok0 + (size_t)(nb0 * 128 + 16 * w + fr) * dl) * 512; qn0 = *(const bf16x8*)(Qg + qo + fq * 8); qn1 = *(const bf16x8*)(Qg + qo + 32 + fq * 8); }
    __syncthreads();
    for (int nb = nb0; nb < nb0 + 8; ++nb) {
        const bool more = nb + 1 < nb0 + 8;
        if (more) ATT_LOAD(nb + 1);
        const size_t qoff = (tok0 + (size_t)(nb * 128 + 16 * w + fr) * dl) * 512;
        const bf16x8 q0 = qn0, q1 = qn1;
        if (more) { const size_t qo2 = qoff + (size_t)128 * dl * 512; qn0 = *(const bf16x8*)(Qg + qo2 + fq * 8); qn1 = *(const bf16x8*)(Qg + qo2 + 32 + fq * 8); }
        const int pslot = (nb - 1) & 1;
        f32x4 S[10];
        S[9] = (f32x4){0.f, 0.f, 0.f, 0.f};
#pragma unroll
        for (int kbi = 0; kbi < 9; ++kbi) {
            int kb = w + kbi; if (kb > 15) kb = 15;
            const int ki = kb * 16 + fr; const int phys = ((pslot + (ki >> 7)) & 1) * 128 + (ki & 127);
            const bf16x8 k0 = *(const LAS bf16x8*)(Kl + phys * AK_RS + fq * 16), k1 = *(const LAS bf16x8*)(Kl + phys * AK_RS + 64 + fq * 16);
            f32x4 a = (f32x4){0.f, 0.f, 0.f, 0.f};
            a = __builtin_amdgcn_mfma_f32_16x16x32_bf16(k0, q0, a, 0, 0, 0);
            S[kbi] = __builtin_amdgcn_mfma_f32_16x16x32_bf16(k1, q1, a, 0, 0, 0);
        }
        float mx = -INFINITY;
        const int dbase = fr - 4 * fq + 128; const float fb = slope * (float)dbase; const int kmin = (nb > 0) ? 0 : 128 - (16 * w + 4 * fq);
#pragma unroll
        for (int kbi = 0; kbi < 9; ++kbi)
#pragma unroll
            for (int j = 0; j < 4; ++j) { const int cj = 16 * kbi + j;
                const bool ok = (unsigned)(dbase - cj) <= 128u && cj >= kmin;
                const float sc = ok ? __builtin_fmaf(slope, (float)cj, S[kbi][j] - fb) : -INFINITY; S[kbi][j] = sc; mx = fmaxf(mx, sc); }
        mx = fmaxf(mx, __shfl_xor(mx, 16)); mx = fmaxf(mx, __shfl_xor(mx, 32));
        float ls = 0.f;
#pragma unroll
        for (int kbi = 0; kbi < 9; ++kbi)
#pragma unroll
            for (int j = 0; j < 4; ++j) { const float p = __builtin_amdgcn_exp2f(S[kbi][j] - mx); S[kbi][j] = p; ls += p; }
        ls += __shfl_xor(ls, 16); ls += __shfl_xor(ls, 32);
        f32x4 O[4];
#pragma unroll
        for (int db = 0; db < 4; ++db) O[db] = (f32x4){0.f, 0.f, 0.f, 0.f};
#pragma unroll
        for (int k2 = 0; k2 < 5; ++k2) {
            u32x4 pw; pw.x = cvt_pk_bf16(S[2 * k2][0], S[2 * k2][1]); pw.y = cvt_pk_bf16(S[2 * k2][2], S[2 * k2][3]); pw.z = cvt_pk_bf16(S[2 * k2 + 1][0], S[2 * k2 + 1][1]); pw.w = cvt_pk_bf16(S[2 * k2 + 1][2], S[2 * k2 + 1][3]);
            const bf16x8 pf = __builtin_bit_cast(bf16x8, pw);
            int kb0 = w + 2 * k2, kb1 = kb0 + 1; if (kb1 > 15) kb1 = 15; if (kb0 > 15) kb0 = 15;
            const int r0 = kb0 * 16 + 4 * fq + (fr >> 2), r1 = kb1 * 16 + 4 * fq + (fr >> 2);
            const int p0 = ((pslot + (r0 >> 7)) & 1) * 128 + (r0 & 127), p1 = ((pslot + (r1 >> 7)) & 1) * 128 + (r1 & 127);
#pragma unroll
            for (int db = 0; db < 4; ++db) {
                const s16x4 v0 = lds_tr16(Vl + p0 * AV_RS + (db * 16 + 4 * (fr & 3)) * 2), v1 = lds_tr16(Vl + p1 * AV_RS + (db * 16 + 4 * (fr & 3)) * 2);
                const bf16x8 vf = (bf16x8){v0[0], v0[1], v0[2], v0[3], v1[0], v1[1], v1[2], v1[3]};
                O[db] = __builtin_amdgcn_mfma_f32_16x16x32_bf16(vf, pf, O[db], 0, 0, 0);
            }
        }
        const float inv = 1.0f / ls;
#pragma unroll
        for (int db = 0; db < 4; ++db) { u32x2 ow; ow.x = cvt_pk_bf16(O[db][0] * inv, O[db][1] * inv); ow.y = cvt_pk_bf16(O[db][2] * inv, O[db][3] * inv);
            *(u32x2*)(Qg + qoff + db * 16 + 4 * fq) = ow; }
        if (fq == 0) LSE[(qoff >> 9) * 8] = mx + __builtin_amdgcn_logf(ls);
        __syncthreads();
        if (more) ATT_STORE(nb + 1);
        __syncthreads();
    }
#undef ATT_LOAD
#undef ATT_STORE
}
__device__ __forceinline__ void attn_combine(const Ctx& F) {
    const float* LSE = (const float*)(F.ws + WS_LOGITS);
    for (int i0 = F.bid * NTHREADS + F.tid; i0 < T * 64; i0 += 4 * F.G * NTHREADS) {
        u32x4 a[4], bb[4], cc[4]; float l0[4], l1[4], l2[4];
#pragma unroll
        for (int k = 0; k < 4; ++k) { const int i = i0 + k * F.G * NTHREADS; const int ic = i < T * 64 ? i : 0; const int t = ic >> 6, slot = (ic & 63) >> 3;
            a[k] = ((const u32x4*)(F.ws + WS_QA0))[ic]; bb[k] = ((const u32x4*)(F.ws + WS_QA1))[ic]; cc[k] = ((const u32x4*)(F.ws + WS_QA2))[ic];
            l0[k] = LSE[(size_t)t * 8 + slot]; l1[k] = LSE[(size_t)T * 8 + (size_t)t * 8 + slot]; l2[k] = LSE[(size_t)2 * T * 8 + (size_t)t * 8 + slot]; }
        PIN4(a[0], a[1], a[2], a[3]); PIN4(bb[0], bb[1], bb[2], bb[3]); PIN4(cc[0], cc[1], cc[2], cc[3]);
#pragma unroll
        for (int k = 0; k < 4; ++k) { const int i = i0 + k * F.G * NTHREADS; if (i < T * 64) {
            const float m = fmaxf(l0[k], fmaxf(l1[k], l2[k])); float w0 = __builtin_amdgcn_exp2f(l0[k] - m), w1 = __builtin_amdgcn_exp2f(l1[k] - m), w2 = __builtin_amdgcn_exp2f(l2[k] - m); const float inv = __builtin_amdgcn_rcpf(w0 + w1 + w2); w0 *= inv; w1 *= inv; w2 *= inv;
            f32x4 a0, a1, b0, b1, c0, c1; unpack8(a[k], a0, a1); unpack8(bb[k], b0, b1); unpack8(cc[k], c0, c1);
            ((u32x4*)(F.ws + WS_QA0))[i] = pack8(a0 * w0 + b0 * w1 + c0 * w2, a1 * w0 + b1 * w1 + c1 * w2); } }
    }
}

__device__ __forceinline__ void conv_item(const Ctx& F, int layer, int item) {
    const int t0 = item * 32, s0 = t0 & (SEQ - 1), tid = F.tid;
    LAS bf16_t* sin = (LAS bf16_t*)F.lds;
    LAS float* sout = (LAS float*)(F.lds + 65536);
    const bf16_t* YG = (const bf16_t*)(F.ws + WS_YG);
    __syncthreads();
#pragma unroll 1
    for (int kb = 0; kb < 2; ++kb) { u32x4 sv[4];
#pragma unroll
        for (int k = 0; k < 4; ++k) { const int i = tid + (kb * 4 + k) * NTHREADS; const int r = i < 62 * 64 ? (i >> 6) : 0, c8 = i & 63; const int sp = s0 - 30 + r;
            sv[k] = *(const u32x4*)(YG + (size_t)(sp >= 0 ? t0 - 30 + r : t0) * 512 + c8 * 8); }
        PIN4(sv[0], sv[1], sv[2], sv[3]);
#pragma unroll
        for (int k = 0; k < 4; ++k) { const int i = tid + (kb * 4 + k) * NTHREADS; const int r = i >> 6, c8 = i & 63; const int sp = s0 - 30 + r;
            if (i < 62 * 64) *(LAS u32x4*)(sin + r * 512 + c8 * 8) = sp >= 0 ? sv[k] : (u32x4){0u, 0u, 0u, 0u}; } }
    const int cp = tid & 255, hf = tid >> 8;
    f32x2 w[31];
    const float* cw = F.in[I_CONVW] + (size_t)layer * 31 * 512 + 2 * cp;
#pragma unroll
    for (int k = 0; k < 31; ++k) w[k] = *(const f32x2*)(cw + k * 512);
    const f32x2 cb = *(const f32x2*)(F.in[I_CONVB] + layer * 512 + 2 * cp);
    __syncthreads();
#pragma unroll 1
    for (int ps = 0; ps < 2; ++ps) { const int tb = 16 * hf + 8 * ps;
        f32x2 xin[38];
#pragma unroll
        for (int r = 0; r < 38; ++r) { const unsigned u = *(const LAS unsigned*)(sin + (tb + r) * 512 + 2 * cp); xin[r] = (f32x2){bf_lo(u), bf_hi(u)}; }
#pragma unroll
        for (int tt = 0; tt < 8; ++tt) { f32x2 a = cb;
#pragma unroll
            for (int k = 0; k < 31; ++k) a += w[k] * xin[tt + k];
            *(LAS f32x2*)(sout + (tb + tt) * 512 + 2 * cp) = a; } }
    __syncthreads();
    const float* lg = F.in[I_CLNG] + layer * 512 + F.lane * 8; const float* lb = F.in[I_CLNB] + layer * 512 + F.lane * 8;
    for (int tt = F.wave; tt < 32; tt += NWAVES) {
        float v[8]; float sm = 0.f;
#pragma unroll
        for (int j = 0; j < 8; ++j) { v[j] = sout[tt * 512 + F.lane * 8 + j]; sm += v[j]; }
        const float mu = wave_sum(sm) * (1.0f / 512.0f); float q = 0.f;
#pragma unroll
        for (int j = 0; j < 8; ++j) { v[j] -= mu; q += v[j] * v[j]; }
        const float rstd = rsqrtf(wave_sum(q) * (1.0f / 512.0f) + EPS);
        float o[8];
#pragma unroll
        for (int j = 0; j < 8; ++j) o[j] = siluf_(v[j] * rstd * lg[j] + lb[j]);
        u32x4 wv; wv.x = cvt_pk_bf16(o[0], o[1]); wv.y = cvt_pk_bf16(o[2], o[3]); wv.z = cvt_pk_bf16(o[4], o[5]); wv.w = cvt_pk_bf16(o[6], o[7]);
        *(u32x4*)((bf16_t*)(F.ws + WS_YC) + (size_t)(t0 + tt) * 512 + F.lane * 8) = wv;
    }
}

__device__ __forceinline__ float log_sigmoid_(float v) { return fminf(v, 0.f) - log1pf(__expf(-fabsf(v))); }
struct QkW { float w[4][8]; float b[8]; };
__device__ __forceinline__ void qk_load_w(const Ctx& F, int layer, int chq, QkW& W) {
    const float* cw = F.in[I_MCW] + (size_t)layer * 4 * 1024 + chq; const float* cb = F.in[I_MCB] + (size_t)layer * 1024 + chq;
#pragma unroll
    for (int k = 0; k < 4; ++k) { const f32x4 a = *(const f32x4*)(cw + k * 1024), b = *(const f32x4*)(cw + k * 1024 + 4); W.w[k][0] = a.x; W.w[k][1] = a.y; W.w[k][2] = a.z; W.w[k][3] = a.w; W.w[k][4] = b.x; W.w[k][5] = b.y; W.w[k][6] = b.z; W.w[k][7] = b.w; }
    const f32x4 a = *(const f32x4*)cb, b = *(const f32x4*)(cb + 4); W.b[0] = a.x; W.b[1] = a.y; W.b[2] = a.z; W.b[3] = a.w; W.b[4] = b.x; W.b[5] = b.y; W.b[6] = b.z; W.b[7] = b.w;
}
__device__ __forceinline__ void qk_conv8(const QkW& W, const bf16_t* src  , int t, int s, int ch  , float scale, float* o) {
#pragma unroll
    for (int j = 0; j < 8; ++j) o[j] = W.b[j];
#pragma unroll
    for (int k = 0; k < 4; ++k) { const bool ok = s - 3 + k >= 0; u32x4 w = *(const u32x4*)(src + (size_t)(ok ? t - 3 + k : t) * 512 + ch);
            if (!ok) w = (u32x4){0u, 0u, 0u, 0u};
            o[0] += W.w[k][0] * bf_lo(w.x); o[1] += W.w[k][1] * bf_hi(w.x); o[2] += W.w[k][2] * bf_lo(w.y); o[3] += W.w[k][3] * bf_hi(w.y); o[4] += W.w[k][4] * bf_lo(w.z); o[5] += W.w[k][5] * bf_hi(w.z); o[6] += W.w[k][6] * bf_lo(w.w); o[7] += W.w[k][7] * bf_hi(w.w); }
#pragma unroll
    for (int j = 0; j < 8; ++j) o[j] = siluf_(o[j]) * scale;
}
__device__ __forceinline__ void qk_conv8r(const QkW& W, const u32x4 (&rw)[4], int s, float scale, float* o) {
#pragma unroll
    for (int j = 0; j < 8; ++j) o[j] = W.b[j];
#pragma unroll
    for (int k = 0; k < 4; ++k) { u32x4 w = rw[k]; if (s - 3 + k < 0) w = (u32x4){0u, 0u, 0u, 0u};
        o[0] += W.w[k][0] * bf_lo(w.x); o[1] += W.w[k][1] * bf_hi(w.x); o[2] += W.w[k][2] * bf_lo(w.y); o[3] += W.w[k][3] * bf_hi(w.y); o[4] += W.w[k][4] * bf_lo(w.z); o[5] += W.w[k][5] * bf_hi(w.z); o[6] += W.w[k][6] * bf_lo(w.w); o[7] += W.w[k][7] * bf_hi(w.w); }
#pragma unroll
    for (int j = 0; j < 8; ++j) o[j] = siluf_(o[j]) * scale;
}
__device__ __forceinline__ void mlstm_scalars(const Ctx& F, int layer, int t0, int h, LAS float* sIG, LAS float* sBC) {
    if (F.tid < 128) { const float* IFp = (const float*)(F.ws + WS_IF) + (size_t)(t0 + F.tid) * 8;
        sIG[F.tid] = IFp[h] + F.in[I_MIB][layer * 4 + h]; sBC[F.tid] = log_sigmoid_(IFp[4 + h] + F.in[I_MFB][layer * 4 + h]); }
    __syncthreads();
    if (F.wave == 0) { const float a = sBC[2 * F.lane], bb = sBC[2 * F.lane + 1]; float sc = a + bb;
#pragma unroll
        for (int off = 1; off < 64; off <<= 1) { const float t = __shfl_up(sc, off); if (F.lane >= off) sc += t; }
        sBC[2 * F.lane] = sc - bb; sBC[2 * F.lane + 1] = sc; }
    __syncthreads();
}
constexpr int ML_KRS = 288, ML_ERS = 352, ML_E = 128 * ML_KRS, ML_S = ML_E + 128 * ML_ERS;
__device__ __forceinline__ void mlstm_local_mfma(const Ctx& F, int layer, int item) {
    const int c = item & 127, bh = item >> 7, h = bh & 3, b = bh >> 2, t0 = b * SEQ + c * 128, tid = F.tid, lane = F.lane, w = F.wave, fr = lane & 15, fq = lane >> 4;
    LAS unsigned char* L = F.lds;
    LAS float* sIG = (LAS float*)(L + ML_S); LAS float* sBC = sIG + 128; LAS float* sE = sIG + 256; LAS float* sM = sIG + 384;
    __syncthreads();
    mlstm_scalars(F, layer, t0, h, sIG, sBC);
    if (w == 0) { const float gt = sBC[127]; const float m = wave_max(fmaxf(gt - sBC[lane] + sIG[lane], gt - sBC[lane + 64] + sIG[lane + 64])); if (lane == 0) { sM[0] = m; sM[1] = gt; } }
    __syncthreads();
    if (tid < 128) sE[tid] = __expf(sM[1] - sBC[tid] + sIG[tid] - sM[0]);
    __syncthreads();
    const bf16_t* KM = (const bf16_t*)(F.ws + WS_KM); const bf16_t* VM = (const bf16_t*)(F.ws + WS_VM);
    QkW WK; qk_load_w(F, layer, 512 + h * 128 + (tid & 15) * 8, WK);
#pragma unroll 1
    for (int i = tid; i < 128 * 16; i += NTHREADS) { const int l = i >> 4, c8 = (i & 15) * 8; const int t = t0 + l, s = t & (SEQ - 1);
        u32x4 rk[4];
#pragma unroll
        for (int k = 0; k < 4; ++k) rk[k] = *(const u32x4*)(KM + (size_t)(s - 3 + k >= 0 ? t - 3 + k : t) * 512 + h * 128 + c8);
        const u32x4 rv = *(const u32x4*)(VM + (size_t)t * 512 + h * 128 + c8);
        float o[8]; qk_conv8r(WK, rk, s, 0.08838834764831845f, o);
        *(LAS u32x4*)(L + l * ML_KRS + c8 * 2) = pack8((f32x4){o[0], o[1], o[2], o[3]}, (f32x4){o[4], o[5], o[6], o[7]});
        f32x4 v0, v1; unpack8(rv, v0, v1); const float e = sE[l];
        *(LAS u32x4*)(L + ML_E + l * ML_ERS + c8 * 2) = pack8(v0 * e, v1 * e); }
    if (tid < 128) { unsigned zr = 0u; asm volatile("" : "+v"(zr));
        u32x4 z; z.x = f2bf(sE[tid]); z.y = zr; z.z = zr; z.w = zr; *(LAS u32x4*)(L + ML_E + tid * ML_ERS + 256) = z; z.x = zr; *(LAS u32x4*)(L + ML_E + tid * ML_ERS + 272) = z; }
    __syncthreads();
    bf16x8 af[4];
#pragma unroll
    for (int ks = 0; ks < 4; ++ks) { const int ra = ks * 32 + 4 * fq + (fr >> 2);
        const s16x4 a0 = lds_tr16(L + ra * ML_KRS + (w * 16 + 4 * (fr & 3)) * 2), a1 = lds_tr16(L + (ra + 16) * ML_KRS + (w * 16 + 4 * (fr & 3)) * 2);
        af[ks] = (bf16x8){a0[0], a0[1], a0[2], a0[3], a1[0], a1[1], a1[2], a1[3]}; }
    bf16_t* Cp = (bf16_t*)(F.ws + WS_CST) + ((size_t)(bh * 128 + c) << 14);
#pragma unroll
    for (int vb = 0; vb < 9; ++vb) { f32x4 d = (f32x4){0.f, 0.f, 0.f, 0.f};
#pragma unroll
        for (int ks = 0; ks < 4; ++ks) { const int rb = ks * 32 + 4 * fq + (fr >> 2);
            const s16x4 b0 = lds_tr16(L + ML_E + rb * ML_ERS + (vb * 16 + 4 * (fr & 3)) * 2), b1 = lds_tr16(L + ML_E + (rb + 16) * ML_ERS + (vb * 16 + 4 * (fr & 3)) * 2);
            const bf16x8 bfr = (bf16x8){b0[0], b0[1], b0[2], b0[3], b1[0], b1[1], b1[2], b1[3]};
            d = __builtin_amdgcn_mfma_f32_16x16x32_bf16(af[ks], bfr, d, 0, 0, 0); }
        if (vb < 8) { u32x2 o; o.x = pk2(d[0], d[1]); o.y = pk2(d[2], d[3]); *(u32x2*)(Cp + (size_t)(vb * 16 + fr) * 128 + w * 16 + 4 * fq) = o; }
        else if (fr == 0) *(f32x4*)((float*)(F.ws + WS_NST) + (size_t)(bh * 128 + c) * 128 + w * 16 + 4 * fq) = d;
    }
    if (tid == 0) { ((float*)(F.ws + WS_TAB + TAB_MLOC))[bh * 128 + c] = sM[0]; ((float*)(F.ws + WS_TAB + TAB_GTOT))[bh * 128 + c] = sM[1]; }
}
__device__ __forceinline__ void phase_scan(const Ctx& F) {
    const float* GT = (const float*)(F.ws + WS_TAB + TAB_GTOT); const float* ML = (const float*)(F.ws + WS_TAB + TAB_MLOC); float* MS = (float*)(F.ws + WS_TAB + TAB_MST);
    LAS float* sA = (LAS float*)F.lds; LAS float* sB = sA + 128;
    for (int blk = F.bid; blk < 8 * 32; blk += F.G) {
        const int bh = blk >> 5;
        __syncthreads();
        if (F.tid < 128) { sA[F.tid] = GT[bh * 128 + F.tid]; sB[F.tid] = ML[bh * 128 + F.tid]; }
        __syncthreads();
        if (F.wave == 0) {
            const int c0 = 2 * F.lane; const float g0 = sA[c0], m0 = sB[c0], g1 = sA[c0 + 1], m1 = sB[c0 + 1];
            float G = g0 + g1, M = fmaxf(m0 + g1, m1);
#pragma unroll
            for (int off = 1; off < 64; off <<= 1) { const float Gp = __shfl_up(G, off), Mp = __shfl_up(M, off); if (F.lane >= off) { M = fmaxf(Mp + G, M); G = Gp + G; } }
            float Gx = __shfl_up(G, 1), Mx = __shfl_up(M, 1); if (F.lane == 0) { Gx = 0.f; Mx = -INFINITY; }
            const float mA = fmaxf(0.f + Gx, Mx);
            const float mB = fmaxf(mA + g0, m0);
            const float mC = fmaxf(mB + g1, m1);
            sA[c0] = __expf(g0 + mA - mB); sB[c0] = __expf(m0 - mB); sA[c0 + 1] = __expf(g1 + mB - mC); sB[c0 + 1] = __expf(m1 - mC);
            if ((blk & 31) == 0) { MS[bh * 128 + c0] = mA; MS[bh * 128 + c0 + 1] = mB; } }
        __syncthreads();
        bf16_t* cp = (bf16_t*)(F.ws + WS_CST) + ((size_t)(bh * 128) << 14) + (blk & 31) * 512 + F.tid; float val = 0.f;
        const bool hasn = F.tid < 4; float* np = (float*)(F.ws + WS_NST) + (size_t)(bh * 128) * 128 + (hasn ? (blk & 31) * 4 + F.tid : 0); float nval = 0.f;
        for (int c0 = 0; c0 < 128; c0 += 16) { float loc[16], nloc[16];
#pragma unroll
            for (int j = 0; j < 16; ++j) { loc[j] = bf1(cp[(size_t)(c0 + j) << 14]); nloc[j] = np[(size_t)(c0 + j) * 128]; }
            PIN8(loc[0], loc[1], loc[2], loc[3], loc[4], loc[5], loc[6], loc[7]); PIN8(loc[8], loc[9], loc[10], loc[11], loc[12], loc[13], loc[14], loc[15]);
            PIN8(nloc[0], nloc[1], nloc[2], nloc[3], nloc[4], nloc[5], nloc[6], nloc[7]); PIN8(nloc[8], nloc[9], nloc[10], nloc[11], nloc[12], nloc[13], nloc[14], nloc[15]);
#pragma unroll
            for (int j = 0; j < 16; ++j) { const float a = sA[c0 + j], b = sB[c0 + j];
                cp[(size_t)(c0 + j) << 14] = (bf16_t)f2bf(val); val = a * val + b * loc[j];
                if (hasn) np[(size_t)(c0 + j) * 128] = nval; nval = a * nval + b * nloc[j]; } }
    }
    __syncthreads();
}
constexpr int MO_RS = 272, MO_VRS = 288;
constexpr int MO_Q = 0, MO_K = 128 * MO_RS, MO_C = 2 * 128 * MO_RS, MO_V = MO_C + 144 * MO_RS, MO_S = MO_V + 128 * MO_VRS;
static_assert(MO_S + 2560 <= MISC_OFF, "mlstm_out LDS");
__device__ __forceinline__ void mlstm_out_mfma(const Ctx& F, int layer, int item) {
    const int c = item & 127, bh = item >> 7, h = bh & 3, b = bh >> 2, t0 = b * SEQ + c * 128, tid = F.tid, lane = F.lane, w = F.wave, fr = lane & 15, fq = lane >> 4;
    LAS unsigned char* L = F.lds;
    LAS float* sIG = (LAS float*)(L + MO_S); LAS float* sBC = sIG + 128; LAS float* sMT = sIG + 256; LAS float* sSI = sIG + 384; LAS float* sU = sIG + 512;
    __syncthreads();
    mlstm_scalars(F, layer, t0, h, sIG, sBC);
    if (tid < 128) sU[tid] = (sIG[tid] - sBC[tid]) * 1.4426950408889634f;
    const float mst = ((const float*)(F.ws + WS_TAB + TAB_MST))[bh * 128 + c];
    if (w == 0) { const float a = sIG[2 * lane] - sBC[2 * lane], bb = sIG[2 * lane + 1] - sBC[2 * lane + 1]; float pm = fmaxf(a, bb);
#pragma unroll
        for (int off = 1; off < 64; off <<= 1) { const float t = __shfl_up(pm, off); if (lane >= off) pm = fmaxf(pm, t); }
        float pl = __shfl_up(pm, 1); if (lane == 0) pl = -INFINITY;
        const float p0 = fmaxf(pl, a), p1 = pm;
        { const float ai = sBC[2 * lane] + mst, mt = fmaxf(ai, sBC[2 * lane] + p0); sMT[2 * lane] = mt; sSI[2 * lane] = __expf(ai - mt); }
        { const float ai = sBC[2 * lane + 1] + mst, mt = fmaxf(ai, sBC[2 * lane + 1] + p1); sMT[2 * lane + 1] = mt; sSI[2 * lane + 1] = __expf(ai - mt); } }
    const bf16_t* QM = (const bf16_t*)(F.ws + WS_QM); const bf16_t* KM = (const bf16_t*)(F.ws + WS_KM); const bf16_t* VM = (const bf16_t*)(F.ws + WS_VM);
    const bf16_t* Cp = (const bf16_t*)(F.ws + WS_CST) + ((size_t)(bh * 128 + c) << 14);
    QkW WQ, WK; qk_load_w(F, layer, h * 128 + (tid & 15) * 8, WQ); qk_load_w(F, layer, 512 + h * 128 + (tid & 15) * 8, WK);
#pragma unroll 1
    for (int i = tid; i < 128 * 16; i += NTHREADS) { const int l = i >> 4, c8 = (i & 15) * 8; const int t = t0 + l, s = t & (SEQ - 1); float o[8];
        u32x4 rq[4], rk[4];
#pragma unroll
        for (int k = 0; k < 4; ++k) { const size_t ro = (size_t)(s - 3 + k >= 0 ? t - 3 + k : t) * 512 + h * 128 + c8; rq[k] = *(const u32x4*)(QM + ro); rk[k] = *(const u32x4*)(KM + ro); }
        const u32x4 rv = *(const u32x4*)(VM + (size_t)t * 512 + h * 128 + c8), rc = *(const u32x4*)(Cp + l * 128 + c8);
        qk_conv8r(WQ, rq, s, 1.0f, o);
        *(LAS u32x4*)(L + MO_Q + l * MO_RS + c8 * 2) = pack8((f32x4){o[0], o[1], o[2], o[3]}, (f32x4){o[4], o[5], o[6], o[7]});
        qk_conv8r(WK, rk, s, 0.08838834764831845f, o);
        *(LAS u32x4*)(L + MO_K + l * MO_RS + c8 * 2) = pack8((f32x4){o[0], o[1], o[2], o[3]}, (f32x4){o[4], o[5], o[6], o[7]});
        *(LAS u32x4*)(L + MO_V + l * MO_VRS + c8 * 2) = rv;
        *(LAS u32x4*)(L + MO_C + l * MO_RS + c8 * 2) = rc; }
    if (tid < 16) { const float* np = (const float*)(F.ws + WS_NST) + (size_t)(bh * 128 + c) * 128 + tid * 8;
        *(LAS u32x4*)(L + MO_C + 128 * MO_RS + tid * 16) = pack8(*(const f32x4*)np, *(const f32x4*)(np + 4)); }
    __syncthreads();
    const int q = 16 * w + fr;
    bf16x8 qf[4];
#pragma unroll
    for (int ks = 0; ks < 4; ++ks) qf[ks] = *(const LAS bf16x8*)(L + MO_Q + q * MO_RS + ks * 64 + fq * 16);
    f32x4 O[9];
#pragma unroll
    for (int vb = 0; vb < 9; ++vb) { f32x4 a = (f32x4){0.f, 0.f, 0.f, 0.f};
#pragma unroll
        for (int ks = 0; ks < 4; ++ks) { const bf16x8 cf = *(const LAS bf16x8*)(L + MO_C + (vb * 16 + fr) * MO_RS + ks * 64 + fq * 16); a = __builtin_amdgcn_mfma_f32_16x16x32_bf16(cf, qf[ks], a, 0, 0, 0); }
        O[vb] = a; }
    const float si = sSI[q], mt = sMT[q], bq = sBC[q]; const float vq = (bq - mt) * 1.4426950408889634f;
    const float dn = __shfl(O[8][0], fr);
#pragma unroll
    for (int vb = 0; vb < 8; ++vb) O[vb] = O[vb] * si;
    float den = 0.f;
    for (int k2 = 0; k2 <= (w >> 1); ++k2) {
        f32x4 P[2];
#pragma unroll
        for (int u = 0; u < 2; ++u) { const int kb = 2 * k2 + u; f32x4 a = (f32x4){0.f, 0.f, 0.f, 0.f};
            const int kr = (kb > 7 ? 7 : kb) * 16 + fr;
#pragma unroll
            for (int ks = 0; ks < 4; ++ks) { const bf16x8 kf = *(const LAS bf16x8*)(L + MO_K + kr * MO_RS + ks * 64 + fq * 16); a = __builtin_amdgcn_mfma_f32_16x16x32_bf16(kf, qf[ks], a, 0, 0, 0); }
#pragma unroll
            for (int j = 0; j < 4; ++j) { const int k = kb * 16 + 4 * fq + j; const int kc = k > 127 ? 127 : k; const float wgt = (k <= q) ? __builtin_amdgcn_exp2f(sU[kc] + vq) : 0.f; a[j] *= wgt; den += a[j]; }
            P[u] = a; }
        u32x4 pw; pw.x = cvt_pk_bf16(P[0][0], P[0][1]); pw.y = cvt_pk_bf16(P[0][2], P[0][3]); pw.z = cvt_pk_bf16(P[1][0], P[1][1]); pw.w = cvt_pk_bf16(P[1][2], P[1][3]);
        const bf16x8 pf = __builtin_bit_cast(bf16x8, pw);
        const int kb1 = (2 * k2 + 1 > 7) ? 7 : 2 * k2 + 1;
        const int r0 = 2 * k2 * 16 + 4 * fq + (fr >> 2), r1 = kb1 * 16 + 4 * fq + (fr >> 2);
#pragma unroll
        for (int vb = 0; vb < 8; ++vb) {
            const s16x4 v0 = lds_tr16(L + MO_V + r0 * MO_VRS + (vb * 16 + 4 * (fr & 3)) * 2), v1 = lds_tr16(L + MO_V + r1 * MO_VRS + (vb * 16 + 4 * (fr & 3)) * 2);
            const bf16x8 vf = (bf16x8){v0[0], v0[1], v0[2], v0[3], v1[0], v1[1], v1[2], v1[3]};
            O[vb] = __builtin_amdgcn_mfma_f32_16x16x32_bf16(vf, pf, O[vb], 0, 0, 0);
        }
    }
    den += __shfl_xor(den, 16); den += __shfl_xor(den, 32);
    const float dd = den + si * dn; const float inv = 1.0f / fmaxf(fabsf(dd), __expf(-mt));
    bf16_t* OM = (bf16_t*)(F.ws + WS_OM) + (size_t)(t0 + q) * 512 + h * 128;
#pragma unroll
    for (int vb = 0; vb < 8; ++vb) { u32x2* p = (u32x2*)(OM + vb * 16 + 4 * fq); const u32x2 g = *p;
        u32x2 o; o.x = cvt_pk_bf16(bf_lo(g.x) * O[vb][0] * inv, bf_hi(g.x) * O[vb][1] * inv); o.y = cvt_pk_bf16(bf_lo(g.y) * O[vb][2] * inv, bf_hi(g.y) * O[vb][3] * inv); *p = o; }
}

__device__ __forceinline__ void phase_route(const Ctx& F, int layer, int tile0, int tile1, int tstep) {
    LAS int* hist = (LAS int*)F.lds;
    const float* brg = F.in[I_BRG] + layer * 4; const float* bre = F.in[I_BRE] + layer * 32;
    for (int tile = tile0; tile < tile1; tile += tstep) {
        __syncthreads();
        if (F.tid < 128) { const int t = tile * 128 + F.tid; const float* lg = (const float*)(F.ws + WS_LOGITS) + (size_t)t * 64;
            float g[4]; int gs = 0; float gm;
#pragma unroll
            for (int j = 0; j < 4; ++j) g[j] = lg[j] + brg[j];
            gm = g[0];
#pragma unroll
            for (int j = 1; j < 4; ++j) if (g[j] > gm) { gm = g[j]; gs = j; }
            float se = 0.f;
#pragma unroll
            for (int j = 0; j < 4; ++j) se += __expf(g[j] - gm);
            const float pg = 1.0f / se;
            float le[8];
#pragma unroll
            for (int j = 0; j < 8; ++j) le[j] = lg[4 + gs * 8 + j] + bre[gs * 8 + j];
            int i0 = 0; float v0 = le[0];
#pragma unroll
            for (int j = 1; j < 8; ++j) if (le[j] > v0) { v0 = le[j]; i0 = j; }
            int i1 = -1; float v1 = -INFINITY;
#pragma unroll
            for (int j = 0; j < 8; ++j) if (j != i0 && le[j] > v1) { v1 = le[j]; i1 = j; }
            const float e1 = __expf(v1 - v0); const float wsc = (ABL == 4) ? 0.f : ((ABL == 6) ? 2.f : 1.f); const float w0 = wsc * pg / (1.0f + e1), w1 = wsc * pg * e1 / (1.0f + e1);
            const int x0 = gs * 8 + i0, x1 = gs * 8 + i1;
            ((int*)(F.ws + WS_ROUTE))[2 * t] = x0; ((int*)(F.ws + WS_ROUTE))[2 * t + 1] = x1;
            ((float*)(F.ws + WS_ROUTE))[2 * T + 2 * t] = w0; ((float*)(F.ws + WS_ROUTE))[2 * T + 2 * t + 1] = w1;
            hist[F.tid] = x0; hist[128 + F.tid] = x1;
        }
        __syncthreads();
        if (F.tid < 64) { const int k = F.tid >> 5, e = F.tid & 31; int cnt = 0; for (int j = 0; j < 128; ++j) cnt += (hist[k * 128 + j] == e) ? 1 : 0; ((int*)(F.ws + WS_TAB + TAB_CNT))[tile * 64 + F.tid] = cnt; }
        __syncthreads();
    }
}
__device__ __forceinline__ void phase_dispatch(const Ctx& F) {
    LAS int* sTot = (LAS int*)F.lds; LAS int* sBef = sTot + 64; LAS int* sPs = sTot + 128; LAS int* sE = sTot + 256; LAS int* sPart = sTot + 512;
    const int* CNT = (const int*)(F.ws + WS_TAB + TAB_CNT); int* META = (int*)(F.ws + WS_TAB + TAB_META);
    int* tokl = (int*)(F.ws + WS_LISTS); float* wl = (float*)(F.ws + WS_LISTS) + 2 * LISTCAP;
    for (int tile = F.bid; tile < 256; tile += F.G) {
        { const int ke = F.tid & 63, grp = F.tid >> 6; int cv[32];
#pragma unroll
            for (int i = 0; i < 32; ++i) cv[i] = CNT[(grp + 8 * i) * 64 + ke];
            int tot = 0, bef = 0;
#pragma unroll
            for (int i = 0; i < 32; ++i) { tot += cv[i]; bef += (grp + 8 * i < tile) ? cv[i] : 0; }
            sPart[grp * 64 + ke] = tot; sPart[512 + grp * 64 + ke] = bef; }
        __syncthreads();
        if (F.tid < 64) { int tot = 0, bef = 0;
#pragma unroll
            for (int gI = 0; gI < 8; ++gI) { tot += sPart[gI * 64 + F.tid]; bef += sPart[512 + gI * 64 + F.tid]; }
            sTot[F.tid] = tot; sBef[F.tid] = bef; }
        __syncthreads();
        if (F.tid < 2) { int ps = 0; for (int e = 0; e < 32; ++e) { sPs[F.tid * 33 + e] = ps; ps += ((sTot[F.tid * 32 + e] + 255) >> 8) << 8; } sPs[F.tid * 33 + 32] = ps;
            if (tile == 0) { META[F.tid] = ps >> 8; for (int e = 0; e <= 32; ++e) META[16 + 64 * F.tid + e] = sPs[F.tid * 33 + e]; } }
        int e0 = 0, e1 = 0; float w0 = 0.f, w1 = 0.f;
        if (F.tid < 128) { const int t = tile * 128 + F.tid; e0 = ((const int*)(F.ws + WS_ROUTE))[2 * t]; e1 = ((const int*)(F.ws + WS_ROUTE))[2 * t + 1];
            w0 = ((const float*)(F.ws + WS_ROUTE))[2 * T + 2 * t]; w1 = ((const float*)(F.ws + WS_ROUTE))[2 * T + 2 * t + 1]; sE[F.tid] = e0; sE[128 + F.tid] = e1; }
        __syncthreads();
        if (F.tid < 128) { int r0 = 0, r1 = 0; for (int j = 0; j < F.tid; ++j) { r0 += (sE[j] == e0) ? 1 : 0; r1 += (sE[128 + j] == e1) ? 1 : 0; }
            const int p0 = sPs[e0] + sBef[e0] + r0, p1 = sPs[33 + e1] + sBef[32 + e1] + r1;
            tokl[p0] = tile * 128 + F.tid; wl[p0] = w0; tokl[LISTCAP + p1] = tile * 128 + F.tid; wl[LISTCAP + p1] = w1; }
        __syncthreads();
    }
}
__device__ __forceinline__ void phase_final(const Ctx& F, const float* SS) {
    const int gw = F.bid * NWAVES + F.wave, NGW = F.G * NWAVES, lane = F.lane;
    const f32x4* g = (const f32x4*)F.in[I_GFIN] + 2 * lane; const f32x4 g00 = g[0], g01 = g[1], g10 = g[128], g11 = g[129];
    for (int m0 = gw; m0 < T; m0 += 4 * NGW) {
        u32x4 xr[4][2]; f32x4 sa[4];
#pragma unroll
        for (int r = 0; r < 4; ++r) { const int m = m0 + r * NGW; const u32x4* xp = (const u32x4*)((const bf16_t*)(F.ws + WS_XBT) + (size_t)m * D) + lane; xr[r][0] = xp[0]; xr[r][1] = xp[64];
            sa[r] = *((const f32x4*)(SS + (size_t)m * 16) + (lane & 3)); }
        PIN8(xr[0][0], xr[0][1], xr[1][0], xr[1][1], xr[2][0], xr[2][1], xr[3][0], xr[3][1]); PIN4(sa[0], sa[1], sa[2], sa[3]);
#pragma unroll
        for (int r = 0; r < 4; ++r) { const int m = m0 + r * NGW; float sq = (sa[r].x + sa[r].y) + (sa[r].z + sa[r].w); sq += __shfl_xor(sq, 1); sq += __shfl_xor(sq, 2);
            const float rs = rsqrtf(sq * (1.0f / 1024.0f) + EPS); f32x4* o = (f32x4*)(F.out + (size_t)m * D) + 2 * lane;
            f32x4 x0, x1; unpack8(xr[r][0], x0, x1); o[0] = x0 * rs * g00; o[1] = x1 * rs * g01; unpack8(xr[r][1], x0, x1); o[128] = x0 * rs * g10; o[129] = x1 * rs * g11; }
    }
}
constexpr int PH_PER_LAYER = 15, PH_FINAL = DEPTH * PH_PER_LAYER, N_PHASES = PH_FINAL + 1;
struct Args { const float* in[28]; float* out; unsigned char* ws; int ph_lo, ph_hi; };

__device__ __forceinline__ Ctx mkctx(const Args& args, LAS unsigned char* lds, int wave_s) {
    Ctx F; asm volatile("" : "+s"(wave_s)); int tid = wave_s * 64 + lane_id_(); asm volatile("" : "+v"(tid));
    GAS unsigned char* wsg = (GAS unsigned char*)args.ws; asm volatile("" : "+s"(wsg)); unsigned char* ws = (unsigned char*)wsg;
    GAS float* outg = (GAS float*)args.out; asm volatile("" : "+s"(outg)); float* outp = (float*)outg;
    int bid = blockIdx.x; asm volatile("" : "+s"(bid)); int G = gridDim.x; asm volatile("" : "+s"(G));
    F.in.p = args.in; F.out = outp; F.ws = ws; F.lds = lds;
    F.tid = tid; F.lane = tid & 63; F.wave = wave_s; F.G = G; F.bid = bid;
    return F;
}
#ifndef ONLY_PHASE
#define ONLY_PHASE -1
#endif
#ifndef STAGGER_TICKS
#define STAGGER_TICKS 1300
#endif
__device__ __forceinline__ void run_phase(const Args& args, LAS unsigned char* lds, int ph, int wave_s) {
    const int layer = ph / PH_PER_LAYER, lp = ph - layer * PH_PER_LAYER;
    const size_t ssin = (layer & 1) ? WS_SS1 : WS_SS0, ssmid = (layer & 1) ? WS_SS0 : WS_SS1;
    if (ph == PH_FINAL) { const Ctx F = mkctx(args, lds, wave_s); phase_final(F, (const float*)(F.ws + WS_SS0)); return; }
    if (ONLY_PHASE >= 0 && lp != ONLY_PHASE) return;
    switch (lp) {
    case 0: { const Ctx F = mkctx(args, lds, wave_s); phase_prep(F, layer, (float*)(F.ws + ssin)); } break;
    case 1: { const Ctx F = mkctx(args, lds, wave_s); PhProj P{(const char*)F.ws + WS_XB, (const char*)F.ws + WS_WIN, (const float*)(F.ws + ssin), F.ws, F.G, F.bid}; pg8::gemm_phase(F.lds, P, F.tid); } break;
    case 2: { const Ctx F = mkctx(args, lds, wave_s);
        for (int it = F.bid; it < 768; it += F.G) attn_strip(F, it);
        __syncthreads();
        for (int it = F.bid; it < 1024; it += F.G) mlstm_local_mfma(F, layer, it);
        for (int it = F.bid; it < 1024; it += F.G) conv_item(F, layer, it);
    } break;
    case 3: { const Ctx F = mkctx(args, lds, wave_s); phase_scan(F); attn_combine(F); } break;
    case 4: { const Ctx F = mkctx(args, lds, wave_s); for (int it = F.bid; it < 1024; it += F.G) mlstm_out_mfma(F, layer, it); } break;
    case 5: { const Ctx F = mkctx(args, lds, wave_s); PhGates P{(const char*)F.ws + WS_XB, (const char*)F.ws + WS_WIN, (const float*)(F.ws + ssin), F.ws, F.G, F.bid}; pg8::gemm_phase(F.lds, P, F.tid); } break;
    case 6: { const Ctx F = mkctx(args, lds, wave_s); PhMerge P{F.ws, F.G, F.bid};
        pg8::gemm_phase(F.lds, P, F.tid); } break;
    case 7: { const Ctx F = mkctx(args, lds, wave_s); PhOut P{F.ws, (float*)(F.ws + ssmid), F.G, F.bid}; pg8::gemm_phase(F.lds, P, F.tid); } break;
    case 8: { const Ctx F = mkctx(args, lds, wave_s); PhRouter P{F.ws, (const float*)(F.ws + ssmid), F.G, F.bid}; pg8::gemm_phase(F.lds, P, F.tid);
        { int* tokl = (int*)(F.ws + WS_LISTS); for (int i = F.bid * NTHREADS + F.tid; i < 2 * LISTCAP; i += F.G * NTHREADS) tokl[i] = -1; }
        for (int pm = F.bid; pm < 128; pm += F.G) phase_route(F, layer, 2 * pm, 2 * pm + 2, 1);
        phase_prep_experts(F, layer); } break;
    case 9: break;
    case 10: { const Ctx F = mkctx(args, lds, wave_s); phase_dispatch(F); } break;
    case 11: { const Ctx F = mkctx(args, lds, wave_s); PhUp P{F.ws, (const float*)(F.ws + ssmid), (const int*)(F.ws + WS_TAB + TAB_META), (const int*)(F.ws + WS_LISTS), F.G, F.bid}; pg8::gemm_phase(F.lds, P, F.tid); } break;
    case 12: { const Ctx F = mkctx(args, lds, wave_s); PhDown<1> P{F.ws, (float*)(F.ws + ssin), (const int*)(F.ws + WS_TAB + TAB_META), (const int*)(F.ws + WS_LISTS), (const float*)(F.ws + WS_LISTS) + 2 * LISTCAP, F.G, F.bid}; pg8::gemm_phase(F.lds, P, F.tid); } break;
    case 13: { const Ctx F = mkctx(args, lds, wave_s); PhDown<0> P{F.ws, (float*)(F.ws + ssin), (const int*)(F.ws + WS_TAB + TAB_META), (const int*)(F.ws + WS_LISTS), (const float*)(F.ws + WS_LISTS) + 2 * LISTCAP, F.G, F.bid}; pg8::gemm_phase(F.lds, P, F.tid); } break;
    case 14: { const Ctx F = mkctx(args, lds, wave_s); PhPle P{F.ws, (const float*)(F.ws + ssin), (float*)(F.ws + ssmid), F.G, F.bid}; pg8::gemm_phase(F.lds, P, F.tid); } break;
    }
}

__global__ void __launch_bounds__(NTHREADS, 2) fwd_kernel(Args args) {
    extern __shared__ __attribute__((aligned(16))) unsigned char lds_raw[];
    LAS unsigned char* lds = (LAS unsigned char*)lds_raw;
    volatile LAS unsigned* MISC = (volatile LAS unsigned*)(lds + MISC_OFF);
    const int wave_s = __builtin_amdgcn_readfirstlane((int)threadIdx.x >> 6);
    if (wave_s == 0) MISC[lane_id_()] = 0u;
    __syncthreads();
#if MK_MEGA
    XcdBarrier bar = xcd_barrier_post((unsigned*)(args.ws + WS_CTL) + 4096, MISC + 8, wave_s);
#endif
#ifndef PROBE_SEL
#define PROBE_SEL 0
#endif
    unsigned long long extra = 0ull;
    for (int ph = args.ph_lo; ph < args.ph_hi; ++ph) {
        if (ph < PH_FINAL && (ph % PH_PER_LAYER) == 9) continue;
        const unsigned long long t0 = PROBE_SEL ? __builtin_amdgcn_s_memrealtime() : 0ull;
        run_phase(args, lds, ph, wave_s);
#if MK_MEGA
        if (ph + 1 < args.ph_hi) xcd_barrier(bar);
#endif
        if (PROBE_SEL) { const int lp = ph % PH_PER_LAYER; if (ph < PH_FINAL && ((PROBE_SEL >> lp) & 1)) extra += __builtin_amdgcn_s_memrealtime() - t0; }
    }
    if (PROBE_SEL && blockIdx.x == 0) { const unsigned long long te = __builtin_amdgcn_s_memrealtime(); while (__builtin_amdgcn_s_memrealtime() - te < extra) __builtin_amdgcn_s_sleep(8); }
}

extern "C" void kernel_launch(void* const* d_in, const int* in_sizes, int n_in, void* d_out, int out_size, void* d_ws, size_t ws_size, hipStream_t stream) {
    static int grid = 0;
    if (grid == 0) {
        if (n_in != 28 || out_size != T * D || ws_size < WS_END) { fprintf(stderr, "kernel_launch: unexpected shapes (n_in %d out %d ws %zu, need %zu)\n", n_in, out_size, ws_size, (size_t)WS_END); grid = -1; return; }
        int dev = 0, cus = 0, per_cu = 0;
        if (hipGetDevice(&dev) != hipSuccess || hipDeviceGetAttribute(&cus, hipDeviceAttributeMultiprocessorCount, dev) != hipSuccess) { grid = -1; return; }
        if (hipFuncSetAttribute((const void*)fwd_kernel, hipFuncAttributeMaxDynamicSharedMemorySize, LDS_BYTES) != hipSuccess) { fprintf(stderr, "kernel_launch: hipFuncSetAttribute failed\n"); grid = -1; return; }
        if (hipOccupancyMaxActiveBlocksPerMultiprocessor(&per_cu, (const void*)fwd_kernel, NTHREADS, LDS_BYTES) != hipSuccess || per_cu < 1) { fprintf(stderr, "kernel_launch: occupancy query says %d blocks per CU\n", per_cu); }
        (void)hipGetLastError();
        grid = cus;
    }
    if (grid < 0) return;
    Args a{};
    for (int i = 0; i < 28; ++i) a.in[i] = (const float*)d_in[i];
    a.out = (float*)d_out; a.ws = (unsigned char*)d_ws;
#if MK_MEGA
    (void)hipMemsetAsync((char*)d_ws + WS_CTL, 0, CTL_ZERO_BYTES, stream);
    a.ph_lo = 0; a.ph_hi = N_PHASES;
    hipLaunchKernelGGL(fwd_kernel, dim3(grid), dim3(NTHREADS), LDS_BYTES, stream, a);
#else
    for (int ph = 0; ph < N_PHASES; ++ph) { a.ph_lo = ph; a.ph_hi = ph + 1; hipLaunchKernelGGL(fwd_kernel, dim3(grid), dim3(NTHREADS), LDS_BYTES, stream, a); }
#endif
}
```

```cpp
#include <hip/hip_runtime.h>
#include <cstdio>
#include <cstdint>

#ifndef MK_MEGA
#define MK_MEGA 1
#endif

#ifndef ABL
#define ABL 0
#endif
#define LAS __attribute__((address_space(3)))
#define GAS __attribute__((address_space(1)))
typedef unsigned short bf16_t;
typedef short bf16x8 __attribute__((ext_vector_type(8)));
typedef float f32x4 __attribute__((ext_vector_type(4)));
typedef float f32x2 __attribute__((ext_vector_type(2)));
typedef unsigned u32x4 __attribute__((ext_vector_type(4)));
typedef unsigned u32x2 __attribute__((ext_vector_type(2)));

constexpr int T = 32768, SEQ = 16384, D = 1024, DEPTH = 2;
constexpr int D_IN = 8712;
constexpr float EPS = 1e-6f;
constexpr int NTHREADS = 512, NWAVES = 8;
constexpr int LISTCAP = 40960;

constexpr size_t MiB = 1u << 20;
constexpr size_t WS_CTL = 0, CTL_ZERO_BYTES = 1 * MiB;
constexpr size_t WS_TAB = 1 * MiB;
constexpr size_t WS_ROUTE = 2 * MiB;
constexpr size_t WS_LISTS = 3 * MiB;
constexpr size_t WS_SS0 = 4 * MiB, WS_SS1 = 6 * MiB;
constexpr size_t WS_IF = 8 * MiB;
constexpr size_t WS_NST = 9 * MiB;
constexpr size_t WS_LOGITS = 10 * MiB;
constexpr size_t WS_WIN = 18 * MiB;
constexpr size_t WS_WBR = WS_WIN + 8960ull * 1024 * 2;
constexpr size_t WS_WOUT = WS_WBR + 3ull * 1024 * 512 * 2;
constexpr size_t WS_WPG = WS_WOUT + 1024ull * 1024 * 2;
constexpr size_t WS_WPP = WS_WPG + 1024ull * 1024 * 2;
constexpr size_t WS_WR = WS_WPP + 1024ull * 256 * 2;
static_assert(WS_WR + 256ull * 1024 * 2 <= 44 * MiB, "small weights");
constexpr size_t WS_XB = 44 * MiB;
constexpr size_t WS_QA0 = 108 * MiB;
constexpr size_t WS_YATT = WS_QA0;
constexpr size_t WS_OM = 140 * MiB;
constexpr size_t WS_YC = 172 * MiB;
constexpr size_t WS_CST = 204 * MiB;
constexpr size_t WS_B = 236 * MiB;
constexpr size_t WS_KA = WS_B, WS_QA1 = WS_B + 32 * MiB, WS_QA2 = WS_B + 64 * MiB, WS_VA = WS_B + 96 * MiB, WS_YG = WS_B + 128 * MiB, WS_QM = WS_B + 160 * MiB, WS_KM = WS_B + 192 * MiB, WS_VM = WS_B + 224 * MiB;
constexpr size_t WS_G0 = WS_B, WS_MERGED = WS_B + 192 * MiB;
constexpr size_t WS_WEXP = WS_B, WS_HB = WS_B + 48 * MiB, WS_PBF = WS_B + 88 * MiB, WS_PE = WS_B + 104 * MiB, WS_YB1 = WS_B + 168 * MiB;
constexpr size_t WS_XBT = WS_QA0;
constexpr size_t WS_END = 492 * MiB;
constexpr size_t TAB_CNT = 0;
constexpr size_t TAB_META = 65536;
constexpr size_t TAB_MLOC = 131072, TAB_GTOT = 131072 + 4096, TAB_MST = 131072 + 8192;

constexpr int RING_BYTES = 131072;
constexpr int MISC_OFF = 155648;
constexpr int LDS_BYTES = 156672;

__device__ __forceinline__ unsigned f2bf(float f) { unsigned u = __builtin_bit_cast(unsigned, f); return (u + 0x7fffu + ((u >> 16) & 1u)) >> 16; }
__device__ __forceinline__ unsigned pk2(float lo, float hi) { return f2bf(lo) | (f2bf(hi) << 16); }
__device__ __forceinline__ unsigned cvt_pk_bf16(float lo, float hi) { unsigned r; asm volatile("v_cvt_pk_bf16_f32 %0, %1, %2" : "=v"(r) : "v"(lo), "v"(hi)); return r; }
__device__ __forceinline__ float bf_lo(unsigned w) { return __builtin_bit_cast(float, w << 16); }
__device__ __forceinline__ float bf_hi(unsigned w) { return __builtin_bit_cast(float, w & 0xffff0000u); }
__device__ __forceinline__ float bf1(bf16_t h) { return __builtin_bit_cast(float, ((unsigned)h) << 16); }
__device__ __forceinline__ float sigmoidf_(float v) { return __builtin_amdgcn_rcpf(1.0f + __expf(-v)); }
__device__ __forceinline__ float siluf_(float v) { return v * __builtin_amdgcn_rcpf(1.0f + __expf(-v)); }
__device__ __forceinline__ float wave_sum(float v) {
#pragma unroll
    for (int o = 1; o < 64; o <<= 1) v += __shfl_xor(v, o);
    return v;
}
__device__ __forceinline__ float wave_max(float v) {
#pragma unroll
    for (int o = 1; o < 64; o <<= 1) v = fmaxf(v, __shfl_xor(v, o));
    return v;
}
__device__ __forceinline__ int lane_id_() { int l; asm volatile("v_mbcnt_lo_u32_b32 %0, -1, 0\n\tv_mbcnt_hi_u32_b32 %0, -1, %0" : "=&v"(l)); return l; }
#define LDS_WAIT() asm volatile("s_waitcnt lgkmcnt(0)" ::: "memory")
#define VM_WAIT() asm volatile("s_waitcnt vmcnt(0)" ::: "memory")

#define XB_TMO      128
#define XB_XCNT(j)  (256  + 64 * (j))
#define XB_XSUB(j)  (1280 + 64 * (j))
#define XB_XGEN(j)  (2304 + 64 * (j))
#define XB_TOP      3328
#define XB_TOPGEN   3392
#define XCD_BAR_WORDS 3456
#define XB_SPIN_CAP (1u << 22)
__device__ __forceinline__ unsigned xb_ld(unsigned* p)              { return __hip_atomic_load(p, __ATOMIC_RELAXED, __HIP_MEMORY_SCOPE_AGENT); }
__device__ __forceinline__ unsigned xb_add(unsigned* p, unsigned v) { return __hip_atomic_fetch_add(p, v, __ATOMIC_RELAXED, __HIP_MEMORY_SCOPE_AGENT); }
__device__ __forceinline__ unsigned xb_xcc_id() { return (unsigned)__builtin_amdgcn_s_getreg((3 << 11) | 20) & 0xFu; }
#define XB_SPIN(cond, bar) do { unsigned _sp = 0; while (cond) { __builtin_amdgcn_s_sleep(1); \
    if ((++_sp & 255u) == 0u) { if (xb_ld(&(bar)[XB_TMO])) break; if (_sp > XB_SPIN_CAP) { atomicAdd(&(bar)[XB_TMO], 1u); break; } } } } while (0)
struct XcdBarrier { unsigned* bar; unsigned x; volatile LAS unsigned* st; int wave; };
__device__ __forceinline__ XcdBarrier xcd_barrier_post(unsigned* bar, volatile LAS unsigned* st, int wave) {
    XcdBarrier b; b.bar = bar; b.x = xb_xcc_id(); b.st = st; b.wave = wave;
    if (wave == 0 && lane_id_() == 0) (void)xb_add(&bar[XB_XCNT(b.x)], 1u);
    return b;
}
__device__ __forceinline__ void xcd_barrier_complete(unsigned* bar, unsigned x, unsigned& nloc, unsigned& nx) {
    const unsigned G = gridDim.x * gridDim.y * gridDim.z;
    unsigned sum, cnt, mine, sp = 0u;
    for (;;) {
        sum = 0u; cnt = 0u; mine = 0u;
#pragma unroll
        for (unsigned j = 0; j < 16; ++j) { const unsigned c = xb_ld(&bar[XB_XCNT(j)]); sum += c; cnt += (c > 0u) ? 1u : 0u; mine = (j == x) ? c : mine; }
        if (sum == G) break;
        __builtin_amdgcn_s_sleep(1);
        if ((++sp & 255u) == 0u) { if (xb_ld(&bar[XB_TMO])) break; if (sp > XB_SPIN_CAP) { atomicAdd(&bar[XB_TMO], 1u); break; } }
    }
    nloc = mine > 0u ? mine : 1u; nx = cnt > 0u ? cnt : 1u;
}
__device__ __forceinline__ void xcd_barrier(const XcdBarrier& b) {
    asm volatile("s_waitcnt vmcnt(0)" ::: "memory");
    __syncthreads();
    if (b.wave == 0 && lane_id_() == 0) {
        unsigned* bar = b.bar;
        __builtin_amdgcn_s_waitcnt(0);
        unsigned nloc = b.st[0], nx = b.st[1];
        if (nloc == 0u) { xcd_barrier_complete(bar, b.x, nloc, nx); b.st[0] = nloc; b.st[1] = nx; }
        const unsigned old = xb_add(&bar[XB_XSUB(b.x)], 1u);
        const unsigned gen = old / nloc;
        if (old + 1u == (gen + 1u) * nloc) {
            __builtin_amdgcn_fence(__ATOMIC_RELEASE, "agent");
            asm volatile("s_waitcnt vmcnt(0)" ::: "memory");
            const unsigned og = xb_add(&bar[XB_TOP], 1u);
            const unsigned tg = og / nx;
            if (og + 1u == (tg + 1u) * nx) xb_add(&bar[XB_TOPGEN], 1u);
            else XB_SPIN(xb_ld(&bar[XB_TOPGEN]) == tg, bar);
            __builtin_amdgcn_fence(__ATOMIC_ACQUIRE, "agent");
            xb_add(&bar[XB_XGEN(b.x)], 1u);
            asm volatile("s_waitcnt vmcnt(0)" ::: "memory");
        } else {
            XB_SPIN(xb_ld(&bar[XB_XGEN(b.x)]) == gen, bar);
            __builtin_amdgcn_fence(__ATOMIC_ACQUIRE, "agent");
            asm volatile("s_waitcnt vmcnt(0)" ::: "memory");
        }
    }
    __syncthreads();
}

namespace pg8 {
constexpr int BM = 256, BK = 64, HALF = 128, HTB = HALF * BK * 2, NXCD = 8, WGM = 8;
__device__ __forceinline__ int lds_byte(int r, int c) { const int st = (r >> 4) * 2 + (c >> 5), rr = r & 15, cc = c & 31, ob = rr * 64 + cc * 2; return st * 1024 + (ob ^ (((ob >> 9) & 1) << 5)); }
__device__ __forceinline__ void stage_rc(int b, int& R, int& C) { const int st = b / 1024, sb = b % 1024, swz = sb ^ (((sb >> 9) & 1) << 5); R = (st >> 1) * 16 + swz / 64; C = (st & 1) * 32 + (swz % 64) / 2; }
__device__ __forceinline__ int perm32(int rho) { const int n = rho >> 4, i = rho & 15; return 8 * (i >> 2) + 4 * n + (i & 3); }

struct GUnit { const char* A; const char* B; int pm, pn, a0, a1; };

__device__ __forceinline__ void tile_order(int L, int nM, int nN, int& pm, int& pn) {
    const int nwg = nM * nN; int wgid = L;
    { const int q = nwg / NXCD, r = nwg % NXCD, xcd = wgid % NXCD, off = wgid / NXCD; wgid = (xcd < r ? xcd * (q + 1) : r * (q + 1) + (xcd - r) * q) + off; }
    const int nig = WGM * nN, gid = wgid / nig, fm = gid * WGM, gsz = (nM - fm) < WGM ? (nM - fm) : WGM;
    pm = fm + ((wgid % nig) % gsz); pn = (wgid % nig) / gsz;
}

typedef f32x4 Acc[2][2][4][2];

template <class P>
__device__ __forceinline__ void gemm_phase(LAS unsigned char* lds, const P& S, int tid) {
    asm volatile("" : "+v"(tid));
    const int wid = __builtin_amdgcn_readfirstlane(tid >> 6), lane = tid & 63, wr = wid >> 2, wc = wid & 3, fr = lane & 15, fq = lane >> 4;
    constexpr int K = P::K, nt = K / BK;
    static_assert(nt >= 4 && (nt % 2) == 0, "K multiple of 128, >= 256");
    unsigned voffB[2];
#pragma unroll
    for (int i = 0; i < 2; ++i) { int R, C; stage_rc(tid * 16 + i * 8192, R, C); const int Rb = (R & ~31) + perm32(R & 31); voffB[i] = (unsigned)(Rb * K + C) * 2u; }
    constexpr size_t kstep = (size_t)(BK * 2);
    constexpr size_t hstepB = (size_t)HALF * K * 2;
    const unsigned ldsw = (unsigned)wid * 1024u;
    const int aoff = lds_byte(wr * 64 + fr, fq * 8), boff = lds_byte(wc * 32 + fr, fq * 8);
#define PG8_SA(b, h) (((b) * 2 + (h)) * HTB)
#define PG8_SB(b, h) ((4 + (b) * 2 + (h)) * HTB)
#define PG8_STAGE(bufoff, gbase, voff) do { _Pragma("unroll") for (int _i = 0; _i < 2; ++_i) \
        __builtin_amdgcn_global_load_lds((const unsigned*)((const char*)(gbase) + (voff)[_i]), (LAS unsigned*)(lds + (bufoff) + ldsw + _i * 8192), 16, 0, 0); } while (0)
#define PG8_LDA(dst, b, h) do { _Pragma("unroll") for (int m = 0; m < 4; ++m) _Pragma("unroll") for (int k = 0; k < 2; ++k) dst[m][k] = *(const LAS bf16x8*)(lds + PG8_SA(b, h) + aoff + m * 2048 + k * 1024); } while (0)
#define PG8_LDB(dst, b, h) do { _Pragma("unroll") for (int n = 0; n < 2; ++n) _Pragma("unroll") for (int k = 0; k < 2; ++k) dst[n][k] = *(const LAS bf16x8*)(lds + PG8_SB(b, h) + boff + n * 2048 + k * 1024); } while (0)
#define PG8_MMA(ai, bj, At, Bt) do { __builtin_amdgcn_s_setprio(1); _Pragma("unroll") for (int m = 0; m < 4; ++m) _Pragma("unroll") for (int n = 0; n < 2; ++n) _Pragma("unroll") for (int k = 0; k < 2; ++k) \
        acc[ai][bj][m][n] = __builtin_amdgcn_mfma_f32_16x16x32_bf16(Bt[n][k], At[m][k], acc[ai][bj][m][n], 0, 0, 0); __builtin_amdgcn_s_setprio(0); } while (0)
#define PG8_WAIT_V(n) asm volatile("s_waitcnt vmcnt(" #n ")" ::: "memory")
#define PG8_WAIT_L(n) asm volatile("s_waitcnt lgkmcnt(" #n ")" ::: "memory")
#define PG8_BAR __builtin_amdgcn_s_barrier()
#define PG8_SCHED __builtin_amdgcn_sched_barrier(0)
#define PG8_VOA(dst, u) do { _Pragma("unroll") for (int _h = 0; _h < 2; ++_h) _Pragma("unroll") for (int _i = 0; _i < 2; ++_i) { int _R, _C; stage_rc(tid * 16 + _i * 8192, _R, _C); \
        if constexpr (P::GATHER) dst[_h][_i] = (S.arow(u, _h * HALF + _R) * (unsigned)K + (unsigned)_C) * 2u; \
        else dst[_h][_i] = (unsigned)((_h * HALF + _R) * K + _C) * 2u; } } while (0)
    GUnit cur, nxt; int ui = 0;
    if (!S.next(0, cur)) return;
    Acc acc;
#pragma unroll
    for (int a = 0; a < 2; ++a)
#pragma unroll
        for (int b = 0; b < 2; ++b)
#pragma unroll
            for (int m = 0; m < 4; ++m)
#pragma unroll
                for (int n = 0; n < 2; ++n) acc[a][b][m][n] = (f32x4){0.f, 0.f, 0.f, 0.f};
    bf16x8 At[4][2], B0[2][2], B1[2][2];
    unsigned voA[2][2], voAn[2][2];
    PG8_VOA(voA, cur);
    const char* cA = cur.A; const char* cB = cur.B;
    PG8_STAGE(PG8_SB(0, 0), cB, voffB); PG8_STAGE(PG8_SB(0, 1), cB + hstepB, voffB); PG8_STAGE(PG8_SA(0, 0), cA, voA[0]); PG8_STAGE(PG8_SA(0, 1), cA, voA[1]);
    if (wr == 1) PG8_BAR;
    PG8_WAIT_V(2); PG8_BAR;
    PG8_STAGE(PG8_SB(1, 0), cB + kstep, voffB); PG8_STAGE(PG8_SA(1, 0), cA + kstep, voA[0]); PG8_STAGE(PG8_SB(1, 1), cB + hstepB + kstep, voffB);
    PG8_WAIT_V(6); PG8_BAR;
    for (;;) {
        const bool has_next = S.next(ui + 1, nxt);
        const char* nA = has_next ? nxt.A : cA; const char* nB = has_next ? nxt.B : cB;
        if constexpr (P::GATHER) {
            if (has_next) { PG8_VOA(voAn, nxt); }
            else {
#pragma unroll
                for (int h = 0; h < 2; ++h)
#pragma unroll
                    for (int i = 0; i < 2; ++i) voAn[h][i] = voA[h][i];
            }
        }
#pragma unroll 1
        for (int t = 0; t < nt; t += 2) {
            const bool last = (t == nt - 2);
            const char* a1 = cA + (size_t)(t + 1) * kstep;
            const char* a2 = last ? nA : cA + (size_t)(t + 2) * kstep; const char* b2 = last ? nB : cB + (size_t)(t + 2) * kstep;
            const char* a3 = a2 + kstep; const char* b3 = b2 + kstep;
            unsigned s0[2], s1[2];
#pragma unroll
            for (int i = 0; i < 2; ++i) {
                if constexpr (P::GATHER) { s0[i] = last ? voAn[0][i] : voA[0][i]; s1[i] = last ? voAn[1][i] : voA[1][i]; }
                else { s0[i] = voA[0][i]; s1[i] = voA[1][i]; }
            }
            PG8_LDB(B0, 0, 0); PG8_LDB(B1, 0, 1); PG8_SCHED; PG8_LDA(At, 0, 0); PG8_STAGE(PG8_SA(1, 1), a1, voA[1]);
            PG8_WAIT_V(8); PG8_WAIT_L(0); PG8_BAR; PG8_MMA(0, 0, At, B0); PG8_MMA(0, 1, At, B1); PG8_BAR; PG8_SCHED;
            PG8_LDA(At, 0, 1); PG8_STAGE(PG8_SB(0, 0), b2, voffB); PG8_STAGE(PG8_SB(0, 1), b2 + hstepB, voffB); PG8_STAGE(PG8_SA(0, 0), a2, s0);
            PG8_WAIT_V(8); PG8_WAIT_L(0); PG8_BAR; PG8_MMA(1, 0, At, B0); PG8_MMA(1, 1, At, B1); PG8_BAR; PG8_SCHED;
            PG8_LDB(B0, 1, 0); PG8_LDB(B1, 1, 1); PG8_SCHED; PG8_LDA(At, 1, 0); PG8_STAGE(PG8_SA(0, 1), a2, s1);
            PG8_WAIT_V(8); PG8_WAIT_L(0); PG8_BAR; PG8_MMA(0, 0, At, B0); PG8_MMA(0, 1, At, B1); PG8_BAR; PG8_SCHED;
            PG8_LDA(At, 1, 1); PG8_STAGE(PG8_SB(1, 0), b3, voffB); PG8_STAGE(PG8_SB(1, 1), b3 + hstepB, voffB); PG8_STAGE(PG8_SA(1, 0), a3, s0);
            PG8_WAIT_V(8); PG8_WAIT_L(0); PG8_BAR; PG8_MMA(1, 0, At, B0); PG8_MMA(1, 1, At, B1); PG8_BAR; PG8_SCHED;
        }
        if (wr == 0) PG8_BAR;
        const bool zero = S.epi(acc, cur, wr, wc, fr, fq);
        if (!has_next) break;
        if (zero) {
#pragma unroll
            for (int a = 0; a < 2; ++a)
#pragma unroll
                for (int b = 0; b < 2; ++b)
#pragma unroll
                    for (int m = 0; m < 4; ++m)
#pragma unroll
                        for (int n = 0; n < 2; ++n) acc[a][b][m][n] = (f32x4){0.f, 0.f, 0.f, 0.f};
        }
        cur = nxt; cA = nA; cB = nB; ++ui;
        if constexpr (P::GATHER) {
#pragma unroll
            for (int h = 0; h < 2; ++h)
#pragma unroll
                for (int i = 0; i < 2; ++i) voA[h][i] = voAn[h][i];
        }
        if (wr == 1) PG8_BAR;
    }
    PG8_WAIT_V(0);
    PG8_BAR;
#undef PG8_SA
#undef PG8_SB
#undef PG8_STAGE
#undef PG8_LDA
#undef PG8_LDB
#undef PG8_MMA
#undef PG8_WAIT_V
#undef PG8_WAIT_L
#undef PG8_BAR
#undef PG8_SCHED
#undef PG8_VOA
}
}
using pg8::GUnit; using pg8::Acc;

__device__ __forceinline__ float row_rs(const float* SS, int row) {
    const f32x4* p = (const f32x4*)(SS + (size_t)row * 16);
    const f32x4 a = p[0], b = p[1], c = p[2], d = p[3];
    const float s = (((a.x + a.y) + (a.z + a.w)) + ((b.x + b.y) + (b.z + b.w))) + (((c.x + c.y) + (c.z + c.w)) + ((d.x + d.y) + (d.z + d.w)));
    return rsqrtf(s * (1.0f / 1024.0f) + EPS);
}
#define PIN1(a) asm volatile("" : "+v"(a))
#define PIN2(a, b) asm volatile("" : "+v"(a), "+v"(b))
#define PIN4(a, b, c, d) asm volatile("" : "+v"(a), "+v"(b), "+v"(c), "+v"(d))
#define PIN8(a, b, c, d, e, f, g, h) asm volatile("" : "+v"(a), "+v"(b), "+v"(c), "+v"(d), "+v"(e), "+v"(f), "+v"(g), "+v"(h))
__device__ __forceinline__ void row_rs8(const float* SS, int row0, float (&rs)[8]) {
#pragma unroll
    for (int hh = 0; hh < 4; ++hh) { f32x4 a[2], b[2], c[2], d[2];
#pragma unroll
        for (int g = 0; g < 2; ++g) { const f32x4* p = (const f32x4*)(SS + (size_t)(row0 + (hh >> 1) * 128 + ((hh & 1) * 2 + g) * 16) * 16); a[g] = p[0]; b[g] = p[1]; c[g] = p[2]; d[g] = p[3]; }
#pragma unroll
        for (int g = 0; g < 2; ++g) { const f32x4 t = (a[g] + b[g]) + (c[g] + d[g]); rs[hh * 2 + g] = rsqrtf(((t.x + t.y) + (t.z + t.w)) * (1.0f / 1024.0f) + EPS); }
        PIN2(rs[hh * 2], rs[hh * 2 + 1]); }
}
__device__ __forceinline__ u32x4 pack8(const f32x4 v0, const f32x4 v1) { u32x4 w; w.x = cvt_pk_bf16(v0[0], v0[1]); w.y = cvt_pk_bf16(v0[2], v0[3]); w.z = cvt_pk_bf16(v1[0], v1[1]); w.w = cvt_pk_bf16(v1[2], v1[3]); return w; }
__device__ __forceinline__ void unpack8(const u32x4 w, f32x4& v0, f32x4& v1) { v0 = (f32x4){bf_lo(w.x), bf_hi(w.x), bf_lo(w.y), bf_hi(w.y)}; v1 = (f32x4){bf_lo(w.z), bf_hi(w.z), bf_lo(w.w), bf_hi(w.w)}; }
__device__ __forceinline__ f32x4 sig4(const f32x4 v) { return (f32x4){sigmoidf_(v[0]), sigmoidf_(v[1]), sigmoidf_(v[2]), sigmoidf_(v[3])}; }
__device__ __forceinline__ f32x4 gate4(const f32x4 v) { f32x4 s = sig4(v); return (f32x4){fmaxf(s[0], 1e-6f), fmaxf(s[1], 1e-6f), fmaxf(s[2], 1e-6f), fmaxf(s[3], 1e-6f)}; }

struct PhProj {
    static constexpr int K = 1024; static constexpr bool GATHER = false;
    const char* xb; const char* W; const float* SS; unsigned char* ws; int G, c;
    __device__ __forceinline__ bool next(int i, GUnit& u) const {
        const long L = (long)i * G + c; if (L >= 128 * 23) return false;
        pg8::tile_order((int)L, 128, 23, u.pm, u.pn);
        u.A = xb + (size_t)u.pm * 256 * K * 2; u.B = W + (size_t)u.pn * 256 * K * 2; u.a0 = 0; u.a1 = 0; return true;
    }
    __device__ __forceinline__ unsigned arow(const GUnit&, int) const { return 0u; }
    __device__ __forceinline__ bool epi(Acc& acc, const GUnit& u, int wr, int wc, int fr, int fq) const {
        const int pn = u.pn; const int row0 = u.pm * 256 + wr * 64 + fr;
        float rs8[8]; row_rs8(SS, row0, rs8);
        if (pn == 22) {
            if (wc == 0 && fq == 0) {
                float* IFp = (float*)(ws + WS_IF);
#pragma unroll
                for (int ai = 0; ai < 2; ++ai)
#pragma unroll
                    for (int m = 0; m < 4; ++m) { const int row = row0 + ai * 128 + m * 16; const float rs = rs8[ai * 4 + m];
                        *(f32x4*)(IFp + (size_t)row * 8) = acc[ai][0][m][0] * rs; *(f32x4*)(IFp + (size_t)row * 8 + 4) = acc[ai][0][m][1] * rs; }
            }
            return true;
        }
        if (pn >= 10 && pn < 14) {
            bf16_t* Y = (bf16_t*)(ws + WS_YG);
#pragma unroll
            for (int ai = 0; ai < 2; ++ai)
#pragma unroll
                for (int m = 0; m < 4; ++m) { const int row = row0 + ai * 128 + m * 16; const float rs = rs8[ai * 4 + m];
#pragma unroll
                    for (int bj = 0; bj < 2; ++bj) { const f32x4 a = acc[ai][bj][m][0] * rs, g = sig4(acc[ai][bj][m][1] * rs), y = a * g;
                        u32x2 w; w.x = cvt_pk_bf16(y[0], y[1]); w.y = cvt_pk_bf16(y[2], y[3]);
                        *(u32x2*)(Y + (size_t)row * 512 + (pn - 10) * 128 + bj * 64 + wc * 16 + fq * 4) = w; } }
            return true;
        }
        bf16_t* dst; int col0; bool sg = false;
        if (pn < 6) { dst = (bf16_t*)(ws + (pn < 2 ? WS_QA0 : (pn < 4 ? WS_QA1 : WS_QA2))); col0 = (pn & 1) * 256; }
        else if (pn < 8) { dst = (bf16_t*)(ws + WS_KA); col0 = (pn - 6) * 256; }
        else if (pn < 10) { dst = (bf16_t*)(ws + WS_VA); col0 = (pn - 8) * 256; }
        else if (pn < 16) { dst = (bf16_t*)(ws + WS_QM); col0 = (pn - 14) * 256; }
        else if (pn < 18) { dst = (bf16_t*)(ws + WS_KM); col0 = (pn - 16) * 256; }
        else if (pn < 20) { dst = (bf16_t*)(ws + WS_VM); col0 = (pn - 18) * 256; }
        else { dst = (bf16_t*)(ws + WS_OM); col0 = (pn - 20) * 256; sg = true; }
        col0 += wc * 32 + fq * 8;
#pragma unroll
        for (int ai = 0; ai < 2; ++ai)
#pragma unroll
            for (int m = 0; m < 4; ++m) { const int row = row0 + ai * 128 + m * 16; const float rs = rs8[ai * 4 + m];
#pragma unroll
                for (int bj = 0; bj < 2; ++bj) { f32x4 v0 = acc[ai][bj][m][0] * rs, v1 = acc[ai][bj][m][1] * rs;
                    if (sg) { v0 = sig4(v0); v1 = sig4(v1); }
                    *(u32x4*)(dst + (size_t)row * 512 + col0 + bj * 128) = pack8(v0, v1); } }
        return true;
    }
};
struct PhGates {
    static constexpr int K = 1024; static constexpr bool GATHER = false;
    const char* xb; const char* W; const float* SS; unsigned char* ws; int G, c;
    __device__ __forceinline__ bool next(int i, GUnit& u) const {
        const long L = (long)i * G + c; if (L >= 128 * 12) return false;
        pg8::tile_order((int)L, 128, 12, u.pm, u.pn);
        u.A = xb + (size_t)u.pm * 256 * K * 2; u.B = W + (size_t)(5888 + u.pn * 256) * K * 2; u.a0 = 0; u.a1 = 0; return true;
    }
    __device__ __forceinline__ unsigned arow(const GUnit&, int) const { return 0u; }
    __device__ __forceinline__ bool epi(Acc& acc, const GUnit& u, int wr, int wc, int fr, int fq) const {
        const int row0 = u.pm * 256 + wr * 64 + fr;
        float rs8[8]; row_rs8(SS, row0, rs8);
        bf16_t* dst = (bf16_t*)(ws + WS_G0 + (size_t)(u.pn >> 2) * 64 * MiB); const int col0 = (u.pn & 3) * 256 + wc * 32 + fq * 8;
#pragma unroll
        for (int ai = 0; ai < 2; ++ai)
#pragma unroll
            for (int m = 0; m < 4; ++m) { const int row = row0 + ai * 128 + m * 16; const float rs = rs8[ai * 4 + m];
#pragma unroll
                for (int bj = 0; bj < 2; ++bj) *(u32x4*)(dst + (size_t)row * 1024 + col0 + bj * 128) = pack8(gate4(acc[ai][bj][m][0] * rs), gate4(acc[ai][bj][m][1] * rs)); }
        return true;
    }
};
struct PhMerge {
    static constexpr int K = 512; static constexpr bool GATHER = false;
    unsigned char* ws; int G, c;
    __device__ __forceinline__ bool next(int i, GUnit& u) const {
        const int ti = i / 3, seg = i - ti * 3; const long L = (long)ti * G + c; if (L >= 128 * 4) return false;
        pg8::tile_order((int)L, 128, 4, u.pm, u.pn);
        const size_t ya = seg == 0 ? WS_YATT : (seg == 1 ? WS_YC : WS_OM);
        u.A = (const char*)ws + ya + (size_t)u.pm * 256 * K * 2; u.B = (const char*)ws + WS_WBR + (size_t)seg * 1024 * 512 * 2 + (size_t)u.pn * 256 * K * 2; u.a0 = seg; u.a1 = 0; return true;
    }
    __device__ __forceinline__ unsigned arow(const GUnit&, int) const { return 0u; }
    __device__ __forceinline__ bool epi(Acc& acc, const GUnit& u, int wr, int wc, int fr, int fq) const {
        const int seg = u.a0; const int row0 = u.pm * 256 + wr * 64 + fr; const int col0 = u.pn * 256 + wc * 32 + fq * 8;
        const bf16_t* Gn = (const bf16_t*)(ws + WS_G0 + (size_t)seg * 64 * MiB);
        const bf16_t* Gd = (const bf16_t*)(ws + WS_G0 + (size_t)(seg < 2 ? seg + 1 : seg) * 64 * MiB);
        bf16_t* Mo = (bf16_t*)(ws + WS_MERGED);
#pragma unroll
        for (int ai = 0; ai < 2; ++ai)
#pragma unroll
            for (int mp = 0; mp < 2; ++mp) {
                u32x4 gn[2][2], gd[2][2];
#pragma unroll
                for (int mm = 0; mm < 2; ++mm)
#pragma unroll
                    for (int bj = 0; bj < 2; ++bj) { const size_t off = (size_t)(row0 + ai * 128 + (2 * mp + mm) * 16) * 1024 + col0 + bj * 128; gn[mm][bj] = *(const u32x4*)(Gn + off); gd[mm][bj] = *(const u32x4*)(Gd + off); }
                PIN8(gn[0][0], gn[0][1], gn[1][0], gn[1][1], gd[0][0], gd[0][1], gd[1][0], gd[1][1]);
#pragma unroll
                for (int mm = 0; mm < 2; ++mm)
#pragma unroll
                    for (int bj = 0; bj < 2; ++bj) { const int m = 2 * mp + mm; const size_t off = (size_t)(row0 + ai * 128 + m * 16) * 1024 + col0 + bj * 128;
                        f32x4 n0, n1, d0, d1; unpack8(gn[mm][bj], n0, n1); unpack8(gd[mm][bj], d0, d1);
                        if (seg < 2) {
#pragma unroll
                            for (int j = 0; j < 4; ++j) { acc[ai][bj][m][0][j] *= n0[j] * __builtin_amdgcn_rcpf(d0[j]); acc[ai][bj][m][1][j] *= n1[j] * __builtin_amdgcn_rcpf(d1[j]); } }
                        else *(u32x4*)(Mo + off) = pack8(acc[ai][bj][m][0] * n0, acc[ai][bj][m][1] * n1); }
            }
        return seg == 2;
    }
};
__device__ __forceinline__ float store_x8(bf16_t* xbp, const f32x4 v0, const f32x4 v1) {
    *(u32x4*)xbp = pack8(v0, v1);
    return ((v0[0] * v0[0] + v0[1] * v0[1]) + (v0[2] * v0[2] + v0[3] * v0[3])) + ((v1[0] * v1[0] + v1[1] * v1[1]) + (v1[2] * v1[2] + v1[3] * v1[3]));
}
struct PhOut {
    static constexpr int K = 1024; static constexpr bool GATHER = false;
    unsigned char* ws; float* SSo; int G, c;
    __device__ __forceinline__ bool next(int i, GUnit& u) const {
        const long L = (long)i * G + c; if (L >= 128 * 4) return false;
        pg8::tile_order((int)L, 128, 4, u.pm, u.pn);
        u.A = (const char*)ws + WS_MERGED + (size_t)u.pm * 256 * K * 2; u.B = (const char*)ws + WS_WOUT + (size_t)u.pn * 256 * K * 2; u.a0 = 0; u.a1 = 0; return true;
    }
    __device__ __forceinline__ unsigned arow(const GUnit&, int) const { return 0u; }
    __device__ __forceinline__ bool epi(Acc& acc, const GUnit& u, int wr, int wc, int fr, int fq) const {
        const int row0 = u.pm * 256 + wr * 64 + fr; const int col0 = u.pn * 256 + wc * 32 + fq * 8; bf16_t* XB = (bf16_t*)(ws + WS_XB);
#pragma unroll
        for (int ai = 0; ai < 2; ++ai) {
            u32x4 xr[4][2];
#pragma unroll
            for (int m = 0; m < 4; ++m)
#pragma unroll
                for (int bj = 0; bj < 2; ++bj) xr[m][bj] = *(const u32x4*)(XB + (size_t)(row0 + ai * 128 + m * 16) * 1024 + col0 + bj * 128);
            PIN8(xr[0][0], xr[0][1], xr[1][0], xr[1][1], xr[2][0], xr[2][1], xr[3][0], xr[3][1]);
#pragma unroll
            for (int m = 0; m < 4; ++m) { const int row = row0 + ai * 128 + m * 16; const size_t off = (size_t)row * 1024 + col0; float ss = 0.f;
#pragma unroll
                for (int bj = 0; bj < 2; ++bj) { f32x4 x0, x1; unpack8(xr[m][bj], x0, x1); ss += store_x8(XB + off + bj * 128, x0 + acc[ai][bj][m][0], x1 + acc[ai][bj][m][1]); }
                ss += __shfl_xor(ss, 16); ss += __shfl_xor(ss, 32);
                if (fq == 0) SSo[(size_t)row * 16 + u.pn * 4 + wc] = ss; } }
        return true;
    }
};
struct PhRouter {
    static constexpr int K = 1024; static constexpr bool GATHER = false;
    unsigned char* ws; const float* SS; int G, c;
    __device__ __forceinline__ bool next(int i, GUnit& u) const {
        const long L = (long)i * G + c; if (L >= 128) return false;
        u.pm = (int)L; u.pn = 0; u.A = (const char*)ws + WS_XB + (size_t)u.pm * 256 * K * 2; u.B = (const char*)ws + WS_WR; u.a0 = 0; u.a1 = 0; return true;
    }
    __device__ __forceinline__ unsigned arow(const GUnit&, int) const { return 0u; }
    __device__ __forceinline__ bool epi(Acc& acc, const GUnit& u, int wr, int wc, int fr, int fq) const {
        if (wc < 2) { float* Lg = (float*)(ws + WS_LOGITS); const int row0 = u.pm * 256 + wr * 64 + fr;
            float rs8[8]; row_rs8(SS, row0, rs8);
#pragma unroll
            for (int ai = 0; ai < 2; ++ai)
#pragma unroll
                for (int m = 0; m < 4; ++m) { const int row = row0 + ai * 128 + m * 16; const float rs = rs8[ai * 4 + m]; float* p = Lg + (size_t)row * 64 + wc * 32 + fq * 8;
                    *(f32x4*)p = acc[ai][0][m][0] * rs; *(f32x4*)(p + 4) = acc[ai][0][m][1] * rs; } }
        return true;
    }
};
__device__ __forceinline__ int moe_expert_of(const int* META, int k, int rb) {
    const int r = rb * 256; int e = 0;
    for (int j = 1; j < 32; ++j) e += (META[16 + 64 * k + j] <= r) ? 1 : 0;
    return __builtin_amdgcn_readfirstlane(e);
}
struct PhUp {
    static constexpr int K = 1024; static constexpr bool GATHER = true;
    unsigned char* ws; const float* SS; const int* META; const int* tok; int G, c;
    __device__ __forceinline__ bool next(int i, GUnit& u) const {
        const int nb0 = __builtin_amdgcn_readfirstlane(META[0]), nb1 = __builtin_amdgcn_readfirstlane(META[1]); const long L = (long)i * G + c; if (L >= 2L * (nb0 + nb1)) return false;
        int blk = (int)(L >> 1); u.pn = (int)(L & 1); int k = 0; if (blk >= nb0) { k = 1; blk -= nb0; }
        const int e = moe_expert_of(META, k, blk);
        u.pm = blk; u.a0 = k; u.a1 = e; u.A = (const char*)ws + WS_XB; u.B = (const char*)ws + WS_WEXP + (size_t)e * 512 * 1024 * 2 + (size_t)u.pn * 256 * K * 2; return true;
    }
    __device__ __forceinline__ unsigned arow(const GUnit& u, int r) const { const int t = tok[u.a0 * LISTCAP + u.pm * 256 + r]; return t < 0 ? 0u : (unsigned)t; }
    __device__ __forceinline__ bool epi(Acc& acc, const GUnit& u, int wr, int wc, int fr, int fq) const {
        const int lr0 = u.a0 * LISTCAP + u.pm * 256 + wr * 64 + fr; bf16_t* HB = (bf16_t*)(ws + WS_HB);
        int tk[8]; float rs8[8];
#pragma unroll
        for (int g = 0; g < 8; ++g) tk[g] = tok[lr0 + (g >> 2) * 128 + (g & 3) * 16];
        PIN8(tk[0], tk[1], tk[2], tk[3], tk[4], tk[5], tk[6], tk[7]);
#pragma unroll
        for (int hh = 0; hh < 4; ++hh) { f32x4 a[2], b[2], c[2], d[2];
#pragma unroll
            for (int g = 0; g < 2; ++g) { const int t = tk[hh * 2 + g]; const f32x4* p = (const f32x4*)(SS + (size_t)(t < 0 ? 0 : t) * 16); a[g] = p[0]; b[g] = p[1]; c[g] = p[2]; d[g] = p[3]; }
#pragma unroll
            for (int g = 0; g < 2; ++g) { const f32x4 tt = (a[g] + b[g]) + (c[g] + d[g]); rs8[hh * 2 + g] = tk[hh * 2 + g] < 0 ? 0.f : rsqrtf(((tt.x + tt.y) + (tt.z + tt.w)) * (1.0f / 1024.0f) + EPS); }
            PIN2(rs8[hh * 2], rs8[hh * 2 + 1]); }
#pragma unroll
        for (int ai = 0; ai < 2; ++ai)
#pragma unroll
            for (int m = 0; m < 4; ++m) { const int lr = lr0 + ai * 128 + m * 16; const float rs = rs8[ai * 4 + m];
#pragma unroll
                for (int bj = 0; bj < 2; ++bj) { const f32x4 g = acc[ai][bj][m][0] * rs, uu = acc[ai][bj][m][1] * rs;
                    f32x4 h = (f32x4){siluf_(g[0]) * uu[0], siluf_(g[1]) * uu[1], siluf_(g[2]) * uu[2], siluf_(g[3]) * uu[3]}; if (ABL == 8) h = (f32x4){1.f, 1.f, 1.f, 1.f};
                    u32x2 w; w.x = cvt_pk_bf16(h[0], h[1]); w.y = cvt_pk_bf16(h[2], h[3]);
                    *(u32x2*)(HB + (size_t)lr * 256 + u.pn * 128 + bj * 64 + wc * 16 + fq * 4) = w; }
                asm volatile("" ::: "memory"); }
        return true;
    }
};
template <int KL> struct PhDown {
    static constexpr int K = 256; static constexpr bool GATHER = false;
    unsigned char* ws; float* SSo; const int* META; const int* tok; const float* wl; int G, c;
    __device__ __forceinline__ bool next(int i, GUnit& u) const {
        const int nb = __builtin_amdgcn_readfirstlane(META[KL]); const long L = (long)i * G + c;
        if (L < 4L * nb) { const int blk = (int)(L >> 2); u.pn = (int)(L & 3); const int e = moe_expert_of(META, KL, blk); u.pm = blk; u.a0 = 0; u.a1 = e;
            u.A = (const char*)ws + WS_HB + (size_t)(KL * LISTCAP + blk * 256) * 256 * 2; u.B = (const char*)ws + WS_WEXP + 32ull * 512 * 1024 * 2 + (size_t)e * 1024 * 256 * 2 + (size_t)u.pn * 256 * K * 2; return true; }
        if (KL == 1) { const long L2 = L - 4L * nb; if (L2 >= 128 * 4) return false;
            pg8::tile_order((int)L2, 128, 4, u.pm, u.pn); u.a0 = 1; u.a1 = 0;
            u.A = (const char*)ws + WS_PBF + (size_t)u.pm * 256 * K * 2; u.B = (const char*)ws + WS_WPP + (size_t)u.pn * 256 * K * 2; return true; }
        return false;
    }
    __device__ __forceinline__ unsigned arow(const GUnit&, int) const { return 0u; }
    __device__ __forceinline__ bool epi(Acc& acc, const GUnit& u, int wr, int wc, int fr, int fq) const {
        const int col0 = u.pn * 256 + wc * 32 + fq * 8;
        if (KL == 1 && u.a0 == 1) {
            bf16_t* PE = (bf16_t*)(ws + WS_PE); const int row0 = u.pm * 256 + wr * 64 + fr;
#pragma unroll
            for (int ai = 0; ai < 2; ++ai)
#pragma unroll
                for (int m = 0; m < 4; ++m)
#pragma unroll
                    for (int bj = 0; bj < 2; ++bj) *(u32x4*)(PE + (size_t)(row0 + ai * 128 + m * 16) * 1024 + col0 + bj * 128) = pack8(acc[ai][bj][m][0], acc[ai][bj][m][1]);
            return true;
        }
        const int lr0 = KL * LISTCAP + u.pm * 256 + wr * 64 + fr; bf16_t* YB = (bf16_t*)(ws + WS_YB1); const bf16_t* XB = (const bf16_t*)(ws + WS_XB); bf16_t* XT = (bf16_t*)(ws + WS_XBT);
        int tk[8]; float wk[8];
#pragma unroll
        for (int g = 0; g < 8; ++g) { const int lr = lr0 + (g >> 2) * 128 + (g & 3) * 16; tk[g] = tok[lr]; wk[g] = wl[lr]; }
        PIN8(tk[0], tk[1], tk[2], tk[3], tk[4], tk[5], tk[6], tk[7]); PIN8(wk[0], wk[1], wk[2], wk[3], wk[4], wk[5], wk[6], wk[7]);
#pragma unroll
        for (int ai = 0; ai < 2; ++ai)
#pragma unroll
            for (int m = 0; m < 4; ++m) { const int t = tk[ai * 4 + m]; const float w = wk[ai * 4 + m]; const size_t off = (size_t)(t < 0 ? 0 : t) * 1024 + col0;
                if (KL == 1) { if (t >= 0) {
#pragma unroll
                        for (int bj = 0; bj < 2; ++bj) *(u32x4*)(YB + off + bj * 128) = pack8(acc[ai][bj][m][0] * w, acc[ai][bj][m][1] * w); } }
                else { float ss = 0.f;
                    if (t >= 0) {
                        u32x4 xr[2], yr[2];
#pragma unroll
                        for (int bj = 0; bj < 2; ++bj) { xr[bj] = *(const u32x4*)(XB + off + bj * 128); yr[bj] = *(const u32x4*)(YB + off + bj * 128); }
                        PIN4(xr[0], xr[1], yr[0], yr[1]);
#pragma unroll
                        for (int bj = 0; bj < 2; ++bj) { f32x4 x0, x1, y0, y1; unpack8(xr[bj], x0, x1); unpack8(yr[bj], y0, y1);
                            ss += store_x8(XT + off + bj * 128, (x0 + y0) + acc[ai][bj][m][0] * w, (x1 + y1) + acc[ai][bj][m][1] * w); } }
                    ss += __shfl_xor(ss, 16); ss += __shfl_xor(ss, 32);
                    if (fq == 0 && t >= 0) SSo[(size_t)t * 16 + u.pn * 4 + wc] = ss; }
                if (m & 1) asm volatile("" ::: "memory"); }
        return true;
    }
};
struct PhPle {
    static constexpr int K = 1024; static constexpr bool GATHER = false;
    unsigned char* ws; const float* SSi; float* SSo; int G, c;
    __device__ __forceinline__ bool next(int i, GUnit& u) const {
        const long L = (long)i * G + c; if (L >= 128 * 4) return false;
        pg8::tile_order((int)L, 128, 4, u.pm, u.pn);
        u.A = (const char*)ws + WS_XBT + (size_t)u.pm * 256 * K * 2; u.B = (const char*)ws + WS_WPG + (size_t)u.pn * 256 * K * 2; u.a0 = 0; u.a1 = 0; return true;
    }
    __device__ __forceinline__ unsigned arow(const GUnit&, int) const { return 0u; }
    __device__ __forceinline__ bool epi(Acc& acc, const GUnit& u, int wr, int wc, int fr, int fq) const {
        const int row0 = u.pm * 256 + wr * 64 + fr; const int col0 = u.pn * 256 + wc * 32 + fq * 8; bf16_t* XT = (bf16_t*)(ws + WS_XB); const bf16_t* PE = (const bf16_t*)(ws + WS_PE); const bf16_t* XBc = (const bf16_t*)(ws + WS_XBT);
        float rs8[8]; row_rs8(SSi, row0, rs8);
#pragma unroll
        for (int ai = 0; ai < 2; ++ai)
#pragma unroll
            for (int m = 0; m < 4; ++m) { const int row = row0 + ai * 128 + m * 16; const size_t off = (size_t)row * 1024 + col0; const float rs = rs8[ai * 4 + m]; float ss = 0.f;
                u32x4 xr[2], pr[2];
#pragma unroll
                for (int bj = 0; bj < 2; ++bj) { xr[bj] = *(const u32x4*)(XBc + off + bj * 128); pr[bj] = *(const u32x4*)(PE + off + bj * 128); }
                PIN4(xr[0], xr[1], pr[0], pr[1]);
#pragma unroll
                for (int bj = 0; bj < 2; ++bj) { f32x4 p0, p1, x0, x1; unpack8(pr[bj], p0, p1); unpack8(xr[bj], x0, x1);
                    ss += store_x8(XT + off + bj * 128, x0 + sig4(acc[ai][bj][m][0] * rs) * p0, x1 + sig4(acc[ai][bj][m][1] * rs) * p1); }
                ss += __shfl_xor(ss, 16); ss += __shfl_xor(ss, 32);
                if (fq == 0) SSo[(size_t)row * 16 + u.pn * 4 + wc] = ss; }
        return true;
    }
};

struct InPtrs { const float* const* p; __device__ __forceinline__ const float* operator[](int i) const { return (const float*)(GAS const float*)p[i]; } };
struct Ctx {
    InPtrs in; float* out; unsigned char* ws; LAS unsigned char* lds;
    int tid, lane, wave, G, bid;
};
enum { I_X = 0, I_P, I_GMIX, I_WIN, I_CONVW, I_CONVB, I_CLNG, I_CLNB, I_MCW, I_MCB, I_MIB, I_MFB, I_WBA, I_WBC, I_WBM, I_WOUT, I_GFFN, I_WRG, I_BRG, I_WRE, I_BRE,
       I_WEG, I_WEU, I_WED, I_GPLE, I_WPG, I_WPP, I_GFIN };

constexpr int TR_LDS = 64 * 65 * 4;
template <bool GAIN>
__device__ __forceinline__ void tr_item64(const float* colptr4, size_t pitch, const float* gainp, float cscale, bf16_t* dst, int K, int n0, int k0, LAS float* scr, int lane, const float* gain_or_valid) {
    const float* gain = GAIN ? gainp : nullptr;
    const int g = lane & 15, r = lane >> 4;
    f32x4 v[16]; float gs[16];
    const float* cp = colptr4 ? colptr4 : gain_or_valid;
#pragma unroll
    for (int i = 0; i < 16; ++i) { const int kk = 4 * i + r; v[i] = *(const f32x4*)(cp + (colptr4 ? (size_t)(k0 + kk) * pitch : 0)); gs[i] = gain ? gain[k0 + kk] : 1.0f; }
    PIN8(v[0], v[1], v[2], v[3], v[4], v[5], v[6], v[7]); PIN8(v[8], v[9], v[10], v[11], v[12], v[13], v[14], v[15]);
    const float zs = colptr4 ? cscale : 0.f;
#pragma unroll
    for (int i = 0; i < 16; ++i) { const int kk = 4 * i + r; const float m = gs[i] * zs; LAS float* p = scr + kk * 65 + 4 * g; p[0] = v[i].x * m; p[1] = v[i].y * m; p[2] = v[i].z * m; p[3] = v[i].w * m; }
    LDS_WAIT(); asm volatile("" ::: "memory");
    const int c = lane & 7, n8 = lane >> 3;
#pragma unroll
    for (int j = 0; j < 8; ++j) { const int n = n8 + 8 * j; const LAS float* sp = scr + (8 * c) * 65 + n;
        u32x4 o; o.x = pk2(sp[0 * 65], sp[1 * 65]); o.y = pk2(sp[2 * 65], sp[3 * 65]); o.z = pk2(sp[4 * 65], sp[5 * 65]); o.w = pk2(sp[6 * 65], sp[7 * 65]);
        *(u32x4*)(dst + (size_t)(n0 + n) * K + k0 + 8 * c) = o; }
    LDS_WAIT(); asm volatile("" ::: "memory");
}
__device__ __forceinline__ void phase_prep(const Ctx& F, int layer, float* SS) {
    const int gw = F.bid * NWAVES + F.wave, NGW = F.G * NWAVES, lane = F.lane;
    LAS float* scr = (LAS float*)(F.lds + F.wave * TR_LDS);
    bf16_t* XB = (bf16_t*)(F.ws + WS_XB);
    if (layer == 0) {
        for (int m0 = gw; m0 < T; m0 += 4 * NGW) {
            f32x4 v[4][4];
#pragma unroll
            for (int r = 0; r < 4; ++r) { const f32x4* xr = (const f32x4*)(F.in[I_X] + (size_t)(m0 + r * NGW) * D) + lane;
#pragma unroll
                for (int j = 0; j < 4; ++j) v[r][j] = xr[64 * j]; }
            PIN8(v[0][0], v[0][1], v[0][2], v[0][3], v[1][0], v[1][1], v[1][2], v[1][3]); PIN8(v[2][0], v[2][1], v[2][2], v[2][3], v[3][0], v[3][1], v[3][2], v[3][3]);
#pragma unroll
            for (int r = 0; r < 4; ++r) { const int m = m0 + r * NGW; u32x2* xbr = (u32x2*)(XB + (size_t)m * D) + lane; float sq = 0.f;
#pragma unroll
                for (int j = 0; j < 4; ++j) { const f32x4 x = v[r][j]; sq += (x.x * x.x + x.y * x.y) + (x.z * x.z + x.w * x.w); u32x2 w; w.x = cvt_pk_bf16(x.x, x.y); w.y = cvt_pk_bf16(x.z, x.w); xbr[64 * j] = w; }
                sq = wave_sum(sq);
                if (lane < 16) SS[(size_t)m * 16 + lane] = lane == 0 ? sq : 0.f; }
        }
    }
    const float* w_in = F.in[I_WIN] + (size_t)layer * D * D_IN; const float* g_mix = F.in[I_GMIX] + (size_t)layer * D;
    constexpr int N_WIN = 140 * 16, N_BR = 16 * 8, N_SQ = 16 * 16, N_PP = 16 * 4, N_R = 4 * 16;
    constexpr int NITEMS = N_WIN + 3 * N_BR + 2 * N_SQ + N_PP + N_R;
    const int g4 = 4 * (lane & 15);
    for (int it = gw; it < NITEMS; it += NGW) {
        int r = it;
        if (r < N_WIN) { const int nb = r >> 4, kb = r & 15; const int n = nb * 64 + g4; int src = -1; float cs = 1.f;
            if (n < 2560) { src = n; if (n < 1536) cs = 0.125f * 1.4426950408889634f; }
            else if (n < 3584) { const int np = n - 2560, q8 = np >> 3, sg = (np >> 2) & 1; src = 2560 + sg * 512 + 4 * q8; }
            else if (n < 5640) src = n;
            else if (n < 5888) src = -1;
            else src = 5640 + (n - 5888);
            tr_item64<true>(src >= 0 ? w_in + src : nullptr, D_IN, g_mix, cs, (bf16_t*)(F.ws + WS_WIN), 1024, nb * 64, kb * 64, scr, lane, g_mix); continue; }
        r -= N_WIN;
        if (r < 3 * N_BR) { const int b = r / N_BR; r -= b * N_BR; const int nb = r >> 3, kb = r & 7; const int n = nb * 64 + g4;
            const float* w = (b == 0 ? F.in[I_WBA] : (b == 1 ? F.in[I_WBC] : F.in[I_WBM])) + (size_t)layer * 512 * 1024;
            tr_item64<false>(w + n, 1024, nullptr, 1.f, (bf16_t*)(F.ws + WS_WBR) + (size_t)b * 1024 * 512, 512, nb * 64, kb * 64, scr, lane, g_mix); continue; }
        r -= 3 * N_BR;
        if (r < 2 * N_SQ) { const int b = r / N_SQ; r -= b * N_SQ; const int nb = r >> 4, kb = r & 15; const int n = nb * 64 + g4;
            const float* w = (b == 0 ? F.in[I_WOUT] : F.in[I_WPG]) + (size_t)layer * 1024 * 1024;
            if (b == 0) tr_item64<false>(w + n, 1024, nullptr, 1.f, (bf16_t*)(F.ws + WS_WOUT), 1024, nb * 64, kb * 64, scr, lane, g_mix);
            else tr_item64<true>(w + n, 1024, F.in[I_GPLE] + (size_t)layer * D, 1.f, (bf16_t*)(F.ws + WS_WPG), 1024, nb * 64, kb * 64, scr, lane, g_mix);
            continue; }
        r -= 2 * N_SQ;
        if (r < N_PP) { const int nb = r >> 2, kb = r & 3; const int n = nb * 64 + g4;
            tr_item64<false>(F.in[I_WPP] + (size_t)layer * 256 * 1024 + n, 1024, nullptr, 1.f, (bf16_t*)(F.ws + WS_WPP), 256, nb * 64, kb * 64, scr, lane, g_mix); continue; }
        r -= N_PP;
        { const int nb = r >> 4, kb = r & 15; const int n = nb * 64 + g4; const float* cp = nullptr; size_t pitch = 4;
            if (n < 4) { cp = F.in[I_WRG] + (size_t)layer * 1024 * 4 + n; pitch = 4; } else if (n < 36) { cp = F.in[I_WRE] + (size_t)layer * 1024 * 32 + (n - 4); pitch = 32; }
            tr_item64<true>(cp, pitch, F.in[I_GFFN] + (size_t)layer * D, 1.f, (bf16_t*)(F.ws + WS_WR), 1024, nb * 64, kb * 64, scr, lane, g_mix); }
    }
}
__device__ __forceinline__ void phase_prep_experts(const Ctx& F, int layer) {
    const int gw = F.bid * NWAVES + F.wave, NGW = F.G * NWAVES, lane = F.lane;
    LAS float* scr = (LAS float*)(F.lds + F.wave * TR_LDS);
    const float* g_ffn = F.in[I_GFFN] + (size_t)layer * D;
    constexpr int N_UP = 32 * 8 * 16, N_DN = 32 * 16 * 4;
    const int g4 = 4 * (lane & 15);
    for (int it = gw; it < N_UP + N_DN; it += NGW) {
        int r = it;
        if (r < N_UP) { const int e = r >> 7; r &= 127; const int nb = r >> 4, kb = r & 15; const int n = nb * 64 + g4; const int q8 = n >> 3, sg = (n >> 2) & 1;
            const float* w = (sg ? F.in[I_WEU] : F.in[I_WEG]) + ((size_t)layer * 32 + e) * 1024 * 256 + 4 * q8;
            tr_item64<true>(w, 256, g_ffn, 1.f, (bf16_t*)(F.ws + WS_WEXP) + (size_t)e * 512 * 1024, 1024, nb * 64, kb * 64, scr, lane, g_ffn); continue; }
        r -= N_UP;
        { const int e = r >> 6; r &= 63; const int nb = r >> 2, kb = r & 3; const int n = nb * 64 + g4;
            const float* w = F.in[I_WED] + ((size_t)layer * 32 + e) * 256 * 1024 + n;
            tr_item64<false>(w, 1024, nullptr, 1.f, (bf16_t*)(F.ws + WS_WEXP) + 32ull * 512 * 1024 + (size_t)e * 1024 * 256, 256, nb * 64, kb * 64, scr, lane, g_ffn); }
    }
    const f32x4* p = (const f32x4*)(F.in[I_P] + (size_t)layer * T * 256); u32x2* pb = (u32x2*)(F.ws + WS_PBF);
    { const size_t n = (size_t)T * 256 / 4, st = (size_t)F.G * NTHREADS;
        for (size_t i0 = (size_t)F.bid * NTHREADS + F.tid; i0 < n; i0 += 8 * st) { f32x4 v[8];
#pragma unroll
            for (int k = 0; k < 8; ++k) { const size_t i = i0 + k * st; v[k] = p[i < n ? i : 0]; }
            PIN8(v[0], v[1], v[2], v[3], v[4], v[5], v[6], v[7]);
#pragma unroll
            for (int k = 0; k < 8; ++k) { const size_t i = i0 + k * st; if (i < n) { u32x2 w; w.x = cvt_pk_bf16(v[k].x, v[k].y); w.y = cvt_pk_bf16(v[k].z, v[k].w); pb[i] = w; } } } }
}

constexpr int AK_RS = 144, AV_RS = 160, AV_OFF = 2 * 128 * AK_RS;
typedef short s16x4 __attribute__((ext_vector_type(4)));
__device__ __forceinline__ s16x4 lds_tr16(LAS unsigned char* p) { return __builtin_amdgcn_ds_read_tr16_b64_v4i16((LAS s16x4*)p); }
__device__ __forceinline__ void attn_strip(const Ctx& F, int strip) {
    const int bs = strip / 48, sg = strip - bs * 48, b = bs >> 3, slot = bs & 7;
    int g, r, nb0;
    if (sg < 16) { g = 0; r = 0; nb0 = sg * 8; } else if (sg < 32) { g = 1; r = (sg - 16) >> 2; nb0 = ((sg - 16) & 3) * 8; } else { g = 2; r = sg - 32; nb0 = 0; }
    const int dl = 1 << (2 * g); const float slope = exp2f(-(float)(g * 8 + slot + 1) * (1.0f / 3.0f)) * (float)dl * 1.4426950408889634f;
    bf16_t* Qg = (bf16_t*)(F.ws + (g == 0 ? WS_QA0 : (g == 1 ? WS_QA1 : WS_QA2))) + slot * 64;
    const bf16_t* Kg = (const bf16_t*)(F.ws + WS_KA) + slot * 64; const bf16_t* Vg = (const bf16_t*)(F.ws + WS_VA) + slot * 64;
    float* LSE = (float*)(F.ws + WS_LOGITS) + (size_t)g * T * 8 + slot;
    const size_t tok0 = (size_t)b * SEQ + r;
    LAS unsigned char* Kl = F.lds; LAS unsigned char* Vl = F.lds + AV_OFF;
    const int tid = F.tid, lane = F.lane, w = F.wave, fr = lane & 15, fq = lane >> 4;
    const int srow = tid >> 2, sc4 = tid & 3;
    u32x4 kx[2], vx[2];
#define ATT_LOAD(blk) do { const size_t _t = (tok0 + (size_t)((blk) * 128 + srow) * dl) * 512; \
        kx[0] = *(const u32x4*)(Kg + _t + sc4 * 8); kx[1] = *(const u32x4*)(Kg + _t + 32 + sc4 * 8); vx[0] = *(const u32x4*)(Vg + _t + sc4 * 8); vx[1] = *(const u32x4*)(Vg + _t + 32 + sc4 * 8); } while (0)
#define ATT_STORE(blk) do { const int _p = (((blk) & 1) * 128 + srow); \
        *(LAS u32x4*)(Kl + _p * AK_RS + sc4 * 16) = kx[0]; *(LAS u32x4*)(Kl + _p * AK_RS + 64 + sc4 * 16) = kx[1]; *(LAS u32x4*)(Vl + _p * AV_RS + sc4 * 16) = vx[0]; *(LAS u32x4*)(Vl + _p * AV_RS + 64 + sc4 * 16) = vx[1]; } while (0)
    __syncthreads();
    if (nb0 > 0) { ATT_LOAD(nb0 - 1); ATT_STORE(nb0 - 1); }
    else { kx[0] = kx[1] = vx[0] = vx[1] = (u32x4){0u, 0u, 0u, 0u}; ATT_STORE(1); }
    ATT_LOAD(nb0); ATT_STORE(nb0);
    bf16x8 qn0, qn1;
    { const size_t qo = (tok0 + (size_t)(nb0 * 128 + 16 * w + fr) * dl) * 512; qn0 = *(const bf16x8*)(Qg + qo + fq * 8); qn1 = *(const bf16x8*)(Qg + qo + 32 + fq * 8); }
    __syncthreads();
    for (int nb = nb0; nb < nb0 + 8; ++nb) {
        const bool more = nb + 1 < nb0 + 8;
        if (more) ATT_LOAD(nb + 1);
        const size_t qoff = (tok0 + (size_t)(nb * 128 + 16 * w + fr) * dl) * 512;
        const bf16x8 q0 = qn0, q1 = qn1;
        if (more) { const size_t qo2 = qoff + (size_t)128 * dl * 512; qn0 = *(const bf16x8*)(Qg + qo2 + fq * 8); qn1 = *(const bf16x8*)(Qg + qo2 + 32 + fq * 8); }
        const int pslot = (nb - 1) & 1;
        f32x4 S[10];
        S[9] = (f32x4){0.f, 0.f, 0.f, 0.f};
#pragma unroll
        for (int kbi = 0; kbi < 9; ++kbi) {
            int kb = w + kbi; if (kb > 15) kb = 15;
            const int ki = kb * 16 + fr; const int phys = ((pslot + (ki >> 7)) & 1) * 128 + (ki & 127);
            const bf16x8 k0 = *(const LAS bf16x8*)(Kl + phys * AK_RS + fq * 16), k1 = *(const LAS bf16x8*)(Kl + phys * AK_RS + 64 + fq * 16);
            f32x4 a = (f32x4){0.f, 0.f, 0.f, 0.f};
            a = __builtin_amdgcn_mfma_f32_16x16x32_bf16(k0, q0, a, 0, 0, 0);
            S[kbi] = __builtin_amdgcn_mfma_f32_16x16x32_bf16(k1, q1, a, 0, 0, 0);
        }
        float mx = -INFINITY;
        const int dbase = fr - 4 * fq + 128; const float fb = slope * (float)dbase; const int kmin = (nb > 0) ? 0 : 128 - (16 * w + 4 * fq);
#pragma unroll
        for (int kbi = 0; kbi < 9; ++kbi)
#pragma unroll
            for (int j = 0; j < 4; ++j) { const int cj = 16 * kbi + j;
                const bool ok = (unsigned)(dbase - cj) <= 128u && cj >= kmin;
                const float sc = ok ? __builtin_fmaf(slope, (float)cj, S[kbi][j] - fb) : -INFINITY; S[kbi][j] = sc; mx = fmaxf(mx, sc); }
        mx = fmaxf(mx, __shfl_xor(mx, 16)); mx = fmaxf(mx, __shfl_xor(mx, 32));
        float ls = 0.f;
#pragma unroll
        for (int kbi = 0; kbi < 9; ++kbi)
#pragma unroll
            for (int j = 0; j < 4; ++j) { const float p = __builtin_amdgcn_exp2f(S[kbi][j] - mx); S[kbi][j] = p; ls += p; }
        ls += __shfl_xor(ls, 16); ls += __shfl_xor(ls, 32);
        f32x4 O[4];
#pragma unroll
        for (int db = 0; db < 4; ++db) O[db] = (f32x4){0.f, 0.f, 0.f, 0.f};
#pragma unroll
        for (int k2 = 0; k2 < 5; ++k2) {
            u32x4 pw; pw.x = cvt_pk_bf16(S[2 * k2][0], S[2 * k2][1]); pw.y = cvt_pk_bf16(S[2 * k2][2], S[2 * k2][3]); pw.z = cvt_pk_bf16(S[2 * k2 + 1][0], S[2 * k2 + 1][1]); pw.w = cvt_pk_bf16(S[2 * k2 + 1][2], S[2 * k2 + 1][3]);
            const bf16x8 pf = __builtin_bit_cast(bf16x8, pw);
            int kb0 = w + 2 * k2, kb1 = kb0 + 1; if (kb1 > 15) kb1 = 15; if (kb0 > 15) kb0 = 15;
            const int r0 = kb0 * 16 + 4 * fq + (fr >> 2), r1 = kb1 * 16 + 4 * fq + (fr >> 2);
            const int p0 = ((pslot + (r0 >> 7)) & 1) * 128 + (r0 & 127), p1 = ((pslot + (r1 >> 7)) & 1) * 128 + (r1 & 127);
#pragma unroll
            for (int db = 0; db < 4; ++db) {
                const s16x4 v0 = lds_tr16(Vl + p0 * AV_RS + (db * 16 + 4 * (fr & 3)) * 2), v1 = lds_tr16(Vl + p1 * AV_RS + (db * 16 + 4 * (fr & 3)) * 2);
                const bf16x8 vf = (bf16x8){v0[0], v0[1], v0[2], v0[3], v1[0], v1[1], v1[2], v1[3]};
                O[db] = __builtin_amdgcn_mfma_f32_16x16x32_bf16(vf, pf, O[db], 0, 0, 0);
            }
        }
        const float inv = 1.0f / ls;
#pragma unroll
        for (int db = 0; db < 4; ++db) { u32x2 ow; ow.x = cvt_pk_bf16(O[db][0] * inv, O[db][1] * inv); ow.y = cvt_pk_bf16(O[db][2] * inv, O[db][3] * inv);
            *(u32x2*)(Qg + qoff + db * 16 + 4 * fq) = ow; }
        if (fq == 0) LSE[(qoff >> 9) * 8] = mx + __builtin_amdgcn_logf(ls);
        __syncthreads();
        if (more) ATT_STORE(nb + 1);
        __syncthreads();
    }
#undef ATT_LOAD
#undef ATT_STORE
}
__device__ __forceinline__ void attn_combine(const Ctx& F) {
    const float* LSE = (const float*)(F.ws + WS_LOGITS);
    for (int i0 = F.bid * NTHREADS + F.tid; i0 < T * 64; i0 += 4 * F.G * NTHREADS) {
        u32x4 a[4], bb[4], cc[4]; float l0[4], l1[4], l2[4];
#pragma unroll
        for (int k = 0; k < 4; ++k) { const int i = i0 + k * F.G * NTHREADS; const int ic = i < T * 64 ? i : 0; const int t = ic >> 6, slot = (ic & 63) >> 3;
            a[k] = ((const u32x4*)(F.ws + WS_QA0))[ic]; bb[k] = ((const u32x4*)(F.ws + WS_QA1))[ic]; cc[k] = ((const u32x4*)(F.ws + WS_QA2))[ic];
            l0[k] = LSE[(size_t)t * 8 + slot]; l1[k] = LSE[(size_t)T * 8 + (size_t)t * 8 + slot]; l2[k] = LSE[(size_t)2 * T * 8 + (size_t)t * 8 + slot]; }
        PIN4(a[0], a[1], a[2], a[3]); PIN4(bb[0], bb[1], bb[2], bb[3]); PIN4(cc[0], cc[1], cc[2], cc[3]);
#pragma unroll
        for (int k = 0; k < 4; ++k) { const int i = i0 + k * F.G * NTHREADS; if (i < T * 64) {
            const float m = fmaxf(l0[k], fmaxf(l1[k], l2[k])); float w0 = __builtin_amdgcn_exp2f(l0[k] - m), w1 = __builtin_amdgcn_exp2f(l1[k] - m), w2 = __builtin_amdgcn_exp2f(l2[k] - m); const float inv = __builtin_amdgcn_rcpf(w0 + w1 + w2); w0 *= inv; w1 *= inv; w2 *= inv;
            f32x4 a0, a1, b0, b1, c0, c1; unpack8(a[k], a0, a1); unpack8(bb[k], b0, b1); unpack8(cc[k], c0, c1);
            ((u32x4*)(F.ws + WS_QA0))[i] = pack8(a0 * w0 + b0 * w1 + c0 * w2, a1 * w0 + b1 * w1 + c1 * w2); } }
    }
}

__device__ __forceinline__ void conv_item(const Ctx& F, int layer, int item) {
    const int t0 = item * 32, s0 = t0 & (SEQ - 1), tid = F.tid;
    LAS bf16_t* sin = (LAS bf16_t*)F.lds;
    LAS float* sout = (LAS float*)(F.lds + 65536);
    const bf16_t* YG = (const bf16_t*)(F.ws + WS_YG);
    __syncthreads();
#pragma unroll 1
    for (int kb = 0; kb < 2; ++kb) { u32x4 sv[4];
#pragma unroll
        for (int k = 0; k < 4; ++k) { const int i = tid + (kb * 4 + k) * NTHREADS; const int r = i < 62 * 64 ? (i >> 6) : 0, c8 = i & 63; const int sp = s0 - 30 + r;
            sv[k] = *(const u32x4*)(YG + (size_t)(sp >= 0 ? t0 - 30 + r : t0) * 512 + c8 * 8); }
        PIN4(sv[0], sv[1], sv[2], sv[3]);
#pragma unroll
        for (int k = 0; k < 4; ++k) { const int i = tid + (kb * 4 + k) * NTHREADS; const int r = i >> 6, c8 = i & 63; const int sp = s0 - 30 + r;
            if (i < 62 * 64) *(LAS u32x4*)(sin + r * 512 + c8 * 8) = sp >= 0 ? sv[k] : (u32x4){0u, 0u, 0u, 0u}; } }
    const int cp = tid & 255, hf = tid >> 8;
    f32x2 w[31];
    const float* cw = F.in[I_CONVW] + (size_t)layer * 31 * 512 + 2 * cp;
#pragma unroll
    for (int k = 0; k < 31; ++k) w[k] = *(const f32x2*)(cw + k * 512);
    const f32x2 cb = *(const f32x2*)(F.in[I_CONVB] + layer * 512 + 2 * cp);
    __syncthreads();
#pragma unroll 1
    for (int ps = 0; ps < 2; ++ps) { const int tb = 16 * hf + 8 * ps;
        f32x2 xin[38];
#pragma unroll
        for (int r = 0; r < 38; ++r) { const unsigned u = *(const LAS unsigned*)(sin + (tb + r) * 512 + 2 * cp); xin[r] = (f32x2){bf_lo(u), bf_hi(u)}; }
#pragma unroll
        for (int tt = 0; tt < 8; ++tt) { f32x2 a = cb;
#pragma unroll
            for (int k = 0; k < 31; ++k) a += w[k] * xin[tt + k];
            *(LAS f32x2*)(sout + (tb + tt) * 512 + 2 * cp) = a; } }
    __syncthreads();
    const float* lg = F.in[I_CLNG] + layer * 512 + F.lane * 8; const float* lb = F.in[I_CLNB] + layer * 512 + F.lane * 8;
    for (int tt = F.wave; tt < 32; tt += NWAVES) {
        float v[8]; float sm = 0.f;
#pragma unroll
        for (int j = 0; j < 8; ++j) { v[j] = sout[tt * 512 + F.lane * 8 + j]; sm += v[j]; }
        const float mu = wave_sum(sm) * (1.0f / 512.0f); float q = 0.f;
#pragma unroll
        for (int j = 0; j < 8; ++j) { v[j] -= mu; q += v[j] * v[j]; }
        const float rstd = rsqrtf(wave_sum(q) * (1.0f / 512.0f) + EPS);
        float o[8];
#pragma unroll
        for (int j = 0; j < 8; ++j) o[j] = siluf_(v[j] * rstd * lg[j] + lb[j]);
        u32x4 wv; wv.x = cvt_pk_bf16(o[0], o[1]); wv.y = cvt_pk_bf16(o[2], o[3]); wv.z = cvt_pk_bf16(o[4], o[5]); wv.w = cvt_pk_bf16(o[6], o[7]);
        *(u32x4*)((bf16_t*)(F.ws + WS_YC) + (size_t)(t0 + tt) * 512 + F.lane * 8) = wv;
    }
}

__device__ __forceinline__ float log_sigmoid_(float v) { return fminf(v, 0.f) - log1pf(__expf(-fabsf(v))); }
struct QkW { float w[4][8]; float b[8]; };
__device__ __forceinline__ void qk_load_w(const Ctx& F, int layer, int chq, QkW& W) {
    const float* cw = F.in[I_MCW] + (size_t)layer * 4 * 1024 + chq; const float* cb = F.in[I_MCB] + (size_t)layer * 1024 + chq;
#pragma unroll
    for (int k = 0; k < 4; ++k) { const f32x4 a = *(const f32x4*)(cw + k * 1024), b = *(const f32x4*)(cw + k * 1024 + 4); W.w[k][0] = a.x; W.w[k][1] = a.y; W.w[k][2] = a.z; W.w[k][3] = a.w; W.w[k][4] = b.x; W.w[k][5] = b.y; W.w[k][6] = b.z; W.w[k][7] = b.w; }
    const f32x4 a = *(const f32x4*)cb, b = *(const f32x4*)(cb + 4); W.b[0] = a.x; W.b[1] = a.y; W.b[2] = a.z; W.b[3] = a.w; W.b[4] = b.x; W.b[5] = b.y; W.b[6] = b.z; W.b[7] = b.w;
}
__device__ __forceinline__ void qk_conv8(const QkW& W, const bf16_t* src  , int t, int s, int ch  , float scale, float* o) {
#pragma unroll
    for (int j = 0; j < 8; ++j) o[j] = W.b[j];
#pragma unroll
    for (int k = 0; k < 4; ++k) { const bool ok = s - 3 + k >= 0; u32x4 w = *(const u32x4*)(src + (size_t)(ok ? t - 3 + k : t) * 512 + ch);
            if (!ok) w = (u32x4){0u, 0u, 0u, 0u};
            o[0] += W.w[k][0] * bf_lo(w.x); o[1] += W.w[k][1] * bf_hi(w.x); o[2] += W.w[k][2] * bf_lo(w.y); o[3] += W.w[k][3] * bf_hi(w.y); o[4] += W.w[k][4] * bf_lo(w.z); o[5] += W.w[k][5] * bf_hi(w.z); o[6] += W.w[k][6] * bf_lo(w.w); o[7] += W.w[k][7] * bf_hi(w.w); }
#pragma unroll
    for (int j = 0; j < 8; ++j) o[j] = siluf_(o[j]) * scale;
}
__device__ __forceinline__ void qk_conv8r(const QkW& W, const u32x4 (&rw)[4], int s, float scale, float* o) {
#pragma unroll
    for (int j = 0; j < 8; ++j) o[j] = W.b[j];
#pragma unroll
    for (int k = 0; k < 4; ++k) { u32x4 w = rw[k]; if (s - 3 + k < 0) w = (u32x4){0u, 0u, 0u, 0u};
        o[0] += W.w[k][0] * bf_lo(w.x); o[1] += W.w[k][1] * bf_hi(w.x); o[2] += W.w[k][2] * bf_lo(w.y); o[3] += W.w[k][3] * bf_hi(w.y); o[4] += W.w[k][4] * bf_lo(w.z); o[5] += W.w[k][5] * bf_hi(w.z); o[6] += W.w[k][6] * bf_lo(w.w); o[7] += W.w[k][7] * bf_hi(w.w); }
#pragma unroll
    for (int j = 0; j < 8; ++j) o[j] = siluf_(o[j]) * scale;
}
__device__ __forceinline__ void mlstm_scalars(const Ctx& F, int layer, int t0, int h, LAS float* sIG, LAS float* sBC) {
    if (F.tid < 128) { const float* IFp = (const float*)(F.ws + WS_IF) + (size_t)(t0 + F.tid) * 8;
        sIG[F.tid] = IFp[h] + F.in[I_MIB][layer * 4 + h]; sBC[F.tid] = log_sigmoid_(IFp[4 + h] + F.in[I_MFB][layer * 4 + h]); }
    __syncthreads();
    if (F.wave == 0) { const float a = sBC[2 * F.lane], bb = sBC[2 * F.lane + 1]; float sc = a + bb;
#pragma unroll
        for (int off = 1; off < 64; off <<= 1) { const float t = __shfl_up(sc, off); if (F.lane >= off) sc += t; }
        sBC[2 * F.lane] = sc - bb; sBC[2 * F.lane + 1] = sc; }
    __syncthreads();
}
constexpr int ML_KRS = 288, ML_ERS = 352, ML_E = 128 * ML_KRS, ML_S = ML_E + 128 * ML_ERS;
__device__ __forceinline__ void mlstm_local_mfma(const Ctx& F, int layer, int item) {
    const int c = item & 127, bh = item >> 7, h = bh & 3, b = bh >> 2, t0 = b * SEQ + c * 128, tid = F.tid, lane = F.lane, w = F.wave, fr = lane & 15, fq = lane >> 4;
    LAS unsigned char* L = F.lds;
    LAS float* sIG = (LAS float*)(L + ML_S); LAS float* sBC = sIG + 128; LAS float* sE = sIG + 256; LAS float* sM = sIG + 384;
    __syncthreads();
    mlstm_scalars(F, layer, t0, h, sIG, sBC);
    if (w == 0) { const float gt = sBC[127]; const float m = wave_max(fmaxf(gt - sBC[lane] + sIG[lane], gt - sBC[lane + 64] + sIG[lane + 64])); if (lane == 0) { sM[0] = m; sM[1] = gt; } }
    __syncthreads();
    if (tid < 128) sE[tid] = __expf(sM[1] - sBC[tid] + sIG[tid] - sM[0]);
    __syncthreads();
    const bf16_t* KM = (const bf16_t*)(F.ws + WS_KM); const bf16_t* VM = (const bf16_t*)(F.ws + WS_VM);
    QkW WK; qk_load_w(F, layer, 512 + h * 128 + (tid & 15) * 8, WK);
#pragma unroll 1
    for (int i = tid; i < 128 * 16; i += NTHREADS) { const int l = i >> 4, c8 = (i & 15) * 8; const int t = t0 + l, s = t & (SEQ - 1);
        u32x4 rk[4];
#pragma unroll
        for (int k = 0; k < 4; ++k) rk[k] = *(const u32x4*)(KM + (size_t)(s - 3 + k >= 0 ? t - 3 + k : t) * 512 + h * 128 + c8);
        const u32x4 rv = *(const u32x4*)(VM + (size_t)t * 512 + h * 128 + c8);
        float o[8]; qk_conv8r(WK, rk, s, 0.08838834764831845f, o);
        *(LAS u32x4*)(L + l * ML_KRS + c8 * 2) = pack8((f32x4){o[0], o[1], o[2], o[3]}, (f32x4){o[4], o[5], o[6], o[7]});
        f32x4 v0, v1; unpack8(rv, v0, v1); const float e = sE[l];
        *(LAS u32x4*)(L + ML_E + l * ML_ERS + c8 * 2) = pack8(v0 * e, v1 * e); }
    if (tid < 128) { unsigned zr = 0u; asm volatile("" : "+v"(zr));
        u32x4 z; z.x = f2bf(sE[tid]); z.y = zr; z.z = zr; z.w = zr; *(LAS u32x4*)(L + ML_E + tid * ML_ERS + 256) = z; z.x = zr; *(LAS u32x4*)(L + ML_E + tid * ML_ERS + 272) = z; }
    __syncthreads();
    bf16x8 af[4];
#pragma unroll
    for (int ks = 0; ks < 4; ++ks) { const int ra = ks * 32 + 4 * fq + (fr >> 2);
        const s16x4 a0 = lds_tr16(L + ra * ML_KRS + (w * 16 + 4 * (fr & 3)) * 2), a1 = lds_tr16(L + (ra + 16) * ML_KRS + (w * 16 + 4 * (fr & 3)) * 2);
        af[ks] = (bf16x8){a0[0], a0[1], a0[2], a0[3], a1[0], a1[1], a1[2], a1[3]}; }
    bf16_t* Cp = (bf16_t*)(F.ws + WS_CST) + ((size_t)(bh * 128 + c) << 14);
#pragma unroll
    for (int vb = 0; vb < 9; ++vb) { f32x4 d = (f32x4){0.f, 0.f, 0.f, 0.f};
#pragma unroll
        for (int ks = 0; ks < 4; ++ks) { const int rb = ks * 32 + 4 * fq + (fr >> 2);
            const s16x4 b0 = lds_tr16(L + ML_E + rb * ML_ERS + (vb * 16 + 4 * (fr & 3)) * 2), b1 = lds_tr16(L + ML_E + (rb + 16) * ML_ERS + (vb * 16 + 4 * (fr & 3)) * 2);
            const bf16x8 bfr = (bf16x8){b0[0], b0[1], b0[2], b0[3], b1[0], b1[1], b1[2], b1[3]};
            d = __builtin_amdgcn_mfma_f32_16x16x32_bf16(af[ks], bfr, d, 0, 0, 0); }
        if (vb < 8) { u32x2 o; o.x = pk2(d[0], d[1]); o.y = pk2(d[2], d[3]); *(u32x2*)(Cp + (size_t)(vb * 16 + fr) * 128 + w * 16 + 4 * fq) = o; }
        else if (fr == 0) *(f32x4*)((float*)(F.ws + WS_NST) + (size_t)(bh * 128 + c) * 128 + w * 16 + 4 * fq) = d;
    }
    if (tid == 0) { ((float*)(F.ws + WS_TAB + TAB_MLOC))[bh * 128 + c] = sM[0]; ((float*)(F.ws + WS_TAB + TAB_GTOT))[bh * 128 + c] = sM[1]; }
}
__device__ __forceinline__ void phase_scan(const Ctx& F) {
    const float* GT = (const float*)(F.ws + WS_TAB + TAB_GTOT); const float* ML = (const float*)(F.ws + WS_TAB + TAB_MLOC); float* MS = (float*)(F.ws + WS_TAB + TAB_MST);
    LAS float* sA = (LAS float*)F.lds; LAS float* sB = sA + 128;
    for (int blk = F.bid; blk < 8 * 32; blk += F.G) {
        const int bh = blk >> 5;
        __syncthreads();
        if (F.tid < 128) { sA[F.tid] = GT[bh * 128 + F.tid]; sB[F.tid] = ML[bh * 128 + F.tid]; }
        __syncthreads();
        if (F.wave == 0) {
            const int c0 = 2 * F.lane; const float g0 = sA[c0], m0 = sB[c0], g1 = sA[c0 + 1], m1 = sB[c0 + 1];
            float G = g0 + g1, M = fmaxf(m0 + g1, m1);
#pragma unroll
            for (int off = 1; off < 64; off <<= 1) { const float Gp = __shfl_up(G, off), Mp = __shfl_up(M, off); if (F.lane >= off) { M = fmaxf(Mp + G, M); G = Gp + G; } }
            float Gx = __shfl_up(G, 1), Mx = __shfl_up(M, 1); if (F.lane == 0) { Gx = 0.f; Mx = -INFINITY; }
            const float mA = fmaxf(0.f + Gx, Mx);
            const float mB = fmaxf(mA + g0, m0);
            const float mC = fmaxf(mB + g1, m1);
            sA[c0] = __expf(g0 + mA - mB); sB[c0] = __expf(m0 - mB); sA[c0 + 1] = __expf(g1 + mB - mC); sB[c0 + 1] = __expf(m1 - mC);
            if ((blk & 31) == 0) { MS[bh * 128 + c0] = mA; MS[bh * 128 + c0 + 1] = mB; } }
        __syncthreads();
        bf16_t* cp = (bf16_t*)(F.ws + WS_CST) + ((size_t)(bh * 128) << 14) + (blk & 31) * 512 + F.tid; float val = 0.f;
        const bool hasn = F.tid < 4; float* np = (float*)(F.ws + WS_NST) + (size_t)(bh * 128) * 128 + (hasn ? (blk & 31) * 4 + F.tid : 0); float nval = 0.f;
        for (int c0 = 0; c0 < 128; c0 += 16) { float loc[16], nloc[16];
#pragma unroll
            for (int j = 0; j < 16; ++j) { loc[j] = bf1(cp[(size_t)(c0 + j) << 14]); nloc[j] = np[(size_t)(c0 + j) * 128]; }
            PIN8(loc[0], loc[1], loc[2], loc[3], loc[4], loc[5], loc[6], loc[7]); PIN8(loc[8], loc[9], loc[10], loc[11], loc[12], loc[13], loc[14], loc[15]);
            PIN8(nloc[0], nloc[1], nloc[2], nloc[3], nloc[4], nloc[5], nloc[6], nloc[7]); PIN8(nloc[8], nloc[9], nloc[10], nloc[11], nloc[12], nloc[13], nloc[14], nloc[15]);
#pragma unroll
            for (int j = 0; j < 16; ++j) { const float a = sA[c0 + j], b = sB[c0 + j];
                cp[(size_t)(c0 + j) << 14] = (bf16_t)f2bf(val); val = a * val + b * loc[j];
                if (hasn) np[(size_t)(c0 + j) * 128] = nval; nval = a * nval + b * nloc[j]; } }
    }
    __syncthreads();
}
constexpr int MO_RS = 272, MO_VRS = 288;
constexpr int MO_Q = 0, MO_K = 128 * MO_RS, MO_C = 2 * 128 * MO_RS, MO_V = MO_C + 144 * MO_RS, MO_S = MO_V + 128 * MO_VRS;
static_assert(MO_S + 2560 <= MISC_OFF, "mlstm_out LDS");
__device__ __forceinline__ void mlstm_out_mfma(const Ctx& F, int layer, int item) {
    const int c = item & 127, bh = item >> 7, h = bh & 3, b = bh >> 2, t0 = b * SEQ + c * 128, tid = F.tid, lane = F.lane, w = F.wave, fr = lane & 15, fq = lane >> 4;
    LAS unsigned char* L = F.lds;
    LAS float* sIG = (LAS float*)(L + MO_S); LAS float* sBC = sIG + 128; LAS float* sMT = sIG + 256; LAS float* sSI = sIG + 384; LAS float* sU = sIG + 512;
    __syncthreads();
    mlstm_scalars(F, layer, t0, h, sIG, sBC);
    if (tid < 128) sU[tid] = (sIG[tid] - sBC[tid]) * 1.4426950408889634f;
    const float mst = ((const float*)(F.ws + WS_TAB + TAB_MST))[bh * 128 + c];
    if (w == 0) { const float a = sIG[2 * lane] - sBC[2 * lane], bb = sIG[2 * lane + 1] - sBC[2 * lane + 1]; float pm = fmaxf(a, bb);
#pragma unroll
        for (int off = 1; off < 64; off <<= 1) { const float t = __shfl_up(pm, off); if (lane >= off) pm = fmaxf(pm, t); }
        float pl = __shfl_up(pm, 1); if (lane == 0) pl = -INFINITY;
        const float p0 = fmaxf(pl, a), p1 = pm;
        { const float ai = sBC[2 * lane] + mst, mt = fmaxf(ai, sBC[2 * lane] + p0); sMT[2 * lane] = mt; sSI[2 * lane] = __expf(ai - mt); }
        { const float ai = sBC[2 * lane + 1] + mst, mt = fmaxf(ai, sBC[2 * lane + 1] + p1); sMT[2 * lane + 1] = mt; sSI[2 * lane + 1] = __expf(ai - mt); } }
    const bf16_t* QM = (const bf16_t*)(F.ws + WS_QM); const bf16_t* KM = (const bf16_t*)(F.ws + WS_KM); const bf16_t* VM = (const bf16_t*)(F.ws + WS_VM);
    const bf16_t* Cp = (const bf16_t*)(F.ws + WS_CST) + ((size_t)(bh * 128 + c) << 14);
    QkW WQ, WK; qk_load_w(F, layer, h * 128 + (tid & 15) * 8, WQ); qk_load_w(F, layer, 512 + h * 128 + (tid & 15) * 8, WK);
#pragma unroll 1
    for (int i = tid; i < 128 * 16; i += NTHREADS) { const int l = i >> 4, c8 = (i & 15) * 8; const int t = t0 + l, s = t & (SEQ - 1); float o[8];
        u32x4 rq[4], rk[4];
#pragma unroll
        for (int k = 0; k < 4; ++k) { const size_t ro = (size_t)(s - 3 + k >= 0 ? t - 3 + k : t) * 512 + h * 128 + c8; rq[k] = *(const u32x4*)(QM + ro); rk[k] = *(const u32x4*)(KM + ro); }
        const u32x4 rv = *(const u32x4*)(VM + (size_t)t * 512 + h * 128 + c8), rc = *(const u32x4*)(Cp + l * 128 + c8);
        qk_conv8r(WQ, rq, s, 1.0f, o);
        *(LAS u32x4*)(L + MO_Q + l * MO_RS + c8 * 2) = pack8((f32x4){o[0], o[1], o[2], o[3]}, (f32x4){o[4], o[5], o[6], o[7]});
        qk_conv8r(WK, rk, s, 0.08838834764831845f, o);
        *(LAS u32x4*)(L + MO_K + l * MO_RS + c8 * 2) = pack8((f32x4){o[0], o[1], o[2], o[3]}, (f32x4){o[4], o[5], o[6], o[7]});
        *(LAS u32x4*)(L + MO_V + l * MO_VRS + c8 * 2) = rv;
        *(LAS u32x4*)(L + MO_C + l * MO_RS + c8 * 2) = rc; }
    if (tid < 16) { const float* np = (const float*)(F.ws + WS_NST) + (size_t)(bh * 128 + c) * 128 + tid * 8;
        *(LAS u32x4*)(L + MO_C + 128 * MO_RS + tid * 16) = pack8(*(const f32x4*)np, *(const f32x4*)(np + 4)); }
    __syncthreads();
    const int q = 16 * w + fr;
    bf16x8 qf[4];
#pragma unroll
    for (int ks = 0; ks < 4; ++ks) qf[ks] = *(const LAS bf16x8*)(L + MO_Q + q * MO_RS + ks * 64 + fq * 16);
    f32x4 O[9];
#pragma unroll
    for (int vb = 0; vb < 9; ++vb) { f32x4 a = (f32x4){0.f, 0.f, 0.f, 0.f};
#pragma unroll
        for (int ks = 0; ks < 4; ++ks) { const bf16x8 cf = *(const LAS bf16x8*)(L + MO_C + (vb * 16 + fr) * MO_RS + ks * 64 + fq * 16); a = __builtin_amdgcn_mfma_f32_16x16x32_bf16(cf, qf[ks], a, 0, 0, 0); }
        O[vb] = a; }
    const float si = sSI[q], mt = sMT[q], bq = sBC[q]; const float vq = (bq - mt) * 1.4426950408889634f;
    const float dn = __shfl(O[8][0], fr);
#pragma unroll
    for (int vb = 0; vb < 8; ++vb) O[vb] = O[vb] * si;
    float den = 0.f;
    for (int k2 = 0; k2 <= (w >> 1); ++k2) {
        f32x4 P[2];
#pragma unroll
        for (int u = 0; u < 2; ++u) { const int kb = 2 * k2 + u; f32x4 a = (f32x4){0.f, 0.f, 0.f, 0.f};
            const int kr = (kb > 7 ? 7 : kb) * 16 + fr;
#pragma unroll
            for (int ks = 0; ks < 4; ++ks) { const bf16x8 kf = *(const LAS bf16x8*)(L + MO_K + kr * MO_RS + ks * 64 + fq * 16); a = __builtin_amdgcn_mfma_f32_16x16x32_bf16(kf, qf[ks], a, 0, 0, 0); }
#pragma unroll
            for (int j = 0; j < 4; ++j) { const int k = kb * 16 + 4 * fq + j; const int kc = k > 127 ? 127 : k; const float wgt = (k <= q) ? __builtin_amdgcn_exp2f(sU[kc] + vq) : 0.f; a[j] *= wgt; den += a[j]; }
            P[u] = a; }
        u32x4 pw; pw.x = cvt_pk_bf16(P[0][0], P[0][1]); pw.y = cvt_pk_bf16(P[0][2], P[0][3]); pw.z = cvt_pk_bf16(P[1][0], P[1][1]); pw.w = cvt_pk_bf16(P[1][2], P[1][3]);
        const bf16x8 pf = __builtin_bit_cast(bf16x8, pw);
        const int kb1 = (2 * k2 + 1 > 7) ? 7 : 2 * k2 + 1;
        const int r0 = 2 * k2 * 16 + 4 * fq + (fr >> 2), r1 = kb1 * 16 + 4 * fq + (fr >> 2);
#pragma unroll
        for (int vb = 0; vb < 8; ++vb) {
            const s16x4 v0 = lds_tr16(L + MO_V + r0 * MO_VRS + (vb * 16 + 4 * (fr & 3)) * 2), v1 = lds_tr16(L + MO_V + r1 * MO_VRS + (vb * 16 + 4 * (fr & 3)) * 2);
            const bf16x8 vf = (bf16x8){v0[0], v0[1], v0[2], v0[3], v1[0], v1[1], v1[2], v1[3]};
            O[vb] = __builtin_amdgcn_mfma_f32_16x16x32_bf16(vf, pf, O[vb], 0, 0, 0);
        }
    }
    den += __shfl_xor(den, 16); den += __shfl_xor(den, 32);
    const float dd = den + si * dn; const float inv = 1.0f / fmaxf(fabsf(dd), __expf(-mt));
    bf16_t* OM = (bf16_t*)(F.ws + WS_OM) + (size_t)(t0 + q) * 512 + h * 128;
#pragma unroll
    for (int vb = 0; vb < 8; ++vb) { u32x2* p = (u32x2*)(OM + vb * 16 + 4 * fq); const u32x2 g = *p;
        u32x2 o; o.x = cvt_pk_bf16(bf_lo(g.x) * O[vb][0] * inv, bf_hi(g.x) * O[vb][1] * inv); o.y = cvt_pk_bf16(bf_lo(g.y) * O[vb][2] * inv, bf_hi(g.y) * O[vb][3] * inv); *p = o; }
}

__device__ __forceinline__ void phase_route(const Ctx& F, int layer, int tile0, int tile1, int tstep) {
    LAS int* hist = (LAS int*)F.lds;
    const float* brg = F.in[I_BRG] + layer * 4; const float* bre = F.in[I_BRE] + layer * 32;
    for (int tile = tile0; tile < tile1; tile += tstep) {
        __syncthreads();
        if (F.tid < 128) { const int t = tile * 128 + F.tid; const float* lg = (const float*)(F.ws + WS_LOGITS) + (size_t)t * 64;
            float g[4]; int gs = 0; float gm;
#pragma unroll
            for (int j = 0; j < 4; ++j) g[j] = lg[j] + brg[j];
            gm = g[0];
#pragma unroll
            for (int j = 1; j < 4; ++j) if (g[j] > gm) { gm = g[j]; gs = j; }
            float se = 0.f;
#pragma unroll
            for (int j = 0; j < 4; ++j) se += __expf(g[j] - gm);
            const float pg = 1.0f / se;
            float le[8];
#pragma unroll
            for (int j = 0; j < 8; ++j) le[j] = lg[4 + gs * 8 + j] + bre[gs * 8 + j];
            int i0 = 0; float v0 = le[0];
#pragma unroll
            for (int j = 1; j < 8; ++j) if (le[j] > v0) { v0 = le[j]; i0 = j; }
            int i1 = -1; float v1 = -INFINITY;
#pragma unroll
            for (int j = 0; j < 8; ++j) if (j != i0 && le[j] > v1) { v1 = le[j]; i1 = j; }
            const float e1 = __expf(v1 - v0); const float wsc = (ABL == 4) ? 0.f : ((ABL == 6) ? 2.f : 1.f); const float w0 = wsc * pg / (1.0f + e1), w1 = wsc * pg * e1 / (1.0f + e1);
            const int x0 = gs * 8 + i0, x1 = gs * 8 + i1;
            ((int*)(F.ws + WS_ROUTE))[2 * t] = x0; ((int*)(F.ws + WS_ROUTE))[2 * t + 1] = x1;
            ((float*)(F.ws + WS_ROUTE))[2 * T + 2 * t] = w0; ((float*)(F.ws + WS_ROUTE))[2 * T + 2 * t + 1] = w1;
            hist[F.tid] = x0; hist[128 + F.tid] = x1;
        }
        __syncthreads();
        if (F.tid < 64) { const int k = F.tid >> 5, e = F.tid & 31; int cnt = 0; for (int j = 0; j < 128; ++j) cnt += (hist[k * 128 + j] == e) ? 1 : 0; ((int*)(F.ws + WS_TAB + TAB_CNT))[tile * 64 + F.tid] = cnt; }
        __syncthreads();
    }
}
__device__ __forceinline__ void phase_dispatch(const Ctx& F) {
    LAS int* sTot = (LAS int*)F.lds; LAS int* sBef = sTot + 64; LAS int* sPs = sTot + 128; LAS int* sE = sTot + 256; LAS int* sPart = sTot + 512;
    const int* CNT = (const int*)(F.ws + WS_TAB + TAB_CNT); int* META = (int*)(F.ws + WS_TAB + TAB_META);
    int* tokl = (int*)(F.ws + WS_LISTS); float* wl = (float*)(F.ws + WS_LISTS) + 2 * LISTCAP;
    for (int tile = F.bid; tile < 256; tile += F.G) {
        { const int ke = F.tid & 63, grp = F.tid >> 6; int cv[32];
#pragma unroll
            for (int i = 0; i < 32; ++i) cv[i] = CNT[(grp + 8 * i) * 64 + ke];
            int tot = 0, bef = 0;
#pragma unroll
            for (int i = 0; i < 32; ++i) { tot += cv[i]; bef += (grp + 8 * i < tile) ? cv[i] : 0; }
            sPart[grp * 64 + ke] = tot; sPart[512 + grp * 64 + ke] = bef; }
        __syncthreads();
        if (F.tid < 64) { int tot = 0, bef = 0;
#pragma unroll
            for (int gI = 0; gI < 8; ++gI) { tot += sPart[gI * 64 + F.tid]; bef += sPart[512 + gI * 64 + F.tid]; }
            sTot[F.tid] = tot; sBef[F.tid] = bef; }
        __syncthreads();
        if (F.tid < 2) { int ps = 0; for (int e = 0; e < 32; ++e) { sPs[F.tid * 33 + e] = ps; ps += ((sTot[F.tid * 32 + e] + 255) >> 8) << 8; } sPs[F.tid * 33 + 32] = ps;
            if (tile == 0) { META[F.tid] = ps >> 8; for (int e = 0; e <= 32; ++e) META[16 + 64 * F.tid + e] = sPs[F.tid * 33 + e]; } }
        int e0 = 0, e1 = 0; float w0 = 0.f, w1 = 0.f;
        if (F.tid < 128) { const int t = tile * 128 + F.tid; e0 = ((const int*)(F.ws + WS_ROUTE))[2 * t]; e1 = ((const int*)(F.ws + WS_ROUTE))[2 * t + 1];
            w0 = ((const float*)(F.ws + WS_ROUTE))[2 * T + 2 * t]; w1 = ((const float*)(F.ws + WS_ROUTE))[2 * T + 2 * t + 1]; sE[F.tid] = e0; sE[128 + F.tid] = e1; }
        __syncthreads();
        if (F.tid < 128) { int r0 = 0, r1 = 0; for (int j = 0; j < F.tid; ++j) { r0 += (sE[j] == e0) ? 1 : 0; r1 += (sE[128 + j] == e1) ? 1 : 0; }
            const int p0 = sPs[e0] + sBef[e0] + r0, p1 = sPs[33 + e1] + sBef[32 + e1] + r1;
            tokl[p0] = tile * 128 + F.tid; wl[p0] = w0; tokl[LISTCAP + p1] = tile * 128 + F.tid; wl[LISTCAP + p1] = w1; }
        __syncthreads();
    }
}
__device__ __forceinline__ void phase_final(const Ctx& F, const float* SS) {
    const int gw = F.bid * NWAVES + F.wave, NGW = F.G * NWAVES, lane = F.lane;
    const f32x4* g = (const f32x4*)F.in[I_GFIN] + 2 * lane; const f32x4 g00 = g[0], g01 = g[1], g10 = g[128], g11 = g[129];
    for (int m0 = gw; m0 < T; m0 += 4 * NGW) {
        u32x4 xr[4][2]; f32x4 sa[4];
#pragma unroll
        for (int r = 0; r < 4; ++r) { const int m = m0 + r * NGW; const u32x4* xp = (const u32x4*)((const bf16_t*)(F.ws + WS_XB) + (size_t)m * D) + lane; xr[r][0] = xp[0]; xr[r][1] = xp[64];
            sa[r] = *((const f32x4*)(SS + (size_t)m * 16) + (lane & 3)); }
        PIN8(xr[0][0], xr[0][1], xr[1][0], xr[1][1], xr[2][0], xr[2][1], xr[3][0], xr[3][1]); PIN4(sa[0], sa[1], sa[2], sa[3]);
#pragma unroll
        for (int r = 0; r < 4; ++r) { const int m = m0 + r * NGW; float sq = (sa[r].x + sa[r].y) + (sa[r].z + sa[r].w); sq += __shfl_xor(sq, 1); sq += __shfl_xor(sq, 2);
            const float rs = rsqrtf(sq * (1.0f / 1024.0f) + EPS); f32x4* o = (f32x4*)(F.out + (size_t)m * D) + 2 * lane;
            f32x4 x0, x1; unpack8(xr[r][0], x0, x1); o[0] = x0 * rs * g00; o[1] = x1 * rs * g01; unpack8(xr[r][1], x0, x1); o[128] = x0 * rs * g10; o[129] = x1 * rs * g11; }
    }
}
constexpr int PH_PER_LAYER = 15, PH_FINAL = DEPTH * PH_PER_LAYER, N_PHASES = PH_FINAL + 1;
struct Args { const float* in[28]; float* out; unsigned char* ws; int ph_lo, ph_hi; };

__device__ __forceinline__ Ctx mkctx(const Args& args, LAS unsigned char* lds, int wave_s) {
    Ctx F; asm volatile("" : "+s"(wave_s)); int tid = wave_s * 64 + lane_id_(); asm volatile("" : "+v"(tid));
    GAS unsigned char* wsg = (GAS unsigned char*)args.ws; asm volatile("" : "+s"(wsg)); unsigned char* ws = (unsigned char*)wsg;
    GAS float* outg = (GAS float*)args.out; asm volatile("" : "+s"(outg)); float* outp = (float*)outg;
    int bid = blockIdx.x; asm volatile("" : "+s"(bid)); int G = gridDim.x; asm volatile("" : "+s"(G));
    F.in.p = args.in; F.out = outp; F.ws = ws; F.lds = lds;
    F.tid = tid; F.lane = tid & 63; F.wave = wave_s; F.G = G; F.bid = bid;
    return F;
}
#ifndef ONLY_PHASE
#define ONLY_PHASE -1
#endif
#ifndef STAGGER_TICKS
#define STAGGER_TICKS 1300
#endif
__device__ __forceinline__ void run_phase(const Args& args, LAS unsigned char* lds, int ph, int wave_s) {
    const int layer = ph / PH_PER_LAYER, lp = ph - layer * PH_PER_LAYER;
    const size_t ssin = (layer & 1) ? WS_SS1 : WS_SS0, ssmid = (layer & 1) ? WS_SS0 : WS_SS1;
    if (ph == PH_FINAL) { const Ctx F = mkctx(args, lds, wave_s); phase_final(F, (const float*)(F.ws + WS_SS0)); return; }
    if (ONLY_PHASE >= 0 && lp != ONLY_PHASE) return;
    switch (lp) {
    case 0: { const Ctx F = mkctx(args, lds, wave_s); phase_prep(F, layer, (float*)(F.ws + ssin)); } break;
    case 1: { const Ctx F = mkctx(args, lds, wave_s); PhProj P{(const char*)F.ws + WS_XB, (const char*)F.ws + WS_WIN, (const float*)(F.ws + ssin), F.ws, F.G, F.bid}; pg8::gemm_phase(F.lds, P, F.tid); } break;
    case 2: { const Ctx F = mkctx(args, lds, wave_s);
        for (int it = F.bid; it < 768; it += F.G) attn_strip(F, it);
        __syncthreads();
        for (int it = F.bid; it < 1024; it += F.G) mlstm_local_mfma(F, layer, it);
        for (int it = F.bid; it < 1024; it += F.G) conv_item(F, layer, it);
    } break;
    case 3: { const Ctx F = mkctx(args, lds, wave_s); phase_scan(F); attn_combine(F); } break;
    case 4: { const Ctx F = mkctx(args, lds, wave_s); for (int it = F.bid; it < 1024; it += F.G) mlstm_out_mfma(F, layer, it); } break;
    case 5: { const Ctx F = mkctx(args, lds, wave_s); PhGates P{(const char*)F.ws + WS_XB, (const char*)F.ws + WS_WIN, (const float*)(F.ws + ssin), F.ws, F.G, F.bid}; pg8::gemm_phase(F.lds, P, F.tid); } break;
    case 6: { const Ctx F = mkctx(args, lds, wave_s); PhMerge P{F.ws, F.G, F.bid};
        pg8::gemm_phase(F.lds, P, F.tid); } break;
    case 7: { const Ctx F = mkctx(args, lds, wave_s); PhOut P{F.ws, (float*)(F.ws + ssmid), F.G, F.bid}; pg8::gemm_phase(F.lds, P, F.tid); } break;
    case 8: { const Ctx F = mkctx(args, lds, wave_s); PhRouter P{F.ws, (const float*)(F.ws + ssmid), F.G, F.bid}; pg8::gemm_phase(F.lds, P, F.tid);
        { int* tokl = (int*)(F.ws + WS_LISTS); for (int i = F.bid * NTHREADS + F.tid; i < 2 * LISTCAP; i += F.G * NTHREADS) tokl[i] = -1; }
        for (int pm = F.bid; pm < 128; pm += F.G) phase_route(F, layer, 2 * pm, 2 * pm + 2, 1);
        phase_prep_experts(F, layer); } break;
    case 9: break;
    case 10: { const Ctx F = mkctx(args, lds, wave_s); phase_dispatch(F); } break;
    case 11: { const Ctx F = mkctx(args, lds, wave_s); PhUp P{F.ws, (const float*)(F.ws + ssmid), (const int*)(F.ws + WS_TAB + TAB_META), (const int*)(F.ws + WS_LISTS), F.G, F.bid}; pg8::gemm_phase(F.lds, P, F.tid); } break;
    case 12: { const Ctx F = mkctx(args, lds, wave_s); PhDown<1> P{F.ws, (float*)(F.ws + ssin), (const int*)(F.ws + WS_TAB + TAB_META), (const int*)(F.ws + WS_LISTS), (const float*)(F.ws + WS_LISTS) + 2 * LISTCAP, F.G, F.bid}; pg8::gemm_phase(F.lds, P, F.tid); } break;
    case 13: { const Ctx F = mkctx(args, lds, wave_s); PhDown<0> P{F.ws, (float*)(F.ws + ssin), (const int*)(F.ws + WS_TAB + TAB_META), (const int*)(F.ws + WS_LISTS), (const float*)(F.ws + WS_LISTS) + 2 * LISTCAP, F.G, F.bid}; pg8::gemm_phase(F.lds, P, F.tid); } break;
    case 14: { const Ctx F = mkctx(args, lds, wave_s); PhPle P{F.ws, (const float*)(F.ws + ssin), (float*)(F.ws + ssmid), F.G, F.bid}; pg8::gemm_phase(F.lds, P, F.tid); } break;
    }
}

__global__ void __launch_bounds__(NTHREADS, 2) fwd_kernel(Args args) {
    extern __shared__ __attribute__((aligned(16))) unsigned char lds_raw[];
    LAS unsigned char* lds = (LAS unsigned char*)lds_raw;
    volatile LAS unsigned* MISC = (volatile LAS unsigned*)(lds + MISC_OFF);
    const int wave_s = __builtin_amdgcn_readfirstlane((int)threadIdx.x >> 6);
    if (wave_s == 0) MISC[lane_id_()] = 0u;
    __syncthreads();
#if MK_MEGA
    XcdBarrier bar = xcd_barrier_post((unsigned*)(args.ws + WS_CTL) + 4096, MISC + 8, wave_s);
#endif
#ifndef PROBE_SEL
#define PROBE_SEL 0
#endif
    unsigned long long extra = 0ull;
    for (int ph = args.ph_lo; ph < args.ph_hi; ++ph) {
        if (ph < PH_FINAL && (ph % PH_PER_LAYER) == 9) continue;
        const unsigned long long t0 = PROBE_SEL ? __builtin_amdgcn_s_memrealtime() : 0ull;
        run_phase(args, lds, ph, wave_s);
#if MK_MEGA
        if (ph + 1 < args.ph_hi) xcd_barrier(bar);
#endif
        if (PROBE_SEL) { const int lp = ph % PH_PER_LAYER; if (ph < PH_FINAL && ((PROBE_SEL >> lp) & 1)) extra += __builtin_amdgcn_s_memrealtime() - t0; }
    }
    if (PROBE_SEL && blockIdx.x == 0) { const unsigned long long te = __builtin_amdgcn_s_memrealtime(); while (__builtin_amdgcn_s_memrealtime() - te < extra) __builtin_amdgcn_s_sleep(8); }
}

extern "C" void kernel_launch(void* const* d_in, const int* in_sizes, int n_in, void* d_out, int out_size, void* d_ws, size_t ws_size, hipStream_t stream) {
    static int grid = 0;
    if (grid == 0) {
        if (n_in != 28 || out_size != T * D || ws_size < WS_END) { fprintf(stderr, "kernel_launch: unexpected shapes (n_in %d out %d ws %zu, need %zu)\n", n_in, out_size, ws_size, (size_t)WS_END); grid = -1; return; }
        int dev = 0, cus = 0, per_cu = 0;
        if (hipGetDevice(&dev) != hipSuccess || hipDeviceGetAttribute(&cus, hipDeviceAttributeMultiprocessorCount, dev) != hipSuccess) { grid = -1; return; }
        if (hipFuncSetAttribute((const void*)fwd_kernel, hipFuncAttributeMaxDynamicSharedMemorySize, LDS_BYTES) != hipSuccess) { fprintf(stderr, "kernel_launch: hipFuncSetAttribute failed\n"); grid = -1; return; }
        if (hipOccupancyMaxActiveBlocksPerMultiprocessor(&per_cu, (const void*)fwd_kernel, NTHREADS, LDS_BYTES) != hipSuccess || per_cu < 1) { fprintf(stderr, "kernel_launch: occupancy query says %d blocks per CU\n", per_cu); }
        (void)hipGetLastError();
        grid = cus;
    }
    if (grid < 0) return;
    Args a{};
    for (int i = 0; i < 28; ++i) a.in[i] = (const float*)d_in[i];
    a.out = (float*)d_out; a.ws = (unsigned char*)d_ws;
#if MK_MEGA
    (void)hipMemsetAsync((char*)d_ws + WS_CTL, 0, CTL_ZERO_BYTES, stream);
    a.ph_lo = 0; a.ph_hi = N_PHASES;
    hipLaunchKernelGGL(fwd_kernel, dim3(grid), dim3(NTHREADS), LDS_BYTES, stream, a);
#else
    for (int ph = 0; ph < N_PHASES; ++ph) { a.ph_lo = ph; a.ph_hi = ph + 1; hipLaunchKernelGGL(fwd_kernel, dim3(grid), dim3(NTHREADS), LDS_BYTES, stream, a); }
#endif
}
```

```cpp
#include <hip/hip_runtime.h>
#include <cstdio>
#include <cstdint>

#ifndef MK_MEGA
#define MK_MEGA 1
#endif

#ifndef ABL
#define ABL 0
#endif
#define LAS __attribute__((address_space(3)))
#define GAS __attribute__((address_space(1)))
typedef unsigned short bf16_t;
typedef short bf16x8 __attribute__((ext_vector_type(8)));
typedef float f32x4 __attribute__((ext_vector_type(4)));
typedef float f32x2 __attribute__((ext_vector_type(2)));
typedef unsigned u32x4 __attribute__((ext_vector_type(4)));
typedef unsigned u32x2 __attribute__((ext_vector_type(2)));

constexpr int T = 32768, SEQ = 16384, D = 1024, DEPTH = 2;
constexpr int D_IN = 8712;
constexpr float EPS = 1e-6f;
constexpr int NTHREADS = 512, NWAVES = 8;
constexpr int LISTCAP = 40960;

constexpr size_t MiB = 1u << 20;
constexpr size_t WS_CTL = 0, CTL_ZERO_BYTES = 1 * MiB;
constexpr size_t WS_TAB = 1 * MiB;
constexpr size_t WS_ROUTE = 2 * MiB;
constexpr size_t WS_LISTS = 3 * MiB;
constexpr size_t WS_SS0 = 4 * MiB, WS_SS1 = 6 * MiB;
constexpr size_t WS_IF = 8 * MiB;
constexpr size_t WS_NST = 9 * MiB;
constexpr size_t WS_LOGITS = 10 * MiB;
constexpr size_t WS_WIN = 18 * MiB;
constexpr size_t WS_WBR = WS_WIN + 8960ull * 1024 * 2;
constexpr size_t WS_WOUT = WS_WBR + 3ull * 1024 * 512 * 2;
constexpr size_t WS_WPG = WS_WOUT + 1024ull * 1024 * 2;
constexpr size_t WS_WPP = WS_WPG + 1024ull * 1024 * 2;
constexpr size_t WS_WR = WS_WPP + 1024ull * 256 * 2;
static_assert(WS_WR + 256ull * 1024 * 2 <= 44 * MiB, "small weights");
constexpr size_t WS_XB = 44 * MiB;
constexpr size_t WS_QA0 = 108 * MiB;
constexpr size_t WS_YATT = WS_QA0;
constexpr size_t WS_OM = 140 * MiB;
constexpr size_t WS_YC = 172 * MiB;
constexpr size_t WS_CST = 204 * MiB;
constexpr size_t WS_B = 236 * MiB;
constexpr size_t WS_KA = WS_B, WS_QA1 = WS_B + 32 * MiB, WS_QA2 = WS_B + 64 * MiB, WS_VA = WS_B + 96 * MiB, WS_YG = WS_B + 128 * MiB, WS_QM = WS_B + 160 * MiB, WS_KM = WS_B + 192 * MiB, WS_VM = WS_B + 224 * MiB;
constexpr size_t WS_G0 = WS_B, WS_MERGED = WS_B + 192 * MiB;
constexpr size_t WS_WEXP = WS_B, WS_HB = WS_B + 48 * MiB, WS_PBF = WS_B + 88 * MiB, WS_PE = WS_B + 104 * MiB, WS_YB1 = WS_B + 168 * MiB;
constexpr size_t WS_XBT = WS_QA0;
constexpr size_t WS_END = 492 * MiB;
constexpr size_t TAB_CNT = 0;
constexpr size_t TAB_META = 65536;
constexpr size_t TAB_RSA = 262144, TAB_RSM = 524288;
constexpr size_t TAB_MLOC = 131072, TAB_GTOT = 131072 + 4096, TAB_MST = 131072 + 8192;

constexpr int RING_BYTES = 131072;
constexpr int MISC_OFF = 155648;
constexpr int LDS_BYTES = 156672;

__device__ __forceinline__ unsigned f2bf(float f) { unsigned u = __builtin_bit_cast(unsigned, f); return (u + 0x7fffu + ((u >> 16) & 1u)) >> 16; }
__device__ __forceinline__ unsigned pk2(float lo, float hi) { return f2bf(lo) | (f2bf(hi) << 16); }
__device__ __forceinline__ unsigned cvt_pk_bf16(float lo, float hi) { unsigned r; asm volatile("v_cvt_pk_bf16_f32 %0, %1, %2" : "=v"(r) : "v"(lo), "v"(hi)); return r; }
__device__ __forceinline__ float bf_lo(unsigned w) { return __builtin_bit_cast(float, w << 16); }
__device__ __forceinline__ float bf_hi(unsigned w) { return __builtin_bit_cast(float, w & 0xffff0000u); }
__device__ __forceinline__ float bf1(bf16_t h) { return __builtin_bit_cast(float, ((unsigned)h) << 16); }
__device__ __forceinline__ float sigmoidf_(float v) { return __builtin_amdgcn_rcpf(1.0f + __expf(-v)); }
__device__ __forceinline__ float siluf_(float v) { return v * __builtin_amdgcn_rcpf(1.0f + __expf(-v)); }
__device__ __forceinline__ float wave_sum(float v) {
#pragma unroll
    for (int o = 1; o < 64; o <<= 1) v += __shfl_xor(v, o);
    return v;
}
__device__ __forceinline__ float wave_max(float v) {
#pragma unroll
    for (int o = 1; o < 64; o <<= 1) v = fmaxf(v, __shfl_xor(v, o));
    return v;
}
__device__ __forceinline__ int lane_id_() { int l; asm volatile("v_mbcnt_lo_u32_b32 %0, -1, 0\n\tv_mbcnt_hi_u32_b32 %0, -1, %0" : "=&v"(l)); return l; }
#define LDS_WAIT() asm volatile("s_waitcnt lgkmcnt(0)" ::: "memory")
#define VM_WAIT() asm volatile("s_waitcnt vmcnt(0)" ::: "memory")

#define XB_TMO      128
#define XB_XCNT(j)  (256  + 64 * (j))
#define XB_XSUB(j)  (1280 + 64 * (j))
#define XB_XGEN(j)  (2304 + 64 * (j))
#define XB_TOP      3328
#define XB_TOPGEN   3392
#define XCD_BAR_WORDS 3456
#define XB_SPIN_CAP (1u << 22)
__device__ __forceinline__ unsigned xb_ld(unsigned* p)              { return __hip_atomic_load(p, __ATOMIC_RELAXED, __HIP_MEMORY_SCOPE_AGENT); }
__device__ __forceinline__ unsigned xb_add(unsigned* p, unsigned v) { return __hip_atomic_fetch_add(p, v, __ATOMIC_RELAXED, __HIP_MEMORY_SCOPE_AGENT); }
__device__ __forceinline__ unsigned xb_xcc_id() { return (unsigned)__builtin_amdgcn_s_getreg((3 << 11) | 20) & 0xFu; }
#define XB_SPIN(cond, bar) do { unsigned _sp = 0; while (cond) { __builtin_amdgcn_s_sleep(1); \
    if ((++_sp & 255u) == 0u) { if (xb_ld(&(bar)[XB_TMO])) break; if (_sp > XB_SPIN_CAP) { atomicAdd(&(bar)[XB_TMO], 1u); break; } } } } while (0)
struct XcdBarrier { unsigned* bar; unsigned x; volatile LAS unsigned* st; int wave; };
__device__ __forceinline__ XcdBarrier xcd_barrier_post(unsigned* bar, volatile LAS unsigned* st, int wave) {
    XcdBarrier b; b.bar = bar; b.x = xb_xcc_id(); b.st = st; b.wave = wave;
    if (wave == 0 && lane_id_() == 0) (void)xb_add(&bar[XB_XCNT(b.x)], 1u);
    return b;
}
__device__ __forceinline__ void xcd_barrier_complete(unsigned* bar, unsigned x, unsigned& nloc, unsigned& nx) {
    const unsigned G = gridDim.x * gridDim.y * gridDim.z;
    unsigned sum, cnt, mine, sp = 0u;
    for (;;) {
        sum = 0u; cnt = 0u; mine = 0u;
#pragma unroll
        for (unsigned j = 0; j < 16; ++j) { const unsigned c = xb_ld(&bar[XB_XCNT(j)]); sum += c; cnt += (c > 0u) ? 1u : 0u; mine = (j == x) ? c : mine; }
        if (sum == G) break;
        __builtin_amdgcn_s_sleep(1);
        if ((++sp & 255u) == 0u) { if (xb_ld(&bar[XB_TMO])) break; if (sp > XB_SPIN_CAP) { atomicAdd(&bar[XB_TMO], 1u); break; } }
    }
    nloc = mine > 0u ? mine : 1u; nx = cnt > 0u ? cnt : 1u;
}
__device__ __forceinline__ void xcd_barrier(const XcdBarrier& b) {
    asm volatile("s_waitcnt vmcnt(0)" ::: "memory");
    __syncthreads();
    if (b.wave == 0 && lane_id_() == 0) {
        unsigned* bar = b.bar;
        __builtin_amdgcn_s_waitcnt(0);
        unsigned nloc = b.st[0], nx = b.st[1];
        if (nloc == 0u) { xcd_barrier_complete(bar, b.x, nloc, nx); b.st[0] = nloc; b.st[1] = nx; }
        const unsigned old = xb_add(&bar[XB_XSUB(b.x)], 1u);
        const unsigned gen = old / nloc;
        if (old + 1u == (gen + 1u) * nloc) {
            __builtin_amdgcn_fence(__ATOMIC_RELEASE, "agent");
            asm volatile("s_waitcnt vmcnt(0)" ::: "memory");
            const unsigned og = xb_add(&bar[XB_TOP], 1u);
            const unsigned tg = og / nx;
            if (og + 1u == (tg + 1u) * nx) xb_add(&bar[XB_TOPGEN], 1u);
            else XB_SPIN(xb_ld(&bar[XB_TOPGEN]) == tg, bar);
            __builtin_amdgcn_fence(__ATOMIC_ACQUIRE, "agent");
            xb_add(&bar[XB_XGEN(b.x)], 1u);
            asm volatile("s_waitcnt vmcnt(0)" ::: "memory");
        } else {
            XB_SPIN(xb_ld(&bar[XB_XGEN(b.x)]) == gen, bar);
            __builtin_amdgcn_fence(__ATOMIC_ACQUIRE, "agent");
            asm volatile("s_waitcnt vmcnt(0)" ::: "memory");
        }
    }
    __syncthreads();
}

namespace pg8 {
constexpr int BM = 256, BK = 64, HALF = 128, HTB = HALF * BK * 2, NXCD = 8, WGM = 8;
__device__ __forceinline__ int lds_byte(int r, int c) { const int st = (r >> 4) * 2 + (c >> 5), rr = r & 15, cc = c & 31, ob = rr * 64 + cc * 2; return st * 1024 + (ob ^ (((ob >> 9) & 1) << 5)); }
__device__ __forceinline__ void stage_rc(int b, int& R, int& C) { const int st = b / 1024, sb = b % 1024, swz = sb ^ (((sb >> 9) & 1) << 5); R = (st >> 1) * 16 + swz / 64; C = (st & 1) * 32 + (swz % 64) / 2; }
__device__ __forceinline__ int perm32(int rho) { const int n = rho >> 4, i = rho & 15; return 8 * (i >> 2) + 4 * n + (i & 3); }

struct GUnit { const char* A; const char* B; int pm, pn, a0, a1; };

__device__ __forceinline__ void tile_order(int L, int nM, int nN, int& pm, int& pn) {
    const int nwg = nM * nN; int wgid = L;
    { const int q = nwg / NXCD, r = nwg % NXCD, xcd = wgid % NXCD, off = wgid / NXCD; wgid = (xcd < r ? xcd * (q + 1) : r * (q + 1) + (xcd - r) * q) + off; }
    const int nig = WGM * nN, gid = wgid / nig, fm = gid * WGM, gsz = (nM - fm) < WGM ? (nM - fm) : WGM;
    pm = fm + ((wgid % nig) % gsz); pn = (wgid % nig) / gsz;
}

typedef f32x4 Acc[2][2][4][2];

template <class P>
__device__ __forceinline__ void gemm_phase(LAS unsigned char* lds, const P& S, int tid) {
    asm volatile("" : "+v"(tid));
    const int wid = __builtin_amdgcn_readfirstlane(tid >> 6), lane = tid & 63, wr = wid >> 2, wc = wid & 3, fr = lane & 15, fq = lane >> 4;
    constexpr int K = P::K, nt = K / BK;
    static_assert(nt >= 4 && (nt % 2) == 0, "K multiple of 128, >= 256");
    unsigned voffB[2];
#pragma unroll
    for (int i = 0; i < 2; ++i) { int R, C; stage_rc(tid * 16 + i * 8192, R, C); const int Rb = (R & ~31) + perm32(R & 31); voffB[i] = (unsigned)(Rb * K + C) * 2u; }
    constexpr size_t kstep = (size_t)(BK * 2);
    constexpr size_t hstepB = (size_t)HALF * K * 2;
    const unsigned ldsw = (unsigned)wid * 1024u;
    const int aoff = lds_byte(wr * 64 + fr, fq * 8), boff = lds_byte(wc * 32 + fr, fq * 8);
#define PG8_SA(b, h) (((b) * 2 + (h)) * HTB)
#define PG8_SB(b, h) ((4 + (b) * 2 + (h)) * HTB)
#define PG8_STAGE(bufoff, gbase, voff) do { _Pragma("unroll") for (int _i = 0; _i < 2; ++_i) \
        __builtin_amdgcn_global_load_lds((const unsigned*)((const char*)(gbase) + (voff)[_i]), (LAS unsigned*)(lds + (bufoff) + ldsw + _i * 8192), 16, 0, 0); } while (0)
#define PG8_LDA(dst, b, h) do { _Pragma("unroll") for (int m = 0; m < 4; ++m) _Pragma("unroll") for (int k = 0; k < 2; ++k) dst[m][k] = *(const LAS bf16x8*)(lds + PG8_SA(b, h) + aoff + m * 2048 + k * 1024); } while (0)
#define PG8_LDB(dst, b, h) do { _Pragma("unroll") for (int n = 0; n < 2; ++n) _Pragma("unroll") for (int k = 0; k < 2; ++k) dst[n][k] = *(const LAS bf16x8*)(lds + PG8_SB(b, h) + boff + n * 2048 + k * 1024); } while (0)
#define PG8_MMA(ai, bj, At, Bt) do { __builtin_amdgcn_s_setprio(1); _Pragma("unroll") for (int m = 0; m < 4; ++m) _Pragma("unroll") for (int n = 0; n < 2; ++n) _Pragma("unroll") for (int k = 0; k < 2; ++k) \
        acc[ai][bj][m][n] = __builtin_amdgcn_mfma_f32_16x16x32_bf16(Bt[n][k], At[m][k], acc[ai][bj][m][n], 0, 0, 0); __builtin_amdgcn_s_setprio(0); } while (0)
#define PG8_WAIT_V(n) asm volatile("s_waitcnt vmcnt(" #n ")" ::: "memory")
#define PG8_WAIT_L(n) asm volatile("s_waitcnt lgkmcnt(" #n ")" ::: "memory")
#define PG8_BAR __builtin_amdgcn_s_barrier()
#define PG8_SCHED __builtin_amdgcn_sched_barrier(0)
#define PG8_VOA(dst, u) do { _Pragma("unroll") for (int _h = 0; _h < 2; ++_h) _Pragma("unroll") for (int _i = 0; _i < 2; ++_i) { int _R, _C; stage_rc(tid * 16 + _i * 8192, _R, _C); \
        if constexpr (P::GATHER) dst[_h][_i] = (S.arow(u, _h * HALF + _R) * (unsigned)K + (unsigned)_C) * 2u; \
        else dst[_h][_i] = (unsigned)((_h * HALF + _R) * K + _C) * 2u; } } while (0)
    GUnit cur, nxt; int ui = 0;
    if (!S.next(0, cur)) return;
    float pre8[8];
    S.pre(cur, wr, fr, pre8);
    Acc acc;
#pragma unroll
    for (int a = 0; a < 2; ++a)
#pragma unroll
        for (int b = 0; b < 2; ++b)
#pragma unroll
            for (int m = 0; m < 4; ++m)
#pragma unroll
                for (int n = 0; n < 2; ++n) acc[a][b][m][n] = (f32x4){0.f, 0.f, 0.f, 0.f};
    bf16x8 At[4][2], B0[2][2], B1[2][2];
    unsigned voA[2][2], voAn[2][2];
    PG8_VOA(voA, cur);
    const char* cA = cur.A; const char* cB = cur.B;
    PG8_STAGE(PG8_SB(0, 0), cB, voffB); PG8_STAGE(PG8_SB(0, 1), cB + hstepB, voffB); PG8_STAGE(PG8_SA(0, 0), cA, voA[0]); PG8_STAGE(PG8_SA(0, 1), cA, voA[1]);
    if (wr == 1) PG8_BAR;
    PG8_WAIT_V(2); PG8_BAR;
    PG8_STAGE(PG8_SB(1, 0), cB + kstep, voffB); PG8_STAGE(PG8_SA(1, 0), cA + kstep, voA[0]); PG8_STAGE(PG8_SB(1, 1), cB + hstepB + kstep, voffB);
    PG8_WAIT_V(6); PG8_BAR;
    for (;;) {
        const bool has_next = S.next(ui + 1, nxt);
        const char* nA = has_next ? nxt.A : cA; const char* nB = has_next ? nxt.B : cB;
        if constexpr (P::GATHER) {
            if (has_next) { PG8_VOA(voAn, nxt); }
            else {
#pragma unroll
                for (int h = 0; h < 2; ++h)
#pragma unroll
                    for (int i = 0; i < 2; ++i) voAn[h][i] = voA[h][i];
            }
        }
#pragma unroll 1
        for (int t = 0; t < nt; t += 2) {
            const bool last = (t == nt - 2);
            const char* a1 = cA + (size_t)(t + 1) * kstep;
            const char* a2 = last ? nA : cA + (size_t)(t + 2) * kstep; const char* b2 = last ? nB : cB + (size_t)(t + 2) * kstep;
            const char* a3 = a2 + kstep; const char* b3 = b2 + kstep;
            unsigned s0[2], s1[2];
#pragma unroll
            for (int i = 0; i < 2; ++i) {
                if constexpr (P::GATHER) { s0[i] = last ? voAn[0][i] : voA[0][i]; s1[i] = last ? voAn[1][i] : voA[1][i]; }
                else { s0[i] = voA[0][i]; s1[i] = voA[1][i]; }
            }
            PG8_LDB(B0, 0, 0); PG8_LDB(B1, 0, 1); PG8_SCHED; PG8_LDA(At, 0, 0); PG8_STAGE(PG8_SA(1, 1), a1, voA[1]);
            PG8_WAIT_V(8); PG8_WAIT_L(0); PG8_BAR; PG8_MMA(0, 0, At, B0); PG8_MMA(0, 1, At, B1); PG8_BAR; PG8_SCHED;
            PG8_LDA(At, 0, 1); PG8_STAGE(PG8_SB(0, 0), b2, voffB); PG8_STAGE(PG8_SB(0, 1), b2 + hstepB, voffB); PG8_STAGE(PG8_SA(0, 0), a2, s0);
            PG8_WAIT_V(8); PG8_WAIT_L(0); PG8_BAR; PG8_MMA(1, 0, At, B0); PG8_MMA(1, 1, At, B1); PG8_BAR; PG8_SCHED;
            PG8_LDB(B0, 1, 0); PG8_LDB(B1, 1, 1); PG8_SCHED; PG8_LDA(At, 1, 0); PG8_STAGE(PG8_SA(0, 1), a2, s1);
            PG8_WAIT_V(8); PG8_WAIT_L(0); PG8_BAR; PG8_MMA(0, 0, At, B0); PG8_MMA(0, 1, At, B1); PG8_BAR; PG8_SCHED;
            PG8_LDA(At, 1, 1); PG8_STAGE(PG8_SB(1, 0), b3, voffB); PG8_STAGE(PG8_SB(1, 1), b3 + hstepB, voffB); PG8_STAGE(PG8_SA(1, 0), a3, s0);
            PG8_WAIT_V(8); PG8_WAIT_L(0); PG8_BAR; PG8_MMA(1, 0, At, B0); PG8_MMA(1, 1, At, B1); PG8_BAR; PG8_SCHED;
        }
        if (wr == 0) PG8_BAR;
        const bool zero = S.epi(acc, cur, wr, wc, fr, fq, pre8);
        if (!has_next) break;
        S.pre(nxt, wr, fr, pre8);
        if (zero) {
#pragma unroll
            for (int a = 0; a < 2; ++a)
#pragma unroll
                for (int b = 0; b < 2; ++b)
#pragma unroll
                    for (int m = 0; m < 4; ++m)
#pragma unroll
                        for (int n = 0; n < 2; ++n) acc[a][b][m][n] = (f32x4){0.f, 0.f, 0.f, 0.f};
        }
        cur = nxt; cA = nA; cB = nB; ++ui;
        if constexpr (P::GATHER) {
#pragma unroll
            for (int h = 0; h < 2; ++h)
#pragma unroll
                for (int i = 0; i < 2; ++i) voA[h][i] = voAn[h][i];
        }
        if (wr == 1) PG8_BAR;
    }
    PG8_WAIT_V(0);
    PG8_BAR;
#undef PG8_SA
#undef PG8_SB
#undef PG8_STAGE
#undef PG8_LDA
#undef PG8_LDB
#undef PG8_MMA
#undef PG8_WAIT_V
#undef PG8_WAIT_L
#undef PG8_BAR
#undef PG8_SCHED
#undef PG8_VOA
}
}
using pg8::GUnit; using pg8::Acc;

__device__ __forceinline__ float row_rs(const float* SS, int row) {
    const f32x4* p = (const f32x4*)(SS + (size_t)row * 16);
    const f32x4 a = p[0], b = p[1], c = p[2], d = p[3];
    const float s = (((a.x + a.y) + (a.z + a.w)) + ((b.x + b.y) + (b.z + b.w))) + (((c.x + c.y) + (c.z + c.w)) + ((d.x + d.y) + (d.z + d.w)));
    return rsqrtf(s * (1.0f / 1024.0f) + EPS);
}
#define PIN1(a) asm volatile("" : "+v"(a))
#define PIN2(a, b) asm volatile("" : "+v"(a), "+v"(b))
#define PIN4(a, b, c, d) asm volatile("" : "+v"(a), "+v"(b), "+v"(c), "+v"(d))
#define PIN8(a, b, c, d, e, f, g, h) asm volatile("" : "+v"(a), "+v"(b), "+v"(c), "+v"(d), "+v"(e), "+v"(f), "+v"(g), "+v"(h))
__device__ __forceinline__ void row_rs8(const float* SS, int row0, float (&rs)[8]) {
#pragma unroll
    for (int hh = 0; hh < 4; ++hh) { f32x4 a[2], b[2], c[2], d[2];
#pragma unroll
        for (int g = 0; g < 2; ++g) { const f32x4* p = (const f32x4*)(SS + (size_t)(row0 + (hh >> 1) * 128 + ((hh & 1) * 2 + g) * 16) * 16); a[g] = p[0]; b[g] = p[1]; c[g] = p[2]; d[g] = p[3]; }
#pragma unroll
        for (int g = 0; g < 2; ++g) { const f32x4 t = (a[g] + b[g]) + (c[g] + d[g]); rs[hh * 2 + g] = rsqrtf(((t.x + t.y) + (t.z + t.w)) * (1.0f / 1024.0f) + EPS); }
        PIN2(rs[hh * 2], rs[hh * 2 + 1]); }
}
__device__ __forceinline__ u32x4 pack8(const f32x4 v0, const f32x4 v1) { u32x4 w; w.x = cvt_pk_bf16(v0[0], v0[1]); w.y = cvt_pk_bf16(v0[2], v0[3]); w.z = cvt_pk_bf16(v1[0], v1[1]); w.w = cvt_pk_bf16(v1[2], v1[3]); return w; }
__device__ __forceinline__ void unpack8(const u32x4 w, f32x4& v0, f32x4& v1) { v0 = (f32x4){bf_lo(w.x), bf_hi(w.x), bf_lo(w.y), bf_hi(w.y)}; v1 = (f32x4){bf_lo(w.z), bf_hi(w.z), bf_lo(w.w), bf_hi(w.w)}; }
__device__ __forceinline__ f32x4 sig4(const f32x4 v) { return (f32x4){sigmoidf_(v[0]), sigmoidf_(v[1]), sigmoidf_(v[2]), sigmoidf_(v[3])}; }
__device__ __forceinline__ f32x4 gate4(const f32x4 v) { f32x4 s = sig4(v); return (f32x4){fmaxf(s[0], 1e-6f), fmaxf(s[1], 1e-6f), fmaxf(s[2], 1e-6f), fmaxf(s[3], 1e-6f)}; }

struct PhProj {
    static constexpr int K = 1024; static constexpr bool GATHER = false;
    const char* xb; const char* W; const float* SS; unsigned char* ws; int G, c;
    __device__ __forceinline__ bool next(int i, GUnit& u) const {
        const long L = (long)i * G + c; if (L >= 128 * 23) return false;
        pg8::tile_order((int)L, 128, 23, u.pm, u.pn);
        u.A = xb + (size_t)u.pm * 256 * K * 2; u.B = W + (size_t)u.pn * 256 * K * 2; u.a0 = 0; u.a1 = 0; return true;
    }
    __device__ __forceinline__ unsigned arow(const GUnit&, int) const { return 0u; }
    __device__ __forceinline__ void pre(const GUnit& u, int wr, int fr, float (&rs)[8]) const { const float* R = (const float*)(ws + WS_TAB + TAB_RSA) + u.pm * 256 + wr * 64 + fr;
#pragma unroll
        for (int g = 0; g < 8; ++g) rs[g] = R[(g >> 2) * 128 + (g & 3) * 16]; }
    __device__ __forceinline__ bool epi(Acc& acc, const GUnit& u, int wr, int wc, int fr, int fq, const float (&rs8)[8]) const {
        const int pn = u.pn; const int row0 = u.pm * 256 + wr * 64 + fr;
        if (pn == 22) {
            if (wc == 0 && fq == 0) {
                float* IFp = (float*)(ws + WS_IF);
#pragma unroll
                for (int ai = 0; ai < 2; ++ai)
#pragma unroll
                    for (int m = 0; m < 4; ++m) { const int row = row0 + ai * 128 + m * 16; const float rs = rs8[ai * 4 + m];
                        *(f32x4*)(IFp + (size_t)row * 8) = acc[ai][0][m][0] * rs; *(f32x4*)(IFp + (size_t)row * 8 + 4) = acc[ai][0][m][1] * rs; }
            }
            return true;
        }
        if (pn >= 10 && pn < 14) {
            bf16_t* Y = (bf16_t*)(ws + WS_YG);
#pragma unroll
            for (int ai = 0; ai < 2; ++ai)
#pragma unroll
                for (int m = 0; m < 4; ++m) { const int row = row0 + ai * 128 + m * 16; const float rs = rs8[ai * 4 + m];
#pragma unroll
                    for (int bj = 0; bj < 2; ++bj) { const f32x4 a = acc[ai][bj][m][0] * rs, g = sig4(acc[ai][bj][m][1] * rs), y = a * g;
                        u32x2 w; w.x = cvt_pk_bf16(y[0], y[1]); w.y = cvt_pk_bf16(y[2], y[3]);
                        *(u32x2*)(Y + (size_t)row * 512 + (pn - 10) * 128 + bj * 64 + wc * 16 + fq * 4) = w; } }
            return true;
        }
        bf16_t* dst; int col0; bool sg = false;
        if (pn < 6) { dst = (bf16_t*)(ws + (pn < 2 ? WS_QA0 : (pn < 4 ? WS_QA1 : WS_QA2))); col0 = (pn & 1) * 256; }
        else if (pn < 8) { dst = (bf16_t*)(ws + WS_KA); col0 = (pn - 6) * 256; }
        else if (pn < 10) { dst = (bf16_t*)(ws + WS_VA); col0 = (pn - 8) * 256; }
        else if (pn < 16) { dst = (bf16_t*)(ws + WS_QM); col0 = (pn - 14) * 256; }
        else if (pn < 18) { dst = (bf16_t*)(ws + WS_KM); col0 = (pn - 16) * 256; }
        else if (pn < 20) { dst = (bf16_t*)(ws + WS_VM); col0 = (pn - 18) * 256; }
        else { dst = (bf16_t*)(ws + WS_OM); col0 = (pn - 20) * 256; sg = true; }
        col0 += wc * 32 + fq * 8;
#pragma unroll
        for (int ai = 0; ai < 2; ++ai)
#pragma unroll
            for (int m = 0; m < 4; ++m) { const int row = row0 + ai * 128 + m * 16; const float rs = rs8[ai * 4 + m];
#pragma unroll
                for (int bj = 0; bj < 2; ++bj) { f32x4 v0 = acc[ai][bj][m][0] * rs, v1 = acc[ai][bj][m][1] * rs;
                    if (sg) { v0 = sig4(v0); v1 = sig4(v1); }
                    *(u32x4*)(dst + (size_t)row * 512 + col0 + bj * 128) = pack8(v0, v1); } }
        return true;
    }
};
struct PhGates {
    static constexpr int K = 1024; static constexpr bool GATHER = false;
    const char* xb; const char* W; const float* SS; unsigned char* ws; int G, c;
    __device__ __forceinline__ bool next(int i, GUnit& u) const {
        const long L = (long)i * G + c; if (L >= 128 * 12) return false;
        pg8::tile_order((int)L, 128, 12, u.pm, u.pn);
        u.A = xb + (size_t)u.pm * 256 * K * 2; u.B = W + (size_t)(5888 + u.pn * 256) * K * 2; u.a0 = 0; u.a1 = 0; return true;
    }
    __device__ __forceinline__ unsigned arow(const GUnit&, int) const { return 0u; }
    __device__ __forceinline__ void pre(const GUnit& u, int wr, int fr, float (&rs)[8]) const { const float* R = (const float*)(ws + WS_TAB + TAB_RSA) + u.pm * 256 + wr * 64 + fr;
#pragma unroll
        for (int g = 0; g < 8; ++g) rs[g] = R[(g >> 2) * 128 + (g & 3) * 16]; }
    __device__ __forceinline__ bool epi(Acc& acc, const GUnit& u, int wr, int wc, int fr, int fq, const float (&rs8)[8]) const {
        const int row0 = u.pm * 256 + wr * 64 + fr;
        bf16_t* dst = (bf16_t*)(ws + WS_G0 + (size_t)(u.pn >> 2) * 64 * MiB); const int col0 = (u.pn & 3) * 256 + wc * 32 + fq * 8;
#pragma unroll
        for (int ai = 0; ai < 2; ++ai)
#pragma unroll
            for (int m = 0; m < 4; ++m) { const int row = row0 + ai * 128 + m * 16; const float rs = rs8[ai * 4 + m];
#pragma unroll
                for (int bj = 0; bj < 2; ++bj) *(u32x4*)(dst + (size_t)row * 1024 + col0 + bj * 128) = pack8(gate4(acc[ai][bj][m][0] * rs), gate4(acc[ai][bj][m][1] * rs)); }
        return true;
    }
};
struct PhMerge {
    static constexpr int K = 512; static constexpr bool GATHER = false;
    unsigned char* ws; int G, c;
    __device__ __forceinline__ bool next(int i, GUnit& u) const {
        const int ti = i / 3, seg = i - ti * 3; const long L = (long)ti * G + c; if (L >= 128 * 4) return false;
        pg8::tile_order((int)L, 128, 4, u.pm, u.pn);
        const size_t ya = seg == 0 ? WS_YATT : (seg == 1 ? WS_YC : WS_OM);
        u.A = (const char*)ws + ya + (size_t)u.pm * 256 * K * 2; u.B = (const char*)ws + WS_WBR + (size_t)seg * 1024 * 512 * 2 + (size_t)u.pn * 256 * K * 2; u.a0 = seg; u.a1 = 0; return true;
    }
    __device__ __forceinline__ unsigned arow(const GUnit&, int) const { return 0u; }
    __device__ __forceinline__ void pre(const GUnit&, int, int, float (&)[8]) const {}
    __device__ __forceinline__ bool epi(Acc& acc, const GUnit& u, int wr, int wc, int fr, int fq, const float (&rs8)[8]) const {
        const int seg = u.a0; const int row0 = u.pm * 256 + wr * 64 + fr; const int col0 = u.pn * 256 + wc * 32 + fq * 8;
        const bf16_t* Gn = (const bf16_t*)(ws + WS_G0 + (size_t)seg * 64 * MiB);
        const bf16_t* Gd = (const bf16_t*)(ws + WS_G0 + (size_t)(seg < 2 ? seg + 1 : seg) * 64 * MiB);
        bf16_t* Mo = (bf16_t*)(ws + WS_MERGED);
#pragma unroll
        for (int ai = 0; ai < 2; ++ai) {
            u32x4 gn[4][2], gd[4][2];
#pragma unroll
            for (int m = 0; m < 4; ++m)
#pragma unroll
                for (int bj = 0; bj < 2; ++bj) { const size_t off = (size_t)(row0 + ai * 128 + m * 16) * 1024 + col0 + bj * 128; gn[m][bj] = *(const u32x4*)(Gn + off); gd[m][bj] = *(const u32x4*)(Gd + off); }
            PIN8(gn[0][0], gn[0][1], gn[1][0], gn[1][1], gn[2][0], gn[2][1], gn[3][0], gn[3][1]); PIN8(gd[0][0], gd[0][1], gd[1][0], gd[1][1], gd[2][0], gd[2][1], gd[3][0], gd[3][1]);
#pragma unroll
            for (int m = 0; m < 4; ++m)
#pragma unroll
                for (int bj = 0; bj < 2; ++bj) { const size_t off = (size_t)(row0 + ai * 128 + m * 16) * 1024 + col0 + bj * 128;
                    f32x4 n0, n1, d0, d1; unpack8(gn[m][bj], n0, n1); unpack8(gd[m][bj], d0, d1);
                    if (seg < 2) {
#pragma unroll
                        for (int j = 0; j < 4; ++j) { acc[ai][bj][m][0][j] *= n0[j] * __builtin_amdgcn_rcpf(d0[j]); acc[ai][bj][m][1][j] *= n1[j] * __builtin_amdgcn_rcpf(d1[j]); } }
                    else *(u32x4*)(Mo + off) = pack8(acc[ai][bj][m][0] * n0, acc[ai][bj][m][1] * n1); }
        }
        return seg == 2;
    }
};
__device__ __forceinline__ float store_x8(bf16_t* xbp, const f32x4 v0, const f32x4 v1) {
    *(u32x4*)xbp = pack8(v0, v1);
    return ((v0[0] * v0[0] + v0[1] * v0[1]) + (v0[2] * v0[2] + v0[3] * v0[3])) + ((v1[0] * v1[0] + v1[1] * v1[1]) + (v1[2] * v1[2] + v1[3] * v1[3]));
}
struct PhOut {
    static constexpr int K = 1024; static constexpr bool GATHER = false;
    unsigned char* ws; float* SSo; int G, c;
    __device__ __forceinline__ bool next(int i, GUnit& u) const {
        const long L = (long)i * G + c; if (L >= 128 * 4) return false;
        pg8::tile_order((int)L, 128, 4, u.pm, u.pn);
        u.A = (const char*)ws + WS_MERGED + (size_t)u.pm * 256 * K * 2; u.B = (const char*)ws + WS_WOUT + (size_t)u.pn * 256 * K * 2; u.a0 = 0; u.a1 = 0; return true;
    }
    __device__ __forceinline__ unsigned arow(const GUnit&, int) const { return 0u; }
    __device__ __forceinline__ void pre(const GUnit&, int, int, float (&)[8]) const {}
    __device__ __forceinline__ bool epi(Acc& acc, const GUnit& u, int wr, int wc, int fr, int fq, const float (&rs8)[8]) const {
        const int row0 = u.pm * 256 + wr * 64 + fr; const int col0 = u.pn * 256 + wc * 32 + fq * 8; bf16_t* XB = (bf16_t*)(ws + WS_XB);
#pragma unroll
        for (int ai = 0; ai < 2; ++ai) {
            u32x4 xr[4][2];
#pragma unroll
            for (int m = 0; m < 4; ++m)
#pragma unroll
                for (int bj = 0; bj < 2; ++bj) xr[m][bj] = *(const u32x4*)(XB + (size_t)(row0 + ai * 128 + m * 16) * 1024 + col0 + bj * 128);
            PIN8(xr[0][0], xr[0][1], xr[1][0], xr[1][1], xr[2][0], xr[2][1], xr[3][0], xr[3][1]);
#pragma unroll
            for (int m = 0; m < 4; ++m) { const int row = row0 + ai * 128 + m * 16; const size_t off = (size_t)row * 1024 + col0; float ss = 0.f;
#pragma unroll
                for (int bj = 0; bj < 2; ++bj) { f32x4 x0, x1; unpack8(xr[m][bj], x0, x1); ss += store_x8(XB + off + bj * 128, x0 + acc[ai][bj][m][0], x1 + acc[ai][bj][m][1]); }
                ss += __shfl_xor(ss, 16); ss += __shfl_xor(ss, 32);
                if (fq == 0) SSo[(size_t)row * 16 + u.pn * 4 + wc] = ss; } }
        return true;
    }
};
struct PhRouter {
    static constexpr int K = 1024; static constexpr bool GATHER = false;
    unsigned char* ws; const float* SS; int G, c;
    __device__ __forceinline__ bool next(int i, GUnit& u) const {
        const long L = (long)i * G + c; if (L >= 128) return false;
        u.pm = (int)L; u.pn = 0; u.A = (const char*)ws + WS_XB + (size_t)u.pm * 256 * K * 2; u.B = (const char*)ws + WS_WR; u.a0 = 0; u.a1 = 0; return true;
    }
    __device__ __forceinline__ unsigned arow(const GUnit&, int) const { return 0u; }
    __device__ __forceinline__ void pre(const GUnit&, int, int, float (&)[8]) const {}
    __device__ __forceinline__ bool epi(Acc& acc, const GUnit& u, int wr, int wc, int fr, int fq, const float (&rs8)[8]) const {
        if (wc < 2) { float* Lg = (float*)(ws + WS_LOGITS); const int row0 = u.pm * 256 + wr * 64 + fr;
            float rl8[8]; row_rs8(SS, row0, rl8);
#pragma unroll
            for (int ai = 0; ai < 2; ++ai)
#pragma unroll
                for (int m = 0; m < 4; ++m) { const int row = row0 + ai * 128 + m * 16; const float rs = rl8[ai * 4 + m]; float* p = Lg + (size_t)row * 64 + wc * 32 + fq * 8;
                    *(f32x4*)p = acc[ai][0][m][0] * rs; *(f32x4*)(p + 4) = acc[ai][0][m][1] * rs; } }
        return true;
    }
};
__device__ __forceinline__ int moe_expert_of(const int* META, int k, int rb) {
    const int r = rb * 256; int e = 0;
    for (int j = 1; j < 32; ++j) e += (META[16 + 64 * k + j] <= r) ? 1 : 0;
    return __builtin_amdgcn_readfirstlane(e);
}
struct PhUp {
    static constexpr int K = 1024; static constexpr bool GATHER = true;
    unsigned char* ws; const float* SS; const int* META; const int* tok; int G, c;
    __device__ __forceinline__ bool next(int i, GUnit& u) const {
        const int nb0 = __builtin_amdgcn_readfirstlane(META[0]), nb1 = __builtin_amdgcn_readfirstlane(META[1]); const long L = (long)i * G + c; if (L >= 2L * (nb0 + nb1)) return false;
        int blk = (int)(L >> 1); u.pn = (int)(L & 1); int k = 0; if (blk >= nb0) { k = 1; blk -= nb0; }
        const int e = moe_expert_of(META, k, blk);
        u.pm = blk; u.a0 = k; u.a1 = e; u.A = (const char*)ws + WS_XB; u.B = (const char*)ws + WS_WEXP + (size_t)e * 512 * 1024 * 2 + (size_t)u.pn * 256 * K * 2; return true;
    }
    __device__ __forceinline__ unsigned arow(const GUnit& u, int r) const { const int t = tok[u.a0 * LISTCAP + u.pm * 256 + r]; return t < 0 ? 0u : (unsigned)t; }
    __device__ __forceinline__ void pre(const GUnit& u, int wr, int fr, float (&rs)[8]) const {
        const int lr0 = u.a0 * LISTCAP + u.pm * 256 + wr * 64 + fr; const float* R = (const float*)(ws + WS_TAB + TAB_RSM); int tk[8];
#pragma unroll
        for (int g = 0; g < 8; ++g) tk[g] = tok[lr0 + (g >> 2) * 128 + (g & 3) * 16];
#pragma unroll
        for (int g = 0; g < 8; ++g) { const float r = R[tk[g] < 0 ? 0 : tk[g]]; rs[g] = tk[g] < 0 ? 0.f : r; }
    }
    __device__ __forceinline__ bool epi(Acc& acc, const GUnit& u, int wr, int wc, int fr, int fq, const float (&rs8)[8]) const {
        const int lr0 = u.a0 * LISTCAP + u.pm * 256 + wr * 64 + fr; bf16_t* HB = (bf16_t*)(ws + WS_HB);
#pragma unroll
        for (int ai = 0; ai < 2; ++ai)
#pragma unroll
            for (int m = 0; m < 4; ++m) { const int lr = lr0 + ai * 128 + m * 16; const float rs = rs8[ai * 4 + m];
#pragma unroll
                for (int bj = 0; bj < 2; ++bj) { const f32x4 g = acc[ai][bj][m][0] * rs, uu = acc[ai][bj][m][1] * rs;
                    f32x4 h = (f32x4){siluf_(g[0]) * uu[0], siluf_(g[1]) * uu[1], siluf_(g[2]) * uu[2], siluf_(g[3]) * uu[3]}; if (ABL == 8) h = (f32x4){1.f, 1.f, 1.f, 1.f};
                    u32x2 w; w.x = cvt_pk_bf16(h[0], h[1]); w.y = cvt_pk_bf16(h[2], h[3]);
                    *(u32x2*)(HB + (size_t)lr * 256 + u.pn * 128 + bj * 64 + wc * 16 + fq * 4) = w; }
                asm volatile("" ::: "memory"); }
        return true;
    }
};
template <int KL> struct PhDown {
    static constexpr int K = 256; static constexpr bool GATHER = false;
    unsigned char* ws; float* SSo; const int* META; const int* tok; const float* wl; int G, c;
    __device__ __forceinline__ bool next(int i, GUnit& u) const {
        const int nb = __builtin_amdgcn_readfirstlane(META[KL]); const long L = (long)i * G + c;
        if (L < 4L * nb) { const int blk = (int)(L >> 2); u.pn = (int)(L & 3); const int e = moe_expert_of(META, KL, blk); u.pm = blk; u.a0 = 0; u.a1 = e;
            u.A = (const char*)ws + WS_HB + (size_t)(KL * LISTCAP + blk * 256) * 256 * 2; u.B = (const char*)ws + WS_WEXP + 32ull * 512 * 1024 * 2 + (size_t)e * 1024 * 256 * 2 + (size_t)u.pn * 256 * K * 2; return true; }
        if (KL == 1) { const long L2 = L - 4L * nb; if (L2 >= 128 * 4) return false;
            pg8::tile_order((int)L2, 128, 4, u.pm, u.pn); u.a0 = 1; u.a1 = 0;
            u.A = (const char*)ws + WS_PBF + (size_t)u.pm * 256 * K * 2; u.B = (const char*)ws + WS_WPP + (size_t)u.pn * 256 * K * 2; return true; }
        return false;
    }
    __device__ __forceinline__ unsigned arow(const GUnit&, int) const { return 0u; }
    __device__ __forceinline__ void pre(const GUnit&, int, int, float (&)[8]) const {}
    __device__ __forceinline__ bool epi(Acc& acc, const GUnit& u, int wr, int wc, int fr, int fq, const float (&rs8)[8]) const {
        const int col0 = u.pn * 256 + wc * 32 + fq * 8;
        if (KL == 1 && u.a0 == 1) {
            bf16_t* PE = (bf16_t*)(ws + WS_PE); const int row0 = u.pm * 256 + wr * 64 + fr;
#pragma unroll
            for (int ai = 0; ai < 2; ++ai)
#pragma unroll
                for (int m = 0; m < 4; ++m)
#pragma unroll
                    for (int bj = 0; bj < 2; ++bj) *(u32x4*)(PE + (size_t)(row0 + ai * 128 + m * 16) * 1024 + col0 + bj * 128) = pack8(acc[ai][bj][m][0], acc[ai][bj][m][1]);
            return true;
        }
        const int lr0 = KL * LISTCAP + u.pm * 256 + wr * 64 + fr; bf16_t* YB = (bf16_t*)(ws + WS_YB1); const bf16_t* XB = (const bf16_t*)(ws + WS_XB); bf16_t* XT = (bf16_t*)(ws + WS_XBT);
        int tk[8]; float wk[8];
#pragma unroll
        for (int g = 0; g < 8; ++g) { const int lr = lr0 + (g >> 2) * 128 + (g & 3) * 16; tk[g] = tok[lr]; wk[g] = wl[lr]; }
        PIN8(tk[0], tk[1], tk[2], tk[3], tk[4], tk[5], tk[6], tk[7]); PIN8(wk[0], wk[1], wk[2], wk[3], wk[4], wk[5], wk[6], wk[7]);
#pragma unroll
        for (int ai = 0; ai < 2; ++ai)
#pragma unroll
            for (int mp = 0; mp < 2; ++mp) {
                if (KL == 1) {
#pragma unroll
                    for (int mm = 0; mm < 2; ++mm) { const int m = 2 * mp + mm; const int t = tk[ai * 4 + m]; const float w = wk[ai * 4 + m]; const size_t off = (size_t)(t < 0 ? 0 : t) * 1024 + col0;
                        if (t >= 0) {
#pragma unroll
                            for (int bj = 0; bj < 2; ++bj) *(u32x4*)(YB + off + bj * 128) = pack8(acc[ai][bj][m][0] * w, acc[ai][bj][m][1] * w); } }
                } else {
                    u32x4 xr[2][2], yr[2][2];
#pragma unroll
                    for (int mm = 0; mm < 2; ++mm) { const int t = tk[ai * 4 + 2 * mp + mm]; const size_t off = (size_t)(t < 0 ? 0 : t) * 1024 + col0;
#pragma unroll
                        for (int bj = 0; bj < 2; ++bj) { xr[mm][bj] = *(const u32x4*)(XB + off + bj * 128); yr[mm][bj] = *(const u32x4*)(YB + off + bj * 128); } }
                    PIN8(xr[0][0], xr[0][1], xr[1][0], xr[1][1], yr[0][0], yr[0][1], yr[1][0], yr[1][1]);
#pragma unroll
                    for (int mm = 0; mm < 2; ++mm) { const int m = 2 * mp + mm; const int t = tk[ai * 4 + m]; const float w = wk[ai * 4 + m]; const size_t off = (size_t)(t < 0 ? 0 : t) * 1024 + col0; float ss = 0.f;
                        if (t >= 0) {
#pragma unroll
                            for (int bj = 0; bj < 2; ++bj) { f32x4 x0, x1, y0, y1; unpack8(xr[mm][bj], x0, x1); unpack8(yr[mm][bj], y0, y1);
                                ss += store_x8(XT + off + bj * 128, (x0 + y0) + acc[ai][bj][m][0] * w, (x1 + y1) + acc[ai][bj][m][1] * w); } }
                        ss += __shfl_xor(ss, 16); ss += __shfl_xor(ss, 32);
                        if (fq == 0 && t >= 0) SSo[(size_t)t * 16 + u.pn * 4 + wc] = ss; }
                }
            }
        return true;
    }
};
struct PhPle {
    static constexpr int K = 1024; static constexpr bool GATHER = false;
    unsigned char* ws; const float* SSi; float* SSo; int G, c;
    __device__ __forceinline__ bool next(int i, GUnit& u) const {
        const long L = (long)i * G + c; if (L >= 128 * 4) return false;
        pg8::tile_order((int)L, 128, 4, u.pm, u.pn);
        u.A = (const char*)ws + WS_XBT + (size_t)u.pm * 256 * K * 2; u.B = (const char*)ws + WS_WPG + (size_t)u.pn * 256 * K * 2; u.a0 = 0; u.a1 = 0; return true;
    }
    __device__ __forceinline__ unsigned arow(const GUnit&, int) const { return 0u; }
    __device__ __forceinline__ void pre(const GUnit&, int, int, float (&)[8]) const {}
    __device__ __forceinline__ bool epi(Acc& acc, const GUnit& u, int wr, int wc, int fr, int fq, const float (&rs8)[8]) const {
        const int row0 = u.pm * 256 + wr * 64 + fr; const int col0 = u.pn * 256 + wc * 32 + fq * 8; bf16_t* XT = (bf16_t*)(ws + WS_XB); const bf16_t* PE = (const bf16_t*)(ws + WS_PE); const bf16_t* XBc = (const bf16_t*)(ws + WS_XBT);
        float rl8[8]; row_rs8(SSi, row0, rl8);
#pragma unroll
        for (int ai = 0; ai < 2; ++ai)
#pragma unroll
            for (int mp = 0; mp < 2; ++mp) {
                u32x4 xr[2][2], pr[2][2];
#pragma unroll
                for (int mm = 0; mm < 2; ++mm)
#pragma unroll
                    for (int bj = 0; bj < 2; ++bj) { const size_t off = (size_t)(row0 + ai * 128 + (2 * mp + mm) * 16) * 1024 + col0 + bj * 128; xr[mm][bj] = *(const u32x4*)(XBc + off); pr[mm][bj] = *(const u32x4*)(PE + off); }
                PIN8(xr[0][0], xr[0][1], xr[1][0], xr[1][1], pr[0][0], pr[0][1], pr[1][0], pr[1][1]);
#pragma unroll
                for (int mm = 0; mm < 2; ++mm) { const int m = 2 * mp + mm; const int row = row0 + ai * 128 + m * 16; const size_t off = (size_t)row * 1024 + col0; const float rs = rl8[ai * 4 + m]; float ss = 0.f;
#pragma unroll
                    for (int bj = 0; bj < 2; ++bj) { f32x4 p0, p1, x0, x1; unpack8(pr[mm][bj], p0, p1); unpack8(xr[mm][bj], x0, x1);
                        ss += store_x8(XT + off + bj * 128, x0 + sig4(acc[ai][bj][m][0] * rs) * p0, x1 + sig4(acc[ai][bj][m][1] * rs) * p1); }
                    ss += __shfl_xor(ss, 16); ss += __shfl_xor(ss, 32);
                    if (fq == 0) SSo[(size_t)row * 16 + u.pn * 4 + wc] = ss; }
            }
        return true;
    }
};

struct InPtrs { const float* const* p; __device__ __forceinline__ const float* operator[](int i) const { return (const float*)(GAS const float*)p[i]; } };
struct Ctx {
    InPtrs in; float* out; unsigned char* ws; LAS unsigned char* lds;
    int tid, lane, wave, G, bid;
};
enum { I_X = 0, I_P, I_GMIX, I_WIN, I_CONVW, I_CONVB, I_CLNG, I_CLNB, I_MCW, I_MCB, I_MIB, I_MFB, I_WBA, I_WBC, I_WBM, I_WOUT, I_GFFN, I_WRG, I_BRG, I_WRE, I_BRE,
       I_WEG, I_WEU, I_WED, I_GPLE, I_WPG, I_WPP, I_GFIN };

constexpr int TR_LDS = 64 * 65 * 4;
template <bool GAIN>
__device__ __forceinline__ void tr_item64(const float* colptr4, size_t pitch, const float* gainp, float cscale, bf16_t* dst, int K, int n0, int k0, LAS float* scr, int lane, const float* gain_or_valid) {
    const float* gain = GAIN ? gainp : nullptr;
    const int g = lane & 15, r = lane >> 4;
    f32x4 v[16]; float gs[16];
    const float* cp = colptr4 ? colptr4 : gain_or_valid;
#pragma unroll
    for (int i = 0; i < 16; ++i) { const int kk = 4 * i + r; v[i] = *(const f32x4*)(cp + (colptr4 ? (size_t)(k0 + kk) * pitch : 0)); gs[i] = gain ? gain[k0 + kk] : 1.0f; }
    PIN8(v[0], v[1], v[2], v[3], v[4], v[5], v[6], v[7]); PIN8(v[8], v[9], v[10], v[11], v[12], v[13], v[14], v[15]);
    const float zs = colptr4 ? cscale : 0.f;
#pragma unroll
    for (int i = 0; i < 16; ++i) { const int kk = 4 * i + r; const float m = gs[i] * zs; LAS float* p = scr + kk * 65 + 4 * g; p[0] = v[i].x * m; p[1] = v[i].y * m; p[2] = v[i].z * m; p[3] = v[i].w * m; }
    LDS_WAIT(); asm volatile("" ::: "memory");
    const int c = lane & 7, n8 = lane >> 3;
#pragma unroll
    for (int j = 0; j < 8; ++j) { const int n = n8 + 8 * j; const LAS float* sp = scr + (8 * c) * 65 + n;
        u32x4 o; o.x = pk2(sp[0 * 65], sp[1 * 65]); o.y = pk2(sp[2 * 65], sp[3 * 65]); o.z = pk2(sp[4 * 65], sp[5 * 65]); o.w = pk2(sp[6 * 65], sp[7 * 65]);
        *(u32x4*)(dst + (size_t)(n0 + n) * K + k0 + 8 * c) = o; }
    LDS_WAIT(); asm volatile("" ::: "memory");
}
__device__ __forceinline__ void rs_pass(const Ctx& F, const float* SS, float* RS) {
    for (int m = F.bid * NTHREADS + F.tid; m < T; m += F.G * NTHREADS) RS[m] = row_rs(SS, m);
}
__device__ __forceinline__ void phase_prep(const Ctx& F, int layer, float* SS) {
    const int gw = F.bid * NWAVES + F.wave, NGW = F.G * NWAVES, lane = F.lane;
    LAS float* scr = (LAS float*)(F.lds + F.wave * TR_LDS);
    bf16_t* XB = (bf16_t*)(F.ws + WS_XB);
    if (layer == 0) {
        for (int m0 = gw; m0 < T; m0 += 4 * NGW) {
            f32x4 v[4][4];
#pragma unroll
            for (int r = 0; r < 4; ++r) { const f32x4* xr = (const f32x4*)(F.in[I_X] + (size_t)(m0 + r * NGW) * D) + lane;
#pragma unroll
                for (int j = 0; j < 4; ++j) v[r][j] = xr[64 * j]; }
            PIN8(v[0][0], v[0][1], v[0][2], v[0][3], v[1][0], v[1][1], v[1][2], v[1][3]); PIN8(v[2][0], v[2][1], v[2][2], v[2][3], v[3][0], v[3][1], v[3][2], v[3][3]);
#pragma unroll
            for (int r = 0; r < 4; ++r) { const int m = m0 + r * NGW; u32x2* xbr = (u32x2*)(XB + (size_t)m * D) + lane; float sq = 0.f;
#pragma unroll
                for (int j = 0; j < 4; ++j) { const f32x4 x = v[r][j]; sq += (x.x * x.x + x.y * x.y) + (x.z * x.z + x.w * x.w); u32x2 w; w.x = cvt_pk_bf16(x.x, x.y); w.y = cvt_pk_bf16(x.z, x.w); xbr[64 * j] = w; }
                sq = wave_sum(sq);
                if (lane == 0) ((float*)(F.ws + WS_TAB + TAB_RSA))[m] = rsqrtf(sq * (1.0f / 1024.0f) + EPS); }
        }
    }
    if (layer > 0) rs_pass(F, SS, (float*)(F.ws + WS_TAB + TAB_RSA));
    const float* w_in = F.in[I_WIN] + (size_t)layer * D * D_IN; const float* g_mix = F.in[I_GMIX] + (size_t)layer * D;
    constexpr int N_WIN = 140 * 16, N_BR = 16 * 8, N_SQ = 16 * 16, N_PP = 16 * 4, N_R = 4 * 16;
    constexpr int NITEMS = N_WIN + 3 * N_BR + 2 * N_SQ + N_PP + N_R;
    const int g4 = 4 * (lane & 15);
    for (int it = gw; it < NITEMS; it += NGW) {
        int r = it;
        if (r < N_WIN) { const int nb = r >> 4, kb = r & 15; const int n = nb * 64 + g4; int src = -1; float cs = 1.f;
            if (n < 2560) { src = n; if (n < 1536) cs = 0.125f * 1.4426950408889634f; }
            else if (n < 3584) { const int np = n - 2560, q8 = np >> 3, sg = (np >> 2) & 1; src = 2560 + sg * 512 + 4 * q8; }
            else if (n < 5640) src = n;
            else if (n < 5888) src = -1;
            else src = 5640 + (n - 5888);
            tr_item64<true>(src >= 0 ? w_in + src : nullptr, D_IN, g_mix, cs, (bf16_t*)(F.ws + WS_WIN), 1024, nb * 64, kb * 64, scr, lane, g_mix); continue; }
        r -= N_WIN;
        if (r < 3 * N_BR) { const int b = r / N_BR; r -= b * N_BR; const int nb = r >> 3, kb = r & 7; const int n = nb * 64 + g4;
            const float* w = (b == 0 ? F.in[I_WBA] : (b == 1 ? F.in[I_WBC] : F.in[I_WBM])) + (size_t)layer * 512 * 1024;
            tr_item64<false>(w + n, 1024, nullptr, 1.f, (bf16_t*)(F.ws + WS_WBR) + (size_t)b * 1024 * 512, 512, nb * 64, kb * 64, scr, lane, g_mix); continue; }
        r -= 3 * N_BR;
        if (r < 2 * N_SQ) { const int b = r / N_SQ; r -= b * N_SQ; const int nb = r >> 4, kb = r & 15; const int n = nb * 64 + g4;
            const float* w = (b == 0 ? F.in[I_WOUT] : F.in[I_WPG]) + (size_t)layer * 1024 * 1024;
            if (b == 0) tr_item64<false>(w + n, 1024, nullptr, 1.f, (bf16_t*)(F.ws + WS_WOUT), 1024, nb * 64, kb * 64, scr, lane, g_mix);
            else tr_item64<true>(w + n, 1024, F.in[I_GPLE] + (size_t)layer * D, 1.f, (bf16_t*)(F.ws + WS_WPG), 1024, nb * 64, kb * 64, scr, lane, g_mix);
            continue; }
        r -= 2 * N_SQ;
        if (r < N_PP) { const int nb = r >> 2, kb = r & 3; const int n = nb * 64 + g4;
            tr_item64<false>(F.in[I_WPP] + (size_t)layer * 256 * 1024 + n, 1024, nullptr, 1.f, (bf16_t*)(F.ws + WS_WPP), 256, nb * 64, kb * 64, scr, lane, g_mix); continue; }
        r -= N_PP;
        { const int nb = r >> 4, kb = r & 15; const int n = nb * 64 + g4; const float* cp = nullptr; size_t pitch = 4;
            if (n < 4) { cp = F.in[I_WRG] + (size_t)layer * 1024 * 4 + n; pitch = 4; } else if (n < 36) { cp = F.in[I_WRE] + (size_t)layer * 1024 * 32 + (n - 4); pitch = 32; }
            tr_item64<true>(cp, pitch, F.in[I_GFFN] + (size_t)layer * D, 1.f, (bf16_t*)(F.ws + WS_WR), 1024, nb * 64, kb * 64, scr, lane, g_mix); }
    }
}
__device__ __forceinline__ void phase_prep_experts(const Ctx& F, int layer) {
    const int gw = F.bid * NWAVES + F.wave, NGW = F.G * NWAVES, lane = F.lane;
    LAS float* scr = (LAS float*)(F.lds + F.wave * TR_LDS);
    const float* g_ffn = F.in[I_GFFN] + (size_t)layer * D;
    constexpr int N_UP = 32 * 8 * 16, N_DN = 32 * 16 * 4;
    const int g4 = 4 * (lane & 15);
    for (int it = gw; it < N_UP + N_DN; it += NGW) {
        int r = it;
        if (r < N_UP) { const int e = r >> 7; r &= 127; const int nb = r >> 4, kb = r & 15; const int n = nb * 64 + g4; const int q8 = n >> 3, sg = (n >> 2) & 1;
            const float* w = (sg ? F.in[I_WEU] : F.in[I_WEG]) + ((size_t)layer * 32 + e) * 1024 * 256 + 4 * q8;
            tr_item64<true>(w, 256, g_ffn, 1.f, (bf16_t*)(F.ws + WS_WEXP) + (size_t)e * 512 * 1024, 1024, nb * 64, kb * 64, scr, lane, g_ffn); continue; }
        r -= N_UP;
        { const int e = r >> 6; r &= 63; const int nb = r >> 2, kb = r & 3; const int n = nb * 64 + g4;
            const float* w = F.in[I_WED] + ((size_t)layer * 32 + e) * 256 * 1024 + n;
            tr_item64<false>(w, 1024, nullptr, 1.f, (bf16_t*)(F.ws + WS_WEXP) + 32ull * 512 * 1024 + (size_t)e * 1024 * 256, 256, nb * 64, kb * 64, scr, lane, g_ffn); }
    }
    const f32x4* p = (const f32x4*)(F.in[I_P] + (size_t)layer * T * 256); u32x2* pb = (u32x2*)(F.ws + WS_PBF);
    { const size_t n = (size_t)T * 256 / 4, st = (size_t)F.G * NTHREADS;
        for (size_t i0 = (size_t)F.bid * NTHREADS + F.tid; i0 < n; i0 += 8 * st) { f32x4 v[8];
#pragma unroll
            for (int k = 0; k < 8; ++k) { const size_t i = i0 + k * st; v[k] = p[i < n ? i : 0]; }
            PIN8(v[0], v[1], v[2], v[3], v[4], v[5], v[6], v[7]);
#pragma unroll
            for (int k = 0; k < 8; ++k) { const size_t i = i0 + k * st; if (i < n) { u32x2 w; w.x = cvt_pk_bf16(v[k].x, v[k].y); w.y = cvt_pk_bf16(v[k].z, v[k].w); pb[i] = w; } } } }
}

constexpr int AK_RS = 144, AV_RS = 160, AV_OFF = 2 * 128 * AK_RS;
typedef short s16x4 __attribute__((ext_vector_type(4)));
__device__ __forceinline__ s16x4 lds_tr16(LAS unsigned char* p) { return __builtin_amdgcn_ds_read_tr16_b64_v4i16((LAS s16x4*)p); }
__device__ __forceinline__ void attn_strip(const Ctx& F, int strip) {
    const int bs = strip / 48, sg = strip - bs * 48, b = bs >> 3, slot = bs & 7;
    int g, r, nb0;
    if (sg < 16) { g = 0; r = 0; nb0 = sg * 8; } else if (sg < 32) { g = 1; r = (sg - 16) >> 2; nb0 = ((sg - 16) & 3) * 8; } else { g = 2; r = sg - 32; nb0 = 0; }
    const int dl = 1 << (2 * g); const float slope = exp2f(-(float)(g * 8 + slot + 1) * (1.0f / 3.0f)) * (float)dl * 1.4426950408889634f;
    bf16_t* Qg = (bf16_t*)(F.ws + (g == 0 ? WS_QA0 : (g == 1 ? WS_QA1 : WS_QA2))) + slot * 64;
    const bf16_t* Kg = (const bf16_t*)(F.ws + WS_KA) + slot * 64; const bf16_t* Vg = (const bf16_t*)(F.ws + WS_VA) + slot * 64;
    float* LSE = (float*)(F.ws + WS_LOGITS) + (size_t)g * T * 8 + slot;
    const size_t tok0 = (size_t)b * SEQ + r;
    LAS unsigned char* Kl = F.lds; LAS unsigned char* Vl = F.lds + AV_OFF;
    const int tid = F.tid, lane = F.lane, w = F.wave, fr = lane & 15, fq = lane >> 4;
    const int srow = tid >> 2, sc4 = tid & 3;
    u32x4 kx[2], vx[2];
#define ATT_LOAD(blk) do { const size_t _t = (tok0 + (size_t)((blk) * 128 + srow) * dl) * 512; \
        kx[0] = *(const u32x4*)(Kg + _t + sc4 * 8); kx[1] = *(const u32x4*)(Kg + _t + 32 + sc4 * 8); vx[0] = *(const u32x4*)(Vg + _t + sc4 * 8); vx[1] = *(const u32x4*)(Vg + _t + 32 + sc4 * 8); } while (0)
#define ATT_STORE(blk) do { const int _p = (((blk) & 1) * 128 + srow); \
        *(LAS u32x4*)(Kl + _p * AK_RS + sc4 * 16) = kx[0]; *(LAS u32x4*)(Kl + _p * AK_RS + 64 + sc4 * 16) = kx[1]; *(LAS u32x4*)(Vl + _p * AV_RS + sc4 * 16) = vx[0]; *(LAS u32x4*)(Vl + _p * AV_RS + 64 + sc4 * 16) = vx[1]; } while (0)
    __syncthreads();
    if (nb0 > 0) { ATT_LOAD(nb0 - 1); ATT_STORE(nb0 - 1); }
    else { kx[0] = kx[1] = vx[0] = vx[1] = (u32x4){0u, 0u, 0u, 0u}; ATT_STORE(1); }
    ATT_LOAD(nb0); ATT_STORE(nb0);
    bf16x8 qn0, qn1;
    { const size_t qo = (tok0 + (size_t)(nb0 * 128 + 16 * w + fr) * dl) * 512; qn0 = *(const bf16x8*)(Qg + qo + fq * 8); qn1 = *(const bf16x8*)(Qg + qo + 32 + fq * 8); }
    __syncthreads();
    for (int nb = nb0; nb < nb0 + 8; ++nb) {
        const bool more = nb + 1 < nb0 + 8;
        if (more) ATT_LOAD(nb + 1);
        const size_t qoff = (tok0 + (size_t)(nb * 128 + 16 * w + fr) * dl) * 512;
        const bf16x8 q0 = qn0, q1 = qn1;
        if (more) { const size_t qo2 = qoff + (size_t)128 * dl * 512; qn0 = *(const bf16x8*)(Qg + qo2 + fq * 8); qn1 = *(const bf16x8*)(Qg + qo2 + 32 + fq * 8); }
        const int pslot = (nb - 1) & 1;
        f32x4 S[10];
        S[9] = (f32x4){0.f, 0.f, 0.f, 0.f};
#pragma unroll
        for (int kbi = 0; kbi < 9; ++kbi) {
            int kb = w + kbi; if (kb > 15) kb = 15;
            const int ki = kb * 16 + fr; const int phys = ((pslot + (ki >> 7)) & 1) * 128 + (ki & 127);
            const bf16x8 k0 = *(const LAS bf16x8*)(Kl + phys * AK_RS + fq * 16), k1 = *(const LAS bf16x8*)(Kl + phys * AK_RS + 64 + fq * 16);
            f32x4 a = (f32x4){0.f, 0.f, 0.f, 0.f};
            a = __builtin_amdgcn_mfma_f32_16x16x32_bf16(k0, q0, a, 0, 0, 0);
            S[kbi] = __builtin_amdgcn_mfma_f32_16x16x32_bf16(k1, q1, a, 0, 0, 0);
        }
        float mx = -INFINITY;
        const int dbase = fr - 4 * fq + 128; const float fb = slope * (float)dbase; const int kmin = (nb > 0) ? 0 : 128 - (16 * w + 4 * fq);
#pragma unroll
        for (int kbi = 0; kbi < 9; ++kbi)
#pragma unroll
            for (int j = 0; j < 4; ++j) { const int cj = 16 * kbi + j;
                const bool ok = (unsigned)(dbase - cj) <= 128u && cj >= kmin;
                const float sc = ok ? __builtin_fmaf(slope, (float)cj, S[kbi][j] - fb) : -INFINITY; S[kbi][j] = sc; mx = fmaxf(mx, sc); }
        mx = fmaxf(mx, __shfl_xor(mx, 16)); mx = fmaxf(mx, __shfl_xor(mx, 32));
        float ls = 0.f;
#pragma unroll
        for (int kbi = 0; kbi < 9; ++kbi)
#pragma unroll
            for (int j = 0; j < 4; ++j) { const float p = __builtin_amdgcn_exp2f(S[kbi][j] - mx); S[kbi][j] = p; ls += p; }
        ls += __shfl_xor(ls, 16); ls += __shfl_xor(ls, 32);
        f32x4 O[4];
#pragma unroll
        for (int db = 0; db < 4; ++db) O[db] = (f32x4){0.f, 0.f, 0.f, 0.f};
#pragma unroll
        for (int k2 = 0; k2 < 5; ++k2) {
            u32x4 pw; pw.x = cvt_pk_bf16(S[2 * k2][0], S[2 * k2][1]); pw.y = cvt_pk_bf16(S[2 * k2][2], S[2 * k2][3]); pw.z = cvt_pk_bf16(S[2 * k2 + 1][0], S[2 * k2 + 1][1]); pw.w = cvt_pk_bf16(S[2 * k2 + 1][2], S[2 * k2 + 1][3]);
            const bf16x8 pf = __builtin_bit_cast(bf16x8, pw);
            int kb0 = w + 2 * k2, kb1 = kb0 + 1; if (kb1 > 15) kb1 = 15; if (kb0 > 15) kb0 = 15;
            const int r0 = kb0 * 16 + 4 * fq + (fr >> 2), r1 = kb1 * 16 + 4 * fq + (fr >> 2);
            const int p0 = ((pslot + (r0 >> 7)) & 1) * 128 + (r0 & 127), p1 = ((pslot + (r1 >> 7)) & 1) * 128 + (r1 & 127);
#pragma unroll
            for (int db = 0; db < 4; ++db) {
                const s16x4 v0 = lds_tr16(Vl + p0 * AV_RS + (db * 16 + 4 * (fr & 3)) * 2), v1 = lds_tr16(Vl + p1 * AV_RS + (db * 16 + 4 * (fr & 3)) * 2);
                const bf16x8 vf = (bf16x8){v0[0], v0[1], v0[2], v0[3], v1[0], v1[1], v1[2], v1[3]};
                O[db] = __builtin_amdgcn_mfma_f32_16x16x32_bf16(vf, pf, O[db], 0, 0, 0);
            }
        }
        const float inv = 1.0f / ls;
#pragma unroll
        for (int db = 0; db < 4; ++db) { u32x2 ow; ow.x = cvt_pk_bf16(O[db][0] * inv, O[db][1] * inv); ow.y = cvt_pk_bf16(O[db][2] * inv, O[db][3] * inv);
            *(u32x2*)(Qg + qoff + db * 16 + 4 * fq) = ow; }
        if (fq == 0) LSE[(qoff >> 9) * 8] = mx + __builtin_amdgcn_logf(ls);
        __syncthreads();
        if (more) ATT_STORE(nb + 1);
        __syncthreads();
    }
#undef ATT_LOAD
#undef ATT_STORE
}
__device__ __forceinline__ void attn_combine(const Ctx& F) {
    const float* LSE = (const float*)(F.ws + WS_LOGITS);
    for (int i0 = F.bid * NTHREADS + F.tid; i0 < T * 64; i0 += 4 * F.G * NTHREADS) {
        u32x4 a[4], bb[4], cc[4]; float l0[4], l1[4], l2[4];
#pragma unroll
        for (int k = 0; k < 4; ++k) { const int i = i0 + k * F.G * NTHREADS; const int ic = i < T * 64 ? i : 0; const int t = ic >> 6, slot = (ic & 63) >> 3;
            a[k] = ((const u32x4*)(F.ws + WS_QA0))[ic]; bb[k] = ((const u32x4*)(F.ws + WS_QA1))[ic]; cc[k] = ((const u32x4*)(F.ws + WS_QA2))[ic];
            l0[k] = LSE[(size_t)t * 8 + slot]; l1[k] = LSE[(size_t)T * 8 + (size_t)t * 8 + slot]; l2[k] = LSE[(size_t)2 * T * 8 + (size_t)t * 8 + slot]; }
        PIN4(a[0], a[1], a[2], a[3]); PIN4(bb[0], bb[1], bb[2], bb[3]); PIN4(cc[0], cc[1], cc[2], cc[3]);
#pragma unroll
        for (int k = 0; k < 4; ++k) { const int i = i0 + k * F.G * NTHREADS; if (i < T * 64) {
            const float m = fmaxf(l0[k], fmaxf(l1[k], l2[k])); float w0 = __builtin_amdgcn_exp2f(l0[k] - m), w1 = __builtin_amdgcn_exp2f(l1[k] - m), w2 = __builtin_amdgcn_exp2f(l2[k] - m); const float inv = __builtin_amdgcn_rcpf(w0 + w1 + w2); w0 *= inv; w1 *= inv; w2 *= inv;
            f32x4 a0, a1, b0, b1, c0, c1; unpack8(a[k], a0, a1); unpack8(bb[k], b0, b1); unpack8(cc[k], c0, c1);
            ((u32x4*)(F.ws + WS_QA0))[i] = pack8(a0 * w0 + b0 * w1 + c0 * w2, a1 * w0 + b1 * w1 + c1 * w2); } }
    }
}

__device__ __forceinline__ void conv_item(const Ctx& F, int layer, int item) {
    const int t0 = item * 32, s0 = t0 & (SEQ - 1), tid = F.tid;
    LAS bf16_t* sin = (LAS bf16_t*)F.lds;
    LAS float* sout = (LAS float*)(F.lds + 65536);
    const bf16_t* YG = (const bf16_t*)(F.ws + WS_YG);
    __syncthreads();
#pragma unroll 1
    for (int kb = 0; kb < 2; ++kb) { u32x4 sv[4];
#pragma unroll
        for (int k = 0; k < 4; ++k) { const int i = tid + (kb * 4 + k) * NTHREADS; const int r = i < 62 * 64 ? (i >> 6) : 0, c8 = i & 63; const int sp = s0 - 30 + r;
            sv[k] = *(const u32x4*)(YG + (size_t)(sp >= 0 ? t0 - 30 + r : t0) * 512 + c8 * 8); }
        PIN4(sv[0], sv[1], sv[2], sv[3]);
#pragma unroll
        for (int k = 0; k < 4; ++k) { const int i = tid + (kb * 4 + k) * NTHREADS; const int r = i >> 6, c8 = i & 63; const int sp = s0 - 30 + r;
            if (i < 62 * 64) *(LAS u32x4*)(sin + r * 512 + c8 * 8) = sp >= 0 ? sv[k] : (u32x4){0u, 0u, 0u, 0u}; } }
    const int cp = tid & 255, hf = tid >> 8;
    f32x2 w[31];
    const float* cw = F.in[I_CONVW] + (size_t)layer * 31 * 512 + 2 * cp;
#pragma unroll
    for (int k = 0; k < 31; ++k) w[k] = *(const f32x2*)(cw + k * 512);
    const f32x2 cb = *(const f32x2*)(F.in[I_CONVB] + layer * 512 + 2 * cp);
    __syncthreads();
#pragma unroll 1
    for (int ps = 0; ps < 2; ++ps) { const int tb = 16 * hf + 8 * ps;
        f32x2 xin[38];
#pragma unroll
        for (int r = 0; r < 38; ++r) { const unsigned u = *(const LAS unsigned*)(sin + (tb + r) * 512 + 2 * cp); xin[r] = (f32x2){bf_lo(u), bf_hi(u)}; }
#pragma unroll
        for (int tt = 0; tt < 8; ++tt) { f32x2 a = cb;
#pragma unroll
            for (int k = 0; k < 31; ++k) a += w[k] * xin[tt + k];
            *(LAS f32x2*)(sout + (tb + tt) * 512 + 2 * cp) = a; } }
    __syncthreads();
    const float* lg = F.in[I_CLNG] + layer * 512 + F.lane * 8; const float* lb = F.in[I_CLNB] + layer * 512 + F.lane * 8;
    for (int tt = F.wave; tt < 32; tt += NWAVES) {
        float v[8]; float sm = 0.f;
#pragma unroll
        for (int j = 0; j < 8; ++j) { v[j] = sout[tt * 512 + F.lane * 8 + j]; sm += v[j]; }
        const float mu = wave_sum(sm) * (1.0f / 512.0f); float q = 0.f;
#pragma unroll
        for (int j = 0; j < 8; ++j) { v[j] -= mu; q += v[j] * v[j]; }
        const float rstd = rsqrtf(wave_sum(q) * (1.0f / 512.0f) + EPS);
        float o[8];
#pragma unroll
        for (int j = 0; j < 8; ++j) o[j] = siluf_(v[j] * rstd * lg[j] + lb[j]);
        u32x4 wv; wv.x = cvt_pk_bf16(o[0], o[1]); wv.y = cvt_pk_bf16(o[2], o[3]); wv.z = cvt_pk_bf16(o[4], o[5]); wv.w = cvt_pk_bf16(o[6], o[7]);
        *(u32x4*)((bf16_t*)(F.ws + WS_YC) + (size_t)(t0 + tt) * 512 + F.lane * 8) = wv;
    }
}

__device__ __forceinline__ float log_sigmoid_(float v) { return fminf(v, 0.f) - log1pf(__expf(-fabsf(v))); }
struct QkW { float w[4][8]; float b[8]; };
__device__ __forceinline__ void qk_load_w(const Ctx& F, int layer, int chq, QkW& W) {
    const float* cw = F.in[I_MCW] + (size_t)layer * 4 * 1024 + chq; const float* cb = F.in[I_MCB] + (size_t)layer * 1024 + chq;
#pragma unroll
    for (int k = 0; k < 4; ++k) { const f32x4 a = *(const f32x4*)(cw + k * 1024), b = *(const f32x4*)(cw + k * 1024 + 4); W.w[k][0] = a.x; W.w[k][1] = a.y; W.w[k][2] = a.z; W.w[k][3] = a.w; W.w[k][4] = b.x; W.w[k][5] = b.y; W.w[k][6] = b.z; W.w[k][7] = b.w; }
    const f32x4 a = *(const f32x4*)cb, b = *(const f32x4*)(cb + 4); W.b[0] = a.x; W.b[1] = a.y; W.b[2] = a.z; W.b[3] = a.w; W.b[4] = b.x; W.b[5] = b.y; W.b[6] = b.z; W.b[7] = b.w;
}
__device__ __forceinline__ void qk_conv8(const QkW& W, const bf16_t* src  , int t, int s, int ch  , float scale, float* o) {
#pragma unroll
    for (int j = 0; j < 8; ++j) o[j] = W.b[j];
#pragma unroll
    for (int k = 0; k < 4; ++k) { const bool ok = s - 3 + k >= 0; u32x4 w = *(const u32x4*)(src + (size_t)(ok ? t - 3 + k : t) * 512 + ch);
            if (!ok) w = (u32x4){0u, 0u, 0u, 0u};
            o[0] += W.w[k][0] * bf_lo(w.x); o[1] += W.w[k][1] * bf_hi(w.x); o[2] += W.w[k][2] * bf_lo(w.y); o[3] += W.w[k][3] * bf_hi(w.y); o[4] += W.w[k][4] * bf_lo(w.z); o[5] += W.w[k][5] * bf_hi(w.z); o[6] += W.w[k][6] * bf_lo(w.w); o[7] += W.w[k][7] * bf_hi(w.w); }
#pragma unroll
    for (int j = 0; j < 8; ++j) o[j] = siluf_(o[j]) * scale;
}
__device__ __forceinline__ void qk_conv8r(const QkW& W, const u32x4 (&rw)[4], int s, float scale, float* o) {
#pragma unroll
    for (int j = 0; j < 8; ++j) o[j] = W.b[j];
#pragma unroll
    for (int k = 0; k < 4; ++k) { u32x4 w = rw[k]; if (s - 3 + k < 0) w = (u32x4){0u, 0u, 0u, 0u};
        o[0] += W.w[k][0] * bf_lo(w.x); o[1] += W.w[k][1] * bf_hi(w.x); o[2] += W.w[k][2] * bf_lo(w.y); o[3] += W.w[k][3] * bf_hi(w.y); o[4] += W.w[k][4] * bf_lo(w.z); o[5] += W.w[k][5] * bf_hi(w.z); o[6] += W.w[k][6] * bf_lo(w.w); o[7] += W.w[k][7] * bf_hi(w.w); }
#pragma unroll
    for (int j = 0; j < 8; ++j) o[j] = siluf_(o[j]) * scale;
}
__device__ __forceinline__ void mlstm_scalars(const Ctx& F, int layer, int t0, int h, LAS float* sIG, LAS float* sBC) {
    if (F.tid < 128) { const float* IFp = (const float*)(F.ws + WS_IF) + (size_t)(t0 + F.tid) * 8;
        sIG[F.tid] = IFp[h] + F.in[I_MIB][layer * 4 + h]; sBC[F.tid] = log_sigmoid_(IFp[4 + h] + F.in[I_MFB][layer * 4 + h]); }
    __syncthreads();
    if (F.wave == 0) { const float a = sBC[2 * F.lane], bb = sBC[2 * F.lane + 1]; float sc = a + bb;
#pragma unroll
        for (int off = 1; off < 64; off <<= 1) { const float t = __shfl_up(sc, off); if (F.lane >= off) sc += t; }
        sBC[2 * F.lane] = sc - bb; sBC[2 * F.lane + 1] = sc; }
    __syncthreads();
}
constexpr int ML_KRS = 288, ML_ERS = 352, ML_E = 128 * ML_KRS, ML_S = ML_E + 128 * ML_ERS;
__device__ __forceinline__ void mlstm_local_mfma(const Ctx& F, int layer, int item) {
    const int c = item & 127, bh = item >> 7, h = bh & 3, b = bh >> 2, t0 = b * SEQ + c * 128, tid = F.tid, lane = F.lane, w = F.wave, fr = lane & 15, fq = lane >> 4;
    LAS unsigned char* L = F.lds;
    LAS float* sIG = (LAS float*)(L + ML_S); LAS float* sBC = sIG + 128; LAS float* sE = sIG + 256; LAS float* sM = sIG + 384;
    __syncthreads();
    mlstm_scalars(F, layer, t0, h, sIG, sBC);
    if (w == 0) { const float gt = sBC[127]; const float m = wave_max(fmaxf(gt - sBC[lane] + sIG[lane], gt - sBC[lane + 64] + sIG[lane + 64])); if (lane == 0) { sM[0] = m; sM[1] = gt; } }
    __syncthreads();
    if (tid < 128) sE[tid] = __expf(sM[1] - sBC[tid] + sIG[tid] - sM[0]);
    __syncthreads();
    const bf16_t* KM = (const bf16_t*)(F.ws + WS_KM); const bf16_t* VM = (const bf16_t*)(F.ws + WS_VM);
    QkW WK; qk_load_w(F, layer, 512 + h * 128 + (tid & 15) * 8, WK);
#pragma unroll 1
    for (int i = tid; i < 128 * 16; i += NTHREADS) { const int l = i >> 4, c8 = (i & 15) * 8; const int t = t0 + l, s = t & (SEQ - 1);
        u32x4 rk[4];
#pragma unroll
        for (int k = 0; k < 4; ++k) rk[k] = *(const u32x4*)(KM + (size_t)(s - 3 + k >= 0 ? t - 3 + k : t) * 512 + h * 128 + c8);
        const u32x4 rv = *(const u32x4*)(VM + (size_t)t * 512 + h * 128 + c8);
        float o[8]; qk_conv8r(WK, rk, s, 0.08838834764831845f, o);
        *(LAS u32x4*)(L + l * ML_KRS + c8 * 2) = pack8((f32x4){o[0], o[1], o[2], o[3]}, (f32x4){o[4], o[5], o[6], o[7]});
        f32x4 v0, v1; unpack8(rv, v0, v1); const float e = sE[l];
        *(LAS u32x4*)(L + ML_E + l * ML_ERS + c8 * 2) = pack8(v0 * e, v1 * e); }
    if (tid < 128) { unsigned zr = 0u; asm volatile("" : "+v"(zr));
        u32x4 z; z.x = f2bf(sE[tid]); z.y = zr; z.z = zr; z.w = zr; *(LAS u32x4*)(L + ML_E + tid * ML_ERS + 256) = z; z.x = zr; *(LAS u32x4*)(L + ML_E + tid * ML_ERS + 272) = z; }
    __syncthreads();
    bf16x8 af[4];
#pragma unroll
    for (int ks = 0; ks < 4; ++ks) { const int ra = ks * 32 + 4 * fq + (fr >> 2);
        const s16x4 a0 = lds_tr16(L + ra * ML_KRS + (w * 16 + 4 * (fr & 3)) * 2), a1 = lds_tr16(L + (ra + 16) * ML_KRS + (w * 16 + 4 * (fr & 3)) * 2);
        af[ks] = (bf16x8){a0[0], a0[1], a0[2], a0[3], a1[0], a1[1], a1[2], a1[3]}; }
    bf16_t* Cp = (bf16_t*)(F.ws + WS_CST) + ((size_t)(bh * 128 + c) << 14);
#pragma unroll
    for (int vb = 0; vb < 9; ++vb) { f32x4 d = (f32x4){0.f, 0.f, 0.f, 0.f};
#pragma unroll
        for (int ks = 0; ks < 4; ++ks) { const int rb = ks * 32 + 4 * fq + (fr >> 2);
            const s16x4 b0 = lds_tr16(L + ML_E + rb * ML_ERS + (vb * 16 + 4 * (fr & 3)) * 2), b1 = lds_tr16(L + ML_E + (rb + 16) * ML_ERS + (vb * 16 + 4 * (fr & 3)) * 2);
            const bf16x8 bfr = (bf16x8){b0[0], b0[1], b0[2], b0[3], b1[0], b1[1], b1[2], b1[3]};
            d = __builtin_amdgcn_mfma_f32_16x16x32_bf16(af[ks], bfr, d, 0, 0, 0); }
        if (vb < 8) { u32x2 o; o.x = pk2(d[0], d[1]); o.y = pk2(d[2], d[3]); *(u32x2*)(Cp + (size_t)(vb * 16 + fr) * 128 + w * 16 + 4 * fq) = o; }
        else if (fr == 0) *(f32x4*)((float*)(F.ws + WS_NST) + (size_t)(bh * 128 + c) * 128 + w * 16 + 4 * fq) = d;
    }
    if (tid == 0) { ((float*)(F.ws + WS_TAB + TAB_MLOC))[bh * 128 + c] = sM[0]; ((float*)(F.ws + WS_TAB + TAB_GTOT))[bh * 128 + c] = sM[1]; }
}
__device__ __forceinline__ void phase_scan(const Ctx& F) {
    const float* GT = (const float*)(F.ws + WS_TAB + TAB_GTOT); const float* ML = (const float*)(F.ws + WS_TAB + TAB_MLOC); float* MS = (float*)(F.ws + WS_TAB + TAB_MST);
    LAS float* sA = (LAS float*)F.lds; LAS float* sB = sA + 128;
    for (int blk = F.bid; blk < 8 * 16; blk += F.G) {
        const int bh = blk >> 4;
        __syncthreads();
        if (F.tid < 128) { sA[F.tid] = GT[bh * 128 + F.tid]; sB[F.tid] = ML[bh * 128 + F.tid]; }
        __syncthreads();
        if (F.wave == 0) {
            const int c0 = 2 * F.lane; const float g0 = sA[c0], m0 = sB[c0], g1 = sA[c0 + 1], m1 = sB[c0 + 1];
            float G = g0 + g1, M = fmaxf(m0 + g1, m1);
#pragma unroll
            for (int off = 1; off < 64; off <<= 1) { const float Gp = __shfl_up(G, off), Mp = __shfl_up(M, off); if (F.lane >= off) { M = fmaxf(Mp + G, M); G = Gp + G; } }
            float Gx = __shfl_up(G, 1), Mx = __shfl_up(M, 1); if (F.lane == 0) { Gx = 0.f; Mx = -INFINITY; }
            const float mA = fmaxf(0.f + Gx, Mx);
            const float mB = fmaxf(mA + g0, m0);
            const float mC = fmaxf(mB + g1, m1);
            sA[c0] = __expf(g0 + mA - mB); sB[c0] = __expf(m0 - mB); sA[c0 + 1] = __expf(g1 + mB - mC); sB[c0 + 1] = __expf(m1 - mC);
            if ((blk & 15) == 0) { MS[bh * 128 + c0] = mA; MS[bh * 128 + c0 + 1] = mB; } }
        __syncthreads();
        unsigned* cp = (unsigned*)((bf16_t*)(F.ws + WS_CST) + ((size_t)(bh * 128) << 14) + (blk & 15) * 1024) + F.tid; float v0 = 0.f, v1 = 0.f;
#pragma unroll 1
        for (int c0 = 0; c0 < 128; c0 += 64) { unsigned loc[64];
#pragma unroll
            for (int j = 0; j < 64; ++j) loc[j] = cp[(size_t)(c0 + j) << 13];
#pragma unroll
            for (int j = 0; j < 64; j += 8) PIN8(loc[j], loc[j + 1], loc[j + 2], loc[j + 3], loc[j + 4], loc[j + 5], loc[j + 6], loc[j + 7]);
#pragma unroll
            for (int j = 0; j < 64; ++j) { const float a = sA[c0 + j], b = sB[c0 + j]; cp[(size_t)(c0 + j) << 13] = pk2(v0, v1); v0 = a * v0 + b * bf_lo(loc[j]); v1 = a * v1 + b * bf_hi(loc[j]); } }
        if (F.tid < 8) {
            float* np = (float*)(F.ws + WS_NST) + (size_t)(bh * 128) * 128 + (blk & 15) * 8 + F.tid; float nval = 0.f;
#pragma unroll 1
            for (int c0 = 0; c0 < 128; c0 += 32) { float nloc[32];
#pragma unroll
                for (int j = 0; j < 32; ++j) nloc[j] = np[(size_t)(c0 + j) * 128];
#pragma unroll
                for (int j = 0; j < 32; j += 8) PIN8(nloc[j], nloc[j + 1], nloc[j + 2], nloc[j + 3], nloc[j + 4], nloc[j + 5], nloc[j + 6], nloc[j + 7]);
#pragma unroll
                for (int j = 0; j < 32; ++j) { np[(size_t)(c0 + j) * 128] = nval; nval = sA[c0 + j] * nval + sB[c0 + j] * nloc[j]; } } }
    }
    __syncthreads();
}
constexpr int MO_RS = 272, MO_VRS = 288;
constexpr int MO_Q = 0, MO_K = 128 * MO_RS, MO_C = 2 * 128 * MO_RS, MO_V = MO_C + 144 * MO_RS, MO_S = MO_V + 128 * MO_VRS;
static_assert(MO_S + 2560 <= MISC_OFF, "mlstm_out LDS");
__device__ __forceinline__ void mlstm_out_mfma(const Ctx& F, int layer, int item) {
    const int c = item & 127, bh = item >> 7, h = bh & 3, b = bh >> 2, t0 = b * SEQ + c * 128, tid = F.tid, lane = F.lane, w = F.wave, fr = lane & 15, fq = lane >> 4;
    LAS unsigned char* L = F.lds;
    LAS float* sIG = (LAS float*)(L + MO_S); LAS float* sBC = sIG + 128; LAS float* sMT = sIG + 256; LAS float* sSI = sIG + 384; LAS float* sU = sIG + 512;
    __syncthreads();
    mlstm_scalars(F, layer, t0, h, sIG, sBC);
    if (tid < 128) sU[tid] = (sIG[tid] - sBC[tid]) * 1.4426950408889634f;
    const float mst = ((const float*)(F.ws + WS_TAB + TAB_MST))[bh * 128 + c];
    if (w == 0) { const float a = sIG[2 * lane] - sBC[2 * lane], bb = sIG[2 * lane + 1] - sBC[2 * lane + 1]; float pm = fmaxf(a, bb);
#pragma unroll
        for (int off = 1; off < 64; off <<= 1) { const float t = __shfl_up(pm, off); if (lane >= off) pm = fmaxf(pm, t); }
        float pl = __shfl_up(pm, 1); if (lane == 0) pl = -INFINITY;
        const float p0 = fmaxf(pl, a), p1 = pm;
        { const float ai = sBC[2 * lane] + mst, mt = fmaxf(ai, sBC[2 * lane] + p0); sMT[2 * lane] = mt; sSI[2 * lane] = __expf(ai - mt); }
        { const float ai = sBC[2 * lane + 1] + mst, mt = fmaxf(ai, sBC[2 * lane + 1] + p1); sMT[2 * lane + 1] = mt; sSI[2 * lane + 1] = __expf(ai - mt); } }
    const bf16_t* QM = (const bf16_t*)(F.ws + WS_QM); const bf16_t* KM = (const bf16_t*)(F.ws + WS_KM); const bf16_t* VM = (const bf16_t*)(F.ws + WS_VM);
    const bf16_t* Cp = (const bf16_t*)(F.ws + WS_CST) + ((size_t)(bh * 128 + c) << 14);
    QkW WQ, WK; qk_load_w(F, layer, h * 128 + (tid & 15) * 8, WQ); qk_load_w(F, layer, 512 + h * 128 + (tid & 15) * 8, WK);
#pragma unroll 1
    for (int i = tid; i < 128 * 16; i += NTHREADS) { const int l = i >> 4, c8 = (i & 15) * 8; const int t = t0 + l, s = t & (SEQ - 1); float o[8];
        u32x4 rq[4], rk[4];
#pragma unroll
        for (int k = 0; k < 4; ++k) { const size_t ro = (size_t)(s - 3 + k >= 0 ? t - 3 + k : t) * 512 + h * 128 + c8; rq[k] = *(const u32x4*)(QM + ro); rk[k] = *(const u32x4*)(KM + ro); }
        const u32x4 rv = *(const u32x4*)(VM + (size_t)t * 512 + h * 128 + c8), rc = *(const u32x4*)(Cp + l * 128 + c8);
        qk_conv8r(WQ, rq, s, 1.0f, o);
        *(LAS u32x4*)(L + MO_Q + l * MO_RS + c8 * 2) = pack8((f32x4){o[0], o[1], o[2], o[3]}, (f32x4){o[4], o[5], o[6], o[7]});
        qk_conv8r(WK, rk, s, 0.08838834764831845f, o);
        *(LAS u32x4*)(L + MO_K + l * MO_RS + c8 * 2) = pack8((f32x4){o[0], o[1], o[2], o[3]}, (f32x4){o[4], o[5], o[6], o[7]});
        *(LAS u32x4*)(L + MO_V + l * MO_VRS + c8 * 2) = rv;
        *(LAS u32x4*)(L + MO_C + l * MO_RS + c8 * 2) = rc; }
    if (tid < 16) { const float* np = (const float*)(F.ws + WS_NST) + (size_t)(bh * 128 + c) * 128 + tid * 8;
        *(LAS u32x4*)(L + MO_C + 128 * MO_RS + tid * 16) = pack8(*(const f32x4*)np, *(const f32x4*)(np + 4)); }
    __syncthreads();
    const int q = 16 * w + fr;
    bf16x8 qf[4];
#pragma unroll
    for (int ks = 0; ks < 4; ++ks) qf[ks] = *(const LAS bf16x8*)(L + MO_Q + q * MO_RS + ks * 64 + fq * 16);
    f32x4 O[9];
#pragma unroll
    for (int vb = 0; vb < 9; ++vb) { f32x4 a = (f32x4){0.f, 0.f, 0.f, 0.f};
#pragma unroll
        for (int ks = 0; ks < 4; ++ks) { const bf16x8 cf = *(const LAS bf16x8*)(L + MO_C + (vb * 16 + fr) * MO_RS + ks * 64 + fq * 16); a = __builtin_amdgcn_mfma_f32_16x16x32_bf16(cf, qf[ks], a, 0, 0, 0); }
        O[vb] = a; }
    const float si = sSI[q], mt = sMT[q], bq = sBC[q]; const float vq = (bq - mt) * 1.4426950408889634f;
    const float dn = __shfl(O[8][0], fr);
#pragma unroll
    for (int vb = 0; vb < 8; ++vb) O[vb] = O[vb] * si;
    float den = 0.f;
    for (int k2 = 0; k2 <= (w >> 1); ++k2) {
        f32x4 P[2];
#pragma unroll
        for (int u = 0; u < 2; ++u) { const int kb = 2 * k2 + u; f32x4 a = (f32x4){0.f, 0.f, 0.f, 0.f};
            const int kr = (kb > 7 ? 7 : kb) * 16 + fr;
#pragma unroll
            for (int ks = 0; ks < 4; ++ks) { const bf16x8 kf = *(const LAS bf16x8*)(L + MO_K + kr * MO_RS + ks * 64 + fq * 16); a = __builtin_amdgcn_mfma_f32_16x16x32_bf16(kf, qf[ks], a, 0, 0, 0); }
#pragma unroll
            for (int j = 0; j < 4; ++j) { const int k = kb * 16 + 4 * fq + j; const int kc = k > 127 ? 127 : k; const float wgt = (k <= q) ? __builtin_amdgcn_exp2f(sU[kc] + vq) : 0.f; a[j] *= wgt; den += a[j]; }
            P[u] = a; }
        u32x4 pw; pw.x = cvt_pk_bf16(P[0][0], P[0][1]); pw.y = cvt_pk_bf16(P[0][2], P[0][3]); pw.z = cvt_pk_bf16(P[1][0], P[1][1]); pw.w = cvt_pk_bf16(P[1][2], P[1][3]);
        const bf16x8 pf = __builtin_bit_cast(bf16x8, pw);
        const int kb1 = (2 * k2 + 1 > 7) ? 7 : 2 * k2 + 1;
        const int r0 = 2 * k2 * 16 + 4 * fq + (fr >> 2), r1 = kb1 * 16 + 4 * fq + (fr >> 2);
#pragma unroll
        for (int vb = 0; vb < 8; ++vb) {
            const s16x4 v0 = lds_tr16(L + MO_V + r0 * MO_VRS + (vb * 16 + 4 * (fr & 3)) * 2), v1 = lds_tr16(L + MO_V + r1 * MO_VRS + (vb * 16 + 4 * (fr & 3)) * 2);
            const bf16x8 vf = (bf16x8){v0[0], v0[1], v0[2], v0[3], v1[0], v1[1], v1[2], v1[3]};
            O[vb] = __builtin_amdgcn_mfma_f32_16x16x32_bf16(vf, pf, O[vb], 0, 0, 0);
        }
    }
    den += __shfl_xor(den, 16); den += __shfl_xor(den, 32);
    const float dd = den + si * dn; const float inv = 1.0f / fmaxf(fabsf(dd), __expf(-mt));
    bf16_t* OM = (bf16_t*)(F.ws + WS_OM) + (size_t)(t0 + q) * 512 + h * 128;
#pragma unroll
    for (int vb = 0; vb < 8; ++vb) { u32x2* p = (u32x2*)(OM + vb * 16 + 4 * fq); const u32x2 g = *p;
        u32x2 o; o.x = cvt_pk_bf16(bf_lo(g.x) * O[vb][0] * inv, bf_hi(g.x) * O[vb][1] * inv); o.y = cvt_pk_bf16(bf_lo(g.y) * O[vb][2] * inv, bf_hi(g.y) * O[vb][3] * inv); *p = o; }
}

__device__ __forceinline__ void phase_route(const Ctx& F, int layer, int tile0, int tile1, int tstep) {
    LAS int* hist = (LAS int*)F.lds;
    const float* brg = F.in[I_BRG] + layer * 4; const float* bre = F.in[I_BRE] + layer * 32;
    for (int tile = tile0; tile < tile1; tile += tstep) {
        __syncthreads();
        if (F.tid < 128) { const int t = tile * 128 + F.tid; const float* lg = (const float*)(F.ws + WS_LOGITS) + (size_t)t * 64;
            float g[4]; int gs = 0; float gm;
#pragma unroll
            for (int j = 0; j < 4; ++j) g[j] = lg[j] + brg[j];
            gm = g[0];
#pragma unroll
            for (int j = 1; j < 4; ++j) if (g[j] > gm) { gm = g[j]; gs = j; }
            float se = 0.f;
#pragma unroll
            for (int j = 0; j < 4; ++j) se += __expf(g[j] - gm);
            const float pg = 1.0f / se;
            float le[8];
#pragma unroll
            for (int j = 0; j < 8; ++j) le[j] = lg[4 + gs * 8 + j] + bre[gs * 8 + j];
            int i0 = 0; float v0 = le[0];
#pragma unroll
            for (int j = 1; j < 8; ++j) if (le[j] > v0) { v0 = le[j]; i0 = j; }
            int i1 = -1; float v1 = -INFINITY;
#pragma unroll
            for (int j = 0; j < 8; ++j) if (j != i0 && le[j] > v1) { v1 = le[j]; i1 = j; }
            const float e1 = __expf(v1 - v0); const float wsc = (ABL == 4) ? 0.f : ((ABL == 6) ? 2.f : 1.f); const float w0 = wsc * pg / (1.0f + e1), w1 = wsc * pg * e1 / (1.0f + e1);
            const int x0 = gs * 8 + i0, x1 = gs * 8 + i1;
            ((int*)(F.ws + WS_ROUTE))[2 * t] = x0; ((int*)(F.ws + WS_ROUTE))[2 * t + 1] = x1;
            ((float*)(F.ws + WS_ROUTE))[2 * T + 2 * t] = w0; ((float*)(F.ws + WS_ROUTE))[2 * T + 2 * t + 1] = w1;
            hist[F.tid] = x0; hist[128 + F.tid] = x1;
        }
        __syncthreads();
        if (F.tid < 64) { const int k = F.tid >> 5, e = F.tid & 31; int cnt = 0; for (int j = 0; j < 128; ++j) cnt += (hist[k * 128 + j] == e) ? 1 : 0; ((int*)(F.ws + WS_TAB + TAB_CNT))[tile * 64 + F.tid] = cnt; }
        __syncthreads();
    }
}
__device__ __forceinline__ void phase_dispatch(const Ctx& F) {
    LAS int* sTot = (LAS int*)F.lds; LAS int* sBef = sTot + 64; LAS int* sPs = sTot + 128; LAS int* sE = sTot + 256; LAS int* sPart = sTot + 512;
    const int* CNT = (const int*)(F.ws + WS_TAB + TAB_CNT); int* META = (int*)(F.ws + WS_TAB + TAB_META);
    int* tokl = (int*)(F.ws + WS_LISTS); float* wl = (float*)(F.ws + WS_LISTS) + 2 * LISTCAP;
    for (int tile = F.bid; tile < 256; tile += F.G) {
        { const int ke = F.tid & 63, grp = F.tid >> 6; int cv[32];
#pragma unroll
            for (int i = 0; i < 32; ++i) cv[i] = CNT[(grp + 8 * i) * 64 + ke];
            int tot = 0, bef = 0;
#pragma unroll
            for (int i = 0; i < 32; ++i) { tot += cv[i]; bef += (grp + 8 * i < tile) ? cv[i] : 0; }
            sPart[grp * 64 + ke] = tot; sPart[512 + grp * 64 + ke] = bef; }
        __syncthreads();
        if (F.tid < 64) { int tot = 0, bef = 0;
#pragma unroll
            for (int gI = 0; gI < 8; ++gI) { tot += sPart[gI * 64 + F.tid]; bef += sPart[512 + gI * 64 + F.tid]; }
            sTot[F.tid] = tot; sBef[F.tid] = bef; }
        __syncthreads();
        if (F.tid < 2) { int ps = 0; for (int e = 0; e < 32; ++e) { sPs[F.tid * 33 + e] = ps; ps += ((sTot[F.tid * 32 + e] + 255) >> 8) << 8; } sPs[F.tid * 33 + 32] = ps;
            if (tile == 0) { META[F.tid] = ps >> 8; for (int e = 0; e <= 32; ++e) META[16 + 64 * F.tid + e] = sPs[F.tid * 33 + e]; } }
        int e0 = 0, e1 = 0; float w0 = 0.f, w1 = 0.f;
        if (F.tid < 128) { const int t = tile * 128 + F.tid; e0 = ((const int*)(F.ws + WS_ROUTE))[2 * t]; e1 = ((const int*)(F.ws + WS_ROUTE))[2 * t + 1];
            w0 = ((const float*)(F.ws + WS_ROUTE))[2 * T + 2 * t]; w1 = ((const float*)(F.ws + WS_ROUTE))[2 * T + 2 * t + 1]; sE[F.tid] = e0; sE[128 + F.tid] = e1; }
        __syncthreads();
        if (F.tid < 128) { int r0 = 0, r1 = 0; for (int j = 0; j < F.tid; ++j) { r0 += (sE[j] == e0) ? 1 : 0; r1 += (sE[128 + j] == e1) ? 1 : 0; }
            const int p0 = sPs[e0] + sBef[e0] + r0, p1 = sPs[33 + e1] + sBef[32 + e1] + r1;
            tokl[p0] = tile * 128 + F.tid; wl[p0] = w0; tokl[LISTCAP + p1] = tile * 128 + F.tid; wl[LISTCAP + p1] = w1; }
        __syncthreads();
    }
}
__device__ __forceinline__ void phase_final(const Ctx& F, const float* SS) {
    const int gw = F.bid * NWAVES + F.wave, NGW = F.G * NWAVES, lane = F.lane;
    const f32x4* g = (const f32x4*)F.in[I_GFIN] + 2 * lane; const f32x4 g00 = g[0], g01 = g[1], g10 = g[128], g11 = g[129];
    for (int m0 = gw; m0 < T; m0 += 4 * NGW) {
        u32x4 xr[4][2]; f32x4 sa[4];
#pragma unroll
        for (int r = 0; r < 4; ++r) { const int m = m0 + r * NGW; const u32x4* xp = (const u32x4*)((const bf16_t*)(F.ws + WS_XB) + (size_t)m * D) + lane; xr[r][0] = xp[0]; xr[r][1] = xp[64];
            sa[r] = *((const f32x4*)(SS + (size_t)m * 16) + (lane & 3)); }
        PIN8(xr[0][0], xr[0][1], xr[1][0], xr[1][1], xr[2][0], xr[2][1], xr[3][0], xr[3][1]); PIN4(sa[0], sa[1], sa[2], sa[3]);
#pragma unroll
        for (int r = 0; r < 4; ++r) { const int m = m0 + r * NGW; float sq = (sa[r].x + sa[r].y) + (sa[r].z + sa[r].w); sq += __shfl_xor(sq, 1); sq += __shfl_xor(sq, 2);
            const float rs = rsqrtf(sq * (1.0f / 1024.0f) + EPS); f32x4* o = (f32x4*)(F.out + (size_t)m * D) + 2 * lane;
            f32x4 x0, x1; unpack8(xr[r][0], x0, x1); o[0] = x0 * rs * g00; o[1] = x1 * rs * g01; unpack8(xr[r][1], x0, x1); o[128] = x0 * rs * g10; o[129] = x1 * rs * g11; }
    }
}
constexpr int PH_PER_LAYER = 15, PH_FINAL = DEPTH * PH_PER_LAYER, N_PHASES = PH_FINAL + 1;
struct Args { const float* in[28]; float* out; unsigned char* ws; int ph_lo, ph_hi; };

__device__ __forceinline__ Ctx mkctx(const Args& args, LAS unsigned char* lds, int wave_s) {
    Ctx F; asm volatile("" : "+s"(wave_s)); int tid = wave_s * 64 + lane_id_(); asm volatile("" : "+v"(tid));
    GAS unsigned char* wsg = (GAS unsigned char*)args.ws; asm volatile("" : "+s"(wsg)); unsigned char* ws = (unsigned char*)wsg;
    GAS float* outg = (GAS float*)args.out; asm volatile("" : "+s"(outg)); float* outp = (float*)outg;
    int bid = blockIdx.x; asm volatile("" : "+s"(bid)); int G = gridDim.x; asm volatile("" : "+s"(G));
    F.in.p = args.in; F.out = outp; F.ws = ws; F.lds = lds;
    F.tid = tid; F.lane = tid & 63; F.wave = wave_s; F.G = G; F.bid = bid;
    return F;
}
#ifndef ONLY_PHASE
#define ONLY_PHASE -1
#endif
#ifndef STAGGER_TICKS
#define STAGGER_TICKS 1300
#endif
__device__ __forceinline__ void run_phase(const Args& args, LAS unsigned char* lds, int ph, int wave_s) {
    const int layer = ph / PH_PER_LAYER, lp = ph - layer * PH_PER_LAYER;
    const size_t ssin = (layer & 1) ? WS_SS1 : WS_SS0, ssmid = (layer & 1) ? WS_SS0 : WS_SS1;
    if (ph == PH_FINAL) { const Ctx F = mkctx(args, lds, wave_s); phase_final(F, (const float*)(F.ws + WS_SS0)); return; }
    if (ONLY_PHASE >= 0 && lp != ONLY_PHASE) return;
    switch (lp) {
    case 0: { const Ctx F = mkctx(args, lds, wave_s); phase_prep(F, layer, (float*)(F.ws + ssin)); } break;
    case 1: { const Ctx F = mkctx(args, lds, wave_s); PhProj P{(const char*)F.ws + WS_XB, (const char*)F.ws + WS_WIN, (const float*)(F.ws + ssin), F.ws, F.G, F.bid}; pg8::gemm_phase(F.lds, P, F.tid); } break;
    case 2: { const Ctx F = mkctx(args, lds, wave_s);
        for (int it = F.bid; it < 768; it += F.G) attn_strip(F, it);
        __syncthreads();
        for (int it = F.bid; it < 1024; it += F.G) mlstm_local_mfma(F, layer, it);
        for (int it = F.bid; it < 1024; it += F.G) conv_item(F, layer, it);
    } break;
    case 3: { const Ctx F = mkctx(args, lds, wave_s); phase_scan(F); attn_combine(F); } break;
    case 4: { const Ctx F = mkctx(args, lds, wave_s); for (int it = F.bid; it < 1024; it += F.G) mlstm_out_mfma(F, layer, it); } break;
    case 5: { const Ctx F = mkctx(args, lds, wave_s); PhGates P{(const char*)F.ws + WS_XB, (const char*)F.ws + WS_WIN, (const float*)(F.ws + ssin), F.ws, F.G, F.bid}; pg8::gemm_phase(F.lds, P, F.tid); } break;
    case 6: { const Ctx F = mkctx(args, lds, wave_s); PhMerge P{F.ws, F.G, F.bid};
        pg8::gemm_phase(F.lds, P, F.tid); } break;
    case 7: { const Ctx F = mkctx(args, lds, wave_s); PhOut P{F.ws, (float*)(F.ws + ssmid), F.G, F.bid}; pg8::gemm_phase(F.lds, P, F.tid); } break;
    case 8: { const Ctx F = mkctx(args, lds, wave_s); PhRouter P{F.ws, (const float*)(F.ws + ssmid), F.G, F.bid}; pg8::gemm_phase(F.lds, P, F.tid);
        { int* tokl = (int*)(F.ws + WS_LISTS); for (int i = F.bid * NTHREADS + F.tid; i < 2 * LISTCAP; i += F.G * NTHREADS) tokl[i] = -1; }
        for (int pm = F.bid; pm < 128; pm += F.G) phase_route(F, layer, 2 * pm, 2 * pm + 2, 1);
        phase_prep_experts(F, layer); } break;
    case 9: break;
    case 10: { const Ctx F = mkctx(args, lds, wave_s); phase_dispatch(F); rs_pass(F, (const float*)(F.ws + ssmid), (float*)(F.ws + WS_TAB + TAB_RSM)); } break;
    case 11: { const Ctx F = mkctx(args, lds, wave_s); PhUp P{F.ws, (const float*)(F.ws + ssmid), (const int*)(F.ws + WS_TAB + TAB_META), (const int*)(F.ws + WS_LISTS), F.G, F.bid}; pg8::gemm_phase(F.lds, P, F.tid); } break;
    case 12: { const Ctx F = mkctx(args, lds, wave_s); PhDown<1> P{F.ws, (float*)(F.ws + ssin), (const int*)(F.ws + WS_TAB + TAB_META), (const int*)(F.ws + WS_LISTS), (const float*)(F.ws + WS_LISTS) + 2 * LISTCAP, F.G, F.bid}; pg8::gemm_phase(F.lds, P, F.tid); } break;
    case 13: { const Ctx F = mkctx(args, lds, wave_s); PhDown<0> P{F.ws, (float*)(F.ws + ssin), (const int*)(F.ws + WS_TAB + TAB_META), (const int*)(F.ws + WS_LISTS), (const float*)(F.ws + WS_LISTS) + 2 * LISTCAP, F.G, F.bid}; pg8::gemm_phase(F.lds, P, F.tid); } break;
    case 14: { const Ctx F = mkctx(args, lds, wave_s); PhPle P{F.ws, (const float*)(F.ws + ssin), (float*)(F.ws + ssmid), F.G, F.bid}; pg8::gemm_phase(F.lds, P, F.tid); } break;
    }
}

__global__ void __launch_bounds__(NTHREADS, 2) fwd_kernel(Args args) {
    extern __shared__ __attribute__((aligned(16))) unsigned char lds_raw[];
    LAS unsigned char* lds = (LAS unsigned char*)lds_raw;
    volatile LAS unsigned* MISC = (volatile LAS unsigned*)(lds + MISC_OFF);
    const int wave_s = __builtin_amdgcn_readfirstlane((int)threadIdx.x >> 6);
    if (wave_s == 0) MISC[lane_id_()] = 0u;
    __syncthreads();
#if MK_MEGA
    XcdBarrier bar = xcd_barrier_post((unsigned*)(args.ws + WS_CTL) + 4096, MISC + 8, wave_s);
#endif
#ifndef PROBE_SEL
#define PROBE_SEL 0
#endif
    unsigned long long extra = 0ull;
    for (int ph = args.ph_lo; ph < args.ph_hi; ++ph) {
        if (ph < PH_FINAL && (ph % PH_PER_LAYER) == 9) continue;
        const unsigned long long t0 = PROBE_SEL ? __builtin_amdgcn_s_memrealtime() : 0ull;
        run_phase(args, lds, ph, wave_s);
#if MK_MEGA
        if (ph + 1 < args.ph_hi) xcd_barrier(bar);
#endif
        if (PROBE_SEL) { const int lp = ph % PH_PER_LAYER; if (ph < PH_FINAL && ((PROBE_SEL >> lp) & 1)) extra += __builtin_amdgcn_s_memrealtime() - t0; }
    }
    if (PROBE_SEL && blockIdx.x == 0) { const unsigned long long te = __builtin_amdgcn_s_memrealtime(); while (__builtin_amdgcn_s_memrealtime() - te < extra) __builtin_amdgcn_s_sleep(8); }
}

extern "C" void kernel_launch(void* const* d_in, const int* in_sizes, int n_in, void* d_out, int out_size, void* d_ws, size_t ws_size, hipStream_t stream) {
    static int grid = 0;
    if (grid == 0) {
        if (n_in != 28 || out_size != T * D || ws_size < WS_END) { fprintf(stderr, "kernel_launch: unexpected shapes (n_in %d out %d ws %zu, need %zu)\n", n_in, out_size, ws_size, (size_t)WS_END); grid = -1; return; }
        int dev = 0, cus = 0, per_cu = 0;
        if (hipGetDevice(&dev) != hipSuccess || hipDeviceGetAttribute(&cus, hipDeviceAttributeMultiprocessorCount, dev) != hipSuccess) { grid = -1; return; }
        if (hipFuncSetAttribute((const void*)fwd_kernel, hipFuncAttributeMaxDynamicSharedMemorySize, LDS_BYTES) != hipSuccess) { fprintf(stderr, "kernel_launch: hipFuncSetAttribute failed\n"); grid = -1; return; }
        if (hipOccupancyMaxActiveBlocksPerMultiprocessor(&per_cu, (const void*)fwd_kernel, NTHREADS, LDS_BYTES) != hipSuccess || per_cu < 1) { fprintf(stderr, "kernel_launch: occupancy query says %d blocks per CU\n", per_cu); }
        (void)hipGetLastError();
        grid = cus;
    }
    if (grid < 0) return;
    Args a{};
    for (int i = 0; i < 28; ++i) a.in[i] = (const float*)d_in[i];
    a.out = (float*)d_out; a.ws = (unsigned char*)d_ws;
#if MK_MEGA
    (void)hipMemsetAsync((char*)d_ws + WS_CTL, 0, CTL_ZERO_BYTES, stream);
    a.ph_lo = 0; a.ph_hi = N_PHASES;
    hipLaunchKernelGGL(fwd_kernel, dim3(grid), dim3(NTHREADS), LDS_BYTES, stream, a);
#else
    for (int ph = 0; ph < N_PHASES; ++ph) { a.ph_lo = ph; a.ph_hi = ph + 1; hipLaunchKernelGGL(fwd_kernel, dim3(grid), dim3(NTHREADS), LDS_BYTES, stream, a); }
#endif
}
```

```cpp
#include <hip/hip_runtime.h>
#include <cstdio>
#include <cstdint>

#ifndef MK_MEGA
#define MK_MEGA 1
#endif

#ifndef ABL
#define ABL 0
#endif
#define LAS __attribute__((address_space(3)))
#define GAS __attribute__((address_space(1)))
typedef unsigned short bf16_t;
typedef short bf16x8 __attribute__((ext_vector_type(8)));
typedef float f32x4 __attribute__((ext_vector_type(4)));
typedef float f32x2 __attribute__((ext_vector_type(2)));
typedef unsigned u32x4 __attribute__((ext_vector_type(4)));
typedef unsigned u32x2 __attribute__((ext_vector_type(2)));

constexpr int T = 32768, SEQ = 16384, D = 1024, DEPTH = 2;
constexpr int D_IN = 8712;
constexpr float EPS = 1e-6f;
constexpr int NTHREADS = 512, NWAVES = 8;
constexpr int LISTCAP = 40960;

constexpr size_t MiB = 1u << 20;
constexpr size_t WS_CTL = 0, CTL_ZERO_BYTES = 32768;
constexpr size_t WS_TAB = 1 * MiB;
constexpr size_t WS_ROUTE = 2 * MiB;
constexpr size_t WS_LISTS = 3 * MiB;
constexpr size_t WS_SS0 = 4 * MiB, WS_SS1 = 6 * MiB;
constexpr size_t WS_IF = 8 * MiB;
constexpr size_t WS_NST = 9 * MiB;
constexpr size_t WS_LOGITS = 10 * MiB;
constexpr size_t WS_WIN = 18 * MiB;
constexpr size_t WS_WBR = WS_WIN + 8960ull * 1024 * 2;
constexpr size_t WS_WOUT = WS_WBR + 3ull * 1024 * 512 * 2;
constexpr size_t WS_WPG = WS_WOUT + 1024ull * 1024 * 2;
constexpr size_t WS_WPP = WS_WPG + 1024ull * 1024 * 2;
constexpr size_t WS_WR = WS_WPP + 1024ull * 256 * 2;
static_assert(WS_WR + 256ull * 1024 * 2 <= 44 * MiB, "small weights");
constexpr size_t WS_XB = 44 * MiB;
constexpr size_t WS_QA0 = 108 * MiB;
constexpr size_t WS_YATT = WS_QA0;
constexpr size_t WS_OM = 140 * MiB;
constexpr size_t WS_YC = 172 * MiB;
constexpr size_t WS_CST = 204 * MiB;
constexpr size_t WS_B = 236 * MiB;
constexpr size_t WS_KA = WS_B, WS_QA1 = WS_B + 32 * MiB, WS_QA2 = WS_B + 64 * MiB, WS_VA = WS_B + 96 * MiB, WS_YG = WS_B + 128 * MiB, WS_QM = WS_B + 160 * MiB, WS_KM = WS_B + 192 * MiB, WS_VM = WS_B + 224 * MiB;
constexpr size_t WS_G0 = WS_B, WS_MERGED = WS_B + 192 * MiB;
constexpr size_t WS_WEXP = WS_B, WS_HB = WS_B + 48 * MiB, WS_PBF = WS_B + 88 * MiB, WS_PE = WS_B + 104 * MiB, WS_YB1 = WS_B + 168 * MiB;
constexpr size_t WS_XBT = WS_QA0;
constexpr size_t WS_END = 492 * MiB;
constexpr size_t TAB_CNT = 0;
constexpr size_t TAB_META = 65536;
constexpr size_t TAB_RSA = 262144, TAB_RSM = 524288;
constexpr size_t TAB_MLOC = 131072, TAB_GTOT = 131072 + 4096, TAB_MST = 131072 + 8192;

constexpr int RING_BYTES = 131072;
constexpr int MISC_OFF = 155648;
constexpr int LDS_BYTES = 156672;

__device__ __forceinline__ unsigned f2bf(float f) { unsigned u = __builtin_bit_cast(unsigned, f); return (u + 0x7fffu + ((u >> 16) & 1u)) >> 16; }
__device__ __forceinline__ unsigned pk2(float lo, float hi) { return f2bf(lo) | (f2bf(hi) << 16); }
__device__ __forceinline__ unsigned cvt_pk_bf16(float lo, float hi) { unsigned r; asm volatile("v_cvt_pk_bf16_f32 %0, %1, %2" : "=v"(r) : "v"(lo), "v"(hi)); return r; }
__device__ __forceinline__ float bf_lo(unsigned w) { return __builtin_bit_cast(float, w << 16); }
__device__ __forceinline__ float bf_hi(unsigned w) { return __builtin_bit_cast(float, w & 0xffff0000u); }
__device__ __forceinline__ float bf1(bf16_t h) { return __builtin_bit_cast(float, ((unsigned)h) << 16); }
__device__ __forceinline__ float sigmoidf_(float v) { return __builtin_amdgcn_rcpf(1.0f + __expf(-v)); }
__device__ __forceinline__ float siluf_(float v) { return v * __builtin_amdgcn_rcpf(1.0f + __expf(-v)); }
__device__ __forceinline__ float wave_sum(float v) {
#pragma unroll
    for (int o = 1; o < 64; o <<= 1) v += __shfl_xor(v, o);
    return v;
}
__device__ __forceinline__ float wave_max(float v) {
#pragma unroll
    for (int o = 1; o < 64; o <<= 1) v = fmaxf(v, __shfl_xor(v, o));
    return v;
}
__device__ __forceinline__ int lane_id_() { int l; asm volatile("v_mbcnt_lo_u32_b32 %0, -1, 0\n\tv_mbcnt_hi_u32_b32 %0, -1, %0" : "=&v"(l)); return l; }
#define LDS_WAIT() asm volatile("s_waitcnt lgkmcnt(0)" ::: "memory")
#define VM_WAIT() asm volatile("s_waitcnt vmcnt(0)" ::: "memory")

#define XB_TMO      128
#define XB_XCNT(j)  (256  + 64 * (j))
#define XB_XSUB(j)  (1280 + 64 * (j))
#define XB_XGEN(j)  (2304 + 64 * (j))
#define XB_TOP      3328
#define XB_TOPGEN   3392
#define XCD_BAR_WORDS 3456
#define XB_SPIN_CAP (1u << 22)
__device__ __forceinline__ unsigned xb_ld(unsigned* p)              { return __hip_atomic_load(p, __ATOMIC_RELAXED, __HIP_MEMORY_SCOPE_AGENT); }
__device__ __forceinline__ unsigned xb_add(unsigned* p, unsigned v) { return __hip_atomic_fetch_add(p, v, __ATOMIC_RELAXED, __HIP_MEMORY_SCOPE_AGENT); }
__device__ __forceinline__ unsigned xb_xcc_id() { return (unsigned)__builtin_amdgcn_s_getreg((3 << 11) | 20) & 0xFu; }
__device__ __forceinline__ void st_wt(int* p, int v)     { __hip_atomic_store(p, v, __ATOMIC_RELAXED, __HIP_MEMORY_SCOPE_AGENT); }
__device__ __forceinline__ void st_wt(float* p, float v) { __hip_atomic_store(p, v, __ATOMIC_RELAXED, __HIP_MEMORY_SCOPE_AGENT); }
__device__ __forceinline__ int ld_wt(const int* p)       { return __hip_atomic_load(p, __ATOMIC_RELAXED, __HIP_MEMORY_SCOPE_AGENT); }
__device__ __forceinline__ float ld_wt(const float* p)   { return __hip_atomic_load(p, __ATOMIC_RELAXED, __HIP_MEMORY_SCOPE_AGENT); }
#define XB_SPIN(cond, bar) do { unsigned _sp = 0; while (cond) { __builtin_amdgcn_s_sleep(1); \
    if ((++_sp & 255u) == 0u) { if (xb_ld(&(bar)[XB_TMO])) break; if (_sp > XB_SPIN_CAP) { atomicAdd(&(bar)[XB_TMO], 1u); break; } } } } while (0)
struct XcdBarrier { unsigned* bar; unsigned x; volatile LAS unsigned* st; int wave; };
__device__ __forceinline__ XcdBarrier xcd_barrier_post(unsigned* bar, volatile LAS unsigned* st, int wave) {
    XcdBarrier b; b.bar = bar; b.x = xb_xcc_id(); b.st = st; b.wave = wave;
    if (wave == 0 && lane_id_() == 0) (void)xb_add(&bar[XB_XCNT(b.x)], 1u);
    return b;
}
__device__ __forceinline__ void xcd_barrier_complete(unsigned* bar, unsigned x, unsigned& nloc, unsigned& nx, unsigned& xmask) {
    const unsigned G = gridDim.x * gridDim.y * gridDim.z;
    unsigned sum, cnt, mine, msk, sp = 0u;
    for (;;) {
        sum = 0u; cnt = 0u; mine = 0u; msk = 0u;
#pragma unroll
        for (unsigned j = 0; j < 16; ++j) { const unsigned c = xb_ld(&bar[XB_XCNT(j)]); sum += c; cnt += (c > 0u) ? 1u : 0u; msk |= (c > 0u) ? (1u << j) : 0u; mine = (j == x) ? c : mine; }
        if (sum == G) break;
        __builtin_amdgcn_s_sleep(1);
        if ((++sp & 255u) == 0u) { if (xb_ld(&bar[XB_TMO])) break; if (sp > XB_SPIN_CAP) { atomicAdd(&bar[XB_TMO], 1u); break; } }
    }
    nloc = mine > 0u ? mine : 1u; nx = cnt > 0u ? cnt : 1u; xmask = msk;
}
__device__ __forceinline__ void xcd_barrier(const XcdBarrier& b) {
    asm volatile("s_waitcnt vmcnt(0)" ::: "memory");
    __syncthreads();
    if (b.wave == 0 && lane_id_() == 0) {
        unsigned* bar = b.bar;
        __builtin_amdgcn_s_waitcnt(0);
        unsigned nloc = b.st[0], nx = b.st[1], xmask = b.st[2];
        if (nloc == 0u) { xcd_barrier_complete(bar, b.x, nloc, nx, xmask); b.st[0] = nloc; b.st[1] = nx; b.st[2] = xmask; }
        asm volatile("buffer_inv sc1" ::: "memory");
        const unsigned old = xb_add(&bar[XB_XSUB(b.x)], 1u);
        const unsigned gen = old / nloc;
        if (old == gen * nloc && nloc > 1u) asm volatile("buffer_wbl2 sc1" ::: "memory");
        if (old + 1u == (gen + 1u) * nloc) {
            __builtin_amdgcn_fence(__ATOMIC_RELEASE, "agent");
            asm volatile("s_waitcnt vmcnt(0)" ::: "memory");
            const unsigned og = xb_add(&bar[XB_TOP], 1u);
            const unsigned tg = og / nx;
            if (og + 1u == (tg + 1u) * nx) {
#pragma unroll 1
                for (unsigned m = xmask; m != 0u; m &= m - 1u) xb_add(&bar[XB_XGEN((unsigned)__builtin_ctz(m))], 1u);
            } else XB_SPIN(xb_ld(&bar[XB_XGEN(b.x)]) == gen, bar);
            asm volatile("s_waitcnt vmcnt(0)" ::: "memory");
        } else {
            XB_SPIN(xb_ld(&bar[XB_XGEN(b.x)]) == gen, bar);
            asm volatile("s_waitcnt vmcnt(0)" ::: "memory");
        }
    }
    __syncthreads();
}

namespace pg8 {
constexpr int BM = 256, BK = 64, HALF = 128, HTB = HALF * BK * 2, NXCD = 8, WGM = 8;
__device__ __forceinline__ int lds_byte(int r, int c) { const int st = (r >> 4) * 2 + (c >> 5), rr = r & 15, cc = c & 31, ob = rr * 64 + cc * 2; return st * 1024 + (ob ^ (((ob >> 9) & 1) << 5)); }
__device__ __forceinline__ void stage_rc(int b, int& R, int& C) { const int st = b / 1024, sb = b % 1024, swz = sb ^ (((sb >> 9) & 1) << 5); R = (st >> 1) * 16 + swz / 64; C = (st & 1) * 32 + (swz % 64) / 2; }
__device__ __forceinline__ int perm32(int rho) { const int n = rho >> 4, i = rho & 15; return 8 * (i >> 2) + 4 * n + (i & 3); }

struct GUnit { const char* A; const char* B; int pm, pn, a0, a1; };

__device__ __forceinline__ void tile_order(int L, int nM, int nN, int& pm, int& pn) {
    const int nwg = nM * nN; int wgid = L;
    { const int q = nwg / NXCD, r = nwg % NXCD, xcd = wgid % NXCD, off = wgid / NXCD; wgid = (xcd < r ? xcd * (q + 1) : r * (q + 1) + (xcd - r) * q) + off; }
    const int nig = WGM * nN, gid = wgid / nig, fm = gid * WGM, gsz = (nM - fm) < WGM ? (nM - fm) : WGM;
    pm = fm + ((wgid % nig) % gsz); pn = (wgid % nig) / gsz;
}

typedef f32x4 Acc[2][2][4][2];

template <class P>
__device__ __forceinline__ void gemm_phase(LAS unsigned char* lds, const P& S, int tid) {
    asm volatile("" : "+v"(tid));
    const int wid = __builtin_amdgcn_readfirstlane(tid >> 6), lane = tid & 63, wr = wid >> 2, wc = wid & 3, fr = lane & 15, fq = lane >> 4;
    constexpr int K = P::K, nt = K / BK;
    static_assert(nt >= 4 && (nt % 2) == 0, "K multiple of 128, >= 256");
    unsigned voffB[2];
#pragma unroll
    for (int i = 0; i < 2; ++i) { int R, C; stage_rc(tid * 16 + i * 8192, R, C); const int Rb = (R & ~31) + perm32(R & 31); voffB[i] = (unsigned)(Rb * K + C) * 2u; }
    constexpr size_t kstep = (size_t)(BK * 2);
    constexpr size_t hstepB = (size_t)HALF * K * 2;
    const unsigned ldsw = (unsigned)wid * 1024u;
    const int aoff = lds_byte(wr * 64 + fr, fq * 8), boff = lds_byte(wc * 32 + fr, fq * 8);
#define PG8_SA(b, h) (((b) * 2 + (h)) * HTB)
#define PG8_SB(b, h) ((4 + (b) * 2 + (h)) * HTB)
#define PG8_STAGE(bufoff, gbase, voff) do { _Pragma("unroll") for (int _i = 0; _i < 2; ++_i) \
        __builtin_amdgcn_global_load_lds((const unsigned*)((const char*)(gbase) + (voff)[_i]), (LAS unsigned*)(lds + (bufoff) + ldsw + _i * 8192), 16, 0, 0); } while (0)
#define PG8_LDA(dst, b, h) do { _Pragma("unroll") for (int m = 0; m < 4; ++m) _Pragma("unroll") for (int k = 0; k < 2; ++k) dst[m][k] = *(const LAS bf16x8*)(lds + PG8_SA(b, h) + aoff + m * 2048 + k * 1024); } while (0)
#define PG8_LDB(dst, b, h) do { _Pragma("unroll") for (int n = 0; n < 2; ++n) _Pragma("unroll") for (int k = 0; k < 2; ++k) dst[n][k] = *(const LAS bf16x8*)(lds + PG8_SB(b, h) + boff + n * 2048 + k * 1024); } while (0)
#define PG8_MMA(ai, bj, At, Bt) do { __builtin_amdgcn_s_setprio(1); _Pragma("unroll") for (int m = 0; m < 4; ++m) _Pragma("unroll") for (int n = 0; n < 2; ++n) _Pragma("unroll") for (int k = 0; k < 2; ++k) \
        acc[ai][bj][m][n] = __builtin_amdgcn_mfma_f32_16x16x32_bf16(Bt[n][k], At[m][k], acc[ai][bj][m][n], 0, 0, 0); __builtin_amdgcn_s_setprio(0); } while (0)
#define PG8_WAIT_V(n) asm volatile("s_waitcnt vmcnt(" #n ")" ::: "memory")
#define PG8_WAIT_L(n) asm volatile("s_waitcnt lgkmcnt(" #n ")" ::: "memory")
#define PG8_BAR __builtin_amdgcn_s_barrier()
#define PG8_SCHED __builtin_amdgcn_sched_barrier(0)
#define PG8_VOA(dst, u) do { _Pragma("unroll") for (int _h = 0; _h < 2; ++_h) _Pragma("unroll") for (int _i = 0; _i < 2; ++_i) { int _R, _C; stage_rc(tid * 16 + _i * 8192, _R, _C); \
        if constexpr (P::GATHER) dst[_h][_i] = (S.arow(u, _h * HALF + _R) * (unsigned)K + (unsigned)_C) * 2u; \
        else dst[_h][_i] = (unsigned)((_h * HALF + _R) * K + _C) * 2u; } } while (0)
    GUnit cur, nxt; int ui = 0;
    if (!S.next(0, cur)) return;
    float pre8[8];
    S.pre(cur, wr, fr, pre8);
    Acc acc;
#pragma unroll
    for (int a = 0; a < 2; ++a)
#pragma unroll
        for (int b = 0; b < 2; ++b)
#pragma unroll
            for (int m = 0; m < 4; ++m)
#pragma unroll
                for (int n = 0; n < 2; ++n) acc[a][b][m][n] = (f32x4){0.f, 0.f, 0.f, 0.f};
    bf16x8 At[4][2], B0[2][2], B1[2][2];
    unsigned voA[2][2], voAn[2][2];
    PG8_VOA(voA, cur);
    const char* cA = cur.A; const char* cB = cur.B;
    PG8_STAGE(PG8_SB(0, 0), cB, voffB); PG8_STAGE(PG8_SB(0, 1), cB + hstepB, voffB); PG8_STAGE(PG8_SA(0, 0), cA, voA[0]); PG8_STAGE(PG8_SA(0, 1), cA, voA[1]);
    if (wr == 1) PG8_BAR;
    PG8_WAIT_V(2); PG8_BAR;
    PG8_STAGE(PG8_SB(1, 0), cB + kstep, voffB); PG8_STAGE(PG8_SA(1, 0), cA + kstep, voA[0]); PG8_STAGE(PG8_SB(1, 1), cB + hstepB + kstep, voffB);
    PG8_WAIT_V(6); PG8_BAR;
    for (;;) {
        const bool has_next = S.next(ui + 1, nxt);
        const char* nA = has_next ? nxt.A : cA; const char* nB = has_next ? nxt.B : cB;
        if constexpr (P::GATHER) {
            if (has_next) { PG8_VOA(voAn, nxt); }
            else {
#pragma unroll
                for (int h = 0; h < 2; ++h)
#pragma unroll
                    for (int i = 0; i < 2; ++i) voAn[h][i] = voA[h][i];
            }
        }
#pragma unroll 1
        for (int t = 0; t < nt; t += 2) {
            const bool last = (t == nt - 2);
            const char* a1 = cA + (size_t)(t + 1) * kstep;
            const char* a2 = last ? nA : cA + (size_t)(t + 2) * kstep; const char* b2 = last ? nB : cB + (size_t)(t + 2) * kstep;
            const char* a3 = a2 + kstep; const char* b3 = b2 + kstep;
            unsigned s0[2], s1[2];
#pragma unroll
            for (int i = 0; i < 2; ++i) {
                if constexpr (P::GATHER) { s0[i] = last ? voAn[0][i] : voA[0][i]; s1[i] = last ? voAn[1][i] : voA[1][i]; }
                else { s0[i] = voA[0][i]; s1[i] = voA[1][i]; }
            }
            PG8_LDB(B0, 0, 0); PG8_LDB(B1, 0, 1); PG8_SCHED; PG8_LDA(At, 0, 0); PG8_STAGE(PG8_SA(1, 1), a1, voA[1]);
            PG8_WAIT_V(8); PG8_WAIT_L(0); PG8_BAR; PG8_MMA(0, 0, At, B0); PG8_MMA(0, 1, At, B1); PG8_BAR; PG8_SCHED;
            PG8_LDA(At, 0, 1); PG8_STAGE(PG8_SB(0, 0), b2, voffB); PG8_STAGE(PG8_SB(0, 1), b2 + hstepB, voffB); PG8_STAGE(PG8_SA(0, 0), a2, s0);
            PG8_WAIT_V(8); PG8_WAIT_L(0); PG8_BAR; PG8_MMA(1, 0, At, B0); PG8_MMA(1, 1, At, B1); PG8_BAR; PG8_SCHED;
            PG8_LDB(B0, 1, 0); PG8_LDB(B1, 1, 1); PG8_SCHED; PG8_LDA(At, 1, 0); PG8_STAGE(PG8_SA(0, 1), a2, s1);
            PG8_WAIT_V(8); PG8_WAIT_L(0); PG8_BAR; PG8_MMA(0, 0, At, B0); PG8_MMA(0, 1, At, B1); PG8_BAR; PG8_SCHED;
            PG8_LDA(At, 1, 1); PG8_STAGE(PG8_SB(1, 0), b3, voffB); PG8_STAGE(PG8_SB(1, 1), b3 + hstepB, voffB); PG8_STAGE(PG8_SA(1, 0), a3, s0);
            PG8_WAIT_V(8); PG8_WAIT_L(0); PG8_BAR; PG8_MMA(1, 0, At, B0); PG8_MMA(1, 1, At, B1); PG8_BAR; PG8_SCHED;
        }
        if (wr == 0) PG8_BAR;
        const bool zero = S.epi(acc, cur, wr, wc, fr, fq, pre8);
        if (!has_next) break;
        S.pre(nxt, wr, fr, pre8);
        if (zero) {
#pragma unroll
            for (int a = 0; a < 2; ++a)
#pragma unroll
                for (int b = 0; b < 2; ++b)
#pragma unroll
                    for (int m = 0; m < 4; ++m)
#pragma unroll
                        for (int n = 0; n < 2; ++n) acc[a][b][m][n] = (f32x4){0.f, 0.f, 0.f, 0.f};
        }
        cur = nxt; cA = nA; cB = nB; ++ui;
        if constexpr (P::GATHER) {
#pragma unroll
            for (int h = 0; h < 2; ++h)
#pragma unroll
                for (int i = 0; i < 2; ++i) voA[h][i] = voAn[h][i];
        }
        if (wr == 1) PG8_BAR;
    }
    PG8_WAIT_V(0);
    PG8_BAR;
#undef PG8_SA
#undef PG8_SB
#undef PG8_STAGE
#undef PG8_LDA
#undef PG8_LDB
#undef PG8_MMA
#undef PG8_WAIT_V
#undef PG8_WAIT_L
#undef PG8_BAR
#undef PG8_SCHED
#undef PG8_VOA
}
}
using pg8::GUnit; using pg8::Acc;

__device__ __forceinline__ float row_rs(const float* SS, int row) {
    const f32x4* p = (const f32x4*)(SS + (size_t)row * 16);
    const f32x4 a = p[0], b = p[1], c = p[2], d = p[3];
    const float s = (((a.x + a.y) + (a.z + a.w)) + ((b.x + b.y) + (b.z + b.w))) + (((c.x + c.y) + (c.z + c.w)) + ((d.x + d.y) + (d.z + d.w)));
    return rsqrtf(s * (1.0f / 1024.0f) + EPS);
}
#define PIN1(a) asm volatile("" : "+v"(a))
#define PIN2(a, b) asm volatile("" : "+v"(a), "+v"(b))
#define PIN4(a, b, c, d) asm volatile("" : "+v"(a), "+v"(b), "+v"(c), "+v"(d))
#define PIN8(a, b, c, d, e, f, g, h) asm volatile("" : "+v"(a), "+v"(b), "+v"(c), "+v"(d), "+v"(e), "+v"(f), "+v"(g), "+v"(h))
__device__ __forceinline__ void row_rs8(const float* SS, int row0, float (&rs)[8]) {
#pragma unroll
    for (int hh = 0; hh < 4; ++hh) { f32x4 a[2], b[2], c[2], d[2];
#pragma unroll
        for (int g = 0; g < 2; ++g) { const f32x4* p = (const f32x4*)(SS + (size_t)(row0 + (hh >> 1) * 128 + ((hh & 1) * 2 + g) * 16) * 16); a[g] = p[0]; b[g] = p[1]; c[g] = p[2]; d[g] = p[3]; }
#pragma unroll
        for (int g = 0; g < 2; ++g) { const f32x4 t = (a[g] + b[g]) + (c[g] + d[g]); rs[hh * 2 + g] = rsqrtf(((t.x + t.y) + (t.z + t.w)) * (1.0f / 1024.0f) + EPS); }
        PIN2(rs[hh * 2], rs[hh * 2 + 1]); }
}
__device__ __forceinline__ void row_rs8_all(const float* SS, int row0, float (&rs)[8]) {
    f32x4 v[8][4];
#pragma unroll
    for (int g = 0; g < 8; ++g) { const f32x4* p = (const f32x4*)(SS + (size_t)(row0 + (g >> 2) * 128 + (g & 3) * 16) * 16); v[g][0] = p[0]; v[g][1] = p[1]; v[g][2] = p[2]; v[g][3] = p[3]; }
#pragma unroll
    for (int g = 0; g < 8; g += 2) PIN8(v[g][0], v[g][1], v[g][2], v[g][3], v[g + 1][0], v[g + 1][1], v[g + 1][2], v[g + 1][3]);
#pragma unroll
    for (int g = 0; g < 8; ++g) { const f32x4 t = (v[g][0] + v[g][1]) + (v[g][2] + v[g][3]); rs[g] = rsqrtf(((t.x + t.y) + (t.z + t.w)) * (1.0f / 1024.0f) + EPS); }
}
__device__ __forceinline__ void st16_wt(void* p, const u32x4 v) { asm volatile("global_store_dwordx4 %0, %1, off sc1\n\ts_nop 1" :: "v"(p), "v"(v) : "memory"); }
__device__ __forceinline__ u32x4 pack8(const f32x4 v0, const f32x4 v1) { u32x4 w; w.x = cvt_pk_bf16(v0[0], v0[1]); w.y = cvt_pk_bf16(v0[2], v0[3]); w.z = cvt_pk_bf16(v1[0], v1[1]); w.w = cvt_pk_bf16(v1[2], v1[3]); return w; }
__device__ __forceinline__ void unpack8(const u32x4 w, f32x4& v0, f32x4& v1) { v0 = (f32x4){bf_lo(w.x), bf_hi(w.x), bf_lo(w.y), bf_hi(w.y)}; v1 = (f32x4){bf_lo(w.z), bf_hi(w.z), bf_lo(w.w), bf_hi(w.w)}; }
__device__ __forceinline__ f32x4 sig4(const f32x4 v) { return (f32x4){sigmoidf_(v[0]), sigmoidf_(v[1]), sigmoidf_(v[2]), sigmoidf_(v[3])}; }
__device__ __forceinline__ f32x4 gate4(const f32x4 v) { f32x4 s = sig4(v); return (f32x4){fmaxf(s[0], 1e-6f), fmaxf(s[1], 1e-6f), fmaxf(s[2], 1e-6f), fmaxf(s[3], 1e-6f)}; }

struct PhProj {
    static constexpr int K = 1024; static constexpr bool GATHER = false;
    const char* xb; const char* W; const float* SS; unsigned char* ws; int G, c;
    __device__ __forceinline__ bool next(int i, GUnit& u) const {
        const long L = (long)i * G + c; if (L >= 128 * 22) return false;
        pg8::tile_order((int)L, 128, 22, u.pm, u.pn);
        u.A = xb + (size_t)u.pm * 256 * K * 2; u.B = W + (size_t)u.pn * 256 * K * 2; u.a0 = 0; u.a1 = 0; return true;
    }
    __device__ __forceinline__ unsigned arow(const GUnit&, int) const { return 0u; }
    __device__ __forceinline__ void pre(const GUnit& u, int wr, int fr, float (&rs)[8]) const { const float* R = (const float*)(ws + WS_TAB + TAB_RSA) + u.pm * 256 + wr * 64 + fr;
#pragma unroll
        for (int g = 0; g < 8; ++g) rs[g] = R[(g >> 2) * 128 + (g & 3) * 16]; }
    __device__ __forceinline__ bool epi(Acc& acc, const GUnit& u, int wr, int wc, int fr, int fq, const float (&rs8)[8]) const {
        const int pn = u.pn; const int row0 = u.pm * 256 + wr * 64 + fr;
        if (pn == 22) {
            if (wc == 0 && fq == 0) {
                float* IFp = (float*)(ws + WS_IF);
#pragma unroll
                for (int ai = 0; ai < 2; ++ai)
#pragma unroll
                    for (int m = 0; m < 4; ++m) { const int row = row0 + ai * 128 + m * 16; const float rs = rs8[ai * 4 + m];
                        *(f32x4*)(IFp + (size_t)row * 8) = acc[ai][0][m][0] * rs; *(f32x4*)(IFp + (size_t)row * 8 + 4) = acc[ai][0][m][1] * rs; }
            }
            return true;
        }
        if (pn >= 10 && pn < 14) {
            bf16_t* Y = (bf16_t*)(ws + WS_YG);
#pragma unroll
            for (int ai = 0; ai < 2; ++ai)
#pragma unroll
                for (int m = 0; m < 4; ++m) { const int row = row0 + ai * 128 + m * 16; const float rs = rs8[ai * 4 + m];
                    *(u32x4*)(Y + (size_t)row * 512 + (pn - 10) * 128 + wc * 32 + fq * 8) = pack8((acc[ai][0][m][0] * rs) * sig4(acc[ai][1][m][0] * rs), (acc[ai][0][m][1] * rs) * sig4(acc[ai][1][m][1] * rs)); }
            return true;
        }
        bf16_t* dst; int col0; bool sg = false;
        if (pn < 6) { dst = (bf16_t*)(ws + (pn < 2 ? WS_QA0 : (pn < 4 ? WS_QA1 : WS_QA2))); col0 = (pn & 1) * 256; }
        else if (pn < 8) { dst = (bf16_t*)(ws + WS_KA); col0 = (pn - 6) * 256; }
        else if (pn < 10) { dst = (bf16_t*)(ws + WS_VA); col0 = (pn - 8) * 256; }
        else if (pn < 16) { dst = (bf16_t*)(ws + WS_QM); col0 = (pn - 14) * 256; }
        else if (pn < 18) { dst = (bf16_t*)(ws + WS_KM); col0 = (pn - 16) * 256; }
        else if (pn < 20) { dst = (bf16_t*)(ws + WS_VM); col0 = (pn - 18) * 256; }
        else { dst = (bf16_t*)(ws + WS_OM); col0 = (pn - 20) * 256; sg = true; }
        col0 += wc * 32 + fq * 8;
#pragma unroll
        for (int ai = 0; ai < 2; ++ai)
#pragma unroll
            for (int m = 0; m < 4; ++m) { const int row = row0 + ai * 128 + m * 16; const float rs = rs8[ai * 4 + m];
#pragma unroll
                for (int bj = 0; bj < 2; ++bj) { f32x4 v0 = acc[ai][bj][m][0] * rs, v1 = acc[ai][bj][m][1] * rs;
                    if (sg) { v0 = sig4(v0); v1 = sig4(v1); }
                    *(u32x4*)(dst + (size_t)row * 512 + col0 + bj * 128) = pack8(v0, v1); } }
        return true;
    }
};
struct PhGates {
    static constexpr int K = 1024; static constexpr bool GATHER = false;
    const char* xb; const char* W; const float* SS; unsigned char* ws; int G, c;
    __device__ __forceinline__ bool next(int i, GUnit& u) const {
        const long L = (long)i * G + c; if (L >= 128 * 12) return false;
        pg8::tile_order((int)L, 128, 12, u.pm, u.pn);
        u.A = xb + (size_t)u.pm * 256 * K * 2; u.B = W + (size_t)(5888 + u.pn * 256) * K * 2; u.a0 = 0; u.a1 = 0; return true;
    }
    __device__ __forceinline__ unsigned arow(const GUnit&, int) const { return 0u; }
    __device__ __forceinline__ void pre(const GUnit& u, int wr, int fr, float (&rs)[8]) const { const float* R = (const float*)(ws + WS_TAB + TAB_RSA) + u.pm * 256 + wr * 64 + fr;
#pragma unroll
        for (int g = 0; g < 8; ++g) rs[g] = R[(g >> 2) * 128 + (g & 3) * 16]; }
    __device__ __forceinline__ bool epi(Acc& acc, const GUnit& u, int wr, int wc, int fr, int fq, const float (&rs8)[8]) const {
        const int row0 = u.pm * 256 + wr * 64 + fr;
        bf16_t* dst = (bf16_t*)(ws + WS_G0 + (size_t)(u.pn >> 2) * 64 * MiB) + (size_t)(u.pm * 4 + (u.pn & 3)) * 65536 + (((wr * 4 + wc) * 64 + fq * 16 + fr) << 3);
#pragma unroll
        for (int ai = 0; ai < 2; ++ai)
#pragma unroll
            for (int m = 0; m < 4; ++m) { const float rs = rs8[ai * 4 + m];
#pragma unroll
                for (int bj = 0; bj < 2; ++bj) *(u32x4*)(dst + ((ai * 4 + m) * 2 + bj) * 4096) = pack8(gate4(acc[ai][bj][m][0] * rs), gate4(acc[ai][bj][m][1] * rs)); }
        return true;
    }
};
struct PhMerge {
    static constexpr int K = 512; static constexpr bool GATHER = false;
    unsigned char* ws; int G, c;
    __device__ __forceinline__ bool next(int i, GUnit& u) const {
        const int ti = i / 3, seg = i - ti * 3; const long L = (long)ti * G + c; if (L >= 128 * 4) return false;
        pg8::tile_order((int)L, 128, 4, u.pm, u.pn);
        const size_t ya = seg == 0 ? WS_YATT : (seg == 1 ? WS_YC : WS_OM);
        u.A = (const char*)ws + ya + (size_t)u.pm * 256 * K * 2; u.B = (const char*)ws + WS_WBR + (size_t)seg * 1024 * 512 * 2 + (size_t)u.pn * 256 * K * 2; u.a0 = seg; u.a1 = 0; return true;
    }
    __device__ __forceinline__ unsigned arow(const GUnit&, int) const { return 0u; }
    __device__ __forceinline__ void pre(const GUnit&, int, int, float (&)[8]) const {}
    __device__ __forceinline__ bool epi(Acc& acc, const GUnit& u, int wr, int wc, int fr, int fq, const float (&rs8)[8]) const {
        const int seg = u.a0; const int row0 = u.pm * 256 + wr * 64 + fr; const int col0 = u.pn * 256 + wc * 32 + fq * 8;
        const bf16_t* Gn = (const bf16_t*)(ws + WS_G0 + (size_t)seg * 64 * MiB);
        const bf16_t* Gd = (const bf16_t*)(ws + WS_G0 + (size_t)(seg < 2 ? seg + 1 : seg) * 64 * MiB);
        bf16_t* Mo = (bf16_t*)(ws + WS_MERGED); const size_t goff = (size_t)(u.pm * 4 + u.pn) * 65536 + (((wr * 4 + wc) * 64 + fq * 16 + fr) << 3);
#pragma unroll
        for (int ai = 0; ai < 2; ++ai)
#pragma unroll
            for (int mp = 0; mp < 2; ++mp) {
                u32x4 gn[2][2], gd[2][2];
#pragma unroll
                for (int mm = 0; mm < 2; ++mm)
#pragma unroll
                    for (int bj = 0; bj < 2; ++bj) { const size_t off = goff + ((ai * 4 + 2 * mp + mm) * 2 + bj) * 4096; gn[mm][bj] = *(const u32x4*)(Gn + off); gd[mm][bj] = *(const u32x4*)(Gd + off); }
                PIN8(gn[0][0], gn[0][1], gn[1][0], gn[1][1], gd[0][0], gd[0][1], gd[1][0], gd[1][1]);
#pragma unroll
                for (int mm = 0; mm < 2; ++mm)
#pragma unroll
                    for (int bj = 0; bj < 2; ++bj) { const int m = 2 * mp + mm; const size_t off = (size_t)(row0 + ai * 128 + m * 16) * 1024 + col0 + bj * 128;
                        f32x4 n0, n1, d0, d1; unpack8(gn[mm][bj], n0, n1); unpack8(gd[mm][bj], d0, d1);
                        if (seg < 2) {
#pragma unroll
                            for (int j = 0; j < 4; ++j) { acc[ai][bj][m][0][j] *= n0[j] * __builtin_amdgcn_rcpf(d0[j]); acc[ai][bj][m][1][j] *= n1[j] * __builtin_amdgcn_rcpf(d1[j]); } }
                        else *(u32x4*)(Mo + off) = pack8(acc[ai][bj][m][0] * n0, acc[ai][bj][m][1] * n1); }
            }
        return seg == 2;
    }
};
__device__ __forceinline__ float sel8(const float (&v)[8], int fq, int h) { return fq == 0 ? v[h] : (fq == 1 ? v[2 + h] : (fq == 2 ? v[4 + h] : v[6 + h])); }
__device__ __forceinline__ int sel8i(const int (&v)[8], int fq, int h) { return fq == 0 ? v[h] : (fq == 1 ? v[2 + h] : (fq == 2 ? v[4 + h] : v[6 + h])); }
__device__ __forceinline__ float store_x8(bf16_t* xbp, const f32x4 v0, const f32x4 v1) {
    *(u32x4*)xbp = pack8(v0, v1);
    return ((v0[0] * v0[0] + v0[1] * v0[1]) + (v0[2] * v0[2] + v0[3] * v0[3])) + ((v1[0] * v1[0] + v1[1] * v1[1]) + (v1[2] * v1[2] + v1[3] * v1[3]));
}
struct PhOut {
    static constexpr int K = 1024; static constexpr bool GATHER = false;
    unsigned char* ws; float* SSo; int G, c;
    __device__ __forceinline__ bool next(int i, GUnit& u) const {
        const long L = (long)i * G + c; if (L >= 128 * 4) return false;
        pg8::tile_order((int)L, 128, 4, u.pm, u.pn);
        u.A = (const char*)ws + WS_MERGED + (size_t)u.pm * 256 * K * 2; u.B = (const char*)ws + WS_WOUT + (size_t)u.pn * 256 * K * 2; u.a0 = 0; u.a1 = 0; return true;
    }
    __device__ __forceinline__ unsigned arow(const GUnit&, int) const { return 0u; }
    __device__ __forceinline__ void pre(const GUnit&, int, int, float (&)[8]) const {}
    __device__ __forceinline__ bool epi(Acc& acc, const GUnit& u, int wr, int wc, int fr, int fq, const float (&rs8)[8]) const {
        const int row0 = u.pm * 256 + wr * 64 + fr; const int col0 = u.pn * 256 + wc * 32 + fq * 8; bf16_t* XB = (bf16_t*)(ws + WS_XB);
        u32x4 xq[2][4][2];
#pragma unroll
        for (int ai = 0; ai < 2; ++ai)
#pragma unroll
            for (int m = 0; m < 4; ++m) { const unsigned off = (unsigned)(row0 + ai * 128 + m * 16) * 2048u + (unsigned)col0 * 2u;
#pragma unroll
                for (int bj = 0; bj < 2; ++bj) xq[ai][m][bj] = *(const u32x4*)((const char*)XB + off + bj * 256); }
        PIN8(xq[0][0][0], xq[0][0][1], xq[0][1][0], xq[0][1][1], xq[0][2][0], xq[0][2][1], xq[0][3][0], xq[0][3][1]);
        PIN8(xq[1][0][0], xq[1][0][1], xq[1][1][0], xq[1][1][1], xq[1][2][0], xq[1][2][1], xq[1][3][0], xq[1][3][1]);
        float ssq[8];
#pragma unroll
        for (int ai = 0; ai < 2; ++ai) {
#pragma unroll
            for (int m = 0; m < 4; ++m) { const int row = row0 + ai * 128 + m * 16; const size_t off = (size_t)row * 1024 + col0; float ss = 0.f;
#pragma unroll
                for (int bj = 0; bj < 2; ++bj) { f32x4 x0, x1; unpack8(xq[ai][m][bj], x0, x1); ss += store_x8(XB + off + bj * 128, x0 + acc[ai][bj][m][0], x1 + acc[ai][bj][m][1]); }
                ss += __shfl_xor(ss, 16); ss += __shfl_xor(ss, 32); ssq[ai * 4 + m] = ss; } }
#pragma unroll
        for (int h = 0; h < 2; ++h) { const int g = 2 * fq + h; SSo[(size_t)(row0 + (g >> 2) * 128 + (g & 3) * 16) * 16 + u.pn * 4 + wc] = sel8(ssq, fq, h); }
        return true;
    }
};
struct PhRouter {
    static constexpr int K = 1024; static constexpr bool GATHER = false;
    unsigned char* ws; const float* SS; int G, c;
    __device__ __forceinline__ bool next(int i, GUnit& u) const {
        const long L = (long)i * G + c; if (L >= 128) return false;
        u.pm = (int)L; u.pn = 0; u.A = (const char*)ws + WS_XB + (size_t)u.pm * 256 * K * 2; u.B = (const char*)ws + WS_WR; u.a0 = 0; u.a1 = 0; return true;
    }
    __device__ __forceinline__ unsigned arow(const GUnit&, int) const { return 0u; }
    __device__ __forceinline__ void pre(const GUnit& u, int wr, int fr, float (&rs)[8]) const { row_rs8_all(SS, u.pm * 256 + wr * 64 + fr, rs); }
    __device__ __forceinline__ bool epi(Acc& acc, const GUnit& u, int wr, int wc, int fr, int fq, const float (&rs8)[8]) const {
        if (wc < 2) { float* Lg = (float*)(ws + WS_LOGITS); const int row0 = u.pm * 256 + wr * 64 + fr;
#pragma unroll
            for (int ai = 0; ai < 2; ++ai)
#pragma unroll
                for (int m = 0; m < 4; ++m) { const int row = row0 + ai * 128 + m * 16; const float rs = rs8[ai * 4 + m]; float* p = Lg + (size_t)row * 64 + wc * 32 + fq * 8;
                    *(f32x4*)p = acc[ai][0][m][0] * rs; *(f32x4*)(p + 4) = acc[ai][0][m][1] * rs; } }
        return true;
    }
};
__device__ __forceinline__ int moe_expert_of(const int* META, int k, int rb) {
    const int r = rb * 256; int e = 0;
    for (int j = 1; j < 32; ++j) e += (META[16 + 64 * k + j] <= r) ? 1 : 0;
    return __builtin_amdgcn_readfirstlane(e);
}
struct PhUp {
    static constexpr int K = 1024; static constexpr bool GATHER = true;
    unsigned char* ws; const float* SS; const int* META; const int* tok; int G, c; unsigned* upc;
    __device__ __forceinline__ bool next(int i, GUnit& u) const {
        const int nb0 = __builtin_amdgcn_readfirstlane(META[0]), nb1 = __builtin_amdgcn_readfirstlane(META[1]); const long L = (long)i * G + c; if (L >= 2L * (nb0 + nb1)) return false;
        int blk = (int)(L >> 1); u.pn = (int)(L & 1); int k = 1; if (blk >= nb1) { k = 0; blk -= nb1; }
        const int e = moe_expert_of(META, k, blk);
        u.pm = blk; u.a0 = k; u.a1 = e; u.A = (const char*)ws + WS_XB; u.B = (const char*)ws + WS_WEXP + (size_t)e * 512 * 1024 * 2 + (size_t)u.pn * 256 * K * 2; return true;
    }
    __device__ __forceinline__ unsigned arow(const GUnit& u, int r) const { const int t = tok[u.a0 * LISTCAP + u.pm * 256 + r]; return t < 0 ? 0u : (unsigned)t; }
    __device__ __forceinline__ void pre(const GUnit& u, int wr, int fr, float (&rs)[8]) const {
        const float* R = (const float*)(ws + WS_LISTS) + 4 * LISTCAP + u.a0 * LISTCAP + u.pm * 256 + wr * 64 + fr;
#pragma unroll
        for (int g = 0; g < 8; ++g) rs[g] = R[(g >> 2) * 128 + (g & 3) * 16];
    }
    __device__ __forceinline__ bool epi(Acc& acc, const GUnit& u, int wr, int wc, int fr, int fq, const float (&rs8)[8]) const {
        const int lr0 = u.a0 * LISTCAP + u.pm * 256 + wr * 64 + fr; bf16_t* HB = (bf16_t*)(ws + WS_HB);
#pragma unroll
        for (int ai = 0; ai < 2; ++ai)
#pragma unroll
            for (int m = 0; m < 4; ++m) { const int lr = lr0 + ai * 128 + m * 16; const float rs = rs8[ai * 4 + m];
#pragma unroll
                for (int bj = 0; bj < 1; ++bj) { const f32x4 g0 = acc[ai][0][m][0] * rs, g1 = acc[ai][0][m][1] * rs, u0 = acc[ai][1][m][0] * rs, u1 = acc[ai][1][m][1] * rs;
                    const f32x4 h0 = (f32x4){siluf_(g0[0]) * u0[0], siluf_(g0[1]) * u0[1], siluf_(g0[2]) * u0[2], siluf_(g0[3]) * u0[3]}, h1 = (f32x4){siluf_(g1[0]) * u1[0], siluf_(g1[1]) * u1[1], siluf_(g1[2]) * u1[2], siluf_(g1[3]) * u1[3]};
                    st16_wt(HB + (size_t)lr * 256 + u.pn * 128 + wc * 32 + fq * 8, pack8(h0, h1)); }
                asm volatile("" ::: "memory"); }
        if (u.a0 == 1) { asm volatile("s_waitcnt vmcnt(0)" ::: "memory"); if (fr == 0 && fq == 0) xb_add(upc + u.pm, 1u); }
        return true;
    }
};
template <int KL> struct PhDown {
    static constexpr int K = 256; static constexpr bool GATHER = false;
    unsigned char* ws; float* SSo; const int* META; const int* tok; const float* wl; int G, c; unsigned* upc;
    __device__ __forceinline__ bool next(int i, GUnit& u) const {
        const int nb = __builtin_amdgcn_readfirstlane(META[KL]); long L = (long)i * G + c;
        if (KL == 1) {
            const int nb0 = __builtin_amdgcn_readfirstlane(META[0]); const int nU = 2 * (nb0 + nb);
            const int r = __builtin_amdgcn_readfirstlane(nU % G), lightN = G - r, nd = 4 * nb, ext = nd < 3 * lightN ? nd : 3 * lightN;
            int jx = i; const int cl = c - r;
            const int nxt = (cl >= 0 && ext > cl) ? __builtin_amdgcn_readfirstlane((ext - cl + lightN - 1) / lightN) : 0;
            if (jx < nxt) L = (long)jx * lightN + cl; else { jx -= nxt; L = (long)ext + (long)jx * G + c; }
        }
        if (L < 4L * nb) { const int blk = (int)(L >> 2); u.pn = (int)(L & 3); const int e = moe_expert_of(META, KL, blk); u.pm = blk; u.a0 = 0; u.a1 = e;
            if (KL == 1) { unsigned* barp = (unsigned*)(ws + WS_CTL) + 4096; XB_SPIN(xb_ld(upc + blk) < 16u, barp); }
            u.A = (const char*)ws + WS_HB + (size_t)(KL * LISTCAP + blk * 256) * 256 * 2; u.B = (const char*)ws + WS_WEXP + 32ull * 512 * 1024 * 2 + (size_t)e * 1024 * 256 * 2 + (size_t)u.pn * 256 * K * 2; return true; }
        return false;
    }
    __device__ __forceinline__ unsigned arow(const GUnit&, int) const { return 0u; }
    __device__ __forceinline__ void pre(const GUnit&, int, int, float (&)[8]) const {}
    __device__ __forceinline__ bool epi(Acc& acc, const GUnit& u, int wr, int wc, int fr, int fq, const float (&rs8)[8]) const {
        const int col0 = u.pn * 256 + wc * 32 + fq * 8;
        if (KL == 1 && u.a0 == 1) {
            bf16_t* PE = (bf16_t*)(ws + WS_PE); const int row0 = u.pm * 256 + wr * 64 + fr;
#pragma unroll
            for (int ai = 0; ai < 2; ++ai)
#pragma unroll
                for (int m = 0; m < 4; ++m)
#pragma unroll
                    for (int bj = 0; bj < 2; ++bj) *(u32x4*)(PE + (size_t)(u.pm * 4 + u.pn) * 65536 + (((wr * 4 + wc) * 64 + fq * 16 + fr) << 3) + ((ai * 4 + m) * 2 + bj) * 4096) = pack8(acc[ai][bj][m][0], acc[ai][bj][m][1]);
            return true;
        }
        const int lr0 = KL * LISTCAP + u.pm * 256 + wr * 64 + fr; bf16_t* YB = (bf16_t*)(ws + WS_YB1); const bf16_t* XB = (const bf16_t*)(ws + WS_XB); bf16_t* XT = (bf16_t*)(ws + WS_XBT);
        int tk[8]; float wk[8];
#pragma unroll
        for (int g = 0; g < 8; ++g) { const int lr = lr0 + (g >> 2) * 128 + (g & 3) * 16; tk[g] = tok[lr]; wk[g] = wl[lr]; }
        PIN8(tk[0], tk[1], tk[2], tk[3], tk[4], tk[5], tk[6], tk[7]); PIN8(wk[0], wk[1], wk[2], wk[3], wk[4], wk[5], wk[6], wk[7]);
        if (KL == 1) {
#pragma unroll
            for (int ai = 0; ai < 2; ++ai)
#pragma unroll
                for (int m = 0; m < 4; ++m) { const int t = tk[ai * 4 + m]; const float w = wk[ai * 4 + m]; const size_t off = (size_t)(t < 0 ? 0 : t) * 1024 + col0;
                    if (t >= 0) {
#pragma unroll
                        for (int bj = 0; bj < 2; ++bj) *(u32x4*)(YB + off + bj * 128) = pack8(acc[ai][bj][m][0] * w, acc[ai][bj][m][1] * w); }
                    if (m & 1) asm volatile("" ::: "memory"); }
        } else {
            u32x4 xr[4][2], yr[4][2], res[4][2]; float ssq[8];
#pragma unroll
            for (int m = 0; m < 4; ++m) { const int t = tk[m]; const unsigned off = (unsigned)(t < 0 ? 0 : t) * 2048u + (unsigned)col0 * 2u;
#pragma unroll
                for (int bj = 0; bj < 2; ++bj) { xr[m][bj] = *(const u32x4*)((const char*)XB + off + bj * 256); yr[m][bj] = *(const u32x4*)((const char*)YB + off + bj * 256); } }
            PIN8(xr[0][0], xr[0][1], xr[1][0], xr[1][1], xr[2][0], xr[2][1], xr[3][0], xr[3][1]); PIN8(yr[0][0], yr[0][1], yr[1][0], yr[1][1], yr[2][0], yr[2][1], yr[3][0], yr[3][1]);
#pragma unroll
            for (int ai = 0; ai < 2; ++ai) {
#pragma unroll
                for (int m = 0; m < 4; ++m) { const float w = wk[ai * 4 + m]; float ss = 0.f;
#pragma unroll
                    for (int bj = 0; bj < 2; ++bj) { f32x4 x0, x1, y0, y1; unpack8(xr[m][bj], x0, x1); unpack8(yr[m][bj], y0, y1);
                        const f32x4 v0 = (x0 + y0) + acc[ai][bj][m][0] * w, v1 = (x1 + y1) + acc[ai][bj][m][1] * w; res[m][bj] = pack8(v0, v1);
                        ss += ((v0[0] * v0[0] + v0[1] * v0[1]) + (v0[2] * v0[2] + v0[3] * v0[3])) + ((v1[0] * v1[0] + v1[1] * v1[1]) + (v1[2] * v1[2] + v1[3] * v1[3])); }
                    ss += __shfl_xor(ss, 16); ss += __shfl_xor(ss, 32); ssq[ai * 4 + m] = ss; }
                if (ai == 0) {
#pragma unroll
                    for (int m = 0; m < 4; ++m) { const int t = tk[4 + m]; const unsigned off = (unsigned)(t < 0 ? 0 : t) * 2048u + (unsigned)col0 * 2u;
#pragma unroll
                        for (int bj = 0; bj < 2; ++bj) { xr[m][bj] = *(const u32x4*)((const char*)XB + off + bj * 256); yr[m][bj] = *(const u32x4*)((const char*)YB + off + bj * 256); } }
                    asm volatile("" ::: "memory");
                }
#pragma unroll
                for (int m = 0; m < 4; ++m) { const int t = tk[ai * 4 + m];
                    if (t >= 0) { char* xo = (char*)XT + ((unsigned)t * 2048u + (unsigned)col0 * 2u); *(u32x4*)xo = res[m][0]; *(u32x4*)(xo + 256) = res[m][1]; } }
                if (ai == 0) { asm volatile("" ::: "memory");
                    PIN8(xr[0][0], xr[0][1], xr[1][0], xr[1][1], xr[2][0], xr[2][1], xr[3][0], xr[3][1]); PIN8(yr[0][0], yr[0][1], yr[1][0], yr[1][1], yr[2][0], yr[2][1], yr[3][0], yr[3][1]); }
            }
#pragma unroll
            for (int h = 0; h < 2; ++h) { const int t = sel8i(tk, fq, h); if (t >= 0) *(float*)((char*)SSo + ((unsigned)t * 64u + (unsigned)(u.pn * 4 + wc) * 4u)) = sel8(ssq, fq, h); }
        }
        return true;
    }
};
struct PhPe {
    static constexpr int K = 256; static constexpr bool GATHER = false;
    unsigned char* ws; const int* META; int G, c;
    __device__ __forceinline__ bool next(int i, GUnit& u) const {
        const int nb0 = __builtin_amdgcn_readfirstlane(META[0]); const int r = __builtin_amdgcn_readfirstlane((4 * nb0) % G), lightN = G - r, ext = 512 < 4 * lightN ? 512 : 4 * lightN;
        int jx = i; const int cl = c - r; long L;
        const int nxt = (cl >= 0 && ext > cl) ? __builtin_amdgcn_readfirstlane((ext - cl + lightN - 1) / lightN) : 0;
        if (jx < nxt) L = (long)jx * lightN + cl; else { jx -= nxt; L = (long)ext + (long)jx * G + c; }
        if (L >= 512) return false;
        pg8::tile_order((int)L, 128, 4, u.pm, u.pn); u.a0 = 1; u.a1 = 0;
        u.A = (const char*)ws + WS_PBF + (size_t)u.pm * 256 * K * 2; u.B = (const char*)ws + WS_WPP + (size_t)u.pn * 256 * K * 2; return true;
    }
    __device__ __forceinline__ unsigned arow(const GUnit&, int) const { return 0u; }
    __device__ __forceinline__ void pre(const GUnit&, int, int, float (&)[8]) const {}
    __device__ __forceinline__ bool epi(Acc& acc, const GUnit& u, int wr, int wc, int fr, int fq, const float (&rs8)[8]) const {
        bf16_t* PE = (bf16_t*)(ws + WS_PE);
#pragma unroll
        for (int ai = 0; ai < 2; ++ai)
#pragma unroll
            for (int m = 0; m < 4; ++m)
#pragma unroll
                for (int bj = 0; bj < 2; ++bj) *(u32x4*)(PE + (size_t)(u.pm * 4 + u.pn) * 65536 + (((wr * 4 + wc) * 64 + fq * 16 + fr) << 3) + ((ai * 4 + m) * 2 + bj) * 4096) = pack8(acc[ai][bj][m][0], acc[ai][bj][m][1]);
        return true;
    }
};
struct PhPle {
    static constexpr int K = 1024; static constexpr bool GATHER = false;
    unsigned char* ws; const float* SSi; float* SSo; int G, c;
    __device__ __forceinline__ bool next(int i, GUnit& u) const {
        const long L = (long)i * G + c; if (L >= 128 * 4) return false;
        pg8::tile_order((int)L, 128, 4, u.pm, u.pn);
        u.A = (const char*)ws + WS_XBT + (size_t)u.pm * 256 * K * 2; u.B = (const char*)ws + WS_WPG + (size_t)u.pn * 256 * K * 2; u.a0 = 0; u.a1 = 0; return true;
    }
    __device__ __forceinline__ unsigned arow(const GUnit&, int) const { return 0u; }
    __device__ __forceinline__ void pre(const GUnit& u, int wr, int fr, float (&rs)[8]) const { row_rs8_all(SSi, u.pm * 256 + wr * 64 + fr, rs); }
    __device__ __forceinline__ bool epi(Acc& acc, const GUnit& u, int wr, int wc, int fr, int fq, const float (&rs8)[8]) const {
        const int row0 = u.pm * 256 + wr * 64 + fr; const int col0 = u.pn * 256 + wc * 32 + fq * 8;
        char* XT = (char*)(ws + WS_XB); const char* PE = (const char*)(ws + WS_PE); const char* XBc = (const char*)(ws + WS_XBT);
        float rl8[8];
#pragma unroll
        for (int g = 0; g < 8; ++g) rl8[g] = rs8[g];
        constexpr int DEPTH = 3;
        const unsigned peoff = ((unsigned)(u.pm * 4 + u.pn) * 65536u + (unsigned)((((wr * 4 + wc) * 64 + fq * 16 + fr) << 3))) * 2u;
        u32x4 xr[DEPTH + 1][2], pr[DEPTH + 1][2]; float ssq[8];
#define PLE_LOAD(g) do { const unsigned off_ = (unsigned)(row0 + ((g) >> 2) * 128 + ((g) & 3) * 16) * 2048u + (unsigned)col0 * 2u; _Pragma("unroll") for (int bj = 0; bj < 2; ++bj) { \
            xr[(g) % (DEPTH + 1)][bj] = *(const u32x4*)(XBc + off_ + bj * 256); pr[(g) % (DEPTH + 1)][bj] = *(const u32x4*)(PE + peoff + (unsigned)(((g) * 2 + bj) * 8192)); } } while (0)
#pragma unroll
        for (int g = 0; g < DEPTH; ++g) PLE_LOAD(g);
#pragma unroll
        for (int g = 0; g < 8; ++g) { const int ai = g >> 2, m = g & 3, sl = g % (DEPTH + 1); const float rs = rl8[g]; float ss = 0.f; u32x4 res[2];
            PIN4(xr[sl][0], xr[sl][1], pr[sl][0], pr[sl][1]);
#pragma unroll
            for (int bj = 0; bj < 2; ++bj) { f32x4 p0, p1, x0, x1; unpack8(pr[sl][bj], p0, p1); unpack8(xr[sl][bj], x0, x1);
                const f32x4 v0 = x0 + sig4(acc[ai][bj][m][0] * rs) * p0, v1 = x1 + sig4(acc[ai][bj][m][1] * rs) * p1; res[bj] = pack8(v0, v1);
                ss += ((v0[0] * v0[0] + v0[1] * v0[1]) + (v0[2] * v0[2] + v0[3] * v0[3])) + ((v1[0] * v1[0] + v1[1] * v1[1]) + (v1[2] * v1[2] + v1[3] * v1[3])); }
            ss += __shfl_xor(ss, 16); ss += __shfl_xor(ss, 32);
            if (g + DEPTH < 8) { PLE_LOAD(g + DEPTH); }
            asm volatile("" ::: "memory");
            const int row = row0 + ai * 128 + m * 16; char* xo = XT + ((unsigned)row * 2048u + (unsigned)col0 * 2u);
            *(u32x4*)xo = res[0]; *(u32x4*)(xo + 256) = res[1]; ssq[g] = ss;
            asm volatile("" ::: "memory"); }
#undef PLE_LOAD
#pragma unroll
        for (int h = 0; h < 2; ++h) { const int g = 2 * fq + h; SSo[(size_t)(row0 + (g >> 2) * 128 + (g & 3) * 16) * 16 + u.pn * 4 + wc] = sel8(ssq, fq, h); }
        return true;
    }
};

struct InPtrs { const float* const* p; __device__ __forceinline__ const float* operator[](int i) const { return (const float*)(GAS const float*)p[i]; } };
struct Ctx {
    InPtrs in; float* out; unsigned char* ws; LAS unsigned char* lds;
    int tid, lane, wave, G, bid;
};
enum { I_X = 0, I_P, I_GMIX, I_WIN, I_CONVW, I_CONVB, I_CLNG, I_CLNB, I_MCW, I_MCB, I_MIB, I_MFB, I_WBA, I_WBC, I_WBM, I_WOUT, I_GFFN, I_WRG, I_BRG, I_WRE, I_BRE,
       I_WEG, I_WEU, I_WED, I_GPLE, I_WPG, I_WPP, I_GFIN };

constexpr int TR_LDS = 64 * 65 * 4;
template <bool GAIN>
__device__ __forceinline__ void tr_item64(const float* colptr4, size_t pitch, const float* gainp, float cscale, bf16_t* dst, int K, int n0, int k0, LAS float* scr, int lane, const float* gain_or_valid) {
    const float* gain = GAIN ? gainp : nullptr;
    const int g = lane & 15, r = lane >> 4;
    f32x4 v[16]; float gs[16];
    const float* cp = colptr4 ? colptr4 : gain_or_valid;
#pragma unroll
    for (int i = 0; i < 16; ++i) { const int kk = 4 * i + r; v[i] = *(const f32x4*)(cp + (colptr4 ? (size_t)(k0 + kk) * pitch : 0)); gs[i] = gain ? gain[k0 + kk] : 1.0f; }
    PIN8(v[0], v[1], v[2], v[3], v[4], v[5], v[6], v[7]); PIN8(v[8], v[9], v[10], v[11], v[12], v[13], v[14], v[15]);
    float zs = colptr4 ? cscale : 0.f; asm volatile("" : "+v"(zs));
#pragma unroll
    for (int i = 0; i < 16; ++i) { const int kk = 4 * i + r; const float m = gs[i] * zs; LAS float* p = scr + kk * 65 + 4 * g; p[0] = v[i].x * m; p[1] = v[i].y * m; p[2] = v[i].z * m; p[3] = v[i].w * m; }
    LDS_WAIT(); asm volatile("" ::: "memory");
    const int c = lane & 7, n8 = lane >> 3;
#pragma unroll
    for (int j = 0; j < 8; ++j) { const int n = n8 + 8 * j; const LAS float* sp = scr + (8 * c) * 65 + n;
        u32x4 o; o.x = pk2(sp[0 * 65], sp[1 * 65]); o.y = pk2(sp[2 * 65], sp[3 * 65]); o.z = pk2(sp[4 * 65], sp[5 * 65]); o.w = pk2(sp[6 * 65], sp[7 * 65]);
        *(u32x4*)(dst + (size_t)(n0 + n) * K + k0 + 8 * c) = o; }
    LDS_WAIT(); asm volatile("" ::: "memory");
}
__device__ __forceinline__ void rs_pass(const Ctx& F, const float* SS, float* RS) {
    for (int m = F.bid * NTHREADS + F.tid; m < T; m += F.G * NTHREADS) RS[m] = row_rs(SS, m);
}
__device__ __forceinline__ void phase_prep(const Ctx& F, int layer, float* SS) {
    const int gw = F.bid * NWAVES + F.wave, NGW = F.G * NWAVES, lane = F.lane;
    LAS float* scr = (LAS float*)(F.lds + F.wave * TR_LDS);
    bf16_t* XB = (bf16_t*)(F.ws + WS_XB);
    const float* w_in = F.in[I_WIN] + (size_t)layer * D * D_IN; const float* g_mix = F.in[I_GMIX] + (size_t)layer * D;
    {
        constexpr int WT_RS = 1056;
        LAS unsigned short* Wt = (LAS unsigned short*)(F.lds + 8 * TR_LDS);
        for (int k = F.tid; k < 1024; k += NTHREADS) { const float* wp = w_in + (size_t)k * D_IN + 5632; const f32x4 a = *(const f32x4*)wp, b = *(const f32x4*)(wp + 4); const float g = g_mix[k];
            Wt[0 * WT_RS + k] = (unsigned short)f2bf(a.x * g); Wt[1 * WT_RS + k] = (unsigned short)f2bf(a.y * g); Wt[2 * WT_RS + k] = (unsigned short)f2bf(a.z * g); Wt[3 * WT_RS + k] = (unsigned short)f2bf(a.w * g);
            Wt[4 * WT_RS + k] = (unsigned short)f2bf(b.x * g); Wt[5 * WT_RS + k] = (unsigned short)f2bf(b.y * g); Wt[6 * WT_RS + k] = (unsigned short)f2bf(b.z * g); Wt[7 * WT_RS + k] = (unsigned short)f2bf(b.w * g); }
        __syncthreads();
        float* RSAp = (float*)(F.ws + WS_TAB + TAB_RSA); float* IFp = (float*)(F.ws + WS_IF);
        const int r = lane & 15, q = lane >> 4;
        const LAS unsigned short* wrow = Wt + (r & 7) * WT_RS + 8 * q;
#pragma unroll 1
        for (int rg = gw; rg < T / 16; rg += NGW) {
            const int m = rg * 16 + r; f32x4 acc = (f32x4){0.f, 0.f, 0.f, 0.f}; float sq = 0.f;
            bf16_t* xbr = XB + (size_t)m * D + 8 * q;
            if (layer == 0) {
                const float* xr = F.in[I_X] + (size_t)m * D + 8 * q;
#pragma unroll 1
                for (int sb = 0; sb < 4; ++sb) {
                    f32x4 v[8][2];
#pragma unroll
                    for (int t = 0; t < 8; ++t) { v[t][0] = *(const f32x4*)(xr + 32 * (8 * sb + t)); v[t][1] = *(const f32x4*)(xr + 32 * (8 * sb + t) + 4); }
                    PIN8(v[0][0], v[0][1], v[1][0], v[1][1], v[2][0], v[2][1], v[3][0], v[3][1]); PIN8(v[4][0], v[4][1], v[5][0], v[5][1], v[6][0], v[6][1], v[7][0], v[7][1]);
#pragma unroll
                    for (int t = 0; t < 8; ++t) { const f32x4 x0 = v[t][0], x1 = v[t][1];
                        sq += ((x0.x * x0.x + x0.y * x0.y) + (x0.z * x0.z + x0.w * x0.w)) + ((x1.x * x1.x + x1.y * x1.y) + (x1.z * x1.z + x1.w * x1.w));
                        u32x4 w; w.x = pk2(x0.x, x0.y); w.y = pk2(x0.z, x0.w); w.z = pk2(x1.x, x1.y); w.w = pk2(x1.z, x1.w);
                        *(u32x4*)(xbr + 32 * (8 * sb + t)) = w;
                        bf16x8 af = *(const LAS bf16x8*)(wrow + 32 * (8 * sb + t)); if (r >= 8) af = (bf16x8){0, 0, 0, 0, 0, 0, 0, 0};
                        acc = __builtin_amdgcn_mfma_f32_16x16x32_bf16(af, __builtin_bit_cast(bf16x8, w), acc, 0, 0, 0); }
                }
                sq += __shfl_xor(sq, 16); sq += __shfl_xor(sq, 32);
            } else {
#pragma unroll 1
                for (int sb = 0; sb < 4; ++sb) {
                    u32x4 v[8];
#pragma unroll
                    for (int t = 0; t < 8; ++t) v[t] = *(const u32x4*)(xbr + 32 * (8 * sb + t));
                    PIN8(v[0], v[1], v[2], v[3], v[4], v[5], v[6], v[7]);
#pragma unroll
                    for (int t = 0; t < 8; ++t) { bf16x8 af = *(const LAS bf16x8*)(wrow + 32 * (8 * sb + t)); if (r >= 8) af = (bf16x8){0, 0, 0, 0, 0, 0, 0, 0};
                        acc = __builtin_amdgcn_mfma_f32_16x16x32_bf16(af, __builtin_bit_cast(bf16x8, v[t]), acc, 0, 0, 0); }
                }
            }
            const float rs = layer == 0 ? rsqrtf(sq * (1.0f / 1024.0f) + EPS) : row_rs(SS, m);
            if (q == 0) RSAp[m] = rs;
            if (q < 2) *(f32x4*)(IFp + (size_t)m * 8 + 4 * q) = acc * rs;
        }
    }
    constexpr int N_WIN = 140 * 16, N_BR = 16 * 8, N_SQ = 16 * 16, N_PP = 16 * 4, N_R = 4 * 16;
    constexpr int NITEMS = N_WIN + 3 * N_BR + 2 * N_SQ + N_PP + N_R;
    const int g4 = 4 * (lane & 15);
    for (int it = gw; it < NITEMS; it += NGW) {
        int r = it;
        if (r < N_WIN) { const int nb = r >> 4, kb = r & 15; if (nb >= 88 && nb < 92) continue;
            const int n = nb * 64 + g4; int src = -1; float cs = 1.f;
            if (n < 2560) { src = n; if (n < 1536) cs = 0.125f * 1.4426950408889634f; }
            else if (n < 3584) { const int np = n - 2560; src = 2560 + ((np >> 7) & 1) * 512 + (np >> 8) * 128 + (np & 127); }
            else if (n < 5640) src = n;
            else if (n < 5888) src = -1;
            else src = 5640 + (n - 5888);
            tr_item64<true>(src >= 0 ? w_in + src : nullptr, D_IN, g_mix, cs, (bf16_t*)(F.ws + WS_WIN), 1024, nb * 64, kb * 64, scr, lane, g_mix); continue; }
        r -= N_WIN;
        if (r < 3 * N_BR) { const int b = r / N_BR; r -= b * N_BR; const int nb = r >> 3, kb = r & 7; const int n = nb * 64 + g4;
            const float* w = (b == 0 ? F.in[I_WBA] : (b == 1 ? F.in[I_WBC] : F.in[I_WBM])) + (size_t)layer * 512 * 1024;
            tr_item64<false>(w + n, 1024, nullptr, 1.f, (bf16_t*)(F.ws + WS_WBR) + (size_t)b * 1024 * 512, 512, nb * 64, kb * 64, scr, lane, g_mix); continue; }
        r -= 3 * N_BR;
        if (r < 2 * N_SQ) { const int b = r / N_SQ; r -= b * N_SQ; const int nb = r >> 4, kb = r & 15; const int n = nb * 64 + g4;
            const float* w = (b == 0 ? F.in[I_WOUT] : F.in[I_WPG]) + (size_t)layer * 1024 * 1024;
            if (b == 0) tr_item64<false>(w + n, 1024, nullptr, 1.f, (bf16_t*)(F.ws + WS_WOUT), 1024, nb * 64, kb * 64, scr, lane, g_mix);
            else tr_item64<true>(w + n, 1024, F.in[I_GPLE] + (size_t)layer * D, 1.f, (bf16_t*)(F.ws + WS_WPG), 1024, nb * 64, kb * 64, scr, lane, g_mix);
            continue; }
        r -= 2 * N_SQ;
        if (r < N_PP) { const int nb = r >> 2, kb = r & 3; const int n = nb * 64 + g4;
            tr_item64<false>(F.in[I_WPP] + (size_t)layer * 256 * 1024 + n, 1024, nullptr, 1.f, (bf16_t*)(F.ws + WS_WPP), 256, nb * 64, kb * 64, scr, lane, g_mix); continue; }
        r -= N_PP;
        { const int nb = r >> 4, kb = r & 15; const int n = nb * 64 + g4; const float* cp = nullptr; size_t pitch = 4;
            if (n < 4) { cp = F.in[I_WRG] + (size_t)layer * 1024 * 4 + n; pitch = 4; } else if (n < 36) { cp = F.in[I_WRE] + (size_t)layer * 1024 * 32 + (n - 4); pitch = 32; }
            tr_item64<true>(cp, pitch, F.in[I_GFFN] + (size_t)layer * D, 1.f, (bf16_t*)(F.ws + WS_WR), 1024, nb * 64, kb * 64, scr, lane, g_mix); }
    }
}
__device__ __forceinline__ void phase_prep_experts(const Ctx& F, int layer) {
    const int gw = F.bid * NWAVES + F.wave, NGW = F.G * NWAVES, lane = F.lane;
    LAS float* scr = (LAS float*)(F.lds + F.wave * TR_LDS);
    const float* g_ffn = F.in[I_GFFN] + (size_t)layer * D;
    constexpr int N_UP = 32 * 8 * 16, N_DN = 32 * 16 * 4;
    const int g4 = 4 * (lane & 15);
    for (int it = gw; it < N_UP + N_DN; it += NGW) {
        int r = it;
        if (r < N_UP) { const int e = r >> 7; r &= 127; const int nb = r >> 4, kb = r & 15; const int n = nb * 64 + g4; const int sg = (n >> 7) & 1;
            const float* w = (sg ? F.in[I_WEU] : F.in[I_WEG]) + ((size_t)layer * 32 + e) * 1024 * 256 + (n >> 8) * 128 + (n & 127);
            tr_item64<true>(w, 256, g_ffn, 1.f, (bf16_t*)(F.ws + WS_WEXP) + (size_t)e * 512 * 1024, 1024, nb * 64, kb * 64, scr, lane, g_ffn); continue; }
        r -= N_UP;
        { const int e = r >> 6; r &= 63; const int nb = r >> 2, kb = r & 3; const int n = nb * 64 + g4;
            const float* w = F.in[I_WED] + ((size_t)layer * 32 + e) * 256 * 1024 + n;
            tr_item64<false>(w, 1024, nullptr, 1.f, (bf16_t*)(F.ws + WS_WEXP) + 32ull * 512 * 1024 + (size_t)e * 1024 * 256, 256, nb * 64, kb * 64, scr, lane, g_ffn); }
    }
    const f32x4* p = (const f32x4*)(F.in[I_P] + (size_t)layer * T * 256); u32x4* pb = (u32x4*)(F.ws + WS_PBF);
    { const size_t n = (size_t)T * 256 / 8, st = (size_t)F.G * NTHREADS;
        for (size_t i0 = (size_t)F.bid * NTHREADS + F.tid; i0 < n; i0 += 4 * st) { f32x4 v[4][2];
#pragma unroll
            for (int k = 0; k < 4; ++k) { const size_t i = i0 + k * st; const size_t ic = i < n ? i : 0; v[k][0] = p[2 * ic]; v[k][1] = p[2 * ic + 1]; }
            PIN8(v[0][0], v[0][1], v[1][0], v[1][1], v[2][0], v[2][1], v[3][0], v[3][1]);
#pragma unroll
            for (int k = 0; k < 4; ++k) { const size_t i = i0 + k * st; if (i < n) pb[i] = pack8(v[k][0], v[k][1]); } } }
}

constexpr int AK_RS = 144, AV_RS = 160, AV_OFF = 2 * 128 * AK_RS;
typedef short s16x4 __attribute__((ext_vector_type(4)));
__device__ __forceinline__ s16x4 lds_tr16(LAS unsigned char* p) { return __builtin_amdgcn_ds_read_tr16_b64_v4i16((LAS s16x4*)p); }
__device__ __forceinline__ void attn_strip(const Ctx& F, int strip) {
    const int bs = strip / 48, sg = strip - bs * 48, b = bs >> 3, slot = bs & 7;
    int g, r, nb0;
    if (sg < 16) { g = 0; r = 0; nb0 = sg * 8; } else if (sg < 32) { g = 1; r = (sg - 16) >> 2; nb0 = ((sg - 16) & 3) * 8; } else { g = 2; r = sg - 32; nb0 = 0; }
    const int dl = 1 << (2 * g); const float slope = exp2f(-(float)(g * 8 + slot + 1) * (1.0f / 3.0f)) * (float)dl * 1.4426950408889634f;
    bf16_t* Qg = (bf16_t*)(F.ws + (g == 0 ? WS_QA0 : (g == 1 ? WS_QA1 : WS_QA2))) + slot * 64;
    const bf16_t* Kg = (const bf16_t*)(F.ws + WS_KA) + slot * 64; const bf16_t* Vg = (const bf16_t*)(F.ws + WS_VA) + slot * 64;
    float* LSE = (float*)(F.ws + WS_LOGITS) + (size_t)g * T * 8 + slot;
    const size_t tok0 = (size_t)b * SEQ + r;
    LAS unsigned char* Kl = F.lds; LAS unsigned char* Vl = F.lds + AV_OFF;
    const int tid = F.tid, lane = F.lane, w = F.wave, fr = lane & 15, fq = lane >> 4;
    const int srow = tid >> 2, sc4 = tid & 3;
    u32x4 kx[2], vx[2];
#define ATT_LOAD(blk) do { const size_t _t = (tok0 + (size_t)((blk) * 128 + srow) * dl) * 512; \
        kx[0] = *(const u32x4*)(Kg + _t + sc4 * 8); kx[1] = *(const u32x4*)(Kg + _t + 32 + sc4 * 8); vx[0] = *(const u32x4*)(Vg + _t + sc4 * 8); vx[1] = *(const u32x4*)(Vg + _t + 32 + sc4 * 8); } while (0)
#define ATT_STORE(blk) do { const int _p = (((blk) & 1) * 128 + srow); \
        *(LAS u32x4*)(Kl + _p * AK_RS + sc4 * 16) = kx[0]; *(LAS u32x4*)(Kl + _p * AK_RS + 64 + sc4 * 16) = kx[1]; *(LAS u32x4*)(Vl + _p * AV_RS + sc4 * 16) = vx[0]; *(LAS u32x4*)(Vl + _p * AV_RS + 64 + sc4 * 16) = vx[1]; } while (0)
    __syncthreads();
    bf16x8 qn0, qn1;
    {
        u32x4 kp[2], vp[2]; const int pb = nb0 > 0 ? nb0 - 1 : nb0;
        { const size_t _t = (tok0 + (size_t)(pb * 128 + srow) * dl) * 512; kp[0] = *(const u32x4*)(Kg + _t + sc4 * 8); kp[1] = *(const u32x4*)(Kg + _t + 32 + sc4 * 8); vp[0] = *(const u32x4*)(Vg + _t + sc4 * 8); vp[1] = *(const u32x4*)(Vg + _t + 32 + sc4 * 8); }
        ATT_LOAD(nb0);
        { const size_t qo = (tok0 + (size_t)(nb0 * 128 + 16 * w + fr) * dl) * 512; qn0 = *(const bf16x8*)(Qg + qo + fq * 8); qn1 = *(const bf16x8*)(Qg + qo + 32 + fq * 8); }
        if (nb0 == 0) { kp[0] = kp[1] = vp[0] = vp[1] = (u32x4){0u, 0u, 0u, 0u}; }
        { const int _p = (((nb0 + 1) & 1) * 128 + srow);
          *(LAS u32x4*)(Kl + _p * AK_RS + sc4 * 16) = kp[0]; *(LAS u32x4*)(Kl + _p * AK_RS + 64 + sc4 * 16) = kp[1]; *(LAS u32x4*)(Vl + _p * AV_RS + sc4 * 16) = vp[0]; *(LAS u32x4*)(Vl + _p * AV_RS + 64 + sc4 * 16) = vp[1]; }
        ATT_STORE(nb0);
    }
    __syncthreads();
    for (int nb = nb0; nb < nb0 + 8; ++nb) {
        const bool more = nb + 1 < nb0 + 8;
        if (more) ATT_LOAD(nb + 1);
        const size_t qoff = (tok0 + (size_t)(nb * 128 + 16 * w + fr) * dl) * 512;
        const bf16x8 q0 = qn0, q1 = qn1;
        if (more) { const size_t qo2 = qoff + (size_t)128 * dl * 512; qn0 = *(const bf16x8*)(Qg + qo2 + fq * 8); qn1 = *(const bf16x8*)(Qg + qo2 + 32 + fq * 8); }
        const int pslot = (nb - 1) & 1;
        f32x4 S[10];
        S[9] = (f32x4){0.f, 0.f, 0.f, 0.f};
#pragma unroll
        for (int kbi = 0; kbi < 9; ++kbi) {
            int kb = w + kbi; if (kb > 15) kb = 15;
            const int ki = kb * 16 + fr; const int phys = ((pslot + (ki >> 7)) & 1) * 128 + (ki & 127);
            const bf16x8 k0 = *(const LAS bf16x8*)(Kl + phys * AK_RS + fq * 16), k1 = *(const LAS bf16x8*)(Kl + phys * AK_RS + 64 + fq * 16);
            f32x4 a = (f32x4){0.f, 0.f, 0.f, 0.f};
            a = __builtin_amdgcn_mfma_f32_16x16x32_bf16(k0, q0, a, 0, 0, 0);
            S[kbi] = __builtin_amdgcn_mfma_f32_16x16x32_bf16(k1, q1, a, 0, 0, 0);
        }
        float mx = -INFINITY;
        const int dbase = fr - 4 * fq + 128; const float fb = slope * (float)dbase; const int kmin = (nb > 0) ? 0 : 128 - (16 * w + 4 * fq);
#pragma unroll
        for (int kbi = 0; kbi < 9; ++kbi)
#pragma unroll
            for (int j = 0; j < 4; ++j) { const int cj = 16 * kbi + j;
                const bool ok = (unsigned)(dbase - cj) <= 128u && cj >= kmin;
                const float sc = ok ? __builtin_fmaf(slope, (float)cj, S[kbi][j] - fb) : -INFINITY; S[kbi][j] = sc; mx = fmaxf(mx, sc); }
        mx = fmaxf(mx, __shfl_xor(mx, 16)); mx = fmaxf(mx, __shfl_xor(mx, 32));
        float ls = 0.f;
#pragma unroll
        for (int kbi = 0; kbi < 9; ++kbi)
#pragma unroll
            for (int j = 0; j < 4; ++j) { const float p = __builtin_amdgcn_exp2f(S[kbi][j] - mx); S[kbi][j] = p; ls += p; }
        ls += __shfl_xor(ls, 16); ls += __shfl_xor(ls, 32);
        f32x4 O[4];
#pragma unroll
        for (int db = 0; db < 4; ++db) O[db] = (f32x4){0.f, 0.f, 0.f, 0.f};
#pragma unroll
        for (int k2 = 0; k2 < 5; ++k2) {
            u32x4 pw; pw.x = cvt_pk_bf16(S[2 * k2][0], S[2 * k2][1]); pw.y = cvt_pk_bf16(S[2 * k2][2], S[2 * k2][3]); pw.z = cvt_pk_bf16(S[2 * k2 + 1][0], S[2 * k2 + 1][1]); pw.w = cvt_pk_bf16(S[2 * k2 + 1][2], S[2 * k2 + 1][3]);
            const bf16x8 pf = __builtin_bit_cast(bf16x8, pw);
            int kb0 = w + 2 * k2, kb1 = kb0 + 1; if (kb1 > 15) kb1 = 15; if (kb0 > 15) kb0 = 15;
            const int r0 = kb0 * 16 + 4 * fq + (fr >> 2), r1 = kb1 * 16 + 4 * fq + (fr >> 2);
            const int p0 = ((pslot + (r0 >> 7)) & 1) * 128 + (r0 & 127), p1 = ((pslot + (r1 >> 7)) & 1) * 128 + (r1 & 127);
#pragma unroll
            for (int db = 0; db < 4; ++db) {
                const int dcol = (db >> 1) * 32 + 8 * (fr & 3) + 4 * (db & 1);
                const s16x4 v0 = lds_tr16(Vl + p0 * AV_RS + dcol * 2), v1 = lds_tr16(Vl + p1 * AV_RS + dcol * 2);
                const bf16x8 vf = (bf16x8){v0[0], v0[1], v0[2], v0[3], v1[0], v1[1], v1[2], v1[3]};
                O[db] = __builtin_amdgcn_mfma_f32_16x16x32_bf16(vf, pf, O[db], 0, 0, 0);
            }
        }
        const float inv = 1.0f / ls;
#pragma unroll
        for (int t = 0; t < 2; ++t) *(u32x4*)(Qg + qoff + t * 32 + 8 * fq) = pack8(O[2 * t] * inv, O[2 * t + 1] * inv);
        if (fq == 0) LSE[(qoff >> 9) * 8] = mx + __builtin_amdgcn_logf(ls);
        __syncthreads();
        if (more) ATT_STORE(nb + 1);
        __syncthreads();
    }
#undef ATT_LOAD
#undef ATT_STORE
}
__device__ __forceinline__ void attn_combine(const Ctx& F, int vb, int nv) {
    const float* LSE = (const float*)(F.ws + WS_LOGITS);
    for (int i0 = vb * NTHREADS + F.tid; i0 < T * 64; i0 += 4 * nv * NTHREADS) {
        u32x4 a[4], bb[4], cc[4]; float l0[4], l1[4], l2[4];
#pragma unroll
        for (int k = 0; k < 4; ++k) { const int i = i0 + k * nv * NTHREADS; const int ic = i < T * 64 ? i : 0; const int t = ic >> 6, slot = (ic & 63) >> 3;
            a[k] = ((const u32x4*)(F.ws + WS_QA0))[ic]; bb[k] = ((const u32x4*)(F.ws + WS_QA1))[ic]; cc[k] = ((const u32x4*)(F.ws + WS_QA2))[ic];
            l0[k] = LSE[(size_t)t * 8 + slot]; l1[k] = LSE[(size_t)T * 8 + (size_t)t * 8 + slot]; l2[k] = LSE[(size_t)2 * T * 8 + (size_t)t * 8 + slot]; }
        PIN4(a[0], a[1], a[2], a[3]); PIN4(bb[0], bb[1], bb[2], bb[3]); PIN4(cc[0], cc[1], cc[2], cc[3]);
#pragma unroll
        for (int k = 0; k < 4; ++k) { const int i = i0 + k * nv * NTHREADS; if (i < T * 64) {
            const float m = fmaxf(l0[k], fmaxf(l1[k], l2[k])); float w0 = __builtin_amdgcn_exp2f(l0[k] - m), w1 = __builtin_amdgcn_exp2f(l1[k] - m), w2 = __builtin_amdgcn_exp2f(l2[k] - m); const float inv = __builtin_amdgcn_rcpf(w0 + w1 + w2); w0 *= inv; w1 *= inv; w2 *= inv;
            f32x4 a0, a1, b0, b1, c0, c1; unpack8(a[k], a0, a1); unpack8(bb[k], b0, b1); unpack8(cc[k], c0, c1);
            ((u32x4*)(F.ws + WS_QA0))[i] = pack8(a0 * w0 + b0 * w1 + c0 * w2, a1 * w0 + b1 * w1 + c1 * w2); } }
    }
}

__device__ __forceinline__ void conv_item(const Ctx& F, int layer, int item, const f32x2 (&w)[31], const f32x2 cb) {
    const int t0 = item * 32, s0 = t0 & (SEQ - 1), tid = F.tid;
    LAS bf16_t* sin = (LAS bf16_t*)F.lds;
    LAS float* sout = (LAS float*)(F.lds + 65536);
    const bf16_t* YG = (const bf16_t*)(F.ws + WS_YG);
    __syncthreads();
#pragma unroll 1
    for (int kb = 0; kb < 2; ++kb) { u32x4 sv[4];
#pragma unroll
        for (int k = 0; k < 4; ++k) { const int i = tid + (kb * 4 + k) * NTHREADS; const int r = i < 62 * 64 ? (i >> 6) : 0, c8 = i & 63; const int sp = s0 - 30 + r;
            sv[k] = *(const u32x4*)(YG + (size_t)(sp >= 0 ? t0 - 30 + r : t0) * 512 + c8 * 8); }
        PIN4(sv[0], sv[1], sv[2], sv[3]);
#pragma unroll
        for (int k = 0; k < 4; ++k) { const int i = tid + (kb * 4 + k) * NTHREADS; const int r = i >> 6, c8 = i & 63; const int sp = s0 - 30 + r;
            if (i < 62 * 64) *(LAS u32x4*)(sin + r * 512 + c8 * 8) = sp >= 0 ? sv[k] : (u32x4){0u, 0u, 0u, 0u}; } }
    const int cp = tid & 255, hf = tid >> 8;
    __syncthreads();
#pragma unroll 1
    for (int ps = 0; ps < 2; ++ps) { const int tb = 16 * hf + 8 * ps;
        f32x2 xin[38];
#pragma unroll
        for (int r = 0; r < 38; ++r) { const unsigned u = *(const LAS unsigned*)(sin + (tb + r) * 512 + 2 * cp); xin[r] = (f32x2){bf_lo(u), bf_hi(u)}; }
#pragma unroll
        for (int tt = 0; tt < 8; ++tt) { f32x2 a = cb;
#pragma unroll
            for (int k = 0; k < 31; ++k) a += w[k] * xin[tt + k];
            *(LAS f32x2*)(sout + (tb + tt) * 512 + 2 * cp) = a; } }
    __syncthreads();
    const float* lg = F.in[I_CLNG] + layer * 512 + F.lane * 8; const float* lb = F.in[I_CLNB] + layer * 512 + F.lane * 8;
    for (int tt = F.wave; tt < 32; tt += NWAVES) {
        float v[8]; float sm = 0.f;
#pragma unroll
        for (int j = 0; j < 8; ++j) { v[j] = sout[tt * 512 + F.lane * 8 + j]; sm += v[j]; }
        const float mu = wave_sum(sm) * (1.0f / 512.0f); float q = 0.f;
#pragma unroll
        for (int j = 0; j < 8; ++j) { v[j] -= mu; q += v[j] * v[j]; }
        const float rstd = rsqrtf(wave_sum(q) * (1.0f / 512.0f) + EPS);
        float o[8];
#pragma unroll
        for (int j = 0; j < 8; ++j) o[j] = siluf_(v[j] * rstd * lg[j] + lb[j]);
        u32x4 wv; wv.x = cvt_pk_bf16(o[0], o[1]); wv.y = cvt_pk_bf16(o[2], o[3]); wv.z = cvt_pk_bf16(o[4], o[5]); wv.w = cvt_pk_bf16(o[6], o[7]);
        *(u32x4*)((bf16_t*)(F.ws + WS_YC) + (size_t)(t0 + tt) * 512 + F.lane * 8) = wv;
    }
}

__device__ __forceinline__ float log_sigmoid_(float v) { return fminf(v, 0.f) - log1pf(__expf(-fabsf(v))); }
struct QkW { float w[4][8]; float b[8]; };
__device__ __forceinline__ void qk_load_w(const Ctx& F, int layer, int chq, QkW& W) {
    const float* cw = F.in[I_MCW] + (size_t)layer * 4 * 1024 + chq; const float* cb = F.in[I_MCB] + (size_t)layer * 1024 + chq;
#pragma unroll
    for (int k = 0; k < 4; ++k) { const f32x4 a = *(const f32x4*)(cw + k * 1024), b = *(const f32x4*)(cw + k * 1024 + 4); W.w[k][0] = a.x; W.w[k][1] = a.y; W.w[k][2] = a.z; W.w[k][3] = a.w; W.w[k][4] = b.x; W.w[k][5] = b.y; W.w[k][6] = b.z; W.w[k][7] = b.w; }
    const f32x4 a = *(const f32x4*)cb, b = *(const f32x4*)(cb + 4); W.b[0] = a.x; W.b[1] = a.y; W.b[2] = a.z; W.b[3] = a.w; W.b[4] = b.x; W.b[5] = b.y; W.b[6] = b.z; W.b[7] = b.w;
}
__device__ __forceinline__ void qk_conv8(const QkW& W, const bf16_t* src  , int t, int s, int ch  , float scale, float* o) {
#pragma unroll
    for (int j = 0; j < 8; ++j) o[j] = W.b[j];
#pragma unroll
    for (int k = 0; k < 4; ++k) { const bool ok = s - 3 + k >= 0; u32x4 w = *(const u32x4*)(src + (size_t)(ok ? t - 3 + k : t) * 512 + ch);
            if (!ok) w = (u32x4){0u, 0u, 0u, 0u};
            o[0] += W.w[k][0] * bf_lo(w.x); o[1] += W.w[k][1] * bf_hi(w.x); o[2] += W.w[k][2] * bf_lo(w.y); o[3] += W.w[k][3] * bf_hi(w.y); o[4] += W.w[k][4] * bf_lo(w.z); o[5] += W.w[k][5] * bf_hi(w.z); o[6] += W.w[k][6] * bf_lo(w.w); o[7] += W.w[k][7] * bf_hi(w.w); }
#pragma unroll
    for (int j = 0; j < 8; ++j) o[j] = siluf_(o[j]) * scale;
}
__device__ __forceinline__ void qk_conv8r(const QkW& W, const u32x4 (&rw)[4], int s, float scale, float* o) {
#pragma unroll
    for (int j = 0; j < 8; ++j) o[j] = W.b[j];
#pragma unroll
    for (int k = 0; k < 4; ++k) { u32x4 w = rw[k]; if (s - 3 + k < 0) w = (u32x4){0u, 0u, 0u, 0u};
        o[0] += W.w[k][0] * bf_lo(w.x); o[1] += W.w[k][1] * bf_hi(w.x); o[2] += W.w[k][2] * bf_lo(w.y); o[3] += W.w[k][3] * bf_hi(w.y); o[4] += W.w[k][4] * bf_lo(w.z); o[5] += W.w[k][5] * bf_hi(w.z); o[6] += W.w[k][6] * bf_lo(w.w); o[7] += W.w[k][7] * bf_hi(w.w); }
#pragma unroll
    for (int j = 0; j < 8; ++j) o[j] = siluf_(o[j]) * scale;
}
__device__ __forceinline__ void mlstm_scalars(const Ctx& F, int layer, int t0, int h, LAS float* sIG, LAS float* sBC) {
    if (F.tid < 128) { const float* IFp = (const float*)(F.ws + WS_IF) + (size_t)(t0 + F.tid) * 8;
        sIG[F.tid] = IFp[h] + F.in[I_MIB][layer * 4 + h]; sBC[F.tid] = log_sigmoid_(IFp[4 + h] + F.in[I_MFB][layer * 4 + h]); }
    __syncthreads();
    if (F.wave == 0) { const float a = sBC[2 * F.lane], bb = sBC[2 * F.lane + 1]; float sc = a + bb;
#pragma unroll
        for (int off = 1; off < 64; off <<= 1) { const float t = __shfl_up(sc, off); if (F.lane >= off) sc += t; }
        sBC[2 * F.lane] = sc - bb; sBC[2 * F.lane + 1] = sc; }
    __syncthreads();
}
constexpr int ML_KRS = 288, ML_ERS = 352, ML_E = 128 * ML_KRS, ML_S = ML_E + 128 * ML_ERS;
__device__ __forceinline__ void mlstm_local_mfma(const Ctx& F, int layer, int item) {
    const int c = item & 127, bh = item >> 7, h = bh & 3, b = bh >> 2, t0 = b * SEQ + c * 128, tid = F.tid, lane = F.lane, w = F.wave, fr = lane & 15, fq = lane >> 4;
    LAS unsigned char* L = F.lds;
    LAS float* sIG = (LAS float*)(L + ML_S); LAS float* sBC = sIG + 128; LAS float* sE = sIG + 256; LAS float* sM = sIG + 384;
    __syncthreads();
    const bf16_t* KM = (const bf16_t*)(F.ws + WS_KM); const bf16_t* VM = (const bf16_t*)(F.ws + WS_VM);
    const int c8 = (tid & 15) * 8, l0 = tid >> 4; u32x4 rk[2][4], rv[2];
#define ML_LOAD(it, S) do { const int t_ = t0 + l0 + 32 * (it), s_ = t_ & (SEQ - 1); _Pragma("unroll") for (int k = 0; k < 4; ++k) rk[S][k] = *(const u32x4*)(KM + (size_t)(s_ - 3 + k >= 0 ? t_ - 3 + k : t_) * 512 + h * 128 + c8); \
        rv[S] = *(const u32x4*)(VM + (size_t)t_ * 512 + h * 128 + c8); } while (0)
    ML_LOAD(0, 0);
    mlstm_scalars(F, layer, t0, h, sIG, sBC);
    if (w == 0) { const float gt = sBC[127]; const float m = wave_max(fmaxf(gt - sBC[lane] + sIG[lane], gt - sBC[lane + 64] + sIG[lane + 64])); if (lane == 0) { sM[0] = m; sM[1] = gt; } }
    __syncthreads();
    if (tid < 128) sE[tid] = __expf(sM[1] - sBC[tid] + sIG[tid] - sM[0]);
    __syncthreads();
    QkW WK; qk_load_w(F, layer, 512 + h * 128 + (tid & 15) * 8, WK);
    {
#pragma unroll
        for (int it = 0; it < 4; ++it) { const int S = it & 1, l = l0 + 32 * it, s = (t0 + l) & (SEQ - 1);
            if (it < 3) { if (S == 0) ML_LOAD(it + 1, 1); else ML_LOAD(it + 1, 0); }
            PIN4(rk[S][0], rk[S][1], rk[S][2], rk[S][3]); PIN1(rv[S]);
            float o[8]; qk_conv8r(WK, rk[S], s, 0.08838834764831845f, o);
            *(LAS u32x4*)(L + l * ML_KRS + c8 * 2) = pack8((f32x4){o[0], o[1], o[2], o[3]}, (f32x4){o[4], o[5], o[6], o[7]});
            f32x4 v0, v1; unpack8(rv[S], v0, v1); const float e = sE[l];
            *(LAS u32x4*)(L + ML_E + l * ML_ERS + c8 * 2) = pack8(v0 * e, v1 * e); }
#undef ML_LOAD
    }
    if (tid < 128) { unsigned zr = 0u; asm volatile("" : "+v"(zr));
        u32x4 z; z.x = f2bf(sE[tid]); z.y = zr; z.z = zr; z.w = zr; *(LAS u32x4*)(L + ML_E + tid * ML_ERS + 256) = z; z.x = zr; *(LAS u32x4*)(L + ML_E + tid * ML_ERS + 272) = z; }
    __syncthreads();
    bf16x8 af[4];
#pragma unroll
    for (int ks = 0; ks < 4; ++ks) { const int ra = ks * 32 + 4 * fq + (fr >> 2);
        const s16x4 a0 = lds_tr16(L + ra * ML_KRS + (w * 16 + 4 * (fr & 3)) * 2), a1 = lds_tr16(L + (ra + 16) * ML_KRS + (w * 16 + 4 * (fr & 3)) * 2);
        af[ks] = (bf16x8){a0[0], a0[1], a0[2], a0[3], a1[0], a1[1], a1[2], a1[3]}; }
    bf16_t* Cp = (bf16_t*)(F.ws + WS_CST) + ((size_t)(bh * 128 + c) << 14);
#pragma unroll
    for (int vb = 0; vb < 9; ++vb) { f32x4 d = (f32x4){0.f, 0.f, 0.f, 0.f};
#pragma unroll
        for (int ks = 0; ks < 4; ++ks) { const int rb = ks * 32 + 4 * fq + (fr >> 2);
            const s16x4 b0 = lds_tr16(L + ML_E + rb * ML_ERS + (vb * 16 + 4 * (fr & 3)) * 2), b1 = lds_tr16(L + ML_E + (rb + 16) * ML_ERS + (vb * 16 + 4 * (fr & 3)) * 2);
            const bf16x8 bfr = (bf16x8){b0[0], b0[1], b0[2], b0[3], b1[0], b1[1], b1[2], b1[3]};
            d = __builtin_amdgcn_mfma_f32_16x16x32_bf16(af[ks], bfr, d, 0, 0, 0); }
        if (vb < 8) { u32x2 o; o.x = pk2(d[0], d[1]); o.y = pk2(d[2], d[3]); *(u32x2*)(Cp + (size_t)(vb * 16 + fr) * 128 + w * 16 + 4 * fq) = o; }
        else if (fr == 0) *(f32x4*)((float*)(F.ws + WS_NST) + (size_t)(bh * 128 + c) * 128 + w * 16 + 4 * fq) = d;
    }
    if (tid == 0) { ((float*)(F.ws + WS_TAB + TAB_MLOC))[bh * 128 + c] = sM[0]; ((float*)(F.ws + WS_TAB + TAB_GTOT))[bh * 128 + c] = sM[1]; }
}
__device__ __forceinline__ void phase_scan(const Ctx& F) {
    const float* GT = (const float*)(F.ws + WS_TAB + TAB_GTOT); const float* ML = (const float*)(F.ws + WS_TAB + TAB_MLOC); float* MS = (float*)(F.ws + WS_TAB + TAB_MST);
    LAS float* sA = (LAS float*)F.lds; LAS float* sB = sA + 128;
    for (int blk = F.bid; blk < 8 * 16; blk += F.G) {
        const int bh = blk >> 4;
        __syncthreads();
        if (F.tid < 128) { sA[F.tid] = GT[bh * 128 + F.tid]; sB[F.tid] = ML[bh * 128 + F.tid]; }
        __syncthreads();
        if (F.wave == 0) {
            const int c0 = 2 * F.lane; const float g0 = sA[c0], m0 = sB[c0], g1 = sA[c0 + 1], m1 = sB[c0 + 1];
            float G = g0 + g1, M = fmaxf(m0 + g1, m1);
#pragma unroll
            for (int off = 1; off < 64; off <<= 1) { const float Gp = __shfl_up(G, off), Mp = __shfl_up(M, off); if (F.lane >= off) { M = fmaxf(Mp + G, M); G = Gp + G; } }
            float Gx = __shfl_up(G, 1), Mx = __shfl_up(M, 1); if (F.lane == 0) { Gx = 0.f; Mx = -INFINITY; }
            const float mA = fmaxf(0.f + Gx, Mx);
            const float mB = fmaxf(mA + g0, m0);
            const float mC = fmaxf(mB + g1, m1);
            sA[c0] = __expf(g0 + mA - mB); sB[c0] = __expf(m0 - mB); sA[c0 + 1] = __expf(g1 + mB - mC); sB[c0 + 1] = __expf(m1 - mC);
            if ((blk & 15) == 0) { MS[bh * 128 + c0] = mA; MS[bh * 128 + c0 + 1] = mB; } }
        __syncthreads();
        if (F.tid < 256) {
            u32x2* cp = (u32x2*)((bf16_t*)(F.ws + WS_CST) + ((size_t)(bh * 128) << 14) + (blk & 15) * 1024) + F.tid; float v0 = 0.f, v1 = 0.f, v2 = 0.f, v3 = 0.f;
#pragma unroll 1
            for (int c0 = 0; c0 < 128; c0 += 64) { u32x2 loc[64];
#pragma unroll
                for (int j = 0; j < 64; ++j) loc[j] = cp[(size_t)(c0 + j) << 12];
#pragma unroll
                for (int j = 0; j < 64; j += 8) PIN8(loc[j], loc[j + 1], loc[j + 2], loc[j + 3], loc[j + 4], loc[j + 5], loc[j + 6], loc[j + 7]);
#pragma unroll
                for (int j = 0; j < 64; ++j) { const float a = sA[c0 + j], b = sB[c0 + j]; u32x2 o; o.x = pk2(v0, v1); o.y = pk2(v2, v3); cp[(size_t)(c0 + j) << 12] = o;
                    v0 = a * v0 + b * bf_lo(loc[j].x); v1 = a * v1 + b * bf_hi(loc[j].x); v2 = a * v2 + b * bf_lo(loc[j].y); v3 = a * v3 + b * bf_hi(loc[j].y); } }
        }
        if (F.tid >= 256 && F.tid < 264) {
            float* np = (float*)(F.ws + WS_NST) + (size_t)(bh * 128) * 128 + (blk & 15) * 8 + (F.tid - 256); float nval = 0.f;
#pragma unroll 1
            for (int c0 = 0; c0 < 128; c0 += 64) { float nloc[64];
#pragma unroll
                for (int j = 0; j < 64; ++j) nloc[j] = np[(size_t)(c0 + j) * 128];
#pragma unroll
                for (int j = 0; j < 64; j += 8) PIN8(nloc[j], nloc[j + 1], nloc[j + 2], nloc[j + 3], nloc[j + 4], nloc[j + 5], nloc[j + 6], nloc[j + 7]);
#pragma unroll
                for (int j = 0; j < 64; ++j) { np[(size_t)(c0 + j) * 128] = nval; nval = sA[c0 + j] * nval + sB[c0 + j] * nloc[j]; } } }
    }
    __syncthreads();
}
constexpr int MO_RS = 272, MO_VRS = 288;
constexpr int MO_Q = 0, MO_K = 128 * MO_RS, MO_C = 2 * 128 * MO_RS, MO_V = MO_C + 144 * MO_RS, MO_S = MO_V + 128 * MO_VRS;
static_assert(MO_S + 2560 <= MISC_OFF, "mlstm_out LDS");
__device__ __forceinline__ void mlstm_out_mfma(const Ctx& F, int layer, int item) {
    const int c = item & 127, bh = item >> 7, h = bh & 3, b = bh >> 2, t0 = b * SEQ + c * 128, tid = F.tid, lane = F.lane, w = F.wave, fr = lane & 15, fq = lane >> 4;
    LAS unsigned char* L = F.lds;
    LAS float* sIG = (LAS float*)(L + MO_S); LAS float* sBC = sIG + 128; LAS float* sMT = sIG + 256; LAS float* sSI = sIG + 384; LAS float* sU = sIG + 512;
    __syncthreads();
    const bf16_t* QM = (const bf16_t*)(F.ws + WS_QM); const bf16_t* KM = (const bf16_t*)(F.ws + WS_KM); const bf16_t* VM = (const bf16_t*)(F.ws + WS_VM);
    const bf16_t* Cp = (const bf16_t*)(F.ws + WS_CST) + ((size_t)(bh * 128 + c) << 14);
    const int c8 = (tid & 15) * 8, l0 = tid >> 4; u32x4 rq[2][4], rk[2][4], rv[2], rc[2];
#define MO_LOAD(it, S) do { const int l_ = l0 + 32 * (it), t_ = t0 + l_, s_ = t_ & (SEQ - 1); _Pragma("unroll") for (int k = 0; k < 4; ++k) { const size_t ro = (size_t)(s_ - 3 + k >= 0 ? t_ - 3 + k : t_) * 512 + h * 128 + c8; \
        rq[S][k] = *(const u32x4*)(QM + ro); rk[S][k] = *(const u32x4*)(KM + ro); } rv[S] = *(const u32x4*)(VM + (size_t)t_ * 512 + h * 128 + c8); rc[S] = *(const u32x4*)(Cp + l_ * 128 + c8); } while (0)
    mlstm_scalars(F, layer, t0, h, sIG, sBC);
    if (tid < 128) sU[tid] = (sIG[tid] - sBC[tid]) * 1.4426950408889634f;
    const float mst = ((const float*)(F.ws + WS_TAB + TAB_MST))[bh * 128 + c];
    if (w == 0) { const float a = sIG[2 * lane] - sBC[2 * lane], bb = sIG[2 * lane + 1] - sBC[2 * lane + 1]; float pm = fmaxf(a, bb);
#pragma unroll
        for (int off = 1; off < 64; off <<= 1) { const float t = __shfl_up(pm, off); if (lane >= off) pm = fmaxf(pm, t); }
        float pl = __shfl_up(pm, 1); if (lane == 0) pl = -INFINITY;
        const float p0 = fmaxf(pl, a), p1 = pm;
        { const float ai = sBC[2 * lane] + mst, mt = fmaxf(ai, sBC[2 * lane] + p0); sMT[2 * lane] = mt; sSI[2 * lane] = __expf(ai - mt); }
        { const float ai = sBC[2 * lane + 1] + mst, mt = fmaxf(ai, sBC[2 * lane + 1] + p1); sMT[2 * lane + 1] = mt; sSI[2 * lane + 1] = __expf(ai - mt); } }
    QkW WQ, WK; qk_load_w(F, layer, h * 128 + (tid & 15) * 8, WQ); qk_load_w(F, layer, 512 + h * 128 + (tid & 15) * 8, WK);
    MO_LOAD(0, 0);
    {
#pragma unroll
        for (int it = 0; it < 4; ++it) { const int S = it & 1, l = l0 + 32 * it, s = (t0 + l) & (SEQ - 1); float o[8];
            if (it < 3) { if (S == 0) MO_LOAD(it + 1, 1); else MO_LOAD(it + 1, 0); }
            PIN8(rq[S][0], rq[S][1], rq[S][2], rq[S][3], rk[S][0], rk[S][1], rk[S][2], rk[S][3]); PIN2(rv[S], rc[S]);
            qk_conv8r(WQ, rq[S], s, 1.0f, o);
            *(LAS u32x4*)(L + MO_Q + l * MO_RS + c8 * 2) = pack8((f32x4){o[0], o[1], o[2], o[3]}, (f32x4){o[4], o[5], o[6], o[7]});
            qk_conv8r(WK, rk[S], s, 0.08838834764831845f, o);
            *(LAS u32x4*)(L + MO_K + l * MO_RS + c8 * 2) = pack8((f32x4){o[0], o[1], o[2], o[3]}, (f32x4){o[4], o[5], o[6], o[7]});
            *(LAS u32x4*)(L + MO_V + l * MO_VRS + c8 * 2) = rv[S];
            *(LAS u32x4*)(L + MO_C + l * MO_RS + c8 * 2) = rc[S]; }
#undef MO_LOAD
    }
    if (tid < 16) { const float* np = (const float*)(F.ws + WS_NST) + (size_t)(bh * 128 + c) * 128 + tid * 8;
        *(LAS u32x4*)(L + MO_C + 128 * MO_RS + tid * 16) = pack8(*(const f32x4*)np, *(const f32x4*)(np + 4)); }
    __syncthreads();
    const int q = 16 * w + fr;
    bf16_t* OM = (bf16_t*)(F.ws + WS_OM) + (size_t)(t0 + q) * 512 + h * 128 + 8 * fq;
    u32x4 gv[4];
#pragma unroll
    for (int t = 0; t < 4; ++t) gv[t] = *(const u32x4*)(OM + 32 * t);
    bf16x8 qf[4];
#pragma unroll
    for (int ks = 0; ks < 4; ++ks) qf[ks] = *(const LAS bf16x8*)(L + MO_Q + q * MO_RS + ks * 64 + fq * 16);
    f32x4 O[9];
#pragma unroll
    for (int vb = 0; vb < 9; ++vb) { f32x4 a = (f32x4){0.f, 0.f, 0.f, 0.f};
#pragma unroll
        for (int ks = 0; ks < 4; ++ks) { const bf16x8 cf = *(const LAS bf16x8*)(L + MO_C + (vb < 8 ? (vb >> 1) * 32 + 8 * (fr >> 2) + 4 * (vb & 1) + (fr & 3) : 128 + fr) * MO_RS + ks * 64 + fq * 16); a = __builtin_amdgcn_mfma_f32_16x16x32_bf16(cf, qf[ks], a, 0, 0, 0); }
        O[vb] = a; }
    const float si = sSI[q], mt = sMT[q], bq = sBC[q]; const float vq = (bq - mt) * 1.4426950408889634f;
    const float dn = __shfl(O[8][0], fr);
#pragma unroll
    for (int vb = 0; vb < 8; ++vb) O[vb] = O[vb] * si;
    float den = 0.f;
    for (int k2 = 0; k2 <= (w >> 1); ++k2) {
        f32x4 P[2];
#pragma unroll
        for (int u = 0; u < 2; ++u) { const int kb = 2 * k2 + u; f32x4 a = (f32x4){0.f, 0.f, 0.f, 0.f};
            const int kr = (kb > 7 ? 7 : kb) * 16 + fr;
#pragma unroll
            for (int ks = 0; ks < 4; ++ks) { const bf16x8 kf = *(const LAS bf16x8*)(L + MO_K + kr * MO_RS + ks * 64 + fq * 16); a = __builtin_amdgcn_mfma_f32_16x16x32_bf16(kf, qf[ks], a, 0, 0, 0); }
#pragma unroll
            for (int j = 0; j < 4; ++j) { const int k = kb * 16 + 4 * fq + j; const int kc = k > 127 ? 127 : k; const float wgt = (k <= q) ? __builtin_amdgcn_exp2f(sU[kc] + vq) : 0.f; a[j] *= wgt; den += a[j]; }
            P[u] = a; }
        u32x4 pw; pw.x = cvt_pk_bf16(P[0][0], P[0][1]); pw.y = cvt_pk_bf16(P[0][2], P[0][3]); pw.z = cvt_pk_bf16(P[1][0], P[1][1]); pw.w = cvt_pk_bf16(P[1][2], P[1][3]);
        const bf16x8 pf = __builtin_bit_cast(bf16x8, pw);
        const int kb1 = (2 * k2 + 1 > 7) ? 7 : 2 * k2 + 1;
        const int r0 = 2 * k2 * 16 + 4 * fq + (fr >> 2), r1 = kb1 * 16 + 4 * fq + (fr >> 2);
#pragma unroll
        for (int vb = 0; vb < 8; ++vb) {
            const int vcol = (vb >> 1) * 32 + 8 * (fr & 3) + 4 * (vb & 1);
            const s16x4 v0 = lds_tr16(L + MO_V + r0 * MO_VRS + vcol * 2), v1 = lds_tr16(L + MO_V + r1 * MO_VRS + vcol * 2);
            const bf16x8 vf = (bf16x8){v0[0], v0[1], v0[2], v0[3], v1[0], v1[1], v1[2], v1[3]};
            O[vb] = __builtin_amdgcn_mfma_f32_16x16x32_bf16(vf, pf, O[vb], 0, 0, 0);
        }
    }
    den += __shfl_xor(den, 16); den += __shfl_xor(den, 32);
    const float dd = den + si * dn; const float inv = 1.0f / fmaxf(fabsf(dd), __expf(-mt));
    PIN4(gv[0], gv[1], gv[2], gv[3]);
#pragma unroll
    for (int t = 0; t < 4; ++t) { f32x4 g0, g1; unpack8(gv[t], g0, g1); *(u32x4*)(OM + 32 * t) = pack8(g0 * (O[2 * t] * inv), g1 * (O[2 * t + 1] * inv)); }
}


__device__ __forceinline__ void phase_route(const Ctx& F, int layer, int tile0) {
    LAS int* hist = (LAS int*)F.lds;
    const float* brg = F.in[I_BRG] + layer * 4; const float* bre = F.in[I_BRE] + layer * 32;
    __syncthreads();
    if (F.tid < 256) { const int lt = F.tid >> 7, tl = F.tid & 127; const int t = (tile0 + lt) * 128 + tl; const f32x4* lg4 = (const f32x4*)((const float*)(F.ws + WS_LOGITS) + (size_t)t * 64);
        f32x4 lv[9];
#pragma unroll
        for (int j = 0; j < 9; ++j) lv[j] = lg4[j];
        float bg[4], be[32];
#pragma unroll
        for (int j = 0; j < 4; ++j) bg[j] = brg[j];
#pragma unroll
        for (int j = 0; j < 32; ++j) be[j] = bre[j];
        float g[4]; int gs = 0; float gm;
#pragma unroll
        for (int j = 0; j < 4; ++j) g[j] = lv[0][j] + bg[j];
        gm = g[0];
#pragma unroll
        for (int j = 1; j < 4; ++j) if (g[j] > gm) { gm = g[j]; gs = j; }
        float se = 0.f;
#pragma unroll
        for (int j = 0; j < 4; ++j) se += __expf(g[j] - gm);
        const float pg = 1.0f / se;
        float le[8];
#pragma unroll
        for (int j = 0; j < 8; ++j) { const f32x4 a = lv[1 + 2 * 0 + (j >> 2)], b = lv[1 + 2 * 1 + (j >> 2)], cq = lv[1 + 2 * 2 + (j >> 2)], d = lv[1 + 2 * 3 + (j >> 2)];
            const float l = gs == 0 ? a[j & 3] : (gs == 1 ? b[j & 3] : (gs == 2 ? cq[j & 3] : d[j & 3]));
            const float bb = gs == 0 ? be[j] : (gs == 1 ? be[8 + j] : (gs == 2 ? be[16 + j] : be[24 + j])); le[j] = l + bb; }
        int i0 = 0; float v0 = le[0];
#pragma unroll
        for (int j = 1; j < 8; ++j) if (le[j] > v0) { v0 = le[j]; i0 = j; }
        int i1 = -1; float v1 = -INFINITY;
#pragma unroll
        for (int j = 0; j < 8; ++j) if (j != i0 && le[j] > v1) { v1 = le[j]; i1 = j; }
        const float e1 = __expf(v1 - v0); const float w0 = pg / (1.0f + e1), w1 = pg * e1 / (1.0f + e1);
        const int x0 = gs * 8 + i0, x1 = gs * 8 + i1;
        st_wt((int*)(F.ws + WS_ROUTE) + 2 * t, x0); st_wt((int*)(F.ws + WS_ROUTE) + 2 * t + 1, x1);
        st_wt((float*)(F.ws + WS_ROUTE) + 2 * T + 2 * t, w0); st_wt((float*)(F.ws + WS_ROUTE) + 2 * T + 2 * t + 1, w1);
        hist[lt * 256 + tl] = x0; hist[lt * 256 + 128 + tl] = x1;
    }
    __syncthreads();
    if (F.tid < 128) { const int lt = F.tid >> 6, k = (F.tid >> 5) & 1, ex = F.tid & 31; int cnt = 0; for (int j = 0; j < 128; ++j) cnt += (hist[lt * 256 + k * 128 + j] == ex) ? 1 : 0;
        st_wt((int*)(F.ws + WS_TAB + TAB_CNT) + (tile0 + lt) * 64 + (F.tid & 63), cnt); }
    asm volatile("s_waitcnt vmcnt(0)" ::: "memory");
    __syncthreads();
    if (F.tid == 0) xb_add((unsigned*)(F.ws + WS_CTL) + 64, 1u);
}
__device__ __forceinline__ void phase_dispatch(const Ctx& F, const float* SS, int tfirst, int tstep) {
    LAS int* sTot = (LAS int*)F.lds; LAS int* sBef = sTot + 64; LAS int* sPs = sTot + 128; LAS int* sE = sTot + 256; LAS int* sPart = sTot + 512;
    const int* CNT = (const int*)(F.ws + WS_TAB + TAB_CNT); int* META = (int*)(F.ws + WS_TAB + TAB_META);
    int* tokl = (int*)(F.ws + WS_LISTS); float* wl = (float*)(F.ws + WS_LISTS) + 2 * LISTCAP; float* rsl = (float*)(F.ws + WS_LISTS) + 4 * LISTCAP;
    for (int tile = tfirst; tile < 256; tile += tstep) {
        { const int ke = F.tid & 63, grp = F.tid >> 6; int cv[32];
#pragma unroll
            for (int i = 0; i < 32; ++i) cv[i] = ld_wt(CNT + (grp + 8 * i) * 64 + ke);
            int tot = 0, bef = 0;
#pragma unroll
            for (int i = 0; i < 32; ++i) { tot += cv[i]; bef += (grp + 8 * i < tile) ? cv[i] : 0; }
            sPart[grp * 64 + ke] = tot; sPart[512 + grp * 64 + ke] = bef; }
        __syncthreads();
        if (F.tid < 64) { int tot = 0, bef = 0;
#pragma unroll
            for (int gI = 0; gI < 8; ++gI) { tot += sPart[gI * 64 + F.tid]; bef += sPart[512 + gI * 64 + F.tid]; }
            sTot[F.tid] = tot; sBef[F.tid] = bef; }
        __syncthreads();
        if (F.tid < 2) { int ps = 0; for (int e = 0; e < 32; ++e) { sPs[F.tid * 33 + e] = ps; ps += ((sTot[F.tid * 32 + e] + 255) >> 8) << 8; } sPs[F.tid * 33 + 32] = ps;
            if (tile == 0) { META[F.tid] = ps >> 8; for (int e = 0; e <= 32; ++e) META[16 + 64 * F.tid + e] = sPs[F.tid * 33 + e]; } }
        int e0 = 0, e1 = 0; float w0 = 0.f, w1 = 0.f, rsv = 0.f;
        if (F.tid < 128) { const int t = tile * 128 + F.tid; rsv = row_rs(SS, t); e0 = ld_wt((const int*)(F.ws + WS_ROUTE) + 2 * t); e1 = ld_wt((const int*)(F.ws + WS_ROUTE) + 2 * t + 1);
            w0 = ld_wt((const float*)(F.ws + WS_ROUTE) + 2 * T + 2 * t); w1 = ld_wt((const float*)(F.ws + WS_ROUTE) + 2 * T + 2 * t + 1); sE[F.tid] = e0; sE[128 + F.tid] = e1; }
        __syncthreads();
        if (F.tid < 128) { int r0 = 0, r1 = 0; for (int j = 0; j < F.tid; ++j) { r0 += (sE[j] == e0) ? 1 : 0; r1 += (sE[128 + j] == e1) ? 1 : 0; }
            const int p0 = sPs[e0] + sBef[e0] + r0, p1 = sPs[33 + e1] + sBef[32 + e1] + r1;
            tokl[p0] = tile * 128 + F.tid; wl[p0] = w0; rsl[p0] = rsv; tokl[LISTCAP + p1] = tile * 128 + F.tid; wl[LISTCAP + p1] = w1; rsl[LISTCAP + p1] = rsv; }
        __syncthreads();
    }
}
__device__ __forceinline__ void phase_final(const Ctx& F, const float* SS) {
    const int gw = F.bid * NWAVES + F.wave, NGW = F.G * NWAVES, lane = F.lane;
    const f32x4* g = (const f32x4*)F.in[I_GFIN] + 2 * lane; const f32x4 g00 = g[0], g01 = g[1], g10 = g[128], g11 = g[129];
    u32x4 xr[2][4][2]; f32x4 sa[2][4];
#define FIN_LOAD(m0_, S) do { _Pragma("unroll") for (int r = 0; r < 4; ++r) { const int m = (m0_) + r * NGW < T ? (m0_) + r * NGW : gw; const u32x4* xp = (const u32x4*)((const bf16_t*)(F.ws + WS_XB) + (size_t)m * D) + lane; \
        xr[S][r][0] = xp[0]; xr[S][r][1] = xp[64]; sa[S][r] = *((const f32x4*)(SS + (size_t)m * 16) + (lane & 3)); } } while (0)
    FIN_LOAD(gw, 0);
    int par = 0;
#pragma unroll 1
    for (int m0 = gw; m0 < T; m0 += 8 * NGW) {
#pragma unroll
        for (int hs = 0; hs < 2; ++hs) { const int mb = m0 + hs * 4 * NGW; if (mb >= T) break;
            if (hs == 0) FIN_LOAD(mb + 4 * NGW, 1); else FIN_LOAD(mb + 4 * NGW, 0);
            asm volatile("" ::: "memory");
            PIN8(xr[hs][0][0], xr[hs][0][1], xr[hs][1][0], xr[hs][1][1], xr[hs][2][0], xr[hs][2][1], xr[hs][3][0], xr[hs][3][1]); PIN4(sa[hs][0], sa[hs][1], sa[hs][2], sa[hs][3]);
#pragma unroll
            for (int r = 0; r < 4; ++r) { const int m = mb + r * NGW; if (m >= T) break; float sq = (sa[hs][r].x + sa[hs][r].y) + (sa[hs][r].z + sa[hs][r].w); sq += __shfl_xor(sq, 1); sq += __shfl_xor(sq, 2);
                const float rs = rsqrtf(sq * (1.0f / 1024.0f) + EPS); f32x4* o = (f32x4*)(F.out + (size_t)m * D) + 2 * lane;
                f32x4 x0, x1; unpack8(xr[hs][r][0], x0, x1); o[0] = x0 * rs * g00; o[1] = x1 * rs * g01; unpack8(xr[hs][r][1], x0, x1); o[128] = x0 * rs * g10; o[129] = x1 * rs * g11; }
            asm volatile("" ::: "memory"); }
    }
    (void)par;
#undef FIN_LOAD
}
constexpr int PH_PER_LAYER = 15, PH_FINAL = DEPTH * PH_PER_LAYER, N_PHASES = PH_FINAL + 1;
struct Args { const float* in[28]; float* out; unsigned char* ws; int ph_lo, ph_hi; };

__device__ __forceinline__ Ctx mkctx(const Args& args, LAS unsigned char* lds, int wave_s) {
    Ctx F; asm volatile("" : "+s"(wave_s)); int tid = wave_s * 64 + lane_id_(); asm volatile("" : "+v"(tid));
    GAS unsigned char* wsg = (GAS unsigned char*)args.ws; asm volatile("" : "+s"(wsg)); unsigned char* ws = (unsigned char*)wsg;
    GAS float* outg = (GAS float*)args.out; asm volatile("" : "+s"(outg)); float* outp = (float*)outg;
    int bid = blockIdx.x; asm volatile("" : "+s"(bid)); int G = gridDim.x; asm volatile("" : "+s"(G));
    F.in.p = args.in; F.out = outp; F.ws = ws; F.lds = lds;
    F.tid = tid; F.lane = tid & 63; F.wave = wave_s; F.G = G; F.bid = bid;
    return F;
}
#ifndef ONLY_PHASE
#define ONLY_PHASE -1
#endif
#ifndef STAGGER_TICKS
#define STAGGER_TICKS 1300
#endif
__device__ __forceinline__ void run_phase(const Args& args, LAS unsigned char* lds, int ph, int wave_s) {
    const int layer = ph / PH_PER_LAYER, lp = ph - layer * PH_PER_LAYER;
    const size_t ssin = (layer & 1) ? WS_SS1 : WS_SS0, ssmid = (layer & 1) ? WS_SS0 : WS_SS1;
    if (ph == PH_FINAL) { const Ctx F = mkctx(args, lds, wave_s); phase_final(F, (const float*)(F.ws + WS_SS0)); return; }
    if (ONLY_PHASE >= 0 && lp != ONLY_PHASE) return;
    switch (lp) {
    case 0: { const Ctx F = mkctx(args, lds, wave_s); phase_prep(F, layer, (float*)(F.ws + ssin)); } break;
    case 1: { const Ctx F = mkctx(args, lds, wave_s); PhProj P{(const char*)F.ws + WS_XB, (const char*)F.ws + WS_WIN, (const float*)(F.ws + ssin), F.ws, F.G, F.bid}; pg8::gemm_phase(F.lds, P, F.tid); } break;
    case 2: { const Ctx F = mkctx(args, lds, wave_s);
        for (int it = F.bid; it < 768; it += F.G) attn_strip(F, it);
        __syncthreads();
        for (int it = F.bid; it < 1024; it += F.G) mlstm_local_mfma(F, layer, it);
        { f32x2 cwv[31]; const int cp = F.tid & 255; const float* cw = F.in[I_CONVW] + (size_t)layer * 31 * 512 + 2 * cp;
#pragma unroll
          for (int k = 0; k < 31; ++k) cwv[k] = *(const f32x2*)(cw + k * 512);
          const f32x2 cb = *(const f32x2*)(F.in[I_CONVB] + layer * 512 + 2 * cp);
          for (int it = F.bid; it < 1024; it += F.G) conv_item(F, layer, it, cwv, cb); }
    } break;
    case 3: { const Ctx F = mkctx(args, lds, wave_s); phase_scan(F);
        { const int nlow = F.G > 128 ? 128 : F.G, nv = nlow + 3 * (F.G - nlow);
          if (F.bid < nlow) attn_combine(F, F.bid, nv);
          else { const int v0 = nlow + 3 * (F.bid - nlow); attn_combine(F, v0, nv); attn_combine(F, v0 + 1, nv); attn_combine(F, v0 + 2, nv); } } } break;
    case 4: { const Ctx F = mkctx(args, lds, wave_s); for (int it = F.bid; it < 1024; it += F.G) mlstm_out_mfma(F, layer, it); } break;
    case 5: { const Ctx F = mkctx(args, lds, wave_s); PhGates P{(const char*)F.ws + WS_XB, (const char*)F.ws + WS_WIN, (const float*)(F.ws + ssin), F.ws, F.G, F.bid}; pg8::gemm_phase(F.lds, P, F.tid); } break;
    case 6: { const Ctx F = mkctx(args, lds, wave_s); PhMerge P{F.ws, F.G, F.bid};
        pg8::gemm_phase(F.lds, P, F.tid); } break;
    case 7: { const Ctx F = mkctx(args, lds, wave_s); PhOut P{F.ws, (float*)(F.ws + ssmid), F.G, F.bid}; pg8::gemm_phase(F.lds, P, F.tid);
        { int* tokl = (int*)(F.ws + WS_LISTS); float* rsl = (float*)(F.ws + WS_LISTS) + 4 * LISTCAP; for (int i = F.bid * NTHREADS + F.tid; i < 2 * LISTCAP; i += F.G * NTHREADS) { tokl[i] = -1; rsl[i] = 0.f; } } } break;
    case 8: { const Ctx F = mkctx(args, lds, wave_s); PhRouter P{F.ws, (const float*)(F.ws + ssmid), F.G, F.bid}; pg8::gemm_phase(F.lds, P, F.tid);
        for (int pm = F.bid; pm < 128; pm += F.G) phase_route(F, layer, 2 * pm);
        phase_prep_experts(F, layer);
        { const int nlow = F.G > 128 ? 128 : 0, nd = F.G - nlow;
          if (F.bid >= nlow) {
              if (F.tid == 0) { unsigned* barp = (unsigned*)(F.ws + WS_CTL) + 4096; const unsigned target = 128u * (unsigned)(layer + 1); XB_SPIN(xb_ld((unsigned*)(F.ws + WS_CTL) + 64) < target, barp);
                  __builtin_amdgcn_fence(__ATOMIC_ACQUIRE, "agent"); asm volatile("s_waitcnt vmcnt(0)" ::: "memory"); }
              __syncthreads();
              phase_dispatch(F, (const float*)(F.ws + ssmid), F.bid - nlow, nd); } } } break;
    case 9: break;
    case 10: break;
    case 11: { const Ctx F = mkctx(args, lds, wave_s); PhUp P{F.ws, (const float*)(F.ws + ssmid), (const int*)(F.ws + WS_TAB + TAB_META), (const int*)(F.ws + WS_LISTS), F.G, F.bid, (unsigned*)(F.ws + WS_CTL) + 128 + layer * 160}; pg8::gemm_phase(F.lds, P, F.tid); } break;
    case 12: { const Ctx F = mkctx(args, lds, wave_s); PhDown<1> P{F.ws, (float*)(F.ws + ssin), (const int*)(F.ws + WS_TAB + TAB_META), (const int*)(F.ws + WS_LISTS), (const float*)(F.ws + WS_LISTS) + 2 * LISTCAP, F.G, F.bid, (unsigned*)(F.ws + WS_CTL) + 128 + layer * 160}; pg8::gemm_phase(F.lds, P, F.tid); } break;
    case 13: { const Ctx F = mkctx(args, lds, wave_s); PhDown<0> P{F.ws, (float*)(F.ws + ssin), (const int*)(F.ws + WS_TAB + TAB_META), (const int*)(F.ws + WS_LISTS), (const float*)(F.ws + WS_LISTS) + 2 * LISTCAP, F.G, F.bid, (unsigned*)(F.ws + WS_CTL) + 128 + layer * 160}; pg8::gemm_phase(F.lds, P, F.tid);
        { PhPe Q{F.ws, (const int*)(F.ws + WS_TAB + TAB_META), F.G, F.bid}; pg8::gemm_phase(F.lds, Q, F.tid); } } break;
    case 14: { const Ctx F = mkctx(args, lds, wave_s); PhPle P{F.ws, (const float*)(F.ws + ssin), (float*)(F.ws + ssmid), F.G, F.bid}; pg8::gemm_phase(F.lds, P, F.tid); } break;
    }
}

__global__ void __launch_bounds__(NTHREADS, 2) fwd_kernel(Args args) {
    extern __shared__ __attribute__((aligned(16))) unsigned char lds_raw[];
    LAS unsigned char* lds = (LAS unsigned char*)lds_raw;
    volatile LAS unsigned* MISC = (volatile LAS unsigned*)(lds + MISC_OFF);
    const int wave_s = __builtin_amdgcn_readfirstlane((int)threadIdx.x >> 6);
    if (wave_s == 0) MISC[lane_id_()] = 0u;
    __syncthreads();
#if MK_MEGA
    XcdBarrier bar = xcd_barrier_post((unsigned*)(args.ws + WS_CTL) + 4096, MISC + 8, wave_s);
#endif
#ifndef PROBE_SEL
#define PROBE_SEL 0
#endif
    unsigned long long extra = 0ull;
    for (int ph = args.ph_lo; ph < args.ph_hi; ++ph) {
        if (ph < PH_FINAL && ((ph % PH_PER_LAYER) == 9 || (ph % PH_PER_LAYER) == 10)) continue;
        const unsigned long long t0 = PROBE_SEL ? __builtin_amdgcn_s_memrealtime() : 0ull;
        run_phase(args, lds, ph, wave_s);
#if MK_MEGA
        if (ph + 1 < args.ph_hi && !(ph < PH_FINAL && (ph % PH_PER_LAYER) == 11)) xcd_barrier(bar);
#endif
        if (PROBE_SEL) { const int lp = ph % PH_PER_LAYER; if (ph < PH_FINAL && ((PROBE_SEL >> lp) & 1)) extra += __builtin_amdgcn_s_memrealtime() - t0; }
    }
    if (PROBE_SEL && blockIdx.x == 0) { const unsigned long long te = __builtin_amdgcn_s_memrealtime(); while (__builtin_amdgcn_s_memrealtime() - te < extra) __builtin_amdgcn_s_sleep(8); }
}

extern "C" void kernel_launch(void* const* d_in, const int* in_sizes, int n_in, void* d_out, int out_size, void* d_ws, size_t ws_size, hipStream_t stream) {
    static int grid = 0;
    if (grid == 0) {
        if (n_in != 28 || out_size != T * D || ws_size < WS_END) { fprintf(stderr, "kernel_launch: unexpected shapes (n_in %d out %d ws %zu, need %zu)\n", n_in, out_size, ws_size, (size_t)WS_END); grid = -1; return; }
        int dev = 0, cus = 0, per_cu = 0;
        if (hipGetDevice(&dev) != hipSuccess || hipDeviceGetAttribute(&cus, hipDeviceAttributeMultiprocessorCount, dev) != hipSuccess) { grid = -1; return; }
        if (hipFuncSetAttribute((const void*)fwd_kernel, hipFuncAttributeMaxDynamicSharedMemorySize, LDS_BYTES) != hipSuccess) { fprintf(stderr, "kernel_launch: hipFuncSetAttribute failed\n"); grid = -1; return; }
        if (hipOccupancyMaxActiveBlocksPerMultiprocessor(&per_cu, (const void*)fwd_kernel, NTHREADS, LDS_BYTES) != hipSuccess || per_cu < 1) { fprintf(stderr, "kernel_launch: occupancy query says %d blocks per CU\n", per_cu); }
        (void)hipGetLastError();
        grid = cus;
    }
    if (grid < 0) return;
    Args a{};
    for (int i = 0; i < 28; ++i) a.in[i] = (const float*)d_in[i];
    a.out = (float*)d_out; a.ws = (unsigned char*)d_ws;
#if MK_MEGA
    (void)hipMemsetAsync((char*)d_ws + WS_CTL, 0, CTL_ZERO_BYTES, stream);
    a.ph_lo = 0; a.ph_hi = N_PHASES;
    hipLaunchKernelGGL(fwd_kernel, dim3(grid), dim3(NTHREADS), LDS_BYTES, stream, a);
#else
    for (int ph = 0; ph < N_PHASES; ++ph) { a.ph_lo = ph; a.ph_hi = ph + 1; hipLaunchKernelGGL(fwd_kernel, dim3(grid), dim3(NTHREADS), LDS_BYTES, stream, a); }
#endif
}
```
